# Optimizing an MI355X kernel written in HIP

```python
import jax, jax.numpy as jnp
from jax import lax
import numpy as np

D_MODEL = 1024
BATCH = 4
SEQ = 8192
DEPTH = 1

ATTN_HEADS = 8
HEAD_DIM = 64
ATTN_WIDTH = ATTN_HEADS * HEAD_DIM
MOBA_BLOCK = 256
MOBA_TOPK = 3
Q_CHUNK = 32
LRU_WIDTH = D_MODEL - ATTN_WIDTH
LRU_HEADS = 8
LRU_HEAD_DIM = LRU_WIDTH // LRU_HEADS
LRU_CONV = 4
LRU_C = 8.0
N_IN = 3 * ATTN_WIDTH + 2 * LRU_WIDTH
D_FF = 2816
FFN_CONV = 3
N_MOD = 6
EPS = 1e-6

kernel_name = "hymba_rglru_moba_convffn_adaln"


def rmsnorm(x, g):
    xf = x.astype(jnp.float32)
    y = xf * lax.rsqrt(jnp.mean(xf * xf, axis=-1, keepdims=True) + EPS)
    return (y * g.astype(jnp.float32)).astype(x.dtype)


def causal_dwconv(x, w, b):
    K = w.shape[0]
    S = x.shape[1]
    xp = jnp.pad(x, ((0, 0), (K - 1, 0), (0, 0)))
    y = xp[:, 0:S] * w[0]
    for j in range(1, K):
        y = y + xp[:, j:j + S] * w[j]
    return y + b


def rg_lru(xb, w_a, b_a, w_x, b_x, lam):
    B, S, _ = xb.shape
    xh = xb.reshape(B, S, LRU_HEADS, LRU_HEAD_DIM)
    r = jax.nn.sigmoid(jnp.einsum('bshi,hij->bshj', xh, w_a).reshape(B, S, LRU_WIDTH) + b_a)
    i = jax.nn.sigmoid(jnp.einsum('bshi,hij->bshj', xh, w_x).reshape(B, S, LRU_WIDTH) + b_x)
    log_a = -LRU_C * r.astype(jnp.float32) * jax.nn.softplus(-lam.astype(jnp.float32))
    a = jnp.exp(log_a)
    u = jnp.sqrt(-jnp.expm1(2.0 * log_a)) * (i * xb).astype(jnp.float32)

    def combine(left, right):
        a1, b1 = left
        a2, b2 = right
        return a1 * a2, a2 * b1 + b2

    _, h = lax.associative_scan(combine, (a, u), axis=1)
    return h.astype(xb.dtype)


def moba_attention(q, k, v):
    B, S, H, Dh = q.shape
    nb = -(-S // MOBA_BLOCK)
    s_pad = nb * MOBA_BLOCK
    pad = ((0, 0), (0, s_pad - S), (0, 0), (0, 0))
    q, k, v = [jnp.pad(t, pad).transpose(0, 2, 1, 3) for t in (q, k, v)]
    k_blk = k.reshape(B, H, nb, MOBA_BLOCK, Dh)
    v_blk = v.reshape(B, H, nb, MOBA_BLOCK, Dh)
    k_mean = jnp.mean(k_blk.astype(jnp.float32), axis=3)
    gate = jnp.einsum('bhsd,bhnd->bhsn', q.astype(jnp.float32), k_mean)
    q_blk_id = jnp.arange(s_pad) // MOBA_BLOCK
    past = jnp.arange(nb)[None, :] < q_blk_id[:, None]
    gate = jnp.where(past, gate, -jnp.inf)
    n_sel = min(MOBA_TOPK, nb)
    top_v, top_i = lax.top_k(gate, n_sel)
    sel_valid = jnp.isfinite(top_v)
    own = jnp.broadcast_to(q_blk_id[None, None, :, None], (B, H, s_pad, 1)).astype(top_i.dtype)
    blk_idx = jnp.concatenate([top_i, own], axis=-1)
    blk_valid = jnp.concatenate([sel_valid, jnp.ones(own.shape, dtype=bool)], axis=-1)

    nc = s_pad // Q_CHUNK

    def to_chunks(t):
        return jnp.moveaxis(t.reshape(B, H, nc, Q_CHUNK, *t.shape[3:]), 2, 0)

    bi = jnp.arange(B)[:, None, None, None]
    hi = jnp.arange(H)[None, :, None, None]
    offs = jnp.arange(MOBA_BLOCK)
    scale = Dh ** -0.5

    def chunk_attn(args):
        c_idx, qc, idx, valid = args
        kg = k_blk[bi, hi, idx]
        vg = v_blk[bi, hi, idx]
        s = jnp.einsum('bhqd,bhqnkd->bhqnk', qc, kg).astype(jnp.float32) * scale
        q_pos = c_idx * Q_CHUNK + jnp.arange(Q_CHUNK)
        k_pos = idx[..., None] * MOBA_BLOCK + offs
        mask = valid[..., None] & (k_pos <= q_pos[:, None, None])
        s = jnp.where(mask, s, -jnp.inf)
        p = jax.nn.softmax(s.reshape(B, H, Q_CHUNK, -1), axis=-1).reshape(s.shape)
        return jnp.einsum('bhqnk,bhqnkd->bhqd', p.astype(vg.dtype), vg)

    out = lax.map(chunk_attn, (jnp.arange(nc), to_chunks(q), to_chunks(blk_idx), to_chunks(blk_valid)))
    out = jnp.moveaxis(out, 0, 2).reshape(B, H, s_pad, Dh)[:, :, :S]
    return out.transpose(0, 2, 1, 3).reshape(B, S, H * Dh)


def setup_inputs(seed: int = 0) -> dict:
    key = jax.random.key(seed)
    ks = jax.random.split(key, 24)
    f32 = jnp.float32
    nrm = lambda k, shape, s: jax.random.normal(k, shape, f32) * s
    gain = lambda k, shape: 1.0 + 0.02 * jax.random.normal(k, shape, f32)
    u = jax.random.uniform(ks[14], (DEPTH, LRU_WIDTH), f32, 0.9, 0.999)
    a_base = u ** (1.0 / LRU_C)
    lru_lambda = jnp.log(a_base) - jnp.log1p(-a_base)
    return {
        "x": jax.random.normal(ks[0], (BATCH, SEQ, D_MODEL), f32),
        "c": jax.random.normal(ks[1], (BATCH, D_MODEL), f32),
        "w_ada": nrm(ks[2], (DEPTH, D_MODEL, N_MOD * D_MODEL), 0.5 * D_MODEL ** -0.5),
        "b_ada": nrm(ks[3], (DEPTH, N_MOD * D_MODEL), 0.02),
        "norm1_g": gain(ks[4], (DEPTH, D_MODEL)),
        "w_in": nrm(ks[5], (DEPTH, D_MODEL, N_IN), D_MODEL ** -0.5),
        "q_norm_g": gain(ks[6], (DEPTH, HEAD_DIM)),
        "k_norm_g": gain(ks[7], (DEPTH, HEAD_DIM)),
        "lru_conv_w": nrm(ks[8], (DEPTH, LRU_CONV, LRU_WIDTH), LRU_CONV ** -0.5),
        "lru_conv_b": nrm(ks[9], (DEPTH, LRU_WIDTH), 0.02),
        "lru_wa": nrm(ks[10], (DEPTH, LRU_HEADS, LRU_HEAD_DIM, LRU_HEAD_DIM), LRU_HEAD_DIM ** -0.5),
        "lru_ba": nrm(ks[11], (DEPTH, LRU_WIDTH), 0.02),
        "lru_wx": nrm(ks[12], (DEPTH, LRU_HEADS, LRU_HEAD_DIM, LRU_HEAD_DIM), LRU_HEAD_DIM ** -0.5),
        "lru_bx": nrm(ks[13], (DEPTH, LRU_WIDTH), 0.02),
        "lru_lambda": lru_lambda,
        "lru_out_g": gain(ks[15], (DEPTH, LRU_WIDTH)),
        "attn_out_g": gain(ks[16], (DEPTH, ATTN_WIDTH)),
        "w_out": nrm(ks[17], (DEPTH, D_MODEL, D_MODEL), D_MODEL ** -0.5),
        "norm2_g": gain(ks[18], (DEPTH, D_MODEL)),
        "w_up": nrm(ks[19], (DEPTH, D_MODEL, 2 * D_FF), D_MODEL ** -0.5),
        "ffn_conv_w": nrm(ks[20], (DEPTH, FFN_CONV, 2 * D_FF), FFN_CONV ** -0.5),
        "ffn_conv_b": nrm(ks[21], (DEPTH, 2 * D_FF), 0.02),
        "w_down": nrm(ks[22], (DEPTH, D_FF, D_MODEL), D_FF ** -0.5),
    }


def reference(x, c, w_ada, b_ada, norm1_g, w_in, q_norm_g, k_norm_g, lru_conv_w, lru_conv_b,
              lru_wa, lru_ba, lru_wx, lru_bx, lru_lambda, lru_out_g, attn_out_g, w_out,
              norm2_g, w_up, ffn_conv_w, ffn_conv_b, w_down):
    B, S, D = x.shape
    for l in range(DEPTH):
        mod = (c @ w_ada[l] + b_ada[l])[:, None, :]
        sh1, sc1, g1, sh2, sc2, g2 = jnp.split(mod, N_MOD, axis=-1)

        h = rmsnorm(x, norm1_g[l]) * (1.0 + sc1) + sh1
        z = h @ w_in[l]
        q, k, v, xr, gr = jnp.split(
            z, [ATTN_WIDTH, 2 * ATTN_WIDTH, 3 * ATTN_WIDTH, 3 * ATTN_WIDTH + LRU_WIDTH], axis=-1)
        q = rmsnorm(q.reshape(B, S, ATTN_HEADS, HEAD_DIM), q_norm_g[l])
        k = rmsnorm(k.reshape(B, S, ATTN_HEADS, HEAD_DIM), k_norm_g[l])
        v = v.reshape(B, S, ATTN_HEADS, HEAD_DIM)
        attn = moba_attention(q, k, v)
        xr = causal_dwconv(xr, lru_conv_w[l], lru_conv_b[l])
        lru = rg_lru(xr, lru_wa[l], lru_ba[l], lru_wx[l], lru_bx[l], lru_lambda[l]) * jax.nn.gelu(gr)
        mix = jnp.concatenate([rmsnorm(lru, lru_out_g[l]), rmsnorm(attn, attn_out_g[l])], axis=-1)
        x = x + g1 * (mix @ w_out[l])

        h2 = rmsnorm(x, norm2_g[l]) * (1.0 + sc2) + sh2
        up = causal_dwconv(h2 @ w_up[l], ffn_conv_w[l], ffn_conv_b[l])
        gate, val = jnp.split(up, 2, axis=-1)
        x = x + g2 * ((jax.nn.silu(gate) * val) @ w_down[l])
    return x
```

```cpp
#include <hip/hip_runtime.h>
#include <cstdio>
#include <cstdint>

#define GAS __attribute__((address_space(1)))
#define LAS __attribute__((address_space(3)))
typedef unsigned short u16;
typedef short s16x8 __attribute__((ext_vector_type(8)));
typedef _Float16 f16x8 __attribute__((ext_vector_type(8)));
typedef __bf16 bf16x8_t __attribute__((ext_vector_type(8)));
typedef float f32x2 __attribute__((ext_vector_type(2)));
typedef float f32x4 __attribute__((ext_vector_type(4)));
typedef float f32x16 __attribute__((ext_vector_type(16)));
typedef unsigned u32x4 __attribute__((ext_vector_type(4)));
typedef unsigned u32x2 __attribute__((ext_vector_type(2)));
typedef GAS unsigned gu32;
#define RLX_AGENT __ATOMIC_RELAXED, __HIP_MEMORY_SCOPE_AGENT

constexpr int D_MODEL = 1024, BATCH = 4, SEQ = 8192, M_TOK = BATCH * SEQ;
constexpr int N_IN = 2560, D_FF = 2816, N_UP = 2 * D_FF, N_MOD = 6 * D_MODEL;
constexpr int NHEAD = 8, HD = 64, AW = 512, NBLK = 32, BLK = 256;
constexpr float EPS = 1e-6f;
constexpr float LOG2E = 1.4426950408889634f;

__device__ __forceinline__ unsigned cvt_pk_bf16(float lo, float hi) { unsigned r; asm volatile("v_cvt_pk_bf16_f32 %0, %1, %2" : "=v"(r) : "v"(lo), "v"(hi)); return r; }
__device__ __forceinline__ unsigned cvt_pk_f16(float lo, float hi) {
    const _Float16 a = (_Float16)lo, b = (_Float16)hi;
    return (unsigned)__builtin_bit_cast(unsigned short, a) | ((unsigned)__builtin_bit_cast(unsigned short, b) << 16);
}
__device__ __forceinline__ float bf_lo(unsigned w) { return __builtin_bit_cast(float, w << 16); }
__device__ __forceinline__ float bf_hi(unsigned w) { return __builtin_bit_cast(float, w & 0xffff0000u); }
__device__ __forceinline__ float sigmoidf_(float v) { return __builtin_amdgcn_rcpf(1.0f + __builtin_amdgcn_exp2f(-v * LOG2E)); }
__device__ __forceinline__ float gelu_tanh(float v) { const float y = 0.7978845608028654f * (v + 0.044715f * v * v * v); return v * sigmoidf_(2.0f * y); }
__device__ __forceinline__ float wave_sum(float v) {
#pragma unroll
    for (int o = 1; o < 64; o <<= 1) v += __shfl_xor(v, o);
    return v;
}

namespace pg8 {
constexpr int BM = 256, BK = 64, HALF = 128, HTB = HALF * BK * 2, STAGE_BYTES = 8 * HTB, NXCD = 8, WGM = 8;
__host__ __device__ __forceinline__ int lds_byte(int r, int c) { const int st = (r >> 4) * 2 + (c >> 5), rr = r & 15, cc = c & 31, ob = rr * 64 + cc * 2; return st * 1024 + (ob ^ (((ob >> 9) & 1) << 5)); }
__host__ __device__ __forceinline__ void stage_rc(int b, int& R, int& C) { const int st = b / 1024, sb = b % 1024, swz = sb ^ (((sb >> 9) & 1) << 5); R = (st >> 1) * 16 + swz / 64; C = (st & 1) * 32 + (swz % 64) / 2; }
__host__ __device__ __forceinline__ int perm32(int rho) { const int n = rho >> 4, i = rho & 15; return 8 * (i >> 2) + 4 * n + (i & 3); }

struct Unit { int pm, pn; };
struct Gemm { const u16* A; const u16* Bt; int M, N, K; };

struct StaticOrder {
    int nM, nN, nwg, G, c;
    __host__ __device__ void init(int M, int N, int G_, int c_) { nM = M / BM; nN = N / BM; nwg = nM * nN; G = G_; c = c_; }
    __host__ __device__ bool next(int i, Unit& u) const {
        const long L = (long)i * G + c; if (L >= nwg) return false;
        int wgid = (int)L; { const int q = nwg / NXCD, r = nwg % NXCD, xcd = wgid % NXCD, off = wgid / NXCD; wgid = (xcd < r ? xcd * (q + 1) : r * (q + 1) + (xcd - r) * q) + off; }
        const int nig = WGM * nN, gid = wgid / nig, fm = gid * WGM, gsz = (nM - fm) < WGM ? (nM - fm) : WGM;
        u.pm = fm + ((wgid % nig) % gsz); u.pn = (wgid % nig) / gsz; return true;
    }
    __device__ __forceinline__ void a_ready(const Unit&) const {}
    __device__ __forceinline__ void done(const Unit&) const {}
};

template <bool F16> __device__ __forceinline__ f32x4 mfma16(s16x8 a, s16x8 b, f32x4 c) {
    if constexpr (F16) return __builtin_amdgcn_mfma_f32_16x16x32_f16(__builtin_bit_cast(f16x8, a), __builtin_bit_cast(f16x8, b), c, 0, 0, 0);
    else return __builtin_amdgcn_mfma_f32_16x16x32_bf16(__builtin_bit_cast(bf16x8_t, a), __builtin_bit_cast(bf16x8_t, b), c, 0, 0, 0);
}

template <class Epi, class Sched, bool ALIGN_EPI, bool SP2, bool F16>
__device__ __forceinline__ void gemm_phase(LAS unsigned char* lds, const Gemm g, const Sched& S, const Epi& E) {
    const int tid = threadIdx.x, wid = __builtin_amdgcn_readfirstlane(tid >> 6), lane = tid & 63, wr = wid >> 2, wc = wid & 3, fr = lane & 15, fq = lane >> 4;
    const int K = g.K, nt = K / BK;
    unsigned voffA[2], voffB[2];
#pragma unroll
    for (int i = 0; i < 2; ++i) { int R, C; stage_rc(tid * 16 + i * 8192, R, C); const int Rb = Epi::PERM ? ((R & ~31) + perm32(R & 31)) : R;
        voffA[i] = (unsigned)(R * K + C) * 2u; voffB[i] = (unsigned)(Rb * K + C) * 2u; }
    const size_t kstep = (size_t)(BK * 2);
    const size_t hstep = (size_t)HALF * K * 2;
    const size_t tstep = 2 * hstep;
    const unsigned ldsw = (unsigned)wid * 1024u;
    const int aoff = lds_byte(wr * 64 + fr, fq * 8), boff = lds_byte(wc * 32 + fr, fq * 8);
#define PG8_SA(b, h) (((b) * 2 + (h)) * HTB)
#define PG8_SB(b, h) ((4 + (b) * 2 + (h)) * HTB)
#define PG8_STAGE(bufoff, gbase, voff) do { _Pragma("unroll") for (int _i = 0; _i < 2; ++_i) \
        __builtin_amdgcn_global_load_lds((const unsigned*)((const char*)(gbase) + (voff)[_i]), (LAS unsigned*)(lds + (bufoff) + ldsw + _i * 8192), 16, 0, 0); } while (0)
#define PG8_LDA(dst, b, h) do { _Pragma("unroll") for (int m = 0; m < 4; ++m) _Pragma("unroll") for (int k = 0; k < 2; ++k) dst[m][k] = *(const LAS s16x8*)(lds + PG8_SA(b, h) + aoff + m * 2048 + k * 1024); } while (0)
#define PG8_LDB(dst, b, h) do { _Pragma("unroll") for (int n = 0; n < 2; ++n) _Pragma("unroll") for (int k = 0; k < 2; ++k) dst[n][k] = *(const LAS s16x8*)(lds + PG8_SB(b, h) + boff + n * 2048 + k * 1024); } while (0)
#define PG8_MMA(ai, bj, At, Bt) do { __builtin_amdgcn_s_setprio(1); _Pragma("unroll") for (int m = 0; m < 4; ++m) _Pragma("unroll") for (int n = 0; n < 2; ++n) _Pragma("unroll") for (int k = 0; k < 2; ++k) \
        acc[ai][bj][m][n] = mfma16<F16>(Bt[n][k], At[m][k], acc[ai][bj][m][n]); __builtin_amdgcn_s_setprio(0); } while (0)
#define PG8_WAIT_V(n) asm volatile("s_waitcnt vmcnt(" #n ")" ::: "memory")
#define PG8_WAIT_L(n) asm volatile("s_waitcnt lgkmcnt(" #n ")" ::: "memory")
#define PG8_BAR __builtin_amdgcn_s_barrier()
#define PG8_SCHED __builtin_amdgcn_sched_barrier(0)
    Unit cur, nxt; int ui = 0;
    if (!S.next(0, cur)) return;
    f32x4 acc[2][2][4][2];
#pragma unroll
    for (int a = 0; a < 2; ++a)
#pragma unroll
        for (int b = 0; b < 2; ++b)
#pragma unroll
            for (int m = 0; m < 4; ++m)
#pragma unroll
                for (int n = 0; n < 2; ++n) acc[a][b][m][n] = (f32x4){0.f, 0.f, 0.f, 0.f};
    s16x8 At[4][2], B0[2][2], B1[2][2];
    const char* cA = (const char*)g.A + (size_t)cur.pm * tstep; const char* cB = (const char*)g.Bt + (size_t)cur.pn * tstep;
    S.a_ready(cur);
    if constexpr (SP2) {
        PG8_STAGE(PG8_SB(0, 0), cB, voffB); PG8_STAGE(PG8_SB(0, 1), cB + hstep, voffB); PG8_STAGE(PG8_SA(0, 0), cA, voffA); PG8_STAGE(PG8_SA(0, 1), cA + hstep, voffA);
        if (wr == 1) PG8_BAR;
        PG8_WAIT_V(2); PG8_BAR;
        PG8_STAGE(PG8_SB(1, 0), cB + kstep, voffB); PG8_STAGE(PG8_SA(1, 0), cA + kstep, voffA); PG8_STAGE(PG8_SB(1, 1), cB + hstep + kstep, voffB);
        PG8_WAIT_V(6); PG8_BAR;
    } else {
        PG8_STAGE(PG8_SB(0, 0), cB, voffB); PG8_STAGE(PG8_SA(0, 0), cA, voffA); PG8_STAGE(PG8_SB(0, 1), cB + hstep, voffB); PG8_STAGE(PG8_SA(0, 1), cA + hstep, voffA);
        if (wr == 1) PG8_BAR;
        PG8_WAIT_V(4); PG8_BAR;
        PG8_STAGE(PG8_SB(1, 0), cB + kstep, voffB); PG8_STAGE(PG8_SA(1, 0), cA + kstep, voffA); PG8_STAGE(PG8_SB(1, 1), cB + hstep + kstep, voffB);
        PG8_WAIT_V(6); PG8_BAR;
    }
    for (;;) {
        const bool has_next = S.next(ui + 1, nxt);
        const char* nA = has_next ? (const char*)g.A + (size_t)nxt.pm * tstep : cA; const char* nB = has_next ? (const char*)g.Bt + (size_t)nxt.pn * tstep : cB;
        for (int t = 0; t < nt; t += 2) {
            const bool last = (t == nt - 2);
            const char* a1 = cA + (size_t)(t + 1) * kstep;
            const char* a2 = last ? nA : cA + (size_t)(t + 2) * kstep; const char* b2 = last ? nB : cB + (size_t)(t + 2) * kstep;
            const char* a3 = a2 + kstep; const char* b3 = b2 + kstep;
            if (last && has_next) S.a_ready(nxt);
            if constexpr (SP2) {
            PG8_LDB(B0, 0, 0); PG8_LDB(B1, 0, 1); PG8_SCHED; PG8_LDA(At, 0, 0); PG8_STAGE(PG8_SA(1, 1), a1 + hstep, voffA);
            PG8_WAIT_V(8); PG8_WAIT_L(0); PG8_BAR; PG8_MMA(0, 0, At, B0); PG8_MMA(0, 1, At, B1); PG8_BAR; PG8_SCHED;
            PG8_LDA(At, 0, 1); PG8_STAGE(PG8_SB(0, 0), b2, voffB); PG8_STAGE(PG8_SB(0, 1), b2 + hstep, voffB); PG8_STAGE(PG8_SA(0, 0), a2, voffA);
            PG8_WAIT_V(8); PG8_WAIT_L(0); PG8_BAR; PG8_MMA(1, 0, At, B0); PG8_MMA(1, 1, At, B1); PG8_BAR; PG8_SCHED;
            PG8_LDB(B0, 1, 0); PG8_LDB(B1, 1, 1); PG8_SCHED; PG8_LDA(At, 1, 0); PG8_STAGE(PG8_SA(0, 1), a2 + hstep, voffA);
            PG8_WAIT_V(8); PG8_WAIT_L(0); PG8_BAR; PG8_MMA(0, 0, At, B0); PG8_MMA(0, 1, At, B1); PG8_BAR; PG8_SCHED;
            PG8_LDA(At, 1, 1); PG8_STAGE(PG8_SB(1, 0), b3, voffB); PG8_STAGE(PG8_SB(1, 1), b3 + hstep, voffB); PG8_STAGE(PG8_SA(1, 0), a3, voffA);
            PG8_WAIT_V(8); PG8_WAIT_L(0); PG8_BAR; PG8_MMA(1, 0, At, B0); PG8_MMA(1, 1, At, B1); PG8_BAR; PG8_SCHED;
            } else {
            PG8_LDB(B0, 0, 0); PG8_SCHED; PG8_LDA(At, 0, 0); PG8_STAGE(PG8_SA(1, 1), a1 + hstep, voffA);
            PG8_WAIT_L(8); PG8_BAR; PG8_WAIT_L(0); PG8_MMA(0, 0, At, B0); PG8_BAR; PG8_SCHED;
            PG8_LDB(B1, 0, 1); PG8_STAGE(PG8_SB(0, 0), b2, voffB);
            PG8_BAR; PG8_WAIT_L(0); PG8_MMA(0, 1, At, B1); PG8_BAR;
            PG8_LDA(At, 0, 1); PG8_STAGE(PG8_SA(0, 0), a2, voffA);
            PG8_BAR; PG8_WAIT_L(0); PG8_MMA(1, 0, At, B0); PG8_BAR; PG8_SCHED;
            PG8_STAGE(PG8_SB(0, 1), b2 + hstep, voffB);
            PG8_WAIT_V(6); PG8_BAR; PG8_MMA(1, 1, At, B1); PG8_BAR;
            PG8_LDB(B0, 1, 0); PG8_SCHED; PG8_LDA(At, 1, 0); PG8_STAGE(PG8_SA(0, 1), a2 + hstep, voffA);
            PG8_WAIT_L(8); PG8_BAR; PG8_WAIT_L(0); PG8_MMA(0, 0, At, B0); PG8_BAR; PG8_SCHED;
            PG8_LDB(B1, 1, 1); PG8_STAGE(PG8_SB(1, 0), b3, voffB);
            PG8_BAR; PG8_WAIT_L(0); PG8_MMA(0, 1, At, B1); PG8_BAR;
            PG8_LDA(At, 1, 1); PG8_STAGE(PG8_SA(1, 0), a3, voffA);
            PG8_BAR; PG8_WAIT_L(0); PG8_MMA(1, 0, At, B0); PG8_BAR; PG8_SCHED;
            PG8_STAGE(PG8_SB(1, 1), b3 + hstep, voffB);
            PG8_WAIT_V(6); PG8_BAR; PG8_MMA(1, 1, At, B1); PG8_BAR;
            }
        }
        if constexpr (ALIGN_EPI) { if (wr == 0) PG8_BAR; }
        E(acc, cur, wr, wc, fr, fq); S.done(cur);
        if (!has_next) break;
#pragma unroll
        for (int a = 0; a < 2; ++a)
#pragma unroll
            for (int b = 0; b < 2; ++b)
#pragma unroll
                for (int m = 0; m < 4; ++m)
#pragma unroll
                    for (int n = 0; n < 2; ++n) acc[a][b][m][n] = (f32x4){0.f, 0.f, 0.f, 0.f};
        cur = nxt; cA = nA; cB = nB; ++ui;
        if constexpr (ALIGN_EPI) { if (wr == 1) PG8_BAR; }
    }
    PG8_WAIT_V(0);
    if constexpr (!ALIGN_EPI) { if (wr == 0) PG8_BAR; }
    PG8_BAR;
#undef PG8_SA
#undef PG8_SB
#undef PG8_STAGE
#undef PG8_LDA
#undef PG8_LDB
#undef PG8_MMA
#undef PG8_WAIT_V
#undef PG8_WAIT_L
#undef PG8_BAR
#undef PG8_SCHED
}

struct EpiBf16 {
    static constexpr bool PERM = true;
    u16* O; int ldc;
    __device__ __forceinline__ void operator()(const f32x4 (&acc)[2][2][4][2], const Unit& u, int wr, int wc, int fr, int fq) const {
        const int row0 = u.pm * BM + wr * 64 + fr; const int col0 = u.pn * BM + wc * 32 + 8 * fq;
#pragma unroll
        for (int ai = 0; ai < 2; ++ai)
#pragma unroll
            for (int m = 0; m < 4; ++m) { u16* rowp = O + (size_t)(row0 + ai * HALF + m * 16) * ldc + col0;
#pragma unroll
                for (int bj = 0; bj < 2; ++bj) { const f32x4 v0 = acc[ai][bj][m][0], v1 = acc[ai][bj][m][1];
                    u32x4 w; w.x = cvt_pk_bf16(v0[0], v0[1]); w.y = cvt_pk_bf16(v0[2], v0[3]); w.z = cvt_pk_bf16(v1[0], v1[1]); w.w = cvt_pk_bf16(v1[2], v1[3]);
                    *(u32x4*)(rowp + bj * HALF) = w; } }
    }
};
struct EpiResid {
    static constexpr bool PERM = false;
    const float* base; float* out; const float* gate;
    __device__ __forceinline__ void operator()(const f32x4 (&acc)[2][2][4][2], const Unit& u, int wr, int wc, int fr, int fq) const {
        const int row0 = u.pm * BM + wr * 64 + fr, col0 = u.pn * BM + wc * 32 + 4 * fq;
        const int b = (u.pm * BM) / SEQ;
        f32x4 gv[2][2];
#pragma unroll
        for (int bj = 0; bj < 2; ++bj)
#pragma unroll
            for (int n = 0; n < 2; ++n) gv[bj][n] = *(const f32x4*)(gate + (size_t)b * N_MOD + col0 + bj * HALF + n * 16);
#pragma unroll
        for (int ai = 0; ai < 2; ++ai)
#pragma unroll
            for (int m = 0; m < 4; ++m) { const size_t off = (size_t)(row0 + ai * HALF + m * 16) * D_MODEL + col0;
#pragma unroll
                for (int bj = 0; bj < 2; ++bj)
#pragma unroll
                    for (int n = 0; n < 2; ++n) { const f32x4 bs = *(const f32x4*)(base + off + bj * HALF + n * 16);
                        *(f32x4*)(out + off + bj * HALF + n * 16) = bs + gv[bj][n] * acc[ai][bj][m][n]; } }
    }
};
struct EpiInProj {
    static constexpr bool PERM = true;
    float* QF; u16* KB; u16* VT; u16* XR; u16* GG; float* KM; const float* gq; const float* gk;
    __device__ __forceinline__ void operator()(const f32x4 (&acc)[2][2][4][2], const Unit& u, int wr, int wc, int fr, int fq) const {
        const int type = u.pn >> 1, head = (u.pn & 1) * 4 + wc;
        const int b = (u.pm * BM) / SEQ, blk = u.pm % NBLK;
        const int tok0 = u.pm * BM + wr * 64 + fr;
        const int bh = b * NHEAD + head;
        if (type <= 1) {
            const float* gp = type == 0 ? gq : gk;
            f32x4 gv[2][2];
#pragma unroll
            for (int bj = 0; bj < 2; ++bj)
#pragma unroll
                for (int n = 0; n < 2; ++n) gv[bj][n] = *(const f32x4*)(gp + 32 * bj + 8 * fq + 4 * n);
            f32x4 cs[2][2];
#pragma unroll
            for (int bj = 0; bj < 2; ++bj)
#pragma unroll
                for (int n = 0; n < 2; ++n) cs[bj][n] = (f32x4){0.f, 0.f, 0.f, 0.f};
#pragma unroll
            for (int ai = 0; ai < 2; ++ai)
#pragma unroll
                for (int m = 0; m < 4; ++m) {
                    float ss = 0.f;
#pragma unroll
                    for (int bj = 0; bj < 2; ++bj)
#pragma unroll
                        for (int n = 0; n < 2; ++n) { const f32x4 x = acc[ai][bj][m][n]; ss += (x[0] * x[0] + x[1] * x[1]) + (x[2] * x[2] + x[3] * x[3]); }
                    ss += __shfl_xor(ss, 16); ss += __shfl_xor(ss, 32);
                    const float rstd = 1.0f / sqrtf(ss * (1.0f / 64.0f) + EPS);
                    const int tok = tok0 + ai * HALF + m * 16, s = tok % SEQ;
                    const size_t rowoff = ((size_t)bh * SEQ + s) * HD + 8 * fq;
#pragma unroll
                    for (int bj = 0; bj < 2; ++bj) {
                        const f32x4 v0 = acc[ai][bj][m][0] * rstd * gv[bj][0], v1 = acc[ai][bj][m][1] * rstd * gv[bj][1];
                        if (type == 0) { *(f32x4*)(QF + rowoff + 32 * bj) = v0; *(f32x4*)(QF + rowoff + 32 * bj + 4) = v1; }
                        else { u32x4 w; w.x = cvt_pk_bf16(v0[0], v0[1]); w.y = cvt_pk_bf16(v0[2], v0[3]); w.z = cvt_pk_bf16(v1[0], v1[1]); w.w = cvt_pk_bf16(v1[2], v1[3]);
                            *(u32x4*)(KB + rowoff + 32 * bj) = w; cs[bj][0] += v0; cs[bj][1] += v1; }
                    }
                }
            if (type == 1) {
#pragma unroll
                for (int bj = 0; bj < 2; ++bj)
#pragma unroll
                    for (int n = 0; n < 2; ++n)
#pragma unroll
                        for (int i = 0; i < 4; ++i) { float v = cs[bj][n][i]; v += __shfl_xor(v, 1); v += __shfl_xor(v, 2); v += __shfl_xor(v, 4); v += __shfl_xor(v, 8);
                            if (fr == 0) atomicAdd(KM + (((size_t)(b * NBLK + blk) * NHEAD + head) * HD + 32 * bj + 8 * fq + 4 * n + i), v); }
            }
        } else if (type == 2) {
            const int pfr = 8 * ((fr >> 2) & 1) + 4 * (fr >> 3) + (fr & 3);
#pragma unroll
            for (int ai = 0; ai < 2; ++ai)
#pragma unroll
                for (int m = 0; m < 4; ++m) { const int tok = tok0 + ai * HALF + m * 16, s = tok % SEQ; const int spos = (s & ~15) + pfr;
#pragma unroll
                    for (int bj = 0; bj < 2; ++bj)
#pragma unroll
                        for (int n = 0; n < 2; ++n) { const f32x4 x = acc[ai][bj][m][n]; const unsigned w0 = cvt_pk_bf16(x[0], x[1]), w1 = cvt_pk_bf16(x[2], x[3]);
                            u16* dst = VT + ((size_t)bh * HD + 32 * bj + 8 * fq + 4 * n) * SEQ + spos;
                            dst[0] = (u16)(w0 & 0xffffu); dst[SEQ] = (u16)(w0 >> 16); dst[2 * SEQ] = (u16)(w1 & 0xffffu); dst[3 * SEQ] = (u16)(w1 >> 16); } }
        } else {
            u16* O = type == 3 ? XR : GG;
#pragma unroll
            for (int ai = 0; ai < 2; ++ai)
#pragma unroll
                for (int m = 0; m < 4; ++m) { const int tok = tok0 + ai * HALF + m * 16; u16* rowp = O + (size_t)tok * AW + head * HD + 8 * fq;
#pragma unroll
                    for (int bj = 0; bj < 2; ++bj) { f32x4 v0 = acc[ai][bj][m][0], v1 = acc[ai][bj][m][1];
                        if (type == 4) {
#pragma unroll
                            for (int i = 0; i < 4; ++i) { v0[i] = gelu_tanh(v0[i]); v1[i] = gelu_tanh(v1[i]); } }
                        u32x4 w; w.x = cvt_pk_bf16(v0[0], v0[1]); w.y = cvt_pk_bf16(v0[2], v0[3]); w.z = cvt_pk_bf16(v1[0], v1[1]); w.w = cvt_pk_bf16(v1[2], v1[3]);
                        *(u32x4*)(rowp + 32 * bj) = w; } }
        }
    }
};
}

constexpr size_t MiB = 1u << 20;
constexpr size_t WS_CTL = 0;
constexpr size_t WS_KM = 1 * MiB;
constexpr size_t CTL_ZERO_BYTES = 2 * MiB;
constexpr size_t WS_MOD = 2 * MiB;
constexpr size_t WS_WIN = 3 * MiB;
constexpr size_t WS_WO = 8 * MiB;
constexpr size_t WS_WUP = 10 * MiB;
constexpr size_t WS_WDN = 21 * MiB;
constexpr size_t WS_WA = 27 * MiB;
constexpr size_t WS_WX = 27 * MiB + 65536;
constexpr size_t WS_AGG = 28 * MiB;
constexpr size_t WS_SSQL = 29 * MiB;
constexpr size_t WS_SSQA = 30 * MiB;
constexpr size_t WS_H = 32 * MiB;
constexpr size_t WS_QF = 96 * MiB;
constexpr size_t WS_KB = 160 * MiB;
constexpr size_t WS_VT = 192 * MiB;
constexpr size_t WS_XR = 224 * MiB;
constexpr size_t WS_GG = 256 * MiB;
constexpr size_t WS_ATT = 288 * MiB;
constexpr size_t WS_LRU = 320 * MiB;
constexpr size_t WS_MIX = 352 * MiB;
constexpr size_t WS_UPH = 96 * MiB;
constexpr size_t WS_ACT = 272 * MiB;
constexpr size_t WS_END = 448 * MiB;
constexpr int CW_BAR = 4096;

constexpr int RING_BYTES = 131072;
constexpr int MISC_OFF = RING_BYTES + 320;
constexpr int CLDS_OFF = RING_BYTES + 4096;
constexpr int LDS_BYTES = 160 * 1024;
constexpr int NT = 512, NWAVES = 8;

#define XB_TMO      128
#define XB_XCNT(j)  (256  + 64 * (j))
#define XB_XSUB(j)  (1280 + 64 * (j))
#define XB_XGEN(j)  (2304 + 64 * (j))
#define XB_TOP      3328
#define XB_TOPGEN   3392
#define XCD_BAR_WORDS 3456
#define XB_SPIN_CAP (1u << 18)
__device__ __forceinline__ unsigned xb_ld(unsigned* p)              { return __hip_atomic_load(p, __ATOMIC_RELAXED, __HIP_MEMORY_SCOPE_AGENT); }
__device__ __forceinline__ unsigned xb_add(unsigned* p, unsigned v) { return __hip_atomic_fetch_add(p, v, __ATOMIC_RELAXED, __HIP_MEMORY_SCOPE_AGENT); }
__device__ __forceinline__ unsigned xb_xcc_id() { return (unsigned)__builtin_amdgcn_s_getreg((3 << 11) | 20) & 0xFu; }
#define XB_SPIN(cond, bar) do { unsigned _sp = 0; while (cond) { __builtin_amdgcn_s_sleep(1); \
    if ((++_sp & 255u) == 0u) { if (xb_ld(&(bar)[XB_TMO])) break; if (_sp > XB_SPIN_CAP) { atomicAdd(&(bar)[XB_TMO], 1u); break; } } } } while (0)
struct XcdBarrier { unsigned* bar; unsigned x; volatile LAS unsigned* st; };
__device__ __forceinline__ XcdBarrier xcd_barrier_post(unsigned* bar, volatile LAS unsigned* st) {
    XcdBarrier b; b.bar = bar; b.x = xb_xcc_id(); b.st = st;
    if (threadIdx.x == 0) (void)xb_add(&bar[XB_XCNT(b.x)], 1u);
    return b;
}
__device__ __forceinline__ void xcd_barrier_complete(unsigned* bar, unsigned x, unsigned& nloc, unsigned& nx) {
    const unsigned G = gridDim.x * gridDim.y * gridDim.z;
    unsigned sum, cnt, mine, sp = 0u;
    for (;;) {
        sum = 0u; cnt = 0u; mine = 0u;
#pragma unroll
        for (unsigned j = 0; j < 16; ++j) { const unsigned c = xb_ld(&bar[XB_XCNT(j)]); sum += c; cnt += (c > 0u) ? 1u : 0u; mine = (j == x) ? c : mine; }
        if (sum == G) break;
        __builtin_amdgcn_s_sleep(1);
        if ((++sp & 255u) == 0u) { if (xb_ld(&bar[XB_TMO])) break; if (sp > XB_SPIN_CAP) { atomicAdd(&bar[XB_TMO], 1u); break; } }
    }
    nloc = mine > 0u ? mine : 1u; nx = cnt > 0u ? cnt : 1u;
}
__device__ __forceinline__ void xcd_barrier(const XcdBarrier& b) {
    asm volatile("s_waitcnt vmcnt(0)" ::: "memory");
    __syncthreads();
    if (threadIdx.x == 0) {
        unsigned* bar = b.bar;
        __builtin_amdgcn_s_waitcnt(0);
        unsigned nloc = b.st[0], nx = b.st[1];
        if (nloc == 0u) { xcd_barrier_complete(bar, b.x, nloc, nx); b.st[0] = nloc; b.st[1] = nx; }
        const unsigned old = xb_add(&bar[XB_XSUB(b.x)], 1u);
        const unsigned gen = old / nloc;
        if (old + 1u == (gen + 1u) * nloc) {
            __builtin_amdgcn_fence(__ATOMIC_RELEASE, "agent");
            asm volatile("s_waitcnt vmcnt(0)" ::: "memory");
            const unsigned og = xb_add(&bar[XB_TOP], 1u);
            const unsigned tg = og / nx;
            if (og + 1u == (tg + 1u) * nx) xb_add(&bar[XB_TOPGEN], 1u);
            else XB_SPIN(xb_ld(&bar[XB_TOPGEN]) == tg, bar);
            __builtin_amdgcn_fence(__ATOMIC_ACQUIRE, "agent");
            xb_add(&bar[XB_XGEN(b.x)], 1u);
            asm volatile("s_waitcnt vmcnt(0)" ::: "memory");
        } else {
            XB_SPIN(xb_ld(&bar[XB_XGEN(b.x)]) == gen, bar);
            __builtin_amdgcn_fence(__ATOMIC_ACQUIRE, "agent");
            asm volatile("s_waitcnt vmcnt(0)" ::: "memory");
        }
    }
    __syncthreads();
}

struct Frame {
    LAS unsigned char* lds;
    int tid, lane, wave, vcu, G;
    const float *x, *c, *w_ada, *b_ada, *norm1_g, *w_in, *q_norm_g, *k_norm_g, *lru_conv_w, *lru_conv_b, *lru_wa, *lru_ba, *lru_wx, *lru_bx, *lru_lambda,
                *lru_out_g, *attn_out_g, *w_out, *norm2_g, *w_up, *ffn_conv_w, *ffn_conv_b, *w_down;
    float* out; unsigned char* ws;
};
#define LDS_WAIT() asm volatile("s_waitcnt lgkmcnt(0)" ::: "memory")

template <int MODE>
__device__ __forceinline__ void p0_transpose_item(const float* W, int K, int N, u16* WT, LAS float* scr, int item, int lane) {
    const int nblk = N / 32, kb = item / nblk, nb = item % nblk, k0 = 64 * kb, n0 = 32 * nb;
#pragma unroll 8
    for (int i = 0; i < 32; ++i) { const int kk = 2 * i + (lane >> 5); scr[kk * 33 + (lane & 31)] = W[(size_t)(k0 + kk) * N + n0 + (lane & 31)]; }
    LDS_WAIT(); asm volatile("" ::: "memory");
    const int c = lane & 7;
#pragma unroll
    for (int j = 0; j < 4; ++j) { const int n = (lane >> 3) + 8 * j; const LAS float* s = scr + (8 * c) * 33 + n;
        u32x4 o;
        if (MODE == 1) { o.x = cvt_pk_f16(s[0 * 33], s[1 * 33]); o.y = cvt_pk_f16(s[2 * 33], s[3 * 33]); o.z = cvt_pk_f16(s[4 * 33], s[5 * 33]); o.w = cvt_pk_f16(s[6 * 33], s[7 * 33]); }
        else { o.x = cvt_pk_bf16(s[0 * 33], s[1 * 33]); o.y = cvt_pk_bf16(s[2 * 33], s[3 * 33]); o.z = cvt_pk_bf16(s[4 * 33], s[5 * 33]); o.w = cvt_pk_bf16(s[6 * 33], s[7 * 33]); }
        int nn = n0 + n;
        if (MODE == 1) nn = (nn & ~255) + 128 * ((nn >> 5) & 1) + 32 * ((nn >> 6) & 3) + (nn & 31);
        *(GAS u32x4*)(WT + (size_t)nn * K + k0 + 8 * c) = o; }
    LDS_WAIT(); asm volatile("" ::: "memory");
}
__device__ __forceinline__ void p0_prologue(Frame& F) {
    LAS float* cl = (LAS float*)(F.lds + CLDS_OFF);
    for (int i = F.tid; i < BATCH * D_MODEL; i += NT) cl[i] = F.c[i];
    __syncthreads();
    LAS float* scr = (LAS float*)(F.lds + F.wave * 16384);
    const int gw = F.vcu * NWAVES + F.wave, NGW = F.G * NWAVES;
    constexpr int I_MOD = N_MOD / 64;
    constexpr int I_IN = (D_MODEL / 64) * (N_IN / 32), I_O = (D_MODEL / 64) * (D_MODEL / 32), I_UP = (D_MODEL / 64) * (N_UP / 32), I_DN = (D_FF / 64) * (D_MODEL / 32), I_L = 8 * 2;
    constexpr int NITEMS = I_MOD + I_IN + I_O + I_UP + I_DN + 2 * I_L;
    u16* WinT = (u16*)(F.ws + WS_WIN); u16* WoT = (u16*)(F.ws + WS_WO); u16* WupT = (u16*)(F.ws + WS_WUP); u16* WdT = (u16*)(F.ws + WS_WDN);
    u16* WaT = (u16*)(F.ws + WS_WA); u16* WxT = (u16*)(F.ws + WS_WX);
    float* MOD = (float*)(F.ws + WS_MOD);
    for (int it = gw; it < NITEMS; it += NGW) {
        int r = it;
        if (r < I_MOD) {
            const int col = r * 64 + F.lane; float a0 = 0.f, a1 = 0.f, a2 = 0.f, a3 = 0.f;
            const float* wp = F.w_ada + col;
#pragma unroll 8
            for (int k = 0; k < D_MODEL; ++k) { const float w = wp[(size_t)k * N_MOD];
                a0 += cl[k] * w; a1 += cl[D_MODEL + k] * w; a2 += cl[2 * D_MODEL + k] * w; a3 += cl[3 * D_MODEL + k] * w; }
            const float bb = F.b_ada[col];
            MOD[col] = a0 + bb; MOD[N_MOD + col] = a1 + bb; MOD[2 * N_MOD + col] = a2 + bb; MOD[3 * N_MOD + col] = a3 + bb;
            continue; }
        r -= I_MOD;
        if (r < I_IN) { p0_transpose_item<1>(F.w_in, D_MODEL, N_IN, WinT, scr, r, F.lane); continue; } r -= I_IN;
        if (r < I_O) { p0_transpose_item<0>(F.w_out, D_MODEL, D_MODEL, WoT, scr, r, F.lane); continue; } r -= I_O;
        if (r < I_UP) { p0_transpose_item<0>(F.w_up, D_MODEL, N_UP, WupT, scr, r, F.lane); continue; } r -= I_UP;
        if (r < I_DN) { p0_transpose_item<0>(F.w_down, D_FF, D_MODEL, WdT, scr, r, F.lane); continue; } r -= I_DN;
        if (r < I_L) { const int h = r >> 1; p0_transpose_item<0>(F.lru_wa + h * 4096, 64, 64, WaT + h * 4096, scr, r & 1, F.lane); continue; } r -= I_L;
        { const int h = r >> 1; p0_transpose_item<0>(F.lru_wx + h * 4096, 64, 64, WxT + h * 4096, scr, r & 1, F.lane); }
    }
}

template <bool F16>
__device__ __forceinline__ void rownorm_phase(Frame& F, const float* X, const float* g, const float* sh, const float* sc, u16* O) {
    const int gw = F.vcu * NWAVES + F.wave, NGW = F.G * NWAVES;
    for (int m = gw; m < M_TOK; m += NGW) {
        const int b = m / SEQ;
        const GAS f32x4* xr = (const GAS f32x4*)(X + (size_t)m * D_MODEL) + F.lane;
        f32x4 v[4]; float s = 0.f;
#pragma unroll
        for (int j = 0; j < 4; ++j) { v[j] = xr[64 * j]; s += (v[j].x * v[j].x + v[j].y * v[j].y) + (v[j].z * v[j].z + v[j].w * v[j].w); }
        const float rstd = 1.0f / sqrtf(wave_sum(s) * (1.0f / D_MODEL) + EPS);
        GAS u32x2* o8 = (GAS u32x2*)(O + (size_t)m * D_MODEL) + F.lane;
#pragma unroll
        for (int j = 0; j < 4; ++j) {
            const int col = 4 * F.lane + 256 * j;
            const f32x4 gv = *(const f32x4*)(g + col), shv = *(const f32x4*)(sh + (size_t)b * N_MOD + col), scv = *(const f32x4*)(sc + (size_t)b * N_MOD + col);
            const f32x4 y = (v[j] * rstd) * gv * (scv + 1.0f) + shv;
            u32x2 w;
            if (F16) { w.x = cvt_pk_f16(y.x, y.y); w.y = cvt_pk_f16(y.z, y.w); } else { w.x = cvt_pk_bf16(y.x, y.y); w.y = cvt_pk_bf16(y.z, y.w); }
            o8[64 * j] = w; }
    }
}

__device__ __forceinline__ int crow(int r, int hi) { return (r & 3) + 8 * (r >> 2) + 4 * hi; }
constexpr int AL_QS = 0, AL_OACC = 32768, AL_LACC = 98304, AL_KMS = 99328, AL_LIST = 107520, AL_CNT = 115712, AL_MISC = 115840;
__device__ __forceinline__ void attn_item(Frame& F, int bh, int i, float c1, float c2) {
    const float* QF = (const float*)(F.ws + WS_QF); const u16* KB = (const u16*)(F.ws + WS_KB); const u16* VT = (const u16*)(F.ws + WS_VT);
    const float* KM = (const float*)(F.ws + WS_KM); u16* ATT = (u16*)(F.ws + WS_ATT); float* SSQA = (float*)(F.ws + WS_SSQA);
    LAS u16* QS = (LAS u16*)(F.lds + AL_QS); LAS float* OACC = (LAS float*)(F.lds + AL_OACC); LAS float* LACC = (LAS float*)(F.lds + AL_LACC);
    LAS float* KMS = (LAS float*)(F.lds + AL_KMS); LAS unsigned char* LIST = (LAS unsigned char*)(F.lds + AL_LIST); LAS int* CNT = (LAS int*)(F.lds + AL_CNT);
    const int tid = F.tid, lane = F.lane, wave = F.wave, hi = lane >> 5, l31 = lane & 31;
    const int b = bh / NHEAD, h = bh % NHEAD;
    for (int u = tid; u < 256 * 64; u += NT) OACC[u] = 0.f;
    if (tid < 256) LACC[tid] = 0.f;
    if (tid < 32) CNT[tid] = 0;
    for (int u = tid; u < NBLK * HD; u += NT) { const int n = u >> 6, d = u & 63; KMS[u] = KM[(((size_t)(b * NBLK + n)) * NHEAD + h) * HD + d] * (1.0f / 256.0f); }
    __syncthreads();
    {
        const int q = tid >> 1, half = tid & 1;
        const GAS f32x4* qrow = (const GAS f32x4*)(QF + ((size_t)bh * SEQ + (size_t)i * BLK + q) * HD);
        f32x4 qv[16];
#pragma unroll
        for (int d = 0; d < 16; ++d) qv[d] = qrow[d];
#pragma unroll
        for (int d = 0; d < 4; ++d) { const f32x4 a = qv[2 * d], c = qv[2 * d + 1], a2 = qv[8 + 2 * d], c2 = qv[8 + 2 * d + 1];
            u32x4 w, w2; w.x = cvt_pk_bf16(a.x, a.y); w.y = cvt_pk_bf16(a.z, a.w); w.z = cvt_pk_bf16(c.x, c.y); w.w = cvt_pk_bf16(c.z, c.w);
            w2.x = cvt_pk_bf16(a2.x, a2.y); w2.y = cvt_pk_bf16(a2.z, a2.w); w2.z = cvt_pk_bf16(c2.x, c2.y); w2.w = cvt_pk_bf16(c2.z, c2.w);
            if (half) w = w2;
            *(LAS u32x4*)(QS + q * 64 + 32 * half + 8 * d) = w; }
        float v0 = -INFINITY, v1 = -INFINITY, v2 = -INFINITY; int i0 = -1, i1 = -1, i2 = -1;
        for (int nn = 0; nn < 16; ++nn) {
            const int n = 16 * half + nn;
            const LAS f32x4* kr = (const LAS f32x4*)(KMS + n * 64);
            float g = 0.f;
#pragma unroll
            for (int d = 0; d < 16; ++d) { const f32x4 kv = kr[d]; g = fmaf(qv[d].x, kv.x, g); g = fmaf(qv[d].y, kv.y, g); g = fmaf(qv[d].z, kv.z, g); g = fmaf(qv[d].w, kv.w, g); }
            if (n >= i) g = -INFINITY;
            if (g > v0) { v2 = v1; i2 = i1; v1 = v0; i1 = i0; v0 = g; i0 = n; }
            else if (g > v1) { v2 = v1; i2 = i1; v1 = g; i1 = n; }
            else if (g > v2) { v2 = g; i2 = n; }
        }
        const float pv0 = __shfl_xor(v0, 1), pv1 = __shfl_xor(v1, 1), pv2 = __shfl_xor(v2, 1);
        const int pi0 = __shfl_xor(i0, 1), pi1 = __shfl_xor(i1, 1), pi2 = __shfl_xor(i2, 1);
        if (half == 0) {
            float av[3] = {v0, v1, v2}, bv[3] = {pv0, pv1, pv2}; int ai[3] = {i0, i1, i2}, bi[3] = {pi0, pi1, pi2};
            int sel[3]; int pa = 0, pb = 0;
#pragma unroll
            for (int k = 0; k < 3; ++k) {
                const float ca = pa == 0 ? av[0] : (pa == 1 ? av[1] : av[2]); const int cai = pa == 0 ? ai[0] : (pa == 1 ? ai[1] : ai[2]);
                const float cb = pb == 0 ? bv[0] : (pb == 1 ? bv[1] : bv[2]); const int cbi = pb == 0 ? bi[0] : (pb == 1 ? bi[1] : bi[2]);
                if (ca >= cb) { sel[k] = cai; ++pa; } else { sel[k] = cbi; ++pb; }
            }
#pragma unroll
            for (int k = 0; k < 3; ++k) if (sel[k] >= 0) { const int pos = __hip_atomic_fetch_add(&CNT[sel[k]], 1, __ATOMIC_RELAXED, __HIP_MEMORY_SCOPE_WORKGROUP); LIST[sel[k] * 256 + pos] = (unsigned char)q; }
        }
    }
    __syncthreads();
    {
        int base = 0;
        for (int j = 0; j <= i; ++j) {
            const bool own = (j == i);
            const int cntj = own ? 256 : __builtin_amdgcn_readfirstlane(CNT[j]);
            const int ntj = (cntj + 31) >> 5;
            for (int t = base + ((wave - base) & 7); t < base + ntj; t += 8) {
                const int tt = t - base;
                const int ridx = 32 * tt + l31; const bool valid = ridx < cntj;
                const int qidx = own ? ridx : (valid ? (int)LIST[j * 256 + ridx] : 0);
                s16x8 qf[4];
#pragma unroll
                for (int s = 0; s < 4; ++s) qf[s] = *(const LAS s16x8*)(QS + qidx * 64 + 16 * s + 8 * hi);
                const u16* Kp = KB + ((size_t)bh * SEQ + (size_t)j * BLK) * HD;
                const u16* Vp = VT + (size_t)bh * HD * SEQ + (size_t)j * BLK;
                f32x16 o0, o1;
#pragma unroll
                for (int r = 0; r < 16; ++r) { o0[r] = 0.f; o1[r] = 0.f; }
                float lsum = 0.f;
                const int nkt = own ? (tt + 1) : 8;
                for (int kt = 0; kt < nkt; ++kt) {
                    f32x16 p;
#pragma unroll
                    for (int r = 0; r < 16; ++r) p[r] = 0.f;
#pragma unroll
                    for (int s = 0; s < 4; ++s) { const s16x8 kf = *(const s16x8*)(Kp + (size_t)(32 * kt + l31) * HD + 16 * s + 8 * hi);
                        p = __builtin_amdgcn_mfma_f32_32x32x16_bf16(__builtin_bit_cast(bf16x8_t, kf), __builtin_bit_cast(bf16x8_t, qf[s]), p, 0, 0, 0); }
                    const bool diag = own && (kt == tt);
#pragma unroll
                    for (int r = 0; r < 16; ++r) { float e = __builtin_amdgcn_exp2f(p[r] * c1 - c2);
                        if (diag && (32 * kt + crow(r, hi) > qidx)) e = 0.f;
                        p[r] = e; lsum += e; }
#pragma unroll
                    for (int s2 = 0; s2 < 2; ++s2) {
                        u32x4 pw; pw.x = cvt_pk_bf16(p[8 * s2 + 0], p[8 * s2 + 1]); pw.y = cvt_pk_bf16(p[8 * s2 + 2], p[8 * s2 + 3]); pw.z = cvt_pk_bf16(p[8 * s2 + 4], p[8 * s2 + 5]); pw.w = cvt_pk_bf16(p[8 * s2 + 6], p[8 * s2 + 7]);
                        const bf16x8_t pa = __builtin_bit_cast(bf16x8_t, pw);
                        const s16x8 vf0 = *(const s16x8*)(Vp + (size_t)l31 * SEQ + 32 * kt + 16 * s2 + 8 * hi);
                        const s16x8 vf1 = *(const s16x8*)(Vp + (size_t)(32 + l31) * SEQ + 32 * kt + 16 * s2 + 8 * hi);
                        o0 = __builtin_amdgcn_mfma_f32_32x32x16_bf16(pa, __builtin_bit_cast(bf16x8_t, vf0), o0, 0, 0, 0);
                        o1 = __builtin_amdgcn_mfma_f32_32x32x16_bf16(pa, __builtin_bit_cast(bf16x8_t, vf1), o1, 0, 0, 0);
                    }
                }
#pragma unroll
                for (int r = 0; r < 16; ++r) { const int rl = crow(r, hi); const int qi = __shfl(qidx, rl); const int vl = __shfl((int)valid, rl);
                    if (vl) { (void)__hip_atomic_fetch_add(&OACC[qi * 64 + l31], o0[r], __ATOMIC_RELAXED, __HIP_MEMORY_SCOPE_WORKGROUP); (void)__hip_atomic_fetch_add(&OACC[qi * 64 + 32 + l31], o1[r], __ATOMIC_RELAXED, __HIP_MEMORY_SCOPE_WORKGROUP); } }
                if (valid) (void)__hip_atomic_fetch_add(&LACC[qidx], lsum, __ATOMIC_RELAXED, __HIP_MEMORY_SCOPE_WORKGROUP);
            }
            base += ntj;
        }
    }
    __syncthreads();
    {
        const int q = tid >> 1, half = tid & 1;
        const float inv = 1.0f / LACC[q];
        const size_t tok = (size_t)b * SEQ + (size_t)i * BLK + q;
        float ss = 0.f;
#pragma unroll
        for (int d = 0; d < 4; ++d) { const LAS f32x4* op = (const LAS f32x4*)(OACC + q * 64 + 32 * half + 8 * d);
            const f32x4 a = op[0] * inv, c = op[1] * inv;
            ss += (a.x * a.x + a.y * a.y) + (a.z * a.z + a.w * a.w) + (c.x * c.x + c.y * c.y) + (c.z * c.z + c.w * c.w);
            u32x4 w; w.x = cvt_pk_bf16(a.x, a.y); w.y = cvt_pk_bf16(a.z, a.w); w.z = cvt_pk_bf16(c.x, c.y); w.w = cvt_pk_bf16(c.z, c.w);
            *(GAS u32x4*)(ATT + tok * AW + h * HD + 32 * half + 8 * d) = w; }
        ss += __shfl_xor(ss, 1);
        if (half == 0) SSQA[tok * NHEAD + h] = ss;
    }
    __syncthreads();
}
__device__ __forceinline__ void attn_phase(Frame& F) {
    LAS float* mm = (LAS float*)(F.lds + AL_MISC);
    if (F.tid < 64) { float a = fabsf(F.q_norm_g[F.tid]), c = fabsf(F.k_norm_g[F.tid]);
#pragma unroll
        for (int o = 1; o < 64; o <<= 1) { a = fmaxf(a, __shfl_xor(a, o)); c = fmaxf(c, __shfl_xor(c, o)); }
        if (F.tid == 0) { mm[0] = a; mm[1] = c; } }
    __syncthreads();
    const float C = 8.0f * mm[0] * mm[1];
    const float c1 = 0.125f * LOG2E, c2 = C * LOG2E;
    __syncthreads();
    for (int it = F.vcu; it < BATCH * NHEAD * NBLK; it += F.G) {
        const int r = it >> 8, bh = (it >> 3) & 31, s = it & 7;
        const int i = (r == 0) ? s : (r == 1) ? 15 - s : (r == 2) ? 16 + s : 31 - s;
        attn_item(F, bh, i, c1, c2);
    }
}

constexpr int LL_CW = 0;
template <bool FINAL>
__device__ __forceinline__ void lru_item(Frame& F, int b, int chunk) {
    const u16* XR = (const u16*)(F.ws + WS_XR); const u16* GG = (const u16*)(F.ws + WS_GG);
    const u16* WaT = (const u16*)(F.ws + WS_WA); const u16* WxT = (const u16*)(F.ws + WS_WX);
    float* AGG = (float*)(F.ws + WS_AGG); u16* LRU = (u16*)(F.ws + WS_LRU); float* SSQL = (float*)(F.ws + WS_SSQL);
    const int lane = F.lane, hd = F.wave, hi = lane >> 5, j = lane & 31;
    LAS float* CW = (LAS float*)(F.lds + LL_CW + hd * 1280);
    for (int u = lane; u < 320; u += 64) CW[u] = (u < 256) ? F.lru_conv_w[(u >> 6) * AW + hd * HD + (u & 63)] : F.lru_conv_b[hd * HD + (u - 256)];
    LDS_WAIT(); asm volatile("" ::: "memory");
    float ba[2], bx[2], sp8[2], carry[2], arun[2];
#pragma unroll
    for (int ct = 0; ct < 2; ++ct) { const int c = hd * HD + 32 * ct + j; ba[ct] = F.lru_ba[c]; bx[ct] = F.lru_bx[c];
        sp8[ct] = 8.0f * log1pf(expf(-F.lru_lambda[c])); carry[ct] = 0.f; arun[ct] = 1.f;
        if (FINAL) { float hcar = 0.f; for (int cc = 0; cc < chunk; ++cc) { const f32x2 ah = *(const f32x2*)(AGG + (((size_t)(b * 64 + cc)) * AW + c) * 2); hcar = ah.x * hcar + ah.y; } carry[ct] = hcar; } }
    for (int tile = 0; tile < 4; ++tile) {
        const int t0 = chunk * 128 + tile * 32;
        const int pos = t0 + j;
        s16x8 af[4], gf[4];
#pragma unroll
        for (int s = 0; s < 4; ++s) {
            const int ch0 = 16 * s + 8 * hi;
            float xc[8];
            { const LAS f32x4* bp = (const LAS f32x4*)(CW + 256 + ch0); const f32x4 b0 = bp[0], b1 = bp[1];
              xc[0] = b0.x; xc[1] = b0.y; xc[2] = b0.z; xc[3] = b0.w; xc[4] = b1.x; xc[5] = b1.y; xc[6] = b1.z; xc[7] = b1.w; }
            float accv[8];
#pragma unroll
            for (int e = 0; e < 8; ++e) accv[e] = 0.f;
#pragma unroll
            for (int jj = 0; jj < 4; ++jj) {
                const int p = pos - 3 + jj;
                u32x4 xw = (u32x4){0u, 0u, 0u, 0u};
                if (p >= 0) xw = *(const GAS u32x4*)(XR + ((size_t)b * SEQ + p) * AW + hd * HD + ch0);
                const LAS f32x4* wp = (const LAS f32x4*)(CW + jj * 64 + ch0); const f32x4 w0 = wp[0], w1 = wp[1];
                accv[0] += w0.x * bf_lo(xw.x); accv[1] += w0.y * bf_hi(xw.x); accv[2] += w0.z * bf_lo(xw.y); accv[3] += w0.w * bf_hi(xw.y);
                accv[4] += w1.x * bf_lo(xw.z); accv[5] += w1.y * bf_hi(xw.z); accv[6] += w1.z * bf_lo(xw.w); accv[7] += w1.w * bf_hi(xw.w);
            }
#pragma unroll
            for (int e = 0; e < 8; ++e) xc[e] += accv[e];
            u32x4 aw; aw.x = cvt_pk_bf16(xc[0], xc[1]); aw.y = cvt_pk_bf16(xc[2], xc[3]); aw.z = cvt_pk_bf16(xc[4], xc[5]); aw.w = cvt_pk_bf16(xc[6], xc[7]);
            af[s] = __builtin_bit_cast(s16x8, aw);
            if (FINAL) gf[s] = *(const GAS s16x8*)(GG + ((size_t)b * SEQ + pos) * AW + hd * HD + ch0);
        }
        float ssacc[16];
#pragma unroll
        for (int r = 0; r < 16; ++r) ssacc[r] = 0.f;
#pragma unroll
        for (int ct = 0; ct < 2; ++ct) {
            f32x16 aA, aX, aI, aG;
#pragma unroll
            for (int r = 0; r < 16; ++r) { aA[r] = 0.f; aX[r] = 0.f; aI[r] = 0.f; aG[r] = 0.f; }
#pragma unroll
            for (int s = 0; s < 4; ++s) {
                const size_t woff = ((size_t)hd * 64 + 32 * ct + j) * 64 + 16 * s + 8 * hi;
                const s16x8 wa = *(const GAS s16x8*)(WaT + woff), wx = *(const GAS s16x8*)(WxT + woff);
                s16x8 id;
#pragma unroll
                for (int e = 0; e < 8; ++e) id[e] = (16 * s + 8 * hi + e == 32 * ct + j) ? (short)0x3F80 : (short)0;
                const bf16x8_t a = __builtin_bit_cast(bf16x8_t, af[s]);
                aA = __builtin_amdgcn_mfma_f32_32x32x16_bf16(a, __builtin_bit_cast(bf16x8_t, wa), aA, 0, 0, 0);
                aX = __builtin_amdgcn_mfma_f32_32x32x16_bf16(a, __builtin_bit_cast(bf16x8_t, wx), aX, 0, 0, 0);
                aI = __builtin_amdgcn_mfma_f32_32x32x16_bf16(a, __builtin_bit_cast(bf16x8_t, id), aI, 0, 0, 0);
                if (FINAL) aG = __builtin_amdgcn_mfma_f32_32x32x16_bf16(__builtin_bit_cast(bf16x8_t, gf[s]), __builtin_bit_cast(bf16x8_t, id), aG, 0, 0, 0);
            }
            float av[16], uv[16];
#pragma unroll
            for (int r = 0; r < 16; ++r) {
                const float rr = sigmoidf_(aA[r] + ba[ct]), ii = sigmoidf_(aX[r] + bx[ct]);
                const float la = -rr * sp8[ct];
                const float a = __builtin_amdgcn_exp2f(la * LOG2E);
                const float x2 = 2.0f * la;
                const float om = (x2 > -0.05f) ? -x2 * (1.0f + x2 * 0.5f * (1.0f + x2 * (1.0f / 3.0f) * (1.0f + x2 * 0.25f))) : 1.0f - a * a;
                av[r] = a; uv[r] = sqrtf(om) * (ii * aI[r]);
            }
            float Ag[4], Ug[4];
#pragma unroll
            for (int g = 0; g < 4; ++g) { float A = av[4 * g], U = uv[4 * g];
#pragma unroll
                for (int e = 1; e < 4; ++e) { A *= av[4 * g + e]; U = av[4 * g + e] * U + uv[4 * g + e]; }
                Ag[g] = A; Ug[g] = U; }
            float h = carry[ct], ap = arun[ct];
            float hin[4];
#pragma unroll
            for (int g = 0; g < 4; ++g) {
                const float pA = __shfl_xor(Ag[g], 32), pU = __shfl_xor(Ug[g], 32);
                const float fA = hi ? pA : Ag[g], fU = hi ? pU : Ug[g], sA = hi ? Ag[g] : pA, sU = hi ? Ug[g] : pU;
                const float h1 = fA * h + fU;
                hin[g] = hi ? h1 : h;
                h = sA * h1 + sU; ap *= fA * sA;
            }
            carry[ct] = h; arun[ct] = ap;
            if (FINAL) {
#pragma unroll
                for (int g = 0; g < 4; ++g) { float hh = hin[g];
#pragma unroll
                    for (int e = 0; e < 4; ++e) { const int r = 4 * g + e; hh = av[r] * hh + uv[r]; const float o = hh * aG[r]; ssacc[r] += o * o;
                        const size_t tok = (size_t)b * SEQ + t0 + crow(r, hi);
                        LRU[tok * AW + hd * HD + 32 * ct + j] = (u16)(cvt_pk_bf16(o, 0.f) & 0xffffu); } }
            }
        }
        if (FINAL) {
#pragma unroll
            for (int r = 0; r < 16; ++r) {
                const size_t tok = (size_t)b * SEQ + t0 + crow(r, hi);
                float ss = ssacc[r];
                ss += __shfl_xor(ss, 1); ss += __shfl_xor(ss, 2); ss += __shfl_xor(ss, 4); ss += __shfl_xor(ss, 8); ss += __shfl_xor(ss, 16);
                if (j == 0) SSQL[tok * NHEAD + hd] = ss;
            }
        }
    }
    if (!FINAL) { if (hi == 0) {
#pragma unroll
        for (int ct = 0; ct < 2; ++ct) { const int c = hd * HD + 32 * ct + j; *(f32x2*)(AGG + (((size_t)(b * 64 + chunk)) * AW + c) * 2) = (f32x2){arun[ct], carry[ct]}; } } }
}
template <bool FINAL>
__device__ __forceinline__ void lru_phase(Frame& F) {
    for (int it = F.vcu; it < BATCH * 64; it += F.G) { lru_item<FINAL>(F, it >> 6, it & 63); }
}

__device__ __forceinline__ void mix_phase(Frame& F) {
    const u16* LRU = (const u16*)(F.ws + WS_LRU); const u16* ATT = (const u16*)(F.ws + WS_ATT);
    const float* SSQL = (const float*)(F.ws + WS_SSQL); const float* SSQA = (const float*)(F.ws + WS_SSQA); u16* MIX = (u16*)(F.ws + WS_MIX);
    const int gw = F.vcu * NWAVES + F.wave, NGW = F.G * NWAVES, lane = F.lane;
    const f32x4 gl0 = *(const f32x4*)(F.lru_out_g + 8 * lane), gl1 = *(const f32x4*)(F.lru_out_g + 8 * lane + 4);
    const f32x4 ga0 = *(const f32x4*)(F.attn_out_g + 8 * lane), ga1 = *(const f32x4*)(F.attn_out_g + 8 * lane + 4);
    for (int m = gw; m < M_TOK; m += NGW) {
        const f32x4 s0 = *(const GAS f32x4*)(SSQL + (size_t)m * 8), s1 = *(const GAS f32x4*)(SSQL + (size_t)m * 8 + 4);
        const f32x4 t0 = *(const GAS f32x4*)(SSQA + (size_t)m * 8), t1 = *(const GAS f32x4*)(SSQA + (size_t)m * 8 + 4);
        const float ssl = ((s0.x + s0.y) + (s0.z + s0.w)) + ((s1.x + s1.y) + (s1.z + s1.w));
        const float ssa = ((t0.x + t0.y) + (t0.z + t0.w)) + ((t1.x + t1.y) + (t1.z + t1.w));
        const float rl = 1.0f / sqrtf(ssl * (1.0f / AW) + EPS), ra = 1.0f / sqrtf(ssa * (1.0f / AW) + EPS);
        const u32x4 lw = *(const GAS u32x4*)(LRU + (size_t)m * AW + 8 * lane), aw = *(const GAS u32x4*)(ATT + (size_t)m * AW + 8 * lane);
        u32x4 o;
        o.x = cvt_pk_bf16(bf_lo(lw.x) * rl * gl0.x, bf_hi(lw.x) * rl * gl0.y); o.y = cvt_pk_bf16(bf_lo(lw.y) * rl * gl0.z, bf_hi(lw.y) * rl * gl0.w);
        o.z = cvt_pk_bf16(bf_lo(lw.z) * rl * gl1.x, bf_hi(lw.z) * rl * gl1.y); o.w = cvt_pk_bf16(bf_lo(lw.w) * rl * gl1.z, bf_hi(lw.w) * rl * gl1.w);
        *(GAS u32x4*)(MIX + (size_t)m * D_MODEL + 8 * lane) = o;
        o.x = cvt_pk_bf16(bf_lo(aw.x) * ra * ga0.x, bf_hi(aw.x) * ra * ga0.y); o.y = cvt_pk_bf16(bf_lo(aw.y) * ra * ga0.z, bf_hi(aw.y) * ra * ga0.w);
        o.z = cvt_pk_bf16(bf_lo(aw.z) * ra * ga1.x, bf_hi(aw.z) * ra * ga1.y); o.w = cvt_pk_bf16(bf_lo(aw.w) * ra * ga1.z, bf_hi(aw.w) * ra * ga1.w);
        *(GAS u32x4*)(MIX + (size_t)m * D_MODEL + AW + 8 * lane) = o;
    }
}

__device__ __forceinline__ void act_phase(Frame& F, int half) {
    const u16* UP = (const u16*)(F.ws + WS_UPH); u16* ACT = (u16*)(F.ws + WS_ACT);
    constexpr int NF8 = D_FF / 8;
    const long total = (long)(M_TOK / 2) * NF8;
    for (long it = (long)F.vcu * NT + F.tid; it < total; it += (long)F.G * NT) {
        const int tl = (int)(it / NF8), f0 = (int)(it % NF8) * 8;
        const int tok = half * (M_TOK / 2) + tl, pos = tok % SEQ;
        float cg[8], cv[8];
        { const f32x4 a = *(const f32x4*)(F.ffn_conv_b + f0), c = *(const f32x4*)(F.ffn_conv_b + f0 + 4);
          cg[0] = a.x; cg[1] = a.y; cg[2] = a.z; cg[3] = a.w; cg[4] = c.x; cg[5] = c.y; cg[6] = c.z; cg[7] = c.w; }
        { const f32x4 a = *(const f32x4*)(F.ffn_conv_b + D_FF + f0), c = *(const f32x4*)(F.ffn_conv_b + D_FF + f0 + 4);
          cv[0] = a.x; cv[1] = a.y; cv[2] = a.z; cv[3] = a.w; cv[4] = c.x; cv[5] = c.y; cv[6] = c.z; cv[7] = c.w; }
        float sg[8], sv[8];
#pragma unroll
        for (int e = 0; e < 8; ++e) { sg[e] = 0.f; sv[e] = 0.f; }
#pragma unroll
        for (int jj = 0; jj < 3; ++jj) {
            const int p = pos - 2 + jj;
            if (p >= 0) {
                const u32x4 gw = *(const GAS u32x4*)(UP + (size_t)(tl - 2 + jj) * N_UP + f0), vw = *(const GAS u32x4*)(UP + (size_t)(tl - 2 + jj) * N_UP + D_FF + f0);
                const f32x4 wg0 = *(const f32x4*)(F.ffn_conv_w + (size_t)jj * N_UP + f0), wg1 = *(const f32x4*)(F.ffn_conv_w + (size_t)jj * N_UP + f0 + 4);
                const f32x4 wv0 = *(const f32x4*)(F.ffn_conv_w + (size_t)jj * N_UP + D_FF + f0), wv1 = *(const f32x4*)(F.ffn_conv_w + (size_t)jj * N_UP + D_FF + f0 + 4);
                sg[0] += wg0.x * bf_lo(gw.x); sg[1] += wg0.y * bf_hi(gw.x); sg[2] += wg0.z * bf_lo(gw.y); sg[3] += wg0.w * bf_hi(gw.y);
                sg[4] += wg1.x * bf_lo(gw.z); sg[5] += wg1.y * bf_hi(gw.z); sg[6] += wg1.z * bf_lo(gw.w); sg[7] += wg1.w * bf_hi(gw.w);
                sv[0] += wv0.x * bf_lo(vw.x); sv[1] += wv0.y * bf_hi(vw.x); sv[2] += wv0.z * bf_lo(vw.y); sv[3] += wv0.w * bf_hi(vw.y);
                sv[4] += wv1.x * bf_lo(vw.z); sv[5] += wv1.y * bf_hi(vw.z); sv[6] += wv1.z * bf_lo(vw.w); sv[7] += wv1.w * bf_hi(vw.w);
            }
        }
        float o[8];
#pragma unroll
        for (int e = 0; e < 8; ++e) { const float g = sg[e] + cg[e], v = sv[e] + cv[e]; o[e] = g * sigmoidf_(g) * v; }
        u32x4 w; w.x = cvt_pk_bf16(o[0], o[1]); w.y = cvt_pk_bf16(o[2], o[3]); w.z = cvt_pk_bf16(o[4], o[5]); w.w = cvt_pk_bf16(o[6], o[7]);
        *(GAS u32x4*)(ACT + (size_t)tok * D_FF + f0) = w;
    }
}

constexpr int N_PHASES = 13;
struct Args { const float* in[23]; float* out; unsigned char* ws; int ph_lo, ph_hi; };
__global__ void __launch_bounds__(NT, 2) hymba_fwd(Args args) {
    extern __shared__ __attribute__((aligned(16))) unsigned char lds_raw[];
    Frame F;
    F.lds = (LAS unsigned char*)lds_raw;
    F.tid = threadIdx.x; F.lane = F.tid & 63; F.wave = __builtin_amdgcn_readfirstlane(F.tid >> 6);
    F.G = gridDim.x; { const int bx = blockIdx.x; F.vcu = (F.G % 8 == 0) ? (bx % 8) * (F.G / 8) + bx / 8 : bx; }
    F.x = args.in[0]; F.c = args.in[1]; F.w_ada = args.in[2]; F.b_ada = args.in[3]; F.norm1_g = args.in[4]; F.w_in = args.in[5]; F.q_norm_g = args.in[6]; F.k_norm_g = args.in[7];
    F.lru_conv_w = args.in[8]; F.lru_conv_b = args.in[9]; F.lru_wa = args.in[10]; F.lru_ba = args.in[11]; F.lru_wx = args.in[12]; F.lru_bx = args.in[13]; F.lru_lambda = args.in[14];
    F.lru_out_g = args.in[15]; F.attn_out_g = args.in[16]; F.w_out = args.in[17]; F.norm2_g = args.in[18]; F.w_up = args.in[19]; F.ffn_conv_w = args.in[20]; F.ffn_conv_b = args.in[21]; F.w_down = args.in[22];
    F.out = args.out; F.ws = args.ws;
    volatile LAS unsigned* MISC = (volatile LAS unsigned*)(F.lds + MISC_OFF);
    if (F.tid < 32) MISC[F.tid] = 0u;
    __syncthreads();
    const int lo = args.ph_lo, hi = args.ph_hi;
    unsigned* ctl = (unsigned*)(F.ws + WS_CTL);
    XcdBarrier bar; bar.bar = ctl + CW_BAR; bar.x = 0; bar.st = nullptr;
    if (hi - lo > 1) bar = xcd_barrier_post(ctl + CW_BAR, MISC + 8);
#ifndef PHASE_MASK
#define PHASE_MASK 0x1FFF
#endif
#define IN(k) (((PHASE_MASK >> (k)) & 1) && lo <= (k) && (k) < hi)
#define SEAM(k) do { if (IN(k) && IN((k) + 1)) xcd_barrier(bar); } while (0)
    float* MOD = (float*)(F.ws + WS_MOD);
    u16* H = (u16*)(F.ws + WS_H);

    if (IN(0)) { p0_prologue(F); SEAM(0); }
    if (IN(1)) { rownorm_phase<true>(F, F.x, F.norm1_g, MOD + 0, MOD + 1024, H); SEAM(1); }
    if (IN(2)) {
        pg8::Gemm g{H, (const u16*)(F.ws + WS_WIN), M_TOK, N_IN, D_MODEL}; pg8::StaticOrder S; S.init(M_TOK, N_IN, F.G, (int)blockIdx.x);
        pg8::EpiInProj E{(float*)(F.ws + WS_QF), (u16*)(F.ws + WS_KB), (u16*)(F.ws + WS_VT), (u16*)(F.ws + WS_XR), (u16*)(F.ws + WS_GG), (float*)(F.ws + WS_KM), F.q_norm_g, F.k_norm_g};
        pg8::gemm_phase<pg8::EpiInProj, pg8::StaticOrder, true, true, true>(F.lds, g, S, E);
        SEAM(2);
    }
    if (IN(3)) { attn_phase(F); lru_phase<false>(F); SEAM(3); }
    if (IN(4)) { lru_phase<true>(F); SEAM(4); }
    if (IN(5)) { mix_phase(F); SEAM(5); }
    if (IN(6)) {
        pg8::Gemm g{(const u16*)(F.ws + WS_MIX), (const u16*)(F.ws + WS_WO), M_TOK, D_MODEL, D_MODEL}; pg8::StaticOrder S; S.init(M_TOK, D_MODEL, F.G, (int)blockIdx.x);
        pg8::EpiResid E{F.x, F.out, MOD + 2048};
        pg8::gemm_phase<pg8::EpiResid, pg8::StaticOrder, true, true, false>(F.lds, g, S, E);
        SEAM(6);
    }
    if (IN(7)) { rownorm_phase<false>(F, F.out, F.norm2_g, MOD + 3072, MOD + 4096, H); SEAM(7); }
#pragma unroll 1
    for (int half = 0; half < 2; ++half) {
        if (IN(8 + 2 * half)) {
            pg8::Gemm g{H + (size_t)half * (M_TOK / 2) * D_MODEL, (const u16*)(F.ws + WS_WUP), M_TOK / 2, N_UP, D_MODEL}; pg8::StaticOrder S; S.init(M_TOK / 2, N_UP, F.G, (int)blockIdx.x);
            pg8::EpiBf16 E{(u16*)(F.ws + WS_UPH), N_UP};
            pg8::gemm_phase<pg8::EpiBf16, pg8::StaticOrder, true, true, false>(F.lds, g, S, E);
            SEAM(8 + 2 * half);
        }
        if (IN(9 + 2 * half)) { act_phase(F, half); SEAM(9 + 2 * half); }
    }
    if (IN(12)) {
        pg8::Gemm g{(const u16*)(F.ws + WS_ACT), (const u16*)(F.ws + WS_WDN), M_TOK, D_MODEL, D_FF}; pg8::StaticOrder S; S.init(M_TOK, D_MODEL, F.G, (int)blockIdx.x);
        pg8::EpiResid E{F.out, F.out, MOD + 5120};
        pg8::gemm_phase<pg8::EpiResid, pg8::StaticOrder, true, true, false>(F.lds, g, S, E);
    }
    if (hi - lo > 1 && hi == N_PHASES) {
        if (xb_ld(ctl + CW_BAR + XB_TMO) != 0u) { asm volatile("s_waitcnt vmcnt(0)" ::: "memory"); __syncthreads();
            for (size_t i = (size_t)blockIdx.x * NT + F.tid; i < (size_t)M_TOK * D_MODEL; i += (size_t)F.G * NT) F.out[i] = __builtin_nanf(""); }
    }
#undef IN
#undef SEAM
}

#ifndef MK_PER_PHASE
#define MK_PER_PHASE 1
#endif
extern "C" void kernel_launch(void* const* d_in, const int* in_sizes, int n_in, void* d_out, int out_size, void* d_ws, size_t ws_size, hipStream_t stream) {
    static int grid = 0;
    if (grid == 0) {
        if (n_in != 23 || in_sizes[0] != M_TOK * D_MODEL || out_size != M_TOK * D_MODEL || ws_size < WS_END) {
            fprintf(stderr, "kernel_launch: unexpected shapes (n_in %d, in0 %d, out %d, ws %zu); nothing launched\n", n_in, n_in > 0 ? in_sizes[0] : -1, out_size, ws_size); grid = -1; return; }
        int dev = 0, cus = 0;
        if (hipGetDevice(&dev) != hipSuccess || hipDeviceGetAttribute(&cus, hipDeviceAttributeMultiprocessorCount, dev) != hipSuccess) { grid = -1; return; }
        if (hipFuncSetAttribute((const void*)hymba_fwd, hipFuncAttributeMaxDynamicSharedMemorySize, LDS_BYTES) != hipSuccess) { fprintf(stderr, "kernel_launch: hipFuncSetAttribute failed\n"); grid = -1; return; }
        grid = cus;
    }
    if (grid < 0) return;
    (void)hipMemsetAsync((char*)d_ws + WS_CTL, 0, CTL_ZERO_BYTES, stream);
    Args a{};
    for (int i = 0; i < 23; ++i) a.in[i] = (const float*)d_in[i];
    a.out = (float*)d_out; a.ws = (unsigned char*)d_ws;
#if MK_PER_PHASE
    for (int p = 0; p < N_PHASES; ++p) { a.ph_lo = p; a.ph_hi = p + 1; hipLaunchKernelGGL(hymba_fwd, dim3(grid), dim3(NT), LDS_BYTES, stream, a); }
#else
    a.ph_lo = 0; a.ph_hi = N_PHASES; hipLaunchKernelGGL(hymba_fwd, dim3(grid), dim3(NT), LDS_BYTES, stream, a);
#endif
}
```

```cpp
#include <hip/hip_runtime.h>
#include <cstdio>
#include <cstdint>

#define GAS __attribute__((address_space(1)))
#define LAS __attribute__((address_space(3)))
typedef unsigned short u16;
typedef short s16x8 __attribute__((ext_vector_type(8)));
typedef _Float16 f16x8 __attribute__((ext_vector_type(8)));
typedef __bf16 bf16x8_t __attribute__((ext_vector_type(8)));
typedef float f32x2 __attribute__((ext_vector_type(2)));
typedef float f32x4 __attribute__((ext_vector_type(4)));
typedef float f32x16 __attribute__((ext_vector_type(16)));
typedef unsigned u32x4 __attribute__((ext_vector_type(4)));
typedef unsigned u32x2 __attribute__((ext_vector_type(2)));
typedef GAS unsigned gu32;
#define RLX_AGENT __ATOMIC_RELAXED, __HIP_MEMORY_SCOPE_AGENT

constexpr int D_MODEL = 1024, BATCH = 4, SEQ = 8192, M_TOK = BATCH * SEQ;
constexpr int N_IN = 2560, D_FF = 2816, N_UP = 2 * D_FF, N_MOD = 6 * D_MODEL;
constexpr int NHEAD = 8, HD = 64, AW = 512, NBLK = 32, BLK = 256;
constexpr float EPS = 1e-6f;
constexpr float LOG2E = 1.4426950408889634f;

__device__ __forceinline__ unsigned cvt_pk_bf16(float lo, float hi) { unsigned r; asm volatile("v_cvt_pk_bf16_f32 %0, %1, %2" : "=v"(r) : "v"(lo), "v"(hi)); return r; }
__device__ __forceinline__ unsigned cvt_pk_f16(float lo, float hi) {
    const _Float16 a = (_Float16)lo, b = (_Float16)hi;
    return (unsigned)__builtin_bit_cast(unsigned short, a) | ((unsigned)__builtin_bit_cast(unsigned short, b) << 16);
}
__device__ __forceinline__ float bf_lo(unsigned w) { return __builtin_bit_cast(float, w << 16); }
__device__ __forceinline__ float bf_hi(unsigned w) { return __builtin_bit_cast(float, w & 0xffff0000u); }
__device__ __forceinline__ float sigmoidf_(float v) { return __builtin_amdgcn_rcpf(1.0f + __builtin_amdgcn_exp2f(-v * LOG2E)); }
__device__ __forceinline__ float gelu_tanh(float v) { const float y = 0.7978845608028654f * (v + 0.044715f * v * v * v); return v * sigmoidf_(2.0f * y); }
__device__ __forceinline__ float wave_sum(float v) {
#pragma unroll
    for (int o = 1; o < 64; o <<= 1) v += __shfl_xor(v, o);
    return v;
}

namespace pg8 {
constexpr int BM = 256, BK = 64, HALF = 128, HTB = HALF * BK * 2, STAGE_BYTES = 8 * HTB, NXCD = 8, WGM = 8;
__host__ __device__ __forceinline__ int lds_byte(int r, int c) { const int st = (r >> 4) * 2 + (c >> 5), rr = r & 15, cc = c & 31, ob = rr * 64 + cc * 2; return st * 1024 + (ob ^ (((ob >> 9) & 1) << 5)); }
__host__ __device__ __forceinline__ void stage_rc(int b, int& R, int& C) { const int st = b / 1024, sb = b % 1024, swz = sb ^ (((sb >> 9) & 1) << 5); R = (st >> 1) * 16 + swz / 64; C = (st & 1) * 32 + (swz % 64) / 2; }
__host__ __device__ __forceinline__ int perm32(int rho) { const int n = rho >> 4, i = rho & 15; return 8 * (i >> 2) + 4 * n + (i & 3); }

struct Unit { int pm, pn; };
struct Gemm { const u16* A; const u16* Bt; int M, N, K; };

struct StaticOrder {
    int nM, nN, nwg, G, c;
    __host__ __device__ void init(int M, int N, int G_, int c_) { nM = M / BM; nN = N / BM; nwg = nM * nN; G = G_; c = c_; }
    __host__ __device__ bool next(int i, Unit& u) const {
        const long L = (long)i * G + c; if (L >= nwg) return false;
        int wgid = (int)L; { const int q = nwg / NXCD, r = nwg % NXCD, xcd = wgid % NXCD, off = wgid / NXCD; wgid = (xcd < r ? xcd * (q + 1) : r * (q + 1) + (xcd - r) * q) + off; }
        const int nig = WGM * nN, gid = wgid / nig, fm = gid * WGM, gsz = (nM - fm) < WGM ? (nM - fm) : WGM;
        u.pm = fm + ((wgid % nig) % gsz); u.pn = (wgid % nig) / gsz; return true;
    }
    __device__ __forceinline__ void a_ready(const Unit&) const {}
    __device__ __forceinline__ void done(const Unit&) const {}
};

template <bool F16> __device__ __forceinline__ f32x4 mfma16(s16x8 a, s16x8 b, f32x4 c) {
    if constexpr (F16) return __builtin_amdgcn_mfma_f32_16x16x32_f16(__builtin_bit_cast(f16x8, a), __builtin_bit_cast(f16x8, b), c, 0, 0, 0);
    else return __builtin_amdgcn_mfma_f32_16x16x32_bf16(__builtin_bit_cast(bf16x8_t, a), __builtin_bit_cast(bf16x8_t, b), c, 0, 0, 0);
}

template <class Epi, class Sched, bool ALIGN_EPI, bool SP2, bool F16>
__device__ __forceinline__ void gemm_phase(LAS unsigned char* lds, const Gemm g, const Sched& S, const Epi& E) {
    const int tid = threadIdx.x, wid = __builtin_amdgcn_readfirstlane(tid >> 6), lane = tid & 63, wr = wid >> 2, wc = wid & 3, fr = lane & 15, fq = lane >> 4;
    const int K = g.K, nt = K / BK;
    unsigned voffA[2], voffB[2];
#pragma unroll
    for (int i = 0; i < 2; ++i) { int R, C; stage_rc(tid * 16 + i * 8192, R, C); const int Rb = Epi::PERM ? ((R & ~31) + perm32(R & 31)) : R;
        voffA[i] = (unsigned)(R * K + C) * 2u; voffB[i] = (unsigned)(Rb * K + C) * 2u; }
    const size_t kstep = (size_t)(BK * 2);
    const size_t hstep = (size_t)HALF * K * 2;
    const size_t tstep = 2 * hstep;
    const unsigned ldsw = (unsigned)wid * 1024u;
    const int aoff = lds_byte(wr * 64 + fr, fq * 8), boff = lds_byte(wc * 32 + fr, fq * 8);
#define PG8_SA(b, h) (((b) * 2 + (h)) * HTB)
#define PG8_SB(b, h) ((4 + (b) * 2 + (h)) * HTB)
#define PG8_STAGE(bufoff, gbase, voff) do { _Pragma("unroll") for (int _i = 0; _i < 2; ++_i) \
        __builtin_amdgcn_global_load_lds((const unsigned*)((const char*)(gbase) + (voff)[_i]), (LAS unsigned*)(lds + (bufoff) + ldsw + _i * 8192), 16, 0, 0); } while (0)
#define PG8_LDA(dst, b, h) do { _Pragma("unroll") for (int m = 0; m < 4; ++m) _Pragma("unroll") for (int k = 0; k < 2; ++k) dst[m][k] = *(const LAS s16x8*)(lds + PG8_SA(b, h) + aoff + m * 2048 + k * 1024); } while (0)
#define PG8_LDB(dst, b, h) do { _Pragma("unroll") for (int n = 0; n < 2; ++n) _Pragma("unroll") for (int k = 0; k < 2; ++k) dst[n][k] = *(const LAS s16x8*)(lds + PG8_SB(b, h) + boff + n * 2048 + k * 1024); } while (0)
#define PG8_MMA(ai, bj, At, Bt) do { __builtin_amdgcn_s_setprio(1); _Pragma("unroll") for (int m = 0; m < 4; ++m) _Pragma("unroll") for (int n = 0; n < 2; ++n) _Pragma("unroll") for (int k = 0; k < 2; ++k) \
        acc[ai][bj][m][n] = mfma16<F16>(Bt[n][k], At[m][k], acc[ai][bj][m][n]); __builtin_amdgcn_s_setprio(0); } while (0)
#define PG8_WAIT_V(n) asm volatile("s_waitcnt vmcnt(" #n ")" ::: "memory")
#define PG8_WAIT_L(n) asm volatile("s_waitcnt lgkmcnt(" #n ")" ::: "memory")
#define PG8_BAR __builtin_amdgcn_s_barrier()
#define PG8_SCHED __builtin_amdgcn_sched_barrier(0)
    Unit cur, nxt; int ui = 0;
    if (!S.next(0, cur)) return;
    f32x4 acc[2][2][4][2];
#pragma unroll
    for (int a = 0; a < 2; ++a)
#pragma unroll
        for (int b = 0; b < 2; ++b)
#pragma unroll
            for (int m = 0; m < 4; ++m)
#pragma unroll
                for (int n = 0; n < 2; ++n) acc[a][b][m][n] = (f32x4){0.f, 0.f, 0.f, 0.f};
    s16x8 At[4][2], B0[2][2], B1[2][2];
    const char* cA = (const char*)g.A + (size_t)cur.pm * tstep; const char* cB = (const char*)g.Bt + (size_t)cur.pn * tstep;
    S.a_ready(cur);
    if constexpr (SP2) {
        PG8_STAGE(PG8_SB(0, 0), cB, voffB); PG8_STAGE(PG8_SB(0, 1), cB + hstep, voffB); PG8_STAGE(PG8_SA(0, 0), cA, voffA); PG8_STAGE(PG8_SA(0, 1), cA + hstep, voffA);
        if (wr == 1) PG8_BAR;
        PG8_WAIT_V(2); PG8_BAR;
        PG8_STAGE(PG8_SB(1, 0), cB + kstep, voffB); PG8_STAGE(PG8_SA(1, 0), cA + kstep, voffA); PG8_STAGE(PG8_SB(1, 1), cB + hstep + kstep, voffB);
        PG8_WAIT_V(6); PG8_BAR;
    } else {
        PG8_STAGE(PG8_SB(0, 0), cB, voffB); PG8_STAGE(PG8_SA(0, 0), cA, voffA); PG8_STAGE(PG8_SB(0, 1), cB + hstep, voffB); PG8_STAGE(PG8_SA(0, 1), cA + hstep, voffA);
        if (wr == 1) PG8_BAR;
        PG8_WAIT_V(4); PG8_BAR;
        PG8_STAGE(PG8_SB(1, 0), cB + kstep, voffB); PG8_STAGE(PG8_SA(1, 0), cA + kstep, voffA); PG8_STAGE(PG8_SB(1, 1), cB + hstep + kstep, voffB);
        PG8_WAIT_V(6); PG8_BAR;
    }
    for (;;) {
        const bool has_next = S.next(ui + 1, nxt);
        const char* nA = has_next ? (const char*)g.A + (size_t)nxt.pm * tstep : cA; const char* nB = has_next ? (const char*)g.Bt + (size_t)nxt.pn * tstep : cB;
        for (int t = 0; t < nt; t += 2) {
            const bool last = (t == nt - 2);
            const char* a1 = cA + (size_t)(t + 1) * kstep;
            const char* a2 = last ? nA : cA + (size_t)(t + 2) * kstep; const char* b2 = last ? nB : cB + (size_t)(t + 2) * kstep;
            const char* a3 = a2 + kstep; const char* b3 = b2 + kstep;
            if (last && has_next) S.a_ready(nxt);
            if constexpr (SP2) {
            PG8_LDB(B0, 0, 0); PG8_LDB(B1, 0, 1); PG8_SCHED; PG8_LDA(At, 0, 0); PG8_STAGE(PG8_SA(1, 1), a1 + hstep, voffA);
            PG8_WAIT_V(8); PG8_WAIT_L(0); PG8_BAR; PG8_MMA(0, 0, At, B0); PG8_MMA(0, 1, At, B1); PG8_BAR; PG8_SCHED;
            PG8_LDA(At, 0, 1); PG8_STAGE(PG8_SB(0, 0), b2, voffB); PG8_STAGE(PG8_SB(0, 1), b2 + hstep, voffB); PG8_STAGE(PG8_SA(0, 0), a2, voffA);
            PG8_WAIT_V(8); PG8_WAIT_L(0); PG8_BAR; PG8_MMA(1, 0, At, B0); PG8_MMA(1, 1, At, B1); PG8_BAR; PG8_SCHED;
            PG8_LDB(B0, 1, 0); PG8_LDB(B1, 1, 1); PG8_SCHED; PG8_LDA(At, 1, 0); PG8_STAGE(PG8_SA(0, 1), a2 + hstep, voffA);
            PG8_WAIT_V(8); PG8_WAIT_L(0); PG8_BAR; PG8_MMA(0, 0, At, B0); PG8_MMA(0, 1, At, B1); PG8_BAR; PG8_SCHED;
            PG8_LDA(At, 1, 1); PG8_STAGE(PG8_SB(1, 0), b3, voffB); PG8_STAGE(PG8_SB(1, 1), b3 + hstep, voffB); PG8_STAGE(PG8_SA(1, 0), a3, voffA);
            PG8_WAIT_V(8); PG8_WAIT_L(0); PG8_BAR; PG8_MMA(1, 0, At, B0); PG8_MMA(1, 1, At, B1); PG8_BAR; PG8_SCHED;
            } else {
            PG8_LDB(B0, 0, 0); PG8_SCHED; PG8_LDA(At, 0, 0); PG8_STAGE(PG8_SA(1, 1), a1 + hstep, voffA);
            PG8_WAIT_L(8); PG8_BAR; PG8_WAIT_L(0); PG8_MMA(0, 0, At, B0); PG8_BAR; PG8_SCHED;
            PG8_LDB(B1, 0, 1); PG8_STAGE(PG8_SB(0, 0), b2, voffB);
            PG8_BAR; PG8_WAIT_L(0); PG8_MMA(0, 1, At, B1); PG8_BAR;
            PG8_LDA(At, 0, 1); PG8_STAGE(PG8_SA(0, 0), a2, voffA);
            PG8_BAR; PG8_WAIT_L(0); PG8_MMA(1, 0, At, B0); PG8_BAR; PG8_SCHED;
            PG8_STAGE(PG8_SB(0, 1), b2 + hstep, voffB);
            PG8_WAIT_V(6); PG8_BAR; PG8_MMA(1, 1, At, B1); PG8_BAR;
            PG8_LDB(B0, 1, 0); PG8_SCHED; PG8_LDA(At, 1, 0); PG8_STAGE(PG8_SA(0, 1), a2 + hstep, voffA);
            PG8_WAIT_L(8); PG8_BAR; PG8_WAIT_L(0); PG8_MMA(0, 0, At, B0); PG8_BAR; PG8_SCHED;
            PG8_LDB(B1, 1, 1); PG8_STAGE(PG8_SB(1, 0), b3, voffB);
            PG8_BAR; PG8_WAIT_L(0); PG8_MMA(0, 1, At, B1); PG8_BAR;
            PG8_LDA(At, 1, 1); PG8_STAGE(PG8_SA(1, 0), a3, voffA);
            PG8_BAR; PG8_WAIT_L(0); PG8_MMA(1, 0, At, B0); PG8_BAR; PG8_SCHED;
            PG8_STAGE(PG8_SB(1, 1), b3 + hstep, voffB);
            PG8_WAIT_V(6); PG8_BAR; PG8_MMA(1, 1, At, B1); PG8_BAR;
            }
        }
        if constexpr (ALIGN_EPI) { if (wr == 0) PG8_BAR; }
        E(acc, cur, wr, wc, fr, fq); S.done(cur);
        if (!has_next) break;
#pragma unroll
        for (int a = 0; a < 2; ++a)
#pragma unroll
            for (int b = 0; b < 2; ++b)
#pragma unroll
                for (int m = 0; m < 4; ++m)
#pragma unroll
                    for (int n = 0; n < 2; ++n) acc[a][b][m][n] = (f32x4){0.f, 0.f, 0.f, 0.f};
        cur = nxt; cA = nA; cB = nB; ++ui;
        if constexpr (ALIGN_EPI) { if (wr == 1) PG8_BAR; }
    }
    PG8_WAIT_V(0);
    if constexpr (!ALIGN_EPI) { if (wr == 0) PG8_BAR; }
    PG8_BAR;
#undef PG8_SA
#undef PG8_SB
#undef PG8_STAGE
#undef PG8_LDA
#undef PG8_LDB
#undef PG8_MMA
#undef PG8_WAIT_V
#undef PG8_WAIT_L
#undef PG8_BAR
#undef PG8_SCHED
}

struct EpiBf16 {
    static constexpr bool PERM = true;
    u16* O; int ldc;
    __device__ __forceinline__ void operator()(const f32x4 (&acc)[2][2][4][2], const Unit& u, int wr, int wc, int fr, int fq) const {
        const int row0 = u.pm * BM + wr * 64 + fr; const int col0 = u.pn * BM + wc * 32 + 8 * fq;
#pragma unroll
        for (int ai = 0; ai < 2; ++ai)
#pragma unroll
            for (int m = 0; m < 4; ++m) { u16* rowp = O + (size_t)(row0 + ai * HALF + m * 16) * ldc + col0;
#pragma unroll
                for (int bj = 0; bj < 2; ++bj) { const f32x4 v0 = acc[ai][bj][m][0], v1 = acc[ai][bj][m][1];
                    u32x4 w; w.x = cvt_pk_bf16(v0[0], v0[1]); w.y = cvt_pk_bf16(v0[2], v0[3]); w.z = cvt_pk_bf16(v1[0], v1[1]); w.w = cvt_pk_bf16(v1[2], v1[3]);
                    *(u32x4*)(rowp + bj * HALF) = w; } }
    }
};
struct EpiResid {
    static constexpr bool PERM = false;
    const float* base; float* out; const float* gate;
    __device__ __forceinline__ void operator()(const f32x4 (&acc)[2][2][4][2], const Unit& u, int wr, int wc, int fr, int fq) const {
        const int row0 = u.pm * BM + wr * 64 + fr, col0 = u.pn * BM + wc * 32 + 4 * fq;
        const int b = (u.pm * BM) / SEQ;
        f32x4 gv[2][2];
#pragma unroll
        for (int bj = 0; bj < 2; ++bj)
#pragma unroll
            for (int n = 0; n < 2; ++n) gv[bj][n] = *(const f32x4*)(gate + (size_t)b * N_MOD + col0 + bj * HALF + n * 16);
#pragma unroll
        for (int ai = 0; ai < 2; ++ai)
#pragma unroll
            for (int m = 0; m < 4; ++m) { const size_t off = (size_t)(row0 + ai * HALF + m * 16) * D_MODEL + col0;
#pragma unroll
                for (int bj = 0; bj < 2; ++bj)
#pragma unroll
                    for (int n = 0; n < 2; ++n) { const f32x4 bs = *(const f32x4*)(base + off + bj * HALF + n * 16);
                        *(f32x4*)(out + off + bj * HALF + n * 16) = bs + gv[bj][n] * acc[ai][bj][m][n]; } }
    }
};
struct EpiInProj {
    static constexpr bool PERM = true;
    float* QF; u16* KB; u16* VT; u16* XR; u16* GG; float* KM; const float* gq; const float* gk;
    __device__ __forceinline__ void operator()(const f32x4 (&acc)[2][2][4][2], const Unit& u, int wr, int wc, int fr, int fq) const {
        const int type = u.pn >> 1, head = (u.pn & 1) * 4 + wc;
        const int b = (u.pm * BM) / SEQ, blk = u.pm % NBLK;
        const int tok0 = u.pm * BM + wr * 64 + fr;
        const int bh = b * NHEAD + head;
        if (type <= 1) {
            const float* gp = type == 0 ? gq : gk;
            f32x4 gv[2][2];
#pragma unroll
            for (int bj = 0; bj < 2; ++bj)
#pragma unroll
                for (int n = 0; n < 2; ++n) gv[bj][n] = *(const f32x4*)(gp + 32 * bj + 8 * fq + 4 * n);
            f32x4 cs[2][2];
#pragma unroll
            for (int bj = 0; bj < 2; ++bj)
#pragma unroll
                for (int n = 0; n < 2; ++n) cs[bj][n] = (f32x4){0.f, 0.f, 0.f, 0.f};
#pragma unroll
            for (int ai = 0; ai < 2; ++ai)
#pragma unroll
                for (int m = 0; m < 4; ++m) {
                    float ss = 0.f;
#pragma unroll
                    for (int bj = 0; bj < 2; ++bj)
#pragma unroll
                        for (int n = 0; n < 2; ++n) { const f32x4 x = acc[ai][bj][m][n]; ss += (x[0] * x[0] + x[1] * x[1]) + (x[2] * x[2] + x[3] * x[3]); }
                    ss += __shfl_xor(ss, 16); ss += __shfl_xor(ss, 32);
                    const float rstd = 1.0f / sqrtf(ss * (1.0f / 64.0f) + EPS);
                    const int tok = tok0 + ai * HALF + m * 16, s = tok % SEQ;
                    const size_t rowoff = ((size_t)bh * SEQ + s) * HD + 8 * fq;
#pragma unroll
                    for (int bj = 0; bj < 2; ++bj) {
                        const f32x4 v0 = acc[ai][bj][m][0] * rstd * gv[bj][0], v1 = acc[ai][bj][m][1] * rstd * gv[bj][1];
                        if (type == 0) { *(f32x4*)(QF + rowoff + 32 * bj) = v0; *(f32x4*)(QF + rowoff + 32 * bj + 4) = v1; }
                        else { u32x4 w; w.x = cvt_pk_bf16(v0[0], v0[1]); w.y = cvt_pk_bf16(v0[2], v0[3]); w.z = cvt_pk_bf16(v1[0], v1[1]); w.w = cvt_pk_bf16(v1[2], v1[3]);
                            *(u32x4*)(KB + rowoff + 32 * bj) = w; cs[bj][0] += v0; cs[bj][1] += v1; }
                    }
                }
            if (type == 1) {
#pragma unroll
                for (int bj = 0; bj < 2; ++bj)
#pragma unroll
                    for (int n = 0; n < 2; ++n)
#pragma unroll
                        for (int i = 0; i < 4; ++i) { float v = cs[bj][n][i]; v += __shfl_xor(v, 1); v += __shfl_xor(v, 2); v += __shfl_xor(v, 4); v += __shfl_xor(v, 8);
                            if (fr == 0) atomicAdd(KM + (((size_t)(b * NBLK + blk) * NHEAD + head) * HD + 32 * bj + 8 * fq + 4 * n + i), v); }
            }
        } else if (type == 2) {
            const int pfr = 8 * ((fr >> 2) & 1) + 4 * (fr >> 3) + (fr & 3);
#pragma unroll
            for (int ai = 0; ai < 2; ++ai)
#pragma unroll
                for (int m = 0; m < 4; ++m) { const int tok = tok0 + ai * HALF + m * 16, s = tok % SEQ; const int spos = (s & ~15) + pfr;
#pragma unroll
                    for (int bj = 0; bj < 2; ++bj)
#pragma unroll
                        for (int n = 0; n < 2; ++n) { const f32x4 x = acc[ai][bj][m][n]; const unsigned w0 = cvt_pk_bf16(x[0], x[1]), w1 = cvt_pk_bf16(x[2], x[3]);
                            u16* dst = VT + ((size_t)bh * HD + 32 * bj + 8 * fq + 4 * n) * SEQ + spos;
                            dst[0] = (u16)(w0 & 0xffffu); dst[SEQ] = (u16)(w0 >> 16); dst[2 * SEQ] = (u16)(w1 & 0xffffu); dst[3 * SEQ] = (u16)(w1 >> 16); } }
        } else {
            u16* O = type == 3 ? XR : GG;
#pragma unroll
            for (int ai = 0; ai < 2; ++ai)
#pragma unroll
                for (int m = 0; m < 4; ++m) { const int tok = tok0 + ai * HALF + m * 16; u16* rowp = O + (size_t)tok * AW + head * HD + 8 * fq;
#pragma unroll
                    for (int bj = 0; bj < 2; ++bj) { f32x4 v0 = acc[ai][bj][m][0], v1 = acc[ai][bj][m][1];
                        if (type == 4) {
#pragma unroll
                            for (int i = 0; i < 4; ++i) { v0[i] = gelu_tanh(v0[i]); v1[i] = gelu_tanh(v1[i]); } }
                        u32x4 w; w.x = cvt_pk_bf16(v0[0], v0[1]); w.y = cvt_pk_bf16(v0[2], v0[3]); w.z = cvt_pk_bf16(v1[0], v1[1]); w.w = cvt_pk_bf16(v1[2], v1[3]);
                        *(u32x4*)(rowp + 32 * bj) = w; } }
        }
    }
};
}

constexpr size_t MiB = 1u << 20;
constexpr size_t WS_CTL = 0;
constexpr size_t WS_KM = 1 * MiB;
constexpr size_t CTL_ZERO_BYTES = 2 * MiB;
constexpr size_t WS_MOD = 2 * MiB;
constexpr size_t WS_WIN = 3 * MiB;
constexpr size_t WS_WO = 8 * MiB;
constexpr size_t WS_WUP = 10 * MiB;
constexpr size_t WS_WDN = 21 * MiB;
constexpr size_t WS_WA = 27 * MiB;
constexpr size_t WS_WX = 27 * MiB + 65536;
constexpr size_t WS_AGG = 28 * MiB;
constexpr size_t WS_SSQL = 29 * MiB;
constexpr size_t WS_SSQA = 30 * MiB;
constexpr size_t WS_H = 32 * MiB;
constexpr size_t WS_QF = 96 * MiB;
constexpr size_t WS_KB = 160 * MiB;
constexpr size_t WS_VT = 192 * MiB;
constexpr size_t WS_XR = 224 * MiB;
constexpr size_t WS_GG = 256 * MiB;
constexpr size_t WS_ATT = 288 * MiB;
constexpr size_t WS_LRU = 320 * MiB;
constexpr size_t WS_MIX = 352 * MiB;
constexpr size_t WS_UPH = 96 * MiB;
constexpr size_t WS_ACT = 272 * MiB;
constexpr size_t WS_END = 448 * MiB;
constexpr int CW_BAR = 4096;

constexpr int RING_BYTES = 131072;
constexpr int MISC_OFF = RING_BYTES + 320;
constexpr int CLDS_OFF = RING_BYTES + 4096;
constexpr int LDS_BYTES = 160 * 1024;
constexpr int NT = 512, NWAVES = 8;

#define XB_TMO      128
#define XB_XCNT(j)  (256  + 64 * (j))
#define XB_XSUB(j)  (1280 + 64 * (j))
#define XB_XGEN(j)  (2304 + 64 * (j))
#define XB_TOP      3328
#define XB_TOPGEN   3392
#define XCD_BAR_WORDS 3456
#define XB_SPIN_CAP (1u << 18)
__device__ __forceinline__ unsigned xb_ld(unsigned* p)              { return __hip_atomic_load(p, __ATOMIC_RELAXED, __HIP_MEMORY_SCOPE_AGENT); }
__device__ __forceinline__ unsigned xb_add(unsigned* p, unsigned v) { return __hip_atomic_fetch_add(p, v, __ATOMIC_RELAXED, __HIP_MEMORY_SCOPE_AGENT); }
__device__ __forceinline__ unsigned xb_xcc_id() { return (unsigned)__builtin_amdgcn_s_getreg((3 << 11) | 20) & 0xFu; }
#define XB_SPIN(cond, bar) do { unsigned _sp = 0; while (cond) { __builtin_amdgcn_s_sleep(1); \
    if ((++_sp & 255u) == 0u) { if (xb_ld(&(bar)[XB_TMO])) break; if (_sp > XB_SPIN_CAP) { atomicAdd(&(bar)[XB_TMO], 1u); break; } } } } while (0)
struct XcdBarrier { unsigned* bar; unsigned x; volatile LAS unsigned* st; };
__device__ __forceinline__ XcdBarrier xcd_barrier_post(unsigned* bar, volatile LAS unsigned* st) {
    XcdBarrier b; b.bar = bar; b.x = xb_xcc_id(); b.st = st;
    if (threadIdx.x == 0) (void)xb_add(&bar[XB_XCNT(b.x)], 1u);
    return b;
}
__device__ __forceinline__ void xcd_barrier_complete(unsigned* bar, unsigned x, unsigned& nloc, unsigned& nx) {
    const unsigned G = gridDim.x * gridDim.y * gridDim.z;
    unsigned sum, cnt, mine, sp = 0u;
    for (;;) {
        sum = 0u; cnt = 0u; mine = 0u;
#pragma unroll
        for (unsigned j = 0; j < 16; ++j) { const unsigned c = xb_ld(&bar[XB_XCNT(j)]); sum += c; cnt += (c > 0u) ? 1u : 0u; mine = (j == x) ? c : mine; }
        if (sum == G) break;
        __builtin_amdgcn_s_sleep(1);
        if ((++sp & 255u) == 0u) { if (xb_ld(&bar[XB_TMO])) break; if (sp > XB_SPIN_CAP) { atomicAdd(&bar[XB_TMO], 1u); break; } }
    }
    nloc = mine > 0u ? mine : 1u; nx = cnt > 0u ? cnt : 1u;
}
__device__ __forceinline__ void xcd_barrier(const XcdBarrier& b) {
    asm volatile("s_waitcnt vmcnt(0)" ::: "memory");
    __syncthreads();
    if (threadIdx.x == 0) {
        unsigned* bar = b.bar;
        __builtin_amdgcn_s_waitcnt(0);
        unsigned nloc = b.st[0], nx = b.st[1];
        if (nloc == 0u) { xcd_barrier_complete(bar, b.x, nloc, nx); b.st[0] = nloc; b.st[1] = nx; }
        const unsigned old = xb_add(&bar[XB_XSUB(b.x)], 1u);
        const unsigned gen = old / nloc;
        if (old + 1u == (gen + 1u) * nloc) {
            __builtin_amdgcn_fence(__ATOMIC_RELEASE, "agent");
            asm volatile("s_waitcnt vmcnt(0)" ::: "memory");
            const unsigned og = xb_add(&bar[XB_TOP], 1u);
            const unsigned tg = og / nx;
            if (og + 1u == (tg + 1u) * nx) xb_add(&bar[XB_TOPGEN], 1u);
            else XB_SPIN(xb_ld(&bar[XB_TOPGEN]) == tg, bar);
            __builtin_amdgcn_fence(__ATOMIC_ACQUIRE, "agent");
            xb_add(&bar[XB_XGEN(b.x)], 1u);
            asm volatile("s_waitcnt vmcnt(0)" ::: "memory");
        } else {
            XB_SPIN(xb_ld(&bar[XB_XGEN(b.x)]) == gen, bar);
            __builtin_amdgcn_fence(__ATOMIC_ACQUIRE, "agent");
            asm volatile("s_waitcnt vmcnt(0)" ::: "memory");
        }
    }
    __syncthreads();
}

struct Frame {
    LAS unsigned char* lds;
    int tid, lane, wave, vcu, G;
    const float *x, *c, *w_ada, *b_ada, *norm1_g, *w_in, *q_norm_g, *k_norm_g, *lru_conv_w, *lru_conv_b, *lru_wa, *lru_ba, *lru_wx, *lru_bx, *lru_lambda,
                *lru_out_g, *attn_out_g, *w_out, *norm2_g, *w_up, *ffn_conv_w, *ffn_conv_b, *w_down;
    float* out; unsigned char* ws;
};
#define LDS_WAIT() asm volatile("s_waitcnt lgkmcnt(0)" ::: "memory")

template <int MODE>
__device__ __forceinline__ void p0_transpose_item(const float* W, int K, int N, u16* WT, LAS float* scr, int item, int lane) {
    const int nblk = N / 32, kb = item / nblk, nb = item % nblk, k0 = 64 * kb, n0 = 32 * nb;
#pragma unroll 8
    for (int i = 0; i < 32; ++i) { const int kk = 2 * i + (lane >> 5); scr[kk * 33 + (lane & 31)] = W[(size_t)(k0 + kk) * N + n0 + (lane & 31)]; }
    LDS_WAIT(); asm volatile("" ::: "memory");
    const int c = lane & 7;
#pragma unroll
    for (int j = 0; j < 4; ++j) { const int n = (lane >> 3) + 8 * j; const LAS float* s = scr + (8 * c) * 33 + n;
        u32x4 o;
        if (MODE == 1) { o.x = cvt_pk_f16(s[0 * 33], s[1 * 33]); o.y = cvt_pk_f16(s[2 * 33], s[3 * 33]); o.z = cvt_pk_f16(s[4 * 33], s[5 * 33]); o.w = cvt_pk_f16(s[6 * 33], s[7 * 33]); }
        else { o.x = cvt_pk_bf16(s[0 * 33], s[1 * 33]); o.y = cvt_pk_bf16(s[2 * 33], s[3 * 33]); o.z = cvt_pk_bf16(s[4 * 33], s[5 * 33]); o.w = cvt_pk_bf16(s[6 * 33], s[7 * 33]); }
        int nn = n0 + n;
        if (MODE == 1) nn = (nn & ~255) + 128 * ((nn >> 5) & 1) + 32 * ((nn >> 6) & 3) + (nn & 31);
        *(GAS u32x4*)(WT + (size_t)nn * K + k0 + 8 * c) = o; }
    LDS_WAIT(); asm volatile("" ::: "memory");
}
__device__ __forceinline__ void p0_prologue(Frame& F) {
    LAS float* cl = (LAS float*)(F.lds + CLDS_OFF);
    for (int i = F.tid; i < BATCH * D_MODEL; i += NT) cl[i] = F.c[i];
    __syncthreads();
    LAS float* scr = (LAS float*)(F.lds + F.wave * 16384);
    const int gw = F.vcu * NWAVES + F.wave, NGW = F.G * NWAVES;
    constexpr int I_MOD = N_MOD / 64;
    constexpr int I_IN = (D_MODEL / 64) * (N_IN / 32), I_O = (D_MODEL / 64) * (D_MODEL / 32), I_UP = (D_MODEL / 64) * (N_UP / 32), I_DN = (D_FF / 64) * (D_MODEL / 32), I_L = 8 * 2;
    constexpr int NITEMS = I_MOD + I_IN + I_O + I_UP + I_DN + 2 * I_L;
    u16* WinT = (u16*)(F.ws + WS_WIN); u16* WoT = (u16*)(F.ws + WS_WO); u16* WupT = (u16*)(F.ws + WS_WUP); u16* WdT = (u16*)(F.ws + WS_WDN);
    u16* WaT = (u16*)(F.ws + WS_WA); u16* WxT = (u16*)(F.ws + WS_WX);
    float* MOD = (float*)(F.ws + WS_MOD);
    for (int it = gw; it < NITEMS; it += NGW) {
        int r = it;
        if (r < I_MOD) {
            const int col = r * 64 + F.lane; float a0 = 0.f, a1 = 0.f, a2 = 0.f, a3 = 0.f;
            const float* wp = F.w_ada + col;
#pragma unroll 8
            for (int k = 0; k < D_MODEL; ++k) { const float w = wp[(size_t)k * N_MOD];
                a0 += cl[k] * w; a1 += cl[D_MODEL + k] * w; a2 += cl[2 * D_MODEL + k] * w; a3 += cl[3 * D_MODEL + k] * w; }
            const float bb = F.b_ada[col];
            MOD[col] = a0 + bb; MOD[N_MOD + col] = a1 + bb; MOD[2 * N_MOD + col] = a2 + bb; MOD[3 * N_MOD + col] = a3 + bb;
            continue; }
        r -= I_MOD;
        if (r < I_IN) { p0_transpose_item<1>(F.w_in, D_MODEL, N_IN, WinT, scr, r, F.lane); continue; } r -= I_IN;
        if (r < I_O) { p0_transpose_item<0>(F.w_out, D_MODEL, D_MODEL, WoT, scr, r, F.lane); continue; } r -= I_O;
        if (r < I_UP) { p0_transpose_item<0>(F.w_up, D_MODEL, N_UP, WupT, scr, r, F.lane); continue; } r -= I_UP;
        if (r < I_DN) { p0_transpose_item<0>(F.w_down, D_FF, D_MODEL, WdT, scr, r, F.lane); continue; } r -= I_DN;
        if (r < I_L) { const int h = r >> 1; p0_transpose_item<0>(F.lru_wa + h * 4096, 64, 64, WaT + h * 4096, scr, r & 1, F.lane); continue; } r -= I_L;
        { const int h = r >> 1; p0_transpose_item<0>(F.lru_wx + h * 4096, 64, 64, WxT + h * 4096, scr, r & 1, F.lane); }
    }
}

template <bool F16>
__device__ __forceinline__ void rownorm_phase(Frame& F, const float* X, const float* g, const float* sh, const float* sc, u16* O) {
    const int gw = F.vcu * NWAVES + F.wave, NGW = F.G * NWAVES;
    for (int m = gw; m < M_TOK; m += NGW) {
        const int b = m / SEQ;
        const GAS f32x4* xr = (const GAS f32x4*)(X + (size_t)m * D_MODEL) + F.lane;
        f32x4 v[4]; float s = 0.f;
#pragma unroll
        for (int j = 0; j < 4; ++j) { v[j] = xr[64 * j]; s += (v[j].x * v[j].x + v[j].y * v[j].y) + (v[j].z * v[j].z + v[j].w * v[j].w); }
        const float rstd = 1.0f / sqrtf(wave_sum(s) * (1.0f / D_MODEL) + EPS);
        GAS u32x2* o8 = (GAS u32x2*)(O + (size_t)m * D_MODEL) + F.lane;
#pragma unroll
        for (int j = 0; j < 4; ++j) {
            const int col = 4 * F.lane + 256 * j;
            const f32x4 gv = *(const f32x4*)(g + col), shv = *(const f32x4*)(sh + (size_t)b * N_MOD + col), scv = *(const f32x4*)(sc + (size_t)b * N_MOD + col);
            const f32x4 y = (v[j] * rstd) * gv * (scv + 1.0f) + shv;
            u32x2 w;
            if (F16) { w.x = cvt_pk_f16(y.x, y.y); w.y = cvt_pk_f16(y.z, y.w); } else { w.x = cvt_pk_bf16(y.x, y.y); w.y = cvt_pk_bf16(y.z, y.w); }
            o8[64 * j] = w; }
    }
}

__device__ __forceinline__ int crow(int r, int hi) { return (r & 3) + 8 * (r >> 2) + 4 * hi; }
constexpr int AL_QS = 0, AL_OACC = 32768, AL_LACC = 98304, AL_KMS = 99328, AL_LIST = 107520, AL_CNT = 115712, AL_MISC = 115840;
__device__ __forceinline__ void attn_item(Frame& F, int bh, int i, float c1, float c2) {
    const float* QF = (const float*)(F.ws + WS_QF); const u16* KB = (const u16*)(F.ws + WS_KB); const u16* VT = (const u16*)(F.ws + WS_VT);
    const float* KM = (const float*)(F.ws + WS_KM); u16* ATT = (u16*)(F.ws + WS_ATT); float* SSQA = (float*)(F.ws + WS_SSQA);
    LAS u16* QS = (LAS u16*)(F.lds + AL_QS); LAS float* OACC = (LAS float*)(F.lds + AL_OACC); LAS float* LACC = (LAS float*)(F.lds + AL_LACC);
    LAS float* KMS = (LAS float*)(F.lds + AL_KMS); LAS unsigned char* LIST = (LAS unsigned char*)(F.lds + AL_LIST); LAS int* CNT = (LAS int*)(F.lds + AL_CNT);
    const int tid = F.tid, lane = F.lane, wave = F.wave, hi = lane >> 5, l31 = lane & 31;
    const int b = bh / NHEAD, h = bh % NHEAD;
    for (int u = tid; u < 256 * 64; u += NT) OACC[u] = 0.f;
    if (tid < 256) LACC[tid] = 0.f;
    if (tid < 32) CNT[tid] = 0;
    for (int u = tid; u < NBLK * HD; u += NT) { const int n = u >> 6, d = u & 63; KMS[u] = KM[(((size_t)(b * NBLK + n)) * NHEAD + h) * HD + d] * (1.0f / 256.0f); }
    __syncthreads();
    {
        const int q = tid >> 1, half = tid & 1;
        const GAS f32x4* qrow = (const GAS f32x4*)(QF + ((size_t)bh * SEQ + (size_t)i * BLK + q) * HD);
        f32x4 qv[16];
#pragma unroll
        for (int d = 0; d < 16; ++d) qv[d] = qrow[d];
#pragma unroll
        for (int d = 0; d < 4; ++d) { const f32x4 a = qv[2 * d], c = qv[2 * d + 1], a2 = qv[8 + 2 * d], c2 = qv[8 + 2 * d + 1];
            u32x4 w, w2; w.x = cvt_pk_bf16(a.x, a.y); w.y = cvt_pk_bf16(a.z, a.w); w.z = cvt_pk_bf16(c.x, c.y); w.w = cvt_pk_bf16(c.z, c.w);
            w2.x = cvt_pk_bf16(a2.x, a2.y); w2.y = cvt_pk_bf16(a2.z, a2.w); w2.z = cvt_pk_bf16(c2.x, c2.y); w2.w = cvt_pk_bf16(c2.z, c2.w);
            if (half) w = w2;
            *(LAS u32x4*)(QS + q * 64 + 32 * half + 8 * d) = w; }
        float v0 = -INFINITY, v1 = -INFINITY, v2 = -INFINITY; int i0 = -1, i1 = -1, i2 = -1;
        for (int nn = 0; nn < 16; ++nn) {
            const int n = 16 * half + nn;
            const LAS f32x4* kr = (const LAS f32x4*)(KMS + n * 64);
            float g = 0.f;
#pragma unroll
            for (int d = 0; d < 16; ++d) { const f32x4 kv = kr[d]; g = fmaf(qv[d].x, kv.x, g); g = fmaf(qv[d].y, kv.y, g); g = fmaf(qv[d].z, kv.z, g); g = fmaf(qv[d].w, kv.w, g); }
            if (n >= i) g = -INFINITY;
            if (g > v0) { v2 = v1; i2 = i1; v1 = v0; i1 = i0; v0 = g; i0 = n; }
            else if (g > v1) { v2 = v1; i2 = i1; v1 = g; i1 = n; }
            else if (g > v2) { v2 = g; i2 = n; }
        }
        const float pv0 = __shfl_xor(v0, 1), pv1 = __shfl_xor(v1, 1), pv2 = __shfl_xor(v2, 1);
        const int pi0 = __shfl_xor(i0, 1), pi1 = __shfl_xor(i1, 1), pi2 = __shfl_xor(i2, 1);
        if (half == 0) {
            float av[3] = {v0, v1, v2}, bv[3] = {pv0, pv1, pv2}; int ai[3] = {i0, i1, i2}, bi[3] = {pi0, pi1, pi2};
            int sel[3]; int pa = 0, pb = 0;
#pragma unroll
            for (int k = 0; k < 3; ++k) {
                const float ca = pa == 0 ? av[0] : (pa == 1 ? av[1] : av[2]); const int cai = pa == 0 ? ai[0] : (pa == 1 ? ai[1] : ai[2]);
                const float cb = pb == 0 ? bv[0] : (pb == 1 ? bv[1] : bv[2]); const int cbi = pb == 0 ? bi[0] : (pb == 1 ? bi[1] : bi[2]);
                if (ca >= cb) { sel[k] = cai; ++pa; } else { sel[k] = cbi; ++pb; }
            }
#pragma unroll
            for (int k = 0; k < 3; ++k) if (sel[k] >= 0) { const int pos = __hip_atomic_fetch_add(&CNT[sel[k]], 1, __ATOMIC_RELAXED, __HIP_MEMORY_SCOPE_WORKGROUP); LIST[sel[k] * 256 + pos] = (unsigned char)q; }
        }
    }
    __syncthreads();
    {
        int base = 0;
        for (int j = 0; j <= i; ++j) {
            const bool own = (j == i);
            const int cntj = own ? 256 : __builtin_amdgcn_readfirstlane(CNT[j]);
            const int ntj = (cntj + 31) >> 5;
            for (int t = base + ((wave - base) & 7); t < base + ntj; t += 8) {
                const int tt = t - base;
                const int ridx = 32 * tt + l31; const bool valid = ridx < cntj;
                const int qidx = own ? ridx : (valid ? (int)LIST[j * 256 + ridx] : 0);
                s16x8 qf[4];
#pragma unroll
                for (int s = 0; s < 4; ++s) qf[s] = *(const LAS s16x8*)(QS + qidx * 64 + 16 * s + 8 * hi);
                const u16* Kp = KB + ((size_t)bh * SEQ + (size_t)j * BLK) * HD;
                const u16* Vp = VT + (size_t)bh * HD * SEQ + (size_t)j * BLK;
                f32x16 o0, o1;
#pragma unroll
                for (int r = 0; r < 16; ++r) { o0[r] = 0.f; o1[r] = 0.f; }
                float lsum = 0.f;
                const int nkt = own ? (tt + 1) : 8;
                for (int kt = 0; kt < nkt; ++kt) {
                    f32x16 p;
#pragma unroll
                    for (int r = 0; r < 16; ++r) p[r] = 0.f;
#pragma unroll
                    for (int s = 0; s < 4; ++s) { const s16x8 kf = *(const s16x8*)(Kp + (size_t)(32 * kt + l31) * HD + 16 * s + 8 * hi);
                        p = __builtin_amdgcn_mfma_f32_32x32x16_bf16(__builtin_bit_cast(bf16x8_t, kf), __builtin_bit_cast(bf16x8_t, qf[s]), p, 0, 0, 0); }
                    const bool diag = own && (kt == tt);
#pragma unroll
                    for (int r = 0; r < 16; ++r) { float e = __builtin_amdgcn_exp2f(p[r] * c1 - c2);
                        if (diag && (32 * kt + crow(r, hi) > qidx)) e = 0.f;
                        p[r] = e; lsum += e; }
#pragma unroll
                    for (int s2 = 0; s2 < 2; ++s2) {
                        u32x4 pw; pw.x = cvt_pk_bf16(p[8 * s2 + 0], p[8 * s2 + 1]); pw.y = cvt_pk_bf16(p[8 * s2 + 2], p[8 * s2 + 3]); pw.z = cvt_pk_bf16(p[8 * s2 + 4], p[8 * s2 + 5]); pw.w = cvt_pk_bf16(p[8 * s2 + 6], p[8 * s2 + 7]);
                        const bf16x8_t pa = __builtin_bit_cast(bf16x8_t, pw);
                        const s16x8 vf0 = *(const s16x8*)(Vp + (size_t)l31 * SEQ + 32 * kt + 16 * s2 + 8 * hi);
                        const s16x8 vf1 = *(const s16x8*)(Vp + (size_t)(32 + l31) * SEQ + 32 * kt + 16 * s2 + 8 * hi);
                        o0 = __builtin_amdgcn_mfma_f32_32x32x16_bf16(pa, __builtin_bit_cast(bf16x8_t, vf0), o0, 0, 0, 0);
                        o1 = __builtin_amdgcn_mfma_f32_32x32x16_bf16(pa, __builtin_bit_cast(bf16x8_t, vf1), o1, 0, 0, 0);
                    }
                }
#pragma unroll
                for (int r = 0; r < 16; ++r) { const int rl = crow(r, hi); const int qi = __shfl(qidx, rl); const int vl = __shfl((int)valid, rl);
                    if (vl) { (void)__hip_atomic_fetch_add(&OACC[qi * 64 + l31], o0[r], __ATOMIC_RELAXED, __HIP_MEMORY_SCOPE_WORKGROUP); (void)__hip_atomic_fetch_add(&OACC[qi * 64 + 32 + l31], o1[r], __ATOMIC_RELAXED, __HIP_MEMORY_SCOPE_WORKGROUP); } }
                if (valid) (void)__hip_atomic_fetch_add(&LACC[qidx], lsum, __ATOMIC_RELAXED, __HIP_MEMORY_SCOPE_WORKGROUP);
            }
            base += ntj;
        }
    }
    __syncthreads();
    {
        const int q = tid >> 1, half = tid & 1;
        const float inv = 1.0f / LACC[q];
        const size_t tok = (size_t)b * SEQ + (size_t)i * BLK + q;
        float ss = 0.f;
#pragma unroll
        for (int d = 0; d < 4; ++d) { const LAS f32x4* op = (const LAS f32x4*)(OACC + q * 64 + 32 * half + 8 * d);
            const f32x4 a = op[0] * inv, c = op[1] * inv;
            ss += (a.x * a.x + a.y * a.y) + (a.z * a.z + a.w * a.w) + (c.x * c.x + c.y * c.y) + (c.z * c.z + c.w * c.w);
            u32x4 w; w.x = cvt_pk_bf16(a.x, a.y); w.y = cvt_pk_bf16(a.z, a.w); w.z = cvt_pk_bf16(c.x, c.y); w.w = cvt_pk_bf16(c.z, c.w);
            *(GAS u32x4*)(ATT + tok * AW + h * HD + 32 * half + 8 * d) = w; }
        ss += __shfl_xor(ss, 1);
        if (half == 0) SSQA[tok * NHEAD + h] = ss;
    }
    __syncthreads();
}
__device__ __forceinline__ void attn_phase(Frame& F) {
    LAS float* mm = (LAS float*)(F.lds + AL_MISC);
    if (F.tid < 64) { float a = fabsf(F.q_norm_g[F.tid]), c = fabsf(F.k_norm_g[F.tid]);
#pragma unroll
        for (int o = 1; o < 64; o <<= 1) { a = fmaxf(a, __shfl_xor(a, o)); c = fmaxf(c, __shfl_xor(c, o)); }
        if (F.tid == 0) { mm[0] = a; mm[1] = c; } }
    __syncthreads();
    const float C = 8.0f * mm[0] * mm[1];
    const float c1 = 0.125f * LOG2E, c2 = C * LOG2E;
    __syncthreads();
    for (int it = F.vcu; it < BATCH * NHEAD * NBLK; it += F.G) {
        const int r = it >> 8, bh = (it >> 3) & 31, s = it & 7;
        const int i = (r == 0) ? s : (r == 1) ? 15 - s : (r == 2) ? 16 + s : 31 - s;
        attn_item(F, bh, i, c1, c2);
    }
}

constexpr int LL_CW = 0;
template <bool FINAL>
__device__ __forceinline__ void lru_item(Frame& F, int b, int chunk) {
    const u16* XR = (const u16*)(F.ws + WS_XR); const u16* GG = (const u16*)(F.ws + WS_GG);
    const u16* WaT = (const u16*)(F.ws + WS_WA); const u16* WxT = (const u16*)(F.ws + WS_WX);
    float* AGG = (float*)(F.ws + WS_AGG); u16* LRU = (u16*)(F.ws + WS_LRU); float* SSQL = (float*)(F.ws + WS_SSQL);
    const int lane = F.lane, hd = F.wave, hi = lane >> 5, j = lane & 31;
    LAS float* CW = (LAS float*)(F.lds + LL_CW + hd * 1280);
    for (int u = lane; u < 320; u += 64) CW[u] = (u < 256) ? F.lru_conv_w[(u >> 6) * AW + hd * HD + (u & 63)] : F.lru_conv_b[hd * HD + (u - 256)];
    LDS_WAIT(); asm volatile("" ::: "memory");
    float ba[2], bx[2], sp8[2], carry[2], arun[2];
#pragma unroll
    for (int ct = 0; ct < 2; ++ct) { const int c = hd * HD + 32 * ct + j; ba[ct] = F.lru_ba[c]; bx[ct] = F.lru_bx[c];
        sp8[ct] = 8.0f * log1pf(expf(-F.lru_lambda[c])); carry[ct] = 0.f; arun[ct] = 1.f;
        if (FINAL) { float hcar = 0.f; for (int cc = 0; cc < chunk; ++cc) { const f32x2 ah = *(const f32x2*)(AGG + (((size_t)(b * 64 + cc)) * AW + c) * 2); hcar = ah.x * hcar + ah.y; } carry[ct] = hcar; } }
    for (int tile = 0; tile < 4; ++tile) {
        const int t0 = chunk * 128 + tile * 32;
        const int pos = t0 + j;
        s16x8 af[4], gf[4];
#pragma unroll
        for (int s = 0; s < 4; ++s) {
            const int ch0 = 16 * s + 8 * hi;
            float xc[8];
            { const LAS f32x4* bp = (const LAS f32x4*)(CW + 256 + ch0); const f32x4 b0 = bp[0], b1 = bp[1];
              xc[0] = b0.x; xc[1] = b0.y; xc[2] = b0.z; xc[3] = b0.w; xc[4] = b1.x; xc[5] = b1.y; xc[6] = b1.z; xc[7] = b1.w; }
            float accv[8];
#pragma unroll
            for (int e = 0; e < 8; ++e) accv[e] = 0.f;
#pragma unroll
            for (int jj = 0; jj < 4; ++jj) {
                const int p = pos - 3 + jj;
                u32x4 xw = (u32x4){0u, 0u, 0u, 0u};
                if (p >= 0) xw = *(const GAS u32x4*)(XR + ((size_t)b * SEQ + p) * AW + hd * HD + ch0);
                const LAS f32x4* wp = (const LAS f32x4*)(CW + jj * 64 + ch0); const f32x4 w0 = wp[0], w1 = wp[1];
                accv[0] += w0.x * bf_lo(xw.x); accv[1] += w0.y * bf_hi(xw.x); accv[2] += w0.z * bf_lo(xw.y); accv[3] += w0.w * bf_hi(xw.y);
                accv[4] += w1.x * bf_lo(xw.z); accv[5] += w1.y * bf_hi(xw.z); accv[6] += w1.z * bf_lo(xw.w); accv[7] += w1.w * bf_hi(xw.w);
            }
#pragma unroll
            for (int e = 0; e < 8; ++e) xc[e] += accv[e];
            u32x4 aw; aw.x = cvt_pk_bf16(xc[0], xc[1]); aw.y = cvt_pk_bf16(xc[2], xc[3]); aw.z = cvt_pk_bf16(xc[4], xc[5]); aw.w = cvt_pk_bf16(xc[6], xc[7]);
            af[s] = __builtin_bit_cast(s16x8, aw);
            if (FINAL) gf[s] = *(const GAS s16x8*)(GG + ((size_t)b * SEQ + pos) * AW + hd * HD + ch0);
        }
        float ssacc[16];
#pragma unroll
        for (int r = 0; r < 16; ++r) ssacc[r] = 0.f;
#pragma unroll
        for (int ct = 0; ct < 2; ++ct) {
            f32x16 aA, aX, aI, aG;
#pragma unroll
            for (int r = 0; r < 16; ++r) { aA[r] = 0.f; aX[r] = 0.f; aI[r] = 0.f; aG[r] = 0.f; }
#pragma unroll
            for (int s = 0; s < 4; ++s) {
                const size_t woff = ((size_t)hd * 64 + 32 * ct + j) * 64 + 16 * s + 8 * hi;
                const s16x8 wa = *(const GAS s16x8*)(WaT + woff), wx = *(const GAS s16x8*)(WxT + woff);
                s16x8 id;
#pragma unroll
                for (int e = 0; e < 8; ++e) id[e] = (16 * s + 8 * hi + e == 32 * ct + j) ? (short)0x3F80 : (short)0;
                const bf16x8_t a = __builtin_bit_cast(bf16x8_t, af[s]);
                aA = __builtin_amdgcn_mfma_f32_32x32x16_bf16(a, __builtin_bit_cast(bf16x8_t, wa), aA, 0, 0, 0);
                aX = __builtin_amdgcn_mfma_f32_32x32x16_bf16(a, __builtin_bit_cast(bf16x8_t, wx), aX, 0, 0, 0);
                aI = __builtin_amdgcn_mfma_f32_32x32x16_bf16(a, __builtin_bit_cast(bf16x8_t, id), aI, 0, 0, 0);
                if (FINAL) aG = __builtin_amdgcn_mfma_f32_32x32x16_bf16(__builtin_bit_cast(bf16x8_t, gf[s]), __builtin_bit_cast(bf16x8_t, id), aG, 0, 0, 0);
            }
            float av[16], uv[16];
#pragma unroll
            for (int r = 0; r < 16; ++r) {
                const float rr = sigmoidf_(aA[r] + ba[ct]), ii = sigmoidf_(aX[r] + bx[ct]);
                const float la = -rr * sp8[ct];
                const float a = __builtin_amdgcn_exp2f(la * LOG2E);
                const float x2 = 2.0f * la;
                const float om = (x2 > -0.05f) ? -x2 * (1.0f + x2 * 0.5f * (1.0f + x2 * (1.0f / 3.0f) * (1.0f + x2 * 0.25f))) : 1.0f - a * a;
                av[r] = a; uv[r] = sqrtf(om) * (ii * aI[r]);
            }
            float Ag[4], Ug[4];
#pragma unroll
            for (int g = 0; g < 4; ++g) { float A = av[4 * g], U = uv[4 * g];
#pragma unroll
                for (int e = 1; e < 4; ++e) { A *= av[4 * g + e]; U = av[4 * g + e] * U + uv[4 * g + e]; }
                Ag[g] = A; Ug[g] = U; }
            float h = carry[ct], ap = arun[ct];
            float hin[4];
#pragma unroll
            for (int g = 0; g < 4; ++g) {
                const float pA = __shfl_xor(Ag[g], 32), pU = __shfl_xor(Ug[g], 32);
                const float fA = hi ? pA : Ag[g], fU = hi ? pU : Ug[g], sA = hi ? Ag[g] : pA, sU = hi ? Ug[g] : pU;
                const float h1 = fA * h + fU;
                hin[g] = hi ? h1 : h;
                h = sA * h1 + sU; ap *= fA * sA;
            }
            carry[ct] = h; arun[ct] = ap;
            if (FINAL) {
#pragma unroll
                for (int g = 0; g < 4; ++g) { float hh = hin[g];
#pragma unroll
                    for (int e = 0; e < 4; ++e) { const int r = 4 * g + e; hh = av[r] * hh + uv[r]; const float o = hh * aG[r]; ssacc[r] += o * o;
                        const size_t tok = (size_t)b * SEQ + t0 + crow(r, hi);
                        LRU[tok * AW + hd * HD + 32 * ct + j] = (u16)(cvt_pk_bf16(o, 0.f) & 0xffffu); } }
            }
        }
        if (FINAL) {
#pragma unroll
            for (int r = 0; r < 16; ++r) {
                const size_t tok = (size_t)b * SEQ + t0 + crow(r, hi);
                float ss = ssacc[r];
                ss += __shfl_xor(ss, 1); ss += __shfl_xor(ss, 2); ss += __shfl_xor(ss, 4); ss += __shfl_xor(ss, 8); ss += __shfl_xor(ss, 16);
                if (j == 0) SSQL[tok * NHEAD + hd] = ss;
            }
        }
    }
    if (!FINAL) { if (hi == 0) {
#pragma unroll
        for (int ct = 0; ct < 2; ++ct) { const int c = hd * HD + 32 * ct + j; *(f32x2*)(AGG + (((size_t)(b * 64 + chunk)) * AW + c) * 2) = (f32x2){arun[ct], carry[ct]}; } } }
}
template <bool FINAL>
__device__ __forceinline__ void lru_phase(Frame& F) {
    for (int it = F.vcu; it < BATCH * 64; it += F.G) { lru_item<FINAL>(F, it >> 6, it & 63); }
}

__device__ __forceinline__ void mix_phase(Frame& F) {
    const u16* LRU = (const u16*)(F.ws + WS_LRU); const u16* ATT = (const u16*)(F.ws + WS_ATT);
    const float* SSQL = (const float*)(F.ws + WS_SSQL); const float* SSQA = (const float*)(F.ws + WS_SSQA); u16* MIX = (u16*)(F.ws + WS_MIX);
    const int gw = F.vcu * NWAVES + F.wave, NGW = F.G * NWAVES, lane = F.lane;
    const f32x4 gl0 = *(const f32x4*)(F.lru_out_g + 8 * lane), gl1 = *(const f32x4*)(F.lru_out_g + 8 * lane + 4);
    const f32x4 ga0 = *(const f32x4*)(F.attn_out_g + 8 * lane), ga1 = *(const f32x4*)(F.attn_out_g + 8 * lane + 4);
    for (int m = gw; m < M_TOK; m += NGW) {
        const f32x4 s0 = *(const GAS f32x4*)(SSQL + (size_t)m * 8), s1 = *(const GAS f32x4*)(SSQL + (size_t)m * 8 + 4);
        const f32x4 t0 = *(const GAS f32x4*)(SSQA + (size_t)m * 8), t1 = *(const GAS f32x4*)(SSQA + (size_t)m * 8 + 4);
        const float ssl = ((s0.x + s0.y) + (s0.z + s0.w)) + ((s1.x + s1.y) + (s1.z + s1.w));
        const float ssa = ((t0.x + t0.y) + (t0.z + t0.w)) + ((t1.x + t1.y) + (t1.z + t1.w));
        const float rl = 1.0f / sqrtf(ssl * (1.0f / AW) + EPS), ra = 1.0f / sqrtf(ssa * (1.0f / AW) + EPS);
        const u32x4 lw = *(const GAS u32x4*)(LRU + (size_t)m * AW + 8 * lane), aw = *(const GAS u32x4*)(ATT + (size_t)m * AW + 8 * lane);
        u32x4 o;
        o.x = cvt_pk_bf16(bf_lo(lw.x) * rl * gl0.x, bf_hi(lw.x) * rl * gl0.y); o.y = cvt_pk_bf16(bf_lo(lw.y) * rl * gl0.z, bf_hi(lw.y) * rl * gl0.w);
        o.z = cvt_pk_bf16(bf_lo(lw.z) * rl * gl1.x, bf_hi(lw.z) * rl * gl1.y); o.w = cvt_pk_bf16(bf_lo(lw.w) * rl * gl1.z, bf_hi(lw.w) * rl * gl1.w);
        *(GAS u32x4*)(MIX + (size_t)m * D_MODEL + 8 * lane) = o;
        o.x = cvt_pk_bf16(bf_lo(aw.x) * ra * ga0.x, bf_hi(aw.x) * ra * ga0.y); o.y = cvt_pk_bf16(bf_lo(aw.y) * ra * ga0.z, bf_hi(aw.y) * ra * ga0.w);
        o.z = cvt_pk_bf16(bf_lo(aw.z) * ra * ga1.x, bf_hi(aw.z) * ra * ga1.y); o.w = cvt_pk_bf16(bf_lo(aw.w) * ra * ga1.z, bf_hi(aw.w) * ra * ga1.w);
        *(GAS u32x4*)(MIX + (size_t)m * D_MODEL + AW + 8 * lane) = o;
    }
}

__device__ __forceinline__ void act_phase(Frame& F, int half) {
    const u16* UP = (const u16*)(F.ws + WS_UPH); u16* ACT = (u16*)(F.ws + WS_ACT);
    constexpr int NF8 = D_FF / 8;
    const long total = (long)(M_TOK / 2) * NF8;
    for (long it = (long)F.vcu * NT + F.tid; it < total; it += (long)F.G * NT) {
        const int tl = (int)(it / NF8), f0 = (int)(it % NF8) * 8;
        const int tok = half * (M_TOK / 2) + tl, pos = tok % SEQ;
        float cg[8], cv[8];
        { const f32x4 a = *(const f32x4*)(F.ffn_conv_b + f0), c = *(const f32x4*)(F.ffn_conv_b + f0 + 4);
          cg[0] = a.x; cg[1] = a.y; cg[2] = a.z; cg[3] = a.w; cg[4] = c.x; cg[5] = c.y; cg[6] = c.z; cg[7] = c.w; }
        { const f32x4 a = *(const f32x4*)(F.ffn_conv_b + D_FF + f0), c = *(const f32x4*)(F.ffn_conv_b + D_FF + f0 + 4);
          cv[0] = a.x; cv[1] = a.y; cv[2] = a.z; cv[3] = a.w; cv[4] = c.x; cv[5] = c.y; cv[6] = c.z; cv[7] = c.w; }
        float sg[8], sv[8];
#pragma unroll
        for (int e = 0; e < 8; ++e) { sg[e] = 0.f; sv[e] = 0.f; }
#pragma unroll
        for (int jj = 0; jj < 3; ++jj) {
            const int p = pos - 2 + jj;
            if (p >= 0) {
                const u32x4 gw = *(const GAS u32x4*)(UP + (size_t)(tl - 2 + jj) * N_UP + f0), vw = *(const GAS u32x4*)(UP + (size_t)(tl - 2 + jj) * N_UP + D_FF + f0);
                const f32x4 wg0 = *(const f32x4*)(F.ffn_conv_w + (size_t)jj * N_UP + f0), wg1 = *(const f32x4*)(F.ffn_conv_w + (size_t)jj * N_UP + f0 + 4);
                const f32x4 wv0 = *(const f32x4*)(F.ffn_conv_w + (size_t)jj * N_UP + D_FF + f0), wv1 = *(const f32x4*)(F.ffn_conv_w + (size_t)jj * N_UP + D_FF + f0 + 4);
                sg[0] += wg0.x * bf_lo(gw.x); sg[1] += wg0.y * bf_hi(gw.x); sg[2] += wg0.z * bf_lo(gw.y); sg[3] += wg0.w * bf_hi(gw.y);
                sg[4] += wg1.x * bf_lo(gw.z); sg[5] += wg1.y * bf_hi(gw.z); sg[6] += wg1.z * bf_lo(gw.w); sg[7] += wg1.w * bf_hi(gw.w);
                sv[0] += wv0.x * bf_lo(vw.x); sv[1] += wv0.y * bf_hi(vw.x); sv[2] += wv0.z * bf_lo(vw.y); sv[3] += wv0.w * bf_hi(vw.y);
                sv[4] += wv1.x * bf_lo(vw.z); sv[5] += wv1.y * bf_hi(vw.z); sv[6] += wv1.z * bf_lo(vw.w); sv[7] += wv1.w * bf_hi(vw.w);
            }
        }
        float o[8];
#pragma unroll
        for (int e = 0; e < 8; ++e) { const float g = sg[e] + cg[e], v = sv[e] + cv[e]; o[e] = g * sigmoidf_(g) * v; }
        u32x4 w; w.x = cvt_pk_bf16(o[0], o[1]); w.y = cvt_pk_bf16(o[2], o[3]); w.z = cvt_pk_bf16(o[4], o[5]); w.w = cvt_pk_bf16(o[6], o[7]);
        *(GAS u32x4*)(ACT + (size_t)tok * D_FF + f0) = w;
    }
}

constexpr int N_PHASES = 13;
struct Args { const float* in[23]; float* out; unsigned char* ws; int ph_lo, ph_hi; };
__global__ void __launch_bounds__(NT, 2) hymba_fwd(Args args) {
    extern __shared__ __attribute__((aligned(16))) unsigned char lds_raw[];
    Frame F;
    F.lds = (LAS unsigned char*)lds_raw;
    F.tid = threadIdx.x; F.lane = F.tid & 63; F.wave = __builtin_amdgcn_readfirstlane(F.tid >> 6);
    F.G = gridDim.x; { const int bx = blockIdx.x; F.vcu = (F.G % 8 == 0) ? (bx % 8) * (F.G / 8) + bx / 8 : bx; }
    F.x = args.in[0]; F.c = args.in[1]; F.w_ada = args.in[2]; F.b_ada = args.in[3]; F.norm1_g = args.in[4]; F.w_in = args.in[5]; F.q_norm_g = args.in[6]; F.k_norm_g = args.in[7];
    F.lru_conv_w = args.in[8]; F.lru_conv_b = args.in[9]; F.lru_wa = args.in[10]; F.lru_ba = args.in[11]; F.lru_wx = args.in[12]; F.lru_bx = args.in[13]; F.lru_lambda = args.in[14];
    F.lru_out_g = args.in[15]; F.attn_out_g = args.in[16]; F.w_out = args.in[17]; F.norm2_g = args.in[18]; F.w_up = args.in[19]; F.ffn_conv_w = args.in[20]; F.ffn_conv_b = args.in[21]; F.w_down = args.in[22];
    F.out = args.out; F.ws = args.ws;
    volatile LAS unsigned* MISC = (volatile LAS unsigned*)(F.lds + MISC_OFF);
    if (F.tid < 32) MISC[F.tid] = 0u;
    __syncthreads();
    const int lo = args.ph_lo, hi = args.ph_hi;
    unsigned* ctl = (unsigned*)(F.ws + WS_CTL);
    XcdBarrier bar; bar.bar = ctl + CW_BAR; bar.x = 0; bar.st = nullptr;
    if (hi - lo > 1) bar = xcd_barrier_post(ctl + CW_BAR, MISC + 8);
#ifndef PHASE_MASK
#define PHASE_MASK 0x1FFF
#endif
#define IN(k) (((PHASE_MASK >> (k)) & 1) && lo <= (k) && (k) < hi)
#define SEAM(k) do { if (IN(k) && IN((k) + 1)) xcd_barrier(bar); } while (0)
    float* MOD = (float*)(F.ws + WS_MOD);
    u16* H = (u16*)(F.ws + WS_H);

    if (IN(0)) { p0_prologue(F); SEAM(0); }
    if (IN(1)) { rownorm_phase<true>(F, F.x, F.norm1_g, MOD + 0, MOD + 1024, H); SEAM(1); }
    if (IN(2)) {
        pg8::Gemm g{H, (const u16*)(F.ws + WS_WIN), M_TOK, N_IN, D_MODEL}; pg8::StaticOrder S; S.init(M_TOK, N_IN, F.G, (int)blockIdx.x);
        pg8::EpiInProj E{(float*)(F.ws + WS_QF), (u16*)(F.ws + WS_KB), (u16*)(F.ws + WS_VT), (u16*)(F.ws + WS_XR), (u16*)(F.ws + WS_GG), (float*)(F.ws + WS_KM), F.q_norm_g, F.k_norm_g};
        pg8::gemm_phase<pg8::EpiInProj, pg8::StaticOrder, true, true, true>(F.lds, g, S, E);
        SEAM(2);
    }
    if (IN(3)) { attn_phase(F); lru_phase<false>(F); SEAM(3); }
    if (IN(4)) { lru_phase<true>(F); SEAM(4); }
    if (IN(5)) { mix_phase(F); SEAM(5); }
    if (IN(6)) {
        pg8::Gemm g{(const u16*)(F.ws + WS_MIX), (const u16*)(F.ws + WS_WO), M_TOK, D_MODEL, D_MODEL}; pg8::StaticOrder S; S.init(M_TOK, D_MODEL, F.G, (int)blockIdx.x);
        pg8::EpiResid E{F.x, F.out, MOD + 2048};
        pg8::gemm_phase<pg8::EpiResid, pg8::StaticOrder, true, true, false>(F.lds, g, S, E);
        SEAM(6);
    }
    if (IN(7)) { rownorm_phase<false>(F, F.out, F.norm2_g, MOD + 3072, MOD + 4096, H); SEAM(7); }
#pragma unroll 1
    for (int half = 0; half < 2; ++half) {
        if (IN(8 + 2 * half)) {
            pg8::Gemm g{H + (size_t)half * (M_TOK / 2) * D_MODEL, (const u16*)(F.ws + WS_WUP), M_TOK / 2, N_UP, D_MODEL}; pg8::StaticOrder S; S.init(M_TOK / 2, N_UP, F.G, (int)blockIdx.x);
            pg8::EpiBf16 E{(u16*)(F.ws + WS_UPH), N_UP};
            pg8::gemm_phase<pg8::EpiBf16, pg8::StaticOrder, true, true, false>(F.lds, g, S, E);
            SEAM(8 + 2 * half);
        }
        if (IN(9 + 2 * half)) { act_phase(F, half); SEAM(9 + 2 * half); }
    }
    if (IN(12)) {
        pg8::Gemm g{(const u16*)(F.ws + WS_ACT), (const u16*)(F.ws + WS_WDN), M_TOK, D_MODEL, D_FF}; pg8::StaticOrder S; S.init(M_TOK, D_MODEL, F.G, (int)blockIdx.x);
        pg8::EpiResid E{F.out, F.out, MOD + 5120};
        pg8::gemm_phase<pg8::EpiResid, pg8::StaticOrder, true, true, false>(F.lds, g, S, E);
    }
    if (hi - lo > 1 && hi == N_PHASES) {
        if (xb_ld(ctl + CW_BAR + XB_TMO) != 0u) { asm volatile("s_waitcnt vmcnt(0)" ::: "memory"); __syncthreads();
            for (size_t i = (size_t)blockIdx.x * NT + F.tid; i < (size_t)M_TOK * D_MODEL; i += (size_t)F.G * NT) F.out[i] = __builtin_nanf(""); }
    }
#undef IN
#undef SEAM
}

#ifndef MK_PER_PHASE
#define MK_PER_PHASE 0
#endif
extern "C" void kernel_launch(void* const* d_in, const int* in_sizes, int n_in, void* d_out, int out_size, void* d_ws, size_t ws_size, hipStream_t stream) {
    static int grid = 0;
    if (grid == 0) {
        if (n_in != 23 || in_sizes[0] != M_TOK * D_MODEL || out_size != M_TOK * D_MODEL || ws_size < WS_END) {
            fprintf(stderr, "kernel_launch: unexpected shapes (n_in %d, in0 %d, out %d, ws %zu); nothing launched\n", n_in, n_in > 0 ? in_sizes[0] : -1, out_size, ws_size); grid = -1; return; }
        int dev = 0, cus = 0;
        if (hipGetDevice(&dev) != hipSuccess || hipDeviceGetAttribute(&cus, hipDeviceAttributeMultiprocessorCount, dev) != hipSuccess) { grid = -1; return; }
        if (hipFuncSetAttribute((const void*)hymba_fwd, hipFuncAttributeMaxDynamicSharedMemorySize, LDS_BYTES) != hipSuccess) { fprintf(stderr, "kernel_launch: hipFuncSetAttribute failed\n"); grid = -1; return; }
        grid = cus;
    }
    if (grid < 0) return;
    (void)hipMemsetAsync((char*)d_ws + WS_CTL, 0, CTL_ZERO_BYTES, stream);
    Args a{};
    for (int i = 0; i < 23; ++i) a.in[i] = (const float*)d_in[i];
    a.out = (float*)d_out; a.ws = (unsigned char*)d_ws;
#if MK_PER_PHASE
    for (int p = 0; p < N_PHASES; ++p) { a.ph_lo = p; a.ph_hi = p + 1; hipLaunchKernelGGL(hymba_fwd, dim3(grid), dim3(NT), LDS_BYTES, stream, a); }
#else
    a.ph_lo = 0; a.ph_hi = N_PHASES; hipLaunchKernelGGL(hymba_fwd, dim3(grid), dim3(NT), LDS_BYTES, stream, a);
#endif
}
```

```cpp
#include <hip/hip_runtime.h>
#include <cstdio>
#include <cstdint>

#define GAS __attribute__((address_space(1)))
#define LAS __attribute__((address_space(3)))
typedef unsigned short u16;
typedef short s16x8 __attribute__((ext_vector_type(8)));
typedef _Float16 f16x8 __attribute__((ext_vector_type(8)));
typedef __bf16 bf16x8_t __attribute__((ext_vector_type(8)));
typedef float f32x2 __attribute__((ext_vector_type(2)));
typedef float f32x4 __attribute__((ext_vector_type(4)));
typedef float f32x16 __attribute__((ext_vector_type(16)));
typedef unsigned u32x4 __attribute__((ext_vector_type(4)));
typedef unsigned u32x2 __attribute__((ext_vector_type(2)));
typedef GAS unsigned gu32;
#define RLX_AGENT __ATOMIC_RELAXED, __HIP_MEMORY_SCOPE_AGENT

constexpr int D_MODEL = 1024, BATCH = 4, SEQ = 8192, M_TOK = BATCH * SEQ;
constexpr int N_IN = 2560, D_FF = 2816, N_UP = 2 * D_FF, N_MOD = 6 * D_MODEL;
constexpr int NHEAD = 8, HD = 64, AW = 512, NBLK = 32, BLK = 256;
constexpr float EPS = 1e-6f;
constexpr float LOG2E = 1.4426950408889634f;

__device__ __forceinline__ unsigned cvt_pk_bf16(float lo, float hi) { unsigned r; asm volatile("v_cvt_pk_bf16_f32 %0, %1, %2" : "=v"(r) : "v"(lo), "v"(hi)); return r; }
__device__ __forceinline__ unsigned cvt_pk_f16(float lo, float hi) {
    const _Float16 a = (_Float16)lo, b = (_Float16)hi;
    return (unsigned)__builtin_bit_cast(unsigned short, a) | ((unsigned)__builtin_bit_cast(unsigned short, b) << 16);
}
__device__ __forceinline__ float bf_lo(unsigned w) { return __builtin_bit_cast(float, w << 16); }
__device__ __forceinline__ float bf_hi(unsigned w) { return __builtin_bit_cast(float, w & 0xffff0000u); }
__device__ __forceinline__ float sigmoidf_(float v) { return __builtin_amdgcn_rcpf(1.0f + __builtin_amdgcn_exp2f(-v * LOG2E)); }
__device__ __forceinline__ float gelu_tanh(float v) { const float y = 0.7978845608028654f * (v + 0.044715f * v * v * v); return v * sigmoidf_(2.0f * y); }
__device__ __forceinline__ float wave_sum(float v) {
#pragma unroll
    for (int o = 1; o < 64; o <<= 1) v += __shfl_xor(v, o);
    return v;
}

namespace pg8 {
constexpr int BM = 256, BK = 64, HALF = 128, HTB = HALF * BK * 2, STAGE_BYTES = 8 * HTB, NXCD = 8, WGM = 8;
__host__ __device__ __forceinline__ int lds_byte(int r, int c) { const int st = (r >> 4) * 2 + (c >> 5), rr = r & 15, cc = c & 31, ob = rr * 64 + cc * 2; return st * 1024 + (ob ^ (((ob >> 9) & 1) << 5)); }
__host__ __device__ __forceinline__ void stage_rc(int b, int& R, int& C) { const int st = b / 1024, sb = b % 1024, swz = sb ^ (((sb >> 9) & 1) << 5); R = (st >> 1) * 16 + swz / 64; C = (st & 1) * 32 + (swz % 64) / 2; }
__host__ __device__ __forceinline__ int perm32(int rho) { const int n = rho >> 4, i = rho & 15; return 8 * (i >> 2) + 4 * n + (i & 3); }

struct Unit { int pm, pn; };
struct Gemm { const u16* A; const u16* Bt; int M, N, K; };

struct StaticOrder {
    int nM, nN, nwg, G, c;
    __host__ __device__ void init(int M, int N, int G_, int c_) { nM = M / BM; nN = N / BM; nwg = nM * nN; G = G_; c = c_; }
    __host__ __device__ bool next(int i, Unit& u) const {
        const long L = (long)i * G + c; if (L >= nwg) return false;
        int wgid = (int)L; { const int q = nwg / NXCD, r = nwg % NXCD, xcd = wgid % NXCD, off = wgid / NXCD; wgid = (xcd < r ? xcd * (q + 1) : r * (q + 1) + (xcd - r) * q) + off; }
        const int nig = WGM * nN, gid = wgid / nig, fm = gid * WGM, gsz = (nM - fm) < WGM ? (nM - fm) : WGM;
        u.pm = fm + ((wgid % nig) % gsz); u.pn = (wgid % nig) / gsz; return true;
    }
    __device__ __forceinline__ void a_ready(const Unit&) const {}
    __device__ __forceinline__ void done(const Unit&) const {}
};

template <bool F16> __device__ __forceinline__ f32x4 mfma16(s16x8 a, s16x8 b, f32x4 c) {
    if constexpr (F16) return __builtin_amdgcn_mfma_f32_16x16x32_f16(__builtin_bit_cast(f16x8, a), __builtin_bit_cast(f16x8, b), c, 0, 0, 0);
    else return __builtin_amdgcn_mfma_f32_16x16x32_bf16(__builtin_bit_cast(bf16x8_t, a), __builtin_bit_cast(bf16x8_t, b), c, 0, 0, 0);
}

template <class Epi, class Sched, bool ALIGN_EPI, bool SP2, bool F16>
__device__ __forceinline__ void gemm_phase(LAS unsigned char* lds, const Gemm g, const Sched& S, const Epi& E) {
    int tid_ = threadIdx.x; asm volatile("" : "+v"(tid_));
    const int tid = tid_, wid = __builtin_amdgcn_readfirstlane(tid >> 6), lane = tid & 63, wr = wid >> 2, wc = wid & 3, fr = lane & 15, fq = lane >> 4;
    const int K = g.K, nt = K / BK;
    unsigned voffA, voffB;
    { int R, C; stage_rc(tid * 16, R, C); const int Rb = Epi::PERM ? ((R & ~31) + perm32(R & 31)) : R;
        voffA = (unsigned)(R * K + C) * 2u; voffB = (unsigned)(Rb * K + C) * 2u; }
    const unsigned rstep64 = (unsigned)(64 * K * 2);
    const size_t kstep = (size_t)(BK * 2);
    const size_t hstep = (size_t)HALF * K * 2;
    const size_t tstep = 2 * hstep;
    const unsigned ldsw = (unsigned)wid * 1024u;
    const int aoff = lds_byte(wr * 64 + fr, fq * 8), boff = lds_byte(wc * 32 + fr, fq * 8);
#define PG8_SA(b, h) (((b) * 2 + (h)) * HTB)
#define PG8_SB(b, h) ((4 + (b) * 2 + (h)) * HTB)
#define PG8_STAGE(bufoff, gbase, voff) do { _Pragma("unroll") for (int _i = 0; _i < 2; ++_i) \
        __builtin_amdgcn_global_load_lds((const unsigned*)((const char*)(gbase) + _i * rstep64 + (voff)), (LAS unsigned*)(lds + (bufoff) + ldsw + _i * 8192), 16, 0, 0); } while (0)
#define PG8_LDA(dst, b, h) do { _Pragma("unroll") for (int m = 0; m < 4; ++m) _Pragma("unroll") for (int k = 0; k < 2; ++k) dst[m][k] = *(const LAS s16x8*)(lds + PG8_SA(b, h) + aoff + m * 2048 + k * 1024); } while (0)
#define PG8_LDB(dst, b, h) do { _Pragma("unroll") for (int n = 0; n < 2; ++n) _Pragma("unroll") for (int k = 0; k < 2; ++k) dst[n][k] = *(const LAS s16x8*)(lds + PG8_SB(b, h) + boff + n * 2048 + k * 1024); } while (0)
#define PG8_MMA(ai, bj, At, Bt) do { __builtin_amdgcn_s_setprio(1); _Pragma("unroll") for (int m = 0; m < 4; ++m) _Pragma("unroll") for (int n = 0; n < 2; ++n) _Pragma("unroll") for (int k = 0; k < 2; ++k) \
        acc[ai][bj][m][n] = mfma16<F16>(Bt[n][k], At[m][k], acc[ai][bj][m][n]); __builtin_amdgcn_s_setprio(0); } while (0)
#define PG8_WAIT_V(n) asm volatile("s_waitcnt vmcnt(" #n ")" ::: "memory")
#define PG8_WAIT_L(n) asm volatile("s_waitcnt lgkmcnt(" #n ")" ::: "memory")
#define PG8_BAR __builtin_amdgcn_s_barrier()
#define PG8_SCHED __builtin_amdgcn_sched_barrier(0)
    Unit cur, nxt; int ui = 0;
    if (!S.next(0, cur)) return;
    f32x4 acc[2][2][4][2];
#pragma unroll
    for (int a = 0; a < 2; ++a)
#pragma unroll
        for (int b = 0; b < 2; ++b)
#pragma unroll
            for (int m = 0; m < 4; ++m)
#pragma unroll
                for (int n = 0; n < 2; ++n) acc[a][b][m][n] = (f32x4){0.f, 0.f, 0.f, 0.f};
    s16x8 At[4][2], B0[2][2], B1[2][2];
    const char* cA = (const char*)g.A + (size_t)cur.pm * tstep; const char* cB = (const char*)g.Bt + (size_t)cur.pn * tstep;
    S.a_ready(cur);
    if constexpr (SP2) {
        PG8_STAGE(PG8_SB(0, 0), cB, voffB); PG8_STAGE(PG8_SB(0, 1), cB + hstep, voffB); PG8_STAGE(PG8_SA(0, 0), cA, voffA); PG8_STAGE(PG8_SA(0, 1), cA + hstep, voffA);
        if (wr == 1) PG8_BAR;
        PG8_WAIT_V(2); PG8_BAR;
        PG8_STAGE(PG8_SB(1, 0), cB + kstep, voffB); PG8_STAGE(PG8_SA(1, 0), cA + kstep, voffA); PG8_STAGE(PG8_SB(1, 1), cB + hstep + kstep, voffB);
        PG8_WAIT_V(6); PG8_BAR;
    } else {
        PG8_STAGE(PG8_SB(0, 0), cB, voffB); PG8_STAGE(PG8_SA(0, 0), cA, voffA); PG8_STAGE(PG8_SB(0, 1), cB + hstep, voffB); PG8_STAGE(PG8_SA(0, 1), cA + hstep, voffA);
        if (wr == 1) PG8_BAR;
        PG8_WAIT_V(4); PG8_BAR;
        PG8_STAGE(PG8_SB(1, 0), cB + kstep, voffB); PG8_STAGE(PG8_SA(1, 0), cA + kstep, voffA); PG8_STAGE(PG8_SB(1, 1), cB + hstep + kstep, voffB);
        PG8_WAIT_V(6); PG8_BAR;
    }
    for (;;) {
        const bool has_next = S.next(ui + 1, nxt);
        const char* nA = has_next ? (const char*)g.A + (size_t)nxt.pm * tstep : cA; const char* nB = has_next ? (const char*)g.Bt + (size_t)nxt.pn * tstep : cB;
        for (int t = 0; t < nt; t += 2) {
            const bool last = (t == nt - 2);
            const char* a1 = cA + (size_t)(t + 1) * kstep;
            const char* a2 = last ? nA : cA + (size_t)(t + 2) * kstep; const char* b2 = last ? nB : cB + (size_t)(t + 2) * kstep;
            const char* a3 = a2 + kstep; const char* b3 = b2 + kstep;
            if (last && has_next) S.a_ready(nxt);
            if constexpr (SP2) {
            PG8_LDB(B0, 0, 0); PG8_LDB(B1, 0, 1); PG8_SCHED; PG8_LDA(At, 0, 0); PG8_STAGE(PG8_SA(1, 1), a1 + hstep, voffA);
            PG8_WAIT_V(8); PG8_WAIT_L(0); PG8_BAR; PG8_MMA(0, 0, At, B0); PG8_MMA(0, 1, At, B1); PG8_BAR; PG8_SCHED;
            PG8_LDA(At, 0, 1); PG8_STAGE(PG8_SB(0, 0), b2, voffB); PG8_STAGE(PG8_SB(0, 1), b2 + hstep, voffB); PG8_STAGE(PG8_SA(0, 0), a2, voffA);
            PG8_WAIT_V(8); PG8_WAIT_L(0); PG8_BAR; PG8_MMA(1, 0, At, B0); PG8_MMA(1, 1, At, B1); PG8_BAR; PG8_SCHED;
            PG8_LDB(B0, 1, 0); PG8_LDB(B1, 1, 1); PG8_SCHED; PG8_LDA(At, 1, 0); PG8_STAGE(PG8_SA(0, 1), a2 + hstep, voffA);
            PG8_WAIT_V(8); PG8_WAIT_L(0); PG8_BAR; PG8_MMA(0, 0, At, B0); PG8_MMA(0, 1, At, B1); PG8_BAR; PG8_SCHED;
            PG8_LDA(At, 1, 1); PG8_STAGE(PG8_SB(1, 0), b3, voffB); PG8_STAGE(PG8_SB(1, 1), b3 + hstep, voffB); PG8_STAGE(PG8_SA(1, 0), a3, voffA);
            PG8_WAIT_V(8); PG8_WAIT_L(0); PG8_BAR; PG8_MMA(1, 0, At, B0); PG8_MMA(1, 1, At, B1); PG8_BAR; PG8_SCHED;
            } else {
            PG8_LDB(B0, 0, 0); PG8_SCHED; PG8_LDA(At, 0, 0); PG8_STAGE(PG8_SA(1, 1), a1 + hstep, voffA);
            PG8_WAIT_L(8); PG8_BAR; PG8_WAIT_L(0); PG8_MMA(0, 0, At, B0); PG8_BAR; PG8_SCHED;
            PG8_LDB(B1, 0, 1); PG8_STAGE(PG8_SB(0, 0), b2, voffB);
            PG8_BAR; PG8_WAIT_L(0); PG8_MMA(0, 1, At, B1); PG8_BAR;
            PG8_LDA(At, 0, 1); PG8_STAGE(PG8_SA(0, 0), a2, voffA);
            PG8_BAR; PG8_WAIT_L(0); PG8_MMA(1, 0, At, B0); PG8_BAR; PG8_SCHED;
            PG8_STAGE(PG8_SB(0, 1), b2 + hstep, voffB);
            PG8_WAIT_V(6); PG8_BAR; PG8_MMA(1, 1, At, B1); PG8_BAR;
            PG8_LDB(B0, 1, 0); PG8_SCHED; PG8_LDA(At, 1, 0); PG8_STAGE(PG8_SA(0, 1), a2 + hstep, voffA);
            PG8_WAIT_L(8); PG8_BAR; PG8_WAIT_L(0); PG8_MMA(0, 0, At, B0); PG8_BAR; PG8_SCHED;
            PG8_LDB(B1, 1, 1); PG8_STAGE(PG8_SB(1, 0), b3, voffB);
            PG8_BAR; PG8_WAIT_L(0); PG8_MMA(0, 1, At, B1); PG8_BAR;
            PG8_LDA(At, 1, 1); PG8_STAGE(PG8_SA(1, 0), a3, voffA);
            PG8_BAR; PG8_WAIT_L(0); PG8_MMA(1, 0, At, B0); PG8_BAR; PG8_SCHED;
            PG8_STAGE(PG8_SB(1, 1), b3 + hstep, voffB);
            PG8_WAIT_V(6); PG8_BAR; PG8_MMA(1, 1, At, B1); PG8_BAR;
            }
        }
        if constexpr (ALIGN_EPI) { if (wr == 0) PG8_BAR; }
        E(acc, cur, wr, wc, fr, fq); S.done(cur);
        if (!has_next) break;
#pragma unroll
        for (int a = 0; a < 2; ++a)
#pragma unroll
            for (int b = 0; b < 2; ++b)
#pragma unroll
                for (int m = 0; m < 4; ++m)
#pragma unroll
                    for (int n = 0; n < 2; ++n) acc[a][b][m][n] = (f32x4){0.f, 0.f, 0.f, 0.f};
        cur = nxt; cA = nA; cB = nB; ++ui;
        if constexpr (ALIGN_EPI) { if (wr == 1) PG8_BAR; }
    }
    PG8_WAIT_V(0);
    if constexpr (!ALIGN_EPI) { if (wr == 0) PG8_BAR; }
    PG8_BAR;
#undef PG8_SA
#undef PG8_SB
#undef PG8_STAGE
#undef PG8_LDA
#undef PG8_LDB
#undef PG8_MMA
#undef PG8_WAIT_V
#undef PG8_WAIT_L
#undef PG8_BAR
#undef PG8_SCHED
}

struct EpiBf16 {
    static constexpr bool PERM = true;
    u16* O; int ldc;
    __device__ __forceinline__ void operator()(const f32x4 (&acc)[2][2][4][2], const Unit& u, int wr, int wc, int fr, int fq) const {
        const int row0 = u.pm * BM + wr * 64 + fr; const int col0 = u.pn * BM + wc * 32 + 8 * fq;
#pragma unroll
        for (int ai = 0; ai < 2; ++ai)
#pragma unroll
            for (int m = 0; m < 4; ++m) { u16* rowp = O + (size_t)(row0 + ai * HALF + m * 16) * ldc + col0;
#pragma unroll
                for (int bj = 0; bj < 2; ++bj) { const f32x4 v0 = acc[ai][bj][m][0], v1 = acc[ai][bj][m][1];
                    u32x4 w; w.x = cvt_pk_bf16(v0[0], v0[1]); w.y = cvt_pk_bf16(v0[2], v0[3]); w.z = cvt_pk_bf16(v1[0], v1[1]); w.w = cvt_pk_bf16(v1[2], v1[3]);
                    *(u32x4*)(rowp + bj * HALF) = w; } }
    }
};
struct EpiResid {
    static constexpr bool PERM = false;
    const float* base; float* out; const float* gate;
    __device__ __forceinline__ void operator()(const f32x4 (&acc)[2][2][4][2], const Unit& u, int wr, int wc, int fr, int fq) const {
        const int row0 = u.pm * BM + wr * 64 + fr, col0 = u.pn * BM + wc * 32 + 4 * fq;
        const int b = (u.pm * BM) / SEQ;
        f32x4 gv[2][2];
#pragma unroll
        for (int bj = 0; bj < 2; ++bj)
#pragma unroll
            for (int n = 0; n < 2; ++n) gv[bj][n] = *(const f32x4*)(gate + (size_t)b * N_MOD + col0 + bj * HALF + n * 16);
#pragma unroll
        for (int ai = 0; ai < 2; ++ai)
#pragma unroll
            for (int m = 0; m < 4; ++m) { const size_t off = (size_t)(row0 + ai * HALF + m * 16) * D_MODEL + col0;
#pragma unroll
                for (int bj = 0; bj < 2; ++bj)
#pragma unroll
                    for (int n = 0; n < 2; ++n) { const f32x4 bs = *(const f32x4*)(base + off + bj * HALF + n * 16);
                        *(f32x4*)(out + off + bj * HALF + n * 16) = bs + gv[bj][n] * acc[ai][bj][m][n]; } }
    }
};
struct EpiInProj {
    static constexpr bool PERM = true;
    float* QF; u16* KB; u16* VT; u16* XR; u16* GG; float* KM; const float* gq; const float* gk;
    __device__ __forceinline__ void operator()(const f32x4 (&acc)[2][2][4][2], const Unit& u, int wr, int wc, int fr, int fq) const {
        const int type = u.pn >> 1, head = (u.pn & 1) * 4 + wc;
        const int b = (u.pm * BM) / SEQ, blk = u.pm % NBLK;
        const int tok0 = u.pm * BM + wr * 64 + fr;
        const int bh = b * NHEAD + head;
        if (type <= 1) {
            const float* gp = type == 0 ? gq : gk;
            f32x4 gv[2][2];
#pragma unroll
            for (int bj = 0; bj < 2; ++bj)
#pragma unroll
                for (int n = 0; n < 2; ++n) gv[bj][n] = *(const f32x4*)(gp + 32 * bj + 8 * fq + 4 * n);
            f32x4 cs[2][2];
#pragma unroll
            for (int bj = 0; bj < 2; ++bj)
#pragma unroll
                for (int n = 0; n < 2; ++n) cs[bj][n] = (f32x4){0.f, 0.f, 0.f, 0.f};
#pragma unroll
            for (int ai = 0; ai < 2; ++ai)
#pragma unroll
                for (int m = 0; m < 4; ++m) {
                    float ss = 0.f;
#pragma unroll
                    for (int bj = 0; bj < 2; ++bj)
#pragma unroll
                        for (int n = 0; n < 2; ++n) { const f32x4 x = acc[ai][bj][m][n]; ss += (x[0] * x[0] + x[1] * x[1]) + (x[2] * x[2] + x[3] * x[3]); }
                    ss += __shfl_xor(ss, 16); ss += __shfl_xor(ss, 32);
                    const float rstd = 1.0f / sqrtf(ss * (1.0f / 64.0f) + EPS);
                    const int tok = tok0 + ai * HALF + m * 16, s = tok % SEQ;
                    const size_t rowoff = ((size_t)bh * SEQ + s) * HD + 8 * fq;
#pragma unroll
                    for (int bj = 0; bj < 2; ++bj) {
                        const f32x4 v0 = acc[ai][bj][m][0] * rstd * gv[bj][0], v1 = acc[ai][bj][m][1] * rstd * gv[bj][1];
                        if (type == 0) { *(f32x4*)(QF + rowoff + 32 * bj) = v0; *(f32x4*)(QF + rowoff + 32 * bj + 4) = v1; }
                        else { u32x4 w; w.x = cvt_pk_bf16(v0[0], v0[1]); w.y = cvt_pk_bf16(v0[2], v0[3]); w.z = cvt_pk_bf16(v1[0], v1[1]); w.w = cvt_pk_bf16(v1[2], v1[3]);
                            const int kw = s & 255, c8 = 4 * bj + fq;
                            *(u32x4*)(KB + ((size_t)bh * NBLK + blk) * (BLK * HD) + ((((kw >> 5) * 4 + (c8 >> 1)) * 2 + (c8 & 1)) * 32 + (kw & 31)) * 8) = w; cs[bj][0] += v0; cs[bj][1] += v1; }
                    }
                }
            if (type == 1) {
#pragma unroll
                for (int bj = 0; bj < 2; ++bj)
#pragma unroll
                    for (int n = 0; n < 2; ++n)
#pragma unroll
                        for (int i = 0; i < 4; ++i) { float v = cs[bj][n][i]; v += __shfl_xor(v, 1); v += __shfl_xor(v, 2); v += __shfl_xor(v, 4); v += __shfl_xor(v, 8);
                            if (fr == 0) atomicAdd(KM + (((size_t)(b * NBLK + blk) * NHEAD + head) * HD + 32 * bj + 8 * fq + 4 * n + i), v); }
            }
        } else if (type == 2) {
            const int hip = (fr >> 2) & 1, ep = 4 * (fr >> 3) + (fr & 3);
#pragma unroll
            for (int ai = 0; ai < 2; ++ai)
#pragma unroll
                for (int m = 0; m < 4; ++m) { const int kw = ai * HALF + wr * 64 + m * 16 + fr;
#pragma unroll
                    for (int bj = 0; bj < 2; ++bj)
#pragma unroll
                        for (int n = 0; n < 2; ++n) { const f32x4 x = acc[ai][bj][m][n]; const unsigned w0 = cvt_pk_bf16(x[0], x[1]), w1 = cvt_pk_bf16(x[2], x[3]);
                            u16* dst = VT + ((size_t)bh * NBLK + blk) * (BLK * HD) + (((((kw >> 5) * 2 + ((kw >> 4) & 1)) * 2 + bj) * 2 + hip) * 32 + 8 * fq + 4 * n) * 8 + ep;
                            dst[0] = (u16)(w0 & 0xffffu); dst[8] = (u16)(w0 >> 16); dst[16] = (u16)(w1 & 0xffffu); dst[24] = (u16)(w1 >> 16); } }
        } else {
            u16* O = type == 3 ? XR : GG;
#pragma unroll
            for (int ai = 0; ai < 2; ++ai)
#pragma unroll
                for (int m = 0; m < 4; ++m) { const int tok = tok0 + ai * HALF + m * 16; u16* rowp = O + (size_t)tok * AW + head * HD + 8 * fq;
#pragma unroll
                    for (int bj = 0; bj < 2; ++bj) { f32x4 v0 = acc[ai][bj][m][0], v1 = acc[ai][bj][m][1];
                        if (type == 4) {
#pragma unroll
                            for (int i = 0; i < 4; ++i) { v0[i] = gelu_tanh(v0[i]); v1[i] = gelu_tanh(v1[i]); } }
                        u32x4 w; w.x = cvt_pk_bf16(v0[0], v0[1]); w.y = cvt_pk_bf16(v0[2], v0[3]); w.z = cvt_pk_bf16(v1[0], v1[1]); w.w = cvt_pk_bf16(v1[2], v1[3]);
                        *(u32x4*)(rowp + 32 * bj) = w; } }
        }
    }
};
}
#ifndef ATT_DUP
#define ATT_DUP 0
#endif

constexpr size_t MiB = 1u << 20;
constexpr size_t WS_CTL = 0;
constexpr size_t WS_KM = 1 * MiB;
constexpr size_t CTL_ZERO_BYTES = 2 * MiB;
constexpr size_t WS_MOD = 2 * MiB;
constexpr size_t WS_WIN = 3 * MiB;
constexpr size_t WS_WO = 8 * MiB;
constexpr size_t WS_WUP = 10 * MiB;
constexpr size_t WS_WDN = 21 * MiB;
constexpr size_t WS_WA = 27 * MiB;
constexpr size_t WS_WX = 27 * MiB + 65536;
constexpr size_t WS_AGG = 28 * MiB;
constexpr size_t WS_SSQL = 29 * MiB;
constexpr size_t WS_SSQA = 30 * MiB;
constexpr size_t WS_H = 32 * MiB;
constexpr size_t WS_QF = 96 * MiB;
constexpr size_t WS_KB = 160 * MiB;
constexpr size_t WS_VT = 192 * MiB;
constexpr size_t WS_XR = 224 * MiB;
constexpr size_t WS_GG = 256 * MiB;
constexpr size_t WS_ATT = 288 * MiB;
constexpr size_t WS_LRU = 320 * MiB;
constexpr size_t WS_MIX = 352 * MiB;
constexpr size_t WS_UPH = 96 * MiB;
constexpr size_t WS_ACT = 272 * MiB;
constexpr size_t WS_END = 448 * MiB;
constexpr int CW_BAR = 4096;

constexpr int RING_BYTES = 131072;
constexpr int MISC_OFF = 160 * 1024 - 256;
constexpr int CLDS_OFF = RING_BYTES + 4096;
constexpr int LDS_BYTES = 160 * 1024;
constexpr int NT = 512, NWAVES = 8;

#define XB_TMO      128
#define XB_XCNT(j)  (256  + 64 * (j))
#define XB_XSUB(j)  (1280 + 64 * (j))
#define XB_XGEN(j)  (2304 + 64 * (j))
#define XB_TOP      3328
#define XB_TOPGEN   3392
#define XCD_BAR_WORDS 3456
#define XB_SPIN_CAP (1u << 18)
__device__ __forceinline__ unsigned xb_ld(unsigned* p)              { return __hip_atomic_load(p, __ATOMIC_RELAXED, __HIP_MEMORY_SCOPE_AGENT); }
__device__ __forceinline__ unsigned xb_add(unsigned* p, unsigned v) { return __hip_atomic_fetch_add(p, v, __ATOMIC_RELAXED, __HIP_MEMORY_SCOPE_AGENT); }
__device__ __forceinline__ unsigned xb_xcc_id() { return (unsigned)__builtin_amdgcn_s_getreg((3 << 11) | 20) & 0xFu; }
#define XB_SPIN(cond, bar) do { unsigned _sp = 0; while (cond) { __builtin_amdgcn_s_sleep(1); \
    if ((++_sp & 255u) == 0u) { if (xb_ld(&(bar)[XB_TMO])) break; if (_sp > XB_SPIN_CAP) { atomicAdd(&(bar)[XB_TMO], 1u); break; } } } } while (0)
struct XcdBarrier { unsigned* bar; unsigned x; volatile LAS unsigned* st; };
__device__ __forceinline__ XcdBarrier xcd_barrier_post(unsigned* bar, volatile LAS unsigned* st) {
    XcdBarrier b; b.bar = bar; b.x = xb_xcc_id(); b.st = st;
    if (threadIdx.x == 0) (void)xb_add(&bar[XB_XCNT(b.x)], 1u);
    return b;
}
__device__ __forceinline__ void xcd_barrier_complete(unsigned* bar, unsigned x, unsigned& nloc, unsigned& nx) {
    const unsigned G = gridDim.x * gridDim.y * gridDim.z;
    unsigned sum, cnt, mine, sp = 0u;
    for (;;) {
        sum = 0u; cnt = 0u; mine = 0u;
#pragma unroll
        for (unsigned j = 0; j < 16; ++j) { const unsigned c = xb_ld(&bar[XB_XCNT(j)]); sum += c; cnt += (c > 0u) ? 1u : 0u; mine = (j == x) ? c : mine; }
        if (sum == G) break;
        __builtin_amdgcn_s_sleep(1);
        if ((++sp & 255u) == 0u) { if (xb_ld(&bar[XB_TMO])) break; if (sp > XB_SPIN_CAP) { atomicAdd(&bar[XB_TMO], 1u); break; } }
    }
    nloc = mine > 0u ? mine : 1u; nx = cnt > 0u ? cnt : 1u;
}
__device__ __forceinline__ void xcd_barrier(const XcdBarrier& b) {
    asm volatile("s_waitcnt vmcnt(0)" ::: "memory");
    __syncthreads();
    if (threadIdx.x == 0) {
        unsigned* bar = b.bar;
        __builtin_amdgcn_s_waitcnt(0);
        unsigned nloc = b.st[0], nx = b.st[1];
        if (nloc == 0u) { xcd_barrier_complete(bar, b.x, nloc, nx); b.st[0] = nloc; b.st[1] = nx; }
        const unsigned old = xb_add(&bar[XB_XSUB(b.x)], 1u);
        const unsigned gen = old / nloc;
        if (old + 1u == (gen + 1u) * nloc) {
            __builtin_amdgcn_fence(__ATOMIC_RELEASE, "agent");
            asm volatile("s_waitcnt vmcnt(0)" ::: "memory");
            const unsigned og = xb_add(&bar[XB_TOP], 1u);
            const unsigned tg = og / nx;
            if (og + 1u == (tg + 1u) * nx) xb_add(&bar[XB_TOPGEN], 1u);
            else XB_SPIN(xb_ld(&bar[XB_TOPGEN]) == tg, bar);
            __builtin_amdgcn_fence(__ATOMIC_ACQUIRE, "agent");
            xb_add(&bar[XB_XGEN(b.x)], 1u);
            asm volatile("s_waitcnt vmcnt(0)" ::: "memory");
        } else {
            XB_SPIN(xb_ld(&bar[XB_XGEN(b.x)]) == gen, bar);
            __builtin_amdgcn_fence(__ATOMIC_ACQUIRE, "agent");
            asm volatile("s_waitcnt vmcnt(0)" ::: "memory");
        }
    }
    __syncthreads();
}

struct Args { const float* in[23]; float* out; unsigned char* ws; int ph_lo, ph_hi; };
struct Frame {
    LAS unsigned char* lds;
    int tid, lane, wave, vcu, G;
    const Args* pa;
    __device__ __forceinline__ const float* x() const { return pa->in[0]; }
    __device__ __forceinline__ const float* c() const { return pa->in[1]; }
    __device__ __forceinline__ const float* w_ada() const { return pa->in[2]; }
    __device__ __forceinline__ const float* b_ada() const { return pa->in[3]; }
    __device__ __forceinline__ const float* norm1_g() const { return pa->in[4]; }
    __device__ __forceinline__ const float* w_in() const { return pa->in[5]; }
    __device__ __forceinline__ const float* q_norm_g() const { return pa->in[6]; }
    __device__ __forceinline__ const float* k_norm_g() const { return pa->in[7]; }
    __device__ __forceinline__ const float* lru_conv_w() const { return pa->in[8]; }
    __device__ __forceinline__ const float* lru_conv_b() const { return pa->in[9]; }
    __device__ __forceinline__ const float* lru_wa() const { return pa->in[10]; }
    __device__ __forceinline__ const float* lru_ba() const { return pa->in[11]; }
    __device__ __forceinline__ const float* lru_wx() const { return pa->in[12]; }
    __device__ __forceinline__ const float* lru_bx() const { return pa->in[13]; }
    __device__ __forceinline__ const float* lru_lambda() const { return pa->in[14]; }
    __device__ __forceinline__ const float* lru_out_g() const { return pa->in[15]; }
    __device__ __forceinline__ const float* attn_out_g() const { return pa->in[16]; }
    __device__ __forceinline__ const float* w_out() const { return pa->in[17]; }
    __device__ __forceinline__ const float* norm2_g() const { return pa->in[18]; }
    __device__ __forceinline__ const float* w_up() const { return pa->in[19]; }
    __device__ __forceinline__ const float* ffn_conv_w() const { return pa->in[20]; }
    __device__ __forceinline__ const float* ffn_conv_b() const { return pa->in[21]; }
    __device__ __forceinline__ const float* w_down() const { return pa->in[22]; }
    float* out; unsigned char* ws;
};
#define LDS_WAIT() asm volatile("s_waitcnt lgkmcnt(0)" ::: "memory")

template <int MODE>
__device__ __forceinline__ void p0_transpose_item(const float* W, int K, int N, u16* WT, LAS float* scr, int item, int lane) {
    const int nblk = N / 32, kb = item / nblk, nb = item % nblk, k0 = 64 * kb, n0 = 32 * nb;
#pragma unroll 8
    for (int i = 0; i < 32; ++i) { const int kk = 2 * i + (lane >> 5); scr[kk * 33 + (lane & 31)] = W[(size_t)(k0 + kk) * N + n0 + (lane & 31)]; }
    LDS_WAIT(); asm volatile("" ::: "memory");
    const int c = lane & 7;
#pragma unroll
    for (int j = 0; j < 4; ++j) { const int n = (lane >> 3) + 8 * j; const LAS float* s = scr + (8 * c) * 33 + n;
        u32x4 o;
        if (MODE == 1) { o.x = cvt_pk_f16(s[0 * 33], s[1 * 33]); o.y = cvt_pk_f16(s[2 * 33], s[3 * 33]); o.z = cvt_pk_f16(s[4 * 33], s[5 * 33]); o.w = cvt_pk_f16(s[6 * 33], s[7 * 33]); }
        else { o.x = cvt_pk_bf16(s[0 * 33], s[1 * 33]); o.y = cvt_pk_bf16(s[2 * 33], s[3 * 33]); o.z = cvt_pk_bf16(s[4 * 33], s[5 * 33]); o.w = cvt_pk_bf16(s[6 * 33], s[7 * 33]); }
        int nn = n0 + n;
        if (MODE == 1) nn = (nn & ~255) + 128 * ((nn >> 5) & 1) + 32 * ((nn >> 6) & 3) + (nn & 31);
        *(GAS u32x4*)(WT + (size_t)nn * K + k0 + 8 * c) = o; }
    LDS_WAIT(); asm volatile("" ::: "memory");
}
__device__ __forceinline__ void p0_prologue(Frame& F) {
    unsigned char* wsp = F.ws; asm volatile("" : "+s"(wsp));
    LAS float* cl = (LAS float*)(F.lds + CLDS_OFF);
    for (int i = F.tid; i < BATCH * D_MODEL; i += NT) cl[i] = F.c()[i];
    __syncthreads();
    LAS float* scr = (LAS float*)(F.lds + F.wave * 16384);
    const int gw = F.vcu * NWAVES + F.wave, NGW = F.G * NWAVES;
    constexpr int I_MOD = N_MOD / 64;
    constexpr int I_IN = (D_MODEL / 64) * (N_IN / 32), I_O = (D_MODEL / 64) * (D_MODEL / 32), I_UP = (D_MODEL / 64) * (N_UP / 32), I_DN = (D_FF / 64) * (D_MODEL / 32), I_L = 8 * 2;
    constexpr int NITEMS = I_MOD + I_IN + I_O + I_UP + I_DN + 2 * I_L;
    u16* WinT = (u16*)(wsp + WS_WIN); u16* WoT = (u16*)(wsp + WS_WO); u16* WupT = (u16*)(wsp + WS_WUP); u16* WdT = (u16*)(wsp + WS_WDN);
    u16* WaT = (u16*)(wsp + WS_WA); u16* WxT = (u16*)(wsp + WS_WX);
    float* MOD = (float*)(wsp + WS_MOD);
    for (int it = gw; it < NITEMS; it += NGW) {
        int r = it;
        if (r < I_MOD) {
            const int col = r * 64 + F.lane; float a0 = 0.f, a1 = 0.f, a2 = 0.f, a3 = 0.f;
            const float* wp = F.w_ada() + col;
#pragma unroll 8
            for (int k = 0; k < D_MODEL; ++k) { const float w = wp[(size_t)k * N_MOD];
                a0 += cl[k] * w; a1 += cl[D_MODEL + k] * w; a2 += cl[2 * D_MODEL + k] * w; a3 += cl[3 * D_MODEL + k] * w; }
            const float bb = F.b_ada()[col];
            MOD[col] = a0 + bb; MOD[N_MOD + col] = a1 + bb; MOD[2 * N_MOD + col] = a2 + bb; MOD[3 * N_MOD + col] = a3 + bb;
            continue; }
        r -= I_MOD;
        if (r < I_IN) { p0_transpose_item<1>(F.w_in(), D_MODEL, N_IN, WinT, scr, r, F.lane); continue; } r -= I_IN;
        if (r < I_O) { p0_transpose_item<0>(F.w_out(), D_MODEL, D_MODEL, WoT, scr, r, F.lane); continue; } r -= I_O;
        if (r < I_UP) { p0_transpose_item<0>(F.w_up(), D_MODEL, N_UP, WupT, scr, r, F.lane); continue; } r -= I_UP;
        if (r < I_DN) { p0_transpose_item<0>(F.w_down(), D_FF, D_MODEL, WdT, scr, r, F.lane); continue; } r -= I_DN;
        if (r < I_L) { const int h = r >> 1; p0_transpose_item<0>(F.lru_wa() + h * 4096, 64, 64, WaT + h * 4096, scr, r & 1, F.lane); continue; } r -= I_L;
        { const int h = r >> 1; p0_transpose_item<0>(F.lru_wx() + h * 4096, 64, 64, WxT + h * 4096, scr, r & 1, F.lane); }
    }
}

template <bool F16>
__device__ __forceinline__ void rownorm_phase(Frame& F, const float* X, const float* g, const float* sh, const float* sc, u16* O) {
    const int gw = F.vcu * NWAVES + F.wave, NGW = F.G * NWAVES;
    for (int m = gw; m < M_TOK; m += NGW) {
        const int b = m / SEQ;
        const GAS f32x4* xr = (const GAS f32x4*)(X + (size_t)m * D_MODEL) + F.lane;
        f32x4 v[4]; float s = 0.f;
#pragma unroll
        for (int j = 0; j < 4; ++j) { v[j] = xr[64 * j]; s += (v[j].x * v[j].x + v[j].y * v[j].y) + (v[j].z * v[j].z + v[j].w * v[j].w); }
        const float rstd = 1.0f / sqrtf(wave_sum(s) * (1.0f / D_MODEL) + EPS);
        GAS u32x2* o8 = (GAS u32x2*)(O + (size_t)m * D_MODEL) + F.lane;
#pragma unroll
        for (int j = 0; j < 4; ++j) {
            const int col = 4 * F.lane + 256 * j;
            const f32x4 gv = *(const f32x4*)(g + col), shv = *(const f32x4*)(sh + (size_t)b * N_MOD + col), scv = *(const f32x4*)(sc + (size_t)b * N_MOD + col);
            const f32x4 y = (v[j] * rstd) * gv * (scv + 1.0f) + shv;
            u32x2 w;
            if (F16) { w.x = cvt_pk_f16(y.x, y.y); w.y = cvt_pk_f16(y.z, y.w); } else { w.x = cvt_pk_bf16(y.x, y.y); w.y = cvt_pk_bf16(y.z, y.w); }
            o8[64 * j] = w; }
    }
}

__device__ __forceinline__ int crow(int r, int hi) { return (r & 3) + 8 * (r >> 2) + 4 * hi; }
constexpr int AL_QS = 0, AL_SLOT = 32768, AL_LSL = 131072, AL_LIST = 134144, AL_CNT = 150528, AL_MISC = 150656, AL_KMS = 150912;
__device__ __forceinline__ void attn_tile(const u16* Kp, const u16* Vp, const s16x8 (&qf)[4], int nkt, bool own, int tt, int qidx, int hi, float c1, float c2, f32x16& o0, f32x16& o1, float& lsum) {
#pragma unroll
    for (int r = 0; r < 16; ++r) { o0[r] = 0.f; o1[r] = 0.f; }
    lsum = 0.f;
    s16x8 kc[4], kn[4], vc[4];
#pragma unroll
    for (int s = 0; s < 4; ++s) { kc[s] = *(const GAS s16x8*)(Kp + s * 512); kn[s] = kc[s]; }
#pragma unroll 1
    for (int kt = 0; kt < nkt; ++kt) {
#pragma unroll
        for (int s = 0; s < 4; ++s) vc[s] = *(const GAS s16x8*)(Vp + (kt * 4 + s) * 512);
        if (kt + 1 < nkt) {
#pragma unroll
            for (int s = 0; s < 4; ++s) kn[s] = *(const GAS s16x8*)(Kp + ((kt + 1) * 4 + s) * 512);
        }
        f32x16 p;
#pragma unroll
        for (int r = 0; r < 16; ++r) p[r] = 0.f;
#pragma unroll
        for (int s = 0; s < 4; ++s) p = __builtin_amdgcn_mfma_f32_32x32x16_bf16(__builtin_bit_cast(bf16x8_t, kc[s]), __builtin_bit_cast(bf16x8_t, qf[s]), p, 0, 0, 0);
        const bool diag = own && (kt == tt);
#pragma unroll
        for (int r = 0; r < 16; ++r) { float e = __builtin_amdgcn_exp2f(p[r] * c1 - c2);
            if (diag && (32 * kt + crow(r, hi) > qidx)) e = 0.f;
            p[r] = e; lsum += e; }
#pragma unroll
        for (int s2 = 0; s2 < 2; ++s2) {
            u32x4 pw; pw.x = cvt_pk_bf16(p[8 * s2 + 0], p[8 * s2 + 1]); pw.y = cvt_pk_bf16(p[8 * s2 + 2], p[8 * s2 + 3]); pw.z = cvt_pk_bf16(p[8 * s2 + 4], p[8 * s2 + 5]); pw.w = cvt_pk_bf16(p[8 * s2 + 6], p[8 * s2 + 7]);
            const bf16x8_t pa = __builtin_bit_cast(bf16x8_t, pw);
            o0 = __builtin_amdgcn_mfma_f32_32x32x16_bf16(pa, __builtin_bit_cast(bf16x8_t, vc[2 * s2]), o0, 0, 0, 0);
            o1 = __builtin_amdgcn_mfma_f32_32x32x16_bf16(pa, __builtin_bit_cast(bf16x8_t, vc[2 * s2 + 1]), o1, 0, 0, 0);
        }
#pragma unroll
        for (int s = 0; s < 4; ++s) kc[s] = kn[s];
    }
}
__device__ __forceinline__ void attn_item(Frame& F, int bh, int i, float c1, float c2) {
    unsigned char* wsp = F.ws; asm volatile("" : "+s"(wsp));
    const float* QF = (const float*)(wsp + WS_QF); const u16* KB = (const u16*)(wsp + WS_KB); const u16* VT = (const u16*)(wsp + WS_VT);
    const float* KM = (const float*)(wsp + WS_KM); u16* ATT = (u16*)(wsp + WS_ATT); float* SSQA = (float*)(wsp + WS_SSQA);
    LAS u16* QS = (LAS u16*)(F.lds + AL_QS); LAS u16* SLOT = (LAS u16*)(F.lds + AL_SLOT); LAS float* LSL = (LAS float*)(F.lds + AL_LSL);
    LAS float* KMS = (LAS float*)(F.lds + AL_KMS); LAS u16* LIST = (LAS u16*)(F.lds + AL_LIST); LAS int* CNT = (LAS int*)(F.lds + AL_CNT);
    const int tid = F.tid, lane = F.lane, wave = F.wave, hi = lane >> 5, l31 = lane & 31;
    const int b = bh / NHEAD, h = bh % NHEAD;
    for (int u = tid; u < (3 * 32768 + 3072) / 16; u += NT) *(LAS u32x4*)(F.lds + AL_SLOT + u * 16) = (u32x4){0u, 0u, 0u, 0u};
    if (tid < 32) CNT[tid] = 0;
    for (int u = tid; u < NBLK * HD; u += NT) { const int n = u >> 6, d = u & 63; KMS[u] = KM[(((size_t)(b * NBLK + n)) * NHEAD + h) * HD + d] * (1.0f / 256.0f); }
    __syncthreads();
    {
        const int q = tid >> 1, half = tid & 1;
        const GAS f32x4* qrow = (const GAS f32x4*)(QF + ((size_t)bh * SEQ + (size_t)i * BLK + q) * HD);
        f32x4 qv[16];
#pragma unroll
        for (int d = 0; d < 16; ++d) qv[d] = qrow[d];
#pragma unroll
        for (int d = 0; d < 4; ++d) { const f32x4 a = qv[2 * d], c = qv[2 * d + 1], a2 = qv[8 + 2 * d], c2 = qv[8 + 2 * d + 1];
            u32x4 w, w2; w.x = cvt_pk_bf16(a.x, a.y); w.y = cvt_pk_bf16(a.z, a.w); w.z = cvt_pk_bf16(c.x, c.y); w.w = cvt_pk_bf16(c.z, c.w);
            w2.x = cvt_pk_bf16(a2.x, a2.y); w2.y = cvt_pk_bf16(a2.z, a2.w); w2.z = cvt_pk_bf16(c2.x, c2.y); w2.w = cvt_pk_bf16(c2.z, c2.w);
            if (half) w = w2;
            *(LAS u32x4*)(QS + q * 64 + 32 * half + 8 * d) = w; }
        float v0 = -INFINITY, v1 = -INFINITY, v2 = -INFINITY; int i0 = -1, i1 = -1, i2 = -1;
        for (int nn = 0; nn < 16; ++nn) {
            const int n = 16 * half + nn;
            const LAS f32x4* kr = (const LAS f32x4*)(KMS + n * 64);
            float g = 0.f;
#pragma unroll
            for (int d = 0; d < 16; ++d) { const f32x4 kv = kr[d]; g = fmaf(qv[d].x, kv.x, g); g = fmaf(qv[d].y, kv.y, g); g = fmaf(qv[d].z, kv.z, g); g = fmaf(qv[d].w, kv.w, g); }
            if (n >= i) g = -INFINITY;
            if (g > v0) { v2 = v1; i2 = i1; v1 = v0; i1 = i0; v0 = g; i0 = n; }
            else if (g > v1) { v2 = v1; i2 = i1; v1 = g; i1 = n; }
            else if (g > v2) { v2 = g; i2 = n; }
        }
        const float pv0 = __shfl_xor(v0, 1), pv1 = __shfl_xor(v1, 1), pv2 = __shfl_xor(v2, 1);
        const int pi0 = __shfl_xor(i0, 1), pi1 = __shfl_xor(i1, 1), pi2 = __shfl_xor(i2, 1);
        if (half == 0) {
            float av[3] = {v0, v1, v2}, bv[3] = {pv0, pv1, pv2}; int ai[3] = {i0, i1, i2}, bi[3] = {pi0, pi1, pi2};
            int sel[3]; int pa = 0, pb = 0;
#pragma unroll
            for (int k = 0; k < 3; ++k) {
                const float ca = pa == 0 ? av[0] : (pa == 1 ? av[1] : av[2]); const int cai = pa == 0 ? ai[0] : (pa == 1 ? ai[1] : ai[2]);
                const float cb = pb == 0 ? bv[0] : (pb == 1 ? bv[1] : bv[2]); const int cbi = pb == 0 ? bi[0] : (pb == 1 ? bi[1] : bi[2]);
                if (ca >= cb) { sel[k] = cai; ++pa; } else { sel[k] = cbi; ++pb; }
            }
#pragma unroll
            for (int k = 0; k < 3; ++k) if (sel[k] >= 0) { const int pos = __hip_atomic_fetch_add(&CNT[sel[k]], 1, __ATOMIC_RELAXED, __HIP_MEMORY_SCOPE_WORKGROUP); LIST[sel[k] * 256 + pos] = (u16)(q | (k << 8)); }
        }
    }
    __syncthreads();
    {
        int base = 0;
        for (int j = 0; j < i; ++j) {
            const int cntj = __builtin_amdgcn_readfirstlane(CNT[j]);
            const int ntj = (cntj + 31) >> 5;
            for (int t = base + ((wave - base) & 7); t < base + ntj; t += 8) {
                const int tt = t - base;
                const int ridx = 32 * tt + l31; const bool valid = ridx < cntj;
                const int ent = valid ? (int)LIST[j * 256 + ridx] : 0;
                const int qidx = ent & 255;
                s16x8 qf[4];
#pragma unroll
                for (int s = 0; s < 4; ++s) qf[s] = *(const LAS s16x8*)(QS + qidx * 64 + 16 * s + 8 * hi);
                const size_t boff = ((size_t)bh * NBLK + j) * (BLK * HD) + lane * 8;
                f32x16 o0, o1; float lsum;
                attn_tile(KB + boff, VT + boff, qf, 8, false, 0, qidx, hi, c1, c2, o0, o1, lsum);
                const int srow = valid ? ((ent >> 8) * 256 + qidx) : -1;
                lsum += __shfl_xor(lsum, 32);
                if (valid && hi == 0) LSL[srow] = lsum;
#pragma unroll
                for (int r = 0; r < 16; ++r) { const int sr = __shfl(srow, crow(r, hi));
                    if (sr >= 0) { const unsigned w = cvt_pk_bf16(o0[r], o1[r]); SLOT[sr * 64 + l31] = (u16)(w & 0xffffu); SLOT[sr * 64 + 32 + l31] = (u16)(w >> 16); }
                    if ((r & 3) == 3) asm volatile("" ::: "memory"); }
            }
            base += ntj;
        }
    }
    f32x16 oo0, oo1; float lown;
    {
        s16x8 qf[4];
#pragma unroll
        for (int s = 0; s < 4; ++s) qf[s] = *(const LAS s16x8*)(QS + (32 * wave + l31) * 64 + 16 * s + 8 * hi);
        const size_t boff = ((size_t)bh * NBLK + i) * (BLK * HD) + lane * 8;
        attn_tile(KB + boff, VT + boff, qf, wave + 1, true, wave, 32 * wave + l31, hi, c1, c2, oo0, oo1, lown);
    }
    __syncthreads();
    {
        const int q = 32 * wave + l31;
        float lt = lown + __shfl_xor(lown, 32);
        lt += LSL[q] + LSL[256 + q] + LSL[512 + q];
        const float inv = 1.0f / lt;
#pragma unroll
        for (int r = 0; r < 16; ++r) { const int rl = crow(r, hi), qq = 32 * wave + rl; const float iv = __shfl(inv, rl);
            float a = oo0[r], c = oo1[r];
#pragma unroll
            for (int k = 0; k < 3; ++k) { a += __builtin_bit_cast(float, (unsigned)SLOT[(k * 256 + qq) * 64 + l31] << 16); c += __builtin_bit_cast(float, (unsigned)SLOT[(k * 256 + qq) * 64 + 32 + l31] << 16); }
            const unsigned w = cvt_pk_bf16(a * iv, c * iv);
            QS[qq * 64 + l31] = (u16)(w & 0xffffu); QS[qq * 64 + 32 + l31] = (u16)(w >> 16);
            if ((r & 3) == 3) asm volatile("" ::: "memory"); }
        LDS_WAIT(); asm volatile("" ::: "memory");
#pragma unroll
        for (int it = 0; it < 4; ++it) { const int c = lane + 64 * it, row = c >> 3, ch = c & 7;
            const u32x4 w = *(const LAS u32x4*)(QS + (32 * wave + row) * 64 + 8 * ch);
            const size_t tok = (size_t)b * SEQ + (size_t)i * BLK + 32 * wave + row;
            *(GAS u32x4*)(ATT + tok * AW + h * HD + 8 * ch) = w;
            float ss = bf_lo(w.x) * bf_lo(w.x) + bf_hi(w.x) * bf_hi(w.x) + bf_lo(w.y) * bf_lo(w.y) + bf_hi(w.y) * bf_hi(w.y) + bf_lo(w.z) * bf_lo(w.z) + bf_hi(w.z) * bf_hi(w.z) + bf_lo(w.w) * bf_lo(w.w) + bf_hi(w.w) * bf_hi(w.w);
            ss += __shfl_xor(ss, 1); ss += __shfl_xor(ss, 2); ss += __shfl_xor(ss, 4);
            if (ch == 0) SSQA[tok * NHEAD + h] = ss; }
    }
    __syncthreads();
}
__device__ __forceinline__ void attn_phase(Frame& F) {
    LAS float* mm = (LAS float*)(F.lds + AL_MISC);
    if (F.tid < 64) { float a = fabsf(F.q_norm_g()[F.tid]), c = fabsf(F.k_norm_g()[F.tid]);
#pragma unroll
        for (int o = 1; o < 64; o <<= 1) { a = fmaxf(a, __shfl_xor(a, o)); c = fmaxf(c, __shfl_xor(c, o)); }
        if (F.tid == 0) { mm[0] = a; mm[1] = c; } }
    __syncthreads();
    const float C = 8.0f * mm[0] * mm[1];
    const float c1 = 0.125f * LOG2E, c2 = C * LOG2E;
    __syncthreads();
    if (F.G == 256) {
        const int xcd = F.vcu >> 5, k = F.vcu & 31;
#pragma unroll 1
        for (int r = 0; r < 4; ++r) attn_item(F, xcd * 4 + r, (r & 1) ? 31 - k : k, c1, c2);
    } else {
        for (int it = F.vcu; it < BATCH * NHEAD * NBLK; it += F.G) attn_item(F, it >> 5, it & 31, c1, c2);
    }
}

constexpr int LL_CW = 0;
template <bool FINAL>
__device__ __forceinline__ void lru_item(Frame& F, int b, int chunk) {
    unsigned char* wsp = F.ws; asm volatile("" : "+s"(wsp));
    const u16* XR = (const u16*)(wsp + WS_XR); const u16* GG = (const u16*)(wsp + WS_GG);
    const u16* WaT = (const u16*)(wsp + WS_WA); const u16* WxT = (const u16*)(wsp + WS_WX);
    float* AGG = (float*)(wsp + WS_AGG); u16* LRU = (u16*)(wsp + WS_LRU); float* SSQL = (float*)(wsp + WS_SSQL);
    const int lane = F.lane, hd = F.wave, hi = lane >> 5, j = lane & 31;
    LAS float* CW = (LAS float*)(F.lds + LL_CW + hd * 1280);
    for (int u = lane; u < 320; u += 64) CW[u] = (u < 256) ? F.lru_conv_w()[(u >> 6) * AW + hd * HD + (u & 63)] : F.lru_conv_b()[hd * HD + (u - 256)];
    LDS_WAIT(); asm volatile("" ::: "memory");
    float ba[2], bx[2], sp8[2], carry[2], arun[2];
#pragma unroll
    for (int ct = 0; ct < 2; ++ct) { const int c = hd * HD + 32 * ct + j; ba[ct] = F.lru_ba()[c]; bx[ct] = F.lru_bx()[c];
        sp8[ct] = 8.0f * log1pf(expf(-F.lru_lambda()[c])); carry[ct] = 0.f; arun[ct] = 1.f;
        if (FINAL) { float hcar = 0.f; for (int cc = 0; cc < chunk; ++cc) { const f32x2 ah = *(const f32x2*)(AGG + (((size_t)(b * 64 + cc)) * AW + c) * 2); hcar = ah.x * hcar + ah.y; } carry[ct] = hcar; } }
    for (int tile = 0; tile < 4; ++tile) {
        const int t0 = chunk * 128 + tile * 32;
        const int pos = t0 + j;
        s16x8 af[4], gf[4];
#pragma unroll
        for (int s = 0; s < 4; ++s) {
            const int ch0 = 16 * s + 8 * hi;
            float xc[8];
            { const LAS f32x4* bp = (const LAS f32x4*)(CW + 256 + ch0); const f32x4 b0 = bp[0], b1 = bp[1];
              xc[0] = b0.x; xc[1] = b0.y; xc[2] = b0.z; xc[3] = b0.w; xc[4] = b1.x; xc[5] = b1.y; xc[6] = b1.z; xc[7] = b1.w; }
            float accv[8];
#pragma unroll
            for (int e = 0; e < 8; ++e) accv[e] = 0.f;
#pragma unroll
            for (int jj = 0; jj < 4; ++jj) {
                const int p = pos - 3 + jj;
                u32x4 xw = (u32x4){0u, 0u, 0u, 0u};
                if (p >= 0) xw = *(const GAS u32x4*)(XR + ((size_t)b * SEQ + p) * AW + hd * HD + ch0);
                const LAS f32x4* wp = (const LAS f32x4*)(CW + jj * 64 + ch0); const f32x4 w0 = wp[0], w1 = wp[1];
                accv[0] += w0.x * bf_lo(xw.x); accv[1] += w0.y * bf_hi(xw.x); accv[2] += w0.z * bf_lo(xw.y); accv[3] += w0.w * bf_hi(xw.y);
                accv[4] += w1.x * bf_lo(xw.z); accv[5] += w1.y * bf_hi(xw.z); accv[6] += w1.z * bf_lo(xw.w); accv[7] += w1.w * bf_hi(xw.w);
            }
#pragma unroll
            for (int e = 0; e < 8; ++e) xc[e] += accv[e];
            u32x4 aw; aw.x = cvt_pk_bf16(xc[0], xc[1]); aw.y = cvt_pk_bf16(xc[2], xc[3]); aw.z = cvt_pk_bf16(xc[4], xc[5]); aw.w = cvt_pk_bf16(xc[6], xc[7]);
            af[s] = __builtin_bit_cast(s16x8, aw);
            if (FINAL) gf[s] = *(const GAS s16x8*)(GG + ((size_t)b * SEQ + pos) * AW + hd * HD + ch0);
        }
        float ssacc[16];
#pragma unroll
        for (int r = 0; r < 16; ++r) ssacc[r] = 0.f;
#pragma unroll
        for (int ct = 0; ct < 2; ++ct) {
            f32x16 aA, aX, aI, aG;
#pragma unroll
            for (int r = 0; r < 16; ++r) { aA[r] = 0.f; aX[r] = 0.f; aI[r] = 0.f; aG[r] = 0.f; }
#pragma unroll
            for (int s = 0; s < 4; ++s) {
                const size_t woff = ((size_t)hd * 64 + 32 * ct + j) * 64 + 16 * s + 8 * hi;
                const s16x8 wa = *(const GAS s16x8*)(WaT + woff), wx = *(const GAS s16x8*)(WxT + woff);
                s16x8 id;
#pragma unroll
                for (int e = 0; e < 8; ++e) id[e] = (16 * s + 8 * hi + e == 32 * ct + j) ? (short)0x3F80 : (short)0;
                const bf16x8_t a = __builtin_bit_cast(bf16x8_t, af[s]);
                aA = __builtin_amdgcn_mfma_f32_32x32x16_bf16(a, __builtin_bit_cast(bf16x8_t, wa), aA, 0, 0, 0);
                aX = __builtin_amdgcn_mfma_f32_32x32x16_bf16(a, __builtin_bit_cast(bf16x8_t, wx), aX, 0, 0, 0);
                aI = __builtin_amdgcn_mfma_f32_32x32x16_bf16(a, __builtin_bit_cast(bf16x8_t, id), aI, 0, 0, 0);
                if (FINAL) aG = __builtin_amdgcn_mfma_f32_32x32x16_bf16(__builtin_bit_cast(bf16x8_t, gf[s]), __builtin_bit_cast(bf16x8_t, id), aG, 0, 0, 0);
            }
            float av[16], uv[16];
#pragma unroll
            for (int r = 0; r < 16; ++r) {
                const float rr = sigmoidf_(aA[r] + ba[ct]), ii = sigmoidf_(aX[r] + bx[ct]);
                const float la = -rr * sp8[ct];
                const float a = __builtin_amdgcn_exp2f(la * LOG2E);
                const float x2 = 2.0f * la;
                const float om = (x2 > -0.05f) ? -x2 * (1.0f + x2 * 0.5f * (1.0f + x2 * (1.0f / 3.0f) * (1.0f + x2 * 0.25f))) : 1.0f - a * a;
                av[r] = a; uv[r] = sqrtf(om) * (ii * aI[r]);
            }
            float Ag[4], Ug[4];
#pragma unroll
            for (int g = 0; g < 4; ++g) { float A = av[4 * g], U = uv[4 * g];
#pragma unroll
                for (int e = 1; e < 4; ++e) { A *= av[4 * g + e]; U = av[4 * g + e] * U + uv[4 * g + e]; }
                Ag[g] = A; Ug[g] = U; }
            float h = carry[ct], ap = arun[ct];
            float hin[4];
#pragma unroll
            for (int g = 0; g < 4; ++g) {
                const float pA = __shfl_xor(Ag[g], 32), pU = __shfl_xor(Ug[g], 32);
                const float fA = hi ? pA : Ag[g], fU = hi ? pU : Ug[g], sA = hi ? Ag[g] : pA, sU = hi ? Ug[g] : pU;
                const float h1 = fA * h + fU;
                hin[g] = hi ? h1 : h;
                h = sA * h1 + sU; ap *= fA * sA;
            }
            carry[ct] = h; arun[ct] = ap;
            if (FINAL) {
#pragma unroll
                for (int g = 0; g < 4; ++g) { float hh = hin[g];
#pragma unroll
                    for (int e = 0; e < 4; ++e) { const int r = 4 * g + e; hh = av[r] * hh + uv[r]; const float o = hh * aG[r]; ssacc[r] += o * o;
                        const size_t tok = (size_t)b * SEQ + t0 + crow(r, hi);
                        LRU[tok * AW + hd * HD + 32 * ct + j] = (u16)(cvt_pk_bf16(o, 0.f) & 0xffffu); } }
            }
        }
        if (FINAL) {
#pragma unroll
            for (int r = 0; r < 16; ++r) {
                const size_t tok = (size_t)b * SEQ + t0 + crow(r, hi);
                float ss = ssacc[r];
                ss += __shfl_xor(ss, 1); ss += __shfl_xor(ss, 2); ss += __shfl_xor(ss, 4); ss += __shfl_xor(ss, 8); ss += __shfl_xor(ss, 16);
                if (j == 0) SSQL[tok * NHEAD + hd] = ss;
            }
        }
    }
    if (!FINAL) { if (hi == 0) {
#pragma unroll
        for (int ct = 0; ct < 2; ++ct) { const int c = hd * HD + 32 * ct + j; *(f32x2*)(AGG + (((size_t)(b * 64 + chunk)) * AW + c) * 2) = (f32x2){arun[ct], carry[ct]}; } } }
}
template <bool FINAL>
__device__ __forceinline__ void lru_phase(Frame& F) {
    for (int it = F.vcu; it < BATCH * 64; it += F.G) { lru_item<FINAL>(F, it >> 6, it & 63); }
}

__device__ __forceinline__ void mix_phase(Frame& F) {
    unsigned char* wsp = F.ws; asm volatile("" : "+s"(wsp));
    const u16* LRU = (const u16*)(wsp + WS_LRU); const u16* ATT = (const u16*)(wsp + WS_ATT);
    const float* SSQL = (const float*)(wsp + WS_SSQL); const float* SSQA = (const float*)(wsp + WS_SSQA); u16* MIX = (u16*)(wsp + WS_MIX);
    const int gw = F.vcu * NWAVES + F.wave, NGW = F.G * NWAVES, lane = F.lane;
    const f32x4 gl0 = *(const f32x4*)(F.lru_out_g() + 8 * lane), gl1 = *(const f32x4*)(F.lru_out_g() + 8 * lane + 4);
    const f32x4 ga0 = *(const f32x4*)(F.attn_out_g() + 8 * lane), ga1 = *(const f32x4*)(F.attn_out_g() + 8 * lane + 4);
    for (int m = gw; m < M_TOK; m += NGW) {
        const f32x4 s0 = *(const GAS f32x4*)(SSQL + (size_t)m * 8), s1 = *(const GAS f32x4*)(SSQL + (size_t)m * 8 + 4);
        const f32x4 t0 = *(const GAS f32x4*)(SSQA + (size_t)m * 8), t1 = *(const GAS f32x4*)(SSQA + (size_t)m * 8 + 4);
        const float ssl = ((s0.x + s0.y) + (s0.z + s0.w)) + ((s1.x + s1.y) + (s1.z + s1.w));
        const float ssa = ((t0.x + t0.y) + (t0.z + t0.w)) + ((t1.x + t1.y) + (t1.z + t1.w));
        const float rl = 1.0f / sqrtf(ssl * (1.0f / AW) + EPS), ra = 1.0f / sqrtf(ssa * (1.0f / AW) + EPS);
        const u32x4 lw = *(const GAS u32x4*)(LRU + (size_t)m * AW + 8 * lane), aw = *(const GAS u32x4*)(ATT + (size_t)m * AW + 8 * lane);
        u32x4 o;
        o.x = cvt_pk_bf16(bf_lo(lw.x) * rl * gl0.x, bf_hi(lw.x) * rl * gl0.y); o.y = cvt_pk_bf16(bf_lo(lw.y) * rl * gl0.z, bf_hi(lw.y) * rl * gl0.w);
        o.z = cvt_pk_bf16(bf_lo(lw.z) * rl * gl1.x, bf_hi(lw.z) * rl * gl1.y); o.w = cvt_pk_bf16(bf_lo(lw.w) * rl * gl1.z, bf_hi(lw.w) * rl * gl1.w);
        *(GAS u32x4*)(MIX + (size_t)m * D_MODEL + 8 * lane) = o;
        o.x = cvt_pk_bf16(bf_lo(aw.x) * ra * ga0.x, bf_hi(aw.x) * ra * ga0.y); o.y = cvt_pk_bf16(bf_lo(aw.y) * ra * ga0.z, bf_hi(aw.y) * ra * ga0.w);
        o.z = cvt_pk_bf16(bf_lo(aw.z) * ra * ga1.x, bf_hi(aw.z) * ra * ga1.y); o.w = cvt_pk_bf16(bf_lo(aw.w) * ra * ga1.z, bf_hi(aw.w) * ra * ga1.w);
        *(GAS u32x4*)(MIX + (size_t)m * D_MODEL + AW + 8 * lane) = o;
    }
}

__device__ __forceinline__ void act_phase(Frame& F, int half) {
    unsigned char* wsp = F.ws; asm volatile("" : "+s"(wsp));
    const u16* UP = (const u16*)(wsp + WS_UPH); u16* ACT = (u16*)(wsp + WS_ACT);
    constexpr int NF8 = D_FF / 8;
    const long total = (long)(M_TOK / 2) * NF8;
    for (long it = (long)F.vcu * NT + F.tid; it < total; it += (long)F.G * NT) {
        const int tl = (int)(it / NF8), f0 = (int)(it % NF8) * 8;
        const int tok = half * (M_TOK / 2) + tl, pos = tok % SEQ;
        float cg[8], cv[8];
        { const f32x4 a = *(const f32x4*)(F.ffn_conv_b() + f0), c = *(const f32x4*)(F.ffn_conv_b() + f0 + 4);
          cg[0] = a.x; cg[1] = a.y; cg[2] = a.z; cg[3] = a.w; cg[4] = c.x; cg[5] = c.y; cg[6] = c.z; cg[7] = c.w; }
        { const f32x4 a = *(const f32x4*)(F.ffn_conv_b() + D_FF + f0), c = *(const f32x4*)(F.ffn_conv_b() + D_FF + f0 + 4);
          cv[0] = a.x; cv[1] = a.y; cv[2] = a.z; cv[3] = a.w; cv[4] = c.x; cv[5] = c.y; cv[6] = c.z; cv[7] = c.w; }
        float sg[8], sv[8];
#pragma unroll
        for (int e = 0; e < 8; ++e) { sg[e] = 0.f; sv[e] = 0.f; }
#pragma unroll
        for (int jj = 0; jj < 3; ++jj) {
            const int p = pos - 2 + jj;
            if (p >= 0) {
                const u32x4 gw = *(const GAS u32x4*)(UP + (size_t)(tl - 2 + jj) * N_UP + f0), vw = *(const GAS u32x4*)(UP + (size_t)(tl - 2 + jj) * N_UP + D_FF + f0);
                const f32x4 wg0 = *(const f32x4*)(F.ffn_conv_w() + (size_t)jj * N_UP + f0), wg1 = *(const f32x4*)(F.ffn_conv_w() + (size_t)jj * N_UP + f0 + 4);
                const f32x4 wv0 = *(const f32x4*)(F.ffn_conv_w() + (size_t)jj * N_UP + D_FF + f0), wv1 = *(const f32x4*)(F.ffn_conv_w() + (size_t)jj * N_UP + D_FF + f0 + 4);
                sg[0] += wg0.x * bf_lo(gw.x); sg[1] += wg0.y * bf_hi(gw.x); sg[2] += wg0.z * bf_lo(gw.y); sg[3] += wg0.w * bf_hi(gw.y);
                sg[4] += wg1.x * bf_lo(gw.z); sg[5] += wg1.y * bf_hi(gw.z); sg[6] += wg1.z * bf_lo(gw.w); sg[7] += wg1.w * bf_hi(gw.w);
                sv[0] += wv0.x * bf_lo(vw.x); sv[1] += wv0.y * bf_hi(vw.x); sv[2] += wv0.z * bf_lo(vw.y); sv[3] += wv0.w * bf_hi(vw.y);
                sv[4] += wv1.x * bf_lo(vw.z); sv[5] += wv1.y * bf_hi(vw.z); sv[6] += wv1.z * bf_lo(vw.w); sv[7] += wv1.w * bf_hi(vw.w);
            }
        }
        float o[8];
#pragma unroll
        for (int e = 0; e < 8; ++e) { const float g = sg[e] + cg[e], v = sv[e] + cv[e]; o[e] = g * sigmoidf_(g) * v; }
        u32x4 w; w.x = cvt_pk_bf16(o[0], o[1]); w.y = cvt_pk_bf16(o[2], o[3]); w.z = cvt_pk_bf16(o[4], o[5]); w.w = cvt_pk_bf16(o[6], o[7]);
        *(GAS u32x4*)(ACT + (size_t)tok * D_FF + f0) = w;
    }
}

constexpr int N_PHASES = 13;
__global__ void __launch_bounds__(NT, 2) hymba_fwd(Args args) {
    extern __shared__ __attribute__((aligned(16))) unsigned char lds_raw[];
    Frame F;
    F.lds = (LAS unsigned char*)lds_raw;
    F.tid = threadIdx.x; F.lane = F.tid & 63; F.wave = __builtin_amdgcn_readfirstlane(F.tid >> 6);
    F.G = gridDim.x; { const int bx = blockIdx.x; F.vcu = (F.G % 8 == 0) ? (bx % 8) * (F.G / 8) + bx / 8 : bx; }
    F.pa = &args;
    F.out = args.out; F.ws = args.ws;
    volatile LAS unsigned* MISC = (volatile LAS unsigned*)(F.lds + MISC_OFF);
    if (F.tid < 32) MISC[F.tid] = 0u;
    __syncthreads();
    const int lo = args.ph_lo, hi = args.ph_hi;
    unsigned* ctl = (unsigned*)(F.ws + WS_CTL);
    XcdBarrier bar; bar.bar = ctl + CW_BAR; bar.x = 0; bar.st = nullptr;
    if (hi - lo > 1) bar = xcd_barrier_post(ctl + CW_BAR, MISC + 8);
#ifndef PHASE_MASK
#define PHASE_MASK 0x1FFF
#endif
#define IN(k) (((PHASE_MASK >> (k)) & 1) && lo <= (k) && (k) < hi)
#ifndef DUP_MASK
#define DUP_MASK 0
#endif
#define REP(k) _Pragma("unroll 1") for (int rep_ = 0; rep_ < 1 + ((DUP_MASK >> (k)) & 1); ++rep_)
#define SEAM(k) do { if (IN(k) && IN((k) + 1)) xcd_barrier(bar); } while (0)
#define MOD ((float*)(wsp + WS_MOD))
#define H ((u16*)(wsp + WS_H))

    if (IN(0)) { unsigned char* wsp = F.ws; asm volatile("" : "+s"(wsp)); { int t_ = threadIdx.x; asm volatile("" : "+v"(t_)); F.tid = t_; F.lane = t_ & 63; F.wave = __builtin_amdgcn_readfirstlane(t_ >> 6); } REP(0) p0_prologue(F); SEAM(0); }
    if (IN(1)) { unsigned char* wsp = F.ws; asm volatile("" : "+s"(wsp)); { int t_ = threadIdx.x; asm volatile("" : "+v"(t_)); F.tid = t_; F.lane = t_ & 63; F.wave = __builtin_amdgcn_readfirstlane(t_ >> 6); } REP(1) rownorm_phase<true>(F, F.x(), F.norm1_g(), MOD + 0, MOD + 1024, H); SEAM(1); }
    if (IN(2)) { unsigned char* wsp = F.ws; asm volatile("" : "+s"(wsp)); { int t_ = threadIdx.x; asm volatile("" : "+v"(t_)); F.tid = t_; F.lane = t_ & 63; F.wave = __builtin_amdgcn_readfirstlane(t_ >> 6); }
        pg8::Gemm g{H, (const u16*)(wsp + WS_WIN), M_TOK, N_IN, D_MODEL}; pg8::StaticOrder S; S.init(M_TOK, N_IN, F.G, (int)blockIdx.x);
        pg8::EpiInProj E{(float*)(wsp + WS_QF), (u16*)(wsp + WS_KB), (u16*)(wsp + WS_VT), (u16*)(wsp + WS_XR), (u16*)(wsp + WS_GG), (float*)(wsp + WS_KM), F.q_norm_g(), F.k_norm_g()};
        REP(2) pg8::gemm_phase<pg8::EpiInProj, pg8::StaticOrder, true, true, true>(F.lds, g, S, E);
        SEAM(2);
    }
    if (IN(3)) { unsigned char* wsp = F.ws; asm volatile("" : "+s"(wsp)); { int t_ = threadIdx.x; asm volatile("" : "+v"(t_)); F.tid = t_; F.lane = t_ & 63; F.wave = __builtin_amdgcn_readfirstlane(t_ >> 6); } REP(3) attn_phase(F); REP(13) lru_phase<false>(F); SEAM(3); }
    if (IN(4)) { unsigned char* wsp = F.ws; asm volatile("" : "+s"(wsp)); { int t_ = threadIdx.x; asm volatile("" : "+v"(t_)); F.tid = t_; F.lane = t_ & 63; F.wave = __builtin_amdgcn_readfirstlane(t_ >> 6); } REP(4) lru_phase<true>(F); SEAM(4); }
    if (IN(5)) { unsigned char* wsp = F.ws; asm volatile("" : "+s"(wsp)); { int t_ = threadIdx.x; asm volatile("" : "+v"(t_)); F.tid = t_; F.lane = t_ & 63; F.wave = __builtin_amdgcn_readfirstlane(t_ >> 6); } REP(5) mix_phase(F); SEAM(5); }
    if (IN(6)) { unsigned char* wsp = F.ws; asm volatile("" : "+s"(wsp)); { int t_ = threadIdx.x; asm volatile("" : "+v"(t_)); F.tid = t_; F.lane = t_ & 63; F.wave = __builtin_amdgcn_readfirstlane(t_ >> 6); }
        pg8::Gemm g{(const u16*)(wsp + WS_MIX), (const u16*)(wsp + WS_WO), M_TOK, D_MODEL, D_MODEL}; pg8::StaticOrder S; S.init(M_TOK, D_MODEL, F.G, (int)blockIdx.x);
        pg8::EpiResid E{F.x(), F.out, MOD + 2048};
        REP(6) pg8::gemm_phase<pg8::EpiResid, pg8::StaticOrder, true, true, false>(F.lds, g, S, E);
        SEAM(6);
    }
    if (IN(7)) { unsigned char* wsp = F.ws; asm volatile("" : "+s"(wsp)); { int t_ = threadIdx.x; asm volatile("" : "+v"(t_)); F.tid = t_; F.lane = t_ & 63; F.wave = __builtin_amdgcn_readfirstlane(t_ >> 6); } REP(7) rownorm_phase<false>(F, F.out, F.norm2_g(), MOD + 3072, MOD + 4096, H); SEAM(7); }
#pragma unroll 1
    for (int half = 0; half < 2; ++half) {
        if (IN(8 + 2 * half)) { unsigned char* wsp = F.ws; asm volatile("" : "+s"(wsp)); { int t_ = threadIdx.x; asm volatile("" : "+v"(t_)); F.tid = t_; F.lane = t_ & 63; F.wave = __builtin_amdgcn_readfirstlane(t_ >> 6); }
            pg8::Gemm g{H + (size_t)half * (M_TOK / 2) * D_MODEL, (const u16*)(wsp + WS_WUP), M_TOK / 2, N_UP, D_MODEL}; pg8::StaticOrder S; S.init(M_TOK / 2, N_UP, F.G, (int)blockIdx.x);
            pg8::EpiBf16 E{(u16*)(wsp + WS_UPH), N_UP};
            REP(8) pg8::gemm_phase<pg8::EpiBf16, pg8::StaticOrder, true, true, false>(F.lds, g, S, E);
            SEAM(8 + 2 * half);
        }
        if (IN(9 + 2 * half)) { unsigned char* wsp = F.ws; asm volatile("" : "+s"(wsp)); { int t_ = threadIdx.x; asm volatile("" : "+v"(t_)); F.tid = t_; F.lane = t_ & 63; F.wave = __builtin_amdgcn_readfirstlane(t_ >> 6); } REP(9) act_phase(F, half); SEAM(9 + 2 * half); }
    }
    if (IN(12)) { unsigned char* wsp = F.ws; asm volatile("" : "+s"(wsp)); { int t_ = threadIdx.x; asm volatile("" : "+v"(t_)); F.tid = t_; F.lane = t_ & 63; F.wave = __builtin_amdgcn_readfirstlane(t_ >> 6); }
        pg8::Gemm g{(const u16*)(wsp + WS_ACT), (const u16*)(wsp + WS_WDN), M_TOK, D_MODEL, D_FF}; pg8::StaticOrder S; S.init(M_TOK, D_MODEL, F.G, (int)blockIdx.x);
        pg8::EpiResid E{F.out, F.out, MOD + 5120};
        pg8::gemm_phase<pg8::EpiResid, pg8::StaticOrder, true, true, false>(F.lds, g, S, E);
    }
    if (hi - lo > 1 && hi == N_PHASES) {
        if (xb_ld(ctl + CW_BAR + XB_TMO) != 0u) { asm volatile("s_waitcnt vmcnt(0)" ::: "memory"); __syncthreads();
            for (size_t i = (size_t)blockIdx.x * NT + F.tid; i < (size_t)M_TOK * D_MODEL; i += (size_t)F.G * NT) F.out[i] = __builtin_nanf(""); }
    }
#undef IN
#undef MOD
#undef H
#undef SEAM
}

#ifndef MK_PER_PHASE
#define MK_PER_PHASE 0
#endif
extern "C" void kernel_launch(void* const* d_in, const int* in_sizes, int n_in, void* d_out, int out_size, void* d_ws, size_t ws_size, hipStream_t stream) {
    static int grid = 0;
    if (grid == 0) {
        if (n_in != 23 || in_sizes[0] != M_TOK * D_MODEL || out_size != M_TOK * D_MODEL || ws_size < WS_END) {
            fprintf(stderr, "kernel_launch: unexpected shapes (n_in %d, in0 %d, out %d, ws %zu); nothing launched\n", n_in, n_in > 0 ? in_sizes[0] : -1, out_size, ws_size); grid = -1; return; }
        int dev = 0, cus = 0;
        if (hipGetDevice(&dev) != hipSuccess || hipDeviceGetAttribute(&cus, hipDeviceAttributeMultiprocessorCount, dev) != hipSuccess) { grid = -1; return; }
        if (hipFuncSetAttribute((const void*)hymba_fwd, hipFuncAttributeMaxDynamicSharedMemorySize, LDS_BYTES) != hipSuccess) { fprintf(stderr, "kernel_launch: hipFuncSetAttribute failed\n"); grid = -1; return; }
        grid = cus;
    }
    if (grid < 0) return;
    (void)hipMemsetAsync((char*)d_ws + WS_CTL, 0, CTL_ZERO_BYTES, stream);
    Args a{};
    for (int i = 0; i < 23; ++i) a.in[i] = (const float*)d_in[i];
    a.out = (float*)d_out; a.ws = (unsigned char*)d_ws;
#if MK_PER_PHASE
    for (int p = 0; p < N_PHASES; ++p) { a.ph_lo = p; a.ph_hi = p + 1; hipLaunchKernelGGL(hymba_fwd, dim3(grid), dim3(NT), LDS_BYTES, stream, a); }
#else
    a.ph_lo = 0; a.ph_hi = N_PHASES; hipLaunchKernelGGL(hymba_fwd, dim3(grid), dim3(NT), LDS_BYTES, stream, a);
#endif
}
```

```cpp
#include <hip/hip_runtime.h>
#include <cstdio>
#include <cstdint>

#define GAS __attribute__((address_space(1)))
#define LAS __attribute__((address_space(3)))
typedef unsigned short u16;
typedef short s16x8 __attribute__((ext_vector_type(8)));
typedef _Float16 f16x8 __attribute__((ext_vector_type(8)));
typedef __bf16 bf16x8_t __attribute__((ext_vector_type(8)));
typedef float f32x2 __attribute__((ext_vector_type(2)));
typedef float f32x4 __attribute__((ext_vector_type(4)));
typedef float f32x16 __attribute__((ext_vector_type(16)));
typedef unsigned u32x4 __attribute__((ext_vector_type(4)));
typedef unsigned u32x2 __attribute__((ext_vector_type(2)));
typedef GAS unsigned gu32;
#define RLX_AGENT __ATOMIC_RELAXED, __HIP_MEMORY_SCOPE_AGENT

constexpr int D_MODEL = 1024, BATCH = 4, SEQ = 8192, M_TOK = BATCH * SEQ;
constexpr int N_IN = 2560, D_FF = 2816, N_UP = 2 * D_FF, N_MOD = 6 * D_MODEL;
constexpr int NHEAD = 8, HD = 64, AW = 512, NBLK = 32, BLK = 256;
constexpr float EPS = 1e-6f;
constexpr float LOG2E = 1.4426950408889634f;

__device__ __forceinline__ unsigned cvt_pk_bf16(float lo, float hi) { unsigned r; asm volatile("v_cvt_pk_bf16_f32 %0, %1, %2" : "=v"(r) : "v"(lo), "v"(hi)); return r; }
__device__ __forceinline__ unsigned cvt_pk_f16(float lo, float hi) {
    const _Float16 a = (_Float16)lo, b = (_Float16)hi;
    return (unsigned)__builtin_bit_cast(unsigned short, a) | ((unsigned)__builtin_bit_cast(unsigned short, b) << 16);
}
__device__ __forceinline__ float bf_lo(unsigned w) { return __builtin_bit_cast(float, w << 16); }
__device__ __forceinline__ float bf_hi(unsigned w) { return __builtin_bit_cast(float, w & 0xffff0000u); }
__device__ __forceinline__ float sigmoidf_(float v) { return __builtin_amdgcn_rcpf(1.0f + __builtin_amdgcn_exp2f(-v * LOG2E)); }
__device__ __forceinline__ float gelu_tanh(float v) { const float y = 0.7978845608028654f * (v + 0.044715f * v * v * v); return v * sigmoidf_(2.0f * y); }
__device__ __forceinline__ float wave_sum(float v) {
#pragma unroll
    for (int o = 1; o < 64; o <<= 1) v += __shfl_xor(v, o);
    return v;
}

namespace pg8 {
constexpr int BM = 256, BK = 64, HALF = 128, HTB = HALF * BK * 2, STAGE_BYTES = 8 * HTB, NXCD = 8, WGM = 8;
__host__ __device__ __forceinline__ int lds_byte(int r, int c) { const int st = (r >> 4) * 2 + (c >> 5), rr = r & 15, cc = c & 31, ob = rr * 64 + cc * 2; return st * 1024 + (ob ^ (((ob >> 9) & 1) << 5)); }
__host__ __device__ __forceinline__ void stage_rc(int b, int& R, int& C) { const int st = b / 1024, sb = b % 1024, swz = sb ^ (((sb >> 9) & 1) << 5); R = (st >> 1) * 16 + swz / 64; C = (st & 1) * 32 + (swz % 64) / 2; }
__host__ __device__ __forceinline__ int perm32(int rho) { const int n = rho >> 4, i = rho & 15; return 8 * (i >> 2) + 4 * n + (i & 3); }

struct Unit { int pm, pn; };
struct Gemm { const u16* A; const u16* Bt; int M, N, K; };

struct StaticOrder {
    int nM, nN, nwg, G, c;
    __host__ __device__ __forceinline__ void init(int M, int N, int G_, int c_) { nM = M / BM; nN = N / BM; nwg = nM * nN; G = G_; c = c_; }
    __host__ __device__ __forceinline__ bool next(int i, Unit& u) const {
        const long L = (long)i * G + c; if (L >= nwg) return false;
        int wgid = (int)L; { const int q = nwg / NXCD, r = nwg % NXCD, xcd = wgid % NXCD, off = wgid / NXCD; wgid = (xcd < r ? xcd * (q + 1) : r * (q + 1) + (xcd - r) * q) + off; }
        const int nig = WGM * nN, gid = wgid / nig, fm = gid * WGM, gsz = (nM - fm) < WGM ? (nM - fm) : WGM;
        u.pm = fm + ((wgid % nig) % gsz); u.pn = (wgid % nig) / gsz; return true;
    }
    __device__ __forceinline__ void a_ready(const Unit&) const {}
    __device__ __forceinline__ void done(const Unit&) const {}
};

template <bool F16> __device__ __forceinline__ f32x4 mfma16(s16x8 a, s16x8 b, f32x4 c) {
    if constexpr (F16) return __builtin_amdgcn_mfma_f32_16x16x32_f16(__builtin_bit_cast(f16x8, a), __builtin_bit_cast(f16x8, b), c, 0, 0, 0);
    else return __builtin_amdgcn_mfma_f32_16x16x32_bf16(__builtin_bit_cast(bf16x8_t, a), __builtin_bit_cast(bf16x8_t, b), c, 0, 0, 0);
}

template <class Epi, class Sched, bool ALIGN_EPI, bool SP2, bool F16>
__device__ __forceinline__ void gemm_phase(LAS unsigned char* lds, const Gemm g, const Sched& S, const Epi& E) {
    int tid_ = threadIdx.x; asm volatile("" : "+v"(tid_));
    const int tid = tid_, wid = __builtin_amdgcn_readfirstlane(tid >> 6), lane = tid & 63, wr = wid >> 2, wc = wid & 3, fr = lane & 15, fq = lane >> 4;
    const int K = g.K, nt = K / BK;
    unsigned voffA, voffB;
    { int R, C; stage_rc(tid * 16, R, C); const int Rb = Epi::PERM ? ((R & ~31) + perm32(R & 31)) : R;
        voffA = (unsigned)(R * K + C) * 2u; voffB = (unsigned)(Rb * K + C) * 2u; }
    const unsigned rstep64 = (unsigned)(64 * K * 2);
    const size_t kstep = (size_t)(BK * 2);
    const size_t hstep = (size_t)HALF * K * 2;
    const size_t tstep = 2 * hstep;
    const unsigned ldsw = (unsigned)wid * 1024u;
    const int aoff = lds_byte(wr * 64 + fr, fq * 8), boff = lds_byte(wc * 32 + fr, fq * 8);
#define PG8_SA(b, h) (((b) * 2 + (h)) * HTB)
#define PG8_SB(b, h) ((4 + (b) * 2 + (h)) * HTB)
#define PG8_STAGE(bufoff, gbase, voff) do { _Pragma("unroll") for (int _i = 0; _i < 2; ++_i) \
        __builtin_amdgcn_global_load_lds((const unsigned*)((const char*)(gbase) + _i * rstep64 + (voff)), (LAS unsigned*)(lds + (bufoff) + ldsw + _i * 8192), 16, 0, 0); } while (0)
#define PG8_LDA(dst, b, h) do { _Pragma("unroll") for (int m = 0; m < 4; ++m) _Pragma("unroll") for (int k = 0; k < 2; ++k) dst[m][k] = *(const LAS s16x8*)(lds + PG8_SA(b, h) + aoff + m * 2048 + k * 1024); } while (0)
#define PG8_LDB(dst, b, h) do { _Pragma("unroll") for (int n = 0; n < 2; ++n) _Pragma("unroll") for (int k = 0; k < 2; ++k) dst[n][k] = *(const LAS s16x8*)(lds + PG8_SB(b, h) + boff + n * 2048 + k * 1024); } while (0)
#define PG8_MMA(ai, bj, At, Bt) do { __builtin_amdgcn_s_setprio(1); _Pragma("unroll") for (int m = 0; m < 4; ++m) _Pragma("unroll") for (int n = 0; n < 2; ++n) _Pragma("unroll") for (int k = 0; k < 2; ++k) \
        acc[ai][bj][m][n] = mfma16<F16>(Bt[n][k], At[m][k], acc[ai][bj][m][n]); __builtin_amdgcn_s_setprio(0); } while (0)
#define PG8_WAIT_V(n) asm volatile("s_waitcnt vmcnt(" #n ")" ::: "memory")
#define PG8_WAIT_L(n) asm volatile("s_waitcnt lgkmcnt(" #n ")" ::: "memory")
#define PG8_BAR __builtin_amdgcn_s_barrier()
#define PG8_SCHED __builtin_amdgcn_sched_barrier(0)
    Unit cur, nxt; int ui = 0;
    if (!S.next(0, cur)) return;
    f32x4 acc[2][2][4][2];
#pragma unroll
    for (int a = 0; a < 2; ++a)
#pragma unroll
        for (int b = 0; b < 2; ++b)
#pragma unroll
            for (int m = 0; m < 4; ++m)
#pragma unroll
                for (int n = 0; n < 2; ++n) acc[a][b][m][n] = (f32x4){0.f, 0.f, 0.f, 0.f};
    s16x8 At[4][2], B0[2][2], B1[2][2];
    const char* cA = (const char*)g.A + (size_t)cur.pm * tstep; const char* cB = (const char*)g.Bt + (size_t)cur.pn * tstep;
    S.a_ready(cur);
    if constexpr (SP2) {
        PG8_STAGE(PG8_SB(0, 0), cB, voffB); PG8_STAGE(PG8_SB(0, 1), cB + hstep, voffB); PG8_STAGE(PG8_SA(0, 0), cA, voffA); PG8_STAGE(PG8_SA(0, 1), cA + hstep, voffA);
        if (wr == 1) PG8_BAR;
        PG8_WAIT_V(2); PG8_BAR;
        PG8_STAGE(PG8_SB(1, 0), cB + kstep, voffB); PG8_STAGE(PG8_SA(1, 0), cA + kstep, voffA); PG8_STAGE(PG8_SB(1, 1), cB + hstep + kstep, voffB);
        PG8_WAIT_V(6); PG8_BAR;
    } else {
        PG8_STAGE(PG8_SB(0, 0), cB, voffB); PG8_STAGE(PG8_SA(0, 0), cA, voffA); PG8_STAGE(PG8_SB(0, 1), cB + hstep, voffB); PG8_STAGE(PG8_SA(0, 1), cA + hstep, voffA);
        if (wr == 1) PG8_BAR;
        PG8_WAIT_V(4); PG8_BAR;
        PG8_STAGE(PG8_SB(1, 0), cB + kstep, voffB); PG8_STAGE(PG8_SA(1, 0), cA + kstep, voffA); PG8_STAGE(PG8_SB(1, 1), cB + hstep + kstep, voffB);
        PG8_WAIT_V(6); PG8_BAR;
    }
    for (;;) {
        const bool has_next = S.next(ui + 1, nxt);
        const char* nA = has_next ? (const char*)g.A + (size_t)nxt.pm * tstep : cA; const char* nB = has_next ? (const char*)g.Bt + (size_t)nxt.pn * tstep : cB;
        for (int t = 0; t < nt; t += 2) {
            const bool last = (t == nt - 2);
            const char* a1 = cA + (size_t)(t + 1) * kstep;
            const char* a2 = last ? nA : cA + (size_t)(t + 2) * kstep; const char* b2 = last ? nB : cB + (size_t)(t + 2) * kstep;
            const char* a3 = a2 + kstep; const char* b3 = b2 + kstep;
            if (last && has_next) S.a_ready(nxt);
            if constexpr (SP2) {
            PG8_LDB(B0, 0, 0); PG8_LDB(B1, 0, 1); PG8_SCHED; PG8_LDA(At, 0, 0); PG8_STAGE(PG8_SA(1, 1), a1 + hstep, voffA);
            PG8_WAIT_V(8); PG8_WAIT_L(0); PG8_BAR; PG8_MMA(0, 0, At, B0); PG8_MMA(0, 1, At, B1); PG8_BAR; PG8_SCHED;
            PG8_LDA(At, 0, 1); PG8_STAGE(PG8_SB(0, 0), b2, voffB); PG8_STAGE(PG8_SB(0, 1), b2 + hstep, voffB); PG8_STAGE(PG8_SA(0, 0), a2, voffA);
            PG8_WAIT_V(8); PG8_WAIT_L(0); PG8_BAR; PG8_MMA(1, 0, At, B0); PG8_MMA(1, 1, At, B1); PG8_BAR; PG8_SCHED;
            PG8_LDB(B0, 1, 0); PG8_LDB(B1, 1, 1); PG8_SCHED; PG8_LDA(At, 1, 0); PG8_STAGE(PG8_SA(0, 1), a2 + hstep, voffA);
            PG8_WAIT_V(8); PG8_WAIT_L(0); PG8_BAR; PG8_MMA(0, 0, At, B0); PG8_MMA(0, 1, At, B1); PG8_BAR; PG8_SCHED;
            PG8_LDA(At, 1, 1); PG8_STAGE(PG8_SB(1, 0), b3, voffB); PG8_STAGE(PG8_SB(1, 1), b3 + hstep, voffB); PG8_STAGE(PG8_SA(1, 0), a3, voffA);
            PG8_WAIT_V(8); PG8_WAIT_L(0); PG8_BAR; PG8_MMA(1, 0, At, B0); PG8_MMA(1, 1, At, B1); PG8_BAR; PG8_SCHED;
            } else {
            PG8_LDB(B0, 0, 0); PG8_SCHED; PG8_LDA(At, 0, 0); PG8_STAGE(PG8_SA(1, 1), a1 + hstep, voffA);
            PG8_WAIT_L(8); PG8_BAR; PG8_WAIT_L(0); PG8_MMA(0, 0, At, B0); PG8_BAR; PG8_SCHED;
            PG8_LDB(B1, 0, 1); PG8_STAGE(PG8_SB(0, 0), b2, voffB);
            PG8_BAR; PG8_WAIT_L(0); PG8_MMA(0, 1, At, B1); PG8_BAR;
            PG8_LDA(At, 0, 1); PG8_STAGE(PG8_SA(0, 0), a2, voffA);
            PG8_BAR; PG8_WAIT_L(0); PG8_MMA(1, 0, At, B0); PG8_BAR; PG8_SCHED;
            PG8_STAGE(PG8_SB(0, 1), b2 + hstep, voffB);
            PG8_WAIT_V(6); PG8_BAR; PG8_MMA(1, 1, At, B1); PG8_BAR;
            PG8_LDB(B0, 1, 0); PG8_SCHED; PG8_LDA(At, 1, 0); PG8_STAGE(PG8_SA(0, 1), a2 + hstep, voffA);
            PG8_WAIT_L(8); PG8_BAR; PG8_WAIT_L(0); PG8_MMA(0, 0, At, B0); PG8_BAR; PG8_SCHED;
            PG8_LDB(B1, 1, 1); PG8_STAGE(PG8_SB(1, 0), b3, voffB);
            PG8_BAR; PG8_WAIT_L(0); PG8_MMA(0, 1, At, B1); PG8_BAR;
            PG8_LDA(At, 1, 1); PG8_STAGE(PG8_SA(1, 0), a3, voffA);
            PG8_BAR; PG8_WAIT_L(0); PG8_MMA(1, 0, At, B0); PG8_BAR; PG8_SCHED;
            PG8_STAGE(PG8_SB(1, 1), b3 + hstep, voffB);
            PG8_WAIT_V(6); PG8_BAR; PG8_MMA(1, 1, At, B1); PG8_BAR;
            }
        }
        if constexpr (ALIGN_EPI) { if (wr == 0) PG8_BAR; }
        E(acc, cur, wr, wc, fr, fq); S.done(cur);
        if (!has_next) break;
#pragma unroll
        for (int a = 0; a < 2; ++a)
#pragma unroll
            for (int b = 0; b < 2; ++b)
#pragma unroll
                for (int m = 0; m < 4; ++m)
#pragma unroll
                    for (int n = 0; n < 2; ++n) acc[a][b][m][n] = (f32x4){0.f, 0.f, 0.f, 0.f};
        cur = nxt; cA = nA; cB = nB; ++ui;
        if constexpr (ALIGN_EPI) { if (wr == 1) PG8_BAR; }
    }
    PG8_WAIT_V(0);
    if constexpr (!ALIGN_EPI) { if (wr == 0) PG8_BAR; }
    PG8_BAR;
#undef PG8_SA
#undef PG8_SB
#undef PG8_STAGE
#undef PG8_LDA
#undef PG8_LDB
#undef PG8_MMA
#undef PG8_WAIT_V
#undef PG8_WAIT_L
#undef PG8_BAR
#undef PG8_SCHED
}

struct EpiBf16 {
    static constexpr bool PERM = true;
    u16* O; int ldc;
    __device__ __forceinline__ void operator()(const f32x4 (&acc)[2][2][4][2], const Unit& u, int wr, int wc, int fr, int fq) const {
        const int row0 = u.pm * BM + wr * 64 + fr; const int col0 = u.pn * BM + wc * 32 + 8 * fq;
#pragma unroll
        for (int ai = 0; ai < 2; ++ai)
#pragma unroll
            for (int m = 0; m < 4; ++m) { u16* rowp = O + (size_t)(row0 + ai * HALF + m * 16) * ldc + col0;
#pragma unroll
                for (int bj = 0; bj < 2; ++bj) { const f32x4 v0 = acc[ai][bj][m][0], v1 = acc[ai][bj][m][1];
                    u32x4 w; w.x = cvt_pk_bf16(v0[0], v0[1]); w.y = cvt_pk_bf16(v0[2], v0[3]); w.z = cvt_pk_bf16(v1[0], v1[1]); w.w = cvt_pk_bf16(v1[2], v1[3]);
                    *(u32x4*)(rowp + bj * HALF) = w; } }
    }
};
struct EpiResid {
    static constexpr bool PERM = false;
    const float* base; float* out; const float* gate;
    __device__ __forceinline__ void operator()(const f32x4 (&acc)[2][2][4][2], const Unit& u, int wr, int wc, int fr, int fq) const {
        const int row0 = u.pm * BM + wr * 64 + fr, col0 = u.pn * BM + wc * 32 + 4 * fq;
        const int b = (u.pm * BM) / SEQ;
        f32x4 gv[2][2];
#pragma unroll
        for (int bj = 0; bj < 2; ++bj)
#pragma unroll
            for (int n = 0; n < 2; ++n) gv[bj][n] = *(const f32x4*)(gate + (size_t)b * N_MOD + col0 + bj * HALF + n * 16);
#pragma unroll
        for (int ai = 0; ai < 2; ++ai)
#pragma unroll
            for (int m = 0; m < 4; ++m) { const size_t off = (size_t)(row0 + ai * HALF + m * 16) * D_MODEL + col0;
#pragma unroll
                for (int bj = 0; bj < 2; ++bj)
#pragma unroll
                    for (int n = 0; n < 2; ++n) { const f32x4 bs = *(const f32x4*)(base + off + bj * HALF + n * 16);
                        *(f32x4*)(out + off + bj * HALF + n * 16) = bs + gv[bj][n] * acc[ai][bj][m][n]; } }
    }
};
struct EpiInProj {
    static constexpr bool PERM = true;
    float* QF; u16* KB; u16* VT; u16* XR; u16* GG; float* KM; const float* gq; const float* gk;
    __device__ __forceinline__ void operator()(const f32x4 (&acc)[2][2][4][2], const Unit& u, int wr, int wc, int fr, int fq) const {
        const int type = u.pn >> 1, head = (u.pn & 1) * 4 + wc;
        const int b = (u.pm * BM) / SEQ, blk = u.pm % NBLK;
        const int tok0 = u.pm * BM + wr * 64 + fr;
        const int bh = b * NHEAD + head;
        if (type <= 1) {
            const float* gp = type == 0 ? gq : gk;
            f32x4 gv[2][2];
#pragma unroll
            for (int bj = 0; bj < 2; ++bj)
#pragma unroll
                for (int n = 0; n < 2; ++n) gv[bj][n] = *(const f32x4*)(gp + 32 * bj + 8 * fq + 4 * n);
            f32x4 cs[2][2];
#pragma unroll
            for (int bj = 0; bj < 2; ++bj)
#pragma unroll
                for (int n = 0; n < 2; ++n) cs[bj][n] = (f32x4){0.f, 0.f, 0.f, 0.f};
#pragma unroll
            for (int ai = 0; ai < 2; ++ai)
#pragma unroll
                for (int m = 0; m < 4; ++m) {
                    float ss = 0.f;
#pragma unroll
                    for (int bj = 0; bj < 2; ++bj)
#pragma unroll
                        for (int n = 0; n < 2; ++n) { const f32x4 x = acc[ai][bj][m][n]; ss += (x[0] * x[0] + x[1] * x[1]) + (x[2] * x[2] + x[3] * x[3]); }
                    ss += __shfl_xor(ss, 16); ss += __shfl_xor(ss, 32);
                    const float rstd = 1.0f / sqrtf(ss * (1.0f / 64.0f) + EPS);
                    const int tok = tok0 + ai * HALF + m * 16, s = tok % SEQ;
                    const size_t rowoff = ((size_t)bh * SEQ + s) * HD + 8 * fq;
#pragma unroll
                    for (int bj = 0; bj < 2; ++bj) {
                        const f32x4 v0 = acc[ai][bj][m][0] * rstd * gv[bj][0], v1 = acc[ai][bj][m][1] * rstd * gv[bj][1];
                        if (type == 0) { *(f32x4*)(QF + rowoff + 32 * bj) = v0; *(f32x4*)(QF + rowoff + 32 * bj + 4) = v1; }
                        else { u32x4 w; w.x = cvt_pk_bf16(v0[0], v0[1]); w.y = cvt_pk_bf16(v0[2], v0[3]); w.z = cvt_pk_bf16(v1[0], v1[1]); w.w = cvt_pk_bf16(v1[2], v1[3]);
                            const int kw = s & 255, c8 = 4 * bj + fq;
                            *(u32x4*)(KB + ((size_t)bh * NBLK + blk) * (BLK * HD) + ((((kw >> 5) * 4 + (c8 >> 1)) * 2 + (c8 & 1)) * 32 + (kw & 31)) * 8) = w; cs[bj][0] += v0; cs[bj][1] += v1; }
                    }
                }
            if (type == 1) {
#pragma unroll
                for (int bj = 0; bj < 2; ++bj)
#pragma unroll
                    for (int n = 0; n < 2; ++n)
#pragma unroll
                        for (int i = 0; i < 4; ++i) { float v = cs[bj][n][i]; v += __shfl_xor(v, 1); v += __shfl_xor(v, 2); v += __shfl_xor(v, 4); v += __shfl_xor(v, 8);
                            if (fr == 0) atomicAdd(KM + (((size_t)(b * NBLK + blk) * NHEAD + head) * HD + 32 * bj + 8 * fq + 4 * n + i), v); }
            }
        } else if (type == 2) {
            const int hip = (fr >> 2) & 1, ep = 4 * (fr >> 3) + (fr & 3);
#pragma unroll
            for (int ai = 0; ai < 2; ++ai)
#pragma unroll
                for (int m = 0; m < 4; ++m) { const int kw = ai * HALF + wr * 64 + m * 16 + fr;
#pragma unroll
                    for (int bj = 0; bj < 2; ++bj)
#pragma unroll
                        for (int n = 0; n < 2; ++n) { const f32x4 x = acc[ai][bj][m][n]; const unsigned w0 = cvt_pk_bf16(x[0], x[1]), w1 = cvt_pk_bf16(x[2], x[3]);
                            u16* dst = VT + ((size_t)bh * NBLK + blk) * (BLK * HD) + (((((kw >> 5) * 2 + ((kw >> 4) & 1)) * 2 + bj) * 2 + hip) * 32 + 8 * fq + 4 * n) * 8 + ep;
                            dst[0] = (u16)(w0 & 0xffffu); dst[8] = (u16)(w0 >> 16); dst[16] = (u16)(w1 & 0xffffu); dst[24] = (u16)(w1 >> 16); } }
        } else {
            u16* O = type == 3 ? XR : GG;
#pragma unroll
            for (int ai = 0; ai < 2; ++ai)
#pragma unroll
                for (int m = 0; m < 4; ++m) { const int tok = tok0 + ai * HALF + m * 16; u16* rowp = O + (size_t)tok * AW + head * HD + 8 * fq;
#pragma unroll
                    for (int bj = 0; bj < 2; ++bj) { f32x4 v0 = acc[ai][bj][m][0], v1 = acc[ai][bj][m][1];
                        if (type == 4) {
#pragma unroll
                            for (int i = 0; i < 4; ++i) { v0[i] = gelu_tanh(v0[i]); v1[i] = gelu_tanh(v1[i]); } }
                        u32x4 w; w.x = cvt_pk_bf16(v0[0], v0[1]); w.y = cvt_pk_bf16(v0[2], v0[3]); w.z = cvt_pk_bf16(v1[0], v1[1]); w.w = cvt_pk_bf16(v1[2], v1[3]);
                        *(u32x4*)(rowp + 32 * bj) = w; } }
        }
    }
};

__device__ __forceinline__ float dpp_f(float old, float x, int ctrl) {
    return 0.f; }
#define DPPF(old, x, ctrl) __builtin_bit_cast(float, __builtin_amdgcn_update_dpp(__builtin_bit_cast(int, (float)(old)), __builtin_bit_cast(int, (float)(x)), (ctrl), 0xf, 0xf, false))
struct EpiFFN {
    static constexpr bool PERM = true;
    u16* ACT; float* RAW; const float* cw; const float* cb; LAS float* XB;
    __device__ __forceinline__ void operator()(const f32x4 (&acc)[2][2][4][2], const Unit& u, int wr, int wc, int fr, int fq) const {
        const int f0 = u.pn * 128 + wc * 32 + 8 * fq;
        if (fr >= 14) {
#pragma unroll
            for (int ai = 0; ai < 2; ++ai)
#pragma unroll
                for (int bj = 0; bj < 2; ++bj)
#pragma unroll
                    for (int n = 0; n < 2; ++n) *(LAS f32x4*)(XB + (((((ai * 2 + wr) * 4 + wc) * 2 + (fr - 14)) * 4 + fq) * 16 + (bj * 2 + n) * 4)) = acc[ai][bj][3][n];
        }
        if (wr == 1 && fr >= 14) {
#pragma unroll
            for (int bj = 0; bj < 2; ++bj)
#pragma unroll
                for (int n = 0; n < 2; ++n) *(f32x4*)(RAW + ((size_t)u.pm * 4 + 2 + (fr - 14)) * N_UP + bj * D_FF + f0 + 4 * n) = acc[1][bj][3][n];
        }
        if (wr == 0 && fr < 2) {
#pragma unroll
            for (int bj = 0; bj < 2; ++bj)
#pragma unroll
                for (int n = 0; n < 2; ++n) *(f32x4*)(RAW + ((size_t)u.pm * 4 + fr) * N_UP + bj * D_FF + f0 + 4 * n) = acc[0][bj][0][n];
        }
        asm volatile("s_waitcnt lgkmcnt(0)" ::: "memory"); __builtin_amdgcn_s_barrier(); asm volatile("" ::: "memory");
        unsigned pk[2][4][2][2];
#pragma unroll
        for (int n = 0; n < 2; ++n) {
            const f32x4 wg0 = *(const f32x4*)(cw + f0 + 4 * n), wg1 = *(const f32x4*)(cw + N_UP + f0 + 4 * n), wg2 = *(const f32x4*)(cw + 2 * N_UP + f0 + 4 * n), bg = *(const f32x4*)(cb + f0 + 4 * n);
            const f32x4 wv0 = *(const f32x4*)(cw + D_FF + f0 + 4 * n), wv1 = *(const f32x4*)(cw + N_UP + D_FF + f0 + 4 * n), wv2 = *(const f32x4*)(cw + 2 * N_UP + D_FF + f0 + 4 * n), bv = *(const f32x4*)(cb + D_FF + f0 + 4 * n);
#pragma unroll
            for (int ai = 0; ai < 2; ++ai) {
                const bool hasprev = (wr == 1) || (ai == 1);
                const int src = (wr == 1) ? (ai * 2 + 0) : ((ai - 1) * 2 + 1);
                f32x4 t1g = (f32x4){0.f, 0.f, 0.f, 0.f}, t2g = t1g, t1v = t1g, t2v = t1g;
                if (hasprev) {
                    const LAS float* xb1 = XB + ((((src * 4 + wc) * 2 + 1) * 4 + fq) * 16);
                    const LAS float* xb2 = XB + ((((src * 4 + wc) * 2 + (fr == 0 ? 0 : 1)) * 4 + fq) * 16);
                    t1g = *(const LAS f32x4*)(xb1 + (0 * 2 + n) * 4); t1v = *(const LAS f32x4*)(xb1 + (1 * 2 + n) * 4);
                    t2g = *(const LAS f32x4*)(xb2 + (0 * 2 + n) * 4); t2v = *(const LAS f32x4*)(xb2 + (1 * 2 + n) * 4);
                }
#pragma unroll
                for (int m = 0; m < 4; ++m) {
                    const f32x4 xg = acc[ai][0][m][n], xv = acc[ai][1][m][n];
                    if (m > 0) {
                        const f32x4 pg = acc[ai][0][m - 1][n], pv = acc[ai][1][m - 1][n];
#pragma unroll
                        for (int i = 0; i < 4; ++i) { t1g[i] = DPPF(0.f, pg[i], 0x121); t2g[i] = DPPF(0.f, pg[i], 0x122); t1v[i] = DPPF(0.f, pv[i], 0x121); t2v[i] = DPPF(0.f, pv[i], 0x122); }
                    }
                    float o[4];
#pragma unroll
                    for (int i = 0; i < 4; ++i) {
                        const float g1 = DPPF(t1g[i], xg[i], 0x111), g2 = DPPF(t2g[i], xg[i], 0x112);
                        const float v1 = DPPF(t1v[i], xv[i], 0x111), v2 = DPPF(t2v[i], xv[i], 0x112);
                        const float cg = ((wg0[i] * g2 + wg1[i] * g1) + wg2[i] * xg[i]) + bg[i];
                        const float cv = ((wv0[i] * v2 + wv1[i] * v1) + wv2[i] * xv[i]) + bv[i];
                        o[i] = cg * sigmoidf_(cg) * cv;
                    }
                    pk[ai][m][n][0] = cvt_pk_bf16(o[0], o[1]); pk[ai][m][n][1] = cvt_pk_bf16(o[2], o[3]);
                }
            }
        }
#pragma unroll
        for (int ai = 0; ai < 2; ++ai)
#pragma unroll
            for (int m = 0; m < 4; ++m) {
                const int row = u.pm * BM + ai * HALF + wr * 64 + m * 16 + fr;
                if (!(ai == 0 && m == 0 && wr == 0 && fr < 2)) {
                    u32x4 w; w.x = pk[ai][m][0][0]; w.y = pk[ai][m][0][1]; w.z = pk[ai][m][1][0]; w.w = pk[ai][m][1][1];
                    *(u32x4*)(ACT + (size_t)row * D_FF + f0) = w; }
            }
    }
};
}
#ifndef ATT_DUP
#define ATT_DUP 0
#endif

constexpr size_t MiB = 1u << 20;
constexpr size_t WS_CTL = 0;
constexpr size_t WS_KM = 1 * MiB;
constexpr size_t CTL_ZERO_BYTES = 2 * MiB;
constexpr size_t WS_MOD = 2 * MiB;
constexpr size_t WS_WIN = 3 * MiB;
constexpr size_t WS_WO = 8 * MiB;
constexpr size_t WS_WUP = 10 * MiB;
constexpr size_t WS_WDN = 21 * MiB;
constexpr size_t WS_WA = 27 * MiB;
constexpr size_t WS_WX = 27 * MiB + 65536;
constexpr size_t WS_AGG = 28 * MiB;
constexpr size_t WS_SSQL = 29 * MiB;
constexpr size_t WS_SSQA = 30 * MiB;
constexpr size_t WS_H = 32 * MiB;
constexpr size_t WS_QF = 96 * MiB;
constexpr size_t WS_KB = 160 * MiB;
constexpr size_t WS_VT = 192 * MiB;
constexpr size_t WS_XR = 224 * MiB;
constexpr size_t WS_GG = 256 * MiB;
constexpr size_t WS_ATT = 288 * MiB;
constexpr size_t WS_LRU = 320 * MiB;
constexpr size_t WS_MIX = 352 * MiB;
constexpr size_t WS_RAW = 96 * MiB;
constexpr size_t WS_ACT = 272 * MiB;
constexpr size_t WS_END = 448 * MiB;
constexpr int CW_BAR = 4096;

constexpr int RING_BYTES = 131072;
constexpr int MISC_OFF = 160 * 1024 - 256;
constexpr int XB_OFF = RING_BYTES;
constexpr int CLDS_OFF = RING_BYTES + 4096;
constexpr int LDS_BYTES = 160 * 1024;
constexpr int NT = 512, NWAVES = 8;

#define XB_TMO      128
#define XB_XCNT(j)  (256  + 64 * (j))
#define XB_XSUB(j)  (1280 + 64 * (j))
#define XB_XGEN(j)  (2304 + 64 * (j))
#define XB_TOP      3328
#define XB_TOPGEN   3392
#define XCD_BAR_WORDS 3456
#define XB_SPIN_CAP (1u << 18)
__device__ __forceinline__ unsigned xb_ld(unsigned* p)              { return __hip_atomic_load(p, __ATOMIC_RELAXED, __HIP_MEMORY_SCOPE_AGENT); }
__device__ __forceinline__ unsigned xb_add(unsigned* p, unsigned v) { return __hip_atomic_fetch_add(p, v, __ATOMIC_RELAXED, __HIP_MEMORY_SCOPE_AGENT); }
__device__ __forceinline__ unsigned xb_xcc_id() { return (unsigned)__builtin_amdgcn_s_getreg((3 << 11) | 20) & 0xFu; }
#define XB_SPIN(cond, bar) do { unsigned _sp = 0; while (cond) { __builtin_amdgcn_s_sleep(1); \
    if ((++_sp & 255u) == 0u) { if (xb_ld(&(bar)[XB_TMO])) break; if (_sp > XB_SPIN_CAP) { atomicAdd(&(bar)[XB_TMO], 1u); break; } } } } while (0)
struct XcdBarrier { unsigned* bar; unsigned x; volatile LAS unsigned* st; };
__device__ __forceinline__ XcdBarrier xcd_barrier_post(unsigned* bar, volatile LAS unsigned* st) {
    XcdBarrier b; b.bar = bar; b.x = xb_xcc_id(); b.st = st;
    if (threadIdx.x == 0) (void)xb_add(&bar[XB_XCNT(b.x)], 1u);
    return b;
}
__device__ __forceinline__ void xcd_barrier_complete(unsigned* bar, unsigned x, unsigned& nloc, unsigned& nx) {
    const unsigned G = gridDim.x * gridDim.y * gridDim.z;
    unsigned sum, cnt, mine, sp = 0u;
    for (;;) {
        sum = 0u; cnt = 0u; mine = 0u;
#pragma unroll
        for (unsigned j = 0; j < 16; ++j) { const unsigned c = xb_ld(&bar[XB_XCNT(j)]); sum += c; cnt += (c > 0u) ? 1u : 0u; mine = (j == x) ? c : mine; }
        if (sum == G) break;
        __builtin_amdgcn_s_sleep(1);
        if ((++sp & 255u) == 0u) { if (xb_ld(&bar[XB_TMO])) break; if (sp > XB_SPIN_CAP) { atomicAdd(&bar[XB_TMO], 1u); break; } }
    }
    nloc = mine > 0u ? mine : 1u; nx = cnt > 0u ? cnt : 1u;
}
__device__ __forceinline__ void xcd_barrier(const XcdBarrier& b) {
    asm volatile("s_waitcnt vmcnt(0)" ::: "memory");
    __syncthreads();
    if (threadIdx.x == 0) {
        unsigned* bar = b.bar;
        __builtin_amdgcn_s_waitcnt(0);
        unsigned nloc = b.st[0], nx = b.st[1];
        if (nloc == 0u) { xcd_barrier_complete(bar, b.x, nloc, nx); b.st[0] = nloc; b.st[1] = nx; }
        const unsigned old = xb_add(&bar[XB_XSUB(b.x)], 1u);
        const unsigned gen = old / nloc;
        if (old + 1u == (gen + 1u) * nloc) {
            __builtin_amdgcn_fence(__ATOMIC_RELEASE, "agent");
            asm volatile("s_waitcnt vmcnt(0)" ::: "memory");
            const unsigned og = xb_add(&bar[XB_TOP], 1u);
            const unsigned tg = og / nx;
            if (og + 1u == (tg + 1u) * nx) xb_add(&bar[XB_TOPGEN], 1u);
            else XB_SPIN(xb_ld(&bar[XB_TOPGEN]) == tg, bar);
            __builtin_amdgcn_fence(__ATOMIC_ACQUIRE, "agent");
            xb_add(&bar[XB_XGEN(b.x)], 1u);
            asm volatile("s_waitcnt vmcnt(0)" ::: "memory");
        } else {
            XB_SPIN(xb_ld(&bar[XB_XGEN(b.x)]) == gen, bar);
            __builtin_amdgcn_fence(__ATOMIC_ACQUIRE, "agent");
            asm volatile("s_waitcnt vmcnt(0)" ::: "memory");
        }
    }
    __syncthreads();
}

struct Args { const float* in[23]; float* out; unsigned char* ws; int ph_lo, ph_hi; };
struct Frame {
    LAS unsigned char* lds;
    int tid, lane, wave, vcu, G;
    const Args* pa;
    __device__ __forceinline__ const float* x() const { return pa->in[0]; }
    __device__ __forceinline__ const float* c() const { return pa->in[1]; }
    __device__ __forceinline__ const float* w_ada() const { return pa->in[2]; }
    __device__ __forceinline__ const float* b_ada() const { return pa->in[3]; }
    __device__ __forceinline__ const float* norm1_g() const { return pa->in[4]; }
    __device__ __forceinline__ const float* w_in() const { return pa->in[5]; }
    __device__ __forceinline__ const float* q_norm_g() const { return pa->in[6]; }
    __device__ __forceinline__ const float* k_norm_g() const { return pa->in[7]; }
    __device__ __forceinline__ const float* lru_conv_w() const { return pa->in[8]; }
    __device__ __forceinline__ const float* lru_conv_b() const { return pa->in[9]; }
    __device__ __forceinline__ const float* lru_wa() const { return pa->in[10]; }
    __device__ __forceinline__ const float* lru_ba() const { return pa->in[11]; }
    __device__ __forceinline__ const float* lru_wx() const { return pa->in[12]; }
    __device__ __forceinline__ const float* lru_bx() const { return pa->in[13]; }
    __device__ __forceinline__ const float* lru_lambda() const { return pa->in[14]; }
    __device__ __forceinline__ const float* lru_out_g() const { return pa->in[15]; }
    __device__ __forceinline__ const float* attn_out_g() const { return pa->in[16]; }
    __device__ __forceinline__ const float* w_out() const { return pa->in[17]; }
    __device__ __forceinline__ const float* norm2_g() const { return pa->in[18]; }
    __device__ __forceinline__ const float* w_up() const { return pa->in[19]; }
    __device__ __forceinline__ const float* ffn_conv_w() const { return pa->in[20]; }
    __device__ __forceinline__ const float* ffn_conv_b() const { return pa->in[21]; }
    __device__ __forceinline__ const float* w_down() const { return pa->in[22]; }
    float* out; unsigned char* ws;
};
#define LDS_WAIT() asm volatile("s_waitcnt lgkmcnt(0)" ::: "memory")

template <int MODE>
__device__ __forceinline__ void p0_transpose_item(const float* W, int K, int N, u16* WT, LAS float* scr, int item, int lane) {
    const int nblk = N / 32, kb = item / nblk, nb = item % nblk, k0 = 64 * kb, n0 = 32 * nb;
#pragma unroll 8
    for (int i = 0; i < 32; ++i) { const int kk = 2 * i + (lane >> 5); scr[kk * 33 + (lane & 31)] = W[(size_t)(k0 + kk) * N + n0 + (lane & 31)]; }
    LDS_WAIT(); asm volatile("" ::: "memory");
    const int c = lane & 7;
#pragma unroll
    for (int j = 0; j < 4; ++j) { const int n = (lane >> 3) + 8 * j; const LAS float* s = scr + (8 * c) * 33 + n;
        u32x4 o;
        if (MODE == 1) { o.x = cvt_pk_f16(s[0 * 33], s[1 * 33]); o.y = cvt_pk_f16(s[2 * 33], s[3 * 33]); o.z = cvt_pk_f16(s[4 * 33], s[5 * 33]); o.w = cvt_pk_f16(s[6 * 33], s[7 * 33]); }
        else { o.x = cvt_pk_bf16(s[0 * 33], s[1 * 33]); o.y = cvt_pk_bf16(s[2 * 33], s[3 * 33]); o.z = cvt_pk_bf16(s[4 * 33], s[5 * 33]); o.w = cvt_pk_bf16(s[6 * 33], s[7 * 33]); }
        int nn = n0 + n;
        if (MODE == 1) nn = (nn & ~255) + 128 * ((nn >> 5) & 1) + 32 * ((nn >> 6) & 3) + (nn & 31);
        if (MODE == 2) { const int bj = nn >= D_FF ? 1 : 0, f = nn - bj * D_FF; nn = 256 * (f >> 7) + 128 * bj + (f & 127); }
        *(GAS u32x4*)(WT + (size_t)nn * K + k0 + 8 * c) = o; }
    LDS_WAIT(); asm volatile("" ::: "memory");
}
__device__ __forceinline__ void p0_prologue(Frame& F) {
    unsigned char* wsp = F.ws; asm volatile("" : "+s"(wsp));
    LAS float* cl = (LAS float*)(F.lds + CLDS_OFF);
    for (int i = F.tid; i < BATCH * D_MODEL; i += NT) cl[i] = F.c()[i];
    __syncthreads();
    LAS float* scr = (LAS float*)(F.lds + F.wave * 16384);
    const int gw = F.vcu * NWAVES + F.wave, NGW = F.G * NWAVES;
    constexpr int I_MOD = N_MOD / 64;
    constexpr int I_IN = (D_MODEL / 64) * (N_IN / 32), I_O = (D_MODEL / 64) * (D_MODEL / 32), I_UP = (D_MODEL / 64) * (N_UP / 32), I_DN = (D_FF / 64) * (D_MODEL / 32), I_L = 8 * 2;
    constexpr int NITEMS = I_MOD + I_IN + I_O + I_UP + I_DN + 2 * I_L;
    u16* WinT = (u16*)(wsp + WS_WIN); u16* WoT = (u16*)(wsp + WS_WO); u16* WupT = (u16*)(wsp + WS_WUP); u16* WdT = (u16*)(wsp + WS_WDN);
    u16* WaT = (u16*)(wsp + WS_WA); u16* WxT = (u16*)(wsp + WS_WX);
    float* MOD = (float*)(wsp + WS_MOD);
    for (int it = gw; it < NITEMS; it += NGW) {
        int r = it;
        if (r < I_MOD) {
            const int col = r * 64 + F.lane; float a0 = 0.f, a1 = 0.f, a2 = 0.f, a3 = 0.f;
            const float* wp = F.w_ada() + col;
#pragma unroll 8
            for (int k = 0; k < D_MODEL; ++k) { const float w = wp[(size_t)k * N_MOD];
                a0 += cl[k] * w; a1 += cl[D_MODEL + k] * w; a2 += cl[2 * D_MODEL + k] * w; a3 += cl[3 * D_MODEL + k] * w; }
            const float bb = F.b_ada()[col];
            MOD[col] = a0 + bb; MOD[N_MOD + col] = a1 + bb; MOD[2 * N_MOD + col] = a2 + bb; MOD[3 * N_MOD + col] = a3 + bb;
            continue; }
        r -= I_MOD;
        if (r < I_IN) { p0_transpose_item<1>(F.w_in(), D_MODEL, N_IN, WinT, scr, r, F.lane); continue; } r -= I_IN;
        if (r < I_O) { p0_transpose_item<0>(F.w_out(), D_MODEL, D_MODEL, WoT, scr, r, F.lane); continue; } r -= I_O;
        if (r < I_UP) { p0_transpose_item<2>(F.w_up(), D_MODEL, N_UP, WupT, scr, r, F.lane); continue; } r -= I_UP;
        if (r < I_DN) { p0_transpose_item<0>(F.w_down(), D_FF, D_MODEL, WdT, scr, r, F.lane); continue; } r -= I_DN;
        if (r < I_L) { const int h = r >> 1; p0_transpose_item<0>(F.lru_wa() + h * 4096, 64, 64, WaT + h * 4096, scr, r & 1, F.lane); continue; } r -= I_L;
        { const int h = r >> 1; p0_transpose_item<0>(F.lru_wx() + h * 4096, 64, 64, WxT + h * 4096, scr, r & 1, F.lane); }
    }
}

template <bool F16>
__device__ __forceinline__ void rownorm_phase(Frame& F, const float* X, const float* g, const float* sh, const float* sc, u16* O) {
    const int gw = F.vcu * NWAVES + F.wave, NGW = F.G * NWAVES;
    for (int m = gw; m < M_TOK; m += NGW) {
        const int b = m / SEQ;
        const GAS f32x4* xr = (const GAS f32x4*)(X + (size_t)m * D_MODEL) + F.lane;
        f32x4 v[4]; float s = 0.f;
#pragma unroll
        for (int j = 0; j < 4; ++j) { v[j] = xr[64 * j]; s += (v[j].x * v[j].x + v[j].y * v[j].y) + (v[j].z * v[j].z + v[j].w * v[j].w); }
        const float rstd = 1.0f / sqrtf(wave_sum(s) * (1.0f / D_MODEL) + EPS);
        GAS u32x2* o8 = (GAS u32x2*)(O + (size_t)m * D_MODEL) + F.lane;
#pragma unroll
        for (int j = 0; j < 4; ++j) {
            const int col = 4 * F.lane + 256 * j;
            const f32x4 gv = *(const f32x4*)(g + col), shv = *(const f32x4*)(sh + (size_t)b * N_MOD + col), scv = *(const f32x4*)(sc + (size_t)b * N_MOD + col);
            const f32x4 y = (v[j] * rstd) * gv * (scv + 1.0f) + shv;
            u32x2 w;
            if (F16) { w.x = cvt_pk_f16(y.x, y.y); w.y = cvt_pk_f16(y.z, y.w); } else { w.x = cvt_pk_bf16(y.x, y.y); w.y = cvt_pk_bf16(y.z, y.w); }
            o8[64 * j] = w; }
    }
}

__device__ __forceinline__ int crow(int r, int hi) { return (r & 3) + 8 * (r >> 2) + 4 * hi; }
constexpr int AL_QS = 0, AL_SLOT = 32768, AL_LSL = 131072, AL_LIST = 134144, AL_CNT = 150528, AL_MISC = 150656, AL_KMS = 150912;
__device__ __forceinline__ void attn_tile(const u16* Kp, const u16* Vp, const s16x8 (&qf)[4], int nkt, bool own, int tt, int qidx, int hi, float c1, float c2, f32x16& o0, f32x16& o1, float& lsum) {
#pragma unroll
    for (int r = 0; r < 16; ++r) { o0[r] = 0.f; o1[r] = 0.f; }
    lsum = 0.f;
    s16x8 kc[4], kn[4], vc[4];
#pragma unroll
    for (int s = 0; s < 4; ++s) { kc[s] = *(const GAS s16x8*)(Kp + s * 512); kn[s] = kc[s]; }
#pragma unroll 1
    for (int kt = 0; kt < nkt; ++kt) {
#pragma unroll
        for (int s = 0; s < 4; ++s) vc[s] = *(const GAS s16x8*)(Vp + (kt * 4 + s) * 512);
        if (kt + 1 < nkt) {
#pragma unroll
            for (int s = 0; s < 4; ++s) kn[s] = *(const GAS s16x8*)(Kp + ((kt + 1) * 4 + s) * 512);
        }
        f32x16 p;
#pragma unroll
        for (int r = 0; r < 16; ++r) p[r] = 0.f;
#pragma unroll
        for (int s = 0; s < 4; ++s) p = __builtin_amdgcn_mfma_f32_32x32x16_bf16(__builtin_bit_cast(bf16x8_t, kc[s]), __builtin_bit_cast(bf16x8_t, qf[s]), p, 0, 0, 0);
        const bool diag = own && (kt == tt);
#pragma unroll
        for (int r = 0; r < 16; ++r) { float e = __builtin_amdgcn_exp2f(p[r] * c1 - c2);
            if (diag && (32 * kt + crow(r, hi) > qidx)) e = 0.f;
            p[r] = e; lsum += e; }
#pragma unroll
        for (int s2 = 0; s2 < 2; ++s2) {
            u32x4 pw; pw.x = cvt_pk_bf16(p[8 * s2 + 0], p[8 * s2 + 1]); pw.y = cvt_pk_bf16(p[8 * s2 + 2], p[8 * s2 + 3]); pw.z = cvt_pk_bf16(p[8 * s2 + 4], p[8 * s2 + 5]); pw.w = cvt_pk_bf16(p[8 * s2 + 6], p[8 * s2 + 7]);
            const bf16x8_t pa = __builtin_bit_cast(bf16x8_t, pw);
            o0 = __builtin_amdgcn_mfma_f32_32x32x16_bf16(pa, __builtin_bit_cast(bf16x8_t, vc[2 * s2]), o0, 0, 0, 0);
            o1 = __builtin_amdgcn_mfma_f32_32x32x16_bf16(pa, __builtin_bit_cast(bf16x8_t, vc[2 * s2 + 1]), o1, 0, 0, 0);
        }
#pragma unroll
        for (int s = 0; s < 4; ++s) kc[s] = kn[s];
    }
}
__device__ __forceinline__ void attn_item(Frame& F, int bh, int i, float c1, float c2) {
    unsigned char* wsp = F.ws; asm volatile("" : "+s"(wsp));
    const float* QF = (const float*)(wsp + WS_QF); const u16* KB = (const u16*)(wsp + WS_KB); const u16* VT = (const u16*)(wsp + WS_VT);
    const float* KM = (const float*)(wsp + WS_KM); u16* ATT = (u16*)(wsp + WS_ATT); float* SSQA = (float*)(wsp + WS_SSQA);
    LAS u16* QS = (LAS u16*)(F.lds + AL_QS); LAS u16* SLOT = (LAS u16*)(F.lds + AL_SLOT); LAS float* LSL = (LAS float*)(F.lds + AL_LSL);
    LAS float* KMS = (LAS float*)(F.lds + AL_KMS); LAS u16* LIST = (LAS u16*)(F.lds + AL_LIST); LAS int* CNT = (LAS int*)(F.lds + AL_CNT);
    const int tid = F.tid, lane = F.lane, wave = F.wave, hi = lane >> 5, l31 = lane & 31;
    const int b = bh / NHEAD, h = bh % NHEAD;
    for (int u = tid; u < (3 * 32768 + 3072) / 16; u += NT) *(LAS u32x4*)(F.lds + AL_SLOT + u * 16) = (u32x4){0u, 0u, 0u, 0u};
    if (tid < 32) CNT[tid] = 0;
    for (int u = tid; u < NBLK * HD; u += NT) { const int n = u >> 6, d = u & 63; KMS[u] = KM[(((size_t)(b * NBLK + n)) * NHEAD + h) * HD + d] * (1.0f / 256.0f); }
    __syncthreads();
    {
        const int q = tid >> 1, half = tid & 1;
        const GAS f32x4* qrow = (const GAS f32x4*)(QF + ((size_t)bh * SEQ + (size_t)i * BLK + q) * HD);
        f32x4 qv[16];
#pragma unroll
        for (int d = 0; d < 16; ++d) qv[d] = qrow[d];
#pragma unroll
        for (int d = 0; d < 4; ++d) { const f32x4 a = qv[2 * d], c = qv[2 * d + 1], a2 = qv[8 + 2 * d], c2 = qv[8 + 2 * d + 1];
            u32x4 w, w2; w.x = cvt_pk_bf16(a.x, a.y); w.y = cvt_pk_bf16(a.z, a.w); w.z = cvt_pk_bf16(c.x, c.y); w.w = cvt_pk_bf16(c.z, c.w);
            w2.x = cvt_pk_bf16(a2.x, a2.y); w2.y = cvt_pk_bf16(a2.z, a2.w); w2.z = cvt_pk_bf16(c2.x, c2.y); w2.w = cvt_pk_bf16(c2.z, c2.w);
            if (half) w = w2;
            *(LAS u32x4*)(QS + q * 64 + 32 * half + 8 * d) = w; }
        float v0 = -INFINITY, v1 = -INFINITY, v2 = -INFINITY; int i0 = -1, i1 = -1, i2 = -1;
        for (int nn = 0; nn < 16; ++nn) {
            const int n = 16 * half + nn;
            const LAS f32x4* kr = (const LAS f32x4*)(KMS + n * 64);
            float g = 0.f;
#pragma unroll
            for (int d = 0; d < 16; ++d) { const f32x4 kv = kr[d]; g = fmaf(qv[d].x, kv.x, g); g = fmaf(qv[d].y, kv.y, g); g = fmaf(qv[d].z, kv.z, g); g = fmaf(qv[d].w, kv.w, g); }
            if (n >= i) g = -INFINITY;
            if (g > v0) { v2 = v1; i2 = i1; v1 = v0; i1 = i0; v0 = g; i0 = n; }
            else if (g > v1) { v2 = v1; i2 = i1; v1 = g; i1 = n; }
            else if (g > v2) { v2 = g; i2 = n; }
        }
        const float pv0 = __shfl_xor(v0, 1), pv1 = __shfl_xor(v1, 1), pv2 = __shfl_xor(v2, 1);
        const int pi0 = __shfl_xor(i0, 1), pi1 = __shfl_xor(i1, 1), pi2 = __shfl_xor(i2, 1);
        if (half == 0) {
            float av[3] = {v0, v1, v2}, bv[3] = {pv0, pv1, pv2}; int ai[3] = {i0, i1, i2}, bi[3] = {pi0, pi1, pi2};
            int sel[3]; int pa = 0, pb = 0;
#pragma unroll
            for (int k = 0; k < 3; ++k) {
                const float ca = pa == 0 ? av[0] : (pa == 1 ? av[1] : av[2]); const int cai = pa == 0 ? ai[0] : (pa == 1 ? ai[1] : ai[2]);
                const float cb = pb == 0 ? bv[0] : (pb == 1 ? bv[1] : bv[2]); const int cbi = pb == 0 ? bi[0] : (pb == 1 ? bi[1] : bi[2]);
                if (ca >= cb) { sel[k] = cai; ++pa; } else { sel[k] = cbi; ++pb; }
            }
#pragma unroll
            for (int k = 0; k < 3; ++k) if (sel[k] >= 0) { const int pos = __hip_atomic_fetch_add(&CNT[sel[k]], 1, __ATOMIC_RELAXED, __HIP_MEMORY_SCOPE_WORKGROUP); LIST[sel[k] * 256 + pos] = (u16)(q | (k << 8)); }
        }
    }
    __syncthreads();
    {
        int base = 0;
        for (int j = 0; j < i; ++j) {
            const int cntj = __builtin_amdgcn_readfirstlane(CNT[j]);
            const int ntj = (cntj + 31) >> 5;
            for (int t = base + ((wave - base) & 7); t < base + ntj; t += 8) {
                const int tt = t - base;
                const int ridx = 32 * tt + l31; const bool valid = ridx < cntj;
                const int ent = valid ? (int)LIST[j * 256 + ridx] : 0;
                const int qidx = ent & 255;
                s16x8 qf[4];
#pragma unroll
                for (int s = 0; s < 4; ++s) qf[s] = *(const LAS s16x8*)(QS + qidx * 64 + 16 * s + 8 * hi);
                const size_t boff = ((size_t)bh * NBLK + j) * (BLK * HD) + lane * 8;
                f32x16 o0, o1; float lsum;
                attn_tile(KB + boff, VT + boff, qf, 8, false, 0, qidx, hi, c1, c2, o0, o1, lsum);
                const int srow = valid ? ((ent >> 8) * 256 + qidx) : -1;
                lsum += __shfl_xor(lsum, 32);
                if (valid && hi == 0) LSL[srow] = lsum;
#pragma unroll
                for (int r = 0; r < 16; ++r) { const int sr = __shfl(srow, crow(r, hi));
                    if (sr >= 0) { const unsigned w = cvt_pk_bf16(o0[r], o1[r]); SLOT[sr * 64 + l31] = (u16)(w & 0xffffu); SLOT[sr * 64 + 32 + l31] = (u16)(w >> 16); }
                    if ((r & 3) == 3) asm volatile("" ::: "memory"); }
            }
            base += ntj;
        }
    }
    f32x16 oo0, oo1; float lown;
    {
        s16x8 qf[4];
#pragma unroll
        for (int s = 0; s < 4; ++s) qf[s] = *(const LAS s16x8*)(QS + (32 * wave + l31) * 64 + 16 * s + 8 * hi);
        const size_t boff = ((size_t)bh * NBLK + i) * (BLK * HD) + lane * 8;
        attn_tile(KB + boff, VT + boff, qf, wave + 1, true, wave, 32 * wave + l31, hi, c1, c2, oo0, oo1, lown);
    }
    __syncthreads();
    {
        const int q = 32 * wave + l31;
        float lt = lown + __shfl_xor(lown, 32);
        lt += LSL[q] + LSL[256 + q] + LSL[512 + q];
        const float inv = 1.0f / lt;
#pragma unroll
        for (int r = 0; r < 16; ++r) { const int rl = crow(r, hi), qq = 32 * wave + rl; const float iv = __shfl(inv, rl);
            float a = oo0[r], c = oo1[r];
#pragma unroll
            for (int k = 0; k < 3; ++k) { a += __builtin_bit_cast(float, (unsigned)SLOT[(k * 256 + qq) * 64 + l31] << 16); c += __builtin_bit_cast(float, (unsigned)SLOT[(k * 256 + qq) * 64 + 32 + l31] << 16); }
            const unsigned w = cvt_pk_bf16(a * iv, c * iv);
            QS[qq * 64 + l31] = (u16)(w & 0xffffu); QS[qq * 64 + 32 + l31] = (u16)(w >> 16);
            if ((r & 3) == 3) asm volatile("" ::: "memory"); }
        LDS_WAIT(); asm volatile("" ::: "memory");
#pragma unroll
        for (int it = 0; it < 4; ++it) { const int c = lane + 64 * it, row = c >> 3, ch = c & 7;
            const u32x4 w = *(const LAS u32x4*)(QS + (32 * wave + row) * 64 + 8 * ch);
            const size_t tok = (size_t)b * SEQ + (size_t)i * BLK + 32 * wave + row;
            *(GAS u32x4*)(ATT + tok * AW + h * HD + 8 * ch) = w;
            float ss = bf_lo(w.x) * bf_lo(w.x) + bf_hi(w.x) * bf_hi(w.x) + bf_lo(w.y) * bf_lo(w.y) + bf_hi(w.y) * bf_hi(w.y) + bf_lo(w.z) * bf_lo(w.z) + bf_hi(w.z) * bf_hi(w.z) + bf_lo(w.w) * bf_lo(w.w) + bf_hi(w.w) * bf_hi(w.w);
            ss += __shfl_xor(ss, 1); ss += __shfl_xor(ss, 2); ss += __shfl_xor(ss, 4);
            if (ch == 0) SSQA[tok * NHEAD + h] = ss; }
    }
    __syncthreads();
}
__device__ __forceinline__ void attn_phase(Frame& F) {
    LAS float* mm = (LAS float*)(F.lds + AL_MISC);
    if (F.tid < 64) { float a = fabsf(F.q_norm_g()[F.tid]), c = fabsf(F.k_norm_g()[F.tid]);
#pragma unroll
        for (int o = 1; o < 64; o <<= 1) { a = fmaxf(a, __shfl_xor(a, o)); c = fmaxf(c, __shfl_xor(c, o)); }
        if (F.tid == 0) { mm[0] = a; mm[1] = c; } }
    __syncthreads();
    const float C = 8.0f * mm[0] * mm[1];
    const float c1 = 0.125f * LOG2E, c2 = C * LOG2E;
    __syncthreads();
    if (F.G == 256) {
        const int xcd = F.vcu >> 5, k = F.vcu & 31;
#pragma unroll 1
        for (int r = 0; r < 4; ++r) attn_item(F, xcd * 4 + r, (r & 1) ? 31 - k : k, c1, c2);
    } else {
        for (int it = F.vcu; it < BATCH * NHEAD * NBLK; it += F.G) attn_item(F, it >> 5, it & 31, c1, c2);
    }
}

constexpr int LL_CW = 0;
template <bool FINAL>
__device__ __forceinline__ void lru_item(Frame& F, int b, int chunk) {
    unsigned char* wsp = F.ws; asm volatile("" : "+s"(wsp));
    const u16* XR = (const u16*)(wsp + WS_XR); const u16* GG = (const u16*)(wsp + WS_GG);
    const u16* WaT = (const u16*)(wsp + WS_WA); const u16* WxT = (const u16*)(wsp + WS_WX);
    float* AGG = (float*)(wsp + WS_AGG); u16* LRU = (u16*)(wsp + WS_LRU); float* SSQL = (float*)(wsp + WS_SSQL);
    const int lane = F.lane, hd = F.wave, hi = lane >> 5, j = lane & 31;
    LAS float* CW = (LAS float*)(F.lds + LL_CW + hd * 1280);
    for (int u = lane; u < 320; u += 64) CW[u] = (u < 256) ? F.lru_conv_w()[(u >> 6) * AW + hd * HD + (u & 63)] : F.lru_conv_b()[hd * HD + (u - 256)];
    LDS_WAIT(); asm volatile("" ::: "memory");
    float ba[2], bx[2], sp8[2], carry[2], arun[2];
#pragma unroll
    for (int ct = 0; ct < 2; ++ct) { const int c = hd * HD + 32 * ct + j; ba[ct] = F.lru_ba()[c]; bx[ct] = F.lru_bx()[c];
        sp8[ct] = 8.0f * log1pf(expf(-F.lru_lambda()[c])); carry[ct] = 0.f; arun[ct] = 1.f;
        if (FINAL) { float hcar = 0.f; for (int cc = 0; cc < chunk; ++cc) { const f32x2 ah = *(const f32x2*)(AGG + (((size_t)(b * 64 + cc)) * AW + c) * 2); hcar = ah.x * hcar + ah.y; } carry[ct] = hcar; } }
    for (int tile = 0; tile < 4; ++tile) {
        const int t0 = chunk * 128 + tile * 32;
        const int pos = t0 + j;
        s16x8 af[4], gf[4];
#pragma unroll
        for (int s = 0; s < 4; ++s) {
            const int ch0 = 16 * s + 8 * hi;
            float xc[8];
            { const LAS f32x4* bp = (const LAS f32x4*)(CW + 256 + ch0); const f32x4 b0 = bp[0], b1 = bp[1];
              xc[0] = b0.x; xc[1] = b0.y; xc[2] = b0.z; xc[3] = b0.w; xc[4] = b1.x; xc[5] = b1.y; xc[6] = b1.z; xc[7] = b1.w; }
            float accv[8];
#pragma unroll
            for (int e = 0; e < 8; ++e) accv[e] = 0.f;
#pragma unroll
            for (int jj = 0; jj < 4; ++jj) {
                const int p = pos - 3 + jj;
                u32x4 xw = (u32x4){0u, 0u, 0u, 0u};
                if (p >= 0) xw = *(const GAS u32x4*)(XR + ((size_t)b * SEQ + p) * AW + hd * HD + ch0);
                const LAS f32x4* wp = (const LAS f32x4*)(CW + jj * 64 + ch0); const f32x4 w0 = wp[0], w1 = wp[1];
                accv[0] += w0.x * bf_lo(xw.x); accv[1] += w0.y * bf_hi(xw.x); accv[2] += w0.z * bf_lo(xw.y); accv[3] += w0.w * bf_hi(xw.y);
                accv[4] += w1.x * bf_lo(xw.z); accv[5] += w1.y * bf_hi(xw.z); accv[6] += w1.z * bf_lo(xw.w); accv[7] += w1.w * bf_hi(xw.w);
            }
#pragma unroll
            for (int e = 0; e < 8; ++e) xc[e] += accv[e];
            u32x4 aw; aw.x = cvt_pk_bf16(xc[0], xc[1]); aw.y = cvt_pk_bf16(xc[2], xc[3]); aw.z = cvt_pk_bf16(xc[4], xc[5]); aw.w = cvt_pk_bf16(xc[6], xc[7]);
            af[s] = __builtin_bit_cast(s16x8, aw);
            if (FINAL) gf[s] = *(const GAS s16x8*)(GG + ((size_t)b * SEQ + pos) * AW + hd * HD + ch0);
        }
        float ssacc[16];
#pragma unroll
        for (int r = 0; r < 16; ++r) ssacc[r] = 0.f;
#pragma unroll
        for (int ct = 0; ct < 2; ++ct) {
            f32x16 aA, aX, aI, aG;
#pragma unroll
            for (int r = 0; r < 16; ++r) { aA[r] = 0.f; aX[r] = 0.f; aI[r] = 0.f; aG[r] = 0.f; }
#pragma unroll
            for (int s = 0; s < 4; ++s) {
                const size_t woff = ((size_t)hd * 64 + 32 * ct + j) * 64 + 16 * s + 8 * hi;
                const s16x8 wa = *(const GAS s16x8*)(WaT + woff), wx = *(const GAS s16x8*)(WxT + woff);
                s16x8 id;
#pragma unroll
                for (int e = 0; e < 8; ++e) id[e] = (16 * s + 8 * hi + e == 32 * ct + j) ? (short)0x3F80 : (short)0;
                const bf16x8_t a = __builtin_bit_cast(bf16x8_t, af[s]);
                aA = __builtin_amdgcn_mfma_f32_32x32x16_bf16(a, __builtin_bit_cast(bf16x8_t, wa), aA, 0, 0, 0);
                aX = __builtin_amdgcn_mfma_f32_32x32x16_bf16(a, __builtin_bit_cast(bf16x8_t, wx), aX, 0, 0, 0);
                aI = __builtin_amdgcn_mfma_f32_32x32x16_bf16(a, __builtin_bit_cast(bf16x8_t, id), aI, 0, 0, 0);
                if (FINAL) aG = __builtin_amdgcn_mfma_f32_32x32x16_bf16(__builtin_bit_cast(bf16x8_t, gf[s]), __builtin_bit_cast(bf16x8_t, id), aG, 0, 0, 0);
            }
            float av[16], uv[16];
#pragma unroll
            for (int r = 0; r < 16; ++r) {
                const float rr = sigmoidf_(aA[r] + ba[ct]), ii = sigmoidf_(aX[r] + bx[ct]);
                const float la = -rr * sp8[ct];
                const float a = __builtin_amdgcn_exp2f(la * LOG2E);
                const float x2 = 2.0f * la;
                const float om = (x2 > -0.05f) ? -x2 * (1.0f + x2 * 0.5f * (1.0f + x2 * (1.0f / 3.0f) * (1.0f + x2 * 0.25f))) : 1.0f - a * a;
                av[r] = a; uv[r] = sqrtf(om) * (ii * aI[r]);
            }
            float Ag[4], Ug[4];
#pragma unroll
            for (int g = 0; g < 4; ++g) { float A = av[4 * g], U = uv[4 * g];
#pragma unroll
                for (int e = 1; e < 4; ++e) { A *= av[4 * g + e]; U = av[4 * g + e] * U + uv[4 * g + e]; }
                Ag[g] = A; Ug[g] = U; }
            float h = carry[ct], ap = arun[ct];
            float hin[4];
#pragma unroll
            for (int g = 0; g < 4; ++g) {
                const float pA = __shfl_xor(Ag[g], 32), pU = __shfl_xor(Ug[g], 32);
                const float fA = hi ? pA : Ag[g], fU = hi ? pU : Ug[g], sA = hi ? Ag[g] : pA, sU = hi ? Ug[g] : pU;
                const float h1 = fA * h + fU;
                hin[g] = hi ? h1 : h;
                h = sA * h1 + sU; ap *= fA * sA;
            }
            carry[ct] = h; arun[ct] = ap;
            if (FINAL) {
#pragma unroll
                for (int g = 0; g < 4; ++g) { float hh = hin[g];
#pragma unroll
                    for (int e = 0; e < 4; ++e) { const int r = 4 * g + e; hh = av[r] * hh + uv[r]; const float o = hh * aG[r]; ssacc[r] += o * o;
                        const size_t tok = (size_t)b * SEQ + t0 + crow(r, hi);
                        LRU[tok * AW + hd * HD + 32 * ct + j] = (u16)(cvt_pk_bf16(o, 0.f) & 0xffffu); } }
            }
        }
        if (FINAL) {
#pragma unroll
            for (int r = 0; r < 16; ++r) {
                const size_t tok = (size_t)b * SEQ + t0 + crow(r, hi);
                float ss = ssacc[r];
                ss += __shfl_xor(ss, 1); ss += __shfl_xor(ss, 2); ss += __shfl_xor(ss, 4); ss += __shfl_xor(ss, 8); ss += __shfl_xor(ss, 16);
                if (j == 0) SSQL[tok * NHEAD + hd] = ss;
            }
        }
    }
    if (!FINAL) { if (hi == 0) {
#pragma unroll
        for (int ct = 0; ct < 2; ++ct) { const int c = hd * HD + 32 * ct + j; *(f32x2*)(AGG + (((size_t)(b * 64 + chunk)) * AW + c) * 2) = (f32x2){arun[ct], carry[ct]}; } } }
}
template <bool FINAL>
__device__ __forceinline__ void lru_phase(Frame& F) {
    for (int it = F.vcu; it < BATCH * 64; it += F.G) { lru_item<FINAL>(F, it >> 6, it & 63); }
}

__device__ __forceinline__ void mix_phase(Frame& F) {
    unsigned char* wsp = F.ws; asm volatile("" : "+s"(wsp));
    const u16* LRU = (const u16*)(wsp + WS_LRU); const u16* ATT = (const u16*)(wsp + WS_ATT);
    const float* SSQL = (const float*)(wsp + WS_SSQL); const float* SSQA = (const float*)(wsp + WS_SSQA); u16* MIX = (u16*)(wsp + WS_MIX);
    const int gw = F.vcu * NWAVES + F.wave, NGW = F.G * NWAVES, lane = F.lane;
    const f32x4 gl0 = *(const f32x4*)(F.lru_out_g() + 8 * lane), gl1 = *(const f32x4*)(F.lru_out_g() + 8 * lane + 4);
    const f32x4 ga0 = *(const f32x4*)(F.attn_out_g() + 8 * lane), ga1 = *(const f32x4*)(F.attn_out_g() + 8 * lane + 4);
    for (int m = gw; m < M_TOK; m += NGW) {
        const f32x4 s0 = *(const GAS f32x4*)(SSQL + (size_t)m * 8), s1 = *(const GAS f32x4*)(SSQL + (size_t)m * 8 + 4);
        const f32x4 t0 = *(const GAS f32x4*)(SSQA + (size_t)m * 8), t1 = *(const GAS f32x4*)(SSQA + (size_t)m * 8 + 4);
        const float ssl = ((s0.x + s0.y) + (s0.z + s0.w)) + ((s1.x + s1.y) + (s1.z + s1.w));
        const float ssa = ((t0.x + t0.y) + (t0.z + t0.w)) + ((t1.x + t1.y) + (t1.z + t1.w));
        const float rl = 1.0f / sqrtf(ssl * (1.0f / AW) + EPS), ra = 1.0f / sqrtf(ssa * (1.0f / AW) + EPS);
        const u32x4 lw = *(const GAS u32x4*)(LRU + (size_t)m * AW + 8 * lane), aw = *(const GAS u32x4*)(ATT + (size_t)m * AW + 8 * lane);
        u32x4 o;
        o.x = cvt_pk_bf16(bf_lo(lw.x) * rl * gl0.x, bf_hi(lw.x) * rl * gl0.y); o.y = cvt_pk_bf16(bf_lo(lw.y) * rl * gl0.z, bf_hi(lw.y) * rl * gl0.w);
        o.z = cvt_pk_bf16(bf_lo(lw.z) * rl * gl1.x, bf_hi(lw.z) * rl * gl1.y); o.w = cvt_pk_bf16(bf_lo(lw.w) * rl * gl1.z, bf_hi(lw.w) * rl * gl1.w);
        *(GAS u32x4*)(MIX + (size_t)m * D_MODEL + 8 * lane) = o;
        o.x = cvt_pk_bf16(bf_lo(aw.x) * ra * ga0.x, bf_hi(aw.x) * ra * ga0.y); o.y = cvt_pk_bf16(bf_lo(aw.y) * ra * ga0.z, bf_hi(aw.y) * ra * ga0.w);
        o.z = cvt_pk_bf16(bf_lo(aw.z) * ra * ga1.x, bf_hi(aw.z) * ra * ga1.y); o.w = cvt_pk_bf16(bf_lo(aw.w) * ra * ga1.z, bf_hi(aw.w) * ra * ga1.w);
        *(GAS u32x4*)(MIX + (size_t)m * D_MODEL + AW + 8 * lane) = o;
    }
}

__device__ __forceinline__ void ffn_fixup(Frame& F, unsigned char* wsp, int pm) {
    const float* RAW = (const float*)(wsp + WS_RAW); u16* ACT = (u16*)(wsp + WS_ACT);
    const float* cw = F.ffn_conv_w(); const float* cb = F.ffn_conv_b();
    const bool first = (pm % NBLK) == 0;
    for (int f = F.tid; f < D_FF; f += NT) {
        float xg[4], xv[4];
        xg[0] = first ? 0.f : RAW[((size_t)(pm - 1) * 4 + 2) * N_UP + f]; xg[1] = first ? 0.f : RAW[((size_t)(pm - 1) * 4 + 3) * N_UP + f];
        xv[0] = first ? 0.f : RAW[((size_t)(pm - 1) * 4 + 2) * N_UP + D_FF + f]; xv[1] = first ? 0.f : RAW[((size_t)(pm - 1) * 4 + 3) * N_UP + D_FF + f];
        xg[2] = RAW[((size_t)pm * 4 + 0) * N_UP + f]; xg[3] = RAW[((size_t)pm * 4 + 1) * N_UP + f];
        xv[2] = RAW[((size_t)pm * 4 + 0) * N_UP + D_FF + f]; xv[3] = RAW[((size_t)pm * 4 + 1) * N_UP + D_FF + f];
        const float wg0 = cw[f], wg1 = cw[N_UP + f], wg2 = cw[2 * N_UP + f], bg = cb[f];
        const float wv0 = cw[D_FF + f], wv1 = cw[N_UP + D_FF + f], wv2 = cw[2 * N_UP + D_FF + f], bv = cb[D_FF + f];
#pragma unroll
        for (int r = 0; r < 2; ++r) {
            const float cg = ((wg0 * xg[r] + wg1 * xg[r + 1]) + wg2 * xg[r + 2]) + bg;
            const float cv = ((wv0 * xv[r] + wv1 * xv[r + 1]) + wv2 * xv[r + 2]) + bv;
            ACT[((size_t)pm * 256 + r) * D_FF + f] = (u16)(cvt_pk_bf16(cg * sigmoidf_(cg) * cv, 0.f) & 0xffffu);
        }
    }
}

constexpr int N_PHASES = 10;
__global__ void __launch_bounds__(NT, 2) hymba_fwd(Args args) {
    extern __shared__ __attribute__((aligned(16))) unsigned char lds_raw[];
    Frame F;
    F.lds = (LAS unsigned char*)lds_raw;
    F.tid = threadIdx.x; F.lane = F.tid & 63; F.wave = __builtin_amdgcn_readfirstlane(F.tid >> 6);
    F.G = gridDim.x; { const int bx = blockIdx.x; F.vcu = (F.G % 8 == 0) ? (bx % 8) * (F.G / 8) + bx / 8 : bx; }
    F.pa = &args;
    F.out = args.out; F.ws = args.ws;
    volatile LAS unsigned* MISC = (volatile LAS unsigned*)(F.lds + MISC_OFF);
    if (F.tid < 32) MISC[F.tid] = 0u;
    __syncthreads();
    const int lo = args.ph_lo, hi = args.ph_hi;
    unsigned* ctl = (unsigned*)(F.ws + WS_CTL);
    XcdBarrier bar; bar.bar = ctl + CW_BAR; bar.x = 0; bar.st = nullptr;
    if (hi - lo > 1) bar = xcd_barrier_post(ctl + CW_BAR, MISC + 8);
#ifndef PHASE_MASK
#define PHASE_MASK 0x3FF
#endif
#define IN(k) (((PHASE_MASK >> (k)) & 1) && lo <= (k) && (k) < hi)
#ifndef DUP_MASK
#define DUP_MASK 0
#endif
#define REP(k) _Pragma("unroll 1") for (int rep_ = 0; rep_ < 1 + ((DUP_MASK >> (k)) & 1); ++rep_)
#define SEAM(k) do { if (IN(k) && IN((k) + 1)) xcd_barrier(bar); } while (0)
#define MOD ((float*)(wsp + WS_MOD))
#define H ((u16*)(wsp + WS_H))

    if (IN(0)) { unsigned char* wsp = F.ws; asm volatile("" : "+s"(wsp)); { int t_ = threadIdx.x; asm volatile("" : "+v"(t_)); F.tid = t_; F.lane = t_ & 63; F.wave = __builtin_amdgcn_readfirstlane(t_ >> 6); } REP(0) p0_prologue(F); SEAM(0); }
    if (IN(1)) { unsigned char* wsp = F.ws; asm volatile("" : "+s"(wsp)); { int t_ = threadIdx.x; asm volatile("" : "+v"(t_)); F.tid = t_; F.lane = t_ & 63; F.wave = __builtin_amdgcn_readfirstlane(t_ >> 6); } REP(1) rownorm_phase<true>(F, F.x(), F.norm1_g(), MOD + 0, MOD + 1024, H); SEAM(1); }
    if (IN(2)) { unsigned char* wsp = F.ws; asm volatile("" : "+s"(wsp)); { int t_ = threadIdx.x; asm volatile("" : "+v"(t_)); F.tid = t_; F.lane = t_ & 63; F.wave = __builtin_amdgcn_readfirstlane(t_ >> 6); }
        pg8::Gemm g{H, (const u16*)(wsp + WS_WIN), M_TOK, N_IN, D_MODEL}; pg8::StaticOrder S; S.init(M_TOK, N_IN, F.G, (int)blockIdx.x);
        pg8::EpiInProj E{(float*)(wsp + WS_QF), (u16*)(wsp + WS_KB), (u16*)(wsp + WS_VT), (u16*)(wsp + WS_XR), (u16*)(wsp + WS_GG), (float*)(wsp + WS_KM), F.q_norm_g(), F.k_norm_g()};
        REP(2) pg8::gemm_phase<pg8::EpiInProj, pg8::StaticOrder, true, true, true>(F.lds, g, S, E);
        SEAM(2);
    }
    if (IN(3)) { unsigned char* wsp = F.ws; asm volatile("" : "+s"(wsp)); { int t_ = threadIdx.x; asm volatile("" : "+v"(t_)); F.tid = t_; F.lane = t_ & 63; F.wave = __builtin_amdgcn_readfirstlane(t_ >> 6); } REP(3) attn_phase(F); REP(13) lru_phase<false>(F); SEAM(3); }
    if (IN(4)) { unsigned char* wsp = F.ws; asm volatile("" : "+s"(wsp)); { int t_ = threadIdx.x; asm volatile("" : "+v"(t_)); F.tid = t_; F.lane = t_ & 63; F.wave = __builtin_amdgcn_readfirstlane(t_ >> 6); } REP(4) lru_phase<true>(F); SEAM(4); }
    if (IN(5)) { unsigned char* wsp = F.ws; asm volatile("" : "+s"(wsp)); { int t_ = threadIdx.x; asm volatile("" : "+v"(t_)); F.tid = t_; F.lane = t_ & 63; F.wave = __builtin_amdgcn_readfirstlane(t_ >> 6); } REP(5) mix_phase(F); SEAM(5); }
    if (IN(6)) { unsigned char* wsp = F.ws; asm volatile("" : "+s"(wsp)); { int t_ = threadIdx.x; asm volatile("" : "+v"(t_)); F.tid = t_; F.lane = t_ & 63; F.wave = __builtin_amdgcn_readfirstlane(t_ >> 6); }
        pg8::Gemm g{(const u16*)(wsp + WS_MIX), (const u16*)(wsp + WS_WO), M_TOK, D_MODEL, D_MODEL}; pg8::StaticOrder S; S.init(M_TOK, D_MODEL, F.G, (int)blockIdx.x);
        pg8::EpiResid E{F.x(), F.out, MOD + 2048};
        REP(6) pg8::gemm_phase<pg8::EpiResid, pg8::StaticOrder, true, true, false>(F.lds, g, S, E);
        SEAM(6);
    }
    if (IN(7)) { unsigned char* wsp = F.ws; asm volatile("" : "+s"(wsp)); { int t_ = threadIdx.x; asm volatile("" : "+v"(t_)); F.tid = t_; F.lane = t_ & 63; F.wave = __builtin_amdgcn_readfirstlane(t_ >> 6); } REP(7) rownorm_phase<false>(F, F.out, F.norm2_g(), MOD + 3072, MOD + 4096, H); SEAM(7); }
    if (IN(8)) { unsigned char* wsp = F.ws; asm volatile("" : "+s"(wsp)); { int t_ = threadIdx.x; asm volatile("" : "+v"(t_)); F.tid = t_; F.lane = t_ & 63; F.wave = __builtin_amdgcn_readfirstlane(t_ >> 6); }
        pg8::Gemm g{H, (const u16*)(wsp + WS_WUP), M_TOK, N_UP, D_MODEL}; pg8::StaticOrder S; S.init(M_TOK, N_UP, F.G, (int)blockIdx.x);
        pg8::EpiFFN E{(u16*)(wsp + WS_ACT), (float*)(wsp + WS_RAW), F.ffn_conv_w(), F.ffn_conv_b(), (LAS float*)(F.lds + XB_OFF)};
        pg8::gemm_phase<pg8::EpiFFN, pg8::StaticOrder, true, true, false>(F.lds, g, S, E);
        SEAM(8);
    }
    if (IN(9)) { unsigned char* wsp = F.ws; asm volatile("" : "+s"(wsp)); { int t_ = threadIdx.x; asm volatile("" : "+v"(t_)); F.tid = t_; F.lane = t_ & 63; F.wave = __builtin_amdgcn_readfirstlane(t_ >> 6); }
        pg8::Gemm g{(const u16*)(wsp + WS_ACT), (const u16*)(wsp + WS_WDN), M_TOK, D_MODEL, D_FF}; pg8::StaticOrder S; S.init(M_TOK, D_MODEL, F.G, (int)blockIdx.x);
        { pg8::Unit u0, u1; int pm0 = -1; if (S.next(0, u0)) { pm0 = u0.pm; ffn_fixup(F, wsp, pm0); } if (S.next(1, u1) && u1.pm != pm0) ffn_fixup(F, wsp, u1.pm);
          for (int i = 2; ; ++i) { pg8::Unit ux; if (!S.next(i, ux)) break; ffn_fixup(F, wsp, ux.pm); }
          asm volatile("s_waitcnt vmcnt(0)" ::: "memory"); __syncthreads(); }
        pg8::EpiResid E{F.out, F.out, MOD + 5120};
        pg8::gemm_phase<pg8::EpiResid, pg8::StaticOrder, true, true, false>(F.lds, g, S, E);
    }
    if (hi - lo > 1 && hi == N_PHASES) {
        if (xb_ld(ctl + CW_BAR + XB_TMO) != 0u) { asm volatile("s_waitcnt vmcnt(0)" ::: "memory"); __syncthreads();
            for (size_t i = (size_t)blockIdx.x * NT + F.tid; i < (size_t)M_TOK * D_MODEL; i += (size_t)F.G * NT) F.out[i] = __builtin_nanf(""); }
    }
#undef IN
#undef MOD
#undef H
#undef SEAM
}

#ifndef MK_PER_PHASE
#define MK_PER_PHASE 0
#endif
extern "C" void kernel_launch(void* const* d_in, const int* in_sizes, int n_in, void* d_out, int out_size, void* d_ws, size_t ws_size, hipStream_t stream) {
    static int grid = 0;
    if (grid == 0) {
        if (n_in != 23 || in_sizes[0] != M_TOK * D_MODEL || out_size != M_TOK * D_MODEL || ws_size < WS_END) {
            fprintf(stderr, "kernel_launch: unexpected shapes (n_in %d, in0 %d, out %d, ws %zu); nothing launched\n", n_in, n_in > 0 ? in_sizes[0] : -1, out_size, ws_size); grid = -1; return; }
        int dev = 0, cus = 0;
        if (hipGetDevice(&dev) != hipSuccess || hipDeviceGetAttribute(&cus, hipDeviceAttributeMultiprocessorCount, dev) != hipSuccess) { grid = -1; return; }
        if (hipFuncSetAttribute((const void*)hymba_fwd, hipFuncAttributeMaxDynamicSharedMemorySize, LDS_BYTES) != hipSuccess) { fprintf(stderr, "kernel_launch: hipFuncSetAttribute failed\n"); grid = -1; return; }
        grid = cus;
    }
    if (grid < 0) return;
    (void)hipMemsetAsync((char*)d_ws + WS_CTL, 0, CTL_ZERO_BYTES, stream);
    Args a{};
    for (int i = 0; i < 23; ++i) a.in[i] = (const float*)d_in[i];
    a.out = (float*)d_out; a.ws = (unsigned char*)d_ws;
#if MK_PER_PHASE
    for (int p = 0; p < N_PHASES; ++p) { a.ph_lo = p; a.ph_hi = p + 1; hipLaunchKernelGGL(hymba_fwd, dim3(grid), dim3(NT), LDS_BYTES, stream, a); }
#else
    a.ph_lo = 0; a.ph_hi = N_PHASES; hipLaunchKernelGGL(hymba_fwd, dim3(grid), dim3(NT), LDS_BYTES, stream, a);
#endif
}
```

```cpp
#include <hip/hip_runtime.h>
#include <cstdio>
#include <cstdint>

#define GAS __attribute__((address_space(1)))
#define LAS __attribute__((address_space(3)))
typedef unsigned short u16;
typedef short s16x8 __attribute__((ext_vector_type(8)));
typedef _Float16 f16x8 __attribute__((ext_vector_type(8)));
typedef __bf16 bf16x8_t __attribute__((ext_vector_type(8)));
typedef float f32x2 __attribute__((ext_vector_type(2)));
typedef float f32x4 __attribute__((ext_vector_type(4)));
typedef float f32x16 __attribute__((ext_vector_type(16)));
typedef unsigned u32x4 __attribute__((ext_vector_type(4)));
typedef unsigned u32x2 __attribute__((ext_vector_type(2)));
typedef GAS unsigned gu32;
#define RLX_AGENT __ATOMIC_RELAXED, __HIP_MEMORY_SCOPE_AGENT

constexpr int D_MODEL = 1024, BATCH = 4, SEQ = 8192, M_TOK = BATCH * SEQ;
constexpr int N_IN = 2560, D_FF = 2816, N_UP = 2 * D_FF, N_MOD = 6 * D_MODEL;
constexpr int NHEAD = 8, HD = 64, AW = 512, NBLK = 32, BLK = 256;
constexpr float EPS = 1e-6f;
constexpr float LOG2E = 1.4426950408889634f;

__device__ __forceinline__ unsigned cvt_pk_bf16(float lo, float hi) { unsigned r; asm volatile("v_cvt_pk_bf16_f32 %0, %1, %2" : "=v"(r) : "v"(lo), "v"(hi)); return r; }
__device__ __forceinline__ unsigned cvt_pk_f16(float lo, float hi) {
    const _Float16 a = (_Float16)lo, b = (_Float16)hi;
    return (unsigned)__builtin_bit_cast(unsigned short, a) | ((unsigned)__builtin_bit_cast(unsigned short, b) << 16);
}
__device__ __forceinline__ float bf_lo(unsigned w) { return __builtin_bit_cast(float, w << 16); }
__device__ __forceinline__ float bf_hi(unsigned w) { return __builtin_bit_cast(float, w & 0xffff0000u); }
__device__ __forceinline__ float sigmoidf_(float v) { return __builtin_amdgcn_rcpf(1.0f + __builtin_amdgcn_exp2f(-v * LOG2E)); }
__device__ __forceinline__ float gelu_tanh(float v) { const float y = 0.7978845608028654f * (v + 0.044715f * v * v * v); return v * sigmoidf_(2.0f * y); }
__device__ __forceinline__ float wave_sum(float v) {
#pragma unroll
    for (int o = 1; o < 64; o <<= 1) v += __shfl_xor(v, o);
    return v;
}

__device__ __forceinline__ int lane_id() { int l; asm volatile("v_mbcnt_lo_u32_b32 %0, -1, 0\n\tv_mbcnt_hi_u32_b32 %0, -1, %0" : "=v"(l)); return l; }

namespace pg8 {
constexpr int BM = 256, BK = 64, HALF = 128, HTB = HALF * BK * 2, STAGE_BYTES = 8 * HTB, NXCD = 8, WGM = 8;
__host__ __device__ __forceinline__ int lds_byte(int r, int c) { const int st = (r >> 4) * 2 + (c >> 5), rr = r & 15, cc = c & 31, ob = rr * 64 + cc * 2; return st * 1024 + (ob ^ (((ob >> 9) & 1) << 5)); }
__host__ __device__ __forceinline__ void stage_rc(int b, int& R, int& C) { const int st = b / 1024, sb = b % 1024, swz = sb ^ (((sb >> 9) & 1) << 5); R = (st >> 1) * 16 + swz / 64; C = (st & 1) * 32 + (swz % 64) / 2; }
__host__ __device__ __forceinline__ int perm32(int rho) { const int n = rho >> 4, i = rho & 15; return 8 * (i >> 2) + 4 * n + (i & 3); }

struct Unit { int pm, pn; };
struct Gemm { const u16* A; const u16* Bt; int M, N, K; size_t bstride; };

struct StaticOrder {
    int nM, nN, nwg, G, c;
    __host__ __device__ __forceinline__ void init(int M, int N, int G_, int c_) { nM = M / BM; nN = N / BM; nwg = nM * nN; G = G_; c = c_; }
    __host__ __device__ __forceinline__ bool next(int i, Unit& u) const {
        const long L = (long)i * G + c; if (L >= nwg) return false;
        int wgid = (int)L; { const int q = nwg / NXCD, r = nwg % NXCD, xcd = wgid % NXCD, off = wgid / NXCD; wgid = (xcd < r ? xcd * (q + 1) : r * (q + 1) + (xcd - r) * q) + off; }
        const int nig = WGM * nN, gid = wgid / nig, fm = gid * WGM, gsz = (nM - fm) < WGM ? (nM - fm) : WGM;
        u.pm = fm + ((wgid % nig) % gsz); u.pn = (wgid % nig) / gsz; return true;
    }
    __device__ __forceinline__ void a_ready(const Unit&) const {}
    __device__ __forceinline__ void done(const Unit&) const {}
};

template <bool F16> __device__ __forceinline__ f32x4 mfma16(s16x8 a, s16x8 b, f32x4 c) {
    if constexpr (F16) return __builtin_amdgcn_mfma_f32_16x16x32_f16(__builtin_bit_cast(f16x8, a), __builtin_bit_cast(f16x8, b), c, 0, 0, 0);
    else return __builtin_amdgcn_mfma_f32_16x16x32_bf16(__builtin_bit_cast(bf16x8_t, a), __builtin_bit_cast(bf16x8_t, b), c, 0, 0, 0);
}

template <class Epi, class Sched, bool ALIGN_EPI, bool SP2, bool F16>
__device__ __forceinline__ void gemm_phase(LAS unsigned char* lds, const Gemm g, const Sched& S, const Epi& E, int wave0) {
    int tid_ = wave0 * 64 + lane_id(); asm volatile("" : "+v"(tid_));
    const int tid = tid_, wid = __builtin_amdgcn_readfirstlane(tid >> 6), lane = tid & 63, wr = wid >> 2, wc = wid & 3, fr = lane & 15, fq = lane >> 4;
    const int K = g.K, nt = K / BK;
    unsigned voffA, voffB;
    { int R, C; stage_rc(tid * 16, R, C); const int Rb = Epi::PERM ? ((R & ~31) + perm32(R & 31)) : R;
        voffA = (unsigned)(R * K + C) * 2u; voffB = (unsigned)(Rb * K + C) * 2u; }
    const unsigned rstep64 = (unsigned)(64 * K * 2);
    const size_t kstep = (size_t)(BK * 2);
    const size_t hstep = (size_t)HALF * K * 2;
    const size_t tstep = 2 * hstep;
    const unsigned ldsw = (unsigned)wid * 1024u;
    const int aoff = lds_byte(wr * 64 + fr, fq * 8), boff = lds_byte(wc * 32 + fr, fq * 8);
#define PG8_SA(b, h) (((b) * 2 + (h)) * HTB)
#define PG8_SB(b, h) ((4 + (b) * 2 + (h)) * HTB)
#define PG8_STAGE(bufoff, gbase, voff) do { _Pragma("unroll") for (int _i = 0; _i < 2; ++_i) \
        __builtin_amdgcn_global_load_lds((const unsigned*)((const char*)(gbase) + _i * rstep64 + (voff)), (LAS unsigned*)(lds + (bufoff) + ldsw + _i * 8192), 16, 0, 0); } while (0)
#define PG8_LDA(dst, b, h) do { _Pragma("unroll") for (int m = 0; m < 4; ++m) _Pragma("unroll") for (int k = 0; k < 2; ++k) dst[m][k] = *(const LAS s16x8*)(lds + PG8_SA(b, h) + aoff + m * 2048 + k * 1024); } while (0)
#define PG8_LDB(dst, b, h) do { _Pragma("unroll") for (int n = 0; n < 2; ++n) _Pragma("unroll") for (int k = 0; k < 2; ++k) dst[n][k] = *(const LAS s16x8*)(lds + PG8_SB(b, h) + boff + n * 2048 + k * 1024); } while (0)
#define PG8_MMA(ai, bj, At, Bt) do { __builtin_amdgcn_s_setprio(1); _Pragma("unroll") for (int m = 0; m < 4; ++m) _Pragma("unroll") for (int n = 0; n < 2; ++n) _Pragma("unroll") for (int k = 0; k < 2; ++k) \
        acc[ai][bj][m][n] = mfma16<F16>(Bt[n][k], At[m][k], acc[ai][bj][m][n]); __builtin_amdgcn_s_setprio(0); } while (0)
#define PG8_WAIT_V(n) asm volatile("s_waitcnt vmcnt(" #n ")" ::: "memory")
#define PG8_WAIT_L(n) asm volatile("s_waitcnt lgkmcnt(" #n ")" ::: "memory")
#define PG8_BAR __builtin_amdgcn_s_barrier()
#define PG8_SCHED __builtin_amdgcn_sched_barrier(0)
    Unit cur, nxt; int ui = 0;
    if (!S.next(0, cur)) return;
    f32x4 acc[2][2][4][2];
#pragma unroll
    for (int a = 0; a < 2; ++a)
#pragma unroll
        for (int b = 0; b < 2; ++b)
#pragma unroll
            for (int m = 0; m < 4; ++m)
#pragma unroll
                for (int n = 0; n < 2; ++n) acc[a][b][m][n] = (f32x4){0.f, 0.f, 0.f, 0.f};
    s16x8 At[4][2], B0[2][2], B1[2][2];
    const char* cA = (const char*)g.A + (size_t)cur.pm * tstep; const char* cB = (const char*)g.Bt + (size_t)cur.pn * tstep + (size_t)(cur.pm >> 5) * g.bstride;
    S.a_ready(cur);
    if constexpr (SP2) {
        PG8_STAGE(PG8_SB(0, 0), cB, voffB); PG8_STAGE(PG8_SB(0, 1), cB + hstep, voffB); PG8_STAGE(PG8_SA(0, 0), cA, voffA); PG8_STAGE(PG8_SA(0, 1), cA + hstep, voffA);
        if (wr == 1) PG8_BAR;
        PG8_WAIT_V(2); PG8_BAR;
        PG8_STAGE(PG8_SB(1, 0), cB + kstep, voffB); PG8_STAGE(PG8_SA(1, 0), cA + kstep, voffA); PG8_STAGE(PG8_SB(1, 1), cB + hstep + kstep, voffB);
        PG8_WAIT_V(6); PG8_BAR;
    } else {
        PG8_STAGE(PG8_SB(0, 0), cB, voffB); PG8_STAGE(PG8_SA(0, 0), cA, voffA); PG8_STAGE(PG8_SB(0, 1), cB + hstep, voffB); PG8_STAGE(PG8_SA(0, 1), cA + hstep, voffA);
        if (wr == 1) PG8_BAR;
        PG8_WAIT_V(4); PG8_BAR;
        PG8_STAGE(PG8_SB(1, 0), cB + kstep, voffB); PG8_STAGE(PG8_SA(1, 0), cA + kstep, voffA); PG8_STAGE(PG8_SB(1, 1), cB + hstep + kstep, voffB);
        PG8_WAIT_V(6); PG8_BAR;
    }
    for (;;) {
        const bool has_next = S.next(ui + 1, nxt);
        const char* nA = has_next ? (const char*)g.A + (size_t)nxt.pm * tstep : cA; const char* nB = has_next ? (const char*)g.Bt + (size_t)nxt.pn * tstep + (size_t)(nxt.pm >> 5) * g.bstride : cB;
        for (int t = 0; t < nt; t += 2) {
            const bool last = (t == nt - 2);
            const char* a1 = cA + (size_t)(t + 1) * kstep;
            const char* a2 = last ? nA : cA + (size_t)(t + 2) * kstep; const char* b2 = last ? nB : cB + (size_t)(t + 2) * kstep;
            const char* a3 = a2 + kstep; const char* b3 = b2 + kstep;
            if (last && has_next) S.a_ready(nxt);
            if constexpr (Epi::MIDK) { if (t == nt / 2) E.midk(acc, cur, wr, fr); }
            if constexpr (SP2) {
            PG8_LDB(B0, 0, 0); PG8_LDB(B1, 0, 1); PG8_SCHED; PG8_LDA(At, 0, 0); PG8_STAGE(PG8_SA(1, 1), a1 + hstep, voffA);
            PG8_WAIT_V(8); PG8_WAIT_L(0); PG8_BAR; PG8_MMA(0, 0, At, B0); PG8_MMA(0, 1, At, B1); PG8_BAR; PG8_SCHED;
            PG8_LDA(At, 0, 1); PG8_STAGE(PG8_SB(0, 0), b2, voffB); PG8_STAGE(PG8_SB(0, 1), b2 + hstep, voffB); PG8_STAGE(PG8_SA(0, 0), a2, voffA);
            PG8_WAIT_V(8); PG8_WAIT_L(0); PG8_BAR; PG8_MMA(1, 0, At, B0); PG8_MMA(1, 1, At, B1); PG8_BAR; PG8_SCHED;
            PG8_LDB(B0, 1, 0); PG8_LDB(B1, 1, 1); PG8_SCHED; PG8_LDA(At, 1, 0); PG8_STAGE(PG8_SA(0, 1), a2 + hstep, voffA);
            PG8_WAIT_V(8); PG8_WAIT_L(0); PG8_BAR; PG8_MMA(0, 0, At, B0); PG8_MMA(0, 1, At, B1); PG8_BAR; PG8_SCHED;
            PG8_LDA(At, 1, 1); PG8_STAGE(PG8_SB(1, 0), b3, voffB); PG8_STAGE(PG8_SB(1, 1), b3 + hstep, voffB); PG8_STAGE(PG8_SA(1, 0), a3, voffA);
            PG8_WAIT_V(8); PG8_WAIT_L(0); PG8_BAR; PG8_MMA(1, 0, At, B0); PG8_MMA(1, 1, At, B1); PG8_BAR; PG8_SCHED;
            } else {
            PG8_LDB(B0, 0, 0); PG8_SCHED; PG8_LDA(At, 0, 0); PG8_STAGE(PG8_SA(1, 1), a1 + hstep, voffA);
            PG8_WAIT_L(8); PG8_BAR; PG8_WAIT_L(0); PG8_MMA(0, 0, At, B0); PG8_BAR; PG8_SCHED;
            PG8_LDB(B1, 0, 1); PG8_STAGE(PG8_SB(0, 0), b2, voffB);
            PG8_BAR; PG8_WAIT_L(0); PG8_MMA(0, 1, At, B1); PG8_BAR;
            PG8_LDA(At, 0, 1); PG8_STAGE(PG8_SA(0, 0), a2, voffA);
            PG8_BAR; PG8_WAIT_L(0); PG8_MMA(1, 0, At, B0); PG8_BAR; PG8_SCHED;
            PG8_STAGE(PG8_SB(0, 1), b2 + hstep, voffB);
            PG8_WAIT_V(6); PG8_BAR; PG8_MMA(1, 1, At, B1); PG8_BAR;
            PG8_LDB(B0, 1, 0); PG8_SCHED; PG8_LDA(At, 1, 0); PG8_STAGE(PG8_SA(0, 1), a2 + hstep, voffA);
            PG8_WAIT_L(8); PG8_BAR; PG8_WAIT_L(0); PG8_MMA(0, 0, At, B0); PG8_BAR; PG8_SCHED;
            PG8_LDB(B1, 1, 1); PG8_STAGE(PG8_SB(1, 0), b3, voffB);
            PG8_BAR; PG8_WAIT_L(0); PG8_MMA(0, 1, At, B1); PG8_BAR;
            PG8_LDA(At, 1, 1); PG8_STAGE(PG8_SA(1, 0), a3, voffA);
            PG8_BAR; PG8_WAIT_L(0); PG8_MMA(1, 0, At, B0); PG8_BAR; PG8_SCHED;
            PG8_STAGE(PG8_SB(1, 1), b3 + hstep, voffB);
            PG8_WAIT_V(6); PG8_BAR; PG8_MMA(1, 1, At, B1); PG8_BAR;
            }
        }
        if constexpr (ALIGN_EPI) { if (wr == 0) PG8_BAR; }
        E(acc, cur, wr, wc, fr, fq); S.done(cur);
        if (!has_next) break;
#pragma unroll
        for (int a = 0; a < 2; ++a)
#pragma unroll
            for (int b = 0; b < 2; ++b)
#pragma unroll
                for (int m = 0; m < 4; ++m)
#pragma unroll
                    for (int n = 0; n < 2; ++n) acc[a][b][m][n] = (f32x4){0.f, 0.f, 0.f, 0.f};
        cur = nxt; cA = nA; cB = nB; ++ui;
        if constexpr (ALIGN_EPI) { if (wr == 1) PG8_BAR; }
    }
    PG8_WAIT_V(0);
    if constexpr (!ALIGN_EPI) { if (wr == 0) PG8_BAR; }
    PG8_BAR;
#undef PG8_SA
#undef PG8_SB
#undef PG8_STAGE
#undef PG8_LDA
#undef PG8_LDB
#undef PG8_MMA
#undef PG8_WAIT_V
#undef PG8_WAIT_L
#undef PG8_BAR
#undef PG8_SCHED
}

struct EpiBf16 {
    static constexpr bool PERM = true, MIDK = false;
    u16* O; int ldc;
    __device__ __forceinline__ void operator()(const f32x4 (&acc)[2][2][4][2], const Unit& u, int wr, int wc, int fr, int fq) const {
        const int row0 = u.pm * BM + wr * 64 + fr; const int col0 = u.pn * BM + wc * 32 + 8 * fq;
#pragma unroll
        for (int ai = 0; ai < 2; ++ai)
#pragma unroll
            for (int m = 0; m < 4; ++m) { u16* rowp = O + (size_t)(row0 + ai * HALF + m * 16) * ldc + col0;
#pragma unroll
                for (int bj = 0; bj < 2; ++bj) { const f32x4 v0 = acc[ai][bj][m][0], v1 = acc[ai][bj][m][1];
                    u32x4 w; w.x = cvt_pk_bf16(v0[0], v0[1]); w.y = cvt_pk_bf16(v0[2], v0[3]); w.z = cvt_pk_bf16(v1[0], v1[1]); w.w = cvt_pk_bf16(v1[2], v1[3]);
                    *(u32x4*)(rowp + bj * HALF) = w; } }
    }
};
struct EpiResid {
    static constexpr bool PERM = false, MIDK = false;
    const float* base; float* out; const float* gate;
    __device__ __forceinline__ void operator()(const f32x4 (&acc)[2][2][4][2], const Unit& u, int wr, int wc, int fr, int fq) const {
        const int row0 = u.pm * BM + wr * 64 + fr, col0 = u.pn * BM + wc * 32 + 4 * fq;
        const int b = (u.pm * BM) / SEQ;
        f32x4 gv[2][2];
#pragma unroll
        for (int bj = 0; bj < 2; ++bj)
#pragma unroll
            for (int n = 0; n < 2; ++n) gv[bj][n] = *(const f32x4*)(gate + (size_t)b * N_MOD + col0 + bj * HALF + n * 16);
#pragma unroll
        for (int ai = 0; ai < 2; ++ai)
#pragma unroll
            for (int m = 0; m < 4; ++m) { const size_t off = (size_t)(row0 + ai * HALF + m * 16) * D_MODEL + col0;
#pragma unroll
                for (int bj = 0; bj < 2; ++bj)
#pragma unroll
                    for (int n = 0; n < 2; ++n) { const f32x4 bs = *(const f32x4*)(base + off + bj * HALF + n * 16);
                        *(f32x4*)(out + off + bj * HALF + n * 16) = bs + gv[bj][n] * acc[ai][bj][m][n]; } }
    }
};
struct EpiInProj {
    static constexpr bool PERM = true, MIDK = false;
    float* QF; u16* KB; u16* VT; u16* XR; u16* GG; float* KM; const float* gq; const float* gk;
    __device__ __forceinline__ void operator()(const f32x4 (&acc)[2][2][4][2], const Unit& u, int wr, int wc, int fr, int fq) const {
        const int type = u.pn >> 1, head = (u.pn & 1) * 4 + wc;
        const int b = (u.pm * BM) / SEQ, blk = u.pm % NBLK;
        const int tok0 = u.pm * BM + wr * 64 + fr;
        const int bh = b * NHEAD + head;
        if (type <= 1) {
            const float* gp = type == 0 ? gq : gk;
            f32x4 gv[2][2];
#pragma unroll
            for (int bj = 0; bj < 2; ++bj)
#pragma unroll
                for (int n = 0; n < 2; ++n) gv[bj][n] = *(const f32x4*)(gp + 32 * bj + 8 * fq + 4 * n);
            f32x4 cs[2][2];
#pragma unroll
            for (int bj = 0; bj < 2; ++bj)
#pragma unroll
                for (int n = 0; n < 2; ++n) cs[bj][n] = (f32x4){0.f, 0.f, 0.f, 0.f};
#pragma unroll
            for (int ai = 0; ai < 2; ++ai)
#pragma unroll
                for (int m = 0; m < 4; ++m) {
                    float ss = 0.f;
#pragma unroll
                    for (int bj = 0; bj < 2; ++bj)
#pragma unroll
                        for (int n = 0; n < 2; ++n) { const f32x4 x = acc[ai][bj][m][n]; ss += (x[0] * x[0] + x[1] * x[1]) + (x[2] * x[2] + x[3] * x[3]); }
                    ss += __shfl_xor(ss, 16); ss += __shfl_xor(ss, 32);
                    const float rstd = 1.0f / sqrtf(ss * (1.0f / 64.0f) + EPS);
                    const int tok = tok0 + ai * HALF + m * 16, s = tok % SEQ;
                    const size_t rowoff = ((size_t)bh * SEQ + s) * HD + 8 * fq;
#pragma unroll
                    for (int bj = 0; bj < 2; ++bj) {
                        const f32x4 v0 = acc[ai][bj][m][0] * rstd * gv[bj][0], v1 = acc[ai][bj][m][1] * rstd * gv[bj][1];
                        if (type == 0) { *(f32x4*)(QF + rowoff + 32 * bj) = v0; *(f32x4*)(QF + rowoff + 32 * bj + 4) = v1; }
                        else { u32x4 w; w.x = cvt_pk_bf16(v0[0], v0[1]); w.y = cvt_pk_bf16(v0[2], v0[3]); w.z = cvt_pk_bf16(v1[0], v1[1]); w.w = cvt_pk_bf16(v1[2], v1[3]);
                            const int kw = s & 255, c8 = 4 * bj + fq;
                            *(u32x4*)(KB + ((size_t)bh * NBLK + blk) * (BLK * HD) + ((((kw >> 5) * 4 + (c8 >> 1)) * 2 + (c8 & 1)) * 32 + (kw & 31)) * 8) = w; cs[bj][0] += v0; cs[bj][1] += v1; }
                    }
                }
            if (type == 1) {
#pragma unroll
                for (int bj = 0; bj < 2; ++bj)
#pragma unroll
                    for (int n = 0; n < 2; ++n)
#pragma unroll
                        for (int i = 0; i < 4; ++i) { float v = cs[bj][n][i]; v += __shfl_xor(v, 1); v += __shfl_xor(v, 2); v += __shfl_xor(v, 4); v += __shfl_xor(v, 8);
                            if (fr == 0) atomicAdd(KM + (((size_t)(b * NBLK + blk) * NHEAD + head) * HD + 32 * bj + 8 * fq + 4 * n + i), v); }
            }
        } else if (type == 2) {
            const int hip = (fr >> 2) & 1, ep = 4 * (fr >> 3) + (fr & 3);
#pragma unroll
            for (int ai = 0; ai < 2; ++ai)
#pragma unroll
                for (int m = 0; m < 4; ++m) { const int kw = ai * HALF + wr * 64 + m * 16 + fr;
#pragma unroll
                    for (int bj = 0; bj < 2; ++bj)
#pragma unroll
                        for (int n = 0; n < 2; ++n) { const f32x4 x = acc[ai][bj][m][n]; const unsigned w0 = cvt_pk_bf16(x[0], x[1]), w1 = cvt_pk_bf16(x[2], x[3]);
                            u16* dst = VT + ((size_t)bh * NBLK + blk) * (BLK * HD) + (((((kw >> 5) * 2 + ((kw >> 4) & 1)) * 2 + bj) * 2 + hip) * 32 + 8 * fq + 4 * n) * 8 + ep;
                            dst[0] = (u16)(w0 & 0xffffu); dst[8] = (u16)(w0 >> 16); dst[16] = (u16)(w1 & 0xffffu); dst[24] = (u16)(w1 >> 16); } }
        } else {
            u16* O = type == 3 ? XR : GG;
#pragma unroll
            for (int ai = 0; ai < 2; ++ai)
#pragma unroll
                for (int m = 0; m < 4; ++m) { const int tok = tok0 + ai * HALF + m * 16; u16* rowp = O + (size_t)tok * AW + head * HD + 8 * fq;
#pragma unroll
                    for (int bj = 0; bj < 2; ++bj) { f32x4 v0 = acc[ai][bj][m][0], v1 = acc[ai][bj][m][1];
                        if (type == 4) {
#pragma unroll
                            for (int i = 0; i < 4; ++i) { v0[i] = gelu_tanh(v0[i]); v1[i] = gelu_tanh(v1[i]); } }
                        u32x4 w; w.x = cvt_pk_bf16(v0[0], v0[1]); w.y = cvt_pk_bf16(v0[2], v0[3]); w.z = cvt_pk_bf16(v1[0], v1[1]); w.w = cvt_pk_bf16(v1[2], v1[3]);
                        *(u32x4*)(rowp + 32 * bj) = w; } }
        }
    }
};

__device__ __forceinline__ float dpp_f(float old, float x, int ctrl) {
    return 0.f; }
#define DPPF(old, x, ctrl) __builtin_bit_cast(float, __builtin_amdgcn_update_dpp(__builtin_bit_cast(int, (float)(old)), __builtin_bit_cast(int, (float)(x)), (ctrl), 0xf, 0xf, false))
struct EpiFFN {
    static constexpr bool PERM = true, MIDK = false;
    u16* ACT; float* RAW; const float* cw; const float* CB2; LAS float* XB; const float* SSQX; const float* BIAS2;
    __device__ __forceinline__ void operator()(const f32x4 (&acc)[2][2][4][2], const Unit& u, int wr, int wc, int fr_, int fq_) const {
        int fr = fr_, fq = fq_; asm volatile("" : "+v"(fr), "+v"(fq));
        const int f0 = u.pn * 128 + wc * 32 + 8 * fq;
        const int b = (u.pm * BM) / SEQ;
        LAS float* R2S = XB + 2048;
        { const int t = (wr * 4 + wc) * 64 + fq * 16 + fr;
          if (t < 256) { const size_t row = (size_t)u.pm * BM + t;
              const f32x4 s0 = *(const f32x4*)(SSQX + row * 16), s1 = *(const f32x4*)(SSQX + row * 16 + 4), s2 = *(const f32x4*)(SSQX + row * 16 + 8), s3 = *(const f32x4*)(SSQX + row * 16 + 12);
              const float ss = (((s0[0] + s0[1]) + (s0[2] + s0[3])) + ((s1[0] + s1[1]) + (s1[2] + s1[3]))) + (((s2[0] + s2[1]) + (s2[2] + s2[3])) + ((s3[0] + s3[1]) + (s3[2] + s3[3])));
              R2S[t] = 1.0f / sqrtf(ss * (1.0f / D_MODEL) + EPS); } }
        asm volatile("s_waitcnt lgkmcnt(0)" ::: "memory"); __builtin_amdgcn_s_barrier(); asm volatile("" ::: "memory");
#define R2(ai, m) (R2S[(ai) * HALF + wr * 64 + (m) * 16 + fr])
#define BBP(kc, bj, n) (*(const f32x4*)(BIAS2 + ((size_t)(kc) * BATCH + b) * N_UP + (bj) * D_FF + f0 + 4 * (n)))
#define BBV(bj, n) ((BBP(0, bj, n) + BBP(1, bj, n)) + (BBP(2, bj, n) + BBP(3, bj, n)))
#define UPV(ai, bj, m, n) (acc[ai][bj][m][n] * r2v[ai][m])
        if (fr >= 14) {
#pragma unroll
            for (int ai = 0; ai < 2; ++ai)
#pragma unroll
                for (int bj = 0; bj < 2; ++bj)
#pragma unroll
                    for (int n = 0; n < 2; ++n) *(LAS f32x4*)(XB + (((((ai * 2 + wr) * 4 + wc) * 2 + (fr - 14)) * 4 + fq) * 16 + (bj * 2 + n) * 4)) = acc[ai][bj][3][n] * R2(ai, 3);
        }
        if (wr == 1 && fr >= 14) {
#pragma unroll
            for (int bj = 0; bj < 2; ++bj)
#pragma unroll
                for (int n = 0; n < 2; ++n) *(f32x4*)(RAW + ((size_t)u.pm * 4 + 2 + (fr - 14)) * N_UP + bj * D_FF + f0 + 4 * n) = acc[1][bj][3][n] * R2(1, 3) + BBV(bj, n);
        }
        if (wr == 0 && fr < 2) {
#pragma unroll
            for (int bj = 0; bj < 2; ++bj)
#pragma unroll
                for (int n = 0; n < 2; ++n) *(f32x4*)(RAW + ((size_t)u.pm * 4 + fr) * N_UP + bj * D_FF + f0 + 4 * n) = acc[0][bj][0][n] * R2(0, 0) + BBV(bj, n);
        }
        asm volatile("s_waitcnt lgkmcnt(0)" ::: "memory"); __builtin_amdgcn_s_barrier(); asm volatile("" ::: "memory");
#pragma unroll
        for (int n = 0; n < 2; ++n) {
            const f32x4 wg0 = *(const f32x4*)(cw + f0 + 4 * n), wg1 = *(const f32x4*)(cw + N_UP + f0 + 4 * n), wg2 = *(const f32x4*)(cw + 2 * N_UP + f0 + 4 * n);
            const f32x4 wv0 = *(const f32x4*)(cw + D_FF + f0 + 4 * n), wv1 = *(const f32x4*)(cw + N_UP + D_FF + f0 + 4 * n), wv2 = *(const f32x4*)(cw + 2 * N_UP + D_FF + f0 + 4 * n);
            const f32x4 bg = *(const f32x4*)(CB2 + (size_t)b * N_UP + f0 + 4 * n), bv = *(const f32x4*)(CB2 + (size_t)b * N_UP + D_FF + f0 + 4 * n);
#pragma unroll
            for (int ai = 0; ai < 2; ++ai) {
                float r2v[2][4];
#pragma unroll
                for (int m = 0; m < 4; ++m) r2v[ai][m] = R2(ai, m);
                const bool hasprev = (wr == 1) || (ai == 1);
                const int src = (wr == 1) ? (ai * 2 + 0) : ((ai - 1) * 2 + 1);
                f32x4 t1g = (f32x4){0.f, 0.f, 0.f, 0.f}, t2g = t1g, t1v = t1g, t2v = t1g;
                if (hasprev) {
                    const LAS float* xb1 = XB + ((((src * 4 + wc) * 2 + 1) * 4 + fq) * 16);
                    const LAS float* xb2 = XB + ((((src * 4 + wc) * 2 + (fr == 0 ? 0 : 1)) * 4 + fq) * 16);
                    t1g = *(const LAS f32x4*)(xb1 + (0 * 2 + n) * 4); t1v = *(const LAS f32x4*)(xb1 + (1 * 2 + n) * 4);
                    t2g = *(const LAS f32x4*)(xb2 + (0 * 2 + n) * 4); t2v = *(const LAS f32x4*)(xb2 + (1 * 2 + n) * 4);
                }
#pragma unroll
                for (int m = 0; m < 4; ++m) {
                    const f32x4 xg = UPV(ai, 0, m, n), xv = UPV(ai, 1, m, n);
                    if (m > 0) {
                        const f32x4 pg = UPV(ai, 0, m - 1, n), pv = UPV(ai, 1, m - 1, n);
#pragma unroll
                        for (int i = 0; i < 4; ++i) { t1g[i] = DPPF(0.f, pg[i], 0x121); t2g[i] = DPPF(0.f, pg[i], 0x122); t1v[i] = DPPF(0.f, pv[i], 0x121); t2v[i] = DPPF(0.f, pv[i], 0x122); }
                    }
                    float o[4];
#pragma unroll
                    for (int i = 0; i < 4; ++i) {
                        const float g1 = DPPF(t1g[i], xg[i], 0x111), g2 = DPPF(t2g[i], xg[i], 0x112);
                        const float v1 = DPPF(t1v[i], xv[i], 0x111), v2 = DPPF(t2v[i], xv[i], 0x112);
                        const float cg = ((wg0[i] * g2 + wg1[i] * g1) + wg2[i] * xg[i]) + bg[i];
                        const float cv = ((wv0[i] * v2 + wv1[i] * v1) + wv2[i] * xv[i]) + bv[i];
                        o[i] = cg * sigmoidf_(cg) * cv;
                    }
                    if (!(ai == 0 && m == 0 && wr == 0 && fr < 2)) { u32x2 w; w.x = cvt_pk_bf16(o[0], o[1]); w.y = cvt_pk_bf16(o[2], o[3]);
                        *(u32x2*)(ACT + (size_t)(u.pm * BM + ai * HALF + wr * 64 + m * 16 + fr) * D_FF + f0 + 4 * n) = w; }
                    __builtin_amdgcn_sched_barrier(0);
                }
            }
        }
    }
};

struct EpiOut {
    static constexpr bool PERM = true, MIDK = true;
    const float* base; u16* X1B; float* SSQX; const float* gate; const float* SSQL; const float* SSQA;
    __device__ __forceinline__ void rstd(int row, float& rl, float& ra) const {
        const f32x4 s0 = *(const f32x4*)(SSQL + (size_t)row * 8), s1 = *(const f32x4*)(SSQL + (size_t)row * 8 + 4);
        const f32x4 t0 = *(const f32x4*)(SSQA + (size_t)row * 8), t1 = *(const f32x4*)(SSQA + (size_t)row * 8 + 4);
        const float ssl = ((s0[0] + s0[1]) + (s0[2] + s0[3])) + ((s1[0] + s1[1]) + (s1[2] + s1[3]));
        const float ssa = ((t0[0] + t0[1]) + (t0[2] + t0[3])) + ((t1[0] + t1[1]) + (t1[2] + t1[3]));
        rl = 1.0f / sqrtf(ssl * (1.0f / AW) + EPS); ra = 1.0f / sqrtf(ssa * (1.0f / AW) + EPS);
    }
    __device__ __forceinline__ void midk(f32x4 (&acc)[2][2][4][2], const Unit& u, int wr, int fr) const {
#pragma unroll
        for (int ai = 0; ai < 2; ++ai)
#pragma unroll
            for (int m = 0; m < 4; ++m) { float rl, ra; rstd(u.pm * BM + ai * HALF + wr * 64 + m * 16 + fr, rl, ra); const float ratio = rl / ra;
#pragma unroll
                for (int bj = 0; bj < 2; ++bj)
#pragma unroll
                    for (int n = 0; n < 2; ++n) acc[ai][bj][m][n] *= ratio; }
    }
    __device__ __forceinline__ void operator()(const f32x4 (&acc)[2][2][4][2], const Unit& u, int wr, int wc, int fr, int fq) const {
        const int row0 = u.pm * BM + wr * 64 + fr, col0 = u.pn * BM + wc * 32 + 8 * fq;
        const int b = (u.pm * BM) / SEQ;
        f32x4 gv[2][2];
#pragma unroll
        for (int bj = 0; bj < 2; ++bj)
#pragma unroll
            for (int n = 0; n < 2; ++n) gv[bj][n] = *(const f32x4*)(gate + (size_t)b * N_MOD + col0 + bj * HALF + n * 4);
#pragma unroll
        for (int ai = 0; ai < 2; ++ai)
#pragma unroll
            for (int m = 0; m < 4; ++m) { const int row = row0 + ai * HALF + m * 16; const size_t off = (size_t)row * D_MODEL + col0;
                float rl, ra; rstd(row, rl, ra);
                float ss = 0.f;
#pragma unroll
                for (int bj = 0; bj < 2; ++bj) {
                    const f32x4 x0 = *(const f32x4*)(base + off + bj * HALF) + gv[bj][0] * (acc[ai][bj][m][0] * ra);
                    const f32x4 x1 = *(const f32x4*)(base + off + bj * HALF + 4) + gv[bj][1] * (acc[ai][bj][m][1] * ra);
                    ss += ((x0[0] * x0[0] + x0[1] * x0[1]) + (x0[2] * x0[2] + x0[3] * x0[3])) + ((x1[0] * x1[0] + x1[1] * x1[1]) + (x1[2] * x1[2] + x1[3] * x1[3]));
                    u32x4 w; w.x = cvt_pk_bf16(x0[0], x0[1]); w.y = cvt_pk_bf16(x0[2], x0[3]); w.z = cvt_pk_bf16(x1[0], x1[1]); w.w = cvt_pk_bf16(x1[2], x1[3]);
                    *(u32x4*)(X1B + off + bj * HALF) = w; }
                ss += __shfl_xor(ss, 16); ss += __shfl_xor(ss, 32);
                if (fq == 0) SSQX[(size_t)row * 16 + u.pn * 4 + wc] = ss; }
    }
};

struct EpiResidB {
    static constexpr bool PERM = false, MIDK = false;
    const u16* base; float* out; const float* gate;
    __device__ __forceinline__ void operator()(const f32x4 (&acc)[2][2][4][2], const Unit& u, int wr, int wc, int fr, int fq) const {
        const int row0 = u.pm * BM + wr * 64 + fr, col0 = u.pn * BM + wc * 32 + 4 * fq;
        const int b = (u.pm * BM) / SEQ;
        f32x4 gv[2][2];
#pragma unroll
        for (int bj = 0; bj < 2; ++bj)
#pragma unroll
            for (int n = 0; n < 2; ++n) gv[bj][n] = *(const f32x4*)(gate + (size_t)b * N_MOD + col0 + bj * HALF + n * 16);
#pragma unroll
        for (int ai = 0; ai < 2; ++ai)
#pragma unroll
            for (int m = 0; m < 4; ++m) { const size_t off = (size_t)(row0 + ai * HALF + m * 16) * D_MODEL + col0;
#pragma unroll
                for (int bj = 0; bj < 2; ++bj)
#pragma unroll
                    for (int n = 0; n < 2; ++n) { const u32x2 xw = *(const u32x2*)(base + off + bj * HALF + n * 16);
                        const f32x4 bs = (f32x4){bf_lo(xw.x), bf_hi(xw.x), bf_lo(xw.y), bf_hi(xw.y)};
                        *(f32x4*)(out + off + bj * HALF + n * 16) = bs + gv[bj][n] * acc[ai][bj][m][n]; } }
    }
};
}
#ifndef ATT_DUP
#define ATT_DUP 0
#endif

constexpr size_t MiB = 1u << 20;
constexpr size_t WS_CTL = 0;
constexpr size_t WS_KM = 1 * MiB;
constexpr size_t CTL_ZERO_BYTES = 2 * MiB;
constexpr size_t WS_MOD = 2 * MiB;
constexpr size_t WS_WIN = 3 * MiB;
constexpr size_t WS_WO = 8 * MiB;
constexpr size_t WS_WUP = 10 * MiB;
constexpr size_t WS_WDN = 21 * MiB;
constexpr size_t WS_WA = 27 * MiB;
constexpr size_t WS_WX = 27 * MiB + 65536;
constexpr size_t WS_AGG = 28 * MiB;
constexpr size_t WS_SSQL = 29 * MiB;
constexpr size_t WS_SSQA = 30 * MiB;
constexpr size_t WS_H = 34 * MiB;
constexpr size_t WS_QF = 98 * MiB;
constexpr size_t WS_KB = 162 * MiB;
constexpr size_t WS_VT = 194 * MiB;
constexpr size_t WS_XR = 226 * MiB;
constexpr size_t WS_GG = 258 * MiB;
constexpr size_t WS_ATT = 288 * MiB;
constexpr size_t WS_LRU = 320 * MiB;
constexpr size_t WS_MIX = 352 * MiB;
constexpr size_t WS_RAW = 98 * MiB;
constexpr size_t WS_ACT = 272 * MiB;
constexpr size_t WS_WUP4 = 448 * MiB;
constexpr size_t WS_BIAS2 = 27 * MiB + 262144;
constexpr size_t WS_CB2 = 27 * MiB + 786432;
constexpr size_t WS_SSQX = 31 * MiB;
constexpr size_t WS_END = 492 * MiB;
constexpr int CW_BAR = 4096;

constexpr int RING_BYTES = 131072;
constexpr int MISC_OFF = 160 * 1024 - 256;
constexpr int XB_OFF = RING_BYTES;
constexpr int CLDS_OFF = RING_BYTES + 4096;
constexpr int LDS_BYTES = 160 * 1024;
constexpr int NT = 512, NWAVES = 8;

#define XB_TMO      128
#define XB_XCNT(j)  (256  + 64 * (j))
#define XB_XSUB(j)  (1280 + 64 * (j))
#define XB_XGEN(j)  (2304 + 64 * (j))
#define XB_TOP      3328
#define XB_TOPGEN   3392
#define XCD_BAR_WORDS 3456
#define XB_SPIN_CAP (1u << 18)
__device__ __forceinline__ unsigned xb_ld(unsigned* p)              { return __hip_atomic_load(p, __ATOMIC_RELAXED, __HIP_MEMORY_SCOPE_AGENT); }
__device__ __forceinline__ unsigned xb_add(unsigned* p, unsigned v) { return __hip_atomic_fetch_add(p, v, __ATOMIC_RELAXED, __HIP_MEMORY_SCOPE_AGENT); }
__device__ __forceinline__ unsigned xb_xcc_id() { return (unsigned)__builtin_amdgcn_s_getreg((3 << 11) | 20) & 0xFu; }
#define XB_SPIN(cond, bar) do { unsigned _sp = 0; while (cond) { __builtin_amdgcn_s_sleep(1); \
    if ((++_sp & 255u) == 0u) { if (xb_ld(&(bar)[XB_TMO])) break; if (_sp > XB_SPIN_CAP) { atomicAdd(&(bar)[XB_TMO], 1u); break; } } } } while (0)
struct XcdBarrier { unsigned* bar; unsigned x; volatile LAS unsigned* st; };
__device__ __forceinline__ XcdBarrier xcd_barrier_post(unsigned* bar, volatile LAS unsigned* st) {
    XcdBarrier b; b.bar = bar; b.x = xb_xcc_id(); b.st = st;
    if (threadIdx.x == 0) (void)xb_add(&bar[XB_XCNT(b.x)], 1u);
    return b;
}
__device__ __forceinline__ void xcd_barrier_complete(unsigned* bar, unsigned x, unsigned& nloc, unsigned& nx) {
    const unsigned G = gridDim.x * gridDim.y * gridDim.z;
    unsigned sum, cnt, mine, sp = 0u;
    for (;;) {
        sum = 0u; cnt = 0u; mine = 0u;
#pragma unroll
        for (unsigned j = 0; j < 16; ++j) { const unsigned c = xb_ld(&bar[XB_XCNT(j)]); sum += c; cnt += (c > 0u) ? 1u : 0u; mine = (j == x) ? c : mine; }
        if (sum == G) break;
        __builtin_amdgcn_s_sleep(1);
        if ((++sp & 255u) == 0u) { if (xb_ld(&bar[XB_TMO])) break; if (sp > XB_SPIN_CAP) { atomicAdd(&bar[XB_TMO], 1u); break; } }
    }
    nloc = mine > 0u ? mine : 1u; nx = cnt > 0u ? cnt : 1u;
}
__device__ __forceinline__ void xcd_barrier(const XcdBarrier& b, int tid) {
    asm volatile("s_waitcnt vmcnt(0)" ::: "memory");
    __syncthreads();
    if (tid == 0) {
        unsigned* bar = b.bar;
        __builtin_amdgcn_s_waitcnt(0);
        unsigned nloc = b.st[0], nx = b.st[1];
        if (nloc == 0u) { xcd_barrier_complete(bar, b.x, nloc, nx); b.st[0] = nloc; b.st[1] = nx; }
        const unsigned old = xb_add(&bar[XB_XSUB(b.x)], 1u);
        const unsigned gen = old / nloc;
        if (old + 1u == (gen + 1u) * nloc) {
            __builtin_amdgcn_fence(__ATOMIC_RELEASE, "agent");
            asm volatile("s_waitcnt vmcnt(0)" ::: "memory");
            const unsigned og = xb_add(&bar[XB_TOP], 1u);
            const unsigned tg = og / nx;
            if (og + 1u == (tg + 1u) * nx) xb_add(&bar[XB_TOPGEN], 1u);
            else XB_SPIN(xb_ld(&bar[XB_TOPGEN]) == tg, bar);
            __builtin_amdgcn_fence(__ATOMIC_ACQUIRE, "agent");
            xb_add(&bar[XB_XGEN(b.x)], 1u);
            asm volatile("s_waitcnt vmcnt(0)" ::: "memory");
        } else {
            XB_SPIN(xb_ld(&bar[XB_XGEN(b.x)]) == gen, bar);
            __builtin_amdgcn_fence(__ATOMIC_ACQUIRE, "agent");
            asm volatile("s_waitcnt vmcnt(0)" ::: "memory");
        }
    }
    __syncthreads();
}

struct Args { const float* in[23]; float* out; unsigned char* ws; int ph_lo, ph_hi; };
struct Frame {
    LAS unsigned char* lds;
    int tid, lane, wave, vcu, G, wave0;
    const Args* pa;
    __device__ __forceinline__ const float* x() const { return pa->in[0]; }
    __device__ __forceinline__ const float* c() const { return pa->in[1]; }
    __device__ __forceinline__ const float* w_ada() const { return pa->in[2]; }
    __device__ __forceinline__ const float* b_ada() const { return pa->in[3]; }
    __device__ __forceinline__ const float* norm1_g() const { return pa->in[4]; }
    __device__ __forceinline__ const float* w_in() const { return pa->in[5]; }
    __device__ __forceinline__ const float* q_norm_g() const { return pa->in[6]; }
    __device__ __forceinline__ const float* k_norm_g() const { return pa->in[7]; }
    __device__ __forceinline__ const float* lru_conv_w() const { return pa->in[8]; }
    __device__ __forceinline__ const float* lru_conv_b() const { return pa->in[9]; }
    __device__ __forceinline__ const float* lru_wa() const { return pa->in[10]; }
    __device__ __forceinline__ const float* lru_ba() const { return pa->in[11]; }
    __device__ __forceinline__ const float* lru_wx() const { return pa->in[12]; }
    __device__ __forceinline__ const float* lru_bx() const { return pa->in[13]; }
    __device__ __forceinline__ const float* lru_lambda() const { return pa->in[14]; }
    __device__ __forceinline__ const float* lru_out_g() const { return pa->in[15]; }
    __device__ __forceinline__ const float* attn_out_g() const { return pa->in[16]; }
    __device__ __forceinline__ const float* w_out() const { return pa->in[17]; }
    __device__ __forceinline__ const float* norm2_g() const { return pa->in[18]; }
    __device__ __forceinline__ const float* w_up() const { return pa->in[19]; }
    __device__ __forceinline__ const float* ffn_conv_w() const { return pa->in[20]; }
    __device__ __forceinline__ const float* ffn_conv_b() const { return pa->in[21]; }
    __device__ __forceinline__ const float* w_down() const { return pa->in[22]; }
    float* out; unsigned char* ws;
};
#define LDS_WAIT() asm volatile("s_waitcnt lgkmcnt(0)" ::: "memory")

template <int MODE>
__device__ __forceinline__ void p0_transpose_item(const float* W, int K, int N, u16* WT, LAS float* scr, int item, int lane, const float* kscale = nullptr) {
    const int nblk = N / 32, kb = item / nblk, nb = item % nblk, k0 = 64 * kb, n0 = 32 * nb;
#pragma unroll 8
    for (int i = 0; i < 32; ++i) { const int kk = 2 * i + (lane >> 5); float w = W[(size_t)(k0 + kk) * N + n0 + (lane & 31)]; if (MODE == 3) w *= kscale[k0 + kk]; scr[kk * 33 + (lane & 31)] = w; }
    LDS_WAIT(); asm volatile("" ::: "memory");
    const int c = lane & 7;
#pragma unroll
    for (int j = 0; j < 4; ++j) { const int n = (lane >> 3) + 8 * j; const LAS float* s = scr + (8 * c) * 33 + n;
        u32x4 o;
        if (MODE == 1) { o.x = cvt_pk_f16(s[0 * 33], s[1 * 33]); o.y = cvt_pk_f16(s[2 * 33], s[3 * 33]); o.z = cvt_pk_f16(s[4 * 33], s[5 * 33]); o.w = cvt_pk_f16(s[6 * 33], s[7 * 33]); }
        else { o.x = cvt_pk_bf16(s[0 * 33], s[1 * 33]); o.y = cvt_pk_bf16(s[2 * 33], s[3 * 33]); o.z = cvt_pk_bf16(s[4 * 33], s[5 * 33]); o.w = cvt_pk_bf16(s[6 * 33], s[7 * 33]); }
        int nn = n0 + n;
        if (MODE == 1) nn = (nn & ~255) + 128 * ((nn >> 5) & 1) + 32 * ((nn >> 6) & 3) + (nn & 31);
        if (MODE == 2) { const int bj = nn >= D_FF ? 1 : 0, f = nn - bj * D_FF; nn = 256 * (f >> 7) + 128 * bj + (f & 127); }
        *(GAS u32x4*)(WT + (size_t)nn * K + k0 + 8 * c) = o; }
    LDS_WAIT(); asm volatile("" ::: "memory");
}
__device__ __forceinline__ void p0_prologue(Frame& F) {
    unsigned char* wsp = F.ws; asm volatile("" : "+s"(wsp));
    LAS float* cl = (LAS float*)(F.lds + CLDS_OFF);
    for (int i = F.tid; i < BATCH * D_MODEL; i += NT) cl[i] = F.c()[i];
    __syncthreads();
    LAS float* scr = (LAS float*)(F.lds + F.wave * 16384);
    const int gw = F.wave * F.G + F.vcu, NGW = F.G * NWAVES;
    constexpr int I_MOD = N_MOD / 64;
    constexpr int I_IN = (D_MODEL / 64) * (N_IN / 32), I_O = (D_MODEL / 64) * (D_MODEL / 32), I_DN = (D_FF / 64) * (D_MODEL / 32), I_L = 8 * 2;
    constexpr int NITEMS = I_MOD + I_IN + I_O + I_DN + 2 * I_L;
    u16* WinT = (u16*)(wsp + WS_WIN); u16* WoT = (u16*)(wsp + WS_WO); u16* WdT = (u16*)(wsp + WS_WDN);
    u16* WaT = (u16*)(wsp + WS_WA); u16* WxT = (u16*)(wsp + WS_WX);
    float* MOD = (float*)(wsp + WS_MOD);
    for (int it = gw; it < NITEMS; it += NGW) {
        int r = it;
        if (r < I_MOD) {
            const int col = r * 64 + F.lane; float a0 = 0.f, a1 = 0.f, a2 = 0.f, a3 = 0.f;
            const float* wp = F.w_ada() + col;
#pragma unroll 8
            for (int k = 0; k < D_MODEL; ++k) { const float w = wp[(size_t)k * N_MOD];
                a0 += cl[k] * w; a1 += cl[D_MODEL + k] * w; a2 += cl[2 * D_MODEL + k] * w; a3 += cl[3 * D_MODEL + k] * w; }
            const float bb = F.b_ada()[col];
            MOD[col] = a0 + bb; MOD[N_MOD + col] = a1 + bb; MOD[2 * N_MOD + col] = a2 + bb; MOD[3 * N_MOD + col] = a3 + bb;
            continue; }
        r -= I_MOD;
        if (r < I_IN) { p0_transpose_item<1>(F.w_in(), D_MODEL, N_IN, WinT, scr, r, F.lane); continue; } r -= I_IN;
        if (r < I_O) { const int kb = r / (D_MODEL / 32); p0_transpose_item<3>(F.w_out(), D_MODEL, D_MODEL, WoT, scr, r, F.lane, (kb < 8 ? F.lru_out_g() : F.attn_out_g() - AW)); continue; } r -= I_O;

        if (r < I_DN) { p0_transpose_item<0>(F.w_down(), D_FF, D_MODEL, WdT, scr, r, F.lane); continue; } r -= I_DN;
        if (r < I_L) { const int h = r >> 1; p0_transpose_item<0>(F.lru_wa() + h * 4096, 64, 64, WaT + h * 4096, scr, r & 1, F.lane); continue; } r -= I_L;
        { const int h = r >> 1; p0_transpose_item<0>(F.lru_wx() + h * 4096, 64, 64, WxT + h * 4096, scr, r & 1, F.lane); }
    }
}


constexpr int SCL_OFF = RING_BYTES;
__device__ __forceinline__ void p1_upweights(Frame& F, unsigned char* wsp) {
    const float* MODp = (const float*)(wsp + WS_MOD);
    LAS float* SC = (LAS float*)(F.lds + SCL_OFF);
#define SHB(b) ((LAS float*)(F.lds + 16384 * (b) + 8448))
    for (int i = F.tid; i < BATCH * D_MODEL; i += NT) { const int b = i >> 10, k = i & 1023; SC[i] = F.norm2_g()[k] * (1.0f + MODp[(size_t)b * N_MOD + 4096 + k]); SHB(b)[k] = MODp[(size_t)b * N_MOD + 3072 + k]; }
    __syncthreads();
    LAS float* scr = (LAS float*)(F.lds + F.wave * 16384);
    u16* W4 = (u16*)(wsp + WS_WUP4); float* BIAS2 = (float*)(wsp + WS_BIAS2);
    const float* W = F.w_up();
    const int gw = F.wave * F.G + F.vcu, NGW = F.G * NWAVES, lane = F.lane;
    for (int it = gw; it < 4 * (N_UP / 32); it += NGW) {
        const int n0 = 32 * (it >> 2), kc = it & 3;
        float bs0 = 0.f, bs1 = 0.f, bs2 = 0.f, bs3 = 0.f;
#pragma unroll 1
        for (int kb = 4 * kc; kb < 4 * kc + 4; ++kb) {
            const int k0 = 64 * kb;
#pragma unroll 8
            for (int i = 0; i < 32; ++i) { const int kk = 2 * i + (lane >> 5); scr[kk * 33 + (lane & 31)] = W[(size_t)(k0 + kk) * N_UP + n0 + (lane & 31)]; }
            LDS_WAIT(); asm volatile("" ::: "memory");
            { const int n = lane & 31, kh = lane >> 5;
#pragma unroll 8
              for (int kk = 0; kk < 32; ++kk) { const float w = scr[(32 * kh + kk) * 33 + n]; const int k = k0 + 32 * kh + kk;
                  bs0 += SHB(0)[k] * w; bs1 += SHB(1)[k] * w; bs2 += SHB(2)[k] * w; bs3 += SHB(3)[k] * w; } }
            const int c = lane & 7;
#pragma unroll
            for (int j = 0; j < 4; ++j) { const int n = (lane >> 3) + 8 * j; const LAS float* s = scr + (8 * c) * 33 + n;
                int nn = n0 + n; { const int bj = nn >= D_FF ? 1 : 0, f = nn - bj * D_FF; nn = 256 * (f >> 7) + 128 * bj + (f & 127); }
                float wv[8];
#pragma unroll
                for (int e = 0; e < 8; ++e) wv[e] = s[e * 33];
#pragma unroll
                for (int b = 0; b < BATCH; ++b) { const LAS float* sc = SC + b * 1024 + k0 + 8 * c;
                    u32x4 o; o.x = cvt_pk_bf16(wv[0] * sc[0], wv[1] * sc[1]); o.y = cvt_pk_bf16(wv[2] * sc[2], wv[3] * sc[3]); o.z = cvt_pk_bf16(wv[4] * sc[4], wv[5] * sc[5]); o.w = cvt_pk_bf16(wv[6] * sc[6], wv[7] * sc[7]);
                    *(GAS u32x4*)(W4 + ((size_t)b * N_UP + nn) * D_MODEL + k0 + 8 * c) = o; } }
            LDS_WAIT(); asm volatile("" ::: "memory");
        }
        bs0 += __shfl_xor(bs0, 32); bs1 += __shfl_xor(bs1, 32); bs2 += __shfl_xor(bs2, 32); bs3 += __shfl_xor(bs3, 32);
        if (lane < 32) { float* bp = BIAS2 + (size_t)kc * BATCH * N_UP + n0 + lane; bp[0] = bs0; bp[N_UP] = bs1; bp[2 * N_UP] = bs2; bp[3 * N_UP] = bs3; }
    }
}


__device__ __forceinline__ void cb2_prep(Frame& F, unsigned char* wsp) {
    const float* BIAS2 = (const float*)(wsp + WS_BIAS2); float* CB2 = (float*)(wsp + WS_CB2);
    const float* cw = F.ffn_conv_w(); const float* cb = F.ffn_conv_b();
    for (int i = F.vcu * NT + F.tid; i < BATCH * N_UP; i += F.G * NT) { const int b = i / N_UP, col = i % N_UP;
        const float bias = (BIAS2[(size_t)(0 * BATCH + b) * N_UP + col] + BIAS2[(size_t)(1 * BATCH + b) * N_UP + col]) + (BIAS2[(size_t)(2 * BATCH + b) * N_UP + col] + BIAS2[(size_t)(3 * BATCH + b) * N_UP + col]);
        CB2[i] = cb[col] + ((cw[col] + cw[N_UP + col]) + cw[2 * N_UP + col]) * bias; }
}

template <bool F16>
__device__ __forceinline__ void rownorm_phase(Frame& F, const float* X, const float* g, const float* sh, const float* sc, u16* O) {
    const int gw = F.vcu * NWAVES + F.wave, NGW = F.G * NWAVES;
    for (int m = gw; m < M_TOK; m += NGW) {
        const int b = m / SEQ;
        const GAS f32x4* xr = (const GAS f32x4*)(X + (size_t)m * D_MODEL) + F.lane;
        f32x4 v[4]; float s = 0.f;
#pragma unroll
        for (int j = 0; j < 4; ++j) { v[j] = xr[64 * j]; s += (v[j].x * v[j].x + v[j].y * v[j].y) + (v[j].z * v[j].z + v[j].w * v[j].w); }
        const float rstd = 1.0f / sqrtf(wave_sum(s) * (1.0f / D_MODEL) + EPS);
        GAS u32x2* o8 = (GAS u32x2*)(O + (size_t)m * D_MODEL) + F.lane;
#pragma unroll
        for (int j = 0; j < 4; ++j) {
            const int col = 4 * F.lane + 256 * j;
            const f32x4 gv = *(const f32x4*)(g + col), shv = *(const f32x4*)(sh + (size_t)b * N_MOD + col), scv = *(const f32x4*)(sc + (size_t)b * N_MOD + col);
            const f32x4 y = (v[j] * rstd) * gv * (scv + 1.0f) + shv;
            u32x2 w;
            if (F16) { w.x = cvt_pk_f16(y.x, y.y); w.y = cvt_pk_f16(y.z, y.w); } else { w.x = cvt_pk_bf16(y.x, y.y); w.y = cvt_pk_bf16(y.z, y.w); }
            o8[64 * j] = w; }
    }
}

__device__ __forceinline__ int crow(int r, int hi) { return (r & 3) + 8 * (r >> 2) + 4 * hi; }
constexpr int AL_QS = 0, AL_SLOT = 32768, AL_LSL = 131072, AL_LIST = 134144, AL_CNT = 150528, AL_MISC = 150656, AL_KMS = 150912;
__device__ __forceinline__ void attn_tile(const u16* Kp, const u16* Vp, const s16x8 (&qf)[4], int nkt, bool own, int tt, int qidx, int hi, float c1, float c2, f32x16& o0, f32x16& o1, float& lsum) {
#pragma unroll
    for (int r = 0; r < 16; ++r) { o0[r] = 0.f; o1[r] = 0.f; }
    lsum = 0.f;
    s16x8 kc[4], kn[4], vc[4];
#pragma unroll
    for (int s = 0; s < 4; ++s) { kc[s] = *(const GAS s16x8*)(Kp + s * 512); kn[s] = kc[s]; }
#pragma unroll 1
    for (int kt = 0; kt < nkt; ++kt) {
#pragma unroll
        for (int s = 0; s < 4; ++s) vc[s] = *(const GAS s16x8*)(Vp + (kt * 4 + s) * 512);
        if (kt + 1 < nkt) {
#pragma unroll
            for (int s = 0; s < 4; ++s) kn[s] = *(const GAS s16x8*)(Kp + ((kt + 1) * 4 + s) * 512);
        }
        f32x16 p;
#pragma unroll
        for (int r = 0; r < 16; ++r) p[r] = 0.f;
#pragma unroll
        for (int s = 0; s < 4; ++s) p = __builtin_amdgcn_mfma_f32_32x32x16_bf16(__builtin_bit_cast(bf16x8_t, kc[s]), __builtin_bit_cast(bf16x8_t, qf[s]), p, 0, 0, 0);
        const bool diag = own && (kt == tt);
#pragma unroll
        for (int r = 0; r < 16; ++r) { float e = __builtin_amdgcn_exp2f(p[r] * c1 - c2);
            if (diag && (32 * kt + crow(r, hi) > qidx)) e = 0.f;
            p[r] = e; lsum += e; }
#pragma unroll
        for (int s2 = 0; s2 < 2; ++s2) {
            u32x4 pw; pw.x = cvt_pk_bf16(p[8 * s2 + 0], p[8 * s2 + 1]); pw.y = cvt_pk_bf16(p[8 * s2 + 2], p[8 * s2 + 3]); pw.z = cvt_pk_bf16(p[8 * s2 + 4], p[8 * s2 + 5]); pw.w = cvt_pk_bf16(p[8 * s2 + 6], p[8 * s2 + 7]);
            const bf16x8_t pa = __builtin_bit_cast(bf16x8_t, pw);
            o0 = __builtin_amdgcn_mfma_f32_32x32x16_bf16(pa, __builtin_bit_cast(bf16x8_t, vc[2 * s2]), o0, 0, 0, 0);
            o1 = __builtin_amdgcn_mfma_f32_32x32x16_bf16(pa, __builtin_bit_cast(bf16x8_t, vc[2 * s2 + 1]), o1, 0, 0, 0);
        }
#pragma unroll
        for (int s = 0; s < 4; ++s) kc[s] = kn[s];
    }
}
__device__ __forceinline__ void attn_item(Frame& F, int bh, int i, float c1, float c2) {
    unsigned char* wsp = F.ws; asm volatile("" : "+s"(wsp));
    const float* QF = (const float*)(wsp + WS_QF); const u16* KB = (const u16*)(wsp + WS_KB); const u16* VT = (const u16*)(wsp + WS_VT);
    const float* KM = (const float*)(wsp + WS_KM); u16* ATT = (u16*)(wsp + WS_MIX); float* SSQA = (float*)(wsp + WS_SSQA);
    LAS u16* QS = (LAS u16*)(F.lds + AL_QS); LAS u16* SLOT = (LAS u16*)(F.lds + AL_SLOT); LAS float* LSL = (LAS float*)(F.lds + AL_LSL);
    LAS float* KMS = (LAS float*)(F.lds + AL_KMS); LAS u16* LIST = (LAS u16*)(F.lds + AL_LIST); LAS int* CNT = (LAS int*)(F.lds + AL_CNT);
    const int tid = F.tid, lane = F.lane, wave = F.wave, hi = lane >> 5, l31 = lane & 31;
    const int b = bh / NHEAD, h = bh % NHEAD;
    for (int u = tid; u < (3 * 32768 + 3072) / 16; u += NT) *(LAS u32x4*)(F.lds + AL_SLOT + u * 16) = (u32x4){0u, 0u, 0u, 0u};
    if (tid < 32) CNT[tid] = 0;
    for (int u = tid; u < NBLK * HD; u += NT) { const int n = u >> 6, d = u & 63; KMS[u] = KM[(((size_t)(b * NBLK + n)) * NHEAD + h) * HD + d] * (1.0f / 256.0f); }
    __syncthreads();
    {
        const int q = tid >> 1, half = tid & 1;
        const GAS f32x4* qrow = (const GAS f32x4*)(QF + ((size_t)bh * SEQ + (size_t)i * BLK + q) * HD);
        f32x4 qv[16];
#pragma unroll
        for (int d = 0; d < 16; ++d) qv[d] = qrow[d];
#pragma unroll
        for (int d = 0; d < 4; ++d) { const f32x4 a = qv[2 * d], c = qv[2 * d + 1], a2 = qv[8 + 2 * d], c2 = qv[8 + 2 * d + 1];
            u32x4 w, w2; w.x = cvt_pk_bf16(a.x, a.y); w.y = cvt_pk_bf16(a.z, a.w); w.z = cvt_pk_bf16(c.x, c.y); w.w = cvt_pk_bf16(c.z, c.w);
            w2.x = cvt_pk_bf16(a2.x, a2.y); w2.y = cvt_pk_bf16(a2.z, a2.w); w2.z = cvt_pk_bf16(c2.x, c2.y); w2.w = cvt_pk_bf16(c2.z, c2.w);
            if (half) w = w2;
            *(LAS u32x4*)(QS + q * 64 + 32 * half + 8 * d) = w; }
        float v0 = -INFINITY, v1 = -INFINITY, v2 = -INFINITY; int i0 = -1, i1 = -1, i2 = -1;
        for (int nn = 0; nn < 16; ++nn) {
            const int n = 16 * half + nn;
            const LAS f32x4* kr = (const LAS f32x4*)(KMS + n * 64);
            float g = 0.f;
#pragma unroll
            for (int d = 0; d < 16; ++d) { const f32x4 kv = kr[d]; g = fmaf(qv[d].x, kv.x, g); g = fmaf(qv[d].y, kv.y, g); g = fmaf(qv[d].z, kv.z, g); g = fmaf(qv[d].w, kv.w, g); }
            if (n >= i) g = -INFINITY;
            if (g > v0) { v2 = v1; i2 = i1; v1 = v0; i1 = i0; v0 = g; i0 = n; }
            else if (g > v1) { v2 = v1; i2 = i1; v1 = g; i1 = n; }
            else if (g > v2) { v2 = g; i2 = n; }
        }
        const float pv0 = __shfl_xor(v0, 1), pv1 = __shfl_xor(v1, 1), pv2 = __shfl_xor(v2, 1);
        const int pi0 = __shfl_xor(i0, 1), pi1 = __shfl_xor(i1, 1), pi2 = __shfl_xor(i2, 1);
        if (half == 0) {
            float av[3] = {v0, v1, v2}, bv[3] = {pv0, pv1, pv2}; int ai[3] = {i0, i1, i2}, bi[3] = {pi0, pi1, pi2};
            int sel[3]; int pa = 0, pb = 0;
#pragma unroll
            for (int k = 0; k < 3; ++k) {
                const float ca = pa == 0 ? av[0] : (pa == 1 ? av[1] : av[2]); const int cai = pa == 0 ? ai[0] : (pa == 1 ? ai[1] : ai[2]);
                const float cb = pb == 0 ? bv[0] : (pb == 1 ? bv[1] : bv[2]); const int cbi = pb == 0 ? bi[0] : (pb == 1 ? bi[1] : bi[2]);
                if (ca >= cb) { sel[k] = cai; ++pa; } else { sel[k] = cbi; ++pb; }
            }
#pragma unroll
            for (int k = 0; k < 3; ++k) if (sel[k] >= 0) { const int pos = __hip_atomic_fetch_add(&CNT[sel[k]], 1, __ATOMIC_RELAXED, __HIP_MEMORY_SCOPE_WORKGROUP); LIST[sel[k] * 256 + pos] = (u16)(q | (k << 8)); }
        }
    }
    __syncthreads();
    {
        int base = 0;
        for (int j = 0; j < i; ++j) {
            const int cntj = __builtin_amdgcn_readfirstlane(CNT[j]);
            const int ntj = (cntj + 31) >> 5;
            for (int t = base + ((wave - base) & 7); t < base + ntj; t += 8) {
                const int tt = t - base;
                const int ridx = 32 * tt + l31; const bool valid = ridx < cntj;
                const int ent = valid ? (int)LIST[j * 256 + ridx] : 0;
                const int qidx = ent & 255;
                s16x8 qf[4];
#pragma unroll
                for (int s = 0; s < 4; ++s) qf[s] = *(const LAS s16x8*)(QS + qidx * 64 + 16 * s + 8 * hi);
                const size_t boff = ((size_t)bh * NBLK + j) * (BLK * HD) + lane * 8;
                f32x16 o0, o1; float lsum;
                attn_tile(KB + boff, VT + boff, qf, 8, false, 0, qidx, hi, c1, c2, o0, o1, lsum);
                const int srow = valid ? ((ent >> 8) * 256 + qidx) : -1;
                lsum += __shfl_xor(lsum, 32);
                if (valid && hi == 0) LSL[srow] = lsum;
#pragma unroll
                for (int r = 0; r < 16; ++r) { const int sr = __shfl(srow, crow(r, hi));
                    if (sr >= 0) { const unsigned w = cvt_pk_bf16(o0[r], o1[r]); SLOT[sr * 64 + l31] = (u16)(w & 0xffffu); SLOT[sr * 64 + 32 + l31] = (u16)(w >> 16); }
                    if ((r & 3) == 3) asm volatile("" ::: "memory"); }
            }
            base += ntj;
        }
    }
    f32x16 oo0, oo1; float lown;
    {
        s16x8 qf[4];
#pragma unroll
        for (int s = 0; s < 4; ++s) qf[s] = *(const LAS s16x8*)(QS + (32 * wave + l31) * 64 + 16 * s + 8 * hi);
        const size_t boff = ((size_t)bh * NBLK + i) * (BLK * HD) + lane * 8;
        attn_tile(KB + boff, VT + boff, qf, wave + 1, true, wave, 32 * wave + l31, hi, c1, c2, oo0, oo1, lown);
    }
    __syncthreads();
    {
        const int q = 32 * wave + l31;
        float lt = lown + __shfl_xor(lown, 32);
        lt += LSL[q] + LSL[256 + q] + LSL[512 + q];
        const float inv = 1.0f / lt;
#pragma unroll
        for (int r = 0; r < 16; ++r) { const int rl = crow(r, hi), qq = 32 * wave + rl; const float iv = __shfl(inv, rl);
            float a = oo0[r], c = oo1[r];
#pragma unroll
            for (int k = 0; k < 3; ++k) { a += __builtin_bit_cast(float, (unsigned)SLOT[(k * 256 + qq) * 64 + l31] << 16); c += __builtin_bit_cast(float, (unsigned)SLOT[(k * 256 + qq) * 64 + 32 + l31] << 16); }
            const unsigned w = cvt_pk_bf16(a * iv, c * iv);
            QS[qq * 64 + l31] = (u16)(w & 0xffffu); QS[qq * 64 + 32 + l31] = (u16)(w >> 16);
            if ((r & 3) == 3) asm volatile("" ::: "memory"); }
        LDS_WAIT(); asm volatile("" ::: "memory");
#pragma unroll
        for (int it = 0; it < 4; ++it) { const int c = lane + 64 * it, row = c >> 3, ch = c & 7;
            const u32x4 w = *(const LAS u32x4*)(QS + (32 * wave + row) * 64 + 8 * ch);
            const size_t tok = (size_t)b * SEQ + (size_t)i * BLK + 32 * wave + row;
            *(GAS u32x4*)(ATT + tok * D_MODEL + AW + h * HD + 8 * ch) = w;
            float ss = bf_lo(w.x) * bf_lo(w.x) + bf_hi(w.x) * bf_hi(w.x) + bf_lo(w.y) * bf_lo(w.y) + bf_hi(w.y) * bf_hi(w.y) + bf_lo(w.z) * bf_lo(w.z) + bf_hi(w.z) * bf_hi(w.z) + bf_lo(w.w) * bf_lo(w.w) + bf_hi(w.w) * bf_hi(w.w);
            ss += __shfl_xor(ss, 1); ss += __shfl_xor(ss, 2); ss += __shfl_xor(ss, 4);
            if (ch == 0) SSQA[tok * NHEAD + h] = ss; }
    }
    __syncthreads();
}
__device__ __forceinline__ void attn_phase(Frame& F) {
    LAS float* mm = (LAS float*)(F.lds + AL_MISC);
    if (F.tid < 64) { float a = fabsf(F.q_norm_g()[F.tid]), c = fabsf(F.k_norm_g()[F.tid]);
#pragma unroll
        for (int o = 1; o < 64; o <<= 1) { a = fmaxf(a, __shfl_xor(a, o)); c = fmaxf(c, __shfl_xor(c, o)); }
        if (F.tid == 0) { mm[0] = a; mm[1] = c; } }
    __syncthreads();
    const float C = 8.0f * mm[0] * mm[1];
    const float c1 = 0.125f * LOG2E, c2 = C * LOG2E;
    __syncthreads();
    if (F.G == 256) {
        const int xcd = F.vcu >> 5, k = F.vcu & 31;
#pragma unroll 1
        for (int r = 0; r < 4; ++r) attn_item(F, xcd * 4 + r, (r & 1) ? 31 - k : k, c1, c2);
    } else {
        for (int it = F.vcu; it < BATCH * NHEAD * NBLK; it += F.G) attn_item(F, it >> 5, it & 31, c1, c2);
    }
}

constexpr int LL_CW = 0;
template <bool FINAL>
__device__ __forceinline__ void lru_item(Frame& F, int b, int chunk) {
    unsigned char* wsp = F.ws; asm volatile("" : "+s"(wsp));
    const u16* XR = (const u16*)(wsp + WS_XR); const u16* GG = (const u16*)(wsp + WS_GG);
    const u16* WaT = (const u16*)(wsp + WS_WA); const u16* WxT = (const u16*)(wsp + WS_WX);
    float* AGG = (float*)(wsp + WS_AGG); u16* LRU = (u16*)(wsp + WS_MIX); float* SSQL = (float*)(wsp + WS_SSQL);
    const int lane = F.lane, hd = F.wave, hi = lane >> 5, j = lane & 31;
    LAS float* CW = (LAS float*)(F.lds + LL_CW + hd * 1280);
    for (int u = lane; u < 320; u += 64) CW[u] = (u < 256) ? F.lru_conv_w()[(u >> 6) * AW + hd * HD + (u & 63)] : F.lru_conv_b()[hd * HD + (u - 256)];
    LDS_WAIT(); asm volatile("" ::: "memory");
    float ba[2], bx[2], sp8[2], carry[2], arun[2];
#pragma unroll
    for (int ct = 0; ct < 2; ++ct) { const int c = hd * HD + 32 * ct + j; ba[ct] = F.lru_ba()[c]; bx[ct] = F.lru_bx()[c];
        sp8[ct] = 8.0f * log1pf(expf(-F.lru_lambda()[c])); carry[ct] = 0.f; arun[ct] = 1.f;
        if (FINAL) { float hcar = 0.f; for (int cc = 0; cc < chunk; ++cc) { const f32x2 ah = *(const f32x2*)(AGG + (((size_t)(b * 64 + cc)) * AW + c) * 2); hcar = ah.x * hcar + ah.y; } carry[ct] = hcar; } }
    for (int tile = 0; tile < 4; ++tile) {
        const int t0 = chunk * 128 + tile * 32;
        const int pos = t0 + j;
        s16x8 af[4], gf[4];
#pragma unroll
        for (int s = 0; s < 4; ++s) {
            const int ch0 = 16 * s + 8 * hi;
            float xc[8];
            { const LAS f32x4* bp = (const LAS f32x4*)(CW + 256 + ch0); const f32x4 b0 = bp[0], b1 = bp[1];
              xc[0] = b0.x; xc[1] = b0.y; xc[2] = b0.z; xc[3] = b0.w; xc[4] = b1.x; xc[5] = b1.y; xc[6] = b1.z; xc[7] = b1.w; }
            float accv[8];
#pragma unroll
            for (int e = 0; e < 8; ++e) accv[e] = 0.f;
#pragma unroll
            for (int jj = 0; jj < 4; ++jj) {
                const int p = pos - 3 + jj;
                u32x4 xw = (u32x4){0u, 0u, 0u, 0u};
                if (p >= 0) xw = *(const GAS u32x4*)(XR + ((size_t)b * SEQ + p) * AW + hd * HD + ch0);
                const LAS f32x4* wp = (const LAS f32x4*)(CW + jj * 64 + ch0); const f32x4 w0 = wp[0], w1 = wp[1];
                accv[0] += w0.x * bf_lo(xw.x); accv[1] += w0.y * bf_hi(xw.x); accv[2] += w0.z * bf_lo(xw.y); accv[3] += w0.w * bf_hi(xw.y);
                accv[4] += w1.x * bf_lo(xw.z); accv[5] += w1.y * bf_hi(xw.z); accv[6] += w1.z * bf_lo(xw.w); accv[7] += w1.w * bf_hi(xw.w);
            }
#pragma unroll
            for (int e = 0; e < 8; ++e) xc[e] += accv[e];
            u32x4 aw; aw.x = cvt_pk_bf16(xc[0], xc[1]); aw.y = cvt_pk_bf16(xc[2], xc[3]); aw.z = cvt_pk_bf16(xc[4], xc[5]); aw.w = cvt_pk_bf16(xc[6], xc[7]);
            af[s] = __builtin_bit_cast(s16x8, aw);
            if (FINAL) gf[s] = *(const GAS s16x8*)(GG + ((size_t)b * SEQ + pos) * AW + hd * HD + ch0);
        }
        float ssacc[16];
#pragma unroll
        for (int r = 0; r < 16; ++r) ssacc[r] = 0.f;
#pragma unroll
        for (int ct = 0; ct < 2; ++ct) {
            f32x16 aA, aX, aI, aG;
#pragma unroll
            for (int r = 0; r < 16; ++r) { aA[r] = 0.f; aX[r] = 0.f; aI[r] = 0.f; aG[r] = 0.f; }
#pragma unroll
            for (int s = 0; s < 4; ++s) {
                const size_t woff = ((size_t)hd * 64 + 32 * ct + j) * 64 + 16 * s + 8 * hi;
                const s16x8 wa = *(const GAS s16x8*)(WaT + woff), wx = *(const GAS s16x8*)(WxT + woff);
                s16x8 id;
#pragma unroll
                for (int e = 0; e < 8; ++e) id[e] = (16 * s + 8 * hi + e == 32 * ct + j) ? (short)0x3F80 : (short)0;
                const bf16x8_t a = __builtin_bit_cast(bf16x8_t, af[s]);
                aA = __builtin_amdgcn_mfma_f32_32x32x16_bf16(a, __builtin_bit_cast(bf16x8_t, wa), aA, 0, 0, 0);
                aX = __builtin_amdgcn_mfma_f32_32x32x16_bf16(a, __builtin_bit_cast(bf16x8_t, wx), aX, 0, 0, 0);
                aI = __builtin_amdgcn_mfma_f32_32x32x16_bf16(a, __builtin_bit_cast(bf16x8_t, id), aI, 0, 0, 0);
                if (FINAL) aG = __builtin_amdgcn_mfma_f32_32x32x16_bf16(__builtin_bit_cast(bf16x8_t, gf[s]), __builtin_bit_cast(bf16x8_t, id), aG, 0, 0, 0);
            }
            float av[16], uv[16];
#pragma unroll
            for (int r = 0; r < 16; ++r) {
                const float rr = sigmoidf_(aA[r] + ba[ct]), ii = sigmoidf_(aX[r] + bx[ct]);
                const float la = -rr * sp8[ct];
                const float a = __builtin_amdgcn_exp2f(la * LOG2E);
                const float x2 = 2.0f * la;
                const float om = (x2 > -0.05f) ? -x2 * (1.0f + x2 * 0.5f * (1.0f + x2 * (1.0f / 3.0f) * (1.0f + x2 * 0.25f))) : 1.0f - a * a;
                av[r] = a; uv[r] = sqrtf(om) * (ii * aI[r]);
            }
            float Ag[4], Ug[4];
#pragma unroll
            for (int g = 0; g < 4; ++g) { float A = av[4 * g], U = uv[4 * g];
#pragma unroll
                for (int e = 1; e < 4; ++e) { A *= av[4 * g + e]; U = av[4 * g + e] * U + uv[4 * g + e]; }
                Ag[g] = A; Ug[g] = U; }
            float h = carry[ct], ap = arun[ct];
            float hin[4];
#pragma unroll
            for (int g = 0; g < 4; ++g) {
                const float pA = __shfl_xor(Ag[g], 32), pU = __shfl_xor(Ug[g], 32);
                const float fA = hi ? pA : Ag[g], fU = hi ? pU : Ug[g], sA = hi ? Ag[g] : pA, sU = hi ? Ug[g] : pU;
                const float h1 = fA * h + fU;
                hin[g] = hi ? h1 : h;
                h = sA * h1 + sU; ap *= fA * sA;
            }
            carry[ct] = h; arun[ct] = ap;
            if (FINAL) {
#pragma unroll
                for (int g = 0; g < 4; ++g) { float hh = hin[g];
#pragma unroll
                    for (int e = 0; e < 4; ++e) { const int r = 4 * g + e; hh = av[r] * hh + uv[r]; const float o = hh * aG[r]; ssacc[r] += o * o;
                        const size_t tok = (size_t)b * SEQ + t0 + crow(r, hi);
                        LRU[tok * D_MODEL + hd * HD + 32 * ct + j] = (u16)(cvt_pk_bf16(o, 0.f) & 0xffffu); } }
            }
        }
        if (FINAL) {
#pragma unroll
            for (int r = 0; r < 16; ++r) {
                const size_t tok = (size_t)b * SEQ + t0 + crow(r, hi);
                float ss = ssacc[r];
                ss += __shfl_xor(ss, 1); ss += __shfl_xor(ss, 2); ss += __shfl_xor(ss, 4); ss += __shfl_xor(ss, 8); ss += __shfl_xor(ss, 16);
                if (j == 0) SSQL[tok * NHEAD + hd] = ss;
            }
        }
    }
    if (!FINAL) { if (hi == 0) {
#pragma unroll
        for (int ct = 0; ct < 2; ++ct) { const int c = hd * HD + 32 * ct + j; *(f32x2*)(AGG + (((size_t)(b * 64 + chunk)) * AW + c) * 2) = (f32x2){arun[ct], carry[ct]}; } } }
}
template <bool FINAL>
__device__ __forceinline__ void lru_phase(Frame& F) {
    for (int it = F.vcu; it < BATCH * 64; it += F.G) { lru_item<FINAL>(F, it >> 6, it & 63); }
}

__device__ __forceinline__ void mix_phase(Frame& F) {
    unsigned char* wsp = F.ws; asm volatile("" : "+s"(wsp));
    const u16* LRU = (const u16*)(wsp + WS_LRU); const u16* ATT = (const u16*)(wsp + WS_ATT);
    const float* SSQL = (const float*)(wsp + WS_SSQL); const float* SSQA = (const float*)(wsp + WS_SSQA); u16* MIX = (u16*)(wsp + WS_MIX);
    const int gw = F.vcu * NWAVES + F.wave, NGW = F.G * NWAVES, lane = F.lane;
    const f32x4 gl0 = *(const f32x4*)(F.lru_out_g() + 8 * lane), gl1 = *(const f32x4*)(F.lru_out_g() + 8 * lane + 4);
    const f32x4 ga0 = *(const f32x4*)(F.attn_out_g() + 8 * lane), ga1 = *(const f32x4*)(F.attn_out_g() + 8 * lane + 4);
    for (int m = gw; m < M_TOK; m += NGW) {
        const f32x4 s0 = *(const GAS f32x4*)(SSQL + (size_t)m * 8), s1 = *(const GAS f32x4*)(SSQL + (size_t)m * 8 + 4);
        const f32x4 t0 = *(const GAS f32x4*)(SSQA + (size_t)m * 8), t1 = *(const GAS f32x4*)(SSQA + (size_t)m * 8 + 4);
        const float ssl = ((s0.x + s0.y) + (s0.z + s0.w)) + ((s1.x + s1.y) + (s1.z + s1.w));
        const float ssa = ((t0.x + t0.y) + (t0.z + t0.w)) + ((t1.x + t1.y) + (t1.z + t1.w));
        const float rl = 1.0f / sqrtf(ssl * (1.0f / AW) + EPS), ra = 1.0f / sqrtf(ssa * (1.0f / AW) + EPS);
        const u32x4 lw = *(const GAS u32x4*)(LRU + (size_t)m * AW + 8 * lane), aw = *(const GAS u32x4*)(ATT + (size_t)m * AW + 8 * lane);
        u32x4 o;
        o.x = cvt_pk_bf16(bf_lo(lw.x) * rl * gl0.x, bf_hi(lw.x) * rl * gl0.y); o.y = cvt_pk_bf16(bf_lo(lw.y) * rl * gl0.z, bf_hi(lw.y) * rl * gl0.w);
        o.z = cvt_pk_bf16(bf_lo(lw.z) * rl * gl1.x, bf_hi(lw.z) * rl * gl1.y); o.w = cvt_pk_bf16(bf_lo(lw.w) * rl * gl1.z, bf_hi(lw.w) * rl * gl1.w);
        *(GAS u32x4*)(MIX + (size_t)m * D_MODEL + 8 * lane) = o;
        o.x = cvt_pk_bf16(bf_lo(aw.x) * ra * ga0.x, bf_hi(aw.x) * ra * ga0.y); o.y = cvt_pk_bf16(bf_lo(aw.y) * ra * ga0.z, bf_hi(aw.y) * ra * ga0.w);
        o.z = cvt_pk_bf16(bf_lo(aw.z) * ra * ga1.x, bf_hi(aw.z) * ra * ga1.y); o.w = cvt_pk_bf16(bf_lo(aw.w) * ra * ga1.z, bf_hi(aw.w) * ra * ga1.w);
        *(GAS u32x4*)(MIX + (size_t)m * D_MODEL + AW + 8 * lane) = o;
    }
}

__device__ __forceinline__ void ffn_fixup(Frame& F, unsigned char* wsp, int pm) {
    const float* RAW = (const float*)(wsp + WS_RAW); u16* ACT = (u16*)(wsp + WS_ACT);
    const float* cw = F.ffn_conv_w(); const float* cb = F.ffn_conv_b();
    const bool first = (pm % NBLK) == 0;
    for (int f = F.tid; f < D_FF; f += NT) {
        float xg[4], xv[4];
        xg[0] = first ? 0.f : RAW[((size_t)(pm - 1) * 4 + 2) * N_UP + f]; xg[1] = first ? 0.f : RAW[((size_t)(pm - 1) * 4 + 3) * N_UP + f];
        xv[0] = first ? 0.f : RAW[((size_t)(pm - 1) * 4 + 2) * N_UP + D_FF + f]; xv[1] = first ? 0.f : RAW[((size_t)(pm - 1) * 4 + 3) * N_UP + D_FF + f];
        xg[2] = RAW[((size_t)pm * 4 + 0) * N_UP + f]; xg[3] = RAW[((size_t)pm * 4 + 1) * N_UP + f];
        xv[2] = RAW[((size_t)pm * 4 + 0) * N_UP + D_FF + f]; xv[3] = RAW[((size_t)pm * 4 + 1) * N_UP + D_FF + f];
        const float wg0 = cw[f], wg1 = cw[N_UP + f], wg2 = cw[2 * N_UP + f], bg = cb[f];
        const float wv0 = cw[D_FF + f], wv1 = cw[N_UP + D_FF + f], wv2 = cw[2 * N_UP + D_FF + f], bv = cb[D_FF + f];
#pragma unroll
        for (int r = 0; r < 2; ++r) {
            const float cg = ((wg0 * xg[r] + wg1 * xg[r + 1]) + wg2 * xg[r + 2]) + bg;
            const float cv = ((wv0 * xv[r] + wv1 * xv[r + 1]) + wv2 * xv[r + 2]) + bv;
            ACT[((size_t)pm * 256 + r) * D_FF + f] = (u16)(cvt_pk_bf16(cg * sigmoidf_(cg) * cv, 0.f) & 0xffffu);
        }
    }
}

constexpr int N_PHASES = 10;
__global__ void __launch_bounds__(NT, 2) hymba_fwd(Args args) {
    extern __shared__ __attribute__((aligned(16))) unsigned char lds_raw[];
    Frame F;
    F.lds = (LAS unsigned char*)lds_raw;
    F.tid = threadIdx.x; F.lane = F.tid & 63; F.wave = __builtin_amdgcn_readfirstlane(F.tid >> 6); F.wave0 = F.wave;
    F.G = gridDim.x; { const int bx = blockIdx.x; F.vcu = (F.G % 8 == 0) ? (bx % 8) * (F.G / 8) + bx / 8 : bx; }
    F.pa = &args;
    F.out = args.out; F.ws = args.ws;
    volatile LAS unsigned* MISC = (volatile LAS unsigned*)(F.lds + MISC_OFF);
    if (F.tid < 32) MISC[F.tid] = 0u;
    __syncthreads();
    const int lo = args.ph_lo, hi = args.ph_hi;
    unsigned* ctl = (unsigned*)(F.ws + WS_CTL);
    XcdBarrier bar; bar.bar = ctl + CW_BAR; bar.x = 0; bar.st = nullptr;
    if (hi - lo > 1) bar = xcd_barrier_post(ctl + CW_BAR, MISC + 8);
#ifndef PHASE_MASK
#define PHASE_MASK 0x3FF
#endif
#define IN(k) (((PHASE_MASK >> (k)) & 1) && lo <= (k) && (k) < hi)
#ifndef DUP_MASK
#define DUP_MASK 0
#endif
#define REP(k) _Pragma("unroll 1") for (int rep_ = 0; rep_ < 1 + ((DUP_MASK >> (k)) & 1); ++rep_)
#define SEAM(k) do { if (IN(k) && IN((k) + 1)) xcd_barrier(bar, F.wave0 * 64 + lane_id()); } while (0)
#define MOD ((float*)(wsp + WS_MOD))
#define H ((u16*)(wsp + WS_H))

    if (IN(0)) { unsigned char* wsp = F.ws; asm volatile("" : "+s"(wsp)); { int t_ = F.wave0 * 64 + lane_id(); asm volatile("" : "+v"(t_)); F.tid = t_; F.lane = t_ & 63; F.wave = __builtin_amdgcn_readfirstlane(t_ >> 6); } REP(0) p0_prologue(F); SEAM(0); }
    if (IN(1)) { unsigned char* wsp = F.ws; asm volatile("" : "+s"(wsp)); { int t_ = F.wave0 * 64 + lane_id(); asm volatile("" : "+v"(t_)); F.tid = t_; F.lane = t_ & 63; F.wave = __builtin_amdgcn_readfirstlane(t_ >> 6); } REP(1) { p1_upweights(F, wsp); rownorm_phase<true>(F, F.x(), F.norm1_g(), MOD + 0, MOD + 1024, H); } SEAM(1); }
    if (IN(2)) { unsigned char* wsp = F.ws; asm volatile("" : "+s"(wsp)); { int t_ = F.wave0 * 64 + lane_id(); asm volatile("" : "+v"(t_)); F.tid = t_; F.lane = t_ & 63; F.wave = __builtin_amdgcn_readfirstlane(t_ >> 6); }
        pg8::Gemm g{H, (const u16*)(wsp + WS_WIN), M_TOK, N_IN, D_MODEL, 0}; pg8::StaticOrder S; S.init(M_TOK, N_IN, F.G, (int)blockIdx.x);
        pg8::EpiInProj E{(float*)(wsp + WS_QF), (u16*)(wsp + WS_KB), (u16*)(wsp + WS_VT), (u16*)(wsp + WS_XR), (u16*)(wsp + WS_GG), (float*)(wsp + WS_KM), F.q_norm_g(), F.k_norm_g()};
        REP(2) pg8::gemm_phase<pg8::EpiInProj, pg8::StaticOrder, true, true, true>(F.lds, g, S, E, F.wave0);
        SEAM(2);
    }
    if (IN(3)) { unsigned char* wsp = F.ws; asm volatile("" : "+s"(wsp)); { int t_ = F.wave0 * 64 + lane_id(); asm volatile("" : "+v"(t_)); F.tid = t_; F.lane = t_ & 63; F.wave = __builtin_amdgcn_readfirstlane(t_ >> 6); } cb2_prep(F, wsp); REP(3) attn_phase(F); REP(13) lru_phase<false>(F); SEAM(3); }
    if (IN(4)) { unsigned char* wsp = F.ws; asm volatile("" : "+s"(wsp)); { int t_ = F.wave0 * 64 + lane_id(); asm volatile("" : "+v"(t_)); F.tid = t_; F.lane = t_ & 63; F.wave = __builtin_amdgcn_readfirstlane(t_ >> 6); } REP(4) lru_phase<true>(F); if (IN(4) && IN(6)) xcd_barrier(bar, F.wave0 * 64 + lane_id()); }
    if (IN(6)) { unsigned char* wsp = F.ws; asm volatile("" : "+s"(wsp)); { int t_ = F.wave0 * 64 + lane_id(); asm volatile("" : "+v"(t_)); F.tid = t_; F.lane = t_ & 63; F.wave = __builtin_amdgcn_readfirstlane(t_ >> 6); }
        pg8::Gemm g{(const u16*)(wsp + WS_MIX), (const u16*)(wsp + WS_WO), M_TOK, D_MODEL, D_MODEL, 0}; pg8::StaticOrder S; S.init(M_TOK, D_MODEL, F.G, (int)blockIdx.x);
        pg8::EpiOut E{F.x(), H, (float*)(wsp + WS_SSQX), MOD + 2048, (const float*)(wsp + WS_SSQL), (const float*)(wsp + WS_SSQA)};
        REP(6) pg8::gemm_phase<pg8::EpiOut, pg8::StaticOrder, true, true, false>(F.lds, g, S, E, F.wave0);
        if (IN(6) && IN(8)) xcd_barrier(bar, F.wave0 * 64 + lane_id());
    }
    if (IN(8)) { unsigned char* wsp = F.ws; asm volatile("" : "+s"(wsp)); { int t_ = F.wave0 * 64 + lane_id(); asm volatile("" : "+v"(t_)); F.tid = t_; F.lane = t_ & 63; F.wave = __builtin_amdgcn_readfirstlane(t_ >> 6); }
        pg8::Gemm g{H, (const u16*)(wsp + WS_WUP4), M_TOK, N_UP, D_MODEL, (size_t)N_UP * D_MODEL * 2}; pg8::StaticOrder S; S.init(M_TOK, N_UP, F.G, (int)blockIdx.x);
        pg8::EpiFFN E{(u16*)(wsp + WS_ACT), (float*)(wsp + WS_RAW), F.ffn_conv_w(), (const float*)(wsp + WS_CB2), (LAS float*)(F.lds + XB_OFF), (const float*)(wsp + WS_SSQX), (const float*)(wsp + WS_BIAS2)};
        REP(8) pg8::gemm_phase<pg8::EpiFFN, pg8::StaticOrder, true, true, false>(F.lds, g, S, E, F.wave0);
        SEAM(8);
    }
    if (IN(9)) { unsigned char* wsp = F.ws; asm volatile("" : "+s"(wsp)); { int t_ = F.wave0 * 64 + lane_id(); asm volatile("" : "+v"(t_)); F.tid = t_; F.lane = t_ & 63; F.wave = __builtin_amdgcn_readfirstlane(t_ >> 6); }
        pg8::Gemm g{(const u16*)(wsp + WS_ACT), (const u16*)(wsp + WS_WDN), M_TOK, D_MODEL, D_FF, 0}; pg8::StaticOrder S; S.init(M_TOK, D_MODEL, F.G, (int)blockIdx.x);
        { pg8::Unit u0, u1; int pm0 = -1; if (S.next(0, u0)) { pm0 = u0.pm; ffn_fixup(F, wsp, pm0); } if (S.next(1, u1) && u1.pm != pm0) ffn_fixup(F, wsp, u1.pm);
          for (int i = 2; ; ++i) { pg8::Unit ux; if (!S.next(i, ux)) break; ffn_fixup(F, wsp, ux.pm); }
          asm volatile("s_waitcnt vmcnt(0)" ::: "memory"); __syncthreads(); }
        pg8::EpiResidB E{H, F.out, MOD + 5120};
        pg8::gemm_phase<pg8::EpiResidB, pg8::StaticOrder, true, true, false>(F.lds, g, S, E, F.wave0);
    }
    if (hi - lo > 1 && hi == N_PHASES) {
        if (xb_ld(ctl + CW_BAR + XB_TMO) != 0u) { asm volatile("s_waitcnt vmcnt(0)" ::: "memory"); __syncthreads();
            for (size_t i = (size_t)blockIdx.x * NT + F.tid; i < (size_t)M_TOK * D_MODEL; i += (size_t)F.G * NT) F.out[i] = __builtin_nanf(""); }
    }
#undef IN
#undef MOD
#undef H
#undef SEAM
}

#ifndef MK_PER_PHASE
#define MK_PER_PHASE 0
#endif
extern "C" void kernel_launch(void* const* d_in, const int* in_sizes, int n_in, void* d_out, int out_size, void* d_ws, size_t ws_size, hipStream_t stream) {
    static int grid = 0;
    if (grid == 0) {
        if (n_in != 23 || in_sizes[0] != M_TOK * D_MODEL || out_size != M_TOK * D_MODEL || ws_size < WS_END) {
            fprintf(stderr, "kernel_launch: unexpected shapes (n_in %d, in0 %d, out %d, ws %zu); nothing launched\n", n_in, n_in > 0 ? in_sizes[0] : -1, out_size, ws_size); grid = -1; return; }
        int dev = 0, cus = 0;
        if (hipGetDevice(&dev) != hipSuccess || hipDeviceGetAttribute(&cus, hipDeviceAttributeMultiprocessorCount, dev) != hipSuccess) { grid = -1; return; }
        if (hipFuncSetAttribute((const void*)hymba_fwd, hipFuncAttributeMaxDynamicSharedMemorySize, LDS_BYTES) != hipSuccess) { fprintf(stderr, "kernel_launch: hipFuncSetAttribute failed\n"); grid = -1; return; }
        grid = cus;
    }
    if (grid < 0) return;
    (void)hipMemsetAsync((char*)d_ws + WS_CTL, 0, CTL_ZERO_BYTES, stream);
    Args a{};
    for (int i = 0; i < 23; ++i) a.in[i] = (const float*)d_in[i];
    a.out = (float*)d_out; a.ws = (unsigned char*)d_ws;
#if MK_PER_PHASE
    for (int p = 0; p < N_PHASES; ++p) { a.ph_lo = p; a.ph_hi = p + 1; hipLaunchKernelGGL(hymba_fwd, dim3(grid), dim3(NT), LDS_BYTES, stream, a); }
#else
    a.ph_lo = 0; a.ph_hi = N_PHASES; hipLaunchKernelGGL(hymba_fwd, dim3(grid), dim3(NT), LDS_BYTES, stream, a);
#endif
}
```

```cpp
#include <hip/hip_runtime.h>
#include <cstdio>
#include <cstdint>

#define GAS __attribute__((address_space(1)))
#define LAS __attribute__((address_space(3)))
typedef unsigned short u16;
typedef short s16x8 __attribute__((ext_vector_type(8)));
typedef _Float16 f16x8 __attribute__((ext_vector_type(8)));
typedef __bf16 bf16x8_t __attribute__((ext_vector_type(8)));
typedef float f32x2 __attribute__((ext_vector_type(2)));
typedef float f32x4 __attribute__((ext_vector_type(4)));
typedef float f32x16 __attribute__((ext_vector_type(16)));
typedef unsigned u32x4 __attribute__((ext_vector_type(4)));
typedef unsigned u32x2 __attribute__((ext_vector_type(2)));
typedef GAS unsigned gu32;
#define RLX_AGENT __ATOMIC_RELAXED, __HIP_MEMORY_SCOPE_AGENT

constexpr int D_MODEL = 1024, BATCH = 4, SEQ = 8192, M_TOK = BATCH * SEQ;
constexpr int N_IN = 2560, D_FF = 2816, N_UP = 2 * D_FF, N_MOD = 6 * D_MODEL;
constexpr int NHEAD = 8, HD = 64, AW = 512, NBLK = 32, BLK = 256;
constexpr float EPS = 1e-6f;
constexpr float LOG2E = 1.4426950408889634f;

__device__ __forceinline__ unsigned cvt_pk_bf16(float lo, float hi) { unsigned r; asm volatile("v_cvt_pk_bf16_f32 %0, %1, %2" : "=v"(r) : "v"(lo), "v"(hi)); return r; }
__device__ __forceinline__ unsigned cvt_pk_f16(float lo, float hi) {
    const _Float16 a = (_Float16)lo, b = (_Float16)hi;
    return (unsigned)__builtin_bit_cast(unsigned short, a) | ((unsigned)__builtin_bit_cast(unsigned short, b) << 16);
}
__device__ __forceinline__ float bf_lo(unsigned w) { return __builtin_bit_cast(float, w << 16); }
__device__ __forceinline__ float bf_hi(unsigned w) { return __builtin_bit_cast(float, w & 0xffff0000u); }
__device__ __forceinline__ float sigmoidf_(float v) { return __builtin_amdgcn_rcpf(1.0f + __builtin_amdgcn_exp2f(-v * LOG2E)); }
__device__ __forceinline__ float gelu_tanh(float v) { const float y = 0.7978845608028654f * (v + 0.044715f * v * v * v); return v * sigmoidf_(2.0f * y); }
__device__ __forceinline__ float wave_sum(float v) {
#pragma unroll
    for (int o = 1; o < 64; o <<= 1) v += __shfl_xor(v, o);
    return v;
}

__device__ __forceinline__ int lane_id() { int l; asm volatile("v_mbcnt_lo_u32_b32 %0, -1, 0\n\tv_mbcnt_hi_u32_b32 %0, -1, %0" : "=v"(l)); return l; }

namespace pg8 {
constexpr int BM = 256, BK = 64, HALF = 128, HTB = HALF * BK * 2, STAGE_BYTES = 8 * HTB, NXCD = 8, WGM = 8;
__host__ __device__ __forceinline__ int lds_byte(int r, int c) { const int st = (r >> 4) * 2 + (c >> 5), rr = r & 15, cc = c & 31, ob = rr * 64 + cc * 2; return st * 1024 + (ob ^ (((ob >> 9) & 1) << 5)); }
__host__ __device__ __forceinline__ void stage_rc(int b, int& R, int& C) { const int st = b / 1024, sb = b % 1024, swz = sb ^ (((sb >> 9) & 1) << 5); R = (st >> 1) * 16 + swz / 64; C = (st & 1) * 32 + (swz % 64) / 2; }
__host__ __device__ __forceinline__ int perm32(int rho) { const int n = rho >> 4, i = rho & 15; return 8 * (i >> 2) + 4 * n + (i & 3); }

struct Unit { int pm, pn; };
struct Gemm { const u16* A; const u16* Bt; int M, N, K; size_t bstride; };

struct StaticOrder {
    int nM, nN, nwg, G, c;
    __host__ __device__ __forceinline__ void init(int M, int N, int G_, int c_) { nM = M / BM; nN = N / BM; nwg = nM * nN; G = G_; c = c_; }
    __host__ __device__ __forceinline__ bool next(int i, Unit& u) const {
        const long L = (long)i * G + c; if (L >= nwg) return false;
        int wgid = (int)L; { const int q = nwg / NXCD, r = nwg % NXCD, xcd = wgid % NXCD, off = wgid / NXCD; wgid = (xcd < r ? xcd * (q + 1) : r * (q + 1) + (xcd - r) * q) + off; }
        const int nig = WGM * nN, gid = wgid / nig, fm = gid * WGM, gsz = (nM - fm) < WGM ? (nM - fm) : WGM;
        u.pm = fm + ((wgid % nig) % gsz); u.pn = (wgid % nig) / gsz; return true;
    }
    __device__ __forceinline__ void a_ready(const Unit&) const {}
    __device__ __forceinline__ void done(const Unit&) const {}
};

template <bool F16> __device__ __forceinline__ f32x4 mfma16(s16x8 a, s16x8 b, f32x4 c) {
    if constexpr (F16) return __builtin_amdgcn_mfma_f32_16x16x32_f16(__builtin_bit_cast(f16x8, a), __builtin_bit_cast(f16x8, b), c, 0, 0, 0);
    else return __builtin_amdgcn_mfma_f32_16x16x32_bf16(__builtin_bit_cast(bf16x8_t, a), __builtin_bit_cast(bf16x8_t, b), c, 0, 0, 0);
}

template <class Epi, class Sched, bool ALIGN_EPI, bool SP2, bool F16>
__device__ __forceinline__ void gemm_phase(LAS unsigned char* lds, const Gemm g, const Sched& S, const Epi& E, int wave0) {
    int tid_ = wave0 * 64 + lane_id(); asm volatile("" : "+v"(tid_));
    const int tid = tid_, wid = __builtin_amdgcn_readfirstlane(tid >> 6), lane = tid & 63, wr = wid >> 2, wc = wid & 3, fr = lane & 15, fq = lane >> 4;
    const int K = g.K, nt = K / BK;
    unsigned voffA, voffB;
    { int R, C; stage_rc(tid * 16, R, C); const int Rb = Epi::PERM ? ((R & ~31) + perm32(R & 31)) : R;
        voffA = (unsigned)(R * K + C) * 2u; voffB = (unsigned)(Rb * K + C) * 2u; }
    const unsigned rstep64 = (unsigned)(64 * K * 2);
    const size_t kstep = (size_t)(BK * 2);
    const size_t hstep = (size_t)HALF * K * 2;
    const size_t tstep = 2 * hstep;
    const unsigned ldsw = (unsigned)wid * 1024u;
    const int aoff = lds_byte(wr * 64 + fr, fq * 8), boff = lds_byte(wc * 32 + fr, fq * 8);
#define PG8_SA(b, h) (((b) * 2 + (h)) * HTB)
#define PG8_SB(b, h) ((4 + (b) * 2 + (h)) * HTB)
#define PG8_STAGE(bufoff, gbase, voff) do { _Pragma("unroll") for (int _i = 0; _i < 2; ++_i) \
        __builtin_amdgcn_global_load_lds((const unsigned*)((const char*)(gbase) + _i * rstep64 + (voff)), (LAS unsigned*)(lds + (bufoff) + ldsw + _i * 8192), 16, 0, 0); } while (0)
#define PG8_LDA(dst, b, h) do { _Pragma("unroll") for (int m = 0; m < 4; ++m) _Pragma("unroll") for (int k = 0; k < 2; ++k) dst[m][k] = *(const LAS s16x8*)(lds + PG8_SA(b, h) + aoff + m * 2048 + k * 1024); } while (0)
#define PG8_LDB(dst, b, h) do { _Pragma("unroll") for (int n = 0; n < 2; ++n) _Pragma("unroll") for (int k = 0; k < 2; ++k) dst[n][k] = *(const LAS s16x8*)(lds + PG8_SB(b, h) + boff + n * 2048 + k * 1024); } while (0)
#define PG8_MMA(ai, bj, At, Bt) do { __builtin_amdgcn_s_setprio(1); _Pragma("unroll") for (int m = 0; m < 4; ++m) _Pragma("unroll") for (int n = 0; n < 2; ++n) _Pragma("unroll") for (int k = 0; k < 2; ++k) \
        acc[ai][bj][m][n] = mfma16<F16>(Bt[n][k], At[m][k], acc[ai][bj][m][n]); __builtin_amdgcn_s_setprio(0); } while (0)
#define PG8_WAIT_V(n) asm volatile("s_waitcnt vmcnt(" #n ")" ::: "memory")
#define PG8_WAIT_L(n) asm volatile("s_waitcnt lgkmcnt(" #n ")" ::: "memory")
#define PG8_BAR __builtin_amdgcn_s_barrier()
#define PG8_SCHED __builtin_amdgcn_sched_barrier(0)
    Unit cur, nxt; int ui = 0;
    if (!S.next(0, cur)) return;
    f32x4 acc[2][2][4][2];
#pragma unroll
    for (int a = 0; a < 2; ++a)
#pragma unroll
        for (int b = 0; b < 2; ++b)
#pragma unroll
            for (int m = 0; m < 4; ++m)
#pragma unroll
                for (int n = 0; n < 2; ++n) acc[a][b][m][n] = (f32x4){0.f, 0.f, 0.f, 0.f};
    s16x8 At[4][2], B0[2][2], B1[2][2];
    const char* cA = (const char*)g.A + (size_t)cur.pm * tstep; const char* cB = (const char*)g.Bt + (size_t)cur.pn * tstep + (size_t)(cur.pm >> 5) * g.bstride;
    S.a_ready(cur);
    if constexpr (SP2) {
        PG8_STAGE(PG8_SB(0, 0), cB, voffB); PG8_STAGE(PG8_SB(0, 1), cB + hstep, voffB); PG8_STAGE(PG8_SA(0, 0), cA, voffA); PG8_STAGE(PG8_SA(0, 1), cA + hstep, voffA);
        if (wr == 1) PG8_BAR;
        PG8_WAIT_V(2); PG8_BAR;
        PG8_STAGE(PG8_SB(1, 0), cB + kstep, voffB); PG8_STAGE(PG8_SA(1, 0), cA + kstep, voffA); PG8_STAGE(PG8_SB(1, 1), cB + hstep + kstep, voffB);
        PG8_WAIT_V(6); PG8_BAR;
    } else {
        PG8_STAGE(PG8_SB(0, 0), cB, voffB); PG8_STAGE(PG8_SA(0, 0), cA, voffA); PG8_STAGE(PG8_SB(0, 1), cB + hstep, voffB); PG8_STAGE(PG8_SA(0, 1), cA + hstep, voffA);
        if (wr == 1) PG8_BAR;
        PG8_WAIT_V(4); PG8_BAR;
        PG8_STAGE(PG8_SB(1, 0), cB + kstep, voffB); PG8_STAGE(PG8_SA(1, 0), cA + kstep, voffA); PG8_STAGE(PG8_SB(1, 1), cB + hstep + kstep, voffB);
        PG8_WAIT_V(6); PG8_BAR;
    }
    for (;;) {
        const bool has_next = S.next(ui + 1, nxt);
        const char* nA = has_next ? (const char*)g.A + (size_t)nxt.pm * tstep : cA; const char* nB = has_next ? (const char*)g.Bt + (size_t)nxt.pn * tstep + (size_t)(nxt.pm >> 5) * g.bstride : cB;
        for (int t = 0; t < nt; t += 2) {
            const bool last = (t == nt - 2);
            const char* a1 = cA + (size_t)(t + 1) * kstep;
            const char* a2 = last ? nA : cA + (size_t)(t + 2) * kstep; const char* b2 = last ? nB : cB + (size_t)(t + 2) * kstep;
            const char* a3 = a2 + kstep; const char* b3 = b2 + kstep;
            if (last && has_next) S.a_ready(nxt);
            if constexpr (Epi::MIDK) { if (t == nt / 2) E.midk(acc, cur, wr, fr); }
            if constexpr (SP2) {
            PG8_LDB(B0, 0, 0); PG8_LDB(B1, 0, 1); PG8_SCHED; PG8_LDA(At, 0, 0); PG8_STAGE(PG8_SA(1, 1), a1 + hstep, voffA);
            PG8_WAIT_V(8); PG8_WAIT_L(0); PG8_BAR; PG8_MMA(0, 0, At, B0); PG8_MMA(0, 1, At, B1); PG8_BAR; PG8_SCHED;
            PG8_LDA(At, 0, 1); PG8_STAGE(PG8_SB(0, 0), b2, voffB); PG8_STAGE(PG8_SB(0, 1), b2 + hstep, voffB); PG8_STAGE(PG8_SA(0, 0), a2, voffA);
            PG8_WAIT_V(8); PG8_WAIT_L(0); PG8_BAR; PG8_MMA(1, 0, At, B0); PG8_MMA(1, 1, At, B1); PG8_BAR; PG8_SCHED;
            PG8_LDB(B0, 1, 0); PG8_LDB(B1, 1, 1); PG8_SCHED; PG8_LDA(At, 1, 0); PG8_STAGE(PG8_SA(0, 1), a2 + hstep, voffA);
            PG8_WAIT_V(8); PG8_WAIT_L(0); PG8_BAR; PG8_MMA(0, 0, At, B0); PG8_MMA(0, 1, At, B1); PG8_BAR; PG8_SCHED;
            PG8_LDA(At, 1, 1); PG8_STAGE(PG8_SB(1, 0), b3, voffB); PG8_STAGE(PG8_SB(1, 1), b3 + hstep, voffB); PG8_STAGE(PG8_SA(1, 0), a3, voffA);
            PG8_WAIT_V(8); PG8_WAIT_L(0); PG8_BAR; PG8_MMA(1, 0, At, B0); PG8_MMA(1, 1, At, B1); PG8_BAR; PG8_SCHED;
            } else {
            PG8_LDB(B0, 0, 0); PG8_SCHED; PG8_LDA(At, 0, 0); PG8_STAGE(PG8_SA(1, 1), a1 + hstep, voffA);
            PG8_WAIT_L(8); PG8_BAR; PG8_WAIT_L(0); PG8_MMA(0, 0, At, B0); PG8_BAR; PG8_SCHED;
            PG8_LDB(B1, 0, 1); PG8_STAGE(PG8_SB(0, 0), b2, voffB);
            PG8_BAR; PG8_WAIT_L(0); PG8_MMA(0, 1, At, B1); PG8_BAR;
            PG8_LDA(At, 0, 1); PG8_STAGE(PG8_SA(0, 0), a2, voffA);
            PG8_BAR; PG8_WAIT_L(0); PG8_MMA(1, 0, At, B0); PG8_BAR; PG8_SCHED;
            PG8_STAGE(PG8_SB(0, 1), b2 + hstep, voffB);
            PG8_WAIT_V(6); PG8_BAR; PG8_MMA(1, 1, At, B1); PG8_BAR;
            PG8_LDB(B0, 1, 0); PG8_SCHED; PG8_LDA(At, 1, 0); PG8_STAGE(PG8_SA(0, 1), a2 + hstep, voffA);
            PG8_WAIT_L(8); PG8_BAR; PG8_WAIT_L(0); PG8_MMA(0, 0, At, B0); PG8_BAR; PG8_SCHED;
            PG8_LDB(B1, 1, 1); PG8_STAGE(PG8_SB(1, 0), b3, voffB);
            PG8_BAR; PG8_WAIT_L(0); PG8_MMA(0, 1, At, B1); PG8_BAR;
            PG8_LDA(At, 1, 1); PG8_STAGE(PG8_SA(1, 0), a3, voffA);
            PG8_BAR; PG8_WAIT_L(0); PG8_MMA(1, 0, At, B0); PG8_BAR; PG8_SCHED;
            PG8_STAGE(PG8_SB(1, 1), b3 + hstep, voffB);
            PG8_WAIT_V(6); PG8_BAR; PG8_MMA(1, 1, At, B1); PG8_BAR;
            }
        }
        if constexpr (ALIGN_EPI) { if (wr == 0) PG8_BAR; }
        E(acc, cur, wr, wc, fr, fq); S.done(cur);
        if (!has_next) break;
#pragma unroll
        for (int a = 0; a < 2; ++a)
#pragma unroll
            for (int b = 0; b < 2; ++b)
#pragma unroll
                for (int m = 0; m < 4; ++m)
#pragma unroll
                    for (int n = 0; n < 2; ++n) acc[a][b][m][n] = (f32x4){0.f, 0.f, 0.f, 0.f};
        cur = nxt; cA = nA; cB = nB; ++ui;
        if constexpr (ALIGN_EPI) { if (wr == 1) PG8_BAR; }
    }
    PG8_WAIT_V(0);
    if constexpr (!ALIGN_EPI) { if (wr == 0) PG8_BAR; }
    PG8_BAR;
#undef PG8_SA
#undef PG8_SB
#undef PG8_STAGE
#undef PG8_LDA
#undef PG8_LDB
#undef PG8_MMA
#undef PG8_WAIT_V
#undef PG8_WAIT_L
#undef PG8_BAR
#undef PG8_SCHED
}

struct EpiBf16 {
    static constexpr bool PERM = true, MIDK = false;
    u16* O; int ldc;
    __device__ __forceinline__ void operator()(const f32x4 (&acc)[2][2][4][2], const Unit& u, int wr, int wc, int fr, int fq) const {
        const int row0 = u.pm * BM + wr * 64 + fr; const int col0 = u.pn * BM + wc * 32 + 8 * fq;
#pragma unroll
        for (int ai = 0; ai < 2; ++ai)
#pragma unroll
            for (int m = 0; m < 4; ++m) { u16* rowp = O + (size_t)(row0 + ai * HALF + m * 16) * ldc + col0;
#pragma unroll
                for (int bj = 0; bj < 2; ++bj) { const f32x4 v0 = acc[ai][bj][m][0], v1 = acc[ai][bj][m][1];
                    u32x4 w; w.x = cvt_pk_bf16(v0[0], v0[1]); w.y = cvt_pk_bf16(v0[2], v0[3]); w.z = cvt_pk_bf16(v1[0], v1[1]); w.w = cvt_pk_bf16(v1[2], v1[3]);
                    *(u32x4*)(rowp + bj * HALF) = w; } }
    }
};
struct EpiResid {
    static constexpr bool PERM = false, MIDK = false;
    const float* base; float* out; const float* gate;
    __device__ __forceinline__ void operator()(const f32x4 (&acc)[2][2][4][2], const Unit& u, int wr, int wc, int fr, int fq) const {
        const int row0 = u.pm * BM + wr * 64 + fr, col0 = u.pn * BM + wc * 32 + 4 * fq;
        const int b = (u.pm * BM) / SEQ;
        f32x4 gv[2][2];
#pragma unroll
        for (int bj = 0; bj < 2; ++bj)
#pragma unroll
            for (int n = 0; n < 2; ++n) gv[bj][n] = *(const f32x4*)(gate + (size_t)b * N_MOD + col0 + bj * HALF + n * 16);
#pragma unroll
        for (int ai = 0; ai < 2; ++ai)
#pragma unroll
            for (int m = 0; m < 4; ++m) { const size_t off = (size_t)(row0 + ai * HALF + m * 16) * D_MODEL + col0;
#pragma unroll
                for (int bj = 0; bj < 2; ++bj)
#pragma unroll
                    for (int n = 0; n < 2; ++n) { const f32x4 bs = *(const f32x4*)(base + off + bj * HALF + n * 16);
                        *(f32x4*)(out + off + bj * HALF + n * 16) = bs + gv[bj][n] * acc[ai][bj][m][n]; } }
    }
};
struct EpiInProj {
    static constexpr bool PERM = true, MIDK = false;
    float* QF; u16* KB; u16* VT; u16* XR; u16* GG; float* KM; const float* gq; const float* gk;
    __device__ __forceinline__ void operator()(const f32x4 (&acc)[2][2][4][2], const Unit& u, int wr, int wc, int fr, int fq) const {
        const int type = u.pn >> 1, head = (u.pn & 1) * 4 + wc;
        const int b = (u.pm * BM) / SEQ, blk = u.pm % NBLK;
        const int tok0 = u.pm * BM + wr * 64 + fr;
        const int bh = b * NHEAD + head;
        if (type <= 1) {
            const float* gp = type == 0 ? gq : gk;
            f32x4 gv[2][2];
#pragma unroll
            for (int bj = 0; bj < 2; ++bj)
#pragma unroll
                for (int n = 0; n < 2; ++n) gv[bj][n] = *(const f32x4*)(gp + 32 * bj + 8 * fq + 4 * n);
            f32x4 cs[2][2];
#pragma unroll
            for (int bj = 0; bj < 2; ++bj)
#pragma unroll
                for (int n = 0; n < 2; ++n) cs[bj][n] = (f32x4){0.f, 0.f, 0.f, 0.f};
#pragma unroll
            for (int ai = 0; ai < 2; ++ai)
#pragma unroll
                for (int m = 0; m < 4; ++m) {
                    float ss = 0.f;
#pragma unroll
                    for (int bj = 0; bj < 2; ++bj)
#pragma unroll
                        for (int n = 0; n < 2; ++n) { const f32x4 x = acc[ai][bj][m][n]; ss += (x[0] * x[0] + x[1] * x[1]) + (x[2] * x[2] + x[3] * x[3]); }
                    ss += __shfl_xor(ss, 16); ss += __shfl_xor(ss, 32);
                    const float rstd = 1.0f / sqrtf(ss * (1.0f / 64.0f) + EPS);
                    const int tok = tok0 + ai * HALF + m * 16, s = tok % SEQ;
                    const size_t rowoff = ((size_t)bh * SEQ + s) * HD + 8 * fq;
#pragma unroll
                    for (int bj = 0; bj < 2; ++bj) {
                        const f32x4 v0 = acc[ai][bj][m][0] * rstd * gv[bj][0], v1 = acc[ai][bj][m][1] * rstd * gv[bj][1];
                        if (type == 0) { *(f32x4*)(QF + rowoff + 32 * bj) = v0; *(f32x4*)(QF + rowoff + 32 * bj + 4) = v1; }
                        else { u32x4 w; w.x = cvt_pk_bf16(v0[0], v0[1]); w.y = cvt_pk_bf16(v0[2], v0[3]); w.z = cvt_pk_bf16(v1[0], v1[1]); w.w = cvt_pk_bf16(v1[2], v1[3]);
                            const int kw = s & 255, c8 = 4 * bj + fq;
                            *(u32x4*)(KB + ((size_t)bh * NBLK + blk) * (BLK * HD) + ((((kw >> 5) * 4 + (c8 >> 1)) * 2 + (c8 & 1)) * 32 + (kw & 31)) * 8) = w; cs[bj][0] += v0; cs[bj][1] += v1; }
                    }
                }
            if (type == 1) {
#pragma unroll
                for (int bj = 0; bj < 2; ++bj)
#pragma unroll
                    for (int n = 0; n < 2; ++n)
#pragma unroll
                        for (int i = 0; i < 4; ++i) { float v = cs[bj][n][i]; v += __shfl_xor(v, 1); v += __shfl_xor(v, 2); v += __shfl_xor(v, 4); v += __shfl_xor(v, 8);
                            if (fr == 0) atomicAdd(KM + (((size_t)(b * NBLK + blk) * NHEAD + head) * HD + 32 * bj + 8 * fq + 4 * n + i), v); }
            }
        } else if (type == 2) {
            const int hip = (fr >> 2) & 1, ep = 4 * (fr >> 3) + (fr & 3);
#pragma unroll
            for (int ai = 0; ai < 2; ++ai)
#pragma unroll
                for (int m = 0; m < 4; ++m) { const int kw = ai * HALF + wr * 64 + m * 16 + fr;
#pragma unroll
                    for (int bj = 0; bj < 2; ++bj)
#pragma unroll
                        for (int n = 0; n < 2; ++n) { const f32x4 x = acc[ai][bj][m][n]; const unsigned w0 = cvt_pk_bf16(x[0], x[1]), w1 = cvt_pk_bf16(x[2], x[3]);
                            u16* dst = VT + ((size_t)bh * NBLK + blk) * (BLK * HD) + (((((kw >> 5) * 2 + ((kw >> 4) & 1)) * 2 + bj) * 2 + hip) * 32 + 8 * fq + 4 * n) * 8 + ep;
                            dst[0] = (u16)(w0 & 0xffffu); dst[8] = (u16)(w0 >> 16); dst[16] = (u16)(w1 & 0xffffu); dst[24] = (u16)(w1 >> 16); } }
        } else {
            u16* O = type == 3 ? XR : GG;
#pragma unroll
            for (int ai = 0; ai < 2; ++ai)
#pragma unroll
                for (int m = 0; m < 4; ++m) { const int tok = tok0 + ai * HALF + m * 16, sq = tok % SEQ;
                    u16* tilep = O + ((((size_t)b * (SEQ / 32) + (sq >> 5)) * NHEAD + head) * 2048) + (sq & 31) * 8;
#pragma unroll
                    for (int bj = 0; bj < 2; ++bj) { f32x4 v0 = acc[ai][bj][m][0], v1 = acc[ai][bj][m][1];
                        if (type == 4) {
#pragma unroll
                            for (int i = 0; i < 4; ++i) { v0[i] = gelu_tanh(v0[i]); v1[i] = gelu_tanh(v1[i]); } }
                        u32x4 w; w.x = cvt_pk_bf16(v0[0], v0[1]); w.y = cvt_pk_bf16(v0[2], v0[3]); w.z = cvt_pk_bf16(v1[0], v1[1]); w.w = cvt_pk_bf16(v1[2], v1[3]);
                        *(u32x4*)(tilep + (4 * bj + fq) * 256) = w; } }
        }
    }
};

__device__ __forceinline__ float dpp_f(float old, float x, int ctrl) {
    return 0.f; }
#define DPPF(old, x, ctrl) __builtin_bit_cast(float, __builtin_amdgcn_update_dpp(__builtin_bit_cast(int, (float)(old)), __builtin_bit_cast(int, (float)(x)), (ctrl), 0xf, 0xf, false))
struct EpiFFN {
    static constexpr bool PERM = true, MIDK = false;
    u16* ACT; float* RAW; const float* cw; const float* CB2; LAS float* XB; const float* SSQX; const float* BIAS2;
    __device__ __forceinline__ void operator()(const f32x4 (&acc)[2][2][4][2], const Unit& u, int wr, int wc, int fr_, int fq_) const {
        int fr = fr_, fq = fq_; asm volatile("" : "+v"(fr), "+v"(fq));
        const int f0 = u.pn * 128 + wc * 32 + 8 * fq;
        const int b = (u.pm * BM) / SEQ;
        LAS float* R2S = XB + 2048;
        { const int t = (wr * 4 + wc) * 64 + fq * 16 + fr;
          if (t < 256) { const size_t row = (size_t)u.pm * BM + t;
              const f32x4 s0 = *(const f32x4*)(SSQX + row * 16), s1 = *(const f32x4*)(SSQX + row * 16 + 4), s2 = *(const f32x4*)(SSQX + row * 16 + 8), s3 = *(const f32x4*)(SSQX + row * 16 + 12);
              const float ss = (((s0[0] + s0[1]) + (s0[2] + s0[3])) + ((s1[0] + s1[1]) + (s1[2] + s1[3]))) + (((s2[0] + s2[1]) + (s2[2] + s2[3])) + ((s3[0] + s3[1]) + (s3[2] + s3[3])));
              R2S[t] = 1.0f / sqrtf(ss * (1.0f / D_MODEL) + EPS); } }
        asm volatile("s_waitcnt lgkmcnt(0)" ::: "memory"); __builtin_amdgcn_s_barrier(); asm volatile("" ::: "memory");
#define R2(ai, m) (R2S[(ai) * HALF + wr * 64 + (m) * 16 + fr])
#define BBP(kc, bj, n) (*(const f32x4*)(BIAS2 + ((size_t)(kc) * BATCH + b) * N_UP + (bj) * D_FF + f0 + 4 * (n)))
#define BBV(bj, n) ((BBP(0, bj, n) + BBP(1, bj, n)) + (BBP(2, bj, n) + BBP(3, bj, n)))
#define UPV(ai, bj, m, n) (acc[ai][bj][m][n] * r2v[ai][m])
        if (fr >= 14) {
#pragma unroll
            for (int ai = 0; ai < 2; ++ai)
#pragma unroll
                for (int bj = 0; bj < 2; ++bj)
#pragma unroll
                    for (int n = 0; n < 2; ++n) *(LAS f32x4*)(XB + (((((ai * 2 + wr) * 4 + wc) * 2 + (fr - 14)) * 4 + fq) * 16 + (bj * 2 + n) * 4)) = acc[ai][bj][3][n] * R2(ai, 3);
        }
        if (wr == 1 && fr >= 14) {
#pragma unroll
            for (int bj = 0; bj < 2; ++bj)
#pragma unroll
                for (int n = 0; n < 2; ++n) *(f32x4*)(RAW + ((size_t)u.pm * 4 + 2 + (fr - 14)) * N_UP + bj * D_FF + f0 + 4 * n) = acc[1][bj][3][n] * R2(1, 3) + BBV(bj, n);
        }
        if (wr == 0 && fr < 2) {
#pragma unroll
            for (int bj = 0; bj < 2; ++bj)
#pragma unroll
                for (int n = 0; n < 2; ++n) *(f32x4*)(RAW + ((size_t)u.pm * 4 + fr) * N_UP + bj * D_FF + f0 + 4 * n) = acc[0][bj][0][n] * R2(0, 0) + BBV(bj, n);
        }
        asm volatile("s_waitcnt lgkmcnt(0)" ::: "memory"); __builtin_amdgcn_s_barrier(); asm volatile("" ::: "memory");
#pragma unroll
        for (int n = 0; n < 2; ++n) {
            const f32x4 wg0 = *(const f32x4*)(cw + f0 + 4 * n), wg1 = *(const f32x4*)(cw + N_UP + f0 + 4 * n), wg2 = *(const f32x4*)(cw + 2 * N_UP + f0 + 4 * n);
            const f32x4 wv0 = *(const f32x4*)(cw + D_FF + f0 + 4 * n), wv1 = *(const f32x4*)(cw + N_UP + D_FF + f0 + 4 * n), wv2 = *(const f32x4*)(cw + 2 * N_UP + D_FF + f0 + 4 * n);
            const f32x4 bg = *(const f32x4*)(CB2 + (size_t)b * N_UP + f0 + 4 * n), bv = *(const f32x4*)(CB2 + (size_t)b * N_UP + D_FF + f0 + 4 * n);
#pragma unroll
            for (int ai = 0; ai < 2; ++ai) {
                float r2v[2][4];
#pragma unroll
                for (int m = 0; m < 4; ++m) r2v[ai][m] = R2(ai, m);
                const bool hasprev = (wr == 1) || (ai == 1);
                const int src = (wr == 1) ? (ai * 2 + 0) : ((ai - 1) * 2 + 1);
                f32x4 t1g = (f32x4){0.f, 0.f, 0.f, 0.f}, t2g = t1g, t1v = t1g, t2v = t1g;
                if (hasprev) {
                    const LAS float* xb1 = XB + ((((src * 4 + wc) * 2 + 1) * 4 + fq) * 16);
                    const LAS float* xb2 = XB + ((((src * 4 + wc) * 2 + (fr == 0 ? 0 : 1)) * 4 + fq) * 16);
                    t1g = *(const LAS f32x4*)(xb1 + (0 * 2 + n) * 4); t1v = *(const LAS f32x4*)(xb1 + (1 * 2 + n) * 4);
                    t2g = *(const LAS f32x4*)(xb2 + (0 * 2 + n) * 4); t2v = *(const LAS f32x4*)(xb2 + (1 * 2 + n) * 4);
                }
#pragma unroll
                for (int m = 0; m < 4; ++m) {
                    const f32x4 xg = UPV(ai, 0, m, n), xv = UPV(ai, 1, m, n);
                    if (m > 0) {
                        const f32x4 pg = UPV(ai, 0, m - 1, n), pv = UPV(ai, 1, m - 1, n);
#pragma unroll
                        for (int i = 0; i < 4; ++i) { t1g[i] = DPPF(0.f, pg[i], 0x121); t2g[i] = DPPF(0.f, pg[i], 0x122); t1v[i] = DPPF(0.f, pv[i], 0x121); t2v[i] = DPPF(0.f, pv[i], 0x122); }
                    }
                    float o[4];
#pragma unroll
                    for (int i = 0; i < 4; ++i) {
                        const float g1 = DPPF(t1g[i], xg[i], 0x111), g2 = DPPF(t2g[i], xg[i], 0x112);
                        const float v1 = DPPF(t1v[i], xv[i], 0x111), v2 = DPPF(t2v[i], xv[i], 0x112);
                        const float cg = ((wg0[i] * g2 + wg1[i] * g1) + wg2[i] * xg[i]) + bg[i];
                        const float cv = ((wv0[i] * v2 + wv1[i] * v1) + wv2[i] * xv[i]) + bv[i];
                        o[i] = cg * sigmoidf_(cg) * cv;
                    }
                    if (!(ai == 0 && m == 0 && wr == 0 && fr < 2)) { u32x2 w; w.x = cvt_pk_bf16(o[0], o[1]); w.y = cvt_pk_bf16(o[2], o[3]);
                        *(u32x2*)(ACT + (size_t)(u.pm * BM + ai * HALF + wr * 64 + m * 16 + fr) * D_FF + f0 + 4 * n) = w; }
                    __builtin_amdgcn_sched_barrier(0);
                }
            }
        }
    }
};

struct EpiOut {
    static constexpr bool PERM = true, MIDK = true;
    const float* base; u16* X1B; float* SSQX; const float* gate; const float* SSQL; const float* SSQA;
    __device__ __forceinline__ void rstd(int row, float& rl, float& ra) const {
        const f32x4 s0 = *(const f32x4*)(SSQL + (size_t)row * 8), s1 = *(const f32x4*)(SSQL + (size_t)row * 8 + 4);
        const f32x4 t0 = *(const f32x4*)(SSQA + (size_t)row * 8), t1 = *(const f32x4*)(SSQA + (size_t)row * 8 + 4);
        const float ssl = ((s0[0] + s0[1]) + (s0[2] + s0[3])) + ((s1[0] + s1[1]) + (s1[2] + s1[3]));
        const float ssa = ((t0[0] + t0[1]) + (t0[2] + t0[3])) + ((t1[0] + t1[1]) + (t1[2] + t1[3]));
        rl = 1.0f / sqrtf(ssl * (1.0f / AW) + EPS); ra = 1.0f / sqrtf(ssa * (1.0f / AW) + EPS);
    }
    __device__ __forceinline__ void midk(f32x4 (&acc)[2][2][4][2], const Unit& u, int wr, int fr) const {
#pragma unroll
        for (int ai = 0; ai < 2; ++ai)
#pragma unroll
            for (int m = 0; m < 4; ++m) { float rl, ra; rstd(u.pm * BM + ai * HALF + wr * 64 + m * 16 + fr, rl, ra); const float ratio = rl / ra;
#pragma unroll
                for (int bj = 0; bj < 2; ++bj)
#pragma unroll
                    for (int n = 0; n < 2; ++n) acc[ai][bj][m][n] *= ratio; }
    }
    __device__ __forceinline__ void operator()(const f32x4 (&acc)[2][2][4][2], const Unit& u, int wr, int wc, int fr, int fq) const {
        const int row0 = u.pm * BM + wr * 64 + fr, col0 = u.pn * BM + wc * 32 + 8 * fq;
        const int b = (u.pm * BM) / SEQ;
        f32x4 gv[2][2];
#pragma unroll
        for (int bj = 0; bj < 2; ++bj)
#pragma unroll
            for (int n = 0; n < 2; ++n) gv[bj][n] = *(const f32x4*)(gate + (size_t)b * N_MOD + col0 + bj * HALF + n * 4);
#pragma unroll
        for (int ai = 0; ai < 2; ++ai)
#pragma unroll
            for (int m = 0; m < 4; ++m) { const int row = row0 + ai * HALF + m * 16; const size_t off = (size_t)row * D_MODEL + col0;
                float rl, ra; rstd(row, rl, ra);
                float ss = 0.f;
#pragma unroll
                for (int bj = 0; bj < 2; ++bj) {
                    const f32x4 x0 = *(const f32x4*)(base + off + bj * HALF) + gv[bj][0] * (acc[ai][bj][m][0] * ra);
                    const f32x4 x1 = *(const f32x4*)(base + off + bj * HALF + 4) + gv[bj][1] * (acc[ai][bj][m][1] * ra);
                    ss += ((x0[0] * x0[0] + x0[1] * x0[1]) + (x0[2] * x0[2] + x0[3] * x0[3])) + ((x1[0] * x1[0] + x1[1] * x1[1]) + (x1[2] * x1[2] + x1[3] * x1[3]));
                    u32x4 w; w.x = cvt_pk_bf16(x0[0], x0[1]); w.y = cvt_pk_bf16(x0[2], x0[3]); w.z = cvt_pk_bf16(x1[0], x1[1]); w.w = cvt_pk_bf16(x1[2], x1[3]);
                    *(u32x4*)(X1B + off + bj * HALF) = w; }
                ss += __shfl_xor(ss, 16); ss += __shfl_xor(ss, 32);
                if (fq == 0) SSQX[(size_t)row * 16 + u.pn * 4 + wc] = ss; }
    }
};

struct EpiResidB {
    static constexpr bool PERM = false, MIDK = false;
    const u16* base; float* out; const float* gate;
    __device__ __forceinline__ void operator()(const f32x4 (&acc)[2][2][4][2], const Unit& u, int wr, int wc, int fr, int fq) const {
        const int row0 = u.pm * BM + wr * 64 + fr, col0 = u.pn * BM + wc * 32 + 4 * fq;
        const int b = (u.pm * BM) / SEQ;
        f32x4 gv[2][2];
#pragma unroll
        for (int bj = 0; bj < 2; ++bj)
#pragma unroll
            for (int n = 0; n < 2; ++n) gv[bj][n] = *(const f32x4*)(gate + (size_t)b * N_MOD + col0 + bj * HALF + n * 16);
#pragma unroll
        for (int ai = 0; ai < 2; ++ai)
#pragma unroll
            for (int m = 0; m < 4; ++m) { const size_t off = (size_t)(row0 + ai * HALF + m * 16) * D_MODEL + col0;
#pragma unroll
                for (int bj = 0; bj < 2; ++bj)
#pragma unroll
                    for (int n = 0; n < 2; ++n) { const u32x2 xw = *(const u32x2*)(base + off + bj * HALF + n * 16);
                        const f32x4 bs = (f32x4){bf_lo(xw.x), bf_hi(xw.x), bf_lo(xw.y), bf_hi(xw.y)};
                        *(f32x4*)(out + off + bj * HALF + n * 16) = bs + gv[bj][n] * acc[ai][bj][m][n]; } }
    }
};
}
#ifndef ATT_DUP
#define ATT_DUP 0
#endif

constexpr size_t MiB = 1u << 20;
constexpr size_t WS_CTL = 0;
constexpr size_t WS_KM = 1 * MiB;
constexpr size_t CTL_ZERO_BYTES = 2 * MiB;
constexpr size_t WS_MOD = 2 * MiB;
constexpr size_t WS_WIN = 3 * MiB;
constexpr size_t WS_WO = 8 * MiB;
constexpr size_t WS_WUP = 10 * MiB;
constexpr size_t WS_WDN = 21 * MiB;
constexpr size_t WS_WA = 27 * MiB;
constexpr size_t WS_WX = 27 * MiB + 65536;
constexpr size_t WS_AGG = 28 * MiB;
constexpr size_t WS_SSQL = 29 * MiB;
constexpr size_t WS_SSQA = 30 * MiB;
constexpr size_t WS_H = 34 * MiB;
constexpr size_t WS_QF = 98 * MiB;
constexpr size_t WS_KB = 162 * MiB;
constexpr size_t WS_VT = 194 * MiB;
constexpr size_t WS_XR = 226 * MiB;
constexpr size_t WS_GG = 258 * MiB;
constexpr size_t WS_ATT = 288 * MiB;
constexpr size_t WS_LRU = 320 * MiB;
constexpr size_t WS_MIX = 352 * MiB;
constexpr size_t WS_RAW = 98 * MiB;
constexpr size_t WS_ACT = 272 * MiB;
constexpr size_t WS_WUP4 = 448 * MiB;
constexpr size_t WS_BIAS2 = 27 * MiB + 262144;
constexpr size_t WS_CB2 = 27 * MiB + 786432;
constexpr size_t WS_SSQX = 31 * MiB;
constexpr size_t WS_END = 492 * MiB;
constexpr int CW_BAR = 4096;

constexpr int RING_BYTES = 131072;
constexpr int MISC_OFF = 160 * 1024 - 256;
constexpr int XB_OFF = RING_BYTES;
constexpr int CLDS_OFF = RING_BYTES + 4096;
constexpr int LDS_BYTES = 160 * 1024;
constexpr int NT = 512, NWAVES = 8;

#define XB_TMO      128
#define XB_XCNT(j)  (256  + 64 * (j))
#define XB_XSUB(j)  (1280 + 64 * (j))
#define XB_XGEN(j)  (2304 + 64 * (j))
#define XB_TOP      3328
#define XB_TOPGEN   3392
#define XCD_BAR_WORDS 3456
#define XB_SPIN_CAP (1u << 18)
__device__ __forceinline__ unsigned xb_ld(unsigned* p)              { return __hip_atomic_load(p, __ATOMIC_RELAXED, __HIP_MEMORY_SCOPE_AGENT); }
__device__ __forceinline__ unsigned xb_add(unsigned* p, unsigned v) { return __hip_atomic_fetch_add(p, v, __ATOMIC_RELAXED, __HIP_MEMORY_SCOPE_AGENT); }
__device__ __forceinline__ unsigned xb_xcc_id() { return (unsigned)__builtin_amdgcn_s_getreg((3 << 11) | 20) & 0xFu; }
#define XB_SPIN(cond, bar) do { unsigned _sp = 0; while (cond) { __builtin_amdgcn_s_sleep(1); \
    if ((++_sp & 255u) == 0u) { if (xb_ld(&(bar)[XB_TMO])) break; if (_sp > XB_SPIN_CAP) { atomicAdd(&(bar)[XB_TMO], 1u); break; } } } } while (0)
struct XcdBarrier { unsigned* bar; unsigned x; volatile LAS unsigned* st; };
__device__ __forceinline__ XcdBarrier xcd_barrier_post(unsigned* bar, volatile LAS unsigned* st) {
    XcdBarrier b; b.bar = bar; b.x = xb_xcc_id(); b.st = st;
    if (threadIdx.x == 0) (void)xb_add(&bar[XB_XCNT(b.x)], 1u);
    return b;
}
__device__ __forceinline__ void xcd_barrier_complete(unsigned* bar, unsigned x, unsigned& nloc, unsigned& nx) {
    const unsigned G = gridDim.x * gridDim.y * gridDim.z;
    unsigned sum, cnt, mine, sp = 0u;
    for (;;) {
        sum = 0u; cnt = 0u; mine = 0u;
#pragma unroll
        for (unsigned j = 0; j < 16; ++j) { const unsigned c = xb_ld(&bar[XB_XCNT(j)]); sum += c; cnt += (c > 0u) ? 1u : 0u; mine = (j == x) ? c : mine; }
        if (sum == G) break;
        __builtin_amdgcn_s_sleep(1);
        if ((++sp & 255u) == 0u) { if (xb_ld(&bar[XB_TMO])) break; if (sp > XB_SPIN_CAP) { atomicAdd(&bar[XB_TMO], 1u); break; } }
    }
    nloc = mine > 0u ? mine : 1u; nx = cnt > 0u ? cnt : 1u;
}
__device__ __forceinline__ void xcd_barrier(const XcdBarrier& b, int tid) {
    asm volatile("s_waitcnt vmcnt(0)" ::: "memory");
    __syncthreads();
    if (tid == 0) {
        unsigned* bar = b.bar;
        __builtin_amdgcn_s_waitcnt(0);
        unsigned nloc = b.st[0], nx = b.st[1];
        if (nloc == 0u) { xcd_barrier_complete(bar, b.x, nloc, nx); b.st[0] = nloc; b.st[1] = nx; }
        const unsigned old = xb_add(&bar[XB_XSUB(b.x)], 1u);
        const unsigned gen = old / nloc;
        if (old + 1u == (gen + 1u) * nloc) {
            __builtin_amdgcn_fence(__ATOMIC_RELEASE, "agent");
            asm volatile("s_waitcnt vmcnt(0)" ::: "memory");
            const unsigned og = xb_add(&bar[XB_TOP], 1u);
            const unsigned tg = og / nx;
            if (og + 1u == (tg + 1u) * nx) xb_add(&bar[XB_TOPGEN], 1u);
            else XB_SPIN(xb_ld(&bar[XB_TOPGEN]) == tg, bar);
            __builtin_amdgcn_fence(__ATOMIC_ACQUIRE, "agent");
            xb_add(&bar[XB_XGEN(b.x)], 1u);
            asm volatile("s_waitcnt vmcnt(0)" ::: "memory");
        } else {
            XB_SPIN(xb_ld(&bar[XB_XGEN(b.x)]) == gen, bar);
            __builtin_amdgcn_fence(__ATOMIC_ACQUIRE, "agent");
            asm volatile("s_waitcnt vmcnt(0)" ::: "memory");
        }
    }
    __syncthreads();
}

struct Args { const float* in[23]; float* out; unsigned char* ws; int ph_lo, ph_hi; };
struct Frame {
    LAS unsigned char* lds;
    int tid, lane, wave, vcu, G, wave0;
    const Args* pa;
    __device__ __forceinline__ const float* x() const { return pa->in[0]; }
    __device__ __forceinline__ const float* c() const { return pa->in[1]; }
    __device__ __forceinline__ const float* w_ada() const { return pa->in[2]; }
    __device__ __forceinline__ const float* b_ada() const { return pa->in[3]; }
    __device__ __forceinline__ const float* norm1_g() const { return pa->in[4]; }
    __device__ __forceinline__ const float* w_in() const { return pa->in[5]; }
    __device__ __forceinline__ const float* q_norm_g() const { return pa->in[6]; }
    __device__ __forceinline__ const float* k_norm_g() const { return pa->in[7]; }
    __device__ __forceinline__ const float* lru_conv_w() const { return pa->in[8]; }
    __device__ __forceinline__ const float* lru_conv_b() const { return pa->in[9]; }
    __device__ __forceinline__ const float* lru_wa() const { return pa->in[10]; }
    __device__ __forceinline__ const float* lru_ba() const { return pa->in[11]; }
    __device__ __forceinline__ const float* lru_wx() const { return pa->in[12]; }
    __device__ __forceinline__ const float* lru_bx() const { return pa->in[13]; }
    __device__ __forceinline__ const float* lru_lambda() const { return pa->in[14]; }
    __device__ __forceinline__ const float* lru_out_g() const { return pa->in[15]; }
    __device__ __forceinline__ const float* attn_out_g() const { return pa->in[16]; }
    __device__ __forceinline__ const float* w_out() const { return pa->in[17]; }
    __device__ __forceinline__ const float* norm2_g() const { return pa->in[18]; }
    __device__ __forceinline__ const float* w_up() const { return pa->in[19]; }
    __device__ __forceinline__ const float* ffn_conv_w() const { return pa->in[20]; }
    __device__ __forceinline__ const float* ffn_conv_b() const { return pa->in[21]; }
    __device__ __forceinline__ const float* w_down() const { return pa->in[22]; }
    float* out; unsigned char* ws;
};
#define LDS_WAIT() asm volatile("s_waitcnt lgkmcnt(0)" ::: "memory")

template <int MODE>
__device__ __forceinline__ void p0_transpose_item(const float* W, int K, int N, u16* WT, LAS float* scr, int item, int lane, const float* kscale = nullptr) {
    const int nblk = N / 32, kb = item / nblk, nb = item % nblk, k0 = 64 * kb, n0 = 32 * nb;
#pragma unroll
    for (int i = 0; i < 8; ++i) { const int f = i * 64 + lane, kk = f >> 3, n4 = f & 7;
        f32x4 w = *(const GAS f32x4*)(W + (size_t)(k0 + kk) * N + n0 + 4 * n4); if (MODE == 3) w *= kscale[k0 + kk];
        LAS float* d = scr + kk * 33 + 4 * n4; d[0] = w.x; d[1] = w.y; d[2] = w.z; d[3] = w.w; }
    LDS_WAIT(); asm volatile("" ::: "memory");
    const int c = lane & 7;
#pragma unroll
    for (int j = 0; j < 4; ++j) { const int n = (lane >> 3) + 8 * j; const LAS float* s = scr + (8 * c) * 33 + n;
        u32x4 o;
        if (MODE == 1) { o.x = cvt_pk_f16(s[0 * 33], s[1 * 33]); o.y = cvt_pk_f16(s[2 * 33], s[3 * 33]); o.z = cvt_pk_f16(s[4 * 33], s[5 * 33]); o.w = cvt_pk_f16(s[6 * 33], s[7 * 33]); }
        else { o.x = cvt_pk_bf16(s[0 * 33], s[1 * 33]); o.y = cvt_pk_bf16(s[2 * 33], s[3 * 33]); o.z = cvt_pk_bf16(s[4 * 33], s[5 * 33]); o.w = cvt_pk_bf16(s[6 * 33], s[7 * 33]); }
        int nn = n0 + n;
        if (MODE == 1) nn = (nn & ~255) + 128 * ((nn >> 5) & 1) + 32 * ((nn >> 6) & 3) + (nn & 31);
        if (MODE == 2) { const int bj = nn >= D_FF ? 1 : 0, f = nn - bj * D_FF; nn = 256 * (f >> 7) + 128 * bj + (f & 127); }
        if (MODE == 4) *(GAS u32x4*)(WT + (((nn >> 5) * 4 + (c >> 1)) * 512 + ((c & 1) * 32 + (nn & 31)) * 8)) = o;
        else *(GAS u32x4*)(WT + (size_t)nn * K + k0 + 8 * c) = o; }
    LDS_WAIT(); asm volatile("" ::: "memory");
}
__device__ __forceinline__ void p0_prologue(Frame& F) {
    unsigned char* wsp = F.ws; asm volatile("" : "+s"(wsp));
    LAS float* cl = (LAS float*)(F.lds + CLDS_OFF);
    for (int i = F.tid; i < BATCH * D_MODEL; i += NT) cl[i] = F.c()[i];
    __syncthreads();
    LAS float* scr = (LAS float*)(F.lds + F.wave * 16384);
    const int gw = F.wave * F.G + F.vcu, NGW = F.G * NWAVES;
    constexpr int I_MOD = N_MOD / 64;
    constexpr int I_IN = (D_MODEL / 64) * (N_IN / 32), I_O = (D_MODEL / 64) * (D_MODEL / 32), I_DN = (D_FF / 64) * (D_MODEL / 32), I_L = 8 * 2;
    constexpr int NITEMS = I_MOD + I_IN + I_O + I_DN + 2 * I_L;
    u16* WinT = (u16*)(wsp + WS_WIN); u16* WoT = (u16*)(wsp + WS_WO); u16* WdT = (u16*)(wsp + WS_WDN);
    u16* WaT = (u16*)(wsp + WS_WA); u16* WxT = (u16*)(wsp + WS_WX);
    float* MOD = (float*)(wsp + WS_MOD);
    for (int it = gw; it < NITEMS; it += NGW) {
        int r = it;
        if (r < I_MOD) {
            const int col = r * 64 + F.lane; float a0 = 0.f, a1 = 0.f, a2 = 0.f, a3 = 0.f;
            const float* wp = F.w_ada() + col;
#pragma unroll 64
            for (int k = 0; k < D_MODEL; ++k) { const float w = wp[(size_t)k * N_MOD];
                a0 += cl[k] * w; a1 += cl[D_MODEL + k] * w; a2 += cl[2 * D_MODEL + k] * w; a3 += cl[3 * D_MODEL + k] * w; }
            const float bb = F.b_ada()[col];
            MOD[col] = a0 + bb; MOD[N_MOD + col] = a1 + bb; MOD[2 * N_MOD + col] = a2 + bb; MOD[3 * N_MOD + col] = a3 + bb;
            continue; }
        r -= I_MOD;
        if (r < I_IN) { p0_transpose_item<1>(F.w_in(), D_MODEL, N_IN, WinT, scr, r, F.lane); continue; } r -= I_IN;
        if (r < I_O) { const int kb = r / (D_MODEL / 32); p0_transpose_item<3>(F.w_out(), D_MODEL, D_MODEL, WoT, scr, r, F.lane, (kb < 8 ? F.lru_out_g() : F.attn_out_g() - AW)); continue; } r -= I_O;

        if (r < I_DN) { p0_transpose_item<0>(F.w_down(), D_FF, D_MODEL, WdT, scr, r, F.lane); continue; } r -= I_DN;
        if (r < I_L) { const int h = r >> 1; p0_transpose_item<4>(F.lru_wa() + h * 4096, 64, 64, WaT + h * 4096, scr, r & 1, F.lane); continue; } r -= I_L;
        { const int h = r >> 1; p0_transpose_item<4>(F.lru_wx() + h * 4096, 64, 64, WxT + h * 4096, scr, r & 1, F.lane); }
    }
}


constexpr int SCL_OFF = RING_BYTES;
__device__ __forceinline__ void p1_upweights(Frame& F, unsigned char* wsp) {
    const float* MODp = (const float*)(wsp + WS_MOD);
    LAS float* SC = (LAS float*)(F.lds + SCL_OFF);
#define SHB(b) ((LAS float*)(F.lds + 16384 * (b) + 8448))
    for (int i = F.tid; i < BATCH * D_MODEL; i += NT) { const int b = i >> 10, k = i & 1023; SC[i] = F.norm2_g()[k] * (1.0f + MODp[(size_t)b * N_MOD + 4096 + k]); SHB(b)[k] = MODp[(size_t)b * N_MOD + 3072 + k]; }
    __syncthreads();
    LAS float* scr = (LAS float*)(F.lds + F.wave * 16384);
    u16* W4 = (u16*)(wsp + WS_WUP4); float* BIAS2 = (float*)(wsp + WS_BIAS2);
    const float* W = F.w_up();
    const int gw = F.wave * F.G + F.vcu, NGW = F.G * NWAVES, lane = F.lane;
    for (int it = gw; it < 4 * (N_UP / 32); it += NGW) {
        const int n0 = 32 * (it >> 2), kc = it & 3;
        float bs0 = 0.f, bs1 = 0.f, bs2 = 0.f, bs3 = 0.f;
#pragma unroll 1
        for (int kb = 4 * kc; kb < 4 * kc + 4; ++kb) {
            const int k0 = 64 * kb;
#pragma unroll
            for (int i = 0; i < 8; ++i) { const int f = i * 64 + lane, kk = f >> 3, n4 = f & 7;
                const f32x4 w = *(const GAS f32x4*)(W + (size_t)(k0 + kk) * N_UP + n0 + 4 * n4);
                LAS float* d = scr + kk * 33 + 4 * n4; d[0] = w.x; d[1] = w.y; d[2] = w.z; d[3] = w.w; }
            LDS_WAIT(); asm volatile("" ::: "memory");
            { const int n = lane & 31, kh = lane >> 5;
#pragma unroll 8
              for (int kk = 0; kk < 32; ++kk) { const float w = scr[(32 * kh + kk) * 33 + n]; const int k = k0 + 32 * kh + kk;
                  bs0 += SHB(0)[k] * w; bs1 += SHB(1)[k] * w; bs2 += SHB(2)[k] * w; bs3 += SHB(3)[k] * w; } }
            const int c = lane & 7;
#pragma unroll
            for (int j = 0; j < 4; ++j) { const int n = (lane >> 3) + 8 * j; const LAS float* s = scr + (8 * c) * 33 + n;
                int nn = n0 + n; { const int bj = nn >= D_FF ? 1 : 0, f = nn - bj * D_FF; nn = 256 * (f >> 7) + 128 * bj + (f & 127); }
                float wv[8];
#pragma unroll
                for (int e = 0; e < 8; ++e) wv[e] = s[e * 33];
#pragma unroll
                for (int b = 0; b < BATCH; ++b) { const LAS float* sc = SC + b * 1024 + k0 + 8 * c;
                    u32x4 o; o.x = cvt_pk_bf16(wv[0] * sc[0], wv[1] * sc[1]); o.y = cvt_pk_bf16(wv[2] * sc[2], wv[3] * sc[3]); o.z = cvt_pk_bf16(wv[4] * sc[4], wv[5] * sc[5]); o.w = cvt_pk_bf16(wv[6] * sc[6], wv[7] * sc[7]);
                    *(GAS u32x4*)(W4 + ((size_t)b * N_UP + nn) * D_MODEL + k0 + 8 * c) = o; } }
            LDS_WAIT(); asm volatile("" ::: "memory");
        }
        bs0 += __shfl_xor(bs0, 32); bs1 += __shfl_xor(bs1, 32); bs2 += __shfl_xor(bs2, 32); bs3 += __shfl_xor(bs3, 32);
        if (lane < 32) { float* bp = BIAS2 + (size_t)kc * BATCH * N_UP + n0 + lane; bp[0] = bs0; bp[N_UP] = bs1; bp[2 * N_UP] = bs2; bp[3 * N_UP] = bs3; }
    }
}


__device__ __forceinline__ void cb2_prep(Frame& F, unsigned char* wsp) {
    const float* BIAS2 = (const float*)(wsp + WS_BIAS2); float* CB2 = (float*)(wsp + WS_CB2);
    const float* cw = F.ffn_conv_w(); const float* cb = F.ffn_conv_b();
    for (int i = F.vcu * NT + F.tid; i < BATCH * N_UP; i += F.G * NT) { const int b = i / N_UP, col = i % N_UP;
        const float bias = (BIAS2[(size_t)(0 * BATCH + b) * N_UP + col] + BIAS2[(size_t)(1 * BATCH + b) * N_UP + col]) + (BIAS2[(size_t)(2 * BATCH + b) * N_UP + col] + BIAS2[(size_t)(3 * BATCH + b) * N_UP + col]);
        CB2[i] = cb[col] + ((cw[col] + cw[N_UP + col]) + cw[2 * N_UP + col]) * bias; }
}

template <bool F16>
__device__ __forceinline__ void rownorm_phase(Frame& F, const float* X, const float* g, const float* sh, const float* sc, u16* O) {
    const int gw = F.vcu * NWAVES + F.wave, NGW = F.G * NWAVES;
    for (int m = gw; m < M_TOK; m += NGW) {
        const int b = m / SEQ;
        const GAS f32x4* xr = (const GAS f32x4*)(X + (size_t)m * D_MODEL) + F.lane;
        f32x4 v[4]; float s = 0.f;
#pragma unroll
        for (int j = 0; j < 4; ++j) { v[j] = xr[64 * j]; s += (v[j].x * v[j].x + v[j].y * v[j].y) + (v[j].z * v[j].z + v[j].w * v[j].w); }
        const float rstd = 1.0f / sqrtf(wave_sum(s) * (1.0f / D_MODEL) + EPS);
        GAS u32x2* o8 = (GAS u32x2*)(O + (size_t)m * D_MODEL) + F.lane;
#pragma unroll
        for (int j = 0; j < 4; ++j) {
            const int col = 4 * F.lane + 256 * j;
            const f32x4 gv = *(const f32x4*)(g + col), shv = *(const f32x4*)(sh + (size_t)b * N_MOD + col), scv = *(const f32x4*)(sc + (size_t)b * N_MOD + col);
            const f32x4 y = (v[j] * rstd) * gv * (scv + 1.0f) + shv;
            u32x2 w;
            if (F16) { w.x = cvt_pk_f16(y.x, y.y); w.y = cvt_pk_f16(y.z, y.w); } else { w.x = cvt_pk_bf16(y.x, y.y); w.y = cvt_pk_bf16(y.z, y.w); }
            o8[64 * j] = w; }
    }
}

__device__ __forceinline__ int crow(int r, int hi) { return (r & 3) + 8 * (r >> 2) + 4 * hi; }
constexpr int AL_QS = 0, AL_SLOT = 32768, AL_LSL = 131072, AL_LIST = 134144, AL_CNT = 150528, AL_MISC = 150656, AL_KMS = 150912;
__device__ __forceinline__ void attn_tile(const u16* Kp, const u16* Vp, const s16x8 (&qf)[4], int nkt, bool own, int tt, int qidx, int hi, float c1, float c2, f32x16& o0, f32x16& o1, float& lsum) {
#pragma unroll
    for (int r = 0; r < 16; ++r) { o0[r] = 0.f; o1[r] = 0.f; }
    lsum = 0.f;
    s16x8 kc[4], kn[4], vc[4];
#pragma unroll
    for (int s = 0; s < 4; ++s) { kc[s] = *(const GAS s16x8*)(Kp + s * 512); kn[s] = kc[s]; }
#pragma unroll 1
    for (int kt = 0; kt < nkt; ++kt) {
#pragma unroll
        for (int s = 0; s < 4; ++s) vc[s] = *(const GAS s16x8*)(Vp + (kt * 4 + s) * 512);
        if (kt + 1 < nkt) {
#pragma unroll
            for (int s = 0; s < 4; ++s) kn[s] = *(const GAS s16x8*)(Kp + ((kt + 1) * 4 + s) * 512);
        }
        f32x16 p;
#pragma unroll
        for (int r = 0; r < 16; ++r) p[r] = 0.f;
#pragma unroll
        for (int s = 0; s < 4; ++s) p = __builtin_amdgcn_mfma_f32_32x32x16_bf16(__builtin_bit_cast(bf16x8_t, kc[s]), __builtin_bit_cast(bf16x8_t, qf[s]), p, 0, 0, 0);
        const bool diag = own && (kt == tt);
#pragma unroll
        for (int r = 0; r < 16; ++r) { float e = __builtin_amdgcn_exp2f(p[r] * c1 - c2);
            if (diag && (32 * kt + crow(r, hi) > qidx)) e = 0.f;
            p[r] = e; lsum += e; }
#pragma unroll
        for (int s2 = 0; s2 < 2; ++s2) {
            u32x4 pw; pw.x = cvt_pk_bf16(p[8 * s2 + 0], p[8 * s2 + 1]); pw.y = cvt_pk_bf16(p[8 * s2 + 2], p[8 * s2 + 3]); pw.z = cvt_pk_bf16(p[8 * s2 + 4], p[8 * s2 + 5]); pw.w = cvt_pk_bf16(p[8 * s2 + 6], p[8 * s2 + 7]);
            const bf16x8_t pa = __builtin_bit_cast(bf16x8_t, pw);
            o0 = __builtin_amdgcn_mfma_f32_32x32x16_bf16(pa, __builtin_bit_cast(bf16x8_t, vc[2 * s2]), o0, 0, 0, 0);
            o1 = __builtin_amdgcn_mfma_f32_32x32x16_bf16(pa, __builtin_bit_cast(bf16x8_t, vc[2 * s2 + 1]), o1, 0, 0, 0);
        }
#pragma unroll
        for (int s = 0; s < 4; ++s) kc[s] = kn[s];
    }
}
__device__ __forceinline__ void attn_item(Frame& F, int bh, int i, float c1, float c2) {
    unsigned char* wsp = F.ws; asm volatile("" : "+s"(wsp));
    const float* QF = (const float*)(wsp + WS_QF); const u16* KB = (const u16*)(wsp + WS_KB); const u16* VT = (const u16*)(wsp + WS_VT);
    const float* KM = (const float*)(wsp + WS_KM); u16* ATT = (u16*)(wsp + WS_MIX); float* SSQA = (float*)(wsp + WS_SSQA);
    LAS u16* QS = (LAS u16*)(F.lds + AL_QS); LAS u16* SLOT = (LAS u16*)(F.lds + AL_SLOT); LAS float* LSL = (LAS float*)(F.lds + AL_LSL);
    LAS float* KMS = (LAS float*)(F.lds + AL_KMS); LAS u16* LIST = (LAS u16*)(F.lds + AL_LIST); LAS int* CNT = (LAS int*)(F.lds + AL_CNT);
    const int tid = F.tid, lane = F.lane, wave = F.wave, hi = lane >> 5, l31 = lane & 31;
    const int b = bh / NHEAD, h = bh % NHEAD;
    for (int u = tid; u < (3 * 32768 + 3072) / 16; u += NT) *(LAS u32x4*)(F.lds + AL_SLOT + u * 16) = (u32x4){0u, 0u, 0u, 0u};
    if (tid < 32) CNT[tid] = 0;
    for (int u = tid; u < NBLK * HD; u += NT) { const int n = u >> 6, d = u & 63; KMS[u] = KM[(((size_t)(b * NBLK + n)) * NHEAD + h) * HD + d] * (1.0f / 256.0f); }
    __syncthreads();
    {
        const int q = 32 * wave + l31;
        const GAS f32x4* qrow = (const GAS f32x4*)(QF + ((size_t)bh * SEQ + (size_t)i * BLK + q) * HD);
        f32x16 p;
#pragma unroll
        for (int r = 0; r < 16; ++r) p[r] = 0.f;
#pragma unroll
        for (int s = 0; s < 4; ++s) {
            const f32x4 qa = qrow[4 * s + 2 * hi], qc = qrow[4 * s + 2 * hi + 1];
            u32x4 qh; qh.x = cvt_pk_bf16(qa.x, qa.y); qh.y = cvt_pk_bf16(qa.z, qa.w); qh.z = cvt_pk_bf16(qc.x, qc.y); qh.w = cvt_pk_bf16(qc.z, qc.w);
            u32x4 ql; ql.x = cvt_pk_bf16(qa.x - bf_lo(qh.x), qa.y - bf_hi(qh.x)); ql.y = cvt_pk_bf16(qa.z - bf_lo(qh.y), qa.w - bf_hi(qh.y));
            ql.z = cvt_pk_bf16(qc.x - bf_lo(qh.z), qc.y - bf_hi(qh.z)); ql.w = cvt_pk_bf16(qc.z - bf_lo(qh.w), qc.w - bf_hi(qh.w));
            *(LAS u32x4*)(QS + q * 64 + 16 * s + 8 * hi) = qh;
            const LAS f32x4* kr = (const LAS f32x4*)(KMS + l31 * 64 + 16 * s + 8 * hi);
            const f32x4 ka = kr[0], kc = kr[1];
            u32x4 kh; kh.x = cvt_pk_bf16(ka.x, ka.y); kh.y = cvt_pk_bf16(ka.z, ka.w); kh.z = cvt_pk_bf16(kc.x, kc.y); kh.w = cvt_pk_bf16(kc.z, kc.w);
            u32x4 kl; kl.x = cvt_pk_bf16(ka.x - bf_lo(kh.x), ka.y - bf_hi(kh.x)); kl.y = cvt_pk_bf16(ka.z - bf_lo(kh.y), ka.w - bf_hi(kh.y));
            kl.z = cvt_pk_bf16(kc.x - bf_lo(kh.z), kc.y - bf_hi(kh.z)); kl.w = cvt_pk_bf16(kc.z - bf_lo(kh.w), kc.w - bf_hi(kh.w));
            p = __builtin_amdgcn_mfma_f32_32x32x16_bf16(__builtin_bit_cast(bf16x8_t, kl), __builtin_bit_cast(bf16x8_t, qh), p, 0, 0, 0);
            p = __builtin_amdgcn_mfma_f32_32x32x16_bf16(__builtin_bit_cast(bf16x8_t, kh), __builtin_bit_cast(bf16x8_t, ql), p, 0, 0, 0);
            p = __builtin_amdgcn_mfma_f32_32x32x16_bf16(__builtin_bit_cast(bf16x8_t, kh), __builtin_bit_cast(bf16x8_t, qh), p, 0, 0, 0);
        }
        float v0 = -INFINITY, v1 = -INFINITY, v2 = -INFINITY; int i0 = -1, i1 = -1, i2 = -1;
#pragma unroll
        for (int r = 0; r < 16; ++r) {
            const int n = crow(r, hi); const float g = (n < i) ? p[r] : -INFINITY;
            if (g > v0) { v2 = v1; i2 = i1; v1 = v0; i1 = i0; v0 = g; i0 = n; }
            else if (g > v1) { v2 = v1; i2 = i1; v1 = g; i1 = n; }
            else if (g > v2) { v2 = g; i2 = n; }
        }
        const float pv0 = __shfl_xor(v0, 32), pv1 = __shfl_xor(v1, 32), pv2 = __shfl_xor(v2, 32);
        const int pi0 = __shfl_xor(i0, 32), pi1 = __shfl_xor(i1, 32), pi2 = __shfl_xor(i2, 32);
        if (hi == 0) {
            float av[3] = {v0, v1, v2}, bv[3] = {pv0, pv1, pv2}; int ai[3] = {i0, i1, i2}, bi[3] = {pi0, pi1, pi2};
            int sel[3]; int pa = 0, pb = 0;
#pragma unroll
            for (int k = 0; k < 3; ++k) {
                const float ca = pa == 0 ? av[0] : (pa == 1 ? av[1] : av[2]); const int cai = pa == 0 ? ai[0] : (pa == 1 ? ai[1] : ai[2]);
                const float cb = pb == 0 ? bv[0] : (pb == 1 ? bv[1] : bv[2]); const int cbi = pb == 0 ? bi[0] : (pb == 1 ? bi[1] : bi[2]);
                if (ca > cb || (ca == cb && (cbi < 0 || (cai >= 0 && cai < cbi)))) { sel[k] = cai; ++pa; } else { sel[k] = cbi; ++pb; }
            }
#pragma unroll
            for (int k = 0; k < 3; ++k) if (sel[k] >= 0) { const int pos = __hip_atomic_fetch_add(&CNT[sel[k]], 1, __ATOMIC_RELAXED, __HIP_MEMORY_SCOPE_WORKGROUP); LIST[sel[k] * 256 + pos] = (u16)(q | (k << 8)); }
        }
    }
    __syncthreads();
    {
        int base = 0;
        for (int j = 0; j < i; ++j) {
            const int cntj = __builtin_amdgcn_readfirstlane(CNT[j]);
            const int ntj = (cntj + 31) >> 5;
            for (int t = base + ((wave - base) & 7); t < base + ntj; t += 8) {
                const int tt = t - base;
                const int ridx = 32 * tt + l31; const bool valid = ridx < cntj;
                const int ent = valid ? (int)LIST[j * 256 + ridx] : 0;
                const int qidx = ent & 255;
                s16x8 qf[4];
#pragma unroll
                for (int s = 0; s < 4; ++s) qf[s] = *(const LAS s16x8*)(QS + qidx * 64 + 16 * s + 8 * hi);
                const size_t boff = ((size_t)bh * NBLK + j) * (BLK * HD) + lane * 8;
                f32x16 o0, o1; float lsum;
                attn_tile(KB + boff, VT + boff, qf, 8, false, 0, qidx, hi, c1, c2, o0, o1, lsum);
                const int srow = valid ? ((ent >> 8) * 256 + qidx) : -1;
                lsum += __shfl_xor(lsum, 32);
                if (valid && hi == 0) LSL[srow] = lsum;
#pragma unroll
                for (int r = 0; r < 16; ++r) { const int sr = __shfl(srow, crow(r, hi));
                    if (sr >= 0) { const unsigned w = cvt_pk_bf16(o0[r], o1[r]); SLOT[sr * 64 + l31] = (u16)(w & 0xffffu); SLOT[sr * 64 + 32 + l31] = (u16)(w >> 16); }
                    if ((r & 3) == 3) asm volatile("" ::: "memory"); }
            }
            base += ntj;
        }
    }
    f32x16 oo0, oo1; float lown;
    {
        s16x8 qf[4];
#pragma unroll
        for (int s = 0; s < 4; ++s) qf[s] = *(const LAS s16x8*)(QS + (32 * wave + l31) * 64 + 16 * s + 8 * hi);
        const size_t boff = ((size_t)bh * NBLK + i) * (BLK * HD) + lane * 8;
        attn_tile(KB + boff, VT + boff, qf, wave + 1, true, wave, 32 * wave + l31, hi, c1, c2, oo0, oo1, lown);
    }
    __syncthreads();
    {
        const int q = 32 * wave + l31;
        float lt = lown + __shfl_xor(lown, 32);
        lt += LSL[q] + LSL[256 + q] + LSL[512 + q];
        const float inv = 1.0f / lt;
#pragma unroll
        for (int r = 0; r < 16; ++r) { const int rl = crow(r, hi), qq = 32 * wave + rl; const float iv = __shfl(inv, rl);
            float a = oo0[r], c = oo1[r];
#pragma unroll
            for (int k = 0; k < 3; ++k) { a += __builtin_bit_cast(float, (unsigned)SLOT[(k * 256 + qq) * 64 + l31] << 16); c += __builtin_bit_cast(float, (unsigned)SLOT[(k * 256 + qq) * 64 + 32 + l31] << 16); }
            const unsigned w = cvt_pk_bf16(a * iv, c * iv);
            QS[qq * 64 + l31] = (u16)(w & 0xffffu); QS[qq * 64 + 32 + l31] = (u16)(w >> 16);
            if ((r & 3) == 3) asm volatile("" ::: "memory"); }
        LDS_WAIT(); asm volatile("" ::: "memory");
#pragma unroll
        for (int it = 0; it < 4; ++it) { const int c = lane + 64 * it, row = c >> 3, ch = c & 7;
            const u32x4 w = *(const LAS u32x4*)(QS + (32 * wave + row) * 64 + 8 * ch);
            const size_t tok = (size_t)b * SEQ + (size_t)i * BLK + 32 * wave + row;
            *(GAS u32x4*)(ATT + tok * D_MODEL + AW + h * HD + 8 * ch) = w;
            float ss = bf_lo(w.x) * bf_lo(w.x) + bf_hi(w.x) * bf_hi(w.x) + bf_lo(w.y) * bf_lo(w.y) + bf_hi(w.y) * bf_hi(w.y) + bf_lo(w.z) * bf_lo(w.z) + bf_hi(w.z) * bf_hi(w.z) + bf_lo(w.w) * bf_lo(w.w) + bf_hi(w.w) * bf_hi(w.w);
            ss += __shfl_xor(ss, 1); ss += __shfl_xor(ss, 2); ss += __shfl_xor(ss, 4);
            if (ch == 0) SSQA[tok * NHEAD + h] = ss; }
    }
    __syncthreads();
}
__device__ __forceinline__ void attn_phase(Frame& F) {
    LAS float* mm = (LAS float*)(F.lds + AL_MISC);
    if (F.tid < 64) { float a = fabsf(F.q_norm_g()[F.tid]), c = fabsf(F.k_norm_g()[F.tid]);
#pragma unroll
        for (int o = 1; o < 64; o <<= 1) { a = fmaxf(a, __shfl_xor(a, o)); c = fmaxf(c, __shfl_xor(c, o)); }
        if (F.tid == 0) { mm[0] = a; mm[1] = c; } }
    __syncthreads();
    const float C = 8.0f * mm[0] * mm[1];
    const float c1 = 0.125f * LOG2E, c2 = C * LOG2E;
    __syncthreads();
    if (F.G == 256) {
        const int xcd = F.vcu >> 5, k = F.vcu & 31;
#pragma unroll 1
        for (int r = 0; r < 4; ++r) attn_item(F, xcd * 4 + r, (r & 1) ? 31 - k : k, c1, c2);
    } else {
        for (int it = F.vcu; it < BATCH * NHEAD * NBLK; it += F.G) attn_item(F, it >> 5, it & 31, c1, c2);
    }
}

constexpr int LL_CW = 0;
template <bool FINAL>
__device__ __forceinline__ void lru_item(Frame& F, int b, int chunk) {
    unsigned char* wsp = F.ws; asm volatile("" : "+s"(wsp));
    const u16* XR = (const u16*)(wsp + WS_XR); const u16* GG = (const u16*)(wsp + WS_GG);
    const u16* WaT = (const u16*)(wsp + WS_WA); const u16* WxT = (const u16*)(wsp + WS_WX);
    float* AGG = (float*)(wsp + WS_AGG); u16* LRU = (u16*)(wsp + WS_MIX); float* SSQL = (float*)(wsp + WS_SSQL);
    const int lane = F.lane, hd = F.wave, hi = lane >> 5, j = lane & 31;
    LAS float* CW = (LAS float*)(F.lds + LL_CW + hd * 2048);
    LAS u16* OT = (LAS u16*)(F.lds + 16384 + hd * 4096);
    for (int u = lane; u < 320; u += 64) CW[u] = (u < 256) ? F.lru_conv_w()[(u >> 6) * AW + hd * HD + (u & 63)] : F.lru_conv_b()[hd * HD + (u - 256)];
    CW[320 + lane] = F.lru_ba()[hd * HD + lane]; CW[384 + lane] = F.lru_bx()[hd * HD + lane]; CW[448 + lane] = 8.0f * log1pf(expf(-F.lru_lambda()[hd * HD + lane]));
    LDS_WAIT(); asm volatile("" ::: "memory");
    float carry[2], arun[2];
#pragma unroll
    for (int ct = 0; ct < 2; ++ct) { const int c = hd * HD + 32 * ct + j; carry[ct] = 0.f; arun[ct] = 1.f;
        if (FINAL) { float hcar = 0.f; for (int cc = 0; cc < chunk; ++cc) { const f32x2 ah = *(const f32x2*)(AGG + (((size_t)(b * 64 + cc)) * AW + c) * 2); hcar = ah.x * hcar + ah.y; } carry[ct] = hcar; } }
    for (int tile = 0; tile < 4; ++tile) {
        const int t0 = chunk * 128 + tile * 32;
        const u16* WaTt = WaT; const u16* WxTt = WxT; int jt = j; asm volatile("" : "+s"(WaTt), "+s"(WxTt), "+v"(jt));
        const int pos = t0 + j;
        s16x8 af[4];
#pragma unroll
        for (int s = 0; s < 4; ++s) {
            const int ch0 = 16 * s + 8 * hi;
            float xc[8];
            { const LAS f32x4* bp = (const LAS f32x4*)(CW + 256 + ch0); const f32x4 b0 = bp[0], b1 = bp[1];
              xc[0] = b0.x; xc[1] = b0.y; xc[2] = b0.z; xc[3] = b0.w; xc[4] = b1.x; xc[5] = b1.y; xc[6] = b1.z; xc[7] = b1.w; }
            float accv[8];
#pragma unroll
            for (int e = 0; e < 8; ++e) accv[e] = 0.f;
#pragma unroll
            for (int jj = 0; jj < 4; ++jj) {
                const int p = pos - 3 + jj;
                u32x4 xw = (u32x4){0u, 0u, 0u, 0u};
                if (p >= 0) xw = *(const GAS u32x4*)(XR + ((((size_t)b * (SEQ / 32) + (p >> 5)) * NHEAD + hd) * 2048) + ((s * 2 + hi) * 32 + (p & 31)) * 8);
                const LAS f32x4* wp = (const LAS f32x4*)(CW + jj * 64 + ch0); const f32x4 w0 = wp[0], w1 = wp[1];
                accv[0] += w0.x * bf_lo(xw.x); accv[1] += w0.y * bf_hi(xw.x); accv[2] += w0.z * bf_lo(xw.y); accv[3] += w0.w * bf_hi(xw.y);
                accv[4] += w1.x * bf_lo(xw.z); accv[5] += w1.y * bf_hi(xw.z); accv[6] += w1.z * bf_lo(xw.w); accv[7] += w1.w * bf_hi(xw.w);
            }
#pragma unroll
            for (int e = 0; e < 8; ++e) xc[e] += accv[e];
            u32x4 aw; aw.x = cvt_pk_bf16(xc[0], xc[1]); aw.y = cvt_pk_bf16(xc[2], xc[3]); aw.z = cvt_pk_bf16(xc[4], xc[5]); aw.w = cvt_pk_bf16(xc[6], xc[7]);
            af[s] = __builtin_bit_cast(s16x8, aw);
            __builtin_amdgcn_sched_barrier(0);
        }
        float ssacc[16];
#pragma unroll
        for (int r = 0; r < 16; ++r) ssacc[r] = 0.f;
#pragma unroll
        for (int ct = 0; ct < 2; ++ct) {
            float av[16], uv[16];
            {
                f32x16 aA, aX;
#pragma unroll
                for (int r = 0; r < 16; ++r) { aA[r] = 0.f; aX[r] = 0.f; }
#pragma unroll
                for (int s = 0; s < 4; ++s) {
                    const size_t woff = (size_t)hd * 4096 + (ct * 4 + s) * 512 + lane * 8;
                    const s16x8 wa = *(const GAS s16x8*)(WaTt + woff), wx = *(const GAS s16x8*)(WxTt + woff);
                    const bf16x8_t a = __builtin_bit_cast(bf16x8_t, af[s]);
                    aA = __builtin_amdgcn_mfma_f32_32x32x16_bf16(a, __builtin_bit_cast(bf16x8_t, wa), aA, 0, 0, 0);
                    aX = __builtin_amdgcn_mfma_f32_32x32x16_bf16(a, __builtin_bit_cast(bf16x8_t, wx), aX, 0, 0, 0);
                }
                const float bac = CW[320 + 32 * ct + jt], bxc = CW[384 + 32 * ct + jt], sp8c = CW[448 + 32 * ct + jt];
#pragma unroll
                for (int r = 0; r < 16; ++r) {
                    const float rr = sigmoidf_(aA[r] + bac), ii = sigmoidf_(aX[r] + bxc);
                    const float la = -rr * sp8c;
                    const float a = __builtin_amdgcn_exp2f(la * LOG2E);
                    const float x2 = 2.0f * la;
                    const float om = (x2 > -0.05f) ? -x2 * (1.0f + x2 * 0.5f * (1.0f + x2 * (1.0f / 3.0f) * (1.0f + x2 * 0.25f))) : 1.0f - a * a;
                    av[r] = a; uv[r] = __builtin_amdgcn_sqrtf(om) * ii;
                }
            }
            f32x16 aG;
            {
                f32x16 aI;
#pragma unroll
                for (int r = 0; r < 16; ++r) { aI[r] = 0.f; aG[r] = 0.f; }
#pragma unroll
                for (int s = 0; s < 4; ++s) {
                    s16x8 id;
#pragma unroll
                    for (int e = 0; e < 8; ++e) id[e] = (16 * s + 8 * hi + e == 32 * ct + jt) ? (short)0x3F80 : (short)0;
                    aI = __builtin_amdgcn_mfma_f32_32x32x16_bf16(__builtin_bit_cast(bf16x8_t, af[s]), __builtin_bit_cast(bf16x8_t, id), aI, 0, 0, 0);
                    if (FINAL) { const s16x8 gfr = *(const GAS s16x8*)(GG + ((((size_t)b * (SEQ / 32) + (t0 >> 5)) * NHEAD + hd) * 2048) + s * 512 + lane * 8);
                        aG = __builtin_amdgcn_mfma_f32_32x32x16_bf16(__builtin_bit_cast(bf16x8_t, gfr), __builtin_bit_cast(bf16x8_t, id), aG, 0, 0, 0); }
                }
#pragma unroll
                for (int r = 0; r < 16; ++r) uv[r] *= aI[r];
            }
            float Ag[4], Ug[4];
#pragma unroll
            for (int g = 0; g < 4; ++g) { float A = av[4 * g], U = uv[4 * g];
#pragma unroll
                for (int e = 1; e < 4; ++e) { A *= av[4 * g + e]; U = av[4 * g + e] * U + uv[4 * g + e]; }
                Ag[g] = A; Ug[g] = U; }
            float h = carry[ct], ap = arun[ct];
            float hin[4];
#pragma unroll
            for (int g = 0; g < 4; ++g) {
                const float pA = __shfl_xor(Ag[g], 32), pU = __shfl_xor(Ug[g], 32);
                const float fA = hi ? pA : Ag[g], fU = hi ? pU : Ug[g], sA = hi ? Ag[g] : pA, sU = hi ? Ug[g] : pU;
                const float h1 = fA * h + fU;
                hin[g] = hi ? h1 : h;
                h = sA * h1 + sU; ap *= fA * sA;
            }
            carry[ct] = h; arun[ct] = ap;
            if (FINAL) {
#pragma unroll
                for (int g = 0; g < 4; ++g) { float hh = hin[g];
#pragma unroll
                    for (int e = 0; e < 4; ++e) { const int r = 4 * g + e; hh = av[r] * hh + uv[r]; const float o = hh * aG[r]; ssacc[r] += o * o;
                        OT[crow(r, hi) * 64 + 32 * ct + j] = (u16)(cvt_pk_bf16(o, 0.f) & 0xffffu); } }
            }
        }
        if (FINAL) {
#pragma unroll
            for (int r = 0; r < 16; ++r) {
                const size_t tok = (size_t)b * SEQ + t0 + crow(r, hi);
                float ss = ssacc[r];
                ss += __shfl_xor(ss, 1); ss += __shfl_xor(ss, 2); ss += __shfl_xor(ss, 4); ss += __shfl_xor(ss, 8); ss += __shfl_xor(ss, 16);
                if (j == 0) SSQL[tok * NHEAD + hd] = ss;
            }
            LDS_WAIT(); asm volatile("" ::: "memory");
#pragma unroll
            for (int it = 0; it < 4; ++it) { const int c = lane + 64 * it, row = c >> 3, ch = c & 7;
                const u32x4 w = *(const LAS u32x4*)(OT + row * 64 + 8 * ch);
                *(GAS u32x4*)(LRU + ((size_t)b * SEQ + t0 + row) * D_MODEL + hd * HD + 8 * ch) = w; }
            LDS_WAIT(); asm volatile("" ::: "memory");
        }
    }
    if (!FINAL) { if (hi == 0) {
#pragma unroll
        for (int ct = 0; ct < 2; ++ct) { const int c = hd * HD + 32 * ct + j; *(f32x2*)(AGG + (((size_t)(b * 64 + chunk)) * AW + c) * 2) = (f32x2){arun[ct], carry[ct]}; } } }
}
template <bool FINAL>
__device__ __forceinline__ void lru_phase(Frame& F) {
    for (int it = F.vcu; it < BATCH * 64; it += F.G) { lru_item<FINAL>(F, it >> 6, it & 63); }
}

__device__ __forceinline__ void mix_phase(Frame& F) {
    unsigned char* wsp = F.ws; asm volatile("" : "+s"(wsp));
    const u16* LRU = (const u16*)(wsp + WS_LRU); const u16* ATT = (const u16*)(wsp + WS_ATT);
    const float* SSQL = (const float*)(wsp + WS_SSQL); const float* SSQA = (const float*)(wsp + WS_SSQA); u16* MIX = (u16*)(wsp + WS_MIX);
    const int gw = F.vcu * NWAVES + F.wave, NGW = F.G * NWAVES, lane = F.lane;
    const f32x4 gl0 = *(const f32x4*)(F.lru_out_g() + 8 * lane), gl1 = *(const f32x4*)(F.lru_out_g() + 8 * lane + 4);
    const f32x4 ga0 = *(const f32x4*)(F.attn_out_g() + 8 * lane), ga1 = *(const f32x4*)(F.attn_out_g() + 8 * lane + 4);
    for (int m = gw; m < M_TOK; m += NGW) {
        const f32x4 s0 = *(const GAS f32x4*)(SSQL + (size_t)m * 8), s1 = *(const GAS f32x4*)(SSQL + (size_t)m * 8 + 4);
        const f32x4 t0 = *(const GAS f32x4*)(SSQA + (size_t)m * 8), t1 = *(const GAS f32x4*)(SSQA + (size_t)m * 8 + 4);
        const float ssl = ((s0.x + s0.y) + (s0.z + s0.w)) + ((s1.x + s1.y) + (s1.z + s1.w));
        const float ssa = ((t0.x + t0.y) + (t0.z + t0.w)) + ((t1.x + t1.y) + (t1.z + t1.w));
        const float rl = 1.0f / sqrtf(ssl * (1.0f / AW) + EPS), ra = 1.0f / sqrtf(ssa * (1.0f / AW) + EPS);
        const u32x4 lw = *(const GAS u32x4*)(LRU + (size_t)m * AW + 8 * lane), aw = *(const GAS u32x4*)(ATT + (size_t)m * AW + 8 * lane);
        u32x4 o;
        o.x = cvt_pk_bf16(bf_lo(lw.x) * rl * gl0.x, bf_hi(lw.x) * rl * gl0.y); o.y = cvt_pk_bf16(bf_lo(lw.y) * rl * gl0.z, bf_hi(lw.y) * rl * gl0.w);
        o.z = cvt_pk_bf16(bf_lo(lw.z) * rl * gl1.x, bf_hi(lw.z) * rl * gl1.y); o.w = cvt_pk_bf16(bf_lo(lw.w) * rl * gl1.z, bf_hi(lw.w) * rl * gl1.w);
        *(GAS u32x4*)(MIX + (size_t)m * D_MODEL + 8 * lane) = o;
        o.x = cvt_pk_bf16(bf_lo(aw.x) * ra * ga0.x, bf_hi(aw.x) * ra * ga0.y); o.y = cvt_pk_bf16(bf_lo(aw.y) * ra * ga0.z, bf_hi(aw.y) * ra * ga0.w);
        o.z = cvt_pk_bf16(bf_lo(aw.z) * ra * ga1.x, bf_hi(aw.z) * ra * ga1.y); o.w = cvt_pk_bf16(bf_lo(aw.w) * ra * ga1.z, bf_hi(aw.w) * ra * ga1.w);
        *(GAS u32x4*)(MIX + (size_t)m * D_MODEL + AW + 8 * lane) = o;
    }
}

__device__ __forceinline__ void ffn_fixup(Frame& F, unsigned char* wsp, int pm) {
    const float* RAW = (const float*)(wsp + WS_RAW); u16* ACT = (u16*)(wsp + WS_ACT);
    const float* cw = F.ffn_conv_w(); const float* cb = F.ffn_conv_b();
    const bool first = (pm % NBLK) == 0;
    for (int f = F.tid; f < D_FF; f += NT) {
        float xg[4], xv[4];
        xg[0] = first ? 0.f : RAW[((size_t)(pm - 1) * 4 + 2) * N_UP + f]; xg[1] = first ? 0.f : RAW[((size_t)(pm - 1) * 4 + 3) * N_UP + f];
        xv[0] = first ? 0.f : RAW[((size_t)(pm - 1) * 4 + 2) * N_UP + D_FF + f]; xv[1] = first ? 0.f : RAW[((size_t)(pm - 1) * 4 + 3) * N_UP + D_FF + f];
        xg[2] = RAW[((size_t)pm * 4 + 0) * N_UP + f]; xg[3] = RAW[((size_t)pm * 4 + 1) * N_UP + f];
        xv[2] = RAW[((size_t)pm * 4 + 0) * N_UP + D_FF + f]; xv[3] = RAW[((size_t)pm * 4 + 1) * N_UP + D_FF + f];
        const float wg0 = cw[f], wg1 = cw[N_UP + f], wg2 = cw[2 * N_UP + f], bg = cb[f];
        const float wv0 = cw[D_FF + f], wv1 = cw[N_UP + D_FF + f], wv2 = cw[2 * N_UP + D_FF + f], bv = cb[D_FF + f];
#pragma unroll
        for (int r = 0; r < 2; ++r) {
            const float cg = ((wg0 * xg[r] + wg1 * xg[r + 1]) + wg2 * xg[r + 2]) + bg;
            const float cv = ((wv0 * xv[r] + wv1 * xv[r + 1]) + wv2 * xv[r + 2]) + bv;
            ACT[((size_t)pm * 256 + r) * D_FF + f] = (u16)(cvt_pk_bf16(cg * sigmoidf_(cg) * cv, 0.f) & 0xffffu);
        }
    }
}

constexpr int N_PHASES = 10;
__global__ void __launch_bounds__(NT, 2) hymba_fwd(Args args) {
    extern __shared__ __attribute__((aligned(16))) unsigned char lds_raw[];
    Frame F;
    F.lds = (LAS unsigned char*)lds_raw;
    F.tid = threadIdx.x; F.lane = F.tid & 63; F.wave = __builtin_amdgcn_readfirstlane(F.tid >> 6); F.wave0 = F.wave;
    F.G = gridDim.x; { const int bx = blockIdx.x; F.vcu = (F.G % 8 == 0) ? (bx % 8) * (F.G / 8) + bx / 8 : bx; }
    F.pa = &args;
    F.out = args.out; F.ws = args.ws;
    volatile LAS unsigned* MISC = (volatile LAS unsigned*)(F.lds + MISC_OFF);
    if (F.tid < 32) MISC[F.tid] = 0u;
    __syncthreads();
    const int lo = args.ph_lo, hi = args.ph_hi;
    unsigned* ctl = (unsigned*)(F.ws + WS_CTL);
    XcdBarrier bar; bar.bar = ctl + CW_BAR; bar.x = 0; bar.st = nullptr;
    if (hi - lo > 1) bar = xcd_barrier_post(ctl + CW_BAR, MISC + 8);
#ifndef PHASE_MASK
#define PHASE_MASK 0x3FF
#endif
#define IN(k) (((PHASE_MASK >> (k)) & 1) && lo <= (k) && (k) < hi)
#ifndef DUP_MASK
#define DUP_MASK 0
#endif
#define REP(k) _Pragma("unroll 1") for (int rep_ = 0; rep_ < 1 + ((DUP_MASK >> (k)) & 1); ++rep_)
#define SEAM(k) do { if (IN(k) && IN((k) + 1)) xcd_barrier(bar, F.wave0 * 64 + lane_id()); } while (0)
#define MOD ((float*)(wsp + WS_MOD))
#define H ((u16*)(wsp + WS_H))

    if (IN(0)) { unsigned char* wsp = F.ws; asm volatile("" : "+s"(wsp)); { int t_ = F.wave0 * 64 + lane_id(); asm volatile("" : "+v"(t_)); F.tid = t_; F.lane = t_ & 63; F.wave = __builtin_amdgcn_readfirstlane(t_ >> 6); } REP(0) p0_prologue(F); SEAM(0); }
    if (IN(1)) { unsigned char* wsp = F.ws; asm volatile("" : "+s"(wsp)); { int t_ = F.wave0 * 64 + lane_id(); asm volatile("" : "+v"(t_)); F.tid = t_; F.lane = t_ & 63; F.wave = __builtin_amdgcn_readfirstlane(t_ >> 6); } REP(1) { p1_upweights(F, wsp); rownorm_phase<true>(F, F.x(), F.norm1_g(), MOD + 0, MOD + 1024, H); } SEAM(1); }
    if (IN(2)) { unsigned char* wsp = F.ws; asm volatile("" : "+s"(wsp)); { int t_ = F.wave0 * 64 + lane_id(); asm volatile("" : "+v"(t_)); F.tid = t_; F.lane = t_ & 63; F.wave = __builtin_amdgcn_readfirstlane(t_ >> 6); }
        pg8::Gemm g{H, (const u16*)(wsp + WS_WIN), M_TOK, N_IN, D_MODEL, 0}; pg8::StaticOrder S; S.init(M_TOK, N_IN, F.G, (int)blockIdx.x);
        pg8::EpiInProj E{(float*)(wsp + WS_QF), (u16*)(wsp + WS_KB), (u16*)(wsp + WS_VT), (u16*)(wsp + WS_XR), (u16*)(wsp + WS_GG), (float*)(wsp + WS_KM), F.q_norm_g(), F.k_norm_g()};
        REP(2) pg8::gemm_phase<pg8::EpiInProj, pg8::StaticOrder, true, true, true>(F.lds, g, S, E, F.wave0);
        SEAM(2);
    }
    if (IN(3)) { unsigned char* wsp = F.ws; asm volatile("" : "+s"(wsp)); { int t_ = F.wave0 * 64 + lane_id(); asm volatile("" : "+v"(t_)); F.tid = t_; F.lane = t_ & 63; F.wave = __builtin_amdgcn_readfirstlane(t_ >> 6); } cb2_prep(F, wsp); REP(3) attn_phase(F); REP(13) lru_phase<false>(F); SEAM(3); }
    if (IN(4)) { unsigned char* wsp = F.ws; asm volatile("" : "+s"(wsp)); { int t_ = F.wave0 * 64 + lane_id(); asm volatile("" : "+v"(t_)); F.tid = t_; F.lane = t_ & 63; F.wave = __builtin_amdgcn_readfirstlane(t_ >> 6); } REP(4) lru_phase<true>(F); if (IN(4) && IN(6)) xcd_barrier(bar, F.wave0 * 64 + lane_id()); }
    if (IN(6)) { unsigned char* wsp = F.ws; asm volatile("" : "+s"(wsp)); { int t_ = F.wave0 * 64 + lane_id(); asm volatile("" : "+v"(t_)); F.tid = t_; F.lane = t_ & 63; F.wave = __builtin_amdgcn_readfirstlane(t_ >> 6); }
        pg8::Gemm g{(const u16*)(wsp + WS_MIX), (const u16*)(wsp + WS_WO), M_TOK, D_MODEL, D_MODEL, 0}; pg8::StaticOrder S; S.init(M_TOK, D_MODEL, F.G, (int)blockIdx.x);
        pg8::EpiOut E{F.x(), H, (float*)(wsp + WS_SSQX), MOD + 2048, (const float*)(wsp + WS_SSQL), (const float*)(wsp + WS_SSQA)};
        REP(6) pg8::gemm_phase<pg8::EpiOut, pg8::StaticOrder, true, true, false>(F.lds, g, S, E, F.wave0);
        if (IN(6) && IN(8)) xcd_barrier(bar, F.wave0 * 64 + lane_id());
    }
    if (IN(8)) { unsigned char* wsp = F.ws; asm volatile("" : "+s"(wsp)); { int t_ = F.wave0 * 64 + lane_id(); asm volatile("" : "+v"(t_)); F.tid = t_; F.lane = t_ & 63; F.wave = __builtin_amdgcn_readfirstlane(t_ >> 6); }
        pg8::Gemm g{H, (const u16*)(wsp + WS_WUP4), M_TOK, N_UP, D_MODEL, (size_t)N_UP * D_MODEL * 2}; pg8::StaticOrder S; S.init(M_TOK, N_UP, F.G, (int)blockIdx.x);
        pg8::EpiFFN E{(u16*)(wsp + WS_ACT), (float*)(wsp + WS_RAW), F.ffn_conv_w(), (const float*)(wsp + WS_CB2), (LAS float*)(F.lds + XB_OFF), (const float*)(wsp + WS_SSQX), (const float*)(wsp + WS_BIAS2)};
        REP(8) pg8::gemm_phase<pg8::EpiFFN, pg8::StaticOrder, true, true, false>(F.lds, g, S, E, F.wave0);
        SEAM(8);
    }
    if (IN(9)) { unsigned char* wsp = F.ws; asm volatile("" : "+s"(wsp)); { int t_ = F.wave0 * 64 + lane_id(); asm volatile("" : "+v"(t_)); F.tid = t_; F.lane = t_ & 63; F.wave = __builtin_amdgcn_readfirstlane(t_ >> 6); }
        pg8::Gemm g{(const u16*)(wsp + WS_ACT), (const u16*)(wsp + WS_WDN), M_TOK, D_MODEL, D_FF, 0}; pg8::StaticOrder S; S.init(M_TOK, D_MODEL, F.G, (int)blockIdx.x);
        { pg8::Unit u0, u1; int pm0 = -1; if (S.next(0, u0)) { pm0 = u0.pm; ffn_fixup(F, wsp, pm0); } if (S.next(1, u1) && u1.pm != pm0) ffn_fixup(F, wsp, u1.pm);
          for (int i = 2; ; ++i) { pg8::Unit ux; if (!S.next(i, ux)) break; ffn_fixup(F, wsp, ux.pm); }
          asm volatile("s_waitcnt vmcnt(0)" ::: "memory"); __syncthreads(); }
        pg8::EpiResidB E{H, F.out, MOD + 5120};
        pg8::gemm_phase<pg8::EpiResidB, pg8::StaticOrder, true, true, false>(F.lds, g, S, E, F.wave0);
    }
    if (hi - lo > 1 && hi == N_PHASES) {
        if (xb_ld(ctl + CW_BAR + XB_TMO) != 0u) { asm volatile("s_waitcnt vmcnt(0)" ::: "memory"); __syncthreads();
            for (size_t i = (size_t)blockIdx.x * NT + F.tid; i < (size_t)M_TOK * D_MODEL; i += (size_t)F.G * NT) F.out[i] = __builtin_nanf(""); }
    }
#undef IN
#undef MOD
#undef H
#undef SEAM
}

#ifndef MK_PER_PHASE
#define MK_PER_PHASE 0
#endif
extern "C" void kernel_launch(void* const* d_in, const int* in_sizes, int n_in, void* d_out, int out_size, void* d_ws, size_t ws_size, hipStream_t stream) {
    static int grid = 0;
    if (grid == 0) {
        if (n_in != 23 || in_sizes[0] != M_TOK * D_MODEL || out_size != M_TOK * D_MODEL || ws_size < WS_END) {
            fprintf(stderr, "kernel_launch: unexpected shapes (n_in %d, in0 %d, out %d, ws %zu); nothing launched\n", n_in, n_in > 0 ? in_sizes[0] : -1, out_size, ws_size); grid = -1; return; }
        int dev = 0, cus = 0;
        if (hipGetDevice(&dev) != hipSuccess || hipDeviceGetAttribute(&cus, hipDeviceAttributeMultiprocessorCount, dev) != hipSuccess) { grid = -1; return; }
        if (hipFuncSetAttribute((const void*)hymba_fwd, hipFuncAttributeMaxDynamicSharedMemorySize, LDS_BYTES) != hipSuccess) { fprintf(stderr, "kernel_launch: hipFuncSetAttribute failed\n"); grid = -1; return; }
        grid = cus;
    }
    if (grid < 0) return;
    (void)hipMemsetAsync((char*)d_ws + WS_CTL, 0, CTL_ZERO_BYTES, stream);
    Args a{};
    for (int i = 0; i < 23; ++i) a.in[i] = (const float*)d_in[i];
    a.out = (float*)d_out; a.ws = (unsigned char*)d_ws;
#if MK_PER_PHASE
    for (int p = 0; p < N_PHASES; ++p) { a.ph_lo = p; a.ph_hi = p + 1; hipLaunchKernelGGL(hymba_fwd, dim3(grid), dim3(NT), LDS_BYTES, stream, a); }
#else
    a.ph_lo = 0; a.ph_hi = N_PHASES; hipLaunchKernelGGL(hymba_fwd, dim3(grid), dim3(NT), LDS_BYTES, stream, a);
#endif
}
```

```cpp
#include <hip/hip_runtime.h>
#include <cstdio>
#include <cstdint>

#define GAS __attribute__((address_space(1)))
#define LAS __attribute__((address_space(3)))
typedef unsigned short u16;
typedef short s16x8 __attribute__((ext_vector_type(8)));
typedef _Float16 f16x8 __attribute__((ext_vector_type(8)));
typedef __bf16 bf16x8_t __attribute__((ext_vector_type(8)));
typedef float f32x2 __attribute__((ext_vector_type(2)));
typedef float f32x4 __attribute__((ext_vector_type(4)));
typedef float f32x16 __attribute__((ext_vector_type(16)));
typedef unsigned u32x4 __attribute__((ext_vector_type(4)));
typedef unsigned u32x2 __attribute__((ext_vector_type(2)));
typedef GAS unsigned gu32;
#define RLX_AGENT __ATOMIC_RELAXED, __HIP_MEMORY_SCOPE_AGENT

constexpr int D_MODEL = 1024, BATCH = 4, SEQ = 8192, M_TOK = BATCH * SEQ;
constexpr int N_IN = 2560, D_FF = 2816, N_UP = 2 * D_FF, N_MOD = 6 * D_MODEL;
constexpr int NHEAD = 8, HD = 64, AW = 512, NBLK = 32, BLK = 256;
constexpr float EPS = 1e-6f;
constexpr float LOG2E = 1.4426950408889634f;

__device__ __forceinline__ unsigned cvt_pk_bf16(float lo, float hi) { unsigned r; asm volatile("v_cvt_pk_bf16_f32 %0, %1, %2" : "=v"(r) : "v"(lo), "v"(hi)); return r; }
__device__ __forceinline__ unsigned cvt_pk_f16(float lo, float hi) {
    const _Float16 a = (_Float16)lo, b = (_Float16)hi;
    return (unsigned)__builtin_bit_cast(unsigned short, a) | ((unsigned)__builtin_bit_cast(unsigned short, b) << 16);
}
__device__ __forceinline__ float bf_lo(unsigned w) { return __builtin_bit_cast(float, w << 16); }
__device__ __forceinline__ float bf_hi(unsigned w) { return __builtin_bit_cast(float, w & 0xffff0000u); }
__device__ __forceinline__ float sigmoidf_(float v) { return __builtin_amdgcn_rcpf(1.0f + __builtin_amdgcn_exp2f(-v * LOG2E)); }
__device__ __forceinline__ float gelu_tanh(float v) { const float y = 0.7978845608028654f * (v + 0.044715f * v * v * v); return v * sigmoidf_(2.0f * y); }
__device__ __forceinline__ float wave_sum(float v) {
#pragma unroll
    for (int o = 1; o < 64; o <<= 1) v += __shfl_xor(v, o);
    return v;
}

__device__ __forceinline__ int lane_id() { int l; asm volatile("v_mbcnt_lo_u32_b32 %0, -1, 0\n\tv_mbcnt_hi_u32_b32 %0, -1, %0" : "=v"(l)); return l; }

namespace pg8 {
constexpr int BM = 256, BK = 64, HALF = 128, HTB = HALF * BK * 2, STAGE_BYTES = 8 * HTB, NXCD = 8, WGM = 8;
__host__ __device__ __forceinline__ int lds_byte(int r, int c) { const int st = (r >> 4) * 2 + (c >> 5), rr = r & 15, cc = c & 31, ob = rr * 64 + cc * 2; return st * 1024 + (ob ^ (((ob >> 9) & 1) << 5)); }
__host__ __device__ __forceinline__ void stage_rc(int b, int& R, int& C) { const int st = b / 1024, sb = b % 1024, swz = sb ^ (((sb >> 9) & 1) << 5); R = (st >> 1) * 16 + swz / 64; C = (st & 1) * 32 + (swz % 64) / 2; }
__host__ __device__ __forceinline__ int perm32(int rho) { const int n = rho >> 4, i = rho & 15; return 8 * (i >> 2) + 4 * n + (i & 3); }

struct Unit { int pm, pn; };
struct Gemm { const u16* A; const u16* Bt; int M, N, K; size_t bstride; };

struct StaticOrder {
    int nM, nN, nwg, G, c;
    __host__ __device__ __forceinline__ void init(int M, int N, int G_, int c_) { nM = M / BM; nN = N / BM; nwg = nM * nN; G = G_; c = c_; }
    __host__ __device__ __forceinline__ bool next(int i, Unit& u) const {
        const long L = (long)i * G + c; if (L >= nwg) return false;
        int wgid = (int)L; { const int q = nwg / NXCD, r = nwg % NXCD, xcd = wgid % NXCD, off = wgid / NXCD; wgid = (xcd < r ? xcd * (q + 1) : r * (q + 1) + (xcd - r) * q) + off; }
        const int nig = WGM * nN, gid = wgid / nig, fm = gid * WGM, gsz = (nM - fm) < WGM ? (nM - fm) : WGM;
        u.pm = fm + ((wgid % nig) % gsz); u.pn = (wgid % nig) / gsz; return true;
    }
    __device__ __forceinline__ void a_ready(const Unit&) const {}
    __device__ __forceinline__ void done(const Unit&) const {}
};

template <bool F16> __device__ __forceinline__ f32x4 mfma16(s16x8 a, s16x8 b, f32x4 c) {
    if constexpr (F16) return __builtin_amdgcn_mfma_f32_16x16x32_f16(__builtin_bit_cast(f16x8, a), __builtin_bit_cast(f16x8, b), c, 0, 0, 0);
    else return __builtin_amdgcn_mfma_f32_16x16x32_bf16(__builtin_bit_cast(bf16x8_t, a), __builtin_bit_cast(bf16x8_t, b), c, 0, 0, 0);
}

template <class Epi, class Sched, bool ALIGN_EPI, bool SP2, bool F16>
__device__ __forceinline__ void gemm_phase(LAS unsigned char* lds, const Gemm g, const Sched& S, const Epi& E, int wave0) {
    int tid_ = wave0 * 64 + lane_id(); asm volatile("" : "+v"(tid_));
    const int tid = tid_, wid = __builtin_amdgcn_readfirstlane(tid >> 6), lane = tid & 63, wr = wid >> 2, wc = wid & 3, fr = lane & 15, fq = lane >> 4;
    const int K = g.K, nt = K / BK;
    unsigned voffA, voffB;
    { int R, C; stage_rc(tid * 16, R, C); const int Rb = Epi::PERM ? ((R & ~31) + perm32(R & 31)) : R;
        voffA = (unsigned)(R * K + C) * 2u; voffB = (unsigned)(Rb * K + C) * 2u; }
    const unsigned rstep64 = (unsigned)(64 * K * 2);
    const size_t kstep = (size_t)(BK * 2);
    const size_t hstep = (size_t)HALF * K * 2;
    const size_t tstep = 2 * hstep;
    const unsigned ldsw = (unsigned)wid * 1024u;
    const int aoff = lds_byte(wr * 64 + fr, fq * 8), boff = lds_byte(wc * 32 + fr, fq * 8);
#define PG8_SA(b, h) (((b) * 2 + (h)) * HTB)
#define PG8_SB(b, h) ((4 + (b) * 2 + (h)) * HTB)
#define PG8_STAGE(bufoff, gbase, voff) do { _Pragma("unroll") for (int _i = 0; _i < 2; ++_i) \
        __builtin_amdgcn_global_load_lds((const unsigned*)((const char*)(gbase) + _i * rstep64 + (voff)), (LAS unsigned*)(lds + (bufoff) + ldsw + _i * 8192), 16, 0, 0); } while (0)
#define PG8_LDA(dst, b, h) do { _Pragma("unroll") for (int m = 0; m < 4; ++m) _Pragma("unroll") for (int k = 0; k < 2; ++k) dst[m][k] = *(const LAS s16x8*)(lds + PG8_SA(b, h) + aoff + m * 2048 + k * 1024); } while (0)
#define PG8_LDB(dst, b, h) do { _Pragma("unroll") for (int n = 0; n < 2; ++n) _Pragma("unroll") for (int k = 0; k < 2; ++k) dst[n][k] = *(const LAS s16x8*)(lds + PG8_SB(b, h) + boff + n * 2048 + k * 1024); } while (0)
#define PG8_MMA(ai, bj, At, Bt) do { __builtin_amdgcn_s_setprio(1); _Pragma("unroll") for (int m = 0; m < 4; ++m) _Pragma("unroll") for (int n = 0; n < 2; ++n) _Pragma("unroll") for (int k = 0; k < 2; ++k) \
        acc[ai][bj][m][n] = mfma16<F16>(Bt[n][k], At[m][k], acc[ai][bj][m][n]); __builtin_amdgcn_s_setprio(0); } while (0)
#define PG8_WAIT_V(n) asm volatile("s_waitcnt vmcnt(" #n ")" ::: "memory")
#define PG8_WAIT_L(n) asm volatile("s_waitcnt lgkmcnt(" #n ")" ::: "memory")
#define PG8_BAR __builtin_amdgcn_s_barrier()
#define PG8_SCHED __builtin_amdgcn_sched_barrier(0)
    Unit cur, nxt; int ui = 0;
    if (!S.next(0, cur)) return;
    f32x4 acc[2][2][4][2];
#pragma unroll
    for (int a = 0; a < 2; ++a)
#pragma unroll
        for (int b = 0; b < 2; ++b)
#pragma unroll
            for (int m = 0; m < 4; ++m)
#pragma unroll
                for (int n = 0; n < 2; ++n) acc[a][b][m][n] = (f32x4){0.f, 0.f, 0.f, 0.f};
    s16x8 At[4][2], B0[2][2], B1[2][2];
    const char* cA = (const char*)g.A + (size_t)cur.pm * tstep; const char* cB = (const char*)g.Bt + (size_t)cur.pn * tstep + (size_t)(cur.pm >> 5) * g.bstride;
    S.a_ready(cur);
    if constexpr (SP2) {
        PG8_STAGE(PG8_SB(0, 0), cB, voffB); PG8_STAGE(PG8_SB(0, 1), cB + hstep, voffB); PG8_STAGE(PG8_SA(0, 0), cA, voffA); PG8_STAGE(PG8_SA(0, 1), cA + hstep, voffA);
        if (wr == 1) PG8_BAR;
        PG8_WAIT_V(2); PG8_BAR;
        PG8_STAGE(PG8_SB(1, 0), cB + kstep, voffB); PG8_STAGE(PG8_SA(1, 0), cA + kstep, voffA); PG8_STAGE(PG8_SB(1, 1), cB + hstep + kstep, voffB);
        PG8_WAIT_V(6); PG8_BAR;
    } else {
        PG8_STAGE(PG8_SB(0, 0), cB, voffB); PG8_STAGE(PG8_SA(0, 0), cA, voffA); PG8_STAGE(PG8_SB(0, 1), cB + hstep, voffB); PG8_STAGE(PG8_SA(0, 1), cA + hstep, voffA);
        if (wr == 1) PG8_BAR;
        PG8_WAIT_V(4); PG8_BAR;
        PG8_STAGE(PG8_SB(1, 0), cB + kstep, voffB); PG8_STAGE(PG8_SA(1, 0), cA + kstep, voffA); PG8_STAGE(PG8_SB(1, 1), cB + hstep + kstep, voffB);
        PG8_WAIT_V(6); PG8_BAR;
    }
    for (;;) {
        const bool has_next = S.next(ui + 1, nxt);
        const char* nA = has_next ? (const char*)g.A + (size_t)nxt.pm * tstep : cA; const char* nB = has_next ? (const char*)g.Bt + (size_t)nxt.pn * tstep + (size_t)(nxt.pm >> 5) * g.bstride : cB;
        for (int t = 0; t < nt; t += 2) {
            const bool last = (t == nt - 2);
            const char* a1 = cA + (size_t)(t + 1) * kstep;
            const char* a2 = last ? nA : cA + (size_t)(t + 2) * kstep; const char* b2 = last ? nB : cB + (size_t)(t + 2) * kstep;
            const char* a3 = a2 + kstep; const char* b3 = b2 + kstep;
            if (last && has_next) S.a_ready(nxt);
            if constexpr (Epi::MIDK) { if (t == nt / 2) E.midk(acc, cur, wr, fr); }
            if constexpr (SP2) {
            PG8_LDB(B0, 0, 0); PG8_LDB(B1, 0, 1); PG8_SCHED; PG8_LDA(At, 0, 0); PG8_STAGE(PG8_SA(1, 1), a1 + hstep, voffA);
            PG8_WAIT_V(8); PG8_WAIT_L(0); PG8_BAR; PG8_MMA(0, 0, At, B0); PG8_MMA(0, 1, At, B1); PG8_BAR; PG8_SCHED;
            PG8_LDA(At, 0, 1); PG8_STAGE(PG8_SB(0, 0), b2, voffB); PG8_STAGE(PG8_SB(0, 1), b2 + hstep, voffB); PG8_STAGE(PG8_SA(0, 0), a2, voffA);
            PG8_WAIT_V(8); PG8_WAIT_L(0); PG8_BAR; PG8_MMA(1, 0, At, B0); PG8_MMA(1, 1, At, B1); PG8_BAR; PG8_SCHED;
            PG8_LDB(B0, 1, 0); PG8_LDB(B1, 1, 1); PG8_SCHED; PG8_LDA(At, 1, 0); PG8_STAGE(PG8_SA(0, 1), a2 + hstep, voffA);
            PG8_WAIT_V(8); PG8_WAIT_L(0); PG8_BAR; PG8_MMA(0, 0, At, B0); PG8_MMA(0, 1, At, B1); PG8_BAR; PG8_SCHED;
            PG8_LDA(At, 1, 1); PG8_STAGE(PG8_SB(1, 0), b3, voffB); PG8_STAGE(PG8_SB(1, 1), b3 + hstep, voffB); PG8_STAGE(PG8_SA(1, 0), a3, voffA);
            PG8_WAIT_V(8); PG8_WAIT_L(0); PG8_BAR; PG8_MMA(1, 0, At, B0); PG8_MMA(1, 1, At, B1); PG8_BAR; PG8_SCHED;
            } else {
            PG8_LDB(B0, 0, 0); PG8_SCHED; PG8_LDA(At, 0, 0); PG8_STAGE(PG8_SA(1, 1), a1 + hstep, voffA);
            PG8_WAIT_L(8); PG8_BAR; PG8_WAIT_L(0); PG8_MMA(0, 0, At, B0); PG8_BAR; PG8_SCHED;
            PG8_LDB(B1, 0, 1); PG8_STAGE(PG8_SB(0, 0), b2, voffB);
            PG8_BAR; PG8_WAIT_L(0); PG8_MMA(0, 1, At, B1); PG8_BAR;
            PG8_LDA(At, 0, 1); PG8_STAGE(PG8_SA(0, 0), a2, voffA);
            PG8_BAR; PG8_WAIT_L(0); PG8_MMA(1, 0, At, B0); PG8_BAR; PG8_SCHED;
            PG8_STAGE(PG8_SB(0, 1), b2 + hstep, voffB);
            PG8_WAIT_V(6); PG8_BAR; PG8_MMA(1, 1, At, B1); PG8_BAR;
            PG8_LDB(B0, 1, 0); PG8_SCHED; PG8_LDA(At, 1, 0); PG8_STAGE(PG8_SA(0, 1), a2 + hstep, voffA);
            PG8_WAIT_L(8); PG8_BAR; PG8_WAIT_L(0); PG8_MMA(0, 0, At, B0); PG8_BAR; PG8_SCHED;
            PG8_LDB(B1, 1, 1); PG8_STAGE(PG8_SB(1, 0), b3, voffB);
            PG8_BAR; PG8_WAIT_L(0); PG8_MMA(0, 1, At, B1); PG8_BAR;
            PG8_LDA(At, 1, 1); PG8_STAGE(PG8_SA(1, 0), a3, voffA);
            PG8_BAR; PG8_WAIT_L(0); PG8_MMA(1, 0, At, B0); PG8_BAR; PG8_SCHED;
            PG8_STAGE(PG8_SB(1, 1), b3 + hstep, voffB);
            PG8_WAIT_V(6); PG8_BAR; PG8_MMA(1, 1, At, B1); PG8_BAR;
            }
        }
        if constexpr (ALIGN_EPI) { if (wr == 0) PG8_BAR; }
        E(acc, cur, wr, wc, fr, fq); S.done(cur);
        if (!has_next) break;
#pragma unroll
        for (int a = 0; a < 2; ++a)
#pragma unroll
            for (int b = 0; b < 2; ++b)
#pragma unroll
                for (int m = 0; m < 4; ++m)
#pragma unroll
                    for (int n = 0; n < 2; ++n) acc[a][b][m][n] = (f32x4){0.f, 0.f, 0.f, 0.f};
        cur = nxt; cA = nA; cB = nB; ++ui;
        if constexpr (ALIGN_EPI) { if (wr == 1) PG8_BAR; }
    }
    PG8_WAIT_V(0);
    if constexpr (!ALIGN_EPI) { if (wr == 0) PG8_BAR; }
    PG8_BAR;
#undef PG8_SA
#undef PG8_SB
#undef PG8_STAGE
#undef PG8_LDA
#undef PG8_LDB
#undef PG8_MMA
#undef PG8_WAIT_V
#undef PG8_WAIT_L
#undef PG8_BAR
#undef PG8_SCHED
}

struct EpiBf16 {
    static constexpr bool PERM = true, MIDK = false;
    u16* O; int ldc;
    __device__ __forceinline__ void operator()(const f32x4 (&acc)[2][2][4][2], const Unit& u, int wr, int wc, int fr, int fq) const {
        const int row0 = u.pm * BM + wr * 64 + fr; const int col0 = u.pn * BM + wc * 32 + 8 * fq;
#pragma unroll
        for (int ai = 0; ai < 2; ++ai)
#pragma unroll
            for (int m = 0; m < 4; ++m) { u16* rowp = O + (size_t)(row0 + ai * HALF + m * 16) * ldc + col0;
#pragma unroll
                for (int bj = 0; bj < 2; ++bj) { const f32x4 v0 = acc[ai][bj][m][0], v1 = acc[ai][bj][m][1];
                    u32x4 w; w.x = cvt_pk_bf16(v0[0], v0[1]); w.y = cvt_pk_bf16(v0[2], v0[3]); w.z = cvt_pk_bf16(v1[0], v1[1]); w.w = cvt_pk_bf16(v1[2], v1[3]);
                    *(u32x4*)(rowp + bj * HALF) = w; } }
    }
};
struct EpiResid {
    static constexpr bool PERM = false, MIDK = false;
    const float* base; float* out; const float* gate;
    __device__ __forceinline__ void operator()(const f32x4 (&acc)[2][2][4][2], const Unit& u, int wr, int wc, int fr, int fq) const {
        const int row0 = u.pm * BM + wr * 64 + fr, col0 = u.pn * BM + wc * 32 + 4 * fq;
        const int b = (u.pm * BM) / SEQ;
        f32x4 gv[2][2];
#pragma unroll
        for (int bj = 0; bj < 2; ++bj)
#pragma unroll
            for (int n = 0; n < 2; ++n) gv[bj][n] = *(const f32x4*)(gate + (size_t)b * N_MOD + col0 + bj * HALF + n * 16);
#pragma unroll
        for (int ai = 0; ai < 2; ++ai)
#pragma unroll
            for (int m = 0; m < 4; ++m) { const size_t off = (size_t)(row0 + ai * HALF + m * 16) * D_MODEL + col0;
#pragma unroll
                for (int bj = 0; bj < 2; ++bj)
#pragma unroll
                    for (int n = 0; n < 2; ++n) { const f32x4 bs = *(const f32x4*)(base + off + bj * HALF + n * 16);
                        *(f32x4*)(out + off + bj * HALF + n * 16) = bs + gv[bj][n] * acc[ai][bj][m][n]; } }
    }
};
struct EpiInProj {
    static constexpr bool PERM = true, MIDK = false;
    float* QF; u16* KB; u16* VT; u16* XR; u16* GG; float* KM; const float* gq; const float* gk;
    __device__ __forceinline__ void operator()(const f32x4 (&acc)[2][2][4][2], const Unit& u, int wr, int wc, int fr, int fq) const {
        const int type = u.pn >> 1, head = (u.pn & 1) * 4 + wc;
        const int b = (u.pm * BM) / SEQ, blk = u.pm % NBLK;
        const int tok0 = u.pm * BM + wr * 64 + fr;
        const int bh = b * NHEAD + head;
        if (type <= 1) {
            const float* gp = type == 0 ? gq : gk;
            f32x4 gv[2][2];
#pragma unroll
            for (int bj = 0; bj < 2; ++bj)
#pragma unroll
                for (int n = 0; n < 2; ++n) gv[bj][n] = *(const f32x4*)(gp + 32 * bj + 8 * fq + 4 * n);
            f32x4 cs[2][2];
#pragma unroll
            for (int bj = 0; bj < 2; ++bj)
#pragma unroll
                for (int n = 0; n < 2; ++n) cs[bj][n] = (f32x4){0.f, 0.f, 0.f, 0.f};
#pragma unroll
            for (int ai = 0; ai < 2; ++ai)
#pragma unroll
                for (int m = 0; m < 4; ++m) {
                    float ss = 0.f;
#pragma unroll
                    for (int bj = 0; bj < 2; ++bj)
#pragma unroll
                        for (int n = 0; n < 2; ++n) { const f32x4 x = acc[ai][bj][m][n]; ss += (x[0] * x[0] + x[1] * x[1]) + (x[2] * x[2] + x[3] * x[3]); }
                    ss += __shfl_xor(ss, 16); ss += __shfl_xor(ss, 32);
                    const float rstd = 1.0f / sqrtf(ss * (1.0f / 64.0f) + EPS);
                    const int tok = tok0 + ai * HALF + m * 16, s = tok % SEQ;
                    const size_t rowoff = ((size_t)bh * SEQ + s) * HD + 8 * fq;
#pragma unroll
                    for (int bj = 0; bj < 2; ++bj) {
                        const f32x4 v0 = acc[ai][bj][m][0] * rstd * gv[bj][0], v1 = acc[ai][bj][m][1] * rstd * gv[bj][1];
                        if (type == 0) { *(f32x4*)(QF + rowoff + 32 * bj) = v0; *(f32x4*)(QF + rowoff + 32 * bj + 4) = v1; }
                        else { u32x4 w; w.x = cvt_pk_bf16(v0[0], v0[1]); w.y = cvt_pk_bf16(v0[2], v0[3]); w.z = cvt_pk_bf16(v1[0], v1[1]); w.w = cvt_pk_bf16(v1[2], v1[3]);
                            const int kw = s & 255, c8 = 4 * bj + fq;
                            *(u32x4*)(KB + ((size_t)bh * NBLK + blk) * (BLK * HD) + ((((kw >> 5) * 4 + (c8 >> 1)) * 2 + (c8 & 1)) * 32 + (kw & 31)) * 8) = w; cs[bj][0] += v0; cs[bj][1] += v1; }
                    }
                }
            if (type == 1) {
#pragma unroll
                for (int bj = 0; bj < 2; ++bj)
#pragma unroll
                    for (int n = 0; n < 2; ++n)
#pragma unroll
                        for (int i = 0; i < 4; ++i) { float v = cs[bj][n][i]; v += __shfl_xor(v, 1); v += __shfl_xor(v, 2); v += __shfl_xor(v, 4); v += __shfl_xor(v, 8);
                            if (fr == 0) atomicAdd(KM + (((size_t)(b * NBLK + blk) * NHEAD + head) * HD + 32 * bj + 8 * fq + 4 * n + i), v); }
            }
        } else if (type == 2) {
            const int hip = (fr >> 2) & 1, ep = 4 * (fr >> 3) + (fr & 3);
#pragma unroll
            for (int ai = 0; ai < 2; ++ai)
#pragma unroll
                for (int m = 0; m < 4; ++m) { const int kw = ai * HALF + wr * 64 + m * 16 + fr;
#pragma unroll
                    for (int bj = 0; bj < 2; ++bj)
#pragma unroll
                        for (int n = 0; n < 2; ++n) { const f32x4 x = acc[ai][bj][m][n]; const unsigned w0 = cvt_pk_bf16(x[0], x[1]), w1 = cvt_pk_bf16(x[2], x[3]);
                            u16* dst = VT + ((size_t)bh * NBLK + blk) * (BLK * HD) + (((((kw >> 5) * 2 + ((kw >> 4) & 1)) * 2 + bj) * 2 + hip) * 32 + 8 * fq + 4 * n) * 8 + ep;
                            dst[0] = (u16)(w0 & 0xffffu); dst[8] = (u16)(w0 >> 16); dst[16] = (u16)(w1 & 0xffffu); dst[24] = (u16)(w1 >> 16); } }
        } else {
            u16* O = type == 3 ? XR : GG;
#pragma unroll
            for (int ai = 0; ai < 2; ++ai)
#pragma unroll
                for (int m = 0; m < 4; ++m) { const int tok = tok0 + ai * HALF + m * 16, sq = tok % SEQ;
                    u16* tilep = O + ((((size_t)b * (SEQ / 32) + (sq >> 5)) * NHEAD + head) * 2048) + (sq & 31) * 8;
#pragma unroll
                    for (int bj = 0; bj < 2; ++bj) { f32x4 v0 = acc[ai][bj][m][0], v1 = acc[ai][bj][m][1];
                        if (type == 4) {
#pragma unroll
                            for (int i = 0; i < 4; ++i) { v0[i] = gelu_tanh(v0[i]); v1[i] = gelu_tanh(v1[i]); } }
                        u32x4 w; w.x = cvt_pk_bf16(v0[0], v0[1]); w.y = cvt_pk_bf16(v0[2], v0[3]); w.z = cvt_pk_bf16(v1[0], v1[1]); w.w = cvt_pk_bf16(v1[2], v1[3]);
                        *(u32x4*)(tilep + (4 * bj + fq) * 256) = w; } }
        }
    }
};

__device__ __forceinline__ float dpp_f(float old, float x, int ctrl) {
    return 0.f; }
#define DPPF(old, x, ctrl) __builtin_bit_cast(float, __builtin_amdgcn_update_dpp(__builtin_bit_cast(int, (float)(old)), __builtin_bit_cast(int, (float)(x)), (ctrl), 0xf, 0xf, false))
struct EpiFFN {
    static constexpr bool PERM = true, MIDK = false;
    u16* ACT; float* RAW; const float* cw; const float* CB2; LAS float* XB; const float* SSQX; const float* BIAS2;
    __device__ __forceinline__ void operator()(const f32x4 (&acc)[2][2][4][2], const Unit& u, int wr, int wc, int fr_, int fq_) const {
        int fr = fr_, fq = fq_; asm volatile("" : "+v"(fr), "+v"(fq));
        const int f0 = u.pn * 128 + wc * 32 + 8 * fq;
        const int b = (u.pm * BM) / SEQ;
        LAS float* R2S = XB + 2048;
        { const int t = (wr * 4 + wc) * 64 + fq * 16 + fr;
          if (t < 256) { const size_t row = (size_t)u.pm * BM + t;
              const f32x4 s0 = *(const f32x4*)(SSQX + row * 16), s1 = *(const f32x4*)(SSQX + row * 16 + 4), s2 = *(const f32x4*)(SSQX + row * 16 + 8), s3 = *(const f32x4*)(SSQX + row * 16 + 12);
              const float ss = (((s0[0] + s0[1]) + (s0[2] + s0[3])) + ((s1[0] + s1[1]) + (s1[2] + s1[3]))) + (((s2[0] + s2[1]) + (s2[2] + s2[3])) + ((s3[0] + s3[1]) + (s3[2] + s3[3])));
              R2S[t] = 1.0f / sqrtf(ss * (1.0f / D_MODEL) + EPS); } }
        asm volatile("s_waitcnt lgkmcnt(0)" ::: "memory"); __builtin_amdgcn_s_barrier(); asm volatile("" ::: "memory");
#define R2(ai, m) (R2S[(ai) * HALF + wr * 64 + (m) * 16 + fr])
#define BBP(kc, bj, n) (*(const f32x4*)(BIAS2 + ((size_t)(kc) * BATCH + b) * N_UP + (bj) * D_FF + f0 + 4 * (n)))
#define BBV(bj, n) ((BBP(0, bj, n) + BBP(1, bj, n)) + (BBP(2, bj, n) + BBP(3, bj, n)))
#define UPV(ai, bj, m, n) (acc[ai][bj][m][n] * r2v[ai][m])
        if (fr >= 14) {
#pragma unroll
            for (int ai = 0; ai < 2; ++ai)
#pragma unroll
                for (int bj = 0; bj < 2; ++bj)
#pragma unroll
                    for (int n = 0; n < 2; ++n) *(LAS f32x4*)(XB + (((((ai * 2 + wr) * 4 + wc) * 2 + (fr - 14)) * 4 + fq) * 16 + (bj * 2 + n) * 4)) = acc[ai][bj][3][n] * R2(ai, 3);
        }
        if (wr == 1 && fr >= 14) {
#pragma unroll
            for (int bj = 0; bj < 2; ++bj)
#pragma unroll
                for (int n = 0; n < 2; ++n) *(f32x4*)(RAW + ((size_t)u.pm * 4 + 2 + (fr - 14)) * N_UP + bj * D_FF + f0 + 4 * n) = acc[1][bj][3][n] * R2(1, 3) + BBV(bj, n);
        }
        if (wr == 0 && fr < 2) {
#pragma unroll
            for (int bj = 0; bj < 2; ++bj)
#pragma unroll
                for (int n = 0; n < 2; ++n) *(f32x4*)(RAW + ((size_t)u.pm * 4 + fr) * N_UP + bj * D_FF + f0 + 4 * n) = acc[0][bj][0][n] * R2(0, 0) + BBV(bj, n);
        }
        asm volatile("s_waitcnt lgkmcnt(0)" ::: "memory"); __builtin_amdgcn_s_barrier(); asm volatile("" ::: "memory");
#pragma unroll
        for (int n = 0; n < 2; ++n) {
            const f32x4 wg0 = *(const f32x4*)(cw + f0 + 4 * n), wg1 = *(const f32x4*)(cw + N_UP + f0 + 4 * n), wg2 = *(const f32x4*)(cw + 2 * N_UP + f0 + 4 * n);
            const f32x4 wv0 = *(const f32x4*)(cw + D_FF + f0 + 4 * n), wv1 = *(const f32x4*)(cw + N_UP + D_FF + f0 + 4 * n), wv2 = *(const f32x4*)(cw + 2 * N_UP + D_FF + f0 + 4 * n);
            const f32x4 bg = *(const f32x4*)(CB2 + (size_t)b * N_UP + f0 + 4 * n), bv = *(const f32x4*)(CB2 + (size_t)b * N_UP + D_FF + f0 + 4 * n);
#pragma unroll
            for (int ai = 0; ai < 2; ++ai) {
                float r2v[2][4];
#pragma unroll
                for (int m = 0; m < 4; ++m) r2v[ai][m] = R2(ai, m);
                const bool hasprev = (wr == 1) || (ai == 1);
                const int src = (wr == 1) ? (ai * 2 + 0) : ((ai - 1) * 2 + 1);
                f32x4 t1g = (f32x4){0.f, 0.f, 0.f, 0.f}, t2g = t1g, t1v = t1g, t2v = t1g;
                if (hasprev) {
                    const LAS float* xb1 = XB + ((((src * 4 + wc) * 2 + 1) * 4 + fq) * 16);
                    const LAS float* xb2 = XB + ((((src * 4 + wc) * 2 + (fr == 0 ? 0 : 1)) * 4 + fq) * 16);
                    t1g = *(const LAS f32x4*)(xb1 + (0 * 2 + n) * 4); t1v = *(const LAS f32x4*)(xb1 + (1 * 2 + n) * 4);
                    t2g = *(const LAS f32x4*)(xb2 + (0 * 2 + n) * 4); t2v = *(const LAS f32x4*)(xb2 + (1 * 2 + n) * 4);
                }
#pragma unroll
                for (int m = 0; m < 4; ++m) {
                    const f32x4 xg = UPV(ai, 0, m, n), xv = UPV(ai, 1, m, n);
                    if (m > 0) {
                        const f32x4 pg = UPV(ai, 0, m - 1, n), pv = UPV(ai, 1, m - 1, n);
#pragma unroll
                        for (int i = 0; i < 4; ++i) { t1g[i] = DPPF(0.f, pg[i], 0x121); t2g[i] = DPPF(0.f, pg[i], 0x122); t1v[i] = DPPF(0.f, pv[i], 0x121); t2v[i] = DPPF(0.f, pv[i], 0x122); }
                    }
                    float o[4];
#pragma unroll
                    for (int i = 0; i < 4; ++i) {
                        const float g1 = DPPF(t1g[i], xg[i], 0x111), g2 = DPPF(t2g[i], xg[i], 0x112);
                        const float v1 = DPPF(t1v[i], xv[i], 0x111), v2 = DPPF(t2v[i], xv[i], 0x112);
                        const float cg = ((wg0[i] * g2 + wg1[i] * g1) + wg2[i] * xg[i]) + bg[i];
                        const float cv = ((wv0[i] * v2 + wv1[i] * v1) + wv2[i] * xv[i]) + bv[i];
                        o[i] = cg * sigmoidf_(cg) * cv;
                    }
                    if (!(ai == 0 && m == 0 && wr == 0 && fr < 2)) { u32x2 w; w.x = cvt_pk_bf16(o[0], o[1]); w.y = cvt_pk_bf16(o[2], o[3]);
                        *(u32x2*)(ACT + (size_t)(u.pm * BM + ai * HALF + wr * 64 + m * 16 + fr) * D_FF + f0 + 4 * n) = w; }
                    __builtin_amdgcn_sched_barrier(0);
                }
            }
        }
    }
};

struct EpiOut {
    static constexpr bool PERM = true, MIDK = true;
    const float* base; u16* X1B; float* SSQX; const float* gate; const float* SSQL; const float* SSQA;
    __device__ __forceinline__ void rstd(int row, float& rl, float& ra) const {
        const f32x4 s0 = *(const f32x4*)(SSQL + (size_t)row * 8), s1 = *(const f32x4*)(SSQL + (size_t)row * 8 + 4);
        const f32x4 t0 = *(const f32x4*)(SSQA + (size_t)row * 8), t1 = *(const f32x4*)(SSQA + (size_t)row * 8 + 4);
        const float ssl = ((s0[0] + s0[1]) + (s0[2] + s0[3])) + ((s1[0] + s1[1]) + (s1[2] + s1[3]));
        const float ssa = ((t0[0] + t0[1]) + (t0[2] + t0[3])) + ((t1[0] + t1[1]) + (t1[2] + t1[3]));
        rl = 1.0f / sqrtf(ssl * (1.0f / AW) + EPS); ra = 1.0f / sqrtf(ssa * (1.0f / AW) + EPS);
    }
    __device__ __forceinline__ void midk(f32x4 (&acc)[2][2][4][2], const Unit& u, int wr, int fr) const {
#pragma unroll
        for (int ai = 0; ai < 2; ++ai)
#pragma unroll
            for (int m = 0; m < 4; ++m) { float rl, ra; rstd(u.pm * BM + ai * HALF + wr * 64 + m * 16 + fr, rl, ra); const float ratio = rl / ra;
#pragma unroll
                for (int bj = 0; bj < 2; ++bj)
#pragma unroll
                    for (int n = 0; n < 2; ++n) acc[ai][bj][m][n] *= ratio; }
    }
    __device__ __forceinline__ void operator()(const f32x4 (&acc)[2][2][4][2], const Unit& u, int wr, int wc, int fr, int fq) const {
        const int row0 = u.pm * BM + wr * 64 + fr, col0 = u.pn * BM + wc * 32 + 8 * fq;
        const int b = (u.pm * BM) / SEQ;
        f32x4 gv[2][2];
#pragma unroll
        for (int bj = 0; bj < 2; ++bj)
#pragma unroll
            for (int n = 0; n < 2; ++n) gv[bj][n] = *(const f32x4*)(gate + (size_t)b * N_MOD + col0 + bj * HALF + n * 4);
#pragma unroll
        for (int ai = 0; ai < 2; ++ai)
#pragma unroll
            for (int m = 0; m < 4; ++m) { const int row = row0 + ai * HALF + m * 16; const size_t off = (size_t)row * D_MODEL + col0;
                float rl, ra; rstd(row, rl, ra);
                float ss = 0.f;
#pragma unroll
                for (int bj = 0; bj < 2; ++bj) {
                    const f32x4 x0 = *(const f32x4*)(base + off + bj * HALF) + gv[bj][0] * (acc[ai][bj][m][0] * ra);
                    const f32x4 x1 = *(const f32x4*)(base + off + bj * HALF + 4) + gv[bj][1] * (acc[ai][bj][m][1] * ra);
                    ss += ((x0[0] * x0[0] + x0[1] * x0[1]) + (x0[2] * x0[2] + x0[3] * x0[3])) + ((x1[0] * x1[0] + x1[1] * x1[1]) + (x1[2] * x1[2] + x1[3] * x1[3]));
                    u32x4 w; w.x = cvt_pk_bf16(x0[0], x0[1]); w.y = cvt_pk_bf16(x0[2], x0[3]); w.z = cvt_pk_bf16(x1[0], x1[1]); w.w = cvt_pk_bf16(x1[2], x1[3]);
                    *(u32x4*)(X1B + off + bj * HALF) = w; }
                ss += __shfl_xor(ss, 16); ss += __shfl_xor(ss, 32);
                if (fq == 0) SSQX[(size_t)row * 16 + u.pn * 4 + wc] = ss; }
    }
};

struct EpiResidB {
    static constexpr bool PERM = false, MIDK = false;
    const u16* base; float* out; const float* gate;
    __device__ __forceinline__ void operator()(const f32x4 (&acc)[2][2][4][2], const Unit& u, int wr, int wc, int fr, int fq) const {
        const int row0 = u.pm * BM + wr * 64 + fr, col0 = u.pn * BM + wc * 32 + 4 * fq;
        const int b = (u.pm * BM) / SEQ;
        f32x4 gv[2][2];
#pragma unroll
        for (int bj = 0; bj < 2; ++bj)
#pragma unroll
            for (int n = 0; n < 2; ++n) gv[bj][n] = *(const f32x4*)(gate + (size_t)b * N_MOD + col0 + bj * HALF + n * 16);
#pragma unroll
        for (int ai = 0; ai < 2; ++ai)
#pragma unroll
            for (int m = 0; m < 4; ++m) { const size_t off = (size_t)(row0 + ai * HALF + m * 16) * D_MODEL + col0;
#pragma unroll
                for (int bj = 0; bj < 2; ++bj)
#pragma unroll
                    for (int n = 0; n < 2; ++n) { const u32x2 xw = *(const u32x2*)(base + off + bj * HALF + n * 16);
                        const f32x4 bs = (f32x4){bf_lo(xw.x), bf_hi(xw.x), bf_lo(xw.y), bf_hi(xw.y)};
                        *(f32x4*)(out + off + bj * HALF + n * 16) = bs + gv[bj][n] * acc[ai][bj][m][n]; } }
    }
};
}
#ifndef ATT_DUP
#define ATT_DUP 0
#endif

constexpr size_t MiB = 1u << 20;
constexpr size_t WS_CTL = 0;
constexpr size_t WS_KM = 1 * MiB;
constexpr size_t CTL_ZERO_BYTES = 2 * MiB;
constexpr size_t WS_MOD = 2 * MiB;
constexpr size_t WS_WIN = 3 * MiB;
constexpr size_t WS_WO = 8 * MiB;
constexpr size_t WS_WUP = 10 * MiB;
constexpr size_t WS_WDN = 21 * MiB;
constexpr size_t WS_WA = 27 * MiB;
constexpr size_t WS_WX = 27 * MiB + 65536;
constexpr size_t WS_AGG = 28 * MiB;
constexpr size_t WS_SSQL = 29 * MiB;
constexpr size_t WS_SSQA = 30 * MiB;
constexpr size_t WS_H = 34 * MiB;
constexpr size_t WS_QF = 98 * MiB;
constexpr size_t WS_KB = 162 * MiB;
constexpr size_t WS_VT = 194 * MiB;
constexpr size_t WS_XR = 226 * MiB;
constexpr size_t WS_GG = 258 * MiB;
constexpr size_t WS_ATT = 288 * MiB;
constexpr size_t WS_LRU = 320 * MiB;
constexpr size_t WS_MIX = 352 * MiB;
constexpr size_t WS_RAW = 98 * MiB;
constexpr size_t WS_ACT = 272 * MiB;
constexpr size_t WS_WUP4 = 448 * MiB;
constexpr size_t WS_BIAS2 = 27 * MiB + 262144;
constexpr size_t WS_CB2 = 27 * MiB + 786432;
constexpr size_t WS_SSQX = 31 * MiB;
constexpr size_t WS_END = 492 * MiB;
constexpr int CW_BAR = 4096;

constexpr int RING_BYTES = 131072;
constexpr int MISC_OFF = 160 * 1024 - 256;
constexpr int XB_OFF = RING_BYTES;
constexpr int CLDS_OFF = RING_BYTES + 4096;
constexpr int LDS_BYTES = 160 * 1024;
constexpr int NT = 512, NWAVES = 8;

#define XB_TMO      128
#define XB_XCNT(j)  (256  + 64 * (j))
#define XB_XSUB(j)  (1280 + 64 * (j))
#define XB_XGEN(j)  (2304 + 64 * (j))
#define XB_TOP      3328
#define XB_TOPGEN   3392
#define XCD_BAR_WORDS 3456
#define XB_SPIN_CAP (1u << 18)
__device__ __forceinline__ unsigned xb_ld(unsigned* p)              { return __hip_atomic_load(p, __ATOMIC_RELAXED, __HIP_MEMORY_SCOPE_AGENT); }
__device__ __forceinline__ unsigned xb_add(unsigned* p, unsigned v) { return __hip_atomic_fetch_add(p, v, __ATOMIC_RELAXED, __HIP_MEMORY_SCOPE_AGENT); }
__device__ __forceinline__ unsigned xb_xcc_id() { return (unsigned)__builtin_amdgcn_s_getreg((3 << 11) | 20) & 0xFu; }
#define XB_SPIN(cond, bar) do { unsigned _sp = 0; while (cond) { __builtin_amdgcn_s_sleep(1); \
    if ((++_sp & 255u) == 0u) { if (xb_ld(&(bar)[XB_TMO])) break; if (_sp > XB_SPIN_CAP) { atomicAdd(&(bar)[XB_TMO], 1u); break; } } } } while (0)
struct XcdBarrier { unsigned* bar; unsigned x; volatile LAS unsigned* st; };
__device__ __forceinline__ XcdBarrier xcd_barrier_post(unsigned* bar, volatile LAS unsigned* st) {
    XcdBarrier b; b.bar = bar; b.x = xb_xcc_id(); b.st = st;
    if (threadIdx.x == 0) (void)xb_add(&bar[XB_XCNT(b.x)], 1u);
    return b;
}
__device__ __forceinline__ void xcd_barrier_complete(unsigned* bar, unsigned x, unsigned& nloc, unsigned& nx) {
    const unsigned G = gridDim.x * gridDim.y * gridDim.z;
    unsigned sum, cnt, mine, sp = 0u;
    for (;;) {
        sum = 0u; cnt = 0u; mine = 0u;
#pragma unroll
        for (unsigned j = 0; j < 16; ++j) { const unsigned c = xb_ld(&bar[XB_XCNT(j)]); sum += c; cnt += (c > 0u) ? 1u : 0u; mine = (j == x) ? c : mine; }
        if (sum == G) break;
        __builtin_amdgcn_s_sleep(1);
        if ((++sp & 255u) == 0u) { if (xb_ld(&bar[XB_TMO])) break; if (sp > XB_SPIN_CAP) { atomicAdd(&bar[XB_TMO], 1u); break; } }
    }
    nloc = mine > 0u ? mine : 1u; nx = cnt > 0u ? cnt : 1u;
}
__device__ __forceinline__ void xcd_barrier(const XcdBarrier& b, int tid) {
    asm volatile("s_waitcnt vmcnt(0)" ::: "memory");
    __syncthreads();
    if (tid == 0) {
        unsigned* bar = b.bar;
        __builtin_amdgcn_s_waitcnt(0);
        unsigned nloc = b.st[0], nx = b.st[1];
        if (nloc == 0u) { xcd_barrier_complete(bar, b.x, nloc, nx); b.st[0] = nloc; b.st[1] = nx; }
        const unsigned old = xb_add(&bar[XB_XSUB(b.x)], 1u);
        const unsigned gen = old / nloc;
        if (old + 1u == (gen + 1u) * nloc) {
            __builtin_amdgcn_fence(__ATOMIC_RELEASE, "agent");
            asm volatile("s_waitcnt vmcnt(0)" ::: "memory");
            const unsigned og = xb_add(&bar[XB_TOP], 1u);
            const unsigned tg = og / nx;
            if (og + 1u == (tg + 1u) * nx) xb_add(&bar[XB_TOPGEN], 1u);
            else XB_SPIN(xb_ld(&bar[XB_TOPGEN]) == tg, bar);
            __builtin_amdgcn_fence(__ATOMIC_ACQUIRE, "agent");
            xb_add(&bar[XB_XGEN(b.x)], 1u);
            asm volatile("s_waitcnt vmcnt(0)" ::: "memory");
        } else {
            XB_SPIN(xb_ld(&bar[XB_XGEN(b.x)]) == gen, bar);
            __builtin_amdgcn_fence(__ATOMIC_ACQUIRE, "agent");
            asm volatile("s_waitcnt vmcnt(0)" ::: "memory");
        }
    }
    __syncthreads();
}

struct Args { const float* in[23]; float* out; unsigned char* ws; int ph_lo, ph_hi; };
struct Frame {
    LAS unsigned char* lds;
    int tid, lane, wave, vcu, G, wave0;
    const Args* pa;
    __device__ __forceinline__ const float* x() const { return pa->in[0]; }
    __device__ __forceinline__ const float* c() const { return pa->in[1]; }
    __device__ __forceinline__ const float* w_ada() const { return pa->in[2]; }
    __device__ __forceinline__ const float* b_ada() const { return pa->in[3]; }
    __device__ __forceinline__ const float* norm1_g() const { return pa->in[4]; }
    __device__ __forceinline__ const float* w_in() const { return pa->in[5]; }
    __device__ __forceinline__ const float* q_norm_g() const { return pa->in[6]; }
    __device__ __forceinline__ const float* k_norm_g() const { return pa->in[7]; }
    __device__ __forceinline__ const float* lru_conv_w() const { return pa->in[8]; }
    __device__ __forceinline__ const float* lru_conv_b() const { return pa->in[9]; }
    __device__ __forceinline__ const float* lru_wa() const { return pa->in[10]; }
    __device__ __forceinline__ const float* lru_ba() const { return pa->in[11]; }
    __device__ __forceinline__ const float* lru_wx() const { return pa->in[12]; }
    __device__ __forceinline__ const float* lru_bx() const { return pa->in[13]; }
    __device__ __forceinline__ const float* lru_lambda() const { return pa->in[14]; }
    __device__ __forceinline__ const float* lru_out_g() const { return pa->in[15]; }
    __device__ __forceinline__ const float* attn_out_g() const { return pa->in[16]; }
    __device__ __forceinline__ const float* w_out() const { return pa->in[17]; }
    __device__ __forceinline__ const float* norm2_g() const { return pa->in[18]; }
    __device__ __forceinline__ const float* w_up() const { return pa->in[19]; }
    __device__ __forceinline__ const float* ffn_conv_w() const { return pa->in[20]; }
    __device__ __forceinline__ const float* ffn_conv_b() const { return pa->in[21]; }
    __device__ __forceinline__ const float* w_down() const { return pa->in[22]; }
    float* out; unsigned char* ws;
};
#define LDS_WAIT() asm volatile("s_waitcnt lgkmcnt(0)" ::: "memory")

template <int MODE>
__device__ __forceinline__ void p0_transpose_item(const float* W, int K, int N, u16* WT, LAS float* scr, int item, int lane, const float* kscale = nullptr) {
    const int nblk = N / 32, kb = item / nblk, nb = item % nblk, k0 = 64 * kb, n0 = 32 * nb;
#pragma unroll
    for (int i = 0; i < 8; ++i) { const int f = i * 64 + lane, kk = f >> 3, n4 = f & 7;
        f32x4 w = *(const GAS f32x4*)(W + (size_t)(k0 + kk) * N + n0 + 4 * n4); if (MODE == 3) w *= kscale[k0 + kk];
        LAS float* d = scr + kk * 33 + 4 * n4; d[0] = w.x; d[1] = w.y; d[2] = w.z; d[3] = w.w; }
    LDS_WAIT(); asm volatile("" ::: "memory");
    const int c = lane & 7;
#pragma unroll
    for (int j = 0; j < 4; ++j) { const int n = (lane >> 3) + 8 * j; const LAS float* s = scr + (8 * c) * 33 + n;
        u32x4 o;
        if (MODE == 1) { o.x = cvt_pk_f16(s[0 * 33], s[1 * 33]); o.y = cvt_pk_f16(s[2 * 33], s[3 * 33]); o.z = cvt_pk_f16(s[4 * 33], s[5 * 33]); o.w = cvt_pk_f16(s[6 * 33], s[7 * 33]); }
        else { o.x = cvt_pk_bf16(s[0 * 33], s[1 * 33]); o.y = cvt_pk_bf16(s[2 * 33], s[3 * 33]); o.z = cvt_pk_bf16(s[4 * 33], s[5 * 33]); o.w = cvt_pk_bf16(s[6 * 33], s[7 * 33]); }
        int nn = n0 + n;
        if (MODE == 1) nn = (nn & ~255) + 128 * ((nn >> 5) & 1) + 32 * ((nn >> 6) & 3) + (nn & 31);
        if (MODE == 2) { const int bj = nn >= D_FF ? 1 : 0, f = nn - bj * D_FF; nn = 256 * (f >> 7) + 128 * bj + (f & 127); }
        if (MODE == 4) *(GAS u32x4*)(WT + (((nn >> 5) * 4 + (c >> 1)) * 512 + ((c & 1) * 32 + (nn & 31)) * 8)) = o;
        else *(GAS u32x4*)(WT + (size_t)nn * K + k0 + 8 * c) = o; }
    LDS_WAIT(); asm volatile("" ::: "memory");
}
__device__ __forceinline__ void p0_prologue(Frame& F) {
    unsigned char* wsp = F.ws; asm volatile("" : "+s"(wsp));
    LAS float* cl = (LAS float*)(F.lds + CLDS_OFF);
    for (int i = F.tid; i < BATCH * D_MODEL; i += NT) cl[i] = F.c()[i];
    __syncthreads();
    LAS float* scr = (LAS float*)(F.lds + F.wave * 16384);
    const int gw = F.wave * F.G + F.vcu, NGW = F.G * NWAVES;
    constexpr int I_MOD = N_MOD / 64;
    constexpr int I_IN = (D_MODEL / 64) * (N_IN / 32), I_O = (D_MODEL / 64) * (D_MODEL / 32), I_DN = (D_FF / 64) * (D_MODEL / 32), I_L = 8 * 2;
    constexpr int NITEMS = I_MOD + I_IN + I_O + I_DN + 2 * I_L;
    u16* WinT = (u16*)(wsp + WS_WIN); u16* WoT = (u16*)(wsp + WS_WO); u16* WdT = (u16*)(wsp + WS_WDN);
    u16* WaT = (u16*)(wsp + WS_WA); u16* WxT = (u16*)(wsp + WS_WX);
    float* MOD = (float*)(wsp + WS_MOD);
    for (int it = gw; it < NITEMS; it += NGW) {
        int r = it;
        if (r < I_MOD) {
            const int col = r * 64 + F.lane; float a0 = 0.f, a1 = 0.f, a2 = 0.f, a3 = 0.f;
            const float* wp = F.w_ada() + col;
#pragma unroll 64
            for (int k = 0; k < D_MODEL; ++k) { const float w = wp[(size_t)k * N_MOD];
                a0 += cl[k] * w; a1 += cl[D_MODEL + k] * w; a2 += cl[2 * D_MODEL + k] * w; a3 += cl[3 * D_MODEL + k] * w; }
            const float bb = F.b_ada()[col];
            MOD[col] = a0 + bb; MOD[N_MOD + col] = a1 + bb; MOD[2 * N_MOD + col] = a2 + bb; MOD[3 * N_MOD + col] = a3 + bb;
            continue; }
        r -= I_MOD;
        if (r < I_IN) { p0_transpose_item<1>(F.w_in(), D_MODEL, N_IN, WinT, scr, r, F.lane); continue; } r -= I_IN;
        if (r < I_O) { const int kb = r / (D_MODEL / 32); p0_transpose_item<3>(F.w_out(), D_MODEL, D_MODEL, WoT, scr, r, F.lane, (kb < 8 ? F.lru_out_g() : F.attn_out_g() - AW)); continue; } r -= I_O;

        if (r < I_DN) { p0_transpose_item<0>(F.w_down(), D_FF, D_MODEL, WdT, scr, r, F.lane); continue; } r -= I_DN;
        if (r < I_L) { const int h = r >> 1; p0_transpose_item<4>(F.lru_wa() + h * 4096, 64, 64, WaT + h * 4096, scr, r & 1, F.lane); continue; } r -= I_L;
        { const int h = r >> 1; p0_transpose_item<4>(F.lru_wx() + h * 4096, 64, 64, WxT + h * 4096, scr, r & 1, F.lane); }
    }
}


constexpr int SCL_OFF = RING_BYTES;
__device__ __forceinline__ void p1_upweights(Frame& F, unsigned char* wsp) {
    const float* MODp = (const float*)(wsp + WS_MOD);
    LAS float* SC = (LAS float*)(F.lds + SCL_OFF);
#define SHB(b) ((LAS float*)(F.lds + 16384 * (b) + 8448))
    for (int i = F.tid; i < BATCH * D_MODEL; i += NT) { const int b = i >> 10, k = i & 1023; SC[i] = F.norm2_g()[k] * (1.0f + MODp[(size_t)b * N_MOD + 4096 + k]); SHB(b)[k] = MODp[(size_t)b * N_MOD + 3072 + k]; }
    __syncthreads();
    LAS float* scr = (LAS float*)(F.lds + F.wave * 16384);
    u16* W4 = (u16*)(wsp + WS_WUP4); float* BIAS2 = (float*)(wsp + WS_BIAS2);
    const float* W = F.w_up();
    const int gw = F.wave * F.G + F.vcu, NGW = F.G * NWAVES, lane = F.lane;
    for (int it = gw; it < 4 * (N_UP / 32); it += NGW) {
        const int n0 = 32 * (it >> 2), kc = it & 3;
        float bs0 = 0.f, bs1 = 0.f, bs2 = 0.f, bs3 = 0.f;
#pragma unroll 1
        for (int kb = 4 * kc; kb < 4 * kc + 4; ++kb) {
            const int k0 = 64 * kb;
#pragma unroll
            for (int i = 0; i < 8; ++i) { const int f = i * 64 + lane, kk = f >> 3, n4 = f & 7;
                const f32x4 w = *(const GAS f32x4*)(W + (size_t)(k0 + kk) * N_UP + n0 + 4 * n4);
                LAS float* d = scr + kk * 33 + 4 * n4; d[0] = w.x; d[1] = w.y; d[2] = w.z; d[3] = w.w; }
            LDS_WAIT(); asm volatile("" ::: "memory");
            { const int n = lane & 31, kh = lane >> 5;
#pragma unroll 8
              for (int kk = 0; kk < 32; ++kk) { const float w = scr[(32 * kh + kk) * 33 + n]; const int k = k0 + 32 * kh + kk;
                  bs0 += SHB(0)[k] * w; bs1 += SHB(1)[k] * w; bs2 += SHB(2)[k] * w; bs3 += SHB(3)[k] * w; } }
            const int c = lane & 7;
#pragma unroll
            for (int j = 0; j < 4; ++j) { const int n = (lane >> 3) + 8 * j; const LAS float* s = scr + (8 * c) * 33 + n;
                int nn = n0 + n; { const int bj = nn >= D_FF ? 1 : 0, f = nn - bj * D_FF; nn = 256 * (f >> 7) + 128 * bj + (f & 127); }
                float wv[8];
#pragma unroll
                for (int e = 0; e < 8; ++e) wv[e] = s[e * 33];
#pragma unroll
                for (int b = 0; b < BATCH; ++b) { const LAS float* sc = SC + b * 1024 + k0 + 8 * c;
                    u32x4 o; o.x = cvt_pk_bf16(wv[0] * sc[0], wv[1] * sc[1]); o.y = cvt_pk_bf16(wv[2] * sc[2], wv[3] * sc[3]); o.z = cvt_pk_bf16(wv[4] * sc[4], wv[5] * sc[5]); o.w = cvt_pk_bf16(wv[6] * sc[6], wv[7] * sc[7]);
                    *(GAS u32x4*)(W4 + ((size_t)b * N_UP + nn) * D_MODEL + k0 + 8 * c) = o; } }
            LDS_WAIT(); asm volatile("" ::: "memory");
        }
        bs0 += __shfl_xor(bs0, 32); bs1 += __shfl_xor(bs1, 32); bs2 += __shfl_xor(bs2, 32); bs3 += __shfl_xor(bs3, 32);
        if (lane < 32) { float* bp = BIAS2 + (size_t)kc * BATCH * N_UP + n0 + lane; bp[0] = bs0; bp[N_UP] = bs1; bp[2 * N_UP] = bs2; bp[3 * N_UP] = bs3; }
    }
}


__device__ __forceinline__ void cb2_prep(Frame& F, unsigned char* wsp) {
    const float* BIAS2 = (const float*)(wsp + WS_BIAS2); float* CB2 = (float*)(wsp + WS_CB2);
    const float* cw = F.ffn_conv_w(); const float* cb = F.ffn_conv_b();
    for (int i = F.vcu * NT + F.tid; i < BATCH * N_UP; i += F.G * NT) { const int b = i / N_UP, col = i % N_UP;
        const float bias = (BIAS2[(size_t)(0 * BATCH + b) * N_UP + col] + BIAS2[(size_t)(1 * BATCH + b) * N_UP + col]) + (BIAS2[(size_t)(2 * BATCH + b) * N_UP + col] + BIAS2[(size_t)(3 * BATCH + b) * N_UP + col]);
        CB2[i] = cb[col] + ((cw[col] + cw[N_UP + col]) + cw[2 * N_UP + col]) * bias; }
}

template <bool F16>
__device__ __forceinline__ void rownorm_phase(Frame& F, const float* X, const float* g, const float* sh, const float* sc, u16* O) {
    const int gw = F.vcu * NWAVES + F.wave, NGW = F.G * NWAVES;
    for (int m = gw; m < M_TOK; m += NGW) {
        const int b = m / SEQ;
        const GAS f32x4* xr = (const GAS f32x4*)(X + (size_t)m * D_MODEL) + F.lane;
        f32x4 v[4]; float s = 0.f;
#pragma unroll
        for (int j = 0; j < 4; ++j) { v[j] = xr[64 * j]; s += (v[j].x * v[j].x + v[j].y * v[j].y) + (v[j].z * v[j].z + v[j].w * v[j].w); }
        const float rstd = 1.0f / sqrtf(wave_sum(s) * (1.0f / D_MODEL) + EPS);
        GAS u32x2* o8 = (GAS u32x2*)(O + (size_t)m * D_MODEL) + F.lane;
#pragma unroll
        for (int j = 0; j < 4; ++j) {
            const int col = 4 * F.lane + 256 * j;
            const f32x4 gv = *(const f32x4*)(g + col), shv = *(const f32x4*)(sh + (size_t)b * N_MOD + col), scv = *(const f32x4*)(sc + (size_t)b * N_MOD + col);
            const f32x4 y = (v[j] * rstd) * gv * (scv + 1.0f) + shv;
            u32x2 w;
            if (F16) { w.x = cvt_pk_f16(y.x, y.y); w.y = cvt_pk_f16(y.z, y.w); } else { w.x = cvt_pk_bf16(y.x, y.y); w.y = cvt_pk_bf16(y.z, y.w); }
            o8[64 * j] = w; }
    }
}

__device__ __forceinline__ int crow(int r, int hi) { return (r & 3) + 8 * (r >> 2) + 4 * hi; }
__device__ __forceinline__ int qs_off(int q, int c) { return q * 64 + ((c ^ ((q >> 1) & 7)) << 3); }
constexpr int AL_QS = 0, AL_SLOT = 32768, AL_LSL = 131072, AL_LIST = 134144, AL_CNT = 150528, AL_MISC = 150656, AL_KMS = 150912;
__device__ __forceinline__ void attn_tile(const u16* Kp, const u16* Vp, const s16x8 (&qf)[4], int nkt, bool own, int tt, int qidx, int hi, float c1, float c2, f32x16& o0, f32x16& o1, float& lsum) {
#pragma unroll
    for (int r = 0; r < 16; ++r) { o0[r] = 0.f; o1[r] = 0.f; }
    lsum = 0.f;
    s16x8 kc[4], kn[4], vc[4];
#pragma unroll
    for (int s = 0; s < 4; ++s) { kc[s] = *(const GAS s16x8*)(Kp + s * 512); kn[s] = kc[s]; }
#pragma unroll 1
    for (int kt = 0; kt < nkt; ++kt) {
#pragma unroll
        for (int s = 0; s < 4; ++s) vc[s] = *(const GAS s16x8*)(Vp + (kt * 4 + s) * 512);
        if (kt + 1 < nkt) {
#pragma unroll
            for (int s = 0; s < 4; ++s) kn[s] = *(const GAS s16x8*)(Kp + ((kt + 1) * 4 + s) * 512);
        }
        f32x16 p;
#pragma unroll
        for (int r = 0; r < 16; ++r) p[r] = 0.f;
#pragma unroll
        for (int s = 0; s < 4; ++s) p = __builtin_amdgcn_mfma_f32_32x32x16_bf16(__builtin_bit_cast(bf16x8_t, kc[s]), __builtin_bit_cast(bf16x8_t, qf[s]), p, 0, 0, 0);
        const bool diag = own && (kt == tt);
#pragma unroll
        for (int r = 0; r < 16; ++r) { float e = __builtin_amdgcn_exp2f(p[r] * c1 - c2);
            if (diag && (32 * kt + crow(r, hi) > qidx)) e = 0.f;
            p[r] = e; lsum += e; }
#pragma unroll
        for (int s2 = 0; s2 < 2; ++s2) {
            u32x4 pw; pw.x = cvt_pk_bf16(p[8 * s2 + 0], p[8 * s2 + 1]); pw.y = cvt_pk_bf16(p[8 * s2 + 2], p[8 * s2 + 3]); pw.z = cvt_pk_bf16(p[8 * s2 + 4], p[8 * s2 + 5]); pw.w = cvt_pk_bf16(p[8 * s2 + 6], p[8 * s2 + 7]);
            const bf16x8_t pa = __builtin_bit_cast(bf16x8_t, pw);
            o0 = __builtin_amdgcn_mfma_f32_32x32x16_bf16(pa, __builtin_bit_cast(bf16x8_t, vc[2 * s2]), o0, 0, 0, 0);
            o1 = __builtin_amdgcn_mfma_f32_32x32x16_bf16(pa, __builtin_bit_cast(bf16x8_t, vc[2 * s2 + 1]), o1, 0, 0, 0);
        }
#pragma unroll
        for (int s = 0; s < 4; ++s) kc[s] = kn[s];
    }
}
__device__ __forceinline__ void attn_tile_full(const u16* Kp, const u16* Vp, const LAS u16* QS, int qidx, int hi, float c1, float c2, f32x16& o0, f32x16& o1, float& lsum) {
#pragma unroll
    for (int r = 0; r < 16; ++r) { o0[r] = 0.f; o1[r] = 0.f; }
    lsum = 0.f;
    s16x8 kr[4][4], vr[4][4];
    const u16* kp = Kp; const u16* vp = Vp;
#pragma unroll
    for (int d = 0; d < 3; ++d) {
#pragma unroll
        for (int s = 0; s < 4; ++s) { kr[d][s] = *(const GAS s16x8*)(kp + s * 512); vr[d][s] = *(const GAS s16x8*)(vp + s * 512); }
        kp += 2048; vp += 2048; asm volatile("" : "+v"(kp), "+v"(vp));
    }
#pragma unroll
    for (int kt = 0; kt < 8; ++kt) {
        if (kt + 3 < 8) {
#pragma unroll
            for (int s = 0; s < 4; ++s) { kr[(kt + 3) & 3][s] = *(const GAS s16x8*)(kp + s * 512); vr[(kt + 3) & 3][s] = *(const GAS s16x8*)(vp + s * 512); }
            kp += 2048; vp += 2048; asm volatile("" : "+v"(kp), "+v"(vp));
        }
        __builtin_amdgcn_sched_barrier(0);
        f32x16 p;
#pragma unroll
        for (int r = 0; r < 16; ++r) p[r] = 0.f;
#pragma unroll
        for (int s = 0; s < 4; ++s) { const s16x8 qf = *(const LAS s16x8*)(QS + qs_off(qidx, 2 * s + hi));
            p = __builtin_amdgcn_mfma_f32_32x32x16_bf16(__builtin_bit_cast(bf16x8_t, kr[kt & 3][s]), __builtin_bit_cast(bf16x8_t, qf), p, 0, 0, 0); }
#pragma unroll
        for (int r = 0; r < 16; ++r) { const float e = __builtin_amdgcn_exp2f(p[r] * c1 - c2); p[r] = e; lsum += e; }
#pragma unroll
        for (int s2 = 0; s2 < 2; ++s2) {
            u32x4 pw; pw.x = cvt_pk_bf16(p[8 * s2 + 0], p[8 * s2 + 1]); pw.y = cvt_pk_bf16(p[8 * s2 + 2], p[8 * s2 + 3]); pw.z = cvt_pk_bf16(p[8 * s2 + 4], p[8 * s2 + 5]); pw.w = cvt_pk_bf16(p[8 * s2 + 6], p[8 * s2 + 7]);
            const bf16x8_t pa = __builtin_bit_cast(bf16x8_t, pw);
            o0 = __builtin_amdgcn_mfma_f32_32x32x16_bf16(pa, __builtin_bit_cast(bf16x8_t, vr[kt & 3][2 * s2]), o0, 0, 0, 0);
            o1 = __builtin_amdgcn_mfma_f32_32x32x16_bf16(pa, __builtin_bit_cast(bf16x8_t, vr[kt & 3][2 * s2 + 1]), o1, 0, 0, 0);
        }
        __builtin_amdgcn_sched_barrier(0);
    }
}
__device__ __forceinline__ void attn_item(Frame& F, int bh, int i, float c1, float c2) {
    unsigned char* wsp = F.ws; asm volatile("" : "+s"(wsp));
    const float* QF = (const float*)(wsp + WS_QF); const u16* KB = (const u16*)(wsp + WS_KB); const u16* VT = (const u16*)(wsp + WS_VT);
    const float* KM = (const float*)(wsp + WS_KM); u16* ATT = (u16*)(wsp + WS_MIX); float* SSQA = (float*)(wsp + WS_SSQA);
    LAS u16* QS = (LAS u16*)(F.lds + AL_QS); LAS u16* SLOT = (LAS u16*)(F.lds + AL_SLOT); LAS float* LSL = (LAS float*)(F.lds + AL_LSL);
    LAS float* KMS = (LAS float*)(F.lds + AL_KMS); LAS u16* LIST = (LAS u16*)(F.lds + AL_LIST); LAS int* CNT = (LAS int*)(F.lds + AL_CNT);
    int tid_ = F.tid; asm volatile("" : "+v"(tid_));
    const int tid = tid_, lane = tid & 63, wave = F.wave, hi = lane >> 5, l31 = lane & 31;
    const int b = bh / NHEAD, h = bh % NHEAD;
    for (int u = tid; u < (3 * 32768 + 3072) / 16; u += NT) *(LAS u32x4*)(F.lds + AL_SLOT + u * 16) = (u32x4){0u, 0u, 0u, 0u};
    if (tid < 32) CNT[tid] = 0;
    for (int u = tid; u < NBLK * HD; u += NT) { const int n = u >> 6, d = u & 63; KMS[u] = KM[(((size_t)(b * NBLK + n)) * NHEAD + h) * HD + d] * (1.0f / 256.0f); }
    __syncthreads();
    {
        const int q = 32 * wave + l31;
        const GAS f32x4* qrow = (const GAS f32x4*)(QF + ((size_t)bh * SEQ + (size_t)i * BLK + q) * HD);
        f32x16 p;
#pragma unroll
        for (int r = 0; r < 16; ++r) p[r] = 0.f;
#pragma unroll
        for (int s = 0; s < 4; ++s) {
            const f32x4 qa = qrow[4 * s + 2 * hi], qc = qrow[4 * s + 2 * hi + 1];
            u32x4 qh; qh.x = cvt_pk_bf16(qa.x, qa.y); qh.y = cvt_pk_bf16(qa.z, qa.w); qh.z = cvt_pk_bf16(qc.x, qc.y); qh.w = cvt_pk_bf16(qc.z, qc.w);
            u32x4 ql; ql.x = cvt_pk_bf16(qa.x - bf_lo(qh.x), qa.y - bf_hi(qh.x)); ql.y = cvt_pk_bf16(qa.z - bf_lo(qh.y), qa.w - bf_hi(qh.y));
            ql.z = cvt_pk_bf16(qc.x - bf_lo(qh.z), qc.y - bf_hi(qh.z)); ql.w = cvt_pk_bf16(qc.z - bf_lo(qh.w), qc.w - bf_hi(qh.w));
            *(LAS u32x4*)(QS + qs_off(q, 2 * s + hi)) = qh;
            const LAS f32x4* kr = (const LAS f32x4*)(KMS + l31 * 64 + 16 * s + 8 * hi);
            const f32x4 ka = kr[0], kc = kr[1];
            u32x4 kh; kh.x = cvt_pk_bf16(ka.x, ka.y); kh.y = cvt_pk_bf16(ka.z, ka.w); kh.z = cvt_pk_bf16(kc.x, kc.y); kh.w = cvt_pk_bf16(kc.z, kc.w);
            u32x4 kl; kl.x = cvt_pk_bf16(ka.x - bf_lo(kh.x), ka.y - bf_hi(kh.x)); kl.y = cvt_pk_bf16(ka.z - bf_lo(kh.y), ka.w - bf_hi(kh.y));
            kl.z = cvt_pk_bf16(kc.x - bf_lo(kh.z), kc.y - bf_hi(kh.z)); kl.w = cvt_pk_bf16(kc.z - bf_lo(kh.w), kc.w - bf_hi(kh.w));
            p = __builtin_amdgcn_mfma_f32_32x32x16_bf16(__builtin_bit_cast(bf16x8_t, kl), __builtin_bit_cast(bf16x8_t, qh), p, 0, 0, 0);
            p = __builtin_amdgcn_mfma_f32_32x32x16_bf16(__builtin_bit_cast(bf16x8_t, kh), __builtin_bit_cast(bf16x8_t, ql), p, 0, 0, 0);
            p = __builtin_amdgcn_mfma_f32_32x32x16_bf16(__builtin_bit_cast(bf16x8_t, kh), __builtin_bit_cast(bf16x8_t, qh), p, 0, 0, 0);
        }
        float v0 = -INFINITY, v1 = -INFINITY, v2 = -INFINITY; int i0 = -1, i1 = -1, i2 = -1;
#pragma unroll
        for (int r = 0; r < 16; ++r) {
            const int n = crow(r, hi); const float g = (n < i) ? p[r] : -INFINITY;
            if (g > v0) { v2 = v1; i2 = i1; v1 = v0; i1 = i0; v0 = g; i0 = n; }
            else if (g > v1) { v2 = v1; i2 = i1; v1 = g; i1 = n; }
            else if (g > v2) { v2 = g; i2 = n; }
        }
        const float pv0 = __shfl_xor(v0, 32), pv1 = __shfl_xor(v1, 32), pv2 = __shfl_xor(v2, 32);
        const int pi0 = __shfl_xor(i0, 32), pi1 = __shfl_xor(i1, 32), pi2 = __shfl_xor(i2, 32);
        if (hi == 0) {
            float av[3] = {v0, v1, v2}, bv[3] = {pv0, pv1, pv2}; int ai[3] = {i0, i1, i2}, bi[3] = {pi0, pi1, pi2};
            int sel[3]; int pa = 0, pb = 0;
#pragma unroll
            for (int k = 0; k < 3; ++k) {
                const float ca = pa == 0 ? av[0] : (pa == 1 ? av[1] : av[2]); const int cai = pa == 0 ? ai[0] : (pa == 1 ? ai[1] : ai[2]);
                const float cb = pb == 0 ? bv[0] : (pb == 1 ? bv[1] : bv[2]); const int cbi = pb == 0 ? bi[0] : (pb == 1 ? bi[1] : bi[2]);
                if (ca > cb || (ca == cb && (cbi < 0 || (cai >= 0 && cai < cbi)))) { sel[k] = cai; ++pa; } else { sel[k] = cbi; ++pb; }
            }
#pragma unroll
            for (int k = 0; k < 3; ++k) if (sel[k] >= 0) { const int pos = __hip_atomic_fetch_add(&CNT[sel[k]], 1, __ATOMIC_RELAXED, __HIP_MEMORY_SCOPE_WORKGROUP); LIST[sel[k] * 256 + pos] = (u16)(q | (k << 8)); }
        }
    }
    __syncthreads();
    {
        int base = 0;
        for (int j = 0; j < i; ++j) {
            const int cntj = __builtin_amdgcn_readfirstlane(CNT[j]);
            const int ntj = (cntj + 31) >> 5;
            for (int t = base + ((wave - base) & 7); t < base + ntj; t += 8) {
                const int tt = t - base;
                const int ridx = 32 * tt + l31; const bool valid = ridx < cntj;
                const int ent = valid ? (int)LIST[j * 256 + ridx] : 0;
                const int qidx = ent & 255;
                s16x8 qf[4];
#pragma unroll
                for (int s = 0; s < 4; ++s) qf[s] = *(const LAS s16x8*)(QS + qs_off(qidx, 2 * s + hi));
                const size_t boff = ((size_t)bh * NBLK + j) * (BLK * HD) + lane * 8;
                f32x16 o0, o1; float lsum;
                attn_tile_full(KB + boff, VT + boff, QS, qidx, hi, c1, c2, o0, o1, lsum);
                const int srow = valid ? ((ent >> 8) * 256 + qidx) : -1;
                lsum += __shfl_xor(lsum, 32);
                if (valid && hi == 0) LSL[srow] = lsum;
#pragma unroll
                for (int r = 0; r < 16; ++r) { const int sr = __shfl(srow, crow(r, hi));
                    if (sr >= 0) { const unsigned w = cvt_pk_bf16(o0[r], o1[r]); SLOT[sr * 64 + l31] = (u16)(w & 0xffffu); SLOT[sr * 64 + 32 + l31] = (u16)(w >> 16); }
                    if ((r & 3) == 3) asm volatile("" ::: "memory"); }
            }
            base += ntj;
        }
    }
    f32x16 oo0, oo1; float lown;
    {
        s16x8 qf[4];
#pragma unroll
        for (int s = 0; s < 4; ++s) qf[s] = *(const LAS s16x8*)(QS + qs_off(32 * wave + l31, 2 * s + hi));
        const size_t boff = ((size_t)bh * NBLK + i) * (BLK * HD) + lane * 8;
        attn_tile(KB + boff, VT + boff, qf, wave + 1, true, wave, 32 * wave + l31, hi, c1, c2, oo0, oo1, lown);
    }
    __syncthreads();
    {
        const int q = 32 * wave + l31;
        float lt = lown + __shfl_xor(lown, 32);
        lt += LSL[q] + LSL[256 + q] + LSL[512 + q];
        const float inv = 1.0f / lt;
#pragma unroll
        for (int r = 0; r < 16; ++r) { const int rl = crow(r, hi), qq = 32 * wave + rl; const float iv = __shfl(inv, rl);
            float a = oo0[r], c = oo1[r];
#pragma unroll
            for (int k = 0; k < 3; ++k) { a += __builtin_bit_cast(float, (unsigned)SLOT[(k * 256 + qq) * 64 + l31] << 16); c += __builtin_bit_cast(float, (unsigned)SLOT[(k * 256 + qq) * 64 + 32 + l31] << 16); }
            const unsigned w = cvt_pk_bf16(a * iv, c * iv);
            QS[qq * 64 + l31] = (u16)(w & 0xffffu); QS[qq * 64 + 32 + l31] = (u16)(w >> 16);
            if ((r & 3) == 3) asm volatile("" ::: "memory"); }
        LDS_WAIT(); asm volatile("" ::: "memory");
#pragma unroll
        for (int it = 0; it < 4; ++it) { const int c = lane + 64 * it, row = c >> 3, ch = c & 7;
            const u32x4 w = *(const LAS u32x4*)(QS + (32 * wave + row) * 64 + 8 * ch);
            const size_t tok = (size_t)b * SEQ + (size_t)i * BLK + 32 * wave + row;
            *(GAS u32x4*)(ATT + tok * D_MODEL + AW + h * HD + 8 * ch) = w;
            float ss = bf_lo(w.x) * bf_lo(w.x) + bf_hi(w.x) * bf_hi(w.x) + bf_lo(w.y) * bf_lo(w.y) + bf_hi(w.y) * bf_hi(w.y) + bf_lo(w.z) * bf_lo(w.z) + bf_hi(w.z) * bf_hi(w.z) + bf_lo(w.w) * bf_lo(w.w) + bf_hi(w.w) * bf_hi(w.w);
            ss += __shfl_xor(ss, 1); ss += __shfl_xor(ss, 2); ss += __shfl_xor(ss, 4);
            if (ch == 0) SSQA[tok * NHEAD + h] = ss; }
    }
    __syncthreads();
}
__device__ __forceinline__ void attn_phase(Frame& F) {
    LAS float* mm = (LAS float*)(F.lds + AL_MISC);
    if (F.tid < 64) { float a = fabsf(F.q_norm_g()[F.tid]), c = fabsf(F.k_norm_g()[F.tid]);
#pragma unroll
        for (int o = 1; o < 64; o <<= 1) { a = fmaxf(a, __shfl_xor(a, o)); c = fmaxf(c, __shfl_xor(c, o)); }
        if (F.tid == 0) { mm[0] = a; mm[1] = c; } }
    __syncthreads();
    const float C = 8.0f * mm[0] * mm[1];
    const float c1 = 0.125f * LOG2E, c2 = C * LOG2E;
    __syncthreads();
    if (F.G == 256) {
        const int xcd = F.vcu >> 5, k = F.vcu & 31;
#pragma unroll 1
        for (int r = 0; r < 4; ++r) attn_item(F, xcd * 4 + r, (r & 1) ? 31 - k : k, c1, c2);
    } else {
        for (int it = F.vcu; it < BATCH * NHEAD * NBLK; it += F.G) attn_item(F, it >> 5, it & 31, c1, c2);
    }
}

constexpr int LL_CW = 0;
template <bool FINAL>
__device__ __forceinline__ void lru_item(Frame& F, int b, int chunk) {
    unsigned char* wsp = F.ws; asm volatile("" : "+s"(wsp));
    const u16* XR = (const u16*)(wsp + WS_XR); const u16* GG = (const u16*)(wsp + WS_GG);
    const u16* WaT = (const u16*)(wsp + WS_WA); const u16* WxT = (const u16*)(wsp + WS_WX);
    float* AGG = (float*)(wsp + WS_AGG); u16* LRU = (u16*)(wsp + WS_MIX); float* SSQL = (float*)(wsp + WS_SSQL);
    const int lane = F.lane, hd = F.wave, hi = lane >> 5, j = lane & 31;
    LAS float* CW = (LAS float*)(F.lds + LL_CW + hd * 2048);
    LAS u16* OT = (LAS u16*)(F.lds + 16384 + hd * 4096);
    for (int u = lane; u < 320; u += 64) CW[u] = (u < 256) ? F.lru_conv_w()[(u >> 6) * AW + hd * HD + (u & 63)] : F.lru_conv_b()[hd * HD + (u - 256)];
    CW[320 + lane] = F.lru_ba()[hd * HD + lane]; CW[384 + lane] = F.lru_bx()[hd * HD + lane]; CW[448 + lane] = 8.0f * log1pf(expf(-F.lru_lambda()[hd * HD + lane]));
    LDS_WAIT(); asm volatile("" ::: "memory");
    float carry[2], arun[2];
#pragma unroll
    for (int ct = 0; ct < 2; ++ct) { const int c = hd * HD + 32 * ct + j; carry[ct] = 0.f; arun[ct] = 1.f;
        if (FINAL) { float hcar = 0.f; for (int cc = 0; cc < chunk; ++cc) { const f32x2 ah = *(const f32x2*)(AGG + (((size_t)(b * 64 + cc)) * AW + c) * 2); hcar = ah.x * hcar + ah.y; } carry[ct] = hcar; } }
    for (int tile = 0; tile < 4; ++tile) {
        const int t0 = chunk * 128 + tile * 32;
        const u16* WaTt = WaT; const u16* WxTt = WxT; int jt = j; asm volatile("" : "+s"(WaTt), "+s"(WxTt), "+v"(jt));
        const int pos = t0 + j;
        s16x8 af[4];
#pragma unroll
        for (int s = 0; s < 4; ++s) {
            const int ch0 = 16 * s + 8 * hi;
            float xc[8];
            { const LAS f32x4* bp = (const LAS f32x4*)(CW + 256 + ch0); const f32x4 b0 = bp[0], b1 = bp[1];
              xc[0] = b0.x; xc[1] = b0.y; xc[2] = b0.z; xc[3] = b0.w; xc[4] = b1.x; xc[5] = b1.y; xc[6] = b1.z; xc[7] = b1.w; }
            float accv[8];
#pragma unroll
            for (int e = 0; e < 8; ++e) accv[e] = 0.f;
#pragma unroll
            for (int jj = 0; jj < 4; ++jj) {
                const int p = pos - 3 + jj;
                u32x4 xw = (u32x4){0u, 0u, 0u, 0u};
                if (p >= 0) xw = *(const GAS u32x4*)(XR + ((((size_t)b * (SEQ / 32) + (p >> 5)) * NHEAD + hd) * 2048) + ((s * 2 + hi) * 32 + (p & 31)) * 8);
                const LAS f32x4* wp = (const LAS f32x4*)(CW + jj * 64 + ch0); const f32x4 w0 = wp[0], w1 = wp[1];
                accv[0] += w0.x * bf_lo(xw.x); accv[1] += w0.y * bf_hi(xw.x); accv[2] += w0.z * bf_lo(xw.y); accv[3] += w0.w * bf_hi(xw.y);
                accv[4] += w1.x * bf_lo(xw.z); accv[5] += w1.y * bf_hi(xw.z); accv[6] += w1.z * bf_lo(xw.w); accv[7] += w1.w * bf_hi(xw.w);
            }
#pragma unroll
            for (int e = 0; e < 8; ++e) xc[e] += accv[e];
            u32x4 aw; aw.x = cvt_pk_bf16(xc[0], xc[1]); aw.y = cvt_pk_bf16(xc[2], xc[3]); aw.z = cvt_pk_bf16(xc[4], xc[5]); aw.w = cvt_pk_bf16(xc[6], xc[7]);
            af[s] = __builtin_bit_cast(s16x8, aw);
            __builtin_amdgcn_sched_barrier(0);
        }
        float ssacc[16];
#pragma unroll
        for (int r = 0; r < 16; ++r) ssacc[r] = 0.f;
#pragma unroll
        for (int ct = 0; ct < 2; ++ct) {
            float av[16], uv[16];
            {
                f32x16 aA, aX;
#pragma unroll
                for (int r = 0; r < 16; ++r) { aA[r] = 0.f; aX[r] = 0.f; }
#pragma unroll
                for (int s = 0; s < 4; ++s) {
                    const size_t woff = (size_t)hd * 4096 + (ct * 4 + s) * 512 + lane * 8;
                    const s16x8 wa = *(const GAS s16x8*)(WaTt + woff), wx = *(const GAS s16x8*)(WxTt + woff);
                    const bf16x8_t a = __builtin_bit_cast(bf16x8_t, af[s]);
                    aA = __builtin_amdgcn_mfma_f32_32x32x16_bf16(a, __builtin_bit_cast(bf16x8_t, wa), aA, 0, 0, 0);
                    aX = __builtin_amdgcn_mfma_f32_32x32x16_bf16(a, __builtin_bit_cast(bf16x8_t, wx), aX, 0, 0, 0);
                }
                const float bac = CW[320 + 32 * ct + jt], bxc = CW[384 + 32 * ct + jt], sp8c = CW[448 + 32 * ct + jt];
#pragma unroll
                for (int r = 0; r < 16; ++r) {
                    const float rr = sigmoidf_(aA[r] + bac), ii = sigmoidf_(aX[r] + bxc);
                    const float la = -rr * sp8c;
                    const float a = __builtin_amdgcn_exp2f(la * LOG2E);
                    const float x2 = 2.0f * la;
                    const float om = (x2 > -0.05f) ? -x2 * (1.0f + x2 * 0.5f * (1.0f + x2 * (1.0f / 3.0f) * (1.0f + x2 * 0.25f))) : 1.0f - a * a;
                    av[r] = a; uv[r] = __builtin_amdgcn_sqrtf(om) * ii;
                }
            }
            f32x16 aG;
            {
                f32x16 aI;
#pragma unroll
                for (int r = 0; r < 16; ++r) { aI[r] = 0.f; aG[r] = 0.f; }
#pragma unroll
                for (int s = 0; s < 4; ++s) {
                    s16x8 id;
#pragma unroll
                    for (int e = 0; e < 8; ++e) id[e] = (16 * s + 8 * hi + e == 32 * ct + jt) ? (short)0x3F80 : (short)0;
                    aI = __builtin_amdgcn_mfma_f32_32x32x16_bf16(__builtin_bit_cast(bf16x8_t, af[s]), __builtin_bit_cast(bf16x8_t, id), aI, 0, 0, 0);
                    if (FINAL) { const s16x8 gfr = *(const GAS s16x8*)(GG + ((((size_t)b * (SEQ / 32) + (t0 >> 5)) * NHEAD + hd) * 2048) + s * 512 + lane * 8);
                        aG = __builtin_amdgcn_mfma_f32_32x32x16_bf16(__builtin_bit_cast(bf16x8_t, gfr), __builtin_bit_cast(bf16x8_t, id), aG, 0, 0, 0); }
                }
#pragma unroll
                for (int r = 0; r < 16; ++r) uv[r] *= aI[r];
            }
            float Ag[4], Ug[4];
#pragma unroll
            for (int g = 0; g < 4; ++g) { float A = av[4 * g], U = uv[4 * g];
#pragma unroll
                for (int e = 1; e < 4; ++e) { A *= av[4 * g + e]; U = av[4 * g + e] * U + uv[4 * g + e]; }
                Ag[g] = A; Ug[g] = U; }
            float h = carry[ct], ap = arun[ct];
            float hin[4];
#pragma unroll
            for (int g = 0; g < 4; ++g) {
                const float pA = __shfl_xor(Ag[g], 32), pU = __shfl_xor(Ug[g], 32);
                const float fA = hi ? pA : Ag[g], fU = hi ? pU : Ug[g], sA = hi ? Ag[g] : pA, sU = hi ? Ug[g] : pU;
                const float h1 = fA * h + fU;
                hin[g] = hi ? h1 : h;
                h = sA * h1 + sU; ap *= fA * sA;
            }
            carry[ct] = h; arun[ct] = ap;
            if (FINAL) {
#pragma unroll
                for (int g = 0; g < 4; ++g) { float hh = hin[g];
#pragma unroll
                    for (int e = 0; e < 4; ++e) { const int r = 4 * g + e; hh = av[r] * hh + uv[r]; const float o = hh * aG[r]; ssacc[r] += o * o;
                        OT[crow(r, hi) * 64 + 32 * ct + j] = (u16)(cvt_pk_bf16(o, 0.f) & 0xffffu); } }
            }
        }
        if (FINAL) {
#pragma unroll
            for (int r = 0; r < 16; ++r) {
                const size_t tok = (size_t)b * SEQ + t0 + crow(r, hi);
                float ss = ssacc[r];
                ss += __shfl_xor(ss, 1); ss += __shfl_xor(ss, 2); ss += __shfl_xor(ss, 4); ss += __shfl_xor(ss, 8); ss += __shfl_xor(ss, 16);
                if (j == 0) SSQL[tok * NHEAD + hd] = ss;
            }
            LDS_WAIT(); asm volatile("" ::: "memory");
#pragma unroll
            for (int it = 0; it < 4; ++it) { const int c = lane + 64 * it, row = c >> 3, ch = c & 7;
                const u32x4 w = *(const LAS u32x4*)(OT + row * 64 + 8 * ch);
                *(GAS u32x4*)(LRU + ((size_t)b * SEQ + t0 + row) * D_MODEL + hd * HD + 8 * ch) = w; }
            LDS_WAIT(); asm volatile("" ::: "memory");
        }
    }
    if (!FINAL) { if (hi == 0) {
#pragma unroll
        for (int ct = 0; ct < 2; ++ct) { const int c = hd * HD + 32 * ct + j; *(f32x2*)(AGG + (((size_t)(b * 64 + chunk)) * AW + c) * 2) = (f32x2){arun[ct], carry[ct]}; } } }
}
template <bool FINAL>
__device__ __forceinline__ void lru_phase(Frame& F) {
    for (int it = F.vcu; it < BATCH * 64; it += F.G) { lru_item<FINAL>(F, it >> 6, it & 63); }
}

__device__ __forceinline__ void mix_phase(Frame& F) {
    unsigned char* wsp = F.ws; asm volatile("" : "+s"(wsp));
    const u16* LRU = (const u16*)(wsp + WS_LRU); const u16* ATT = (const u16*)(wsp + WS_ATT);
    const float* SSQL = (const float*)(wsp + WS_SSQL); const float* SSQA = (const float*)(wsp + WS_SSQA); u16* MIX = (u16*)(wsp + WS_MIX);
    const int gw = F.vcu * NWAVES + F.wave, NGW = F.G * NWAVES, lane = F.lane;
    const f32x4 gl0 = *(const f32x4*)(F.lru_out_g() + 8 * lane), gl1 = *(const f32x4*)(F.lru_out_g() + 8 * lane + 4);
    const f32x4 ga0 = *(const f32x4*)(F.attn_out_g() + 8 * lane), ga1 = *(const f32x4*)(F.attn_out_g() + 8 * lane + 4);
    for (int m = gw; m < M_TOK; m += NGW) {
        const f32x4 s0 = *(const GAS f32x4*)(SSQL + (size_t)m * 8), s1 = *(const GAS f32x4*)(SSQL + (size_t)m * 8 + 4);
        const f32x4 t0 = *(const GAS f32x4*)(SSQA + (size_t)m * 8), t1 = *(const GAS f32x4*)(SSQA + (size_t)m * 8 + 4);
        const float ssl = ((s0.x + s0.y) + (s0.z + s0.w)) + ((s1.x + s1.y) + (s1.z + s1.w));
        const float ssa = ((t0.x + t0.y) + (t0.z + t0.w)) + ((t1.x + t1.y) + (t1.z + t1.w));
        const float rl = 1.0f / sqrtf(ssl * (1.0f / AW) + EPS), ra = 1.0f / sqrtf(ssa * (1.0f / AW) + EPS);
        const u32x4 lw = *(const GAS u32x4*)(LRU + (size_t)m * AW + 8 * lane), aw = *(const GAS u32x4*)(ATT + (size_t)m * AW + 8 * lane);
        u32x4 o;
        o.x = cvt_pk_bf16(bf_lo(lw.x) * rl * gl0.x, bf_hi(lw.x) * rl * gl0.y); o.y = cvt_pk_bf16(bf_lo(lw.y) * rl * gl0.z, bf_hi(lw.y) * rl * gl0.w);
        o.z = cvt_pk_bf16(bf_lo(lw.z) * rl * gl1.x, bf_hi(lw.z) * rl * gl1.y); o.w = cvt_pk_bf16(bf_lo(lw.w) * rl * gl1.z, bf_hi(lw.w) * rl * gl1.w);
        *(GAS u32x4*)(MIX + (size_t)m * D_MODEL + 8 * lane) = o;
        o.x = cvt_pk_bf16(bf_lo(aw.x) * ra * ga0.x, bf_hi(aw.x) * ra * ga0.y); o.y = cvt_pk_bf16(bf_lo(aw.y) * ra * ga0.z, bf_hi(aw.y) * ra * ga0.w);
        o.z = cvt_pk_bf16(bf_lo(aw.z) * ra * ga1.x, bf_hi(aw.z) * ra * ga1.y); o.w = cvt_pk_bf16(bf_lo(aw.w) * ra * ga1.z, bf_hi(aw.w) * ra * ga1.w);
        *(GAS u32x4*)(MIX + (size_t)m * D_MODEL + AW + 8 * lane) = o;
    }
}

__device__ __forceinline__ void ffn_fixup(Frame& F, unsigned char* wsp, int pm) {
    const float* RAW = (const float*)(wsp + WS_RAW); u16* ACT = (u16*)(wsp + WS_ACT);
    const float* cw = F.ffn_conv_w(); const float* cb = F.ffn_conv_b();
    const bool first = (pm % NBLK) == 0;
    for (int f = F.tid; f < D_FF; f += NT) {
        float xg[4], xv[4];
        xg[0] = first ? 0.f : RAW[((size_t)(pm - 1) * 4 + 2) * N_UP + f]; xg[1] = first ? 0.f : RAW[((size_t)(pm - 1) * 4 + 3) * N_UP + f];
        xv[0] = first ? 0.f : RAW[((size_t)(pm - 1) * 4 + 2) * N_UP + D_FF + f]; xv[1] = first ? 0.f : RAW[((size_t)(pm - 1) * 4 + 3) * N_UP + D_FF + f];
        xg[2] = RAW[((size_t)pm * 4 + 0) * N_UP + f]; xg[3] = RAW[((size_t)pm * 4 + 1) * N_UP + f];
        xv[2] = RAW[((size_t)pm * 4 + 0) * N_UP + D_FF + f]; xv[3] = RAW[((size_t)pm * 4 + 1) * N_UP + D_FF + f];
        const float wg0 = cw[f], wg1 = cw[N_UP + f], wg2 = cw[2 * N_UP + f], bg = cb[f];
        const float wv0 = cw[D_FF + f], wv1 = cw[N_UP + D_FF + f], wv2 = cw[2 * N_UP + D_FF + f], bv = cb[D_FF + f];
#pragma unroll
        for (int r = 0; r < 2; ++r) {
            const float cg = ((wg0 * xg[r] + wg1 * xg[r + 1]) + wg2 * xg[r + 2]) + bg;
            const float cv = ((wv0 * xv[r] + wv1 * xv[r + 1]) + wv2 * xv[r + 2]) + bv;
            ACT[((size_t)pm * 256 + r) * D_FF + f] = (u16)(cvt_pk_bf16(cg * sigmoidf_(cg) * cv, 0.f) & 0xffffu);
        }
    }
}

constexpr int N_PHASES = 10;
__global__ void __launch_bounds__(NT, 2) hymba_fwd(Args args) {
    extern __shared__ __attribute__((aligned(16))) unsigned char lds_raw[];
    Frame F;
    F.lds = (LAS unsigned char*)lds_raw;
    F.tid = threadIdx.x; F.lane = F.tid & 63; F.wave = __builtin_amdgcn_readfirstlane(F.tid >> 6); F.wave0 = F.wave;
    F.G = gridDim.x; { const int bx = blockIdx.x; F.vcu = (F.G % 8 == 0) ? (bx % 8) * (F.G / 8) + bx / 8 : bx; }
    F.pa = &args;
    F.out = args.out; F.ws = args.ws;
    volatile LAS unsigned* MISC = (volatile LAS unsigned*)(F.lds + MISC_OFF);
    if (F.tid < 32) MISC[F.tid] = 0u;
    __syncthreads();
    const int lo = args.ph_lo, hi = args.ph_hi;
    unsigned* ctl = (unsigned*)(F.ws + WS_CTL);
    XcdBarrier bar; bar.bar = ctl + CW_BAR; bar.x = 0; bar.st = nullptr;
    if (hi - lo > 1) bar = xcd_barrier_post(ctl + CW_BAR, MISC + 8);
#ifndef PHASE_MASK
#define PHASE_MASK 0x3FF
#endif
#define IN(k) (((PHASE_MASK >> (k)) & 1) && lo <= (k) && (k) < hi)
#ifndef DUP_MASK
#define DUP_MASK 0
#endif
#define REP(k) _Pragma("unroll 1") for (int rep_ = 0; rep_ < 1 + ((DUP_MASK >> (k)) & 1); ++rep_)
#ifndef XBAR
#define XBAR 0
#endif
#define SEAM(k) do { if (IN(k) && IN((k) + 1)) { xcd_barrier(bar, F.wave0 * 64 + lane_id()); for (int xb_ = 0; xb_ < XBAR; ++xb_) xcd_barrier(bar, F.wave0 * 64 + lane_id()); } } while (0)
#define MOD ((float*)(wsp + WS_MOD))
#define H ((u16*)(wsp + WS_H))

    if (IN(0)) { unsigned char* wsp = F.ws; asm volatile("" : "+s"(wsp)); { int t_ = F.wave0 * 64 + lane_id(); asm volatile("" : "+v"(t_)); F.tid = t_; F.lane = t_ & 63; F.wave = __builtin_amdgcn_readfirstlane(t_ >> 6); } REP(0) p0_prologue(F); SEAM(0); }
    if (IN(1)) { unsigned char* wsp = F.ws; asm volatile("" : "+s"(wsp)); { int t_ = F.wave0 * 64 + lane_id(); asm volatile("" : "+v"(t_)); F.tid = t_; F.lane = t_ & 63; F.wave = __builtin_amdgcn_readfirstlane(t_ >> 6); } REP(1) { p1_upweights(F, wsp); rownorm_phase<true>(F, F.x(), F.norm1_g(), MOD + 0, MOD + 1024, H); } SEAM(1); }
    if (IN(2)) { unsigned char* wsp = F.ws; asm volatile("" : "+s"(wsp)); { int t_ = F.wave0 * 64 + lane_id(); asm volatile("" : "+v"(t_)); F.tid = t_; F.lane = t_ & 63; F.wave = __builtin_amdgcn_readfirstlane(t_ >> 6); }
        pg8::Gemm g{H, (const u16*)(wsp + WS_WIN), M_TOK, N_IN, D_MODEL, 0}; pg8::StaticOrder S; S.init(M_TOK, N_IN, F.G, (int)blockIdx.x);
        pg8::EpiInProj E{(float*)(wsp + WS_QF), (u16*)(wsp + WS_KB), (u16*)(wsp + WS_VT), (u16*)(wsp + WS_XR), (u16*)(wsp + WS_GG), (float*)(wsp + WS_KM), F.q_norm_g(), F.k_norm_g()};
        REP(2) pg8::gemm_phase<pg8::EpiInProj, pg8::StaticOrder, true, true, true>(F.lds, g, S, E, F.wave0);
        SEAM(2);
    }
    if (IN(3)) { unsigned char* wsp = F.ws; asm volatile("" : "+s"(wsp)); { int t_ = F.wave0 * 64 + lane_id(); asm volatile("" : "+v"(t_)); F.tid = t_; F.lane = t_ & 63; F.wave = __builtin_amdgcn_readfirstlane(t_ >> 6); } cb2_prep(F, wsp); REP(3) attn_phase(F); { int t_ = F.wave0 * 64 + lane_id(); asm volatile("" : "+v"(t_)); F.tid = t_; F.lane = t_ & 63; F.wave = __builtin_amdgcn_readfirstlane(t_ >> 6); } REP(13) lru_phase<false>(F); SEAM(3); }
    if (IN(4)) { unsigned char* wsp = F.ws; asm volatile("" : "+s"(wsp)); { int t_ = F.wave0 * 64 + lane_id(); asm volatile("" : "+v"(t_)); F.tid = t_; F.lane = t_ & 63; F.wave = __builtin_amdgcn_readfirstlane(t_ >> 6); } REP(4) lru_phase<true>(F); if (IN(4) && IN(6)) xcd_barrier(bar, F.wave0 * 64 + lane_id()); }
    if (IN(6)) { unsigned char* wsp = F.ws; asm volatile("" : "+s"(wsp)); { int t_ = F.wave0 * 64 + lane_id(); asm volatile("" : "+v"(t_)); F.tid = t_; F.lane = t_ & 63; F.wave = __builtin_amdgcn_readfirstlane(t_ >> 6); }
        pg8::Gemm g{(const u16*)(wsp + WS_MIX), (const u16*)(wsp + WS_WO), M_TOK, D_MODEL, D_MODEL, 0}; pg8::StaticOrder S; S.init(M_TOK, D_MODEL, F.G, (int)blockIdx.x);
        pg8::EpiOut E{F.x(), H, (float*)(wsp + WS_SSQX), MOD + 2048, (const float*)(wsp + WS_SSQL), (const float*)(wsp + WS_SSQA)};
        REP(6) pg8::gemm_phase<pg8::EpiOut, pg8::StaticOrder, true, true, false>(F.lds, g, S, E, F.wave0);
        if (IN(6) && IN(8)) xcd_barrier(bar, F.wave0 * 64 + lane_id());
    }
    if (IN(8)) { unsigned char* wsp = F.ws; asm volatile("" : "+s"(wsp)); { int t_ = F.wave0 * 64 + lane_id(); asm volatile("" : "+v"(t_)); F.tid = t_; F.lane = t_ & 63; F.wave = __builtin_amdgcn_readfirstlane(t_ >> 6); }
        pg8::Gemm g{H, (const u16*)(wsp + WS_WUP4), M_TOK, N_UP, D_MODEL, (size_t)N_UP * D_MODEL * 2}; pg8::StaticOrder S; S.init(M_TOK, N_UP, F.G, (int)blockIdx.x);
        pg8::EpiFFN E{(u16*)(wsp + WS_ACT), (float*)(wsp + WS_RAW), F.ffn_conv_w(), (const float*)(wsp + WS_CB2), (LAS float*)(F.lds + XB_OFF), (const float*)(wsp + WS_SSQX), (const float*)(wsp + WS_BIAS2)};
        REP(8) pg8::gemm_phase<pg8::EpiFFN, pg8::StaticOrder, true, true, false>(F.lds, g, S, E, F.wave0);
        SEAM(8);
    }
    if (IN(9)) { unsigned char* wsp = F.ws; asm volatile("" : "+s"(wsp)); { int t_ = F.wave0 * 64 + lane_id(); asm volatile("" : "+v"(t_)); F.tid = t_; F.lane = t_ & 63; F.wave = __builtin_amdgcn_readfirstlane(t_ >> 6); }
        pg8::Gemm g{(const u16*)(wsp + WS_ACT), (const u16*)(wsp + WS_WDN), M_TOK, D_MODEL, D_FF, 0}; pg8::StaticOrder S; S.init(M_TOK, D_MODEL, F.G, (int)blockIdx.x);
        { pg8::Unit u0, u1; int pm0 = -1; if (S.next(0, u0)) { pm0 = u0.pm; ffn_fixup(F, wsp, pm0); } if (S.next(1, u1) && u1.pm != pm0) ffn_fixup(F, wsp, u1.pm);
          for (int i = 2; ; ++i) { pg8::Unit ux; if (!S.next(i, ux)) break; ffn_fixup(F, wsp, ux.pm); }
          asm volatile("s_waitcnt vmcnt(0)" ::: "memory"); __syncthreads(); }
        pg8::EpiResidB E{H, F.out, MOD + 5120};
        REP(9) pg8::gemm_phase<pg8::EpiResidB, pg8::StaticOrder, true, true, false>(F.lds, g, S, E, F.wave0);
    }
    if (hi - lo > 1 && hi == N_PHASES) {
        if (xb_ld(ctl + CW_BAR + XB_TMO) != 0u) { asm volatile("s_waitcnt vmcnt(0)" ::: "memory"); __syncthreads();
            for (size_t i = (size_t)blockIdx.x * NT + F.tid; i < (size_t)M_TOK * D_MODEL; i += (size_t)F.G * NT) F.out[i] = __builtin_nanf(""); }
    }
#undef IN
#undef MOD
#undef H
#undef SEAM
}

#ifndef MK_PER_PHASE
#define MK_PER_PHASE 0
#endif
extern "C" void kernel_launch(void* const* d_in, const int* in_sizes, int n_in, void* d_out, int out_size, void* d_ws, size_t ws_size, hipStream_t stream) {
    static int grid = 0;
    if (grid == 0) {
        if (n_in != 23 || in_sizes[0] != M_TOK * D_MODEL || out_size != M_TOK * D_MODEL || ws_size < WS_END) {
            fprintf(stderr, "kernel_launch: unexpected shapes (n_in %d, in0 %d, out %d, ws %zu); nothing launched\n", n_in, n_in > 0 ? in_sizes[0] : -1, out_size, ws_size); grid = -1; return; }
        int dev = 0, cus = 0;
        if (hipGetDevice(&dev) != hipSuccess || hipDeviceGetAttribute(&cus, hipDeviceAttributeMultiprocessorCount, dev) != hipSuccess) { grid = -1; return; }
        if (hipFuncSetAttribute((const void*)hymba_fwd, hipFuncAttributeMaxDynamicSharedMemorySize, LDS_BYTES) != hipSuccess) { fprintf(stderr, "kernel_launch: hipFuncSetAttribute failed\n"); grid = -1; return; }
        grid = cus;
    }
    if (grid < 0) return;
    (void)hipMemsetAsync((char*)d_ws + WS_CTL, 0, CTL_ZERO_BYTES, stream);
    Args a{};
    for (int i = 0; i < 23; ++i) a.in[i] = (const float*)d_in[i];
    a.out = (float*)d_out; a.ws = (unsigned char*)d_ws;
#if MK_PER_PHASE
    for (int p = 0; p < N_PHASES; ++p) { a.ph_lo = p; a.ph_hi = p + 1; hipLaunchKernelGGL(hymba_fwd, dim3(grid), dim3(NT), LDS_BYTES, stream, a); }
#else
    a.ph_lo = 0; a.ph_hi = N_PHASES; hipLaunchKernelGGL(hymba_fwd, dim3(grid), dim3(NT), LDS_BYTES, stream, a);
#endif
}
```

```cpp
#include <hip/hip_runtime.h>
#include <cstdio>
#include <cstdint>

#define GAS __attribute__((address_space(1)))
#define LAS __attribute__((address_space(3)))
typedef unsigned short u16;
typedef short s16x8 __attribute__((ext_vector_type(8)));
typedef _Float16 f16x8 __attribute__((ext_vector_type(8)));
typedef __bf16 bf16x8_t __attribute__((ext_vector_type(8)));
typedef float f32x2 __attribute__((ext_vector_type(2)));
typedef float f32x4 __attribute__((ext_vector_type(4)));
typedef float f32x16 __attribute__((ext_vector_type(16)));
typedef unsigned u32x4 __attribute__((ext_vector_type(4)));
typedef unsigned u32x2 __attribute__((ext_vector_type(2)));
typedef GAS unsigned gu32;
#define RLX_AGENT __ATOMIC_RELAXED, __HIP_MEMORY_SCOPE_AGENT

constexpr int D_MODEL = 1024, BATCH = 4, SEQ = 8192, M_TOK = BATCH * SEQ;
constexpr int N_IN = 2560, D_FF = 2816, N_UP = 2 * D_FF, N_MOD = 6 * D_MODEL;
constexpr int NHEAD = 8, HD = 64, AW = 512, NBLK = 32, BLK = 256;
constexpr float EPS = 1e-6f;
constexpr float LOG2E = 1.4426950408889634f;

__device__ __forceinline__ unsigned cvt_pk_bf16(float lo, float hi) { unsigned r; asm volatile("v_cvt_pk_bf16_f32 %0, %1, %2" : "=v"(r) : "v"(lo), "v"(hi)); return r; }
__device__ __forceinline__ unsigned cvt_pk_f16(float lo, float hi) {
    const _Float16 a = (_Float16)lo, b = (_Float16)hi;
    return (unsigned)__builtin_bit_cast(unsigned short, a) | ((unsigned)__builtin_bit_cast(unsigned short, b) << 16);
}
__device__ __forceinline__ float bf_lo(unsigned w) { return __builtin_bit_cast(float, w << 16); }
__device__ __forceinline__ float bf_hi(unsigned w) { return __builtin_bit_cast(float, w & 0xffff0000u); }
__device__ __forceinline__ float sigmoidf_(float v) { return __builtin_amdgcn_rcpf(1.0f + __builtin_amdgcn_exp2f(-v * LOG2E)); }
__device__ __forceinline__ float gelu_tanh(float v) { const float y = 0.7978845608028654f * (v + 0.044715f * v * v * v); return v * sigmoidf_(2.0f * y); }
__device__ __forceinline__ float wave_sum(float v) {
#pragma unroll
    for (int o = 1; o < 64; o <<= 1) v += __shfl_xor(v, o);
    return v;
}

__device__ __forceinline__ int lane_id() { int l; asm volatile("v_mbcnt_lo_u32_b32 %0, -1, 0\n\tv_mbcnt_hi_u32_b32 %0, -1, %0" : "=v"(l)); return l; }

namespace pg8 {
constexpr int BM = 256, BK = 64, HALF = 128, HTB = HALF * BK * 2, STAGE_BYTES = 8 * HTB, NXCD = 8, WGM = 8;
__host__ __device__ __forceinline__ int lds_byte(int r, int c) { const int st = (r >> 4) * 2 + (c >> 5), rr = r & 15, cc = c & 31, ob = rr * 64 + cc * 2; return st * 1024 + (ob ^ (((ob >> 9) & 1) << 5)); }
__host__ __device__ __forceinline__ void stage_rc(int b, int& R, int& C) { const int st = b / 1024, sb = b % 1024, swz = sb ^ (((sb >> 9) & 1) << 5); R = (st >> 1) * 16 + swz / 64; C = (st & 1) * 32 + (swz % 64) / 2; }
__host__ __device__ __forceinline__ int perm32(int rho) { const int n = rho >> 4, i = rho & 15; return 8 * (i >> 2) + 4 * n + (i & 3); }

struct Unit { int pm, pn, ord; };
struct Gemm { const u16* A; const u16* Bt; int M, N, K; size_t bstride; };

struct StaticOrder {
    int nM, nN, nwg, G, c;
    __host__ __device__ __forceinline__ void init(int M, int N, int G_, int c_) { nM = M / BM; nN = N / BM; nwg = nM * nN; G = G_; c = c_; }
    __host__ __device__ __forceinline__ bool next(int i, Unit& u) const {
        const long L = (long)i * G + c; if (L >= nwg) return false;
        int wgid = (int)L; { const int q = nwg / NXCD, r = nwg % NXCD, xcd = wgid % NXCD, off = wgid / NXCD; wgid = (xcd < r ? xcd * (q + 1) : r * (q + 1) + (xcd - r) * q) + off; }
        const int nig = WGM * nN, gid = wgid / nig, fm = gid * WGM, gsz = (nM - fm) < WGM ? (nM - fm) : WGM;
        u.pm = fm + ((wgid % nig) % gsz); u.pn = (wgid % nig) / gsz; u.ord = i; return true;
    }
    __device__ __forceinline__ void a_ready(const Unit&) const {}
    __device__ __forceinline__ void done(const Unit&) const {}
};

template <bool F16> __device__ __forceinline__ f32x4 mfma16(s16x8 a, s16x8 b, f32x4 c) {
    if constexpr (F16) return __builtin_amdgcn_mfma_f32_16x16x32_f16(__builtin_bit_cast(f16x8, a), __builtin_bit_cast(f16x8, b), c, 0, 0, 0);
    else return __builtin_amdgcn_mfma_f32_16x16x32_bf16(__builtin_bit_cast(bf16x8_t, a), __builtin_bit_cast(bf16x8_t, b), c, 0, 0, 0);
}

template <class Epi, class Sched, bool ALIGN_EPI, bool SP2, bool F16>
__device__ __forceinline__ void gemm_phase(LAS unsigned char* lds, const Gemm g, const Sched& S, const Epi& E, int wave0) {
    int tid_ = wave0 * 64 + lane_id(); asm volatile("" : "+v"(tid_));
    const int tid = tid_, wid = __builtin_amdgcn_readfirstlane(tid >> 6), lane = tid & 63, wr = wid >> 2, wc = wid & 3, fr = lane & 15, fq = lane >> 4;
    const int K = g.K, nt = K / BK;
    unsigned voffA, voffB;
    { int R, C; stage_rc(tid * 16, R, C); const int Rb = Epi::PERM ? ((R & ~31) + perm32(R & 31)) : R;
        const int Ra = Epi::APERM ? ((R & ~63) + 4 * (R & 15) + ((R >> 4) & 3)) : R;
        voffA = (unsigned)(Ra * K + C) * 2u; voffB = (unsigned)(Rb * K + C) * 2u; }
    const unsigned rstep64 = (unsigned)(64 * K * 2);
    const size_t kstep = (size_t)(BK * 2);
    const size_t hstep = (size_t)HALF * K * 2;
    const size_t tstep = 2 * hstep;
    const unsigned ldsw = (unsigned)wid * 1024u;
    const int aoff = lds_byte(wr * 64 + fr, fq * 8), boff = lds_byte(wc * 32 + fr, fq * 8);
#define PG8_SA(b, h) (((b) * 2 + (h)) * HTB)
#define PG8_SB(b, h) ((4 + (b) * 2 + (h)) * HTB)
#define PG8_STAGE(bufoff, gbase, voff) do { _Pragma("unroll") for (int _i = 0; _i < 2; ++_i) \
        __builtin_amdgcn_global_load_lds((const unsigned*)((const char*)(gbase) + _i * rstep64 + (voff)), (LAS unsigned*)(lds + (bufoff) + ldsw + _i * 8192), 16, 0, 0); } while (0)
#define PG8_LDA(dst, b, h) do { _Pragma("unroll") for (int m = 0; m < 4; ++m) _Pragma("unroll") for (int k = 0; k < 2; ++k) dst[m][k] = *(const LAS s16x8*)(lds + PG8_SA(b, h) + aoff + m * 2048 + k * 1024); } while (0)
#define PG8_LDB(dst, b, h) do { _Pragma("unroll") for (int n = 0; n < 2; ++n) _Pragma("unroll") for (int k = 0; k < 2; ++k) dst[n][k] = *(const LAS s16x8*)(lds + PG8_SB(b, h) + boff + n * 2048 + k * 1024); } while (0)
#define PG8_MMA(ai, bj, At, Bt) do { __builtin_amdgcn_s_setprio(1); _Pragma("unroll") for (int m = 0; m < 4; ++m) _Pragma("unroll") for (int n = 0; n < 2; ++n) _Pragma("unroll") for (int k = 0; k < 2; ++k) \
        acc[ai][bj][m][n] = mfma16<F16>(Bt[n][k], At[m][k], acc[ai][bj][m][n]); __builtin_amdgcn_s_setprio(0); } while (0)
#define PG8_WAIT_V(n) asm volatile("s_waitcnt vmcnt(" #n ")" ::: "memory")
#define PG8_WAIT_L(n) asm volatile("s_waitcnt lgkmcnt(" #n ")" ::: "memory")
#define PG8_BAR __builtin_amdgcn_s_barrier()
#define PG8_SCHED __builtin_amdgcn_sched_barrier(0)
    Unit cur, nxt; int ui = 0;
    if (!S.next(0, cur)) return;
    f32x4 acc[2][2][4][2];
#pragma unroll
    for (int a = 0; a < 2; ++a)
#pragma unroll
        for (int b = 0; b < 2; ++b)
#pragma unroll
            for (int m = 0; m < 4; ++m)
#pragma unroll
                for (int n = 0; n < 2; ++n) acc[a][b][m][n] = (f32x4){0.f, 0.f, 0.f, 0.f};
    s16x8 At[4][2], B0[2][2], B1[2][2];
    const char* cA = (const char*)g.A + (size_t)cur.pm * tstep; const char* cB = (const char*)g.Bt + (size_t)cur.pn * tstep + (size_t)(cur.pm >> 5) * g.bstride;
    S.a_ready(cur);
    if constexpr (SP2) {
        PG8_STAGE(PG8_SB(0, 0), cB, voffB); PG8_STAGE(PG8_SB(0, 1), cB + hstep, voffB); PG8_STAGE(PG8_SA(0, 0), cA, voffA); PG8_STAGE(PG8_SA(0, 1), cA + hstep, voffA);
        if (wr == 1) PG8_BAR;
        PG8_WAIT_V(2); PG8_BAR;
        PG8_STAGE(PG8_SB(1, 0), cB + kstep, voffB); PG8_STAGE(PG8_SA(1, 0), cA + kstep, voffA); PG8_STAGE(PG8_SB(1, 1), cB + hstep + kstep, voffB);
        PG8_WAIT_V(6); PG8_BAR;
    } else {
        PG8_STAGE(PG8_SB(0, 0), cB, voffB); PG8_STAGE(PG8_SA(0, 0), cA, voffA); PG8_STAGE(PG8_SB(0, 1), cB + hstep, voffB); PG8_STAGE(PG8_SA(0, 1), cA + hstep, voffA);
        if (wr == 1) PG8_BAR;
        PG8_WAIT_V(4); PG8_BAR;
        PG8_STAGE(PG8_SB(1, 0), cB + kstep, voffB); PG8_STAGE(PG8_SA(1, 0), cA + kstep, voffA); PG8_STAGE(PG8_SB(1, 1), cB + hstep + kstep, voffB);
        PG8_WAIT_V(6); PG8_BAR;
    }
    for (;;) {
        const bool has_next = S.next(ui + 1, nxt);
        const char* nA = has_next ? (const char*)g.A + (size_t)nxt.pm * tstep : cA; const char* nB = has_next ? (const char*)g.Bt + (size_t)nxt.pn * tstep + (size_t)(nxt.pm >> 5) * g.bstride : cB;
        for (int t = 0; t < nt; t += 2) {
            const bool last = (t == nt - 2);
            const char* a1 = cA + (size_t)(t + 1) * kstep;
            const char* a2 = last ? nA : cA + (size_t)(t + 2) * kstep; const char* b2 = last ? nB : cB + (size_t)(t + 2) * kstep;
            const char* a3 = a2 + kstep; const char* b3 = b2 + kstep;
            if (last && has_next) S.a_ready(nxt);
            if constexpr (Epi::MIDK) { if (t == nt / 2) E.midk(acc, cur, wr, fr); }
            if constexpr (SP2) {
            PG8_LDB(B0, 0, 0); PG8_LDB(B1, 0, 1); PG8_SCHED; PG8_LDA(At, 0, 0); PG8_STAGE(PG8_SA(1, 1), a1 + hstep, voffA);
            PG8_WAIT_V(8); PG8_WAIT_L(0); PG8_BAR; PG8_MMA(0, 0, At, B0); PG8_MMA(0, 1, At, B1); PG8_BAR; PG8_SCHED;
            PG8_LDA(At, 0, 1); PG8_STAGE(PG8_SB(0, 0), b2, voffB); PG8_STAGE(PG8_SB(0, 1), b2 + hstep, voffB); PG8_STAGE(PG8_SA(0, 0), a2, voffA);
            PG8_WAIT_V(8); PG8_WAIT_L(0); PG8_BAR; PG8_MMA(1, 0, At, B0); PG8_MMA(1, 1, At, B1); PG8_BAR; PG8_SCHED;
            PG8_LDB(B0, 1, 0); PG8_LDB(B1, 1, 1); PG8_SCHED; PG8_LDA(At, 1, 0); PG8_STAGE(PG8_SA(0, 1), a2 + hstep, voffA);
            PG8_WAIT_V(8); PG8_WAIT_L(0); PG8_BAR; PG8_MMA(0, 0, At, B0); PG8_MMA(0, 1, At, B1); PG8_BAR; PG8_SCHED;
            PG8_LDA(At, 1, 1); PG8_STAGE(PG8_SB(1, 0), b3, voffB); PG8_STAGE(PG8_SB(1, 1), b3 + hstep, voffB); PG8_STAGE(PG8_SA(1, 0), a3, voffA);
            PG8_WAIT_V(8); PG8_WAIT_L(0); PG8_BAR; PG8_MMA(1, 0, At, B0); PG8_MMA(1, 1, At, B1); PG8_BAR; PG8_SCHED;
            } else {
            PG8_LDB(B0, 0, 0); PG8_SCHED; PG8_LDA(At, 0, 0); PG8_STAGE(PG8_SA(1, 1), a1 + hstep, voffA);
            PG8_WAIT_L(8); PG8_BAR; PG8_WAIT_L(0); PG8_MMA(0, 0, At, B0); PG8_BAR; PG8_SCHED;
            PG8_LDB(B1, 0, 1); PG8_STAGE(PG8_SB(0, 0), b2, voffB);
            PG8_BAR; PG8_WAIT_L(0); PG8_MMA(0, 1, At, B1); PG8_BAR;
            PG8_LDA(At, 0, 1); PG8_STAGE(PG8_SA(0, 0), a2, voffA);
            PG8_BAR; PG8_WAIT_L(0); PG8_MMA(1, 0, At, B0); PG8_BAR; PG8_SCHED;
            PG8_STAGE(PG8_SB(0, 1), b2 + hstep, voffB);
            PG8_WAIT_V(6); PG8_BAR; PG8_MMA(1, 1, At, B1); PG8_BAR;
            PG8_LDB(B0, 1, 0); PG8_SCHED; PG8_LDA(At, 1, 0); PG8_STAGE(PG8_SA(0, 1), a2 + hstep, voffA);
            PG8_WAIT_L(8); PG8_BAR; PG8_WAIT_L(0); PG8_MMA(0, 0, At, B0); PG8_BAR; PG8_SCHED;
            PG8_LDB(B1, 1, 1); PG8_STAGE(PG8_SB(1, 0), b3, voffB);
            PG8_BAR; PG8_WAIT_L(0); PG8_MMA(0, 1, At, B1); PG8_BAR;
            PG8_LDA(At, 1, 1); PG8_STAGE(PG8_SA(1, 0), a3, voffA);
            PG8_BAR; PG8_WAIT_L(0); PG8_MMA(1, 0, At, B0); PG8_BAR; PG8_SCHED;
            PG8_STAGE(PG8_SB(1, 1), b3 + hstep, voffB);
            PG8_WAIT_V(6); PG8_BAR; PG8_MMA(1, 1, At, B1); PG8_BAR;
            }
        }
        if constexpr (ALIGN_EPI) { if (wr == 0) PG8_BAR; }
        E(acc, cur, wr, wc, fr, fq); S.done(cur);
        if (!has_next) break;
#pragma unroll
        for (int a = 0; a < 2; ++a)
#pragma unroll
            for (int b = 0; b < 2; ++b)
#pragma unroll
                for (int m = 0; m < 4; ++m)
#pragma unroll
                    for (int n = 0; n < 2; ++n) acc[a][b][m][n] = (f32x4){0.f, 0.f, 0.f, 0.f};
        cur = nxt; cA = nA; cB = nB; ++ui;
        if constexpr (ALIGN_EPI) { if (wr == 1) PG8_BAR; }
    }
    PG8_WAIT_V(0);
    if constexpr (!ALIGN_EPI) { if (wr == 0) PG8_BAR; }
    PG8_BAR;
#undef PG8_SA
#undef PG8_SB
#undef PG8_STAGE
#undef PG8_LDA
#undef PG8_LDB
#undef PG8_MMA
#undef PG8_WAIT_V
#undef PG8_WAIT_L
#undef PG8_BAR
#undef PG8_SCHED
}

struct EpiBf16 {
    static constexpr bool PERM = true, MIDK = false, APERM = false;
    u16* O; int ldc;
    __device__ __forceinline__ void operator()(const f32x4 (&acc)[2][2][4][2], const Unit& u, int wr, int wc, int fr, int fq) const {
        const int row0 = u.pm * BM + wr * 64 + fr; const int col0 = u.pn * BM + wc * 32 + 8 * fq;
#pragma unroll
        for (int ai = 0; ai < 2; ++ai)
#pragma unroll
            for (int m = 0; m < 4; ++m) { u16* rowp = O + (size_t)(row0 + ai * HALF + m * 16) * ldc + col0;
#pragma unroll
                for (int bj = 0; bj < 2; ++bj) { const f32x4 v0 = acc[ai][bj][m][0], v1 = acc[ai][bj][m][1];
                    u32x4 w; w.x = cvt_pk_bf16(v0[0], v0[1]); w.y = cvt_pk_bf16(v0[2], v0[3]); w.z = cvt_pk_bf16(v1[0], v1[1]); w.w = cvt_pk_bf16(v1[2], v1[3]);
                    *(u32x4*)(rowp + bj * HALF) = w; } }
    }
};
struct EpiResid {
    static constexpr bool PERM = false, MIDK = false, APERM = false;
    const float* base; float* out; const float* gate;
    __device__ __forceinline__ void operator()(const f32x4 (&acc)[2][2][4][2], const Unit& u, int wr, int wc, int fr, int fq) const {
        const int row0 = u.pm * BM + wr * 64 + fr, col0 = u.pn * BM + wc * 32 + 4 * fq;
        const int b = (u.pm * BM) / SEQ;
        f32x4 gv[2][2];
#pragma unroll
        for (int bj = 0; bj < 2; ++bj)
#pragma unroll
            for (int n = 0; n < 2; ++n) gv[bj][n] = *(const f32x4*)(gate + (size_t)b * N_MOD + col0 + bj * HALF + n * 16);
#pragma unroll
        for (int ai = 0; ai < 2; ++ai)
#pragma unroll
            for (int m = 0; m < 4; ++m) { const size_t off = (size_t)(row0 + ai * HALF + m * 16) * D_MODEL + col0;
#pragma unroll
                for (int bj = 0; bj < 2; ++bj)
#pragma unroll
                    for (int n = 0; n < 2; ++n) { const f32x4 bs = *(const f32x4*)(base + off + bj * HALF + n * 16);
                        *(f32x4*)(out + off + bj * HALF + n * 16) = bs + gv[bj][n] * acc[ai][bj][m][n]; } }
    }
};
struct EpiInProj {
    static constexpr bool PERM = true, MIDK = false, APERM = false;
    float* QF; u16* KB; u16* VT; u16* XR; u16* GG; float* KM; const float* gq; const float* gk;
    __device__ __forceinline__ void operator()(const f32x4 (&acc)[2][2][4][2], const Unit& u, int wr, int wc, int fr, int fq) const {
        const int type = u.pn >> 1, head = (u.pn & 1) * 4 + wc;
        const int b = (u.pm * BM) / SEQ, blk = u.pm % NBLK;
        const int tok0 = u.pm * BM + wr * 64 + fr;
        const int bh = b * NHEAD + head;
        if (type <= 1) {
            const float* gp = type == 0 ? gq : gk;
            f32x4 gv[2][2];
#pragma unroll
            for (int bj = 0; bj < 2; ++bj)
#pragma unroll
                for (int n = 0; n < 2; ++n) gv[bj][n] = *(const f32x4*)(gp + 32 * bj + 8 * fq + 4 * n);
            f32x4 cs[2][2];
#pragma unroll
            for (int bj = 0; bj < 2; ++bj)
#pragma unroll
                for (int n = 0; n < 2; ++n) cs[bj][n] = (f32x4){0.f, 0.f, 0.f, 0.f};
#pragma unroll
            for (int ai = 0; ai < 2; ++ai)
#pragma unroll
                for (int m = 0; m < 4; ++m) {
                    float ss = 0.f;
#pragma unroll
                    for (int bj = 0; bj < 2; ++bj)
#pragma unroll
                        for (int n = 0; n < 2; ++n) { const f32x4 x = acc[ai][bj][m][n]; ss += (x[0] * x[0] + x[1] * x[1]) + (x[2] * x[2] + x[3] * x[3]); }
                    ss += __shfl_xor(ss, 16); ss += __shfl_xor(ss, 32);
                    const float rstd = 1.0f / sqrtf(ss * (1.0f / 64.0f) + EPS);
                    const int tok = tok0 + ai * HALF + m * 16, s = tok % SEQ;
                    const size_t rowoff = ((size_t)bh * SEQ + s) * HD + 8 * fq;
#pragma unroll
                    for (int bj = 0; bj < 2; ++bj) {
                        const f32x4 v0 = acc[ai][bj][m][0] * rstd * gv[bj][0], v1 = acc[ai][bj][m][1] * rstd * gv[bj][1];
                        if (type == 0) { *(f32x4*)(QF + rowoff + 32 * bj) = v0; *(f32x4*)(QF + rowoff + 32 * bj + 4) = v1; }
                        else { u32x4 w; w.x = cvt_pk_bf16(v0[0], v0[1]); w.y = cvt_pk_bf16(v0[2], v0[3]); w.z = cvt_pk_bf16(v1[0], v1[1]); w.w = cvt_pk_bf16(v1[2], v1[3]);
                            const int kw = s & 255, c8 = 4 * bj + fq;
                            *(u32x4*)(KB + ((size_t)bh * NBLK + blk) * (BLK * HD) + ((((kw >> 5) * 4 + (c8 >> 1)) * 2 + (c8 & 1)) * 32 + (kw & 31)) * 8) = w; cs[bj][0] += v0; cs[bj][1] += v1; }
                    }
                }
            if (type == 1) {
#pragma unroll
                for (int bj = 0; bj < 2; ++bj)
#pragma unroll
                    for (int n = 0; n < 2; ++n)
#pragma unroll
                        for (int i = 0; i < 4; ++i) { float v = cs[bj][n][i]; v += __shfl_xor(v, 1); v += __shfl_xor(v, 2); v += __shfl_xor(v, 4); v += __shfl_xor(v, 8);
                            if (fr == 0) atomicAdd(KM + (((size_t)(b * NBLK + blk) * NHEAD + head) * HD + 32 * bj + 8 * fq + 4 * n + i), v); }
            }
        } else if (type == 2) {
            const int hip = (fr >> 2) & 1, ep = 4 * (fr >> 3) + (fr & 3);
#pragma unroll
            for (int ai = 0; ai < 2; ++ai)
#pragma unroll
                for (int m = 0; m < 4; ++m) { const int kw = ai * HALF + wr * 64 + m * 16 + fr;
#pragma unroll
                    for (int bj = 0; bj < 2; ++bj)
#pragma unroll
                        for (int n = 0; n < 2; ++n) { const f32x4 x = acc[ai][bj][m][n]; const unsigned w0 = cvt_pk_bf16(x[0], x[1]), w1 = cvt_pk_bf16(x[2], x[3]);
                            u16* dst = VT + ((size_t)bh * NBLK + blk) * (BLK * HD) + (((((kw >> 5) * 2 + ((kw >> 4) & 1)) * 2 + bj) * 2 + hip) * 32 + 8 * fq + 4 * n) * 8 + ep;
                            dst[0] = (u16)(w0 & 0xffffu); dst[8] = (u16)(w0 >> 16); dst[16] = (u16)(w1 & 0xffffu); dst[24] = (u16)(w1 >> 16); } }
        } else {
            u16* O = type == 3 ? XR : GG;
#pragma unroll
            for (int ai = 0; ai < 2; ++ai)
#pragma unroll
                for (int m = 0; m < 4; ++m) { const int tok = tok0 + ai * HALF + m * 16, sq = tok % SEQ;
                    u16* tilep = O + ((((size_t)b * (SEQ / 32) + (sq >> 5)) * NHEAD + head) * 2048) + (sq & 31) * 8;
#pragma unroll
                    for (int bj = 0; bj < 2; ++bj) { f32x4 v0 = acc[ai][bj][m][0], v1 = acc[ai][bj][m][1];
                        if (type == 4) {
#pragma unroll
                            for (int i = 0; i < 4; ++i) { v0[i] = gelu_tanh(v0[i]); v1[i] = gelu_tanh(v1[i]); } }
                        u32x4 w; w.x = cvt_pk_bf16(v0[0], v0[1]); w.y = cvt_pk_bf16(v0[2], v0[3]); w.z = cvt_pk_bf16(v1[0], v1[1]); w.w = cvt_pk_bf16(v1[2], v1[3]);
                        *(u32x4*)(tilep + (4 * bj + fq) * 256) = w; } }
        }
    }
};

__device__ __forceinline__ float dpp_f(float old, float x, int ctrl) {
    return 0.f; }
#define DPPF(old, x, ctrl) __builtin_bit_cast(float, __builtin_amdgcn_update_dpp(__builtin_bit_cast(int, (float)(old)), __builtin_bit_cast(int, (float)(x)), (ctrl), 0xf, 0xf, false))
struct EpiFFN {
    static constexpr bool PERM = true, MIDK = false, APERM = true;
    u16* ACT; float* RAW; const float* cw; const float* CB2; LAS float* XB; const float* SSQX; const float* BIAS2; const LAS float* R2ALL; LAS float* CT;
    __device__ __forceinline__ void operator()(const f32x4 (&acc)[2][2][4][2], const Unit& u, int wr, int wc, int fr_, int fq_) const {
        int fr = fr_, fq = fq_; asm volatile("" : "+v"(fr), "+v"(fq));
        const int f0 = u.pn * 128 + wc * 32 + 8 * fq;
        const int b = (u.pm * BM) / SEQ;
        const LAS float* R2S = R2ALL + u.ord * 256;
        { const int t = (wr * 4 + wc) * 64 + fq * 16 + fr;
          if (t < 256) { const int q = t >> 5, c4 = t & 31; const int f = u.pn * 128 + 4 * c4;
              const float* src = ((q & 3) == 3) ? (CB2 + (size_t)b * N_UP + (q >> 2) * D_FF + f) : (cw + (size_t)(q & 3) * N_UP + (q >> 2) * D_FF + f);
              const f32x4 v = *(const f32x4*)src; *(LAS f32x4*)(CT + q * 128 + 4 * c4) = v; } }
#define BBP(kc, bj, n) (*(const f32x4*)(BIAS2 + ((size_t)(kc) * BATCH + b) * N_UP + (bj) * D_FF + f0 + 4 * (n)))
#define BBV(bj, n) ((BBP(0, bj, n) + BBP(1, bj, n)) + (BBP(2, bj, n) + BBP(3, bj, n)))
        const f32x4 r2a = *(const LAS f32x4*)(R2S + wr * 64 + 4 * fr), r2b = *(const LAS f32x4*)(R2S + HALF + wr * 64 + 4 * fr);
        if (fr == 15) {
#pragma unroll
            for (int ai = 0; ai < 2; ++ai)
#pragma unroll
                for (int rr = 0; rr < 2; ++rr)
#pragma unroll
                    for (int bj = 0; bj < 2; ++bj)
#pragma unroll
                        for (int n = 0; n < 2; ++n) *(LAS f32x4*)(XB + (((((ai * 2 + wr) * 4 + wc) * 2 + rr) * 4 + fq) * 16 + (bj * 2 + n) * 4)) = acc[ai][bj][2 + rr][n] * (ai ? r2b[2 + rr] : r2a[2 + rr]);
        }
        if (wr == 1 && fr == 15) {
#pragma unroll
            for (int rr = 0; rr < 2; ++rr)
#pragma unroll
                for (int bj = 0; bj < 2; ++bj)
#pragma unroll
                    for (int n = 0; n < 2; ++n) *(f32x4*)(RAW + ((size_t)u.pm * 4 + 2 + rr) * N_UP + bj * D_FF + f0 + 4 * n) = acc[1][bj][2 + rr][n] * r2b[2 + rr] + BBV(bj, n);
        }
        if (wr == 0 && fr == 0) {
#pragma unroll
            for (int rr = 0; rr < 2; ++rr)
#pragma unroll
                for (int bj = 0; bj < 2; ++bj)
#pragma unroll
                    for (int n = 0; n < 2; ++n) *(f32x4*)(RAW + ((size_t)u.pm * 4 + rr) * N_UP + bj * D_FF + f0 + 4 * n) = acc[0][bj][rr][n] * r2a[rr] + BBV(bj, n);
        }
        asm volatile("s_waitcnt vmcnt(0) lgkmcnt(0)" ::: "memory"); __builtin_amdgcn_s_barrier(); asm volatile("" ::: "memory");
#pragma unroll
        for (int n = 0; n < 2; ++n) {
            const int cl = wc * 32 + 8 * fq + 4 * n;
            const f32x4 wg0 = *(const LAS f32x4*)(CT + 0 * 128 + cl), wg1 = *(const LAS f32x4*)(CT + 1 * 128 + cl), wg2 = *(const LAS f32x4*)(CT + 2 * 128 + cl);
            const f32x4 wv0 = *(const LAS f32x4*)(CT + 4 * 128 + cl), wv1 = *(const LAS f32x4*)(CT + 5 * 128 + cl), wv2 = *(const LAS f32x4*)(CT + 6 * 128 + cl);
            const f32x4 bg = *(const LAS f32x4*)(CT + 3 * 128 + cl), bv = *(const LAS f32x4*)(CT + 7 * 128 + cl);
#pragma unroll
            for (int ai = 0; ai < 2; ++ai) {
                const f32x4 r2v = ai ? r2b : r2a;
                const bool hasprev = (wr == 1) || (ai == 1);
                const int src = (wr == 1) ? (ai * 2 + 0) : ((ai - 1) * 2 + 1);
                f32x4 t1g = (f32x4){0.f, 0.f, 0.f, 0.f}, t2g = t1g, t1v = t1g, t2v = t1g;
                if (hasprev) {
                    const LAS float* xb1 = XB + ((((src * 4 + wc) * 2 + 1) * 4 + fq) * 16), * xb2 = XB + ((((src * 4 + wc) * 2 + 0) * 4 + fq) * 16);
                    t1g = *(const LAS f32x4*)(xb1 + (0 * 2 + n) * 4); t1v = *(const LAS f32x4*)(xb1 + (1 * 2 + n) * 4);
                    t2g = *(const LAS f32x4*)(xb2 + (0 * 2 + n) * 4); t2v = *(const LAS f32x4*)(xb2 + (1 * 2 + n) * 4);
                }
                f32x4 xg[4], xv[4];
#pragma unroll
                for (int m = 0; m < 4; ++m) { xg[m] = acc[ai][0][m][n] * r2v[m]; xv[m] = acc[ai][1][m][n] * r2v[m]; }
                f32x4 pg3, pg2, pv3, pv2;
#pragma unroll
                for (int i = 0; i < 4; ++i) { pg3[i] = DPPF(t1g[i], xg[3][i], 0x111); pg2[i] = DPPF(t2g[i], xg[2][i], 0x111); pv3[i] = DPPF(t1v[i], xv[3][i], 0x111); pv2[i] = DPPF(t2v[i], xv[2][i], 0x111); }
#pragma unroll
                for (int m = 0; m < 4; ++m) {
                    const f32x4 g1 = m == 0 ? pg3 : xg[m > 0 ? m - 1 : 0], g2 = m == 0 ? pg2 : (m == 1 ? pg3 : xg[m > 1 ? m - 2 : 0]);
                    const f32x4 v1 = m == 0 ? pv3 : xv[m > 0 ? m - 1 : 0], v2 = m == 0 ? pv2 : (m == 1 ? pv3 : xv[m > 1 ? m - 2 : 0]);
                    float o[4];
#pragma unroll
                    for (int i = 0; i < 4; ++i) {
                        const float cg = ((wg0[i] * g2[i] + wg1[i] * g1[i]) + wg2[i] * xg[m][i]) + bg[i];
                        const float cv = ((wv0[i] * v2[i] + wv1[i] * v1[i]) + wv2[i] * xv[m][i]) + bv[i];
                        o[i] = cg * sigmoidf_(cg) * cv;
                    }
                    if (!(ai == 0 && wr == 0 && fr == 0 && m < 2)) { u32x2 w; w.x = cvt_pk_bf16(o[0], o[1]); w.y = cvt_pk_bf16(o[2], o[3]);
                        *(u32x2*)(ACT + (size_t)(u.pm * BM + ai * HALF + wr * 64 + 4 * fr + m) * D_FF + f0 + 4 * n) = w; }
                }
                __builtin_amdgcn_sched_barrier(0);
            }
        }
    }
};

struct EpiOut {
    static constexpr bool PERM = true, MIDK = true, APERM = false;
    const float* base; u16* X1B; float* SSQX; const float* gate; const LAS f32x2* RT;
    __device__ __forceinline__ void rstd(const Unit& u, int rit, float& ratio, float& ra) const { const f32x2 v = RT[u.ord * 256 + rit]; ratio = v.x; ra = v.y; }
    __device__ __forceinline__ void midk(f32x4 (&acc)[2][2][4][2], const Unit& u, int wr, int fr) const {
#pragma unroll
        for (int ai = 0; ai < 2; ++ai)
#pragma unroll
            for (int m = 0; m < 4; ++m) { float ratio, ra; rstd(u, ai * HALF + wr * 64 + m * 16 + fr, ratio, ra);
#pragma unroll
                for (int bj = 0; bj < 2; ++bj)
#pragma unroll
                    for (int n = 0; n < 2; ++n) acc[ai][bj][m][n] *= ratio; }
    }
    __device__ __forceinline__ void operator()(const f32x4 (&acc)[2][2][4][2], const Unit& u, int wr, int wc, int fr, int fq) const {
        const int row0 = u.pm * BM + wr * 64 + fr, col0 = u.pn * BM + wc * 32 + 8 * fq;
        const int b = (u.pm * BM) / SEQ;
        f32x4 gv[2][2];
#pragma unroll
        for (int bj = 0; bj < 2; ++bj)
#pragma unroll
            for (int n = 0; n < 2; ++n) gv[bj][n] = *(const f32x4*)(gate + (size_t)b * N_MOD + col0 + bj * HALF + n * 4);
#pragma unroll
        for (int ai = 0; ai < 2; ++ai)
#pragma unroll
            for (int m = 0; m < 4; ++m) { const int row = row0 + ai * HALF + m * 16; const size_t off = (size_t)row * D_MODEL + col0;
                float rl, ra; rstd(u, wr * 64 + fr + ai * HALF + m * 16, rl, ra);
                float ss = 0.f;
#pragma unroll
                for (int bj = 0; bj < 2; ++bj) {
                    const f32x4 x0 = *(const f32x4*)(base + off + bj * HALF) + gv[bj][0] * (acc[ai][bj][m][0] * ra);
                    const f32x4 x1 = *(const f32x4*)(base + off + bj * HALF + 4) + gv[bj][1] * (acc[ai][bj][m][1] * ra);
                    ss += ((x0[0] * x0[0] + x0[1] * x0[1]) + (x0[2] * x0[2] + x0[3] * x0[3])) + ((x1[0] * x1[0] + x1[1] * x1[1]) + (x1[2] * x1[2] + x1[3] * x1[3]));
                    u32x4 w; w.x = cvt_pk_bf16(x0[0], x0[1]); w.y = cvt_pk_bf16(x0[2], x0[3]); w.z = cvt_pk_bf16(x1[0], x1[1]); w.w = cvt_pk_bf16(x1[2], x1[3]);
                    *(u32x4*)(X1B + off + bj * HALF) = w; }
                ss += __shfl_xor(ss, 16); ss += __shfl_xor(ss, 32);
                if (fq == 0) SSQX[(size_t)row * 16 + u.pn * 4 + wc] = ss; }
    }
};

struct EpiResidB {
    static constexpr bool PERM = false, MIDK = false, APERM = false;
    const u16* base; float* out; const float* gate;
    __device__ __forceinline__ void operator()(const f32x4 (&acc)[2][2][4][2], const Unit& u, int wr, int wc, int fr, int fq) const {
        const int row0 = u.pm * BM + wr * 64 + fr, col0 = u.pn * BM + wc * 32 + 4 * fq;
        const int b = (u.pm * BM) / SEQ;
        f32x4 gv[2][2];
#pragma unroll
        for (int bj = 0; bj < 2; ++bj)
#pragma unroll
            for (int n = 0; n < 2; ++n) gv[bj][n] = *(const f32x4*)(gate + (size_t)b * N_MOD + col0 + bj * HALF + n * 16);
#pragma unroll
        for (int ai = 0; ai < 2; ++ai)
#pragma unroll
            for (int m = 0; m < 4; ++m) { const size_t off = (size_t)(row0 + ai * HALF + m * 16) * D_MODEL + col0;
#pragma unroll
                for (int bj = 0; bj < 2; ++bj)
#pragma unroll
                    for (int n = 0; n < 2; ++n) { const u32x2 xw = *(const u32x2*)(base + off + bj * HALF + n * 16);
                        const f32x4 bs = (f32x4){bf_lo(xw.x), bf_hi(xw.x), bf_lo(xw.y), bf_hi(xw.y)};
                        *(f32x4*)(out + off + bj * HALF + n * 16) = bs + gv[bj][n] * acc[ai][bj][m][n]; } }
    }
};
}
#ifndef ATT_DUP
#define ATT_DUP 0
#endif

constexpr size_t MiB = 1u << 20;
constexpr size_t WS_CTL = 0;
constexpr size_t WS_KM = 1 * MiB;
constexpr size_t CTL_ZERO_BYTES = 2 * MiB;
constexpr size_t WS_MOD = 2 * MiB;
constexpr size_t WS_WIN = 3 * MiB;
constexpr size_t WS_WO = 8 * MiB;
constexpr size_t WS_WUP = 10 * MiB;
constexpr size_t WS_WDN = 21 * MiB;
constexpr size_t WS_WA = 27 * MiB;
constexpr size_t WS_WX = 27 * MiB + 65536;
constexpr size_t WS_AGG = 28 * MiB;
constexpr size_t WS_SSQL = 29 * MiB;
constexpr size_t WS_SSQA = 30 * MiB;
constexpr size_t WS_H = 34 * MiB;
constexpr size_t WS_QF = 98 * MiB;
constexpr size_t WS_KB = 162 * MiB;
constexpr size_t WS_VT = 194 * MiB;
constexpr size_t WS_XR = 226 * MiB;
constexpr size_t WS_GG = 258 * MiB;
constexpr size_t WS_ATT = 288 * MiB;
constexpr size_t WS_LRU = 320 * MiB;
constexpr size_t WS_MIX = 352 * MiB;
constexpr size_t WS_RAW = 98 * MiB;
constexpr size_t WS_ACT = 272 * MiB;
constexpr size_t WS_WUP4 = 448 * MiB;
constexpr size_t WS_BIAS2 = 27 * MiB + 262144;
constexpr size_t WS_CB2 = 27 * MiB + 786432;
constexpr size_t WS_SSQX = 31 * MiB;
constexpr size_t WS_END = 492 * MiB;
constexpr int CW_BAR = 4096;

constexpr int RING_BYTES = 131072;
constexpr int MISC_OFF = 160 * 1024 - 256;
constexpr int XB_OFF = RING_BYTES;
constexpr int CLDS_OFF = RING_BYTES + 4096;
constexpr int LDS_BYTES = 160 * 1024;
constexpr int NT = 512, NWAVES = 8;

#define XB_TMO      128
#define XB_XCNT(j)  (256  + 64 * (j))
#define XB_XSUB(j)  (1280 + 64 * (j))
#define XB_XGEN(j)  (2304 + 64 * (j))
#define XB_TOP      3328
#define XB_TOPGEN   3392
#define XCD_BAR_WORDS 3456
#define XB_SPIN_CAP (1u << 18)
__device__ __forceinline__ unsigned xb_ld(unsigned* p)              { return __hip_atomic_load(p, __ATOMIC_RELAXED, __HIP_MEMORY_SCOPE_AGENT); }
__device__ __forceinline__ unsigned xb_add(unsigned* p, unsigned v) { return __hip_atomic_fetch_add(p, v, __ATOMIC_RELAXED, __HIP_MEMORY_SCOPE_AGENT); }
__device__ __forceinline__ unsigned xb_xcc_id() { return (unsigned)__builtin_amdgcn_s_getreg((3 << 11) | 20) & 0xFu; }
#define XB_SPIN(cond, bar) do { unsigned _sp = 0; while (cond) { __builtin_amdgcn_s_sleep(1); \
    if ((++_sp & 255u) == 0u) { if (xb_ld(&(bar)[XB_TMO])) break; if (_sp > XB_SPIN_CAP) { atomicAdd(&(bar)[XB_TMO], 1u); break; } } } } while (0)
struct XcdBarrier { unsigned* bar; unsigned x; volatile LAS unsigned* st; };
__device__ __forceinline__ XcdBarrier xcd_barrier_post(unsigned* bar, volatile LAS unsigned* st) {
    XcdBarrier b; b.bar = bar; b.x = xb_xcc_id(); b.st = st;
    if (threadIdx.x == 0) (void)xb_add(&bar[XB_XCNT(b.x)], 1u);
    return b;
}
__device__ __forceinline__ void xcd_barrier_complete(unsigned* bar, unsigned x, unsigned& nloc, unsigned& nx) {
    const unsigned G = gridDim.x * gridDim.y * gridDim.z;
    unsigned sum, cnt, mine, sp = 0u;
    for (;;) {
        sum = 0u; cnt = 0u; mine = 0u;
#pragma unroll
        for (unsigned j = 0; j < 16; ++j) { const unsigned c = xb_ld(&bar[XB_XCNT(j)]); sum += c; cnt += (c > 0u) ? 1u : 0u; mine = (j == x) ? c : mine; }
        if (sum == G) break;
        __builtin_amdgcn_s_sleep(1);
        if ((++sp & 255u) == 0u) { if (xb_ld(&bar[XB_TMO])) break; if (sp > XB_SPIN_CAP) { atomicAdd(&bar[XB_TMO], 1u); break; } }
    }
    nloc = mine > 0u ? mine : 1u; nx = cnt > 0u ? cnt : 1u;
}
__device__ __forceinline__ void xcd_barrier(const XcdBarrier& b, int tid) {
    asm volatile("s_waitcnt vmcnt(0)" ::: "memory");
    __syncthreads();
    if (tid == 0) {
        unsigned* bar = b.bar;
        __builtin_amdgcn_s_waitcnt(0);
        unsigned nloc = b.st[0], nx = b.st[1];
        if (nloc == 0u) { xcd_barrier_complete(bar, b.x, nloc, nx); b.st[0] = nloc; b.st[1] = nx; }
        const unsigned old = xb_add(&bar[XB_XSUB(b.x)], 1u);
        const unsigned gen = old / nloc;
        if (old + 1u == (gen + 1u) * nloc) {
            __builtin_amdgcn_fence(__ATOMIC_RELEASE, "agent");
            asm volatile("s_waitcnt vmcnt(0)" ::: "memory");
            const unsigned og = xb_add(&bar[XB_TOP], 1u);
            const unsigned tg = og / nx;
            if (og + 1u == (tg + 1u) * nx) xb_add(&bar[XB_TOPGEN], 1u);
            else XB_SPIN(xb_ld(&bar[XB_TOPGEN]) == tg, bar);
            __builtin_amdgcn_fence(__ATOMIC_ACQUIRE, "agent");
            xb_add(&bar[XB_XGEN(b.x)], 1u);
            asm volatile("s_waitcnt vmcnt(0)" ::: "memory");
        } else {
            XB_SPIN(xb_ld(&bar[XB_XGEN(b.x)]) == gen, bar);
            __builtin_amdgcn_fence(__ATOMIC_ACQUIRE, "agent");
            asm volatile("s_waitcnt vmcnt(0)" ::: "memory");
        }
    }
    __syncthreads();
}

struct Args { const float* in[23]; float* out; unsigned char* ws; int ph_lo, ph_hi; };
struct Frame {
    LAS unsigned char* lds;
    int tid, lane, wave, vcu, G, wave0;
    const Args* pa;
    __device__ __forceinline__ const float* x() const { return pa->in[0]; }
    __device__ __forceinline__ const float* c() const { return pa->in[1]; }
    __device__ __forceinline__ const float* w_ada() const { return pa->in[2]; }
    __device__ __forceinline__ const float* b_ada() const { return pa->in[3]; }
    __device__ __forceinline__ const float* norm1_g() const { return pa->in[4]; }
    __device__ __forceinline__ const float* w_in() const { return pa->in[5]; }
    __device__ __forceinline__ const float* q_norm_g() const { return pa->in[6]; }
    __device__ __forceinline__ const float* k_norm_g() const { return pa->in[7]; }
    __device__ __forceinline__ const float* lru_conv_w() const { return pa->in[8]; }
    __device__ __forceinline__ const float* lru_conv_b() const { return pa->in[9]; }
    __device__ __forceinline__ const float* lru_wa() const { return pa->in[10]; }
    __device__ __forceinline__ const float* lru_ba() const { return pa->in[11]; }
    __device__ __forceinline__ const float* lru_wx() const { return pa->in[12]; }
    __device__ __forceinline__ const float* lru_bx() const { return pa->in[13]; }
    __device__ __forceinline__ const float* lru_lambda() const { return pa->in[14]; }
    __device__ __forceinline__ const float* lru_out_g() const { return pa->in[15]; }
    __device__ __forceinline__ const float* attn_out_g() const { return pa->in[16]; }
    __device__ __forceinline__ const float* w_out() const { return pa->in[17]; }
    __device__ __forceinline__ const float* norm2_g() const { return pa->in[18]; }
    __device__ __forceinline__ const float* w_up() const { return pa->in[19]; }
    __device__ __forceinline__ const float* ffn_conv_w() const { return pa->in[20]; }
    __device__ __forceinline__ const float* ffn_conv_b() const { return pa->in[21]; }
    __device__ __forceinline__ const float* w_down() const { return pa->in[22]; }
    float* out; unsigned char* ws;
};
#define LDS_WAIT() asm volatile("s_waitcnt lgkmcnt(0)" ::: "memory")

template <int MODE>
__device__ __forceinline__ void p0_transpose_item(const float* W, int K, int N, u16* WT, LAS float* scr, int item, int lane, const float* kscale = nullptr) {
    const int nblk = N / 32, kb = item / nblk, nb = item % nblk, k0 = 64 * kb, n0 = 32 * nb;
#pragma unroll
    for (int i = 0; i < 8; ++i) { const int f = i * 64 + lane, kk = f >> 3, n4 = f & 7;
        f32x4 w = *(const GAS f32x4*)(W + (size_t)(k0 + kk) * N + n0 + 4 * n4); if (MODE == 3) w *= kscale[k0 + kk];
        LAS float* d = scr + kk * 33 + 4 * n4; d[0] = w.x; d[1] = w.y; d[2] = w.z; d[3] = w.w; }
    LDS_WAIT(); asm volatile("" ::: "memory");
    const int c = lane & 7;
#pragma unroll
    for (int j = 0; j < 4; ++j) { const int n = (lane >> 3) + 8 * j; const LAS float* s = scr + (8 * c) * 33 + n;
        u32x4 o;
        if (MODE == 1) { o.x = cvt_pk_f16(s[0 * 33], s[1 * 33]); o.y = cvt_pk_f16(s[2 * 33], s[3 * 33]); o.z = cvt_pk_f16(s[4 * 33], s[5 * 33]); o.w = cvt_pk_f16(s[6 * 33], s[7 * 33]); }
        else { o.x = cvt_pk_bf16(s[0 * 33], s[1 * 33]); o.y = cvt_pk_bf16(s[2 * 33], s[3 * 33]); o.z = cvt_pk_bf16(s[4 * 33], s[5 * 33]); o.w = cvt_pk_bf16(s[6 * 33], s[7 * 33]); }
        int nn = n0 + n;
        if (MODE == 1) nn = (nn & ~255) + 128 * ((nn >> 5) & 1) + 32 * ((nn >> 6) & 3) + (nn & 31);
        if (MODE == 2) { const int bj = nn >= D_FF ? 1 : 0, f = nn - bj * D_FF; nn = 256 * (f >> 7) + 128 * bj + (f & 127); }
        if (MODE == 4) *(GAS u32x4*)(WT + (((nn >> 5) * 4 + (c >> 1)) * 512 + ((c & 1) * 32 + (nn & 31)) * 8)) = o;
        else *(GAS u32x4*)(WT + (size_t)nn * K + k0 + 8 * c) = o; }
    LDS_WAIT(); asm volatile("" ::: "memory");
}
__device__ __forceinline__ void p0_prologue(Frame& F) {
    unsigned char* wsp = F.ws; asm volatile("" : "+s"(wsp));
    LAS float* cl = (LAS float*)(F.lds + CLDS_OFF);
    for (int i = F.tid; i < BATCH * D_MODEL; i += NT) cl[i] = F.c()[i];
    __syncthreads();
    LAS float* scr = (LAS float*)(F.lds + F.wave * 16384);
    constexpr int I_MOD = N_MOD / 64;
    constexpr int I_IN = (D_MODEL / 64) * (N_IN / 32), I_O = (D_MODEL / 64) * (D_MODEL / 32), I_DN = (D_FF / 64) * (D_MODEL / 32), I_L = 8 * 2;
    constexpr int NITEMS = I_IN + I_O + I_DN + 2 * I_L;
    u16* WinT = (u16*)(wsp + WS_WIN); u16* WoT = (u16*)(wsp + WS_WO); u16* WdT = (u16*)(wsp + WS_WDN);
    u16* WaT = (u16*)(wsp + WS_WA); u16* WxT = (u16*)(wsp + WS_WX);
    float* MOD = (float*)(wsp + WS_MOD);
    if (F.vcu < I_MOD) {
        const int col = F.vcu * 64 + F.lane; float a0 = 0.f, a1 = 0.f, a2 = 0.f, a3 = 0.f;
        const float* wp = F.w_ada() + (size_t)(F.wave * 128) * N_MOD + col; const LAS float* cw = cl + F.wave * 128;
#pragma unroll 64
        for (int k = 0; k < 128; ++k) { const float w = wp[(size_t)k * N_MOD];
            a0 += cw[k] * w; a1 += cw[D_MODEL + k] * w; a2 += cw[2 * D_MODEL + k] * w; a3 += cw[3 * D_MODEL + k] * w; }
        LAS float* part = (LAS float*)(F.lds + CLDS_OFF + 16384);
        part[(F.wave * 4 + 0) * 64 + F.lane] = a0; part[(F.wave * 4 + 1) * 64 + F.lane] = a1; part[(F.wave * 4 + 2) * 64 + F.lane] = a2; part[(F.wave * 4 + 3) * 64 + F.lane] = a3;
        __syncthreads();
        if (F.tid < 256) { const int bb = F.tid >> 6, l = F.tid & 63; float s = F.b_ada()[F.vcu * 64 + l];
#pragma unroll
            for (int w = 0; w < 8; ++w) s += part[(w * 4 + bb) * 64 + l];
            MOD[(size_t)bb * N_MOD + F.vcu * 64 + l] = s; }
    }
    const int gw = F.wave * F.G + ((F.vcu + F.G - I_MOD) % F.G), NGW = F.G * NWAVES;
    for (int it = gw; it < NITEMS; it += NGW) {
        int r = it;
        if (r < I_IN) { p0_transpose_item<1>(F.w_in(), D_MODEL, N_IN, WinT, scr, r, F.lane); continue; } r -= I_IN;
        if (r < I_O) { const int kb = r / (D_MODEL / 32); p0_transpose_item<3>(F.w_out(), D_MODEL, D_MODEL, WoT, scr, r, F.lane, (kb < 8 ? F.lru_out_g() : F.attn_out_g() - AW)); continue; } r -= I_O;

        if (r < I_DN) { p0_transpose_item<0>(F.w_down(), D_FF, D_MODEL, WdT, scr, r, F.lane); continue; } r -= I_DN;
        if (r < I_L) { const int h = r >> 1; p0_transpose_item<4>(F.lru_wa() + h * 4096, 64, 64, WaT + h * 4096, scr, r & 1, F.lane); continue; } r -= I_L;
        { const int h = r >> 1; p0_transpose_item<4>(F.lru_wx() + h * 4096, 64, 64, WxT + h * 4096, scr, r & 1, F.lane); }
    }
}


constexpr int SCL_OFF = RING_BYTES;
__device__ __forceinline__ void p1_upweights(Frame& F, unsigned char* wsp) {
    const float* MODp = (const float*)(wsp + WS_MOD);
    LAS float* SC = (LAS float*)(F.lds + SCL_OFF);
#define SHB(b) ((LAS float*)(F.lds + 16384 * (b) + 8448))
    if (F.tid == 0) *(LAS int*)(F.lds + MISC_OFF - 64) = 0;
    for (int i = F.tid; i < BATCH * D_MODEL; i += NT) { const int b = i >> 10, k = i & 1023; SC[i] = F.norm2_g()[k] * (1.0f + MODp[(size_t)b * N_MOD + 4096 + k]); SHB(b)[k] = MODp[(size_t)b * N_MOD + 3072 + k]; }
    __syncthreads();
    LAS float* scr = (LAS float*)(F.lds + F.wave * 16384);
    u16* W4 = (u16*)(wsp + WS_WUP4); float* BIAS2 = (float*)(wsp + WS_BIAS2);
    const float* W = F.w_up();
    const int gw = F.wave * F.G + F.vcu, NGW = F.G * NWAVES, lane = F.lane;
    for (int it = gw; it < 4 * (N_UP / 32); it += NGW) {
        const int n0 = 32 * (it >> 2), kc = it & 3;
        float bs0 = 0.f, bs1 = 0.f, bs2 = 0.f, bs3 = 0.f;
#pragma unroll 1
        for (int kb = 4 * kc; kb < 4 * kc + 4; ++kb) {
            const int k0 = 64 * kb;
#pragma unroll
            for (int i = 0; i < 8; ++i) { const int f = i * 64 + lane, kk = f >> 3, n4 = f & 7;
                const f32x4 w = *(const GAS f32x4*)(W + (size_t)(k0 + kk) * N_UP + n0 + 4 * n4);
                LAS float* d = scr + kk * 33 + 4 * n4; d[0] = w.x; d[1] = w.y; d[2] = w.z; d[3] = w.w; }
            LDS_WAIT(); asm volatile("" ::: "memory");
            { const int n = lane & 31, kh = lane >> 5;
#pragma unroll 8
              for (int kk = 0; kk < 32; ++kk) { const float w = scr[(32 * kh + kk) * 33 + n]; const int k = k0 + 32 * kh + kk;
                  bs0 += SHB(0)[k] * w; bs1 += SHB(1)[k] * w; bs2 += SHB(2)[k] * w; bs3 += SHB(3)[k] * w; } }
            const int c = lane & 7;
#pragma unroll
            for (int j = 0; j < 4; ++j) { const int n = (lane >> 3) + 8 * j; const LAS float* s = scr + (8 * c) * 33 + n;
                int nn = n0 + n; { const int bj = nn >= D_FF ? 1 : 0, f = nn - bj * D_FF; nn = 256 * (f >> 7) + 128 * bj + (f & 127); }
                float wv[8];
#pragma unroll
                for (int e = 0; e < 8; ++e) wv[e] = s[e * 33];
#pragma unroll
                for (int b = 0; b < BATCH; ++b) { const LAS float* sc = SC + b * 1024 + k0 + 8 * c;
                    u32x4 o; o.x = cvt_pk_bf16(wv[0] * sc[0], wv[1] * sc[1]); o.y = cvt_pk_bf16(wv[2] * sc[2], wv[3] * sc[3]); o.z = cvt_pk_bf16(wv[4] * sc[4], wv[5] * sc[5]); o.w = cvt_pk_bf16(wv[6] * sc[6], wv[7] * sc[7]);
                    *(GAS u32x4*)(W4 + ((size_t)b * N_UP + nn) * D_MODEL + k0 + 8 * c) = o; } }
            LDS_WAIT(); asm volatile("" ::: "memory");
        }
        bs0 += __shfl_xor(bs0, 32); bs1 += __shfl_xor(bs1, 32); bs2 += __shfl_xor(bs2, 32); bs3 += __shfl_xor(bs3, 32);
        if (lane < 32) { float* bp = BIAS2 + (size_t)kc * BATCH * N_UP + n0 + lane; bp[0] = bs0; bp[N_UP] = bs1; bp[2 * N_UP] = bs2; bp[3 * N_UP] = bs3; }
    }
}


__device__ __forceinline__ void cb2_prep(Frame& F, unsigned char* wsp) {
    const float* BIAS2 = (const float*)(wsp + WS_BIAS2); float* CB2 = (float*)(wsp + WS_CB2);
    const float* cw = F.ffn_conv_w(); const float* cb = F.ffn_conv_b();
    for (int i = F.vcu * NT + F.tid; i < BATCH * N_UP; i += F.G * NT) { const int b = i / N_UP, col = i % N_UP;
        const float bias = (BIAS2[(size_t)(0 * BATCH + b) * N_UP + col] + BIAS2[(size_t)(1 * BATCH + b) * N_UP + col]) + (BIAS2[(size_t)(2 * BATCH + b) * N_UP + col] + BIAS2[(size_t)(3 * BATCH + b) * N_UP + col]);
        CB2[i] = cb[col] + ((cw[col] + cw[N_UP + col]) + cw[2 * N_UP + col]) * bias; }
}

template <bool F16>
__device__ __forceinline__ void rownorm_phase(Frame& F, const float* X, const float* g, const float* sh, const float* sc, u16* O) {
    LAS int* ctr = (LAS int*)(F.lds + MISC_OFF - 64);
    for (;;) {
        int k = 0; if (F.lane == 0) k = __hip_atomic_fetch_add(ctr, 1, __ATOMIC_RELAXED, __HIP_MEMORY_SCOPE_WORKGROUP);
        k = __builtin_amdgcn_readfirstlane(k);
        const int m0 = (F.vcu + k * F.G) * 4;
        if (m0 >= M_TOK) break;
        const int b = m0 / SEQ;
        f32x4 v[4][4]; float s[4];
#pragma unroll
        for (int r = 0; r < 4; ++r) { const GAS f32x4* xr = (const GAS f32x4*)(X + (size_t)(m0 + r) * D_MODEL) + F.lane; s[r] = 0.f;
#pragma unroll
            for (int j = 0; j < 4; ++j) v[r][j] = xr[64 * j]; }
#pragma unroll
        for (int r = 0; r < 4; ++r)
#pragma unroll
            for (int j = 0; j < 4; ++j) s[r] += (v[r][j].x * v[r][j].x + v[r][j].y * v[r][j].y) + (v[r][j].z * v[r][j].z + v[r][j].w * v[r][j].w);
#pragma unroll
        for (int o = 1; o < 64; o <<= 1) {
#pragma unroll
            for (int r = 0; r < 4; ++r) s[r] += __shfl_xor(s[r], o); }
        float rstd[4];
#pragma unroll
        for (int r = 0; r < 4; ++r) rstd[r] = 1.0f / sqrtf(s[r] * (1.0f / D_MODEL) + EPS);
#pragma unroll
        for (int j = 0; j < 4; ++j) {
            const int col = 4 * F.lane + 256 * j;
            const f32x4 gv = *(const f32x4*)(g + col), shv = *(const f32x4*)(sh + (size_t)b * N_MOD + col), scv = *(const f32x4*)(sc + (size_t)b * N_MOD + col);
            const f32x4 gs = gv * (scv + 1.0f);
#pragma unroll
            for (int r = 0; r < 4; ++r) {
                const f32x4 y = (v[r][j] * rstd[r]) * gs + shv;
                u32x2 w;
                if (F16) { w.x = cvt_pk_f16(y.x, y.y); w.y = cvt_pk_f16(y.z, y.w); } else { w.x = cvt_pk_bf16(y.x, y.y); w.y = cvt_pk_bf16(y.z, y.w); }
                *((GAS u32x2*)(O + (size_t)(m0 + r) * D_MODEL) + F.lane + 64 * j) = w; }
        }
    }
}

__device__ __forceinline__ int crow(int r, int hi) { return (r & 3) + 8 * (r >> 2) + 4 * hi; }
__device__ __forceinline__ int qs_off(int q, int c) { return q * 64 + ((c ^ ((q >> 1) & 7)) << 3); }
constexpr int AL_QS = 0, AL_SLOT = 32768, AL_LSL = 131072, AL_LIST = 134144, AL_CNT = 150528, AL_MISC = 150656, AL_KMS = 150912;
__device__ __forceinline__ void attn_tile(const u16* Kp, const u16* Vp, const s16x8 (&qf)[4], int nkt, bool own, int tt, int qidx, int hi, float c1, float c2, f32x16& o0, f32x16& o1, float& lsum) {
#pragma unroll
    for (int r = 0; r < 16; ++r) { o0[r] = 0.f; o1[r] = 0.f; }
    lsum = 0.f;
    s16x8 kc[4], kn[4], vc[4];
#pragma unroll
    for (int s = 0; s < 4; ++s) { kc[s] = *(const GAS s16x8*)(Kp + s * 512); kn[s] = kc[s]; }
#pragma unroll 1
    for (int kt = 0; kt < nkt; ++kt) {
#pragma unroll
        for (int s = 0; s < 4; ++s) vc[s] = *(const GAS s16x8*)(Vp + (kt * 4 + s) * 512);
        if (kt + 1 < nkt) {
#pragma unroll
            for (int s = 0; s < 4; ++s) kn[s] = *(const GAS s16x8*)(Kp + ((kt + 1) * 4 + s) * 512);
        }
        f32x16 p;
#pragma unroll
        for (int r = 0; r < 16; ++r) p[r] = 0.f;
#pragma unroll
        for (int s = 0; s < 4; ++s) p = __builtin_amdgcn_mfma_f32_32x32x16_bf16(__builtin_bit_cast(bf16x8_t, kc[s]), __builtin_bit_cast(bf16x8_t, qf[s]), p, 0, 0, 0);
        const bool diag = own && (kt == tt);
#pragma unroll
        for (int r = 0; r < 16; ++r) { float e = __builtin_amdgcn_exp2f(p[r] * c1 - c2);
            if (diag && (32 * kt + crow(r, hi) > qidx)) e = 0.f;
            p[r] = e; lsum += e; }
#pragma unroll
        for (int s2 = 0; s2 < 2; ++s2) {
            u32x4 pw; pw.x = cvt_pk_bf16(p[8 * s2 + 0], p[8 * s2 + 1]); pw.y = cvt_pk_bf16(p[8 * s2 + 2], p[8 * s2 + 3]); pw.z = cvt_pk_bf16(p[8 * s2 + 4], p[8 * s2 + 5]); pw.w = cvt_pk_bf16(p[8 * s2 + 6], p[8 * s2 + 7]);
            const bf16x8_t pa = __builtin_bit_cast(bf16x8_t, pw);
            o0 = __builtin_amdgcn_mfma_f32_32x32x16_bf16(pa, __builtin_bit_cast(bf16x8_t, vc[2 * s2]), o0, 0, 0, 0);
            o1 = __builtin_amdgcn_mfma_f32_32x32x16_bf16(pa, __builtin_bit_cast(bf16x8_t, vc[2 * s2 + 1]), o1, 0, 0, 0);
        }
#pragma unroll
        for (int s = 0; s < 4; ++s) kc[s] = kn[s];
    }
}
__device__ __forceinline__ void attn_tile_full(const u16* Kp, const u16* Vp, const LAS u16* QS, int qidx, int hi, float c1, float c2, f32x16& o0, f32x16& o1, float& lsum) {
#pragma unroll
    for (int r = 0; r < 16; ++r) { o0[r] = 0.f; o1[r] = 0.f; }
    lsum = 0.f;
    s16x8 kr[4][4], vr[4][4];
    const u16* kp = Kp; const u16* vp = Vp;
#pragma unroll
    for (int d = 0; d < 3; ++d) {
#pragma unroll
        for (int s = 0; s < 4; ++s) { kr[d][s] = *(const GAS s16x8*)(kp + s * 512); vr[d][s] = *(const GAS s16x8*)(vp + s * 512); }
        kp += 2048; vp += 2048; asm volatile("" : "+v"(kp), "+v"(vp));
    }
#pragma unroll
    for (int kt = 0; kt < 8; ++kt) {
        if (kt + 3 < 8) {
#pragma unroll
            for (int s = 0; s < 4; ++s) { kr[(kt + 3) & 3][s] = *(const GAS s16x8*)(kp + s * 512); vr[(kt + 3) & 3][s] = *(const GAS s16x8*)(vp + s * 512); }
            kp += 2048; vp += 2048; asm volatile("" : "+v"(kp), "+v"(vp));
        }
        __builtin_amdgcn_sched_barrier(0x38F);
        f32x16 p;
#pragma unroll
        for (int r = 0; r < 16; ++r) p[r] = 0.f;
#pragma unroll
        for (int s = 0; s < 4; ++s) { const s16x8 qf = *(const LAS s16x8*)(QS + qs_off(qidx, 2 * s + hi));
            p = __builtin_amdgcn_mfma_f32_32x32x16_bf16(__builtin_bit_cast(bf16x8_t, kr[kt & 3][s]), __builtin_bit_cast(bf16x8_t, qf), p, 0, 0, 0); }
#pragma unroll
        for (int r = 0; r < 16; ++r) { const float e = __builtin_amdgcn_exp2f(p[r] * c1 - c2); p[r] = e; lsum += e; }
#pragma unroll
        for (int s2 = 0; s2 < 2; ++s2) {
            u32x4 pw; pw.x = cvt_pk_bf16(p[8 * s2 + 0], p[8 * s2 + 1]); pw.y = cvt_pk_bf16(p[8 * s2 + 2], p[8 * s2 + 3]); pw.z = cvt_pk_bf16(p[8 * s2 + 4], p[8 * s2 + 5]); pw.w = cvt_pk_bf16(p[8 * s2 + 6], p[8 * s2 + 7]);
            const bf16x8_t pa = __builtin_bit_cast(bf16x8_t, pw);
            o0 = __builtin_amdgcn_mfma_f32_32x32x16_bf16(pa, __builtin_bit_cast(bf16x8_t, vr[kt & 3][2 * s2]), o0, 0, 0, 0);
            o1 = __builtin_amdgcn_mfma_f32_32x32x16_bf16(pa, __builtin_bit_cast(bf16x8_t, vr[kt & 3][2 * s2 + 1]), o1, 0, 0, 0);
        }
        __builtin_amdgcn_sched_barrier(0x38F);
    }
}
__device__ __forceinline__ void attn_item(Frame& F, int bh, int i, float c1, float c2) {
    unsigned char* wsp = F.ws; asm volatile("" : "+s"(wsp));
    const float* QF = (const float*)(wsp + WS_QF); const u16* KB = (const u16*)(wsp + WS_KB); const u16* VT = (const u16*)(wsp + WS_VT);
    const float* KM = (const float*)(wsp + WS_KM); u16* ATT = (u16*)(wsp + WS_MIX); float* SSQA = (float*)(wsp + WS_SSQA);
    LAS u16* QS = (LAS u16*)(F.lds + AL_QS); LAS u16* SLOT = (LAS u16*)(F.lds + AL_SLOT); LAS float* LSL = (LAS float*)(F.lds + AL_LSL);
    LAS float* KMS = (LAS float*)(F.lds + AL_KMS); LAS u16* LIST = (LAS u16*)(F.lds + AL_LIST); LAS int* CNT = (LAS int*)(F.lds + AL_CNT);
    int tid_ = F.tid; asm volatile("" : "+v"(tid_));
    const int tid = tid_, lane = tid & 63, wave = F.wave, hi = lane >> 5, l31 = lane & 31;
    const int b = bh / NHEAD, h = bh % NHEAD;
    for (int u = tid; u < (3 * 32768 + 3072) / 16; u += NT) *(LAS u32x4*)(F.lds + AL_SLOT + u * 16) = (u32x4){0u, 0u, 0u, 0u};
    if (tid < 32) CNT[tid] = 0;
    for (int u = tid; u < NBLK * HD; u += NT) { const int n = u >> 6, d = u & 63; KMS[u] = KM[(((size_t)(b * NBLK + n)) * NHEAD + h) * HD + d] * (1.0f / 256.0f); }
    __syncthreads();
    {
        const int q = 32 * wave + l31;
        const GAS f32x4* qrow = (const GAS f32x4*)(QF + ((size_t)bh * SEQ + (size_t)i * BLK + q) * HD);
        f32x16 p;
#pragma unroll
        for (int r = 0; r < 16; ++r) p[r] = 0.f;
#pragma unroll
        for (int s = 0; s < 4; ++s) {
            const f32x4 qa = qrow[4 * s + 2 * hi], qc = qrow[4 * s + 2 * hi + 1];
            u32x4 qh; qh.x = cvt_pk_bf16(qa.x, qa.y); qh.y = cvt_pk_bf16(qa.z, qa.w); qh.z = cvt_pk_bf16(qc.x, qc.y); qh.w = cvt_pk_bf16(qc.z, qc.w);
            u32x4 ql; ql.x = cvt_pk_bf16(qa.x - bf_lo(qh.x), qa.y - bf_hi(qh.x)); ql.y = cvt_pk_bf16(qa.z - bf_lo(qh.y), qa.w - bf_hi(qh.y));
            ql.z = cvt_pk_bf16(qc.x - bf_lo(qh.z), qc.y - bf_hi(qh.z)); ql.w = cvt_pk_bf16(qc.z - bf_lo(qh.w), qc.w - bf_hi(qh.w));
            *(LAS u32x4*)(QS + qs_off(q, 2 * s + hi)) = qh;
            const LAS f32x4* kr = (const LAS f32x4*)(KMS + l31 * 64 + 16 * s + 8 * hi);
            const f32x4 ka = kr[0], kc = kr[1];
            u32x4 kh; kh.x = cvt_pk_bf16(ka.x, ka.y); kh.y = cvt_pk_bf16(ka.z, ka.w); kh.z = cvt_pk_bf16(kc.x, kc.y); kh.w = cvt_pk_bf16(kc.z, kc.w);
            u32x4 kl; kl.x = cvt_pk_bf16(ka.x - bf_lo(kh.x), ka.y - bf_hi(kh.x)); kl.y = cvt_pk_bf16(ka.z - bf_lo(kh.y), ka.w - bf_hi(kh.y));
            kl.z = cvt_pk_bf16(kc.x - bf_lo(kh.z), kc.y - bf_hi(kh.z)); kl.w = cvt_pk_bf16(kc.z - bf_lo(kh.w), kc.w - bf_hi(kh.w));
            p = __builtin_amdgcn_mfma_f32_32x32x16_bf16(__builtin_bit_cast(bf16x8_t, kl), __builtin_bit_cast(bf16x8_t, qh), p, 0, 0, 0);
            p = __builtin_amdgcn_mfma_f32_32x32x16_bf16(__builtin_bit_cast(bf16x8_t, kh), __builtin_bit_cast(bf16x8_t, ql), p, 0, 0, 0);
            p = __builtin_amdgcn_mfma_f32_32x32x16_bf16(__builtin_bit_cast(bf16x8_t, kh), __builtin_bit_cast(bf16x8_t, qh), p, 0, 0, 0);
        }
        float v0 = -INFINITY, v1 = -INFINITY, v2 = -INFINITY; int i0 = -1, i1 = -1, i2 = -1;
#pragma unroll
        for (int r = 0; r < 16; ++r) {
            const int n = crow(r, hi); const float g = (n < i) ? p[r] : -INFINITY;
            if (g > v0) { v2 = v1; i2 = i1; v1 = v0; i1 = i0; v0 = g; i0 = n; }
            else if (g > v1) { v2 = v1; i2 = i1; v1 = g; i1 = n; }
            else if (g > v2) { v2 = g; i2 = n; }
        }
        const float pv0 = __shfl_xor(v0, 32), pv1 = __shfl_xor(v1, 32), pv2 = __shfl_xor(v2, 32);
        const int pi0 = __shfl_xor(i0, 32), pi1 = __shfl_xor(i1, 32), pi2 = __shfl_xor(i2, 32);
        if (hi == 0) {
            float av[3] = {v0, v1, v2}, bv[3] = {pv0, pv1, pv2}; int ai[3] = {i0, i1, i2}, bi[3] = {pi0, pi1, pi2};
            int sel[3]; int pa = 0, pb = 0;
#pragma unroll
            for (int k = 0; k < 3; ++k) {
                const float ca = pa == 0 ? av[0] : (pa == 1 ? av[1] : av[2]); const int cai = pa == 0 ? ai[0] : (pa == 1 ? ai[1] : ai[2]);
                const float cb = pb == 0 ? bv[0] : (pb == 1 ? bv[1] : bv[2]); const int cbi = pb == 0 ? bi[0] : (pb == 1 ? bi[1] : bi[2]);
                if (ca > cb || (ca == cb && (cbi < 0 || (cai >= 0 && cai < cbi)))) { sel[k] = cai; ++pa; } else { sel[k] = cbi; ++pb; }
            }
#pragma unroll
            for (int k = 0; k < 3; ++k) if (sel[k] >= 0) { const int pos = __hip_atomic_fetch_add(&CNT[sel[k]], 1, __ATOMIC_RELAXED, __HIP_MEMORY_SCOPE_WORKGROUP); LIST[sel[k] * 256 + pos] = (u16)(q | (k << 8)); }
        }
    }
    __syncthreads();
    {
        int base = 0;
        for (int j = 0; j < i; ++j) {
            const int cntj = __builtin_amdgcn_readfirstlane(CNT[j]);
            const int ntj = (cntj + 31) >> 5;
            for (int t = base + ((wave - base) & 7); t < base + ntj; t += 8) {
                const int tt = t - base;
                const int ridx = 32 * tt + l31; const bool valid = ridx < cntj;
                const int ent = valid ? (int)LIST[j * 256 + ridx] : 0;
                const int qidx = ent & 255;
                s16x8 qf[4];
#pragma unroll
                for (int s = 0; s < 4; ++s) qf[s] = *(const LAS s16x8*)(QS + qs_off(qidx, 2 * s + hi));
                const size_t boff = ((size_t)bh * NBLK + j) * (BLK * HD) + lane * 8;
                f32x16 o0, o1; float lsum;
                attn_tile_full(KB + boff, VT + boff, QS, qidx, hi, c1, c2, o0, o1, lsum);
                const int srow = valid ? ((ent >> 8) * 256 + qidx) : -1;
                lsum += __shfl_xor(lsum, 32);
                if (valid && hi == 0) LSL[srow] = lsum;
#pragma unroll
                for (int r = 0; r < 16; ++r) { const int sr = __shfl(srow, crow(r, hi));
                    if (sr >= 0) { const unsigned w = cvt_pk_bf16(o0[r], o1[r]); SLOT[sr * 64 + l31] = (u16)(w & 0xffffu); SLOT[sr * 64 + 32 + l31] = (u16)(w >> 16); }
                    if ((r & 3) == 3) asm volatile("" ::: "memory"); }
            }
            base += ntj;
        }
    }
    f32x16 oo0, oo1; float lown;
    {
        s16x8 qf[4];
#pragma unroll
        for (int s = 0; s < 4; ++s) qf[s] = *(const LAS s16x8*)(QS + qs_off(32 * wave + l31, 2 * s + hi));
        const size_t boff = ((size_t)bh * NBLK + i) * (BLK * HD) + lane * 8;
        attn_tile(KB + boff, VT + boff, qf, wave + 1, true, wave, 32 * wave + l31, hi, c1, c2, oo0, oo1, lown);
    }
    __syncthreads();
    {
        const int q = 32 * wave + l31;
        float lt = lown + __shfl_xor(lown, 32);
        lt += LSL[q] + LSL[256 + q] + LSL[512 + q];
        const float inv = 1.0f / lt;
#pragma unroll
        for (int r = 0; r < 16; ++r) { const int rl = crow(r, hi), qq = 32 * wave + rl; const float iv = __shfl(inv, rl);
            float a = oo0[r], c = oo1[r];
#pragma unroll
            for (int k = 0; k < 3; ++k) { a += __builtin_bit_cast(float, (unsigned)SLOT[(k * 256 + qq) * 64 + l31] << 16); c += __builtin_bit_cast(float, (unsigned)SLOT[(k * 256 + qq) * 64 + 32 + l31] << 16); }
            const unsigned w = cvt_pk_bf16(a * iv, c * iv);
            QS[qq * 64 + l31] = (u16)(w & 0xffffu); QS[qq * 64 + 32 + l31] = (u16)(w >> 16);
            if ((r & 3) == 3) asm volatile("" ::: "memory"); }
        LDS_WAIT(); asm volatile("" ::: "memory");
#pragma unroll
        for (int it = 0; it < 4; ++it) { const int c = lane + 64 * it, row = c >> 3, ch = c & 7;
            const u32x4 w = *(const LAS u32x4*)(QS + (32 * wave + row) * 64 + 8 * ch);
            const size_t tok = (size_t)b * SEQ + (size_t)i * BLK + 32 * wave + row;
            *(GAS u32x4*)(ATT + tok * D_MODEL + AW + h * HD + 8 * ch) = w;
            float ss = bf_lo(w.x) * bf_lo(w.x) + bf_hi(w.x) * bf_hi(w.x) + bf_lo(w.y) * bf_lo(w.y) + bf_hi(w.y) * bf_hi(w.y) + bf_lo(w.z) * bf_lo(w.z) + bf_hi(w.z) * bf_hi(w.z) + bf_lo(w.w) * bf_lo(w.w) + bf_hi(w.w) * bf_hi(w.w);
            ss += __shfl_xor(ss, 1); ss += __shfl_xor(ss, 2); ss += __shfl_xor(ss, 4);
            if (ch == 0) SSQA[tok * NHEAD + h] = ss; }
    }
    __syncthreads();
}
__device__ __forceinline__ void attn_phase(Frame& F) {
    LAS float* mm = (LAS float*)(F.lds + AL_MISC);
    if (F.tid < 64) { float a = fabsf(F.q_norm_g()[F.tid]), c = fabsf(F.k_norm_g()[F.tid]);
#pragma unroll
        for (int o = 1; o < 64; o <<= 1) { a = fmaxf(a, __shfl_xor(a, o)); c = fmaxf(c, __shfl_xor(c, o)); }
        if (F.tid == 0) { mm[0] = a; mm[1] = c; } }
    __syncthreads();
    const float C = 8.0f * mm[0] * mm[1];
    const float c1 = 0.125f * LOG2E, c2 = C * LOG2E;
    __syncthreads();
    if (F.G == 256) {
        const int xcd = F.vcu >> 5, k = F.vcu & 31;
#pragma unroll 1
        for (int r = 0; r < 4; ++r) attn_item(F, xcd * 4 + r, (r & 1) ? 31 - k : k, c1, c2);
    } else {
        for (int it = F.vcu; it < BATCH * NHEAD * NBLK; it += F.G) attn_item(F, it >> 5, it & 31, c1, c2);
    }
}

constexpr int LL_CW = 0;
template <bool FINAL>
__device__ __forceinline__ void lru_item(Frame& F, int b, int chunk) {
    unsigned char* wsp = F.ws; asm volatile("" : "+s"(wsp));
    const u16* XR = (const u16*)(wsp + WS_XR); const u16* GG = (const u16*)(wsp + WS_GG);
    const u16* WaT = (const u16*)(wsp + WS_WA); const u16* WxT = (const u16*)(wsp + WS_WX);
    float* AGG = (float*)(wsp + WS_AGG); u16* LRU = (u16*)(wsp + WS_MIX); float* SSQL = (float*)(wsp + WS_SSQL);
    const int lane0 = F.lane, hd = F.wave, hi0 = lane0 >> 5, j0 = lane0 & 31;
    LAS float* CW = (LAS float*)(F.lds + LL_CW + hd * 2048);
    LAS u16* OT = (LAS u16*)(F.lds + 16384 + hd * 4096);
    for (int u = lane0; u < 320; u += 64) CW[u] = (u < 256) ? F.lru_conv_w()[(u >> 6) * AW + hd * HD + (u & 63)] : F.lru_conv_b()[hd * HD + (u - 256)];
    CW[320 + lane0] = F.lru_ba()[hd * HD + lane0]; CW[384 + lane0] = F.lru_bx()[hd * HD + lane0]; CW[448 + lane0] = 8.0f * log1pf(expf(-F.lru_lambda()[hd * HD + lane0]));
    LDS_WAIT(); asm volatile("" ::: "memory");
    float carry[2], arun[2];
#pragma unroll
    for (int ct = 0; ct < 2; ++ct) { const int c = hd * HD + 32 * ct + j0; carry[ct] = 0.f; arun[ct] = 1.f;
        if (FINAL) { float hcar = 0.f; for (int cc = 0; cc < chunk; ++cc) { const f32x2 ah = *(const f32x2*)(AGG + (((size_t)(b * 64 + cc)) * AW + c) * 2); hcar = ah.x * hcar + ah.y; } carry[ct] = hcar; } }
    for (int tile = 0; tile < 4; ++tile) {
        const int t0 = chunk * 128 + tile * 32;
        const u16* WaTt = WaT; const u16* WxTt = WxT; int lane = lane0; asm volatile("" : "+s"(WaTt), "+s"(WxTt), "+v"(lane));
        const int hi = lane >> 5, j = lane & 31, jt = j;
        const int pos = t0 + j;
        s16x8 af[4];
#pragma unroll
        for (int s = 0; s < 4; ++s) {
            const int ch0 = 16 * s + 8 * hi;
            float xc[8];
            { const LAS f32x4* bp = (const LAS f32x4*)(CW + 256 + ch0); const f32x4 b0 = bp[0], b1 = bp[1];
              xc[0] = b0.x; xc[1] = b0.y; xc[2] = b0.z; xc[3] = b0.w; xc[4] = b1.x; xc[5] = b1.y; xc[6] = b1.z; xc[7] = b1.w; }
            float accv[8];
#pragma unroll
            for (int e = 0; e < 8; ++e) accv[e] = 0.f;
#pragma unroll
            for (int jj = 0; jj < 4; ++jj) {
                const int p = pos - 3 + jj;
                u32x4 xw = (u32x4){0u, 0u, 0u, 0u};
                if (p >= 0) xw = *(const GAS u32x4*)(XR + ((((size_t)b * (SEQ / 32) + (p >> 5)) * NHEAD + hd) * 2048) + ((s * 2 + hi) * 32 + (p & 31)) * 8);
                const LAS f32x4* wp = (const LAS f32x4*)(CW + jj * 64 + ch0); const f32x4 w0 = wp[0], w1 = wp[1];
                accv[0] += w0.x * bf_lo(xw.x); accv[1] += w0.y * bf_hi(xw.x); accv[2] += w0.z * bf_lo(xw.y); accv[3] += w0.w * bf_hi(xw.y);
                accv[4] += w1.x * bf_lo(xw.z); accv[5] += w1.y * bf_hi(xw.z); accv[6] += w1.z * bf_lo(xw.w); accv[7] += w1.w * bf_hi(xw.w);
            }
#pragma unroll
            for (int e = 0; e < 8; ++e) xc[e] += accv[e];
            u32x4 aw; aw.x = cvt_pk_bf16(xc[0], xc[1]); aw.y = cvt_pk_bf16(xc[2], xc[3]); aw.z = cvt_pk_bf16(xc[4], xc[5]); aw.w = cvt_pk_bf16(xc[6], xc[7]);
            af[s] = __builtin_bit_cast(s16x8, aw);
            __builtin_amdgcn_sched_barrier(0);
        }
        float ssacc[16];
#pragma unroll
        for (int r = 0; r < 16; ++r) ssacc[r] = 0.f;
#pragma unroll
        for (int ct = 0; ct < 2; ++ct) {
            float av[16], uv[16];
            {
                f32x16 aA, aX;
#pragma unroll
                for (int r = 0; r < 16; ++r) { aA[r] = 0.f; aX[r] = 0.f; }
#pragma unroll
                for (int s = 0; s < 4; ++s) {
                    const size_t woff = (size_t)hd * 4096 + (ct * 4 + s) * 512 + lane * 8;
                    const s16x8 wa = *(const GAS s16x8*)(WaTt + woff), wx = *(const GAS s16x8*)(WxTt + woff);
                    const bf16x8_t a = __builtin_bit_cast(bf16x8_t, af[s]);
                    aA = __builtin_amdgcn_mfma_f32_32x32x16_bf16(a, __builtin_bit_cast(bf16x8_t, wa), aA, 0, 0, 0);
                    aX = __builtin_amdgcn_mfma_f32_32x32x16_bf16(a, __builtin_bit_cast(bf16x8_t, wx), aX, 0, 0, 0);
                }
                const float bac = CW[320 + 32 * ct + jt], bxc = CW[384 + 32 * ct + jt], sp8c = CW[448 + 32 * ct + jt];
#pragma unroll
                for (int r = 0; r < 16; ++r) {
                    const float rr = sigmoidf_(aA[r] + bac), ii = sigmoidf_(aX[r] + bxc);
                    const float la = -rr * sp8c;
                    const float a = __builtin_amdgcn_exp2f(la * LOG2E);
                    const float om = fmaf(-a, a, 1.0f);
                    av[r] = a; uv[r] = __builtin_amdgcn_sqrtf(om) * ii;
                }
            }
            f32x16 aG;
            {
                f32x16 aI;
#pragma unroll
                for (int r = 0; r < 16; ++r) { aI[r] = 0.f; aG[r] = 0.f; }
#pragma unroll
                for (int s = 0; s < 4; ++s) {
                    s16x8 id;
#pragma unroll
                    for (int e = 0; e < 8; ++e) id[e] = (16 * s + 8 * hi + e == 32 * ct + jt) ? (short)0x3F80 : (short)0;
                    aI = __builtin_amdgcn_mfma_f32_32x32x16_bf16(__builtin_bit_cast(bf16x8_t, af[s]), __builtin_bit_cast(bf16x8_t, id), aI, 0, 0, 0);
                    if (FINAL) { const s16x8 gfr = *(const GAS s16x8*)(GG + ((((size_t)b * (SEQ / 32) + (t0 >> 5)) * NHEAD + hd) * 2048) + s * 512 + lane * 8);
                        aG = __builtin_amdgcn_mfma_f32_32x32x16_bf16(__builtin_bit_cast(bf16x8_t, gfr), __builtin_bit_cast(bf16x8_t, id), aG, 0, 0, 0); }
                }
#pragma unroll
                for (int r = 0; r < 16; ++r) uv[r] *= aI[r];
            }
            float Ag[4], Ug[4];
#pragma unroll
            for (int g = 0; g < 4; ++g) { float A = av[4 * g], U = uv[4 * g];
#pragma unroll
                for (int e = 1; e < 4; ++e) { A *= av[4 * g + e]; U = av[4 * g + e] * U + uv[4 * g + e]; }
                Ag[g] = A; Ug[g] = U; }
            float h = carry[ct], ap = arun[ct];
            float hin[4];
#pragma unroll
            for (int g = 0; g < 4; ++g) {
                const float pA = __shfl_xor(Ag[g], 32), pU = __shfl_xor(Ug[g], 32);
                const float fA = hi ? pA : Ag[g], fU = hi ? pU : Ug[g], sA = hi ? Ag[g] : pA, sU = hi ? Ug[g] : pU;
                const float h1 = fA * h + fU;
                hin[g] = hi ? h1 : h;
                h = sA * h1 + sU; ap *= fA * sA;
            }
            carry[ct] = h; arun[ct] = ap;
            if (FINAL) {
#pragma unroll
                for (int g = 0; g < 4; ++g) { float hh = hin[g];
#pragma unroll
                    for (int e = 0; e < 4; ++e) { const int r = 4 * g + e; hh = av[r] * hh + uv[r]; const float o = hh * aG[r]; ssacc[r] += o * o;
                        OT[crow(r, hi) * 64 + 32 * ct + j] = (u16)(cvt_pk_bf16(o, 0.f) & 0xffffu); } }
            }
        }
        if (FINAL) {
#pragma unroll
            for (int r = 0; r < 16; ++r) {
                const size_t tok = (size_t)b * SEQ + t0 + crow(r, hi);
                float ss = ssacc[r];
                ss += __shfl_xor(ss, 1); ss += __shfl_xor(ss, 2); ss += __shfl_xor(ss, 4); ss += __shfl_xor(ss, 8); ss += __shfl_xor(ss, 16);
                if (j == 0) SSQL[tok * NHEAD + hd] = ss;
            }
            LDS_WAIT(); asm volatile("" ::: "memory");
#pragma unroll
            for (int it = 0; it < 4; ++it) { const int c = lane + 64 * it, row = c >> 3, ch = c & 7;
                const u32x4 w = *(const LAS u32x4*)(OT + row * 64 + 8 * ch);
                *(GAS u32x4*)(LRU + ((size_t)b * SEQ + t0 + row) * D_MODEL + hd * HD + 8 * ch) = w; }
            LDS_WAIT(); asm volatile("" ::: "memory");
        }
    }
    if (!FINAL) { if (hi0 == 0) {
#pragma unroll
        for (int ct = 0; ct < 2; ++ct) { const int c = hd * HD + 32 * ct + j0; *(f32x2*)(AGG + (((size_t)(b * 64 + chunk)) * AW + c) * 2) = (f32x2){arun[ct], carry[ct]}; } } }
}
template <bool FINAL>
__device__ __forceinline__ void lru_phase(Frame& F) {
    for (int it = F.vcu; it < BATCH * 64; it += F.G) { lru_item<FINAL>(F, it >> 6, it & 63); }
}

__device__ __forceinline__ void mix_phase(Frame& F) {
    unsigned char* wsp = F.ws; asm volatile("" : "+s"(wsp));
    const u16* LRU = (const u16*)(wsp + WS_LRU); const u16* ATT = (const u16*)(wsp + WS_ATT);
    const float* SSQL = (const float*)(wsp + WS_SSQL); const float* SSQA = (const float*)(wsp + WS_SSQA); u16* MIX = (u16*)(wsp + WS_MIX);
    const int gw = F.vcu * NWAVES + F.wave, NGW = F.G * NWAVES, lane = F.lane;
    const f32x4 gl0 = *(const f32x4*)(F.lru_out_g() + 8 * lane), gl1 = *(const f32x4*)(F.lru_out_g() + 8 * lane + 4);
    const f32x4 ga0 = *(const f32x4*)(F.attn_out_g() + 8 * lane), ga1 = *(const f32x4*)(F.attn_out_g() + 8 * lane + 4);
    for (int m = gw; m < M_TOK; m += NGW) {
        const f32x4 s0 = *(const GAS f32x4*)(SSQL + (size_t)m * 8), s1 = *(const GAS f32x4*)(SSQL + (size_t)m * 8 + 4);
        const f32x4 t0 = *(const GAS f32x4*)(SSQA + (size_t)m * 8), t1 = *(const GAS f32x4*)(SSQA + (size_t)m * 8 + 4);
        const float ssl = ((s0.x + s0.y) + (s0.z + s0.w)) + ((s1.x + s1.y) + (s1.z + s1.w));
        const float ssa = ((t0.x + t0.y) + (t0.z + t0.w)) + ((t1.x + t1.y) + (t1.z + t1.w));
        const float rl = 1.0f / sqrtf(ssl * (1.0f / AW) + EPS), ra = 1.0f / sqrtf(ssa * (1.0f / AW) + EPS);
        const u32x4 lw = *(const GAS u32x4*)(LRU + (size_t)m * AW + 8 * lane), aw = *(const GAS u32x4*)(ATT + (size_t)m * AW + 8 * lane);
        u32x4 o;
        o.x = cvt_pk_bf16(bf_lo(lw.x) * rl * gl0.x, bf_hi(lw.x) * rl * gl0.y); o.y = cvt_pk_bf16(bf_lo(lw.y) * rl * gl0.z, bf_hi(lw.y) * rl * gl0.w);
        o.z = cvt_pk_bf16(bf_lo(lw.z) * rl * gl1.x, bf_hi(lw.z) * rl * gl1.y); o.w = cvt_pk_bf16(bf_lo(lw.w) * rl * gl1.z, bf_hi(lw.w) * rl * gl1.w);
        *(GAS u32x4*)(MIX + (size_t)m * D_MODEL + 8 * lane) = o;
        o.x = cvt_pk_bf16(bf_lo(aw.x) * ra * ga0.x, bf_hi(aw.x) * ra * ga0.y); o.y = cvt_pk_bf16(bf_lo(aw.y) * ra * ga0.z, bf_hi(aw.y) * ra * ga0.w);
        o.z = cvt_pk_bf16(bf_lo(aw.z) * ra * ga1.x, bf_hi(aw.z) * ra * ga1.y); o.w = cvt_pk_bf16(bf_lo(aw.w) * ra * ga1.z, bf_hi(aw.w) * ra * ga1.w);
        *(GAS u32x4*)(MIX + (size_t)m * D_MODEL + AW + 8 * lane) = o;
    }
}

__device__ __forceinline__ void ffn_fixup(Frame& F, unsigned char* wsp, int pm) {
    const float* RAW = (const float*)(wsp + WS_RAW); u16* ACT = (u16*)(wsp + WS_ACT);
    const float* cw = F.ffn_conv_w(); const float* cb = F.ffn_conv_b();
    const bool first = (pm % NBLK) == 0;
    for (int f = F.tid; f < D_FF; f += NT) {
        float xg[4], xv[4];
        xg[0] = first ? 0.f : RAW[((size_t)(pm - 1) * 4 + 2) * N_UP + f]; xg[1] = first ? 0.f : RAW[((size_t)(pm - 1) * 4 + 3) * N_UP + f];
        xv[0] = first ? 0.f : RAW[((size_t)(pm - 1) * 4 + 2) * N_UP + D_FF + f]; xv[1] = first ? 0.f : RAW[((size_t)(pm - 1) * 4 + 3) * N_UP + D_FF + f];
        xg[2] = RAW[((size_t)pm * 4 + 0) * N_UP + f]; xg[3] = RAW[((size_t)pm * 4 + 1) * N_UP + f];
        xv[2] = RAW[((size_t)pm * 4 + 0) * N_UP + D_FF + f]; xv[3] = RAW[((size_t)pm * 4 + 1) * N_UP + D_FF + f];
        const float wg0 = cw[f], wg1 = cw[N_UP + f], wg2 = cw[2 * N_UP + f], bg = cb[f];
        const float wv0 = cw[D_FF + f], wv1 = cw[N_UP + D_FF + f], wv2 = cw[2 * N_UP + D_FF + f], bv = cb[D_FF + f];
#pragma unroll
        for (int r = 0; r < 2; ++r) {
            const float cg = ((wg0 * xg[r] + wg1 * xg[r + 1]) + wg2 * xg[r + 2]) + bg;
            const float cv = ((wv0 * xv[r] + wv1 * xv[r + 1]) + wv2 * xv[r + 2]) + bv;
            ACT[((size_t)pm * 256 + r) * D_FF + f] = (u16)(cvt_pk_bf16(cg * sigmoidf_(cg) * cv, 0.f) & 0xffffu);
        }
    }
}

constexpr int N_PHASES = 10;
__global__ void __launch_bounds__(NT, 2) hymba_fwd(Args args) {
    extern __shared__ __attribute__((aligned(16))) unsigned char lds_raw[];
    Frame F;
    F.lds = (LAS unsigned char*)lds_raw;
    F.tid = threadIdx.x; F.lane = F.tid & 63; F.wave = __builtin_amdgcn_readfirstlane(F.tid >> 6); F.wave0 = F.wave;
    F.G = gridDim.x; { const int bx = blockIdx.x; F.vcu = (F.G % 8 == 0) ? (bx % 8) * (F.G / 8) + bx / 8 : bx; }
    F.pa = &args;
    F.out = args.out; F.ws = args.ws;
    volatile LAS unsigned* MISC = (volatile LAS unsigned*)(F.lds + MISC_OFF);
    if (F.tid < 32) MISC[F.tid] = 0u;
    __syncthreads();
    const int lo = args.ph_lo, hi = args.ph_hi;
#ifndef PROBE_PH
#define PROBE_PH -1
#endif
    unsigned long long tpa = 0, tpb = 0;
#define TP_A(k) do { if ((k) == PROBE_PH) tpa = __builtin_amdgcn_s_memrealtime(); } while (0)
#define TP_B(k) do { if ((k) == PROBE_PH) tpb = __builtin_amdgcn_s_memrealtime(); } while (0)
    unsigned* ctl = (unsigned*)(F.ws + WS_CTL);
    XcdBarrier bar; bar.bar = ctl + CW_BAR; bar.x = 0; bar.st = nullptr;
    if (hi - lo > 1) bar = xcd_barrier_post(ctl + CW_BAR, MISC + 8);
#ifndef PHASE_MASK
#define PHASE_MASK 0x3FF
#endif
#define IN(k) (((PHASE_MASK >> (k)) & 1) && lo <= (k) && (k) < hi)
#ifndef DUP_MASK
#define DUP_MASK 0
#endif
#define REP(k) _Pragma("unroll 1") for (int rep_ = 0; rep_ < 1 + ((DUP_MASK >> (k)) & 1); ++rep_)
#ifndef XBAR
#define XBAR 0
#endif
#define SEAM(k) do { if (IN(k) && IN((k) + 1)) { xcd_barrier(bar, F.wave0 * 64 + lane_id()); for (int xb_ = 0; xb_ < XBAR; ++xb_) xcd_barrier(bar, F.wave0 * 64 + lane_id()); } } while (0)
#define MOD ((float*)(wsp + WS_MOD))
#define H ((u16*)(wsp + WS_H))

    TP_A(0);
    if (IN(0)) { unsigned char* wsp = F.ws; asm volatile("" : "+s"(wsp)); { int t_ = F.wave0 * 64 + lane_id(); asm volatile("" : "+v"(t_)); F.tid = t_; F.lane = t_ & 63; F.wave = __builtin_amdgcn_readfirstlane(t_ >> 6); } REP(0) p0_prologue(F); SEAM(0); }
    TP_B(0);
    TP_A(1);
    if (IN(1)) { unsigned char* wsp = F.ws; asm volatile("" : "+s"(wsp)); { int t_ = F.wave0 * 64 + lane_id(); asm volatile("" : "+v"(t_)); F.tid = t_; F.lane = t_ & 63; F.wave = __builtin_amdgcn_readfirstlane(t_ >> 6); } REP(1) { p1_upweights(F, wsp); rownorm_phase<true>(F, F.x(), F.norm1_g(), MOD + 0, MOD + 1024, H); } SEAM(1); }
    TP_B(1);
    TP_A(2);
    if (IN(2)) { unsigned char* wsp = F.ws; asm volatile("" : "+s"(wsp)); { int t_ = F.wave0 * 64 + lane_id(); asm volatile("" : "+v"(t_)); F.tid = t_; F.lane = t_ & 63; F.wave = __builtin_amdgcn_readfirstlane(t_ >> 6); }
        pg8::Gemm g{H, (const u16*)(wsp + WS_WIN), M_TOK, N_IN, D_MODEL, 0}; pg8::StaticOrder S; S.init(M_TOK, N_IN, F.G, (int)blockIdx.x);
        pg8::EpiInProj E{(float*)(wsp + WS_QF), (u16*)(wsp + WS_KB), (u16*)(wsp + WS_VT), (u16*)(wsp + WS_XR), (u16*)(wsp + WS_GG), (float*)(wsp + WS_KM), F.q_norm_g(), F.k_norm_g()};
        REP(2) pg8::gemm_phase<pg8::EpiInProj, pg8::StaticOrder, true, true, true>(F.lds, g, S, E, F.wave0);
        SEAM(2);
    }
    TP_B(2);
    TP_A(3);
    if (IN(3)) { unsigned char* wsp = F.ws; asm volatile("" : "+s"(wsp)); { int t_ = F.wave0 * 64 + lane_id(); asm volatile("" : "+v"(t_)); F.tid = t_; F.lane = t_ & 63; F.wave = __builtin_amdgcn_readfirstlane(t_ >> 6); } cb2_prep(F, wsp); REP(3) attn_phase(F); { int t_ = F.wave0 * 64 + lane_id(); asm volatile("" : "+v"(t_)); F.tid = t_; F.lane = t_ & 63; F.wave = __builtin_amdgcn_readfirstlane(t_ >> 6); } REP(13) lru_phase<false>(F); SEAM(3); }
    TP_B(3);
    TP_A(4);
    if (IN(4)) { unsigned char* wsp = F.ws; asm volatile("" : "+s"(wsp)); { int t_ = F.wave0 * 64 + lane_id(); asm volatile("" : "+v"(t_)); F.tid = t_; F.lane = t_ & 63; F.wave = __builtin_amdgcn_readfirstlane(t_ >> 6); } REP(4) lru_phase<true>(F); if (IN(4) && IN(6)) xcd_barrier(bar, F.wave0 * 64 + lane_id()); }
    TP_B(4);
    TP_A(6);
    if (IN(6)) { unsigned char* wsp = F.ws; asm volatile("" : "+s"(wsp)); { int t_ = F.wave0 * 64 + lane_id(); asm volatile("" : "+v"(t_)); F.tid = t_; F.lane = t_ & 63; F.wave = __builtin_amdgcn_readfirstlane(t_ >> 6); }
        pg8::Gemm g{(const u16*)(wsp + WS_MIX), (const u16*)(wsp + WS_WO), M_TOK, D_MODEL, D_MODEL, 0}; pg8::StaticOrder S; S.init(M_TOK, D_MODEL, F.G, (int)blockIdx.x);
        LAS f32x2* RT = (LAS f32x2*)(F.lds + XB_OFF);
        { const float* SSQL = (const float*)(wsp + WS_SSQL); const float* SSQA = (const float*)(wsp + WS_SSQA);
          for (int i = 0; i < 8; ++i) { pg8::Unit uu; if (!S.next(i, uu)) break;
              if (F.tid < 256) { const size_t row = (size_t)uu.pm * 256 + F.tid;
                  const f32x4 s0 = *(const f32x4*)(SSQL + row * 8), s1 = *(const f32x4*)(SSQL + row * 8 + 4), t0 = *(const f32x4*)(SSQA + row * 8), t1 = *(const f32x4*)(SSQA + row * 8 + 4);
                  const float ssl = ((s0[0] + s0[1]) + (s0[2] + s0[3])) + ((s1[0] + s1[1]) + (s1[2] + s1[3])), ssa = ((t0[0] + t0[1]) + (t0[2] + t0[3])) + ((t1[0] + t1[1]) + (t1[2] + t1[3]));
                  const float rl = 1.0f / sqrtf(ssl * (1.0f / AW) + EPS), ra = 1.0f / sqrtf(ssa * (1.0f / AW) + EPS);
                  RT[i * 256 + F.tid] = (f32x2){rl / ra, ra}; } }
          __syncthreads(); }
        pg8::EpiOut E{F.x(), H, (float*)(wsp + WS_SSQX), MOD + 2048, RT};
        REP(6) pg8::gemm_phase<pg8::EpiOut, pg8::StaticOrder, true, true, false>(F.lds, g, S, E, F.wave0);
        if (IN(6) && IN(8)) xcd_barrier(bar, F.wave0 * 64 + lane_id());
    }
    TP_B(6);
    TP_A(8);
    if (IN(8)) { unsigned char* wsp = F.ws; asm volatile("" : "+s"(wsp)); { int t_ = F.wave0 * 64 + lane_id(); asm volatile("" : "+v"(t_)); F.tid = t_; F.lane = t_ & 63; F.wave = __builtin_amdgcn_readfirstlane(t_ >> 6); }
        pg8::Gemm g{H, (const u16*)(wsp + WS_WUP4), M_TOK, N_UP, D_MODEL, (size_t)N_UP * D_MODEL * 2}; pg8::StaticOrder S; S.init(M_TOK, N_UP, F.G, (int)blockIdx.x);
        LAS float* R2ALL = (LAS float*)(F.lds + XB_OFF + 8192); LAS float* CT = (LAS float*)(F.lds + XB_OFF + 8192 + 12 * 1024);
        { const float* SSQX = (const float*)(wsp + WS_SSQX);
          for (int i = 0; i < 12; ++i) { pg8::Unit uu; if (!S.next(i, uu)) break;
              if (F.tid < 256) { const size_t row = (size_t)uu.pm * 256 + F.tid;
                  const f32x4 s0 = *(const f32x4*)(SSQX + row * 16), s1 = *(const f32x4*)(SSQX + row * 16 + 4), s2 = *(const f32x4*)(SSQX + row * 16 + 8), s3 = *(const f32x4*)(SSQX + row * 16 + 12);
                  const float ss = (((s0[0] + s0[1]) + (s0[2] + s0[3])) + ((s1[0] + s1[1]) + (s1[2] + s1[3]))) + (((s2[0] + s2[1]) + (s2[2] + s2[3])) + ((s3[0] + s3[1]) + (s3[2] + s3[3])));
                  R2ALL[i * 256 + F.tid] = 1.0f / sqrtf(ss * (1.0f / D_MODEL) + EPS); } }
          __syncthreads(); }
        pg8::EpiFFN E{(u16*)(wsp + WS_ACT), (float*)(wsp + WS_RAW), F.ffn_conv_w(), (const float*)(wsp + WS_CB2), (LAS float*)(F.lds + XB_OFF), (const float*)(wsp + WS_SSQX), (const float*)(wsp + WS_BIAS2), R2ALL, CT};
        REP(8) pg8::gemm_phase<pg8::EpiFFN, pg8::StaticOrder, true, true, false>(F.lds, g, S, E, F.wave0);
        SEAM(8);
    }
    TP_B(8);
    TP_A(9);
    if (IN(9)) { unsigned char* wsp = F.ws; asm volatile("" : "+s"(wsp)); { int t_ = F.wave0 * 64 + lane_id(); asm volatile("" : "+v"(t_)); F.tid = t_; F.lane = t_ & 63; F.wave = __builtin_amdgcn_readfirstlane(t_ >> 6); }
        pg8::Gemm g{(const u16*)(wsp + WS_ACT), (const u16*)(wsp + WS_WDN), M_TOK, D_MODEL, D_FF, 0}; pg8::StaticOrder S; S.init(M_TOK, D_MODEL, F.G, (int)blockIdx.x);
        { pg8::Unit u0, u1; int pm0 = -1; if (S.next(0, u0)) { pm0 = u0.pm; ffn_fixup(F, wsp, pm0); } if (S.next(1, u1) && u1.pm != pm0) ffn_fixup(F, wsp, u1.pm);
          for (int i = 2; ; ++i) { pg8::Unit ux; if (!S.next(i, ux)) break; ffn_fixup(F, wsp, ux.pm); }
          asm volatile("s_waitcnt vmcnt(0)" ::: "memory"); __syncthreads(); }
        pg8::EpiResidB E{H, F.out, MOD + 5120};
        REP(9) pg8::gemm_phase<pg8::EpiResidB, pg8::StaticOrder, true, true, false>(F.lds, g, S, E, F.wave0);
    }
    TP_B(9);
    if (PROBE_PH >= 0 && blockIdx.x == 0) { const unsigned long long t0 = __builtin_amdgcn_s_memrealtime(); const unsigned long long want = 4ull * (tpb - tpa);
        while (__builtin_amdgcn_s_memrealtime() - t0 < want) __builtin_amdgcn_s_sleep(8); }
    if (hi - lo > 1 && hi == N_PHASES) {
        if (xb_ld(ctl + CW_BAR + XB_TMO) != 0u) { asm volatile("s_waitcnt vmcnt(0)" ::: "memory"); __syncthreads();
            for (size_t i = (size_t)blockIdx.x * NT + F.tid; i < (size_t)M_TOK * D_MODEL; i += (size_t)F.G * NT) F.out[i] = __builtin_nanf(""); }
    }
#undef IN
#undef MOD
#undef H
#undef SEAM
}

#ifndef MK_PER_PHASE
#define MK_PER_PHASE 0
#endif
extern "C" void kernel_launch(void* const* d_in, const int* in_sizes, int n_in, void* d_out, int out_size, void* d_ws, size_t ws_size, hipStream_t stream) {
    static int grid = 0;
    if (grid == 0) {
        if (n_in != 23 || in_sizes[0] != M_TOK * D_MODEL || out_size != M_TOK * D_MODEL || ws_size < WS_END) {
            fprintf(stderr, "kernel_launch: unexpected shapes (n_in %d, in0 %d, out %d, ws %zu); nothing launched\n", n_in, n_in > 0 ? in_sizes[0] : -1, out_size, ws_size); grid = -1; return; }
        int dev = 0, cus = 0;
        if (hipGetDevice(&dev) != hipSuccess || hipDeviceGetAttribute(&cus, hipDeviceAttributeMultiprocessorCount, dev) != hipSuccess) { grid = -1; return; }
        if (hipFuncSetAttribute((const void*)hymba_fwd, hipFuncAttributeMaxDynamicSharedMemorySize, LDS_BYTES) != hipSuccess) { fprintf(stderr, "kernel_launch: hipFuncSetAttribute failed\n"); grid = -1; return; }
        grid = cus;
    }
    if (grid < 0) return;
    (void)hipMemsetAsync((char*)d_ws + WS_CTL, 0, CTL_ZERO_BYTES, stream);
    Args a{};
    for (int i = 0; i < 23; ++i) a.in[i] = (const float*)d_in[i];
    a.out = (float*)d_out; a.ws = (unsigned char*)d_ws;
#if MK_PER_PHASE
    for (int p = 0; p < N_PHASES; ++p) { a.ph_lo = p; a.ph_hi = p + 1; hipLaunchKernelGGL(hymba_fwd, dim3(grid), dim3(NT), LDS_BYTES, stream, a); }
#else
    a.ph_lo = 0; a.ph_hi = N_PHASES; hipLaunchKernelGGL(hymba_fwd, dim3(grid), dim3(NT), LDS_BYTES, stream, a);
#endif
}
```

```cpp
#include <hip/hip_runtime.h>
#include <cstdio>
#include <cstdint>

#define GAS __attribute__((address_space(1)))
#define LAS __attribute__((address_space(3)))
typedef unsigned short u16;
typedef short s16x8 __attribute__((ext_vector_type(8)));
typedef _Float16 f16x8 __attribute__((ext_vector_type(8)));
typedef __bf16 bf16x8_t __attribute__((ext_vector_type(8)));
typedef float f32x2 __attribute__((ext_vector_type(2)));
typedef float f32x4 __attribute__((ext_vector_type(4)));
typedef float f32x16 __attribute__((ext_vector_type(16)));
typedef unsigned u32x4 __attribute__((ext_vector_type(4)));
typedef unsigned u32x2 __attribute__((ext_vector_type(2)));
typedef GAS unsigned gu32;
#define RLX_AGENT __ATOMIC_RELAXED, __HIP_MEMORY_SCOPE_AGENT

constexpr int D_MODEL = 1024, BATCH = 4, SEQ = 8192, M_TOK = BATCH * SEQ;
constexpr int N_IN = 2560, D_FF = 2816, N_UP = 2 * D_FF, N_MOD = 6 * D_MODEL;
constexpr int NHEAD = 8, HD = 64, AW = 512, NBLK = 32, BLK = 256;
constexpr float EPS = 1e-6f;
constexpr float LOG2E = 1.4426950408889634f;

__device__ __forceinline__ unsigned cvt_pk_bf16(float lo, float hi) { unsigned r; asm volatile("v_cvt_pk_bf16_f32 %0, %1, %2" : "=v"(r) : "v"(lo), "v"(hi)); return r; }
__device__ __forceinline__ unsigned cvt_pk_f16(float lo, float hi) {
    const _Float16 a = (_Float16)lo, b = (_Float16)hi;
    return (unsigned)__builtin_bit_cast(unsigned short, a) | ((unsigned)__builtin_bit_cast(unsigned short, b) << 16);
}
__device__ __forceinline__ float bf_lo(unsigned w) { return __builtin_bit_cast(float, w << 16); }
__device__ __forceinline__ float bf_hi(unsigned w) { return __builtin_bit_cast(float, w & 0xffff0000u); }
__device__ __forceinline__ float sigmoidf_(float v) { return __builtin_amdgcn_rcpf(1.0f + __builtin_amdgcn_exp2f(-v * LOG2E)); }
__device__ __forceinline__ float gelu_tanh(float v) { const float y = 0.7978845608028654f * (v + 0.044715f * v * v * v); return v * sigmoidf_(2.0f * y); }
__device__ __forceinline__ float wave_sum(float v) {
#pragma unroll
    for (int o = 1; o < 64; o <<= 1) v += __shfl_xor(v, o);
    return v;
}

__device__ __forceinline__ int lane_id() { int l; asm volatile("v_mbcnt_lo_u32_b32 %0, -1, 0\n\tv_mbcnt_hi_u32_b32 %0, -1, %0" : "=v"(l)); return l; }

namespace pg8 {
constexpr int BM = 256, BK = 64, HALF = 128, HTB = HALF * BK * 2, STAGE_BYTES = 8 * HTB, NXCD = 8, WGM = 8;
__host__ __device__ __forceinline__ int lds_byte(int r, int c) { const int st = (r >> 4) * 2 + (c >> 5), rr = r & 15, cc = c & 31, ob = rr * 64 + cc * 2; return st * 1024 + (ob ^ (((ob >> 9) & 1) << 5)); }
__host__ __device__ __forceinline__ void stage_rc(int b, int& R, int& C) { const int st = b / 1024, sb = b % 1024, swz = sb ^ (((sb >> 9) & 1) << 5); R = (st >> 1) * 16 + swz / 64; C = (st & 1) * 32 + (swz % 64) / 2; }
__host__ __device__ __forceinline__ int perm32(int rho) { const int n = rho >> 4, i = rho & 15; return 8 * (i >> 2) + 4 * n + (i & 3); }

struct Unit { int pm, pn, ord; };
struct Gemm { const u16* A; const u16* Bt; int M, N, K; size_t bstride; };

struct StaticOrder {
    int nM, nN, nwg, G, c;
    __host__ __device__ __forceinline__ void init(int M, int N, int G_, int c_) { nM = M / BM; nN = N / BM; nwg = nM * nN; G = G_; c = c_; }
    __host__ __device__ __forceinline__ bool next(int i, Unit& u) const {
        const long L = (long)i * G + c; if (L >= nwg) return false;
        int wgid = (int)L; { const int q = nwg / NXCD, r = nwg % NXCD, xcd = wgid % NXCD, off = wgid / NXCD; wgid = (xcd < r ? xcd * (q + 1) : r * (q + 1) + (xcd - r) * q) + off; }
        const int nig = WGM * nN, gid = wgid / nig, fm = gid * WGM, gsz = (nM - fm) < WGM ? (nM - fm) : WGM;
        u.pm = fm + ((wgid % nig) % gsz); u.pn = (wgid % nig) / gsz; u.ord = i; return true;
    }
    __device__ __forceinline__ void a_ready(const Unit&) const {}
    __device__ __forceinline__ void done(const Unit&) const {}
};

template <bool F16> __device__ __forceinline__ f32x4 mfma16(s16x8 a, s16x8 b, f32x4 c) {
    if constexpr (F16) return __builtin_amdgcn_mfma_f32_16x16x32_f16(__builtin_bit_cast(f16x8, a), __builtin_bit_cast(f16x8, b), c, 0, 0, 0);
    else return __builtin_amdgcn_mfma_f32_16x16x32_bf16(__builtin_bit_cast(bf16x8_t, a), __builtin_bit_cast(bf16x8_t, b), c, 0, 0, 0);
}

template <class Epi, class Sched, bool ALIGN_EPI, bool SP2, bool F16>
__device__ __forceinline__ void gemm_phase(LAS unsigned char* lds, const Gemm g, const Sched& S, const Epi& E, int wave0) {
    int tid_ = wave0 * 64 + lane_id(); asm volatile("" : "+v"(tid_));
    const int tid = tid_, wid = __builtin_amdgcn_readfirstlane(tid >> 6), lane = tid & 63, wr = wid >> 2, wc = wid & 3, fr = lane & 15, fq = lane >> 4;
    const int K = g.K, nt = K / BK;
    unsigned voffA, voffB;
    { int R, C; stage_rc(tid * 16, R, C); const int Rb = Epi::PERM ? ((R & ~31) + perm32(R & 31)) : R;
        const int Ra = Epi::APERM ? ((R & ~63) + 4 * (R & 15) + ((R >> 4) & 3)) : R;
        voffA = (unsigned)(Ra * K + C) * 2u; voffB = (unsigned)(Rb * K + C) * 2u; }
    const unsigned rstep64 = (unsigned)(64 * K * 2);
    const size_t kstep = (size_t)(BK * 2);
    const size_t hstep = (size_t)HALF * K * 2;
    const size_t tstep = 2 * hstep;
    const unsigned ldsw = (unsigned)wid * 1024u;
    const int aoff = lds_byte(wr * 64 + fr, fq * 8), boff = lds_byte(wc * 32 + fr, fq * 8);
#define PG8_SA(b, h) (((b) * 2 + (h)) * HTB)
#define PG8_SB(b, h) ((4 + (b) * 2 + (h)) * HTB)
#define PG8_STAGE(bufoff, gbase, voff) do { _Pragma("unroll") for (int _i = 0; _i < 2; ++_i) \
        __builtin_amdgcn_global_load_lds((const unsigned*)((const char*)(gbase) + _i * rstep64 + (voff)), (LAS unsigned*)(lds + (bufoff) + ldsw + _i * 8192), 16, 0, 0); } while (0)
#define PG8_LDA(dst, b, h) do { _Pragma("unroll") for (int m = 0; m < 4; ++m) _Pragma("unroll") for (int k = 0; k < 2; ++k) dst[m][k] = *(const LAS s16x8*)(lds + PG8_SA(b, h) + aoff + m * 2048 + k * 1024); } while (0)
#define PG8_LDB(dst, b, h) do { _Pragma("unroll") for (int n = 0; n < 2; ++n) _Pragma("unroll") for (int k = 0; k < 2; ++k) dst[n][k] = *(const LAS s16x8*)(lds + PG8_SB(b, h) + boff + n * 2048 + k * 1024); } while (0)
#define PG8_MMA(ai, bj, At, Bt) do { __builtin_amdgcn_s_setprio(1); _Pragma("unroll") for (int m = 0; m < 4; ++m) _Pragma("unroll") for (int n = 0; n < 2; ++n) _Pragma("unroll") for (int k = 0; k < 2; ++k) \
        acc[ai][bj][m][n] = mfma16<F16>(Bt[n][k], At[m][k], acc[ai][bj][m][n]); __builtin_amdgcn_s_setprio(0); } while (0)
#define PG8_WAIT_V(n) asm volatile("s_waitcnt vmcnt(" #n ")" ::: "memory")
#define PG8_WAIT_L(n) asm volatile("s_waitcnt lgkmcnt(" #n ")" ::: "memory")
#define PG8_BAR __builtin_amdgcn_s_barrier()
#define PG8_SCHED __builtin_amdgcn_sched_barrier(0)
    Unit cur, nxt; int ui = 0;
    if (!S.next(0, cur)) return;
    f32x4 acc[2][2][4][2];
#pragma unroll
    for (int a = 0; a < 2; ++a)
#pragma unroll
        for (int b = 0; b < 2; ++b)
#pragma unroll
            for (int m = 0; m < 4; ++m)
#pragma unroll
                for (int n = 0; n < 2; ++n) acc[a][b][m][n] = (f32x4){0.f, 0.f, 0.f, 0.f};
    s16x8 At[4][2], B0[2][2], B1[2][2];
    const char* cA = (const char*)g.A + (size_t)cur.pm * tstep; const char* cB = (const char*)g.Bt + (size_t)cur.pn * tstep + (size_t)(cur.pm >> 5) * g.bstride;
    S.a_ready(cur);
    if constexpr (SP2) {
        PG8_STAGE(PG8_SB(0, 0), cB, voffB); PG8_STAGE(PG8_SB(0, 1), cB + hstep, voffB); PG8_STAGE(PG8_SA(0, 0), cA, voffA); PG8_STAGE(PG8_SA(0, 1), cA + hstep, voffA);
        if (wr == 1) PG8_BAR;
        PG8_WAIT_V(2); PG8_BAR;
        PG8_STAGE(PG8_SB(1, 0), cB + kstep, voffB); PG8_STAGE(PG8_SA(1, 0), cA + kstep, voffA); PG8_STAGE(PG8_SB(1, 1), cB + hstep + kstep, voffB);
        PG8_WAIT_V(6); PG8_BAR;
    } else {
        PG8_STAGE(PG8_SB(0, 0), cB, voffB); PG8_STAGE(PG8_SA(0, 0), cA, voffA); PG8_STAGE(PG8_SB(0, 1), cB + hstep, voffB); PG8_STAGE(PG8_SA(0, 1), cA + hstep, voffA);
        if (wr == 1) PG8_BAR;
        PG8_WAIT_V(4); PG8_BAR;
        PG8_STAGE(PG8_SB(1, 0), cB + kstep, voffB); PG8_STAGE(PG8_SA(1, 0), cA + kstep, voffA); PG8_STAGE(PG8_SB(1, 1), cB + hstep + kstep, voffB);
        PG8_WAIT_V(6); PG8_BAR;
    }
    for (;;) {
        const bool has_next = S.next(ui + 1, nxt);
        const char* nA = has_next ? (const char*)g.A + (size_t)nxt.pm * tstep : cA; const char* nB = has_next ? (const char*)g.Bt + (size_t)nxt.pn * tstep + (size_t)(nxt.pm >> 5) * g.bstride : cB;
        for (int t = 0; t < nt; t += 2) {
            const bool last = (t == nt - 2);
            const char* a1 = cA + (size_t)(t + 1) * kstep;
            const char* a2 = last ? nA : cA + (size_t)(t + 2) * kstep; const char* b2 = last ? nB : cB + (size_t)(t + 2) * kstep;
            const char* a3 = a2 + kstep; const char* b3 = b2 + kstep;
            if (last && has_next) S.a_ready(nxt);
            if constexpr (Epi::MIDK) { if (t == nt / 2) E.midk(acc, cur, wr, fr); }
            if constexpr (SP2) {
            PG8_LDB(B0, 0, 0); PG8_LDB(B1, 0, 1); PG8_SCHED; PG8_LDA(At, 0, 0); PG8_STAGE(PG8_SA(1, 1), a1 + hstep, voffA);
            PG8_WAIT_V(8); PG8_WAIT_L(0); PG8_BAR; PG8_MMA(0, 0, At, B0); PG8_MMA(0, 1, At, B1); PG8_BAR; PG8_SCHED;
            PG8_LDA(At, 0, 1); PG8_STAGE(PG8_SB(0, 0), b2, voffB); PG8_STAGE(PG8_SB(0, 1), b2 + hstep, voffB); PG8_STAGE(PG8_SA(0, 0), a2, voffA);
            PG8_WAIT_V(8); PG8_WAIT_L(0); PG8_BAR; PG8_MMA(1, 0, At, B0); PG8_MMA(1, 1, At, B1); PG8_BAR; PG8_SCHED;
            PG8_LDB(B0, 1, 0); PG8_LDB(B1, 1, 1); PG8_SCHED; PG8_LDA(At, 1, 0); PG8_STAGE(PG8_SA(0, 1), a2 + hstep, voffA);
            PG8_WAIT_V(8); PG8_WAIT_L(0); PG8_BAR; PG8_MMA(0, 0, At, B0); PG8_MMA(0, 1, At, B1); PG8_BAR; PG8_SCHED;
            PG8_LDA(At, 1, 1); PG8_STAGE(PG8_SB(1, 0), b3, voffB); PG8_STAGE(PG8_SB(1, 1), b3 + hstep, voffB); PG8_STAGE(PG8_SA(1, 0), a3, voffA);
            PG8_WAIT_V(8); PG8_WAIT_L(0); PG8_BAR; PG8_MMA(1, 0, At, B0); PG8_MMA(1, 1, At, B1); PG8_BAR; PG8_SCHED;
            } else {
            PG8_LDB(B0, 0, 0); PG8_SCHED; PG8_LDA(At, 0, 0); PG8_STAGE(PG8_SA(1, 1), a1 + hstep, voffA);
            PG8_WAIT_L(8); PG8_BAR; PG8_WAIT_L(0); PG8_MMA(0, 0, At, B0); PG8_BAR; PG8_SCHED;
            PG8_LDB(B1, 0, 1); PG8_STAGE(PG8_SB(0, 0), b2, voffB);
            PG8_BAR; PG8_WAIT_L(0); PG8_MMA(0, 1, At, B1); PG8_BAR;
            PG8_LDA(At, 0, 1); PG8_STAGE(PG8_SA(0, 0), a2, voffA);
            PG8_BAR; PG8_WAIT_L(0); PG8_MMA(1, 0, At, B0); PG8_BAR; PG8_SCHED;
            PG8_STAGE(PG8_SB(0, 1), b2 + hstep, voffB);
            PG8_WAIT_V(6); PG8_BAR; PG8_MMA(1, 1, At, B1); PG8_BAR;
            PG8_LDB(B0, 1, 0); PG8_SCHED; PG8_LDA(At, 1, 0); PG8_STAGE(PG8_SA(0, 1), a2 + hstep, voffA);
            PG8_WAIT_L(8); PG8_BAR; PG8_WAIT_L(0); PG8_MMA(0, 0, At, B0); PG8_BAR; PG8_SCHED;
            PG8_LDB(B1, 1, 1); PG8_STAGE(PG8_SB(1, 0), b3, voffB);
            PG8_BAR; PG8_WAIT_L(0); PG8_MMA(0, 1, At, B1); PG8_BAR;
            PG8_LDA(At, 1, 1); PG8_STAGE(PG8_SA(1, 0), a3, voffA);
            PG8_BAR; PG8_WAIT_L(0); PG8_MMA(1, 0, At, B0); PG8_BAR; PG8_SCHED;
            PG8_STAGE(PG8_SB(1, 1), b3 + hstep, voffB);
            PG8_WAIT_V(6); PG8_BAR; PG8_MMA(1, 1, At, B1); PG8_BAR;
            }
        }
        if constexpr (ALIGN_EPI) { if (wr == 0) PG8_BAR; }
        E(acc, cur, wr, wc, fr, fq); S.done(cur);
        if (!has_next) break;
#pragma unroll
        for (int a = 0; a < 2; ++a)
#pragma unroll
            for (int b = 0; b < 2; ++b)
#pragma unroll
                for (int m = 0; m < 4; ++m)
#pragma unroll
                    for (int n = 0; n < 2; ++n) acc[a][b][m][n] = (f32x4){0.f, 0.f, 0.f, 0.f};
        cur = nxt; cA = nA; cB = nB; ++ui;
        if constexpr (ALIGN_EPI) { if (wr == 1) PG8_BAR; }
    }
    PG8_WAIT_V(0);
    if constexpr (!ALIGN_EPI) { if (wr == 0) PG8_BAR; }
    PG8_BAR;
#undef PG8_SA
#undef PG8_SB
#undef PG8_STAGE
#undef PG8_LDA
#undef PG8_LDB
#undef PG8_MMA
#undef PG8_WAIT_V
#undef PG8_WAIT_L
#undef PG8_BAR
#undef PG8_SCHED
}

struct EpiBf16 {
    static constexpr bool PERM = true, MIDK = false, APERM = false;
    u16* O; int ldc;
    __device__ __forceinline__ void operator()(const f32x4 (&acc)[2][2][4][2], const Unit& u, int wr, int wc, int fr, int fq) const {
        const int row0 = u.pm * BM + wr * 64 + fr; const int col0 = u.pn * BM + wc * 32 + 8 * fq;
#pragma unroll
        for (int ai = 0; ai < 2; ++ai)
#pragma unroll
            for (int m = 0; m < 4; ++m) { u16* rowp = O + (size_t)(row0 + ai * HALF + m * 16) * ldc + col0;
#pragma unroll
                for (int bj = 0; bj < 2; ++bj) { const f32x4 v0 = acc[ai][bj][m][0], v1 = acc[ai][bj][m][1];
                    u32x4 w; w.x = cvt_pk_bf16(v0[0], v0[1]); w.y = cvt_pk_bf16(v0[2], v0[3]); w.z = cvt_pk_bf16(v1[0], v1[1]); w.w = cvt_pk_bf16(v1[2], v1[3]);
                    *(u32x4*)(rowp + bj * HALF) = w; } }
    }
};
struct EpiResid {
    static constexpr bool PERM = false, MIDK = false, APERM = false;
    const float* base; float* out; const float* gate;
    __device__ __forceinline__ void operator()(const f32x4 (&acc)[2][2][4][2], const Unit& u, int wr, int wc, int fr, int fq) const {
        const int row0 = u.pm * BM + wr * 64 + fr, col0 = u.pn * BM + wc * 32 + 4 * fq;
        const int b = (u.pm * BM) / SEQ;
        f32x4 gv[2][2];
#pragma unroll
        for (int bj = 0; bj < 2; ++bj)
#pragma unroll
            for (int n = 0; n < 2; ++n) gv[bj][n] = *(const f32x4*)(gate + (size_t)b * N_MOD + col0 + bj * HALF + n * 16);
#pragma unroll
        for (int ai = 0; ai < 2; ++ai)
#pragma unroll
            for (int m = 0; m < 4; ++m) { const size_t off = (size_t)(row0 + ai * HALF + m * 16) * D_MODEL + col0;
#pragma unroll
                for (int bj = 0; bj < 2; ++bj)
#pragma unroll
                    for (int n = 0; n < 2; ++n) { const f32x4 bs = *(const f32x4*)(base + off + bj * HALF + n * 16);
                        *(f32x4*)(out + off + bj * HALF + n * 16) = bs + gv[bj][n] * acc[ai][bj][m][n]; } }
    }
};
struct EpiInProj {
    static constexpr bool PERM = true, MIDK = false, APERM = false;
    float* QF; u16* KB; u16* VT; u16* XR; u16* GG; float* KM; const float* gq; const float* gk;
    __device__ __forceinline__ void operator()(const f32x4 (&acc)[2][2][4][2], const Unit& u, int wr, int wc, int fr, int fq) const {
        const int type = u.pn >> 1, head = (u.pn & 1) * 4 + wc;
        const int b = (u.pm * BM) / SEQ, blk = u.pm % NBLK;
        const int tok0 = u.pm * BM + wr * 64 + fr;
        const int bh = b * NHEAD + head;
        if (type <= 1) {
            const float* gp = type == 0 ? gq : gk;
            f32x4 gv[2][2];
#pragma unroll
            for (int bj = 0; bj < 2; ++bj)
#pragma unroll
                for (int n = 0; n < 2; ++n) gv[bj][n] = *(const f32x4*)(gp + 32 * bj + 8 * fq + 4 * n);
            f32x4 cs[2][2];
#pragma unroll
            for (int bj = 0; bj < 2; ++bj)
#pragma unroll
                for (int n = 0; n < 2; ++n) cs[bj][n] = (f32x4){0.f, 0.f, 0.f, 0.f};
#pragma unroll
            for (int ai = 0; ai < 2; ++ai)
#pragma unroll
                for (int m = 0; m < 4; ++m) {
                    float ss = 0.f;
#pragma unroll
                    for (int bj = 0; bj < 2; ++bj)
#pragma unroll
                        for (int n = 0; n < 2; ++n) { const f32x4 x = acc[ai][bj][m][n]; ss += (x[0] * x[0] + x[1] * x[1]) + (x[2] * x[2] + x[3] * x[3]); }
                    ss += __shfl_xor(ss, 16); ss += __shfl_xor(ss, 32);
                    const float rstd = 1.0f / sqrtf(ss * (1.0f / 64.0f) + EPS);
                    const int tok = tok0 + ai * HALF + m * 16, s = tok % SEQ;
                    const size_t rowoff = ((size_t)bh * SEQ + s) * HD + 8 * fq;
#pragma unroll
                    for (int bj = 0; bj < 2; ++bj) {
                        const f32x4 v0 = acc[ai][bj][m][0] * rstd * gv[bj][0], v1 = acc[ai][bj][m][1] * rstd * gv[bj][1];
                        if (type == 0) { *(f32x4*)(QF + rowoff + 32 * bj) = v0; *(f32x4*)(QF + rowoff + 32 * bj + 4) = v1; }
                        else { u32x4 w; w.x = cvt_pk_bf16(v0[0], v0[1]); w.y = cvt_pk_bf16(v0[2], v0[3]); w.z = cvt_pk_bf16(v1[0], v1[1]); w.w = cvt_pk_bf16(v1[2], v1[3]);
                            const int kw = s & 255, c8 = 4 * bj + fq;
                            *(u32x4*)(KB + ((size_t)bh * NBLK + blk) * (BLK * HD) + ((((kw >> 5) * 4 + (c8 >> 1)) * 2 + (c8 & 1)) * 32 + (kw & 31)) * 8) = w; cs[bj][0] += v0; cs[bj][1] += v1; }
                    }
                }
            if (type == 1) {
#pragma unroll
                for (int bj = 0; bj < 2; ++bj)
#pragma unroll
                    for (int n = 0; n < 2; ++n)
#pragma unroll
                        for (int i = 0; i < 4; ++i) { float v = cs[bj][n][i]; v += __shfl_xor(v, 1); v += __shfl_xor(v, 2); v += __shfl_xor(v, 4); v += __shfl_xor(v, 8);
                            if (fr == 0) atomicAdd(KM + (((size_t)(b * NBLK + blk) * NHEAD + head) * HD + 32 * bj + 8 * fq + 4 * n + i), v); }
            }
        } else if (type == 2) {
            const int hip = (fr >> 2) & 1, ep = 4 * (fr >> 3) + (fr & 3);
#pragma unroll
            for (int ai = 0; ai < 2; ++ai)
#pragma unroll
                for (int m = 0; m < 4; ++m) { const int kw = ai * HALF + wr * 64 + m * 16 + fr;
#pragma unroll
                    for (int bj = 0; bj < 2; ++bj)
#pragma unroll
                        for (int n = 0; n < 2; ++n) { const f32x4 x = acc[ai][bj][m][n]; const unsigned w0 = cvt_pk_bf16(x[0], x[1]), w1 = cvt_pk_bf16(x[2], x[3]);
                            u16* dst = VT + ((size_t)bh * NBLK + blk) * (BLK * HD) + (((((kw >> 5) * 2 + ((kw >> 4) & 1)) * 2 + bj) * 2 + hip) * 32 + 8 * fq + 4 * n) * 8 + ep;
                            dst[0] = (u16)(w0 & 0xffffu); dst[8] = (u16)(w0 >> 16); dst[16] = (u16)(w1 & 0xffffu); dst[24] = (u16)(w1 >> 16); } }
        } else {
            u16* O = type == 3 ? XR : GG;
#pragma unroll
            for (int ai = 0; ai < 2; ++ai)
#pragma unroll
                for (int m = 0; m < 4; ++m) { const int tok = tok0 + ai * HALF + m * 16, sq = tok % SEQ;
                    u16* tilep = O + ((((size_t)b * (SEQ / 32) + (sq >> 5)) * NHEAD + head) * 2048) + (sq & 31) * 8;
#pragma unroll
                    for (int bj = 0; bj < 2; ++bj) { f32x4 v0 = acc[ai][bj][m][0], v1 = acc[ai][bj][m][1];
                        if (type == 4) {
#pragma unroll
                            for (int i = 0; i < 4; ++i) { v0[i] = gelu_tanh(v0[i]); v1[i] = gelu_tanh(v1[i]); } }
                        u32x4 w; w.x = cvt_pk_bf16(v0[0], v0[1]); w.y = cvt_pk_bf16(v0[2], v0[3]); w.z = cvt_pk_bf16(v1[0], v1[1]); w.w = cvt_pk_bf16(v1[2], v1[3]);
                        *(u32x4*)(tilep + (4 * bj + fq) * 256) = w; } }
        }
    }
};

__device__ __forceinline__ float dpp_f(float old, float x, int ctrl) {
    return 0.f; }
#define DPPF(old, x, ctrl) __builtin_bit_cast(float, __builtin_amdgcn_update_dpp(__builtin_bit_cast(int, (float)(old)), __builtin_bit_cast(int, (float)(x)), (ctrl), 0xf, 0xf, false))
struct EpiFFN {
    static constexpr bool PERM = true, MIDK = false, APERM = true;
    u16* ACT; float* RAW; const float* cw; const float* CB2; LAS float* XB; const float* SSQX; const float* BIAS2; const LAS float* R2ALL; LAS float* CT;
    __device__ __forceinline__ void operator()(const f32x4 (&acc)[2][2][4][2], const Unit& u, int wr, int wc, int fr_, int fq_) const {
        int fr = fr_, fq = fq_; asm volatile("" : "+v"(fr), "+v"(fq));
        const int f0 = u.pn * 128 + wc * 32 + 8 * fq;
        const int b = (u.pm * BM) / SEQ;
        const LAS float* R2S = R2ALL + u.ord * 256;
        { const int t = (wr * 4 + wc) * 64 + fq * 16 + fr;
          if (t < 256) { const int q = t >> 5, c4 = t & 31; const int f = u.pn * 128 + 4 * c4;
              const float* src = ((q & 3) == 3) ? (CB2 + (size_t)b * N_UP + (q >> 2) * D_FF + f) : (cw + (size_t)(q & 3) * N_UP + (q >> 2) * D_FF + f);
              const f32x4 v = *(const f32x4*)src; *(LAS f32x4*)(CT + q * 128 + 4 * c4) = v; } }
#define BBP(kc, bj, n) (*(const f32x4*)(BIAS2 + ((size_t)(kc) * BATCH + b) * N_UP + (bj) * D_FF + f0 + 4 * (n)))
#define BBV(bj, n) ((BBP(0, bj, n) + BBP(1, bj, n)) + (BBP(2, bj, n) + BBP(3, bj, n)))
        const f32x4 r2a = *(const LAS f32x4*)(R2S + wr * 64 + 4 * fr), r2b = *(const LAS f32x4*)(R2S + HALF + wr * 64 + 4 * fr);
        if (fr == 15) {
#pragma unroll
            for (int ai = 0; ai < 2; ++ai)
#pragma unroll
                for (int rr = 0; rr < 2; ++rr)
#pragma unroll
                    for (int bj = 0; bj < 2; ++bj)
#pragma unroll
                        for (int n = 0; n < 2; ++n) *(LAS f32x4*)(XB + (((((ai * 2 + wr) * 4 + wc) * 2 + rr) * 4 + fq) * 16 + (bj * 2 + n) * 4)) = acc[ai][bj][2 + rr][n] * (ai ? r2b[2 + rr] : r2a[2 + rr]);
        }
        if (wr == 1 && fr == 15) {
#pragma unroll
            for (int rr = 0; rr < 2; ++rr)
#pragma unroll
                for (int bj = 0; bj < 2; ++bj)
#pragma unroll
                    for (int n = 0; n < 2; ++n) *(f32x4*)(RAW + ((size_t)u.pm * 4 + 2 + rr) * N_UP + bj * D_FF + f0 + 4 * n) = acc[1][bj][2 + rr][n] * r2b[2 + rr] + BBV(bj, n);
        }
        if (wr == 0 && fr == 0) {
#pragma unroll
            for (int rr = 0; rr < 2; ++rr)
#pragma unroll
                for (int bj = 0; bj < 2; ++bj)
#pragma unroll
                    for (int n = 0; n < 2; ++n) *(f32x4*)(RAW + ((size_t)u.pm * 4 + rr) * N_UP + bj * D_FF + f0 + 4 * n) = acc[0][bj][rr][n] * r2a[rr] + BBV(bj, n);
        }
        asm volatile("s_waitcnt vmcnt(0) lgkmcnt(0)" ::: "memory"); __builtin_amdgcn_s_barrier(); asm volatile("" ::: "memory");
#pragma unroll
        for (int n = 0; n < 2; ++n) {
            const int cl = wc * 32 + 8 * fq + 4 * n;
            const f32x4 wg0 = *(const LAS f32x4*)(CT + 0 * 128 + cl), wg1 = *(const LAS f32x4*)(CT + 1 * 128 + cl), wg2 = *(const LAS f32x4*)(CT + 2 * 128 + cl);
            const f32x4 wv0 = *(const LAS f32x4*)(CT + 4 * 128 + cl), wv1 = *(const LAS f32x4*)(CT + 5 * 128 + cl), wv2 = *(const LAS f32x4*)(CT + 6 * 128 + cl);
            const f32x4 bg = *(const LAS f32x4*)(CT + 3 * 128 + cl), bv = *(const LAS f32x4*)(CT + 7 * 128 + cl);
#pragma unroll
            for (int ai = 0; ai < 2; ++ai) {
                const f32x4 r2v = ai ? r2b : r2a;
                const bool hasprev = (wr == 1) || (ai == 1);
                const int src = (wr == 1) ? (ai * 2 + 0) : ((ai - 1) * 2 + 1);
                f32x4 t1g = (f32x4){0.f, 0.f, 0.f, 0.f}, t2g = t1g, t1v = t1g, t2v = t1g;
                if (hasprev) {
                    const LAS float* xb1 = XB + ((((src * 4 + wc) * 2 + 1) * 4 + fq) * 16), * xb2 = XB + ((((src * 4 + wc) * 2 + 0) * 4 + fq) * 16);
                    t1g = *(const LAS f32x4*)(xb1 + (0 * 2 + n) * 4); t1v = *(const LAS f32x4*)(xb1 + (1 * 2 + n) * 4);
                    t2g = *(const LAS f32x4*)(xb2 + (0 * 2 + n) * 4); t2v = *(const LAS f32x4*)(xb2 + (1 * 2 + n) * 4);
                }
                f32x4 xg[4], xv[4];
#pragma unroll
                for (int m = 0; m < 4; ++m) { xg[m] = acc[ai][0][m][n] * r2v[m]; xv[m] = acc[ai][1][m][n] * r2v[m]; }
                f32x4 pg3, pg2, pv3, pv2;
#pragma unroll
                for (int i = 0; i < 4; ++i) { pg3[i] = DPPF(t1g[i], xg[3][i], 0x111); pg2[i] = DPPF(t2g[i], xg[2][i], 0x111); pv3[i] = DPPF(t1v[i], xv[3][i], 0x111); pv2[i] = DPPF(t2v[i], xv[2][i], 0x111); }
#pragma unroll
                for (int m = 0; m < 4; ++m) {
                    const f32x4 g1 = m == 0 ? pg3 : xg[m > 0 ? m - 1 : 0], g2 = m == 0 ? pg2 : (m == 1 ? pg3 : xg[m > 1 ? m - 2 : 0]);
                    const f32x4 v1 = m == 0 ? pv3 : xv[m > 0 ? m - 1 : 0], v2 = m == 0 ? pv2 : (m == 1 ? pv3 : xv[m > 1 ? m - 2 : 0]);
                    const f32x4 cg = ((wg0 * g2 + wg1 * g1) + wg2 * xg[m]) + bg, cv = ((wv0 * v2 + wv1 * v1) + wv2 * xv[m]) + bv;
                    const f32x4 ex = cg * (-LOG2E);
                    f32x4 sg; sg[0] = __builtin_amdgcn_rcpf(1.0f + __builtin_amdgcn_exp2f(ex[0])); sg[1] = __builtin_amdgcn_rcpf(1.0f + __builtin_amdgcn_exp2f(ex[1]));
                    sg[2] = __builtin_amdgcn_rcpf(1.0f + __builtin_amdgcn_exp2f(ex[2])); sg[3] = __builtin_amdgcn_rcpf(1.0f + __builtin_amdgcn_exp2f(ex[3]));
                    const f32x4 o = (cg * sg) * cv;
                    if (!(ai == 0 && wr == 0 && fr == 0 && m < 2)) { u32x2 w; w.x = cvt_pk_bf16(o[0], o[1]); w.y = cvt_pk_bf16(o[2], o[3]);
                        *(u32x2*)(ACT + (size_t)(u.pm * BM + ai * HALF + wr * 64 + 4 * fr + m) * D_FF + f0 + 4 * n) = w; }
                }
                __builtin_amdgcn_sched_barrier(0);
            }
        }
    }
};

struct EpiOut {
    static constexpr bool PERM = true, MIDK = true, APERM = false;
    const float* base; u16* X1B; float* SSQX; const float* gate; const LAS f32x2* RT;
    __device__ __forceinline__ void rstd(const Unit& u, int rit, float& ratio, float& ra) const { const f32x2 v = RT[u.ord * 256 + rit]; ratio = v.x; ra = v.y; }
    __device__ __forceinline__ void midk(f32x4 (&acc)[2][2][4][2], const Unit& u, int wr, int fr) const {
#pragma unroll
        for (int ai = 0; ai < 2; ++ai)
#pragma unroll
            for (int m = 0; m < 4; ++m) { float ratio, ra; rstd(u, ai * HALF + wr * 64 + m * 16 + fr, ratio, ra);
#pragma unroll
                for (int bj = 0; bj < 2; ++bj)
#pragma unroll
                    for (int n = 0; n < 2; ++n) acc[ai][bj][m][n] *= ratio; }
    }
    __device__ __forceinline__ void operator()(const f32x4 (&acc)[2][2][4][2], const Unit& u, int wr, int wc, int fr, int fq) const {
        const int row0 = u.pm * BM + wr * 64 + fr, col0 = u.pn * BM + wc * 32 + 8 * fq;
        const int b = (u.pm * BM) / SEQ;
        f32x4 gv[2][2];
#pragma unroll
        for (int bj = 0; bj < 2; ++bj)
#pragma unroll
            for (int n = 0; n < 2; ++n) gv[bj][n] = *(const f32x4*)(gate + (size_t)b * N_MOD + col0 + bj * HALF + n * 4);
#pragma unroll
        for (int ai = 0; ai < 2; ++ai)
#pragma unroll
            for (int m = 0; m < 4; ++m) { const int row = row0 + ai * HALF + m * 16; const size_t off = (size_t)row * D_MODEL + col0;
                float rl, ra; rstd(u, wr * 64 + fr + ai * HALF + m * 16, rl, ra);
                float ss = 0.f;
#pragma unroll
                for (int bj = 0; bj < 2; ++bj) {
                    const f32x4 x0 = *(const f32x4*)(base + off + bj * HALF) + gv[bj][0] * (acc[ai][bj][m][0] * ra);
                    const f32x4 x1 = *(const f32x4*)(base + off + bj * HALF + 4) + gv[bj][1] * (acc[ai][bj][m][1] * ra);
                    ss += ((x0[0] * x0[0] + x0[1] * x0[1]) + (x0[2] * x0[2] + x0[3] * x0[3])) + ((x1[0] * x1[0] + x1[1] * x1[1]) + (x1[2] * x1[2] + x1[3] * x1[3]));
                    u32x4 w; w.x = cvt_pk_bf16(x0[0], x0[1]); w.y = cvt_pk_bf16(x0[2], x0[3]); w.z = cvt_pk_bf16(x1[0], x1[1]); w.w = cvt_pk_bf16(x1[2], x1[3]);
                    *(u32x4*)(X1B + off + bj * HALF) = w; }
                ss += __shfl_xor(ss, 16); ss += __shfl_xor(ss, 32);
                if (fq == 0) SSQX[(size_t)row * 16 + u.pn * 4 + wc] = ss; }
    }
};

struct EpiResidB {
    static constexpr bool PERM = false, MIDK = false, APERM = false;
    const u16* base; float* out; const float* gate;
    __device__ __forceinline__ void operator()(const f32x4 (&acc)[2][2][4][2], const Unit& u, int wr, int wc, int fr, int fq) const {
        const int row0 = u.pm * BM + wr * 64 + fr, col0 = u.pn * BM + wc * 32 + 4 * fq;
        const int b = (u.pm * BM) / SEQ;
        f32x4 gv[2][2];
#pragma unroll
        for (int bj = 0; bj < 2; ++bj)
#pragma unroll
            for (int n = 0; n < 2; ++n) gv[bj][n] = *(const f32x4*)(gate + (size_t)b * N_MOD + col0 + bj * HALF + n * 16);
#pragma unroll
        for (int ai = 0; ai < 2; ++ai)
#pragma unroll
            for (int m = 0; m < 4; ++m) { const size_t off = (size_t)(row0 + ai * HALF + m * 16) * D_MODEL + col0;
#pragma unroll
                for (int bj = 0; bj < 2; ++bj)
#pragma unroll
                    for (int n = 0; n < 2; ++n) { const u32x2 xw = *(const u32x2*)(base + off + bj * HALF + n * 16);
                        const f32x4 bs = (f32x4){bf_lo(xw.x), bf_hi(xw.x), bf_lo(xw.y), bf_hi(xw.y)};
                        *(f32x4*)(out + off + bj * HALF + n * 16) = bs + gv[bj][n] * acc[ai][bj][m][n]; } }
    }
};
}
#ifndef ATT_DUP
#define ATT_DUP 0
#endif

constexpr size_t MiB = 1u << 20;
constexpr size_t WS_CTL = 0;
constexpr size_t WS_KM = 1 * MiB;
constexpr size_t CTL_ZERO_BYTES = 2 * MiB;
constexpr size_t WS_MOD = 2 * MiB;
constexpr size_t WS_WIN = 3 * MiB;
constexpr size_t WS_WO = 8 * MiB;
constexpr size_t WS_WUP = 10 * MiB;
constexpr size_t WS_WDN = 21 * MiB;
constexpr size_t WS_WA = 27 * MiB;
constexpr size_t WS_WX = 27 * MiB + 65536;
constexpr size_t WS_AGG = 28 * MiB;
constexpr size_t WS_SSQL = 29 * MiB;
constexpr size_t WS_SSQA = 30 * MiB;
constexpr size_t WS_H = 34 * MiB;
constexpr size_t WS_QF = 98 * MiB;
constexpr size_t WS_KB = 162 * MiB;
constexpr size_t WS_VT = 194 * MiB;
constexpr size_t WS_XR = 226 * MiB;
constexpr size_t WS_GG = 258 * MiB;
constexpr size_t WS_ATT = 288 * MiB;
constexpr size_t WS_LRU = 320 * MiB;
constexpr size_t WS_MIX = 352 * MiB;
constexpr size_t WS_RAW = 98 * MiB;
constexpr size_t WS_ACT = 272 * MiB;
constexpr size_t WS_WUP4 = 448 * MiB;
constexpr size_t WS_BIAS2 = 27 * MiB + 262144;
constexpr size_t WS_CB2 = 27 * MiB + 786432;
constexpr size_t WS_SSQX = 31 * MiB;
constexpr size_t WS_END = 492 * MiB;
constexpr int CW_BAR = 4096;

constexpr int RING_BYTES = 131072;
constexpr int MISC_OFF = 160 * 1024 - 256;
constexpr int XB_OFF = RING_BYTES;
constexpr int CLDS_OFF = RING_BYTES + 4096;
constexpr int LDS_BYTES = 160 * 1024;
constexpr int NT = 512, NWAVES = 8;

#define XB_TMO      128
#define XB_XCNT(j)  (256  + 64 * (j))
#define XB_XSUB(j)  (1280 + 64 * (j))
#define XB_XGEN(j)  (2304 + 64 * (j))
#define XB_TOP      3328
#define XB_TOPGEN   3392
#define XCD_BAR_WORDS 3456
#define XB_SPIN_CAP (1u << 18)
__device__ __forceinline__ unsigned xb_ld(unsigned* p)              { return __hip_atomic_load(p, __ATOMIC_RELAXED, __HIP_MEMORY_SCOPE_AGENT); }
__device__ __forceinline__ unsigned xb_add(unsigned* p, unsigned v) { return __hip_atomic_fetch_add(p, v, __ATOMIC_RELAXED, __HIP_MEMORY_SCOPE_AGENT); }
__device__ __forceinline__ unsigned xb_xcc_id() { return (unsigned)__builtin_amdgcn_s_getreg((3 << 11) | 20) & 0xFu; }
#define XB_SPIN(cond, bar) do { unsigned _sp = 0; while (cond) { __builtin_amdgcn_s_sleep(1); \
    if ((++_sp & 255u) == 0u) { if (xb_ld(&(bar)[XB_TMO])) break; if (_sp > XB_SPIN_CAP) { atomicAdd(&(bar)[XB_TMO], 1u); break; } } } } while (0)
struct XcdBarrier { unsigned* bar; unsigned x; volatile LAS unsigned* st; };
__device__ __forceinline__ XcdBarrier xcd_barrier_post(unsigned* bar, volatile LAS unsigned* st) {
    XcdBarrier b; b.bar = bar; b.x = xb_xcc_id(); b.st = st;
    if (threadIdx.x == 0) (void)xb_add(&bar[XB_XCNT(b.x)], 1u);
    return b;
}
__device__ __forceinline__ void xcd_barrier_complete(unsigned* bar, unsigned x, unsigned& nloc, unsigned& nx) {
    const unsigned G = gridDim.x * gridDim.y * gridDim.z;
    unsigned sum, cnt, mine, sp = 0u;
    for (;;) {
        sum = 0u; cnt = 0u; mine = 0u;
#pragma unroll
        for (unsigned j = 0; j < 16; ++j) { const unsigned c = xb_ld(&bar[XB_XCNT(j)]); sum += c; cnt += (c > 0u) ? 1u : 0u; mine = (j == x) ? c : mine; }
        if (sum == G) break;
        __builtin_amdgcn_s_sleep(1);
        if ((++sp & 255u) == 0u) { if (xb_ld(&bar[XB_TMO])) break; if (sp > XB_SPIN_CAP) { atomicAdd(&bar[XB_TMO], 1u); break; } }
    }
    nloc = mine > 0u ? mine : 1u; nx = cnt > 0u ? cnt : 1u;
}
__device__ __forceinline__ void xcd_barrier(const XcdBarrier& b, int tid) {
    asm volatile("s_waitcnt vmcnt(0)" ::: "memory");
    __syncthreads();
    if (tid == 0) {
        unsigned* bar = b.bar;
        __builtin_amdgcn_s_waitcnt(0);
        unsigned nloc = b.st[0], nx = b.st[1];
        if (nloc == 0u) { xcd_barrier_complete(bar, b.x, nloc, nx); b.st[0] = nloc; b.st[1] = nx; }
        const unsigned old = xb_add(&bar[XB_XSUB(b.x)], 1u);
        const unsigned gen = old / nloc;
        if (old + 1u == (gen + 1u) * nloc) {
            __builtin_amdgcn_fence(__ATOMIC_RELEASE, "agent");
            asm volatile("s_waitcnt vmcnt(0)" ::: "memory");
            const unsigned og = xb_add(&bar[XB_TOP], 1u);
            const unsigned tg = og / nx;
            if (og + 1u == (tg + 1u) * nx) xb_add(&bar[XB_TOPGEN], 1u);
            else XB_SPIN(xb_ld(&bar[XB_TOPGEN]) == tg, bar);
            __builtin_amdgcn_fence(__ATOMIC_ACQUIRE, "agent");
            xb_add(&bar[XB_XGEN(b.x)], 1u);
            asm volatile("s_waitcnt vmcnt(0)" ::: "memory");
        } else {
            XB_SPIN(xb_ld(&bar[XB_XGEN(b.x)]) == gen, bar);
            __builtin_amdgcn_fence(__ATOMIC_ACQUIRE, "agent");
            asm volatile("s_waitcnt vmcnt(0)" ::: "memory");
        }
    }
    __syncthreads();
}

struct Args { const float* in[23]; float* out; unsigned char* ws; int ph_lo, ph_hi; };
struct Frame {
    LAS unsigned char* lds;
    int tid, lane, wave, vcu, G, wave0;
    const Args* pa;
    __device__ __forceinline__ const float* x() const { return pa->in[0]; }
    __device__ __forceinline__ const float* c() const { return pa->in[1]; }
    __device__ __forceinline__ const float* w_ada() const { return pa->in[2]; }
    __device__ __forceinline__ const float* b_ada() const { return pa->in[3]; }
    __device__ __forceinline__ const float* norm1_g() const { return pa->in[4]; }
    __device__ __forceinline__ const float* w_in() const { return pa->in[5]; }
    __device__ __forceinline__ const float* q_norm_g() const { return pa->in[6]; }
    __device__ __forceinline__ const float* k_norm_g() const { return pa->in[7]; }
    __device__ __forceinline__ const float* lru_conv_w() const { return pa->in[8]; }
    __device__ __forceinline__ const float* lru_conv_b() const { return pa->in[9]; }
    __device__ __forceinline__ const float* lru_wa() const { return pa->in[10]; }
    __device__ __forceinline__ const float* lru_ba() const { return pa->in[11]; }
    __device__ __forceinline__ const float* lru_wx() const { return pa->in[12]; }
    __device__ __forceinline__ const float* lru_bx() const { return pa->in[13]; }
    __device__ __forceinline__ const float* lru_lambda() const { return pa->in[14]; }
    __device__ __forceinline__ const float* lru_out_g() const { return pa->in[15]; }
    __device__ __forceinline__ const float* attn_out_g() const { return pa->in[16]; }
    __device__ __forceinline__ const float* w_out() const { return pa->in[17]; }
    __device__ __forceinline__ const float* norm2_g() const { return pa->in[18]; }
    __device__ __forceinline__ const float* w_up() const { return pa->in[19]; }
    __device__ __forceinline__ const float* ffn_conv_w() const { return pa->in[20]; }
    __device__ __forceinline__ const float* ffn_conv_b() const { return pa->in[21]; }
    __device__ __forceinline__ const float* w_down() const { return pa->in[22]; }
    float* out; unsigned char* ws;
};
#define LDS_WAIT() asm volatile("s_waitcnt lgkmcnt(0)" ::: "memory")

template <int MODE>
__device__ __forceinline__ void p0_transpose_item(const float* W, int K, int N, u16* WT, LAS float* scr, int item, int lane, const float* kscale = nullptr) {
    const int nblk = N / 32, kb = item / nblk, nb = item % nblk, k0 = 64 * kb, n0 = 32 * nb;
#pragma unroll
    for (int i = 0; i < 8; ++i) { const int f = i * 64 + lane, kk = f >> 3, n4 = f & 7;
        f32x4 w = *(const GAS f32x4*)(W + (size_t)(k0 + kk) * N + n0 + 4 * n4); if (MODE == 3) w *= kscale[k0 + kk];
        LAS float* d = scr + kk * 33 + 4 * n4; d[0] = w.x; d[1] = w.y; d[2] = w.z; d[3] = w.w; }
    LDS_WAIT(); asm volatile("" ::: "memory");
    const int c = lane & 7;
#pragma unroll
    for (int j = 0; j < 4; ++j) { const int n = (lane >> 3) + 8 * j; const LAS float* s = scr + (8 * c) * 33 + n;
        u32x4 o;
        if (MODE == 1) { o.x = cvt_pk_f16(s[0 * 33], s[1 * 33]); o.y = cvt_pk_f16(s[2 * 33], s[3 * 33]); o.z = cvt_pk_f16(s[4 * 33], s[5 * 33]); o.w = cvt_pk_f16(s[6 * 33], s[7 * 33]); }
        else { o.x = cvt_pk_bf16(s[0 * 33], s[1 * 33]); o.y = cvt_pk_bf16(s[2 * 33], s[3 * 33]); o.z = cvt_pk_bf16(s[4 * 33], s[5 * 33]); o.w = cvt_pk_bf16(s[6 * 33], s[7 * 33]); }
        int nn = n0 + n;
        if (MODE == 1) nn = (nn & ~255) + 128 * ((nn >> 5) & 1) + 32 * ((nn >> 6) & 3) + (nn & 31);
        if (MODE == 2) { const int bj = nn >= D_FF ? 1 : 0, f = nn - bj * D_FF; nn = 256 * (f >> 7) + 128 * bj + (f & 127); }
        if (MODE == 4) *(GAS u32x4*)(WT + (((nn >> 5) * 4 + (c >> 1)) * 512 + ((c & 1) * 32 + (nn & 31)) * 8)) = o;
        else *(GAS u32x4*)(WT + (size_t)nn * K + k0 + 8 * c) = o; }
    LDS_WAIT(); asm volatile("" ::: "memory");
}
__device__ __forceinline__ void p0_prologue(Frame& F) {
    unsigned char* wsp = F.ws; asm volatile("" : "+s"(wsp));
    LAS float* cl = (LAS float*)(F.lds + CLDS_OFF);
    for (int i = F.tid; i < BATCH * D_MODEL; i += NT) cl[i] = F.c()[i];
    __syncthreads();
    LAS float* scr = (LAS float*)(F.lds + F.wave * 16384);
    constexpr int I_MOD = N_MOD / 64;
    constexpr int I_IN = (D_MODEL / 64) * (N_IN / 32), I_O = (D_MODEL / 64) * (D_MODEL / 32), I_DN = (D_FF / 64) * (D_MODEL / 32), I_L = 8 * 2;
    constexpr int NITEMS = I_IN + I_O + I_DN + 2 * I_L;
    u16* WinT = (u16*)(wsp + WS_WIN); u16* WoT = (u16*)(wsp + WS_WO); u16* WdT = (u16*)(wsp + WS_WDN);
    u16* WaT = (u16*)(wsp + WS_WA); u16* WxT = (u16*)(wsp + WS_WX);
    float* MOD = (float*)(wsp + WS_MOD);
    if (F.vcu < I_MOD) {
        const int col = F.vcu * 64 + F.lane; float a0 = 0.f, a1 = 0.f, a2 = 0.f, a3 = 0.f;
        const float* wp = F.w_ada() + (size_t)(F.wave * 128) * N_MOD + col; const LAS float* cw = cl + F.wave * 128;
#pragma unroll 64
        for (int k = 0; k < 128; ++k) { const float w = wp[(size_t)k * N_MOD];
            a0 += cw[k] * w; a1 += cw[D_MODEL + k] * w; a2 += cw[2 * D_MODEL + k] * w; a3 += cw[3 * D_MODEL + k] * w; }
        LAS float* part = (LAS float*)(F.lds + CLDS_OFF + 16384);
        part[(F.wave * 4 + 0) * 64 + F.lane] = a0; part[(F.wave * 4 + 1) * 64 + F.lane] = a1; part[(F.wave * 4 + 2) * 64 + F.lane] = a2; part[(F.wave * 4 + 3) * 64 + F.lane] = a3;
        __syncthreads();
        if (F.tid < 256) { const int bb = F.tid >> 6, l = F.tid & 63; float s = F.b_ada()[F.vcu * 64 + l];
#pragma unroll
            for (int w = 0; w < 8; ++w) s += part[(w * 4 + bb) * 64 + l];
            MOD[(size_t)bb * N_MOD + F.vcu * 64 + l] = s; }
    }
    const int gw = F.wave * F.G + ((F.vcu + F.G - I_MOD) % F.G), NGW = F.G * NWAVES;
    for (int it = gw; it < NITEMS; it += NGW) {
        int r = it;
        if (r < I_IN) { p0_transpose_item<1>(F.w_in(), D_MODEL, N_IN, WinT, scr, r, F.lane); continue; } r -= I_IN;
        if (r < I_O) { const int kb = r / (D_MODEL / 32); p0_transpose_item<3>(F.w_out(), D_MODEL, D_MODEL, WoT, scr, r, F.lane, (kb < 8 ? F.lru_out_g() : F.attn_out_g() - AW)); continue; } r -= I_O;

        if (r < I_DN) { p0_transpose_item<0>(F.w_down(), D_FF, D_MODEL, WdT, scr, r, F.lane); continue; } r -= I_DN;
        if (r < I_L) { const int h = r >> 1; p0_transpose_item<4>(F.lru_wa() + h * 4096, 64, 64, WaT + h * 4096, scr, r & 1, F.lane); continue; } r -= I_L;
        { const int h = r >> 1; p0_transpose_item<4>(F.lru_wx() + h * 4096, 64, 64, WxT + h * 4096, scr, r & 1, F.lane); }
    }
}


constexpr int SCL_OFF = RING_BYTES;
__device__ __forceinline__ void p1_upweights(Frame& F, unsigned char* wsp) {
    const float* MODp = (const float*)(wsp + WS_MOD);
    LAS float* SC = (LAS float*)(F.lds + SCL_OFF);
#define SHB(b) ((LAS float*)(F.lds + 16384 * (b) + 8448))
    if (F.tid == 0) *(LAS int*)(F.lds + MISC_OFF - 64) = 0;
    for (int i = F.tid; i < BATCH * D_MODEL; i += NT) { const int b = i >> 10, k = i & 1023; SC[i] = F.norm2_g()[k] * (1.0f + MODp[(size_t)b * N_MOD + 4096 + k]); SHB(b)[k] = MODp[(size_t)b * N_MOD + 3072 + k]; }
    __syncthreads();
    LAS float* scr = (LAS float*)(F.lds + F.wave * 16384);
    u16* W4 = (u16*)(wsp + WS_WUP4); float* BIAS2 = (float*)(wsp + WS_BIAS2);
    const float* W = F.w_up();
    const int gw = F.wave * F.G + F.vcu, NGW = F.G * NWAVES, lane = F.lane;
    for (int it = gw; it < 4 * (N_UP / 32); it += NGW) {
        const int n0 = 32 * (it >> 2), kc = it & 3;
        float bs0 = 0.f, bs1 = 0.f, bs2 = 0.f, bs3 = 0.f;
#pragma unroll 1
        for (int kb = 4 * kc; kb < 4 * kc + 4; ++kb) {
            const int k0 = 64 * kb;
#pragma unroll
            for (int i = 0; i < 8; ++i) { const int f = i * 64 + lane, kk = f >> 3, n4 = f & 7;
                const f32x4 w = *(const GAS f32x4*)(W + (size_t)(k0 + kk) * N_UP + n0 + 4 * n4);
                LAS float* d = scr + kk * 33 + 4 * n4; d[0] = w.x; d[1] = w.y; d[2] = w.z; d[3] = w.w; }
            LDS_WAIT(); asm volatile("" ::: "memory");
            { const int n = lane & 31, kh = lane >> 5;
#pragma unroll 8
              for (int kk = 0; kk < 32; ++kk) { const float w = scr[(32 * kh + kk) * 33 + n]; const int k = k0 + 32 * kh + kk;
                  bs0 += SHB(0)[k] * w; bs1 += SHB(1)[k] * w; bs2 += SHB(2)[k] * w; bs3 += SHB(3)[k] * w; } }
            const int c = lane & 7;
#pragma unroll
            for (int j = 0; j < 4; ++j) { const int n = (lane >> 3) + 8 * j; const LAS float* s = scr + (8 * c) * 33 + n;
                int nn = n0 + n; { const int bj = nn >= D_FF ? 1 : 0, f = nn - bj * D_FF; nn = 256 * (f >> 7) + 128 * bj + (f & 127); }
                float wv[8];
#pragma unroll
                for (int e = 0; e < 8; ++e) wv[e] = s[e * 33];
#pragma unroll
                for (int b = 0; b < BATCH; ++b) { const LAS float* sc = SC + b * 1024 + k0 + 8 * c;
                    u32x4 o; o.x = cvt_pk_bf16(wv[0] * sc[0], wv[1] * sc[1]); o.y = cvt_pk_bf16(wv[2] * sc[2], wv[3] * sc[3]); o.z = cvt_pk_bf16(wv[4] * sc[4], wv[5] * sc[5]); o.w = cvt_pk_bf16(wv[6] * sc[6], wv[7] * sc[7]);
                    *(GAS u32x4*)(W4 + ((size_t)b * N_UP + nn) * D_MODEL + k0 + 8 * c) = o; } }
            LDS_WAIT(); asm volatile("" ::: "memory");
        }
        bs0 += __shfl_xor(bs0, 32); bs1 += __shfl_xor(bs1, 32); bs2 += __shfl_xor(bs2, 32); bs3 += __shfl_xor(bs3, 32);
        if (lane < 32) { float* bp = BIAS2 + (size_t)kc * BATCH * N_UP + n0 + lane; bp[0] = bs0; bp[N_UP] = bs1; bp[2 * N_UP] = bs2; bp[3 * N_UP] = bs3; }
    }
}


__device__ __forceinline__ void cb2_prep(Frame& F, unsigned char* wsp) {
    const float* BIAS2 = (const float*)(wsp + WS_BIAS2); float* CB2 = (float*)(wsp + WS_CB2);
    const float* cw = F.ffn_conv_w(); const float* cb = F.ffn_conv_b();
    for (int i = F.vcu * NT + F.tid; i < BATCH * N_UP; i += F.G * NT) { const int b = i / N_UP, col = i % N_UP;
        const float bias = (BIAS2[(size_t)(0 * BATCH + b) * N_UP + col] + BIAS2[(size_t)(1 * BATCH + b) * N_UP + col]) + (BIAS2[(size_t)(2 * BATCH + b) * N_UP + col] + BIAS2[(size_t)(3 * BATCH + b) * N_UP + col]);
        CB2[i] = cb[col] + ((cw[col] + cw[N_UP + col]) + cw[2 * N_UP + col]) * bias; }
}

template <bool F16>
__device__ __forceinline__ void rownorm_phase(Frame& F, const float* X, const float* g, const float* sh, const float* sc, u16* O) {
    LAS int* ctr = (LAS int*)(F.lds + MISC_OFF - 64);
    for (;;) {
        int k = 0; if (F.lane == 0) k = __hip_atomic_fetch_add(ctr, 1, __ATOMIC_RELAXED, __HIP_MEMORY_SCOPE_WORKGROUP);
        k = __builtin_amdgcn_readfirstlane(k);
        const int m0 = (F.vcu + k * F.G) * 4;
        if (m0 >= M_TOK) break;
        const int b = m0 / SEQ;
        f32x4 v[4][4]; float s[4];
#pragma unroll
        for (int r = 0; r < 4; ++r) { const GAS f32x4* xr = (const GAS f32x4*)(X + (size_t)(m0 + r) * D_MODEL) + F.lane; s[r] = 0.f;
#pragma unroll
            for (int j = 0; j < 4; ++j) v[r][j] = xr[64 * j]; }
#pragma unroll
        for (int r = 0; r < 4; ++r)
#pragma unroll
            for (int j = 0; j < 4; ++j) s[r] += (v[r][j].x * v[r][j].x + v[r][j].y * v[r][j].y) + (v[r][j].z * v[r][j].z + v[r][j].w * v[r][j].w);
#pragma unroll
        for (int o = 1; o < 64; o <<= 1) {
#pragma unroll
            for (int r = 0; r < 4; ++r) s[r] += __shfl_xor(s[r], o); }
        float rstd[4];
#pragma unroll
        for (int r = 0; r < 4; ++r) rstd[r] = 1.0f / sqrtf(s[r] * (1.0f / D_MODEL) + EPS);
#pragma unroll
        for (int j = 0; j < 4; ++j) {
            const int col = 4 * F.lane + 256 * j;
            const f32x4 gv = *(const f32x4*)(g + col), shv = *(const f32x4*)(sh + (size_t)b * N_MOD + col), scv = *(const f32x4*)(sc + (size_t)b * N_MOD + col);
            const f32x4 gs = gv * (scv + 1.0f);
#pragma unroll
            for (int r = 0; r < 4; ++r) {
                const f32x4 y = (v[r][j] * rstd[r]) * gs + shv;
                u32x2 w;
                if (F16) { w.x = cvt_pk_f16(y.x, y.y); w.y = cvt_pk_f16(y.z, y.w); } else { w.x = cvt_pk_bf16(y.x, y.y); w.y = cvt_pk_bf16(y.z, y.w); }
                *((GAS u32x2*)(O + (size_t)(m0 + r) * D_MODEL) + F.lane + 64 * j) = w; }
        }
    }
}

__device__ __forceinline__ int crow(int r, int hi) { return (r & 3) + 8 * (r >> 2) + 4 * hi; }
__device__ __forceinline__ int qs_off(int q, int c) { return q * 64 + ((c ^ ((q >> 1) & 7)) << 3); }
constexpr int AL_QS = 0, AL_SLOT = 32768, AL_LSL = 131072, AL_LIST = 134144, AL_CNT = 150528, AL_MISC = 150656, AL_KMS = 150912;
__device__ __forceinline__ void attn_tile(const u16* Kp, const u16* Vp, const s16x8 (&qf)[4], int nkt, bool own, int tt, int qidx, int hi, float c1, float c2, f32x16& o0, f32x16& o1, float& lsum) {
#pragma unroll
    for (int r = 0; r < 16; ++r) { o0[r] = 0.f; o1[r] = 0.f; }
    lsum = 0.f;
    s16x8 kc[4], kn[4], vc[4];
#pragma unroll
    for (int s = 0; s < 4; ++s) { kc[s] = *(const GAS s16x8*)(Kp + s * 512); kn[s] = kc[s]; }
#pragma unroll 1
    for (int kt = 0; kt < nkt; ++kt) {
#pragma unroll
        for (int s = 0; s < 4; ++s) vc[s] = *(const GAS s16x8*)(Vp + (kt * 4 + s) * 512);
        if (kt + 1 < nkt) {
#pragma unroll
            for (int s = 0; s < 4; ++s) kn[s] = *(const GAS s16x8*)(Kp + ((kt + 1) * 4 + s) * 512);
        }
        f32x16 p;
#pragma unroll
        for (int r = 0; r < 16; ++r) p[r] = 0.f;
#pragma unroll
        for (int s = 0; s < 4; ++s) p = __builtin_amdgcn_mfma_f32_32x32x16_bf16(__builtin_bit_cast(bf16x8_t, kc[s]), __builtin_bit_cast(bf16x8_t, qf[s]), p, 0, 0, 0);
        const bool diag = own && (kt == tt);
#pragma unroll
        for (int r = 0; r < 16; ++r) { float e = __builtin_amdgcn_exp2f(p[r] * c1 - c2);
            if (diag && (32 * kt + crow(r, hi) > qidx)) e = 0.f;
            p[r] = e; lsum += e; }
#pragma unroll
        for (int s2 = 0; s2 < 2; ++s2) {
            u32x4 pw; pw.x = cvt_pk_bf16(p[8 * s2 + 0], p[8 * s2 + 1]); pw.y = cvt_pk_bf16(p[8 * s2 + 2], p[8 * s2 + 3]); pw.z = cvt_pk_bf16(p[8 * s2 + 4], p[8 * s2 + 5]); pw.w = cvt_pk_bf16(p[8 * s2 + 6], p[8 * s2 + 7]);
            const bf16x8_t pa = __builtin_bit_cast(bf16x8_t, pw);
            o0 = __builtin_amdgcn_mfma_f32_32x32x16_bf16(pa, __builtin_bit_cast(bf16x8_t, vc[2 * s2]), o0, 0, 0, 0);
            o1 = __builtin_amdgcn_mfma_f32_32x32x16_bf16(pa, __builtin_bit_cast(bf16x8_t, vc[2 * s2 + 1]), o1, 0, 0, 0);
        }
#pragma unroll
        for (int s = 0; s < 4; ++s) kc[s] = kn[s];
    }
}
__device__ __forceinline__ void attn_tile_full(const u16* Kp, const u16* Vp, const LAS u16* QS, int qidx, int hi, float c1, float c2, f32x16& o0, f32x16& o1, float& lsum) {
#pragma unroll
    for (int r = 0; r < 16; ++r) { o0[r] = 0.f; o1[r] = 0.f; }
    lsum = 0.f;
    s16x8 kr[4][4], vr[4][4];
    const u16* kp = Kp; const u16* vp = Vp;
#pragma unroll
    for (int d = 0; d < 3; ++d) {
#pragma unroll
        for (int s = 0; s < 4; ++s) { kr[d][s] = *(const GAS s16x8*)(kp + s * 512); vr[d][s] = *(const GAS s16x8*)(vp + s * 512); }
        kp += 2048; vp += 2048; asm volatile("" : "+v"(kp), "+v"(vp));
    }
#pragma unroll
    for (int kt = 0; kt < 8; ++kt) {
        if (kt + 3 < 8) {
#pragma unroll
            for (int s = 0; s < 4; ++s) { kr[(kt + 3) & 3][s] = *(const GAS s16x8*)(kp + s * 512); vr[(kt + 3) & 3][s] = *(const GAS s16x8*)(vp + s * 512); }
            kp += 2048; vp += 2048; asm volatile("" : "+v"(kp), "+v"(vp));
        }
        __builtin_amdgcn_sched_barrier(0x38F);
        f32x16 p;
#pragma unroll
        for (int r = 0; r < 16; ++r) p[r] = 0.f;
#pragma unroll
        for (int s = 0; s < 4; ++s) { const s16x8 qf = *(const LAS s16x8*)(QS + qs_off(qidx, 2 * s + hi));
            p = __builtin_amdgcn_mfma_f32_32x32x16_bf16(__builtin_bit_cast(bf16x8_t, kr[kt & 3][s]), __builtin_bit_cast(bf16x8_t, qf), p, 0, 0, 0); }
#pragma unroll
        for (int r = 0; r < 16; ++r) { const float e = __builtin_amdgcn_exp2f(p[r] * c1 - c2); p[r] = e; lsum += e; }
#pragma unroll
        for (int s2 = 0; s2 < 2; ++s2) {
            u32x4 pw; pw.x = cvt_pk_bf16(p[8 * s2 + 0], p[8 * s2 + 1]); pw.y = cvt_pk_bf16(p[8 * s2 + 2], p[8 * s2 + 3]); pw.z = cvt_pk_bf16(p[8 * s2 + 4], p[8 * s2 + 5]); pw.w = cvt_pk_bf16(p[8 * s2 + 6], p[8 * s2 + 7]);
            const bf16x8_t pa = __builtin_bit_cast(bf16x8_t, pw);
            o0 = __builtin_amdgcn_mfma_f32_32x32x16_bf16(pa, __builtin_bit_cast(bf16x8_t, vr[kt & 3][2 * s2]), o0, 0, 0, 0);
            o1 = __builtin_amdgcn_mfma_f32_32x32x16_bf16(pa, __builtin_bit_cast(bf16x8_t, vr[kt & 3][2 * s2 + 1]), o1, 0, 0, 0);
        }
        __builtin_amdgcn_sched_barrier(0x38F);
    }
}
__device__ __forceinline__ void attn_item(Frame& F, int bh, int i, float c1, float c2) {
    unsigned char* wsp = F.ws; asm volatile("" : "+s"(wsp));
    const float* QF = (const float*)(wsp + WS_QF); const u16* KB = (const u16*)(wsp + WS_KB); const u16* VT = (const u16*)(wsp + WS_VT);
    const float* KM = (const float*)(wsp + WS_KM); u16* ATT = (u16*)(wsp + WS_MIX); float* SSQA = (float*)(wsp + WS_SSQA);
    LAS u16* QS = (LAS u16*)(F.lds + AL_QS); LAS u16* SLOT = (LAS u16*)(F.lds + AL_SLOT); LAS float* LSL = (LAS float*)(F.lds + AL_LSL);
    LAS float* KMS = (LAS float*)(F.lds + AL_KMS); LAS u16* LIST = (LAS u16*)(F.lds + AL_LIST); LAS int* CNT = (LAS int*)(F.lds + AL_CNT);
    int tid_ = F.tid; asm volatile("" : "+v"(tid_));
    const int tid = tid_, lane = tid & 63, wave = F.wave, hi = lane >> 5, l31 = lane & 31;
    const int b = bh / NHEAD, h = bh % NHEAD;
    for (int u = tid; u < (3 * 32768 + 3072) / 16; u += NT) *(LAS u32x4*)(F.lds + AL_SLOT + u * 16) = (u32x4){0u, 0u, 0u, 0u};
    if (tid < 32) CNT[tid] = 0;
    for (int u = tid; u < NBLK * HD; u += NT) { const int n = u >> 6, d = u & 63; KMS[u] = KM[(((size_t)(b * NBLK + n)) * NHEAD + h) * HD + d] * (1.0f / 256.0f); }
    __syncthreads();
    {
        const int q = 32 * wave + l31;
        const GAS f32x4* qrow = (const GAS f32x4*)(QF + ((size_t)bh * SEQ + (size_t)i * BLK + q) * HD);
        f32x16 p;
#pragma unroll
        for (int r = 0; r < 16; ++r) p[r] = 0.f;
#pragma unroll
        for (int s = 0; s < 4; ++s) {
            const f32x4 qa = qrow[4 * s + 2 * hi], qc = qrow[4 * s + 2 * hi + 1];
            u32x4 qh; qh.x = cvt_pk_bf16(qa.x, qa.y); qh.y = cvt_pk_bf16(qa.z, qa.w); qh.z = cvt_pk_bf16(qc.x, qc.y); qh.w = cvt_pk_bf16(qc.z, qc.w);
            u32x4 ql; ql.x = cvt_pk_bf16(qa.x - bf_lo(qh.x), qa.y - bf_hi(qh.x)); ql.y = cvt_pk_bf16(qa.z - bf_lo(qh.y), qa.w - bf_hi(qh.y));
            ql.z = cvt_pk_bf16(qc.x - bf_lo(qh.z), qc.y - bf_hi(qh.z)); ql.w = cvt_pk_bf16(qc.z - bf_lo(qh.w), qc.w - bf_hi(qh.w));
            *(LAS u32x4*)(QS + qs_off(q, 2 * s + hi)) = qh;
            const LAS f32x4* kr = (const LAS f32x4*)(KMS + l31 * 64 + 16 * s + 8 * hi);
            const f32x4 ka = kr[0], kc = kr[1];
            u32x4 kh; kh.x = cvt_pk_bf16(ka.x, ka.y); kh.y = cvt_pk_bf16(ka.z, ka.w); kh.z = cvt_pk_bf16(kc.x, kc.y); kh.w = cvt_pk_bf16(kc.z, kc.w);
            u32x4 kl; kl.x = cvt_pk_bf16(ka.x - bf_lo(kh.x), ka.y - bf_hi(kh.x)); kl.y = cvt_pk_bf16(ka.z - bf_lo(kh.y), ka.w - bf_hi(kh.y));
            kl.z = cvt_pk_bf16(kc.x - bf_lo(kh.z), kc.y - bf_hi(kh.z)); kl.w = cvt_pk_bf16(kc.z - bf_lo(kh.w), kc.w - bf_hi(kh.w));
            p = __builtin_amdgcn_mfma_f32_32x32x16_bf16(__builtin_bit_cast(bf16x8_t, kl), __builtin_bit_cast(bf16x8_t, qh), p, 0, 0, 0);
            p = __builtin_amdgcn_mfma_f32_32x32x16_bf16(__builtin_bit_cast(bf16x8_t, kh), __builtin_bit_cast(bf16x8_t, ql), p, 0, 0, 0);
            p = __builtin_amdgcn_mfma_f32_32x32x16_bf16(__builtin_bit_cast(bf16x8_t, kh), __builtin_bit_cast(bf16x8_t, qh), p, 0, 0, 0);
        }
        float v0 = -INFINITY, v1 = -INFINITY, v2 = -INFINITY; int i0 = -1, i1 = -1, i2 = -1;
#pragma unroll
        for (int r = 0; r < 16; ++r) {
            const int n = crow(r, hi); const float g = (n < i) ? p[r] : -INFINITY;
            if (g > v0) { v2 = v1; i2 = i1; v1 = v0; i1 = i0; v0 = g; i0 = n; }
            else if (g > v1) { v2 = v1; i2 = i1; v1 = g; i1 = n; }
            else if (g > v2) { v2 = g; i2 = n; }
        }
        const float pv0 = __shfl_xor(v0, 32), pv1 = __shfl_xor(v1, 32), pv2 = __shfl_xor(v2, 32);
        const int pi0 = __shfl_xor(i0, 32), pi1 = __shfl_xor(i1, 32), pi2 = __shfl_xor(i2, 32);
        if (hi == 0) {
            float av[3] = {v0, v1, v2}, bv[3] = {pv0, pv1, pv2}; int ai[3] = {i0, i1, i2}, bi[3] = {pi0, pi1, pi2};
            int sel[3]; int pa = 0, pb = 0;
#pragma unroll
            for (int k = 0; k < 3; ++k) {
                const float ca = pa == 0 ? av[0] : (pa == 1 ? av[1] : av[2]); const int cai = pa == 0 ? ai[0] : (pa == 1 ? ai[1] : ai[2]);
                const float cb = pb == 0 ? bv[0] : (pb == 1 ? bv[1] : bv[2]); const int cbi = pb == 0 ? bi[0] : (pb == 1 ? bi[1] : bi[2]);
                if (ca > cb || (ca == cb && (cbi < 0 || (cai >= 0 && cai < cbi)))) { sel[k] = cai; ++pa; } else { sel[k] = cbi; ++pb; }
            }
#pragma unroll
            for (int k = 0; k < 3; ++k) if (sel[k] >= 0) { const int pos = __hip_atomic_fetch_add(&CNT[sel[k]], 1, __ATOMIC_RELAXED, __HIP_MEMORY_SCOPE_WORKGROUP); LIST[sel[k] * 256 + pos] = (u16)(q | (k << 8)); }
        }
    }
    __syncthreads();
    {
        int base = 0;
        for (int j = 0; j < i; ++j) {
            const int cntj = __builtin_amdgcn_readfirstlane(CNT[j]);
            const int ntj = (cntj + 31) >> 5;
            for (int t = base + ((wave - base) & 7); t < base + ntj; t += 8) {
                const int tt = t - base;
                const int ridx = 32 * tt + l31; const bool valid = ridx < cntj;
                const int ent = valid ? (int)LIST[j * 256 + ridx] : 0;
                const int qidx = ent & 255;
                s16x8 qf[4];
#pragma unroll
                for (int s = 0; s < 4; ++s) qf[s] = *(const LAS s16x8*)(QS + qs_off(qidx, 2 * s + hi));
                const size_t boff = ((size_t)bh * NBLK + j) * (BLK * HD) + lane * 8;
                f32x16 o0, o1; float lsum;
                attn_tile_full(KB + boff, VT + boff, QS, qidx, hi, c1, c2, o0, o1, lsum);
                const int srow = valid ? ((ent >> 8) * 256 + qidx) : -1;
                lsum += __shfl_xor(lsum, 32);
                if (valid && hi == 0) LSL[srow] = lsum;
#pragma unroll
                for (int r = 0; r < 16; ++r) { const int sr = __shfl(srow, crow(r, hi));
                    if (sr >= 0) { const unsigned w = cvt_pk_bf16(o0[r], o1[r]); SLOT[sr * 64 + l31] = (u16)(w & 0xffffu); SLOT[sr * 64 + 32 + l31] = (u16)(w >> 16); }
                    if ((r & 3) == 3) asm volatile("" ::: "memory"); }
            }
            base += ntj;
        }
    }
    f32x16 oo0, oo1; float lown;
    {
        s16x8 qf[4];
#pragma unroll
        for (int s = 0; s < 4; ++s) qf[s] = *(const LAS s16x8*)(QS + qs_off(32 * wave + l31, 2 * s + hi));
        const size_t boff = ((size_t)bh * NBLK + i) * (BLK * HD) + lane * 8;
        attn_tile(KB + boff, VT + boff, qf, wave + 1, true, wave, 32 * wave + l31, hi, c1, c2, oo0, oo1, lown);
    }
    __syncthreads();
    {
        const int q = 32 * wave + l31;
        float lt = lown + __shfl_xor(lown, 32);
        lt += LSL[q] + LSL[256 + q] + LSL[512 + q];
        const float inv = 1.0f / lt;
#pragma unroll
        for (int r = 0; r < 16; ++r) { const int rl = crow(r, hi), qq = 32 * wave + rl; const float iv = __shfl(inv, rl);
            float a = oo0[r], c = oo1[r];
#pragma unroll
            for (int k = 0; k < 3; ++k) { a += __builtin_bit_cast(float, (unsigned)SLOT[(k * 256 + qq) * 64 + l31] << 16); c += __builtin_bit_cast(float, (unsigned)SLOT[(k * 256 + qq) * 64 + 32 + l31] << 16); }
            const unsigned w = cvt_pk_bf16(a * iv, c * iv);
            QS[qq * 64 + l31] = (u16)(w & 0xffffu); QS[qq * 64 + 32 + l31] = (u16)(w >> 16);
            if ((r & 3) == 3) asm volatile("" ::: "memory"); }
        LDS_WAIT(); asm volatile("" ::: "memory");
#pragma unroll
        for (int it = 0; it < 4; ++it) { const int c = lane + 64 * it, row = c >> 3, ch = c & 7;
            const u32x4 w = *(const LAS u32x4*)(QS + (32 * wave + row) * 64 + 8 * ch);
            const size_t tok = (size_t)b * SEQ + (size_t)i * BLK + 32 * wave + row;
            *(GAS u32x4*)(ATT + tok * D_MODEL + AW + h * HD + 8 * ch) = w;
            float ss = bf_lo(w.x) * bf_lo(w.x) + bf_hi(w.x) * bf_hi(w.x) + bf_lo(w.y) * bf_lo(w.y) + bf_hi(w.y) * bf_hi(w.y) + bf_lo(w.z) * bf_lo(w.z) + bf_hi(w.z) * bf_hi(w.z) + bf_lo(w.w) * bf_lo(w.w) + bf_hi(w.w) * bf_hi(w.w);
            ss += __shfl_xor(ss, 1); ss += __shfl_xor(ss, 2); ss += __shfl_xor(ss, 4);
            if (ch == 0) SSQA[tok * NHEAD + h] = ss; }
    }
    __syncthreads();
}
__device__ __forceinline__ void attn_phase(Frame& F) {
    LAS float* mm = (LAS float*)(F.lds + AL_MISC);
    if (F.tid < 64) { float a = fabsf(F.q_norm_g()[F.tid]), c = fabsf(F.k_norm_g()[F.tid]);
#pragma unroll
        for (int o = 1; o < 64; o <<= 1) { a = fmaxf(a, __shfl_xor(a, o)); c = fmaxf(c, __shfl_xor(c, o)); }
        if (F.tid == 0) { mm[0] = a; mm[1] = c; } }
    __syncthreads();
    const float C = 8.0f * mm[0] * mm[1];
    const float c1 = 0.125f * LOG2E, c2 = C * LOG2E;
    __syncthreads();
    if (F.G == 256) {
        const int xcd = F.vcu >> 5, k = F.vcu & 31;
#pragma unroll 1
        for (int r = 0; r < 4; ++r) attn_item(F, xcd * 4 + r, (r & 1) ? 31 - k : k, c1, c2);
    } else {
        for (int it = F.vcu; it < BATCH * NHEAD * NBLK; it += F.G) attn_item(F, it >> 5, it & 31, c1, c2);
    }
}

constexpr int LL_CW = 0;
template <bool FINAL>
__device__ __forceinline__ void lru_item(Frame& F, int b, int chunk) {
    unsigned char* wsp = F.ws; asm volatile("" : "+s"(wsp));
    const u16* XR = (const u16*)(wsp + WS_XR); const u16* GG = (const u16*)(wsp + WS_GG);
    const u16* WaT = (const u16*)(wsp + WS_WA); const u16* WxT = (const u16*)(wsp + WS_WX);
    float* AGG = (float*)(wsp + WS_AGG); u16* LRU = (u16*)(wsp + WS_MIX); float* SSQL = (float*)(wsp + WS_SSQL);
    const int lane0 = F.lane, hd = F.wave, hi0 = lane0 >> 5, j0 = lane0 & 31;
    LAS float* CW = (LAS float*)(F.lds + LL_CW + hd * 2048);
    LAS u16* OT = (LAS u16*)(F.lds + 16384 + hd * 4096);
    for (int u = lane0; u < 320; u += 64) CW[u] = (u < 256) ? F.lru_conv_w()[(u >> 6) * AW + hd * HD + (u & 63)] : F.lru_conv_b()[hd * HD + (u - 256)];
    CW[320 + lane0] = F.lru_ba()[hd * HD + lane0]; CW[384 + lane0] = F.lru_bx()[hd * HD + lane0]; CW[448 + lane0] = 8.0f * log1pf(expf(-F.lru_lambda()[hd * HD + lane0]));
    LDS_WAIT(); asm volatile("" ::: "memory");
    float carry[2], arun[2];
#pragma unroll
    for (int ct = 0; ct < 2; ++ct) { const int c = hd * HD + 32 * ct + j0; carry[ct] = 0.f; arun[ct] = 1.f;
        if (FINAL) { float hcar = 0.f; for (int cc = 0; cc < chunk; ++cc) { const f32x2 ah = *(const f32x2*)(AGG + (((size_t)(b * 64 + cc)) * AW + c) * 2); hcar = ah.x * hcar + ah.y; } carry[ct] = hcar; } }
    for (int tile = 0; tile < 4; ++tile) {
        const int t0 = chunk * 128 + tile * 32;
        const u16* WaTt = WaT; const u16* WxTt = WxT; int lane = lane0; asm volatile("" : "+s"(WaTt), "+s"(WxTt), "+v"(lane));
        const int hi = lane >> 5, j = lane & 31, jt = j;
        const int pos = t0 + j;
        s16x8 af[4];
#pragma unroll
        for (int s = 0; s < 4; ++s) {
            const int ch0 = 16 * s + 8 * hi;
            float xc[8];
            { const LAS f32x4* bp = (const LAS f32x4*)(CW + 256 + ch0); const f32x4 b0 = bp[0], b1 = bp[1];
              xc[0] = b0.x; xc[1] = b0.y; xc[2] = b0.z; xc[3] = b0.w; xc[4] = b1.x; xc[5] = b1.y; xc[6] = b1.z; xc[7] = b1.w; }
            float accv[8];
#pragma unroll
            for (int e = 0; e < 8; ++e) accv[e] = 0.f;
#pragma unroll
            for (int jj = 0; jj < 4; ++jj) {
                const int p = pos - 3 + jj;
                const int pc = p < 0 ? 0 : p;
                u32x4 xw = *(const GAS u32x4*)(XR + ((((size_t)b * (SEQ / 32) + (pc >> 5)) * NHEAD + hd) * 2048) + ((s * 2 + hi) * 32 + (pc & 31)) * 8);
                if (p < 0) xw = (u32x4){0u, 0u, 0u, 0u};
                const LAS f32x4* wp = (const LAS f32x4*)(CW + jj * 64 + ch0); const f32x4 w0 = wp[0], w1 = wp[1];
                accv[0] += w0.x * bf_lo(xw.x); accv[1] += w0.y * bf_hi(xw.x); accv[2] += w0.z * bf_lo(xw.y); accv[3] += w0.w * bf_hi(xw.y);
                accv[4] += w1.x * bf_lo(xw.z); accv[5] += w1.y * bf_hi(xw.z); accv[6] += w1.z * bf_lo(xw.w); accv[7] += w1.w * bf_hi(xw.w);
            }
#pragma unroll
            for (int e = 0; e < 8; ++e) xc[e] += accv[e];
            u32x4 aw; aw.x = cvt_pk_bf16(xc[0], xc[1]); aw.y = cvt_pk_bf16(xc[2], xc[3]); aw.z = cvt_pk_bf16(xc[4], xc[5]); aw.w = cvt_pk_bf16(xc[6], xc[7]);
            af[s] = __builtin_bit_cast(s16x8, aw);
        }
        float ssacc[16];
#pragma unroll
        for (int r = 0; r < 16; ++r) ssacc[r] = 0.f;
#pragma unroll
        for (int ct = 0; ct < 2; ++ct) {
            float av[16], uv[16];
            {
                f32x16 aA, aX;
#pragma unroll
                for (int r = 0; r < 16; ++r) { aA[r] = 0.f; aX[r] = 0.f; }
#pragma unroll
                for (int s = 0; s < 4; ++s) {
                    const size_t woff = (size_t)hd * 4096 + (ct * 4 + s) * 512 + lane * 8;
                    const s16x8 wa = *(const GAS s16x8*)(WaTt + woff), wx = *(const GAS s16x8*)(WxTt + woff);
                    const bf16x8_t a = __builtin_bit_cast(bf16x8_t, af[s]);
                    aA = __builtin_amdgcn_mfma_f32_32x32x16_bf16(a, __builtin_bit_cast(bf16x8_t, wa), aA, 0, 0, 0);
                    aX = __builtin_amdgcn_mfma_f32_32x32x16_bf16(a, __builtin_bit_cast(bf16x8_t, wx), aX, 0, 0, 0);
                }
                const float bac = CW[320 + 32 * ct + jt], bxc = CW[384 + 32 * ct + jt], sp8c = CW[448 + 32 * ct + jt];
#pragma unroll
                for (int r = 0; r < 16; ++r) {
                    const float rr = sigmoidf_(aA[r] + bac), ii = sigmoidf_(aX[r] + bxc);
                    const float la = -rr * sp8c;
                    const float a = __builtin_amdgcn_exp2f(la * LOG2E);
                    const float om = fmaf(-a, a, 1.0f);
                    av[r] = a; uv[r] = __builtin_amdgcn_sqrtf(om) * ii;
                }
            }
            f32x16 aG;
            {
                f32x16 aI;
#pragma unroll
                for (int r = 0; r < 16; ++r) { aI[r] = 0.f; aG[r] = 0.f; }
#pragma unroll
                for (int s = 0; s < 4; ++s) {
                    s16x8 id;
#pragma unroll
                    for (int e = 0; e < 8; ++e) id[e] = (16 * s + 8 * hi + e == 32 * ct + jt) ? (short)0x3F80 : (short)0;
                    aI = __builtin_amdgcn_mfma_f32_32x32x16_bf16(__builtin_bit_cast(bf16x8_t, af[s]), __builtin_bit_cast(bf16x8_t, id), aI, 0, 0, 0);
                    if (FINAL) { const s16x8 gfr = *(const GAS s16x8*)(GG + ((((size_t)b * (SEQ / 32) + (t0 >> 5)) * NHEAD + hd) * 2048) + s * 512 + lane * 8);
                        aG = __builtin_amdgcn_mfma_f32_32x32x16_bf16(__builtin_bit_cast(bf16x8_t, gfr), __builtin_bit_cast(bf16x8_t, id), aG, 0, 0, 0); }
                }
#pragma unroll
                for (int r = 0; r < 16; ++r) uv[r] *= aI[r];
            }
            float Ag[4], Ug[4];
#pragma unroll
            for (int g = 0; g < 4; ++g) { float A = av[4 * g], U = uv[4 * g];
#pragma unroll
                for (int e = 1; e < 4; ++e) { A *= av[4 * g + e]; U = av[4 * g + e] * U + uv[4 * g + e]; }
                Ag[g] = A; Ug[g] = U; }
            float h = carry[ct], ap = arun[ct];
            float hin[4];
#pragma unroll
            for (int g = 0; g < 4; ++g) {
                const float pA = __shfl_xor(Ag[g], 32), pU = __shfl_xor(Ug[g], 32);
                const float fA = hi ? pA : Ag[g], fU = hi ? pU : Ug[g], sA = hi ? Ag[g] : pA, sU = hi ? Ug[g] : pU;
                const float h1 = fA * h + fU;
                hin[g] = hi ? h1 : h;
                h = sA * h1 + sU; ap *= fA * sA;
            }
            carry[ct] = h; arun[ct] = ap;
            if (FINAL) {
#pragma unroll
                for (int g = 0; g < 4; ++g) { float hh = hin[g];
#pragma unroll
                    for (int e = 0; e < 4; ++e) { const int r = 4 * g + e; hh = av[r] * hh + uv[r]; const float o = hh * aG[r]; ssacc[r] += o * o;
                        OT[crow(r, hi) * 64 + 32 * ct + j] = (u16)(cvt_pk_bf16(o, 0.f) & 0xffffu); } }
            }
        }
        if (FINAL) {
#pragma unroll
            for (int r = 0; r < 16; ++r) {
                const size_t tok = (size_t)b * SEQ + t0 + crow(r, hi);
                float ss = ssacc[r];
                ss += __shfl_xor(ss, 1); ss += __shfl_xor(ss, 2); ss += __shfl_xor(ss, 4); ss += __shfl_xor(ss, 8); ss += __shfl_xor(ss, 16);
                if (j == 0) SSQL[tok * NHEAD + hd] = ss;
            }
            LDS_WAIT(); asm volatile("" ::: "memory");
#pragma unroll
            for (int it = 0; it < 4; ++it) { const int c = lane + 64 * it, row = c >> 3, ch = c & 7;
                const u32x4 w = *(const LAS u32x4*)(OT + row * 64 + 8 * ch);
                *(GAS u32x4*)(LRU + ((size_t)b * SEQ + t0 + row) * D_MODEL + hd * HD + 8 * ch) = w; }
            LDS_WAIT(); asm volatile("" ::: "memory");
        }
    }
    if (!FINAL) { if (hi0 == 0) {
#pragma unroll
        for (int ct = 0; ct < 2; ++ct) { const int c = hd * HD + 32 * ct + j0; *(f32x2*)(AGG + (((size_t)(b * 64 + chunk)) * AW + c) * 2) = (f32x2){arun[ct], carry[ct]}; } } }
}
template <bool FINAL>
__device__ __forceinline__ void lru_phase(Frame& F) {
    for (int it = F.vcu; it < BATCH * 64; it += F.G) { lru_item<FINAL>(F, it >> 6, it & 63); }
}

__device__ __forceinline__ void mix_phase(Frame& F) {
    unsigned char* wsp = F.ws; asm volatile("" : "+s"(wsp));
    const u16* LRU = (const u16*)(wsp + WS_LRU); const u16* ATT = (const u16*)(wsp + WS_ATT);
    const float* SSQL = (const float*)(wsp + WS_SSQL); const float* SSQA = (const float*)(wsp + WS_SSQA); u16* MIX = (u16*)(wsp + WS_MIX);
    const int gw = F.vcu * NWAVES + F.wave, NGW = F.G * NWAVES, lane = F.lane;
    const f32x4 gl0 = *(const f32x4*)(F.lru_out_g() + 8 * lane), gl1 = *(const f32x4*)(F.lru_out_g() + 8 * lane + 4);
    const f32x4 ga0 = *(const f32x4*)(F.attn_out_g() + 8 * lane), ga1 = *(const f32x4*)(F.attn_out_g() + 8 * lane + 4);
    for (int m = gw; m < M_TOK; m += NGW) {
        const f32x4 s0 = *(const GAS f32x4*)(SSQL + (size_t)m * 8), s1 = *(const GAS f32x4*)(SSQL + (size_t)m * 8 + 4);
        const f32x4 t0 = *(const GAS f32x4*)(SSQA + (size_t)m * 8), t1 = *(const GAS f32x4*)(SSQA + (size_t)m * 8 + 4);
        const float ssl = ((s0.x + s0.y) + (s0.z + s0.w)) + ((s1.x + s1.y) + (s1.z + s1.w));
        const float ssa = ((t0.x + t0.y) + (t0.z + t0.w)) + ((t1.x + t1.y) + (t1.z + t1.w));
        const float rl = 1.0f / sqrtf(ssl * (1.0f / AW) + EPS), ra = 1.0f / sqrtf(ssa * (1.0f / AW) + EPS);
        const u32x4 lw = *(const GAS u32x4*)(LRU + (size_t)m * AW + 8 * lane), aw = *(const GAS u32x4*)(ATT + (size_t)m * AW + 8 * lane);
        u32x4 o;
        o.x = cvt_pk_bf16(bf_lo(lw.x) * rl * gl0.x, bf_hi(lw.x) * rl * gl0.y); o.y = cvt_pk_bf16(bf_lo(lw.y) * rl * gl0.z, bf_hi(lw.y) * rl * gl0.w);
        o.z = cvt_pk_bf16(bf_lo(lw.z) * rl * gl1.x, bf_hi(lw.z) * rl * gl1.y); o.w = cvt_pk_bf16(bf_lo(lw.w) * rl * gl1.z, bf_hi(lw.w) * rl * gl1.w);
        *(GAS u32x4*)(MIX + (size_t)m * D_MODEL + 8 * lane) = o;
        o.x = cvt_pk_bf16(bf_lo(aw.x) * ra * ga0.x, bf_hi(aw.x) * ra * ga0.y); o.y = cvt_pk_bf16(bf_lo(aw.y) * ra * ga0.z, bf_hi(aw.y) * ra * ga0.w);
        o.z = cvt_pk_bf16(bf_lo(aw.z) * ra * ga1.x, bf_hi(aw.z) * ra * ga1.y); o.w = cvt_pk_bf16(bf_lo(aw.w) * ra * ga1.z, bf_hi(aw.w) * ra * ga1.w);
        *(GAS u32x4*)(MIX + (size_t)m * D_MODEL + AW + 8 * lane) = o;
    }
}

__device__ __forceinline__ void ffn_fixup(Frame& F, unsigned char* wsp, int pm) {
    const float* RAW = (const float*)(wsp + WS_RAW); u16* ACT = (u16*)(wsp + WS_ACT);
    const float* cw = F.ffn_conv_w(); const float* cb = F.ffn_conv_b();
    const bool first = (pm % NBLK) == 0;
    for (int f = F.tid; f < D_FF; f += NT) {
        float xg[4], xv[4];
        xg[0] = first ? 0.f : RAW[((size_t)(pm - 1) * 4 + 2) * N_UP + f]; xg[1] = first ? 0.f : RAW[((size_t)(pm - 1) * 4 + 3) * N_UP + f];
        xv[0] = first ? 0.f : RAW[((size_t)(pm - 1) * 4 + 2) * N_UP + D_FF + f]; xv[1] = first ? 0.f : RAW[((size_t)(pm - 1) * 4 + 3) * N_UP + D_FF + f];
        xg[2] = RAW[((size_t)pm * 4 + 0) * N_UP + f]; xg[3] = RAW[((size_t)pm * 4 + 1) * N_UP + f];
        xv[2] = RAW[((size_t)pm * 4 + 0) * N_UP + D_FF + f]; xv[3] = RAW[((size_t)pm * 4 + 1) * N_UP + D_FF + f];
        const float wg0 = cw[f], wg1 = cw[N_UP + f], wg2 = cw[2 * N_UP + f], bg = cb[f];
        const float wv0 = cw[D_FF + f], wv1 = cw[N_UP + D_FF + f], wv2 = cw[2 * N_UP + D_FF + f], bv = cb[D_FF + f];
#pragma unroll
        for (int r = 0; r < 2; ++r) {
            const float cg = ((wg0 * xg[r] + wg1 * xg[r + 1]) + wg2 * xg[r + 2]) + bg;
            const float cv = ((wv0 * xv[r] + wv1 * xv[r + 1]) + wv2 * xv[r + 2]) + bv;
            ACT[((size_t)pm * 256 + r) * D_FF + f] = (u16)(cvt_pk_bf16(cg * sigmoidf_(cg) * cv, 0.f) & 0xffffu);
        }
    }
}

constexpr int N_PHASES = 10;
__global__ void __launch_bounds__(NT, 2) hymba_fwd(Args args) {
    extern __shared__ __attribute__((aligned(16))) unsigned char lds_raw[];
    Frame F;
    F.lds = (LAS unsigned char*)lds_raw;
    F.tid = threadIdx.x; F.lane = F.tid & 63; F.wave = __builtin_amdgcn_readfirstlane(F.tid >> 6); F.wave0 = F.wave;
    F.G = gridDim.x; { const int bx = blockIdx.x; F.vcu = (F.G % 8 == 0) ? (bx % 8) * (F.G / 8) + bx / 8 : bx; }
    F.pa = &args;
    F.out = args.out; F.ws = args.ws;
    volatile LAS unsigned* MISC = (volatile LAS unsigned*)(F.lds + MISC_OFF);
    if (F.tid < 32) MISC[F.tid] = 0u;
    __syncthreads();
    const int lo = args.ph_lo, hi = args.ph_hi;
#ifndef PROBE_PH
#define PROBE_PH -1
#endif
    unsigned long long tpa = 0, tpb = 0;
#define TP_A(k) do { if ((k) == PROBE_PH) tpa = __builtin_amdgcn_s_memrealtime(); } while (0)
#define TP_B(k) do { if ((k) == PROBE_PH) tpb = __builtin_amdgcn_s_memrealtime(); } while (0)
    unsigned* ctl = (unsigned*)(F.ws + WS_CTL);
    XcdBarrier bar; bar.bar = ctl + CW_BAR; bar.x = 0; bar.st = nullptr;
    if (hi - lo > 1) bar = xcd_barrier_post(ctl + CW_BAR, MISC + 8);
#ifndef PHASE_MASK
#define PHASE_MASK 0x3FF
#endif
#define IN(k) (((PHASE_MASK >> (k)) & 1) && lo <= (k) && (k) < hi)
#ifndef DUP_MASK
#define DUP_MASK 0
#endif
#define REP(k) _Pragma("unroll 1") for (int rep_ = 0; rep_ < 1 + ((DUP_MASK >> (k)) & 1); ++rep_)
#ifndef XBAR
#define XBAR 0
#endif
#define SEAM(k) do { if (IN(k) && IN((k) + 1)) { xcd_barrier(bar, F.wave0 * 64 + lane_id()); for (int xb_ = 0; xb_ < XBAR; ++xb_) xcd_barrier(bar, F.wave0 * 64 + lane_id()); } } while (0)
#define MOD ((float*)(wsp + WS_MOD))
#define H ((u16*)(wsp + WS_H))

    TP_A(0);
    if (IN(0)) { unsigned char* wsp = F.ws; asm volatile("" : "+s"(wsp)); { int t_ = F.wave0 * 64 + lane_id(); asm volatile("" : "+v"(t_)); F.tid = t_; F.lane = t_ & 63; F.wave = __builtin_amdgcn_readfirstlane(t_ >> 6); } REP(0) p0_prologue(F); SEAM(0); }
    TP_B(0);
    TP_A(1);
    if (IN(1)) { unsigned char* wsp = F.ws; asm volatile("" : "+s"(wsp)); { int t_ = F.wave0 * 64 + lane_id(); asm volatile("" : "+v"(t_)); F.tid = t_; F.lane = t_ & 63; F.wave = __builtin_amdgcn_readfirstlane(t_ >> 6); } REP(1) { p1_upweights(F, wsp); rownorm_phase<true>(F, F.x(), F.norm1_g(), MOD + 0, MOD + 1024, H); } SEAM(1); }
    TP_B(1);
    TP_A(2);
    if (IN(2)) { unsigned char* wsp = F.ws; asm volatile("" : "+s"(wsp)); { int t_ = F.wave0 * 64 + lane_id(); asm volatile("" : "+v"(t_)); F.tid = t_; F.lane = t_ & 63; F.wave = __builtin_amdgcn_readfirstlane(t_ >> 6); }
        pg8::Gemm g{H, (const u16*)(wsp + WS_WIN), M_TOK, N_IN, D_MODEL, 0}; pg8::StaticOrder S; S.init(M_TOK, N_IN, F.G, (int)blockIdx.x);
        pg8::EpiInProj E{(float*)(wsp + WS_QF), (u16*)(wsp + WS_KB), (u16*)(wsp + WS_VT), (u16*)(wsp + WS_XR), (u16*)(wsp + WS_GG), (float*)(wsp + WS_KM), F.q_norm_g(), F.k_norm_g()};
        REP(2) pg8::gemm_phase<pg8::EpiInProj, pg8::StaticOrder, true, true, true>(F.lds, g, S, E, F.wave0);
        SEAM(2);
    }
    TP_B(2);
    TP_A(3);
    if (IN(3)) { unsigned char* wsp = F.ws; asm volatile("" : "+s"(wsp)); { int t_ = F.wave0 * 64 + lane_id(); asm volatile("" : "+v"(t_)); F.tid = t_; F.lane = t_ & 63; F.wave = __builtin_amdgcn_readfirstlane(t_ >> 6); } cb2_prep(F, wsp); REP(3) attn_phase(F); { int t_ = F.wave0 * 64 + lane_id(); asm volatile("" : "+v"(t_)); F.tid = t_; F.lane = t_ & 63; F.wave = __builtin_amdgcn_readfirstlane(t_ >> 6); } REP(13) lru_phase<false>(F); SEAM(3); }
    TP_B(3);
    TP_A(4);
    if (IN(4)) { unsigned char* wsp = F.ws; asm volatile("" : "+s"(wsp)); { int t_ = F.wave0 * 64 + lane_id(); asm volatile("" : "+v"(t_)); F.tid = t_; F.lane = t_ & 63; F.wave = __builtin_amdgcn_readfirstlane(t_ >> 6); } REP(4) lru_phase<true>(F); if (IN(4) && IN(6)) xcd_barrier(bar, F.wave0 * 64 + lane_id()); }
    TP_B(4);
    TP_A(6);
    if (IN(6)) { unsigned char* wsp = F.ws; asm volatile("" : "+s"(wsp)); { int t_ = F.wave0 * 64 + lane_id(); asm volatile("" : "+v"(t_)); F.tid = t_; F.lane = t_ & 63; F.wave = __builtin_amdgcn_readfirstlane(t_ >> 6); }
        pg8::Gemm g{(const u16*)(wsp + WS_MIX), (const u16*)(wsp + WS_WO), M_TOK, D_MODEL, D_MODEL, 0}; pg8::StaticOrder S; S.init(M_TOK, D_MODEL, F.G, (int)blockIdx.x);
        LAS f32x2* RT = (LAS f32x2*)(F.lds + XB_OFF);
        { const float* SSQL = (const float*)(wsp + WS_SSQL); const float* SSQA = (const float*)(wsp + WS_SSQA);
          for (int i = 0; i < 8; ++i) { pg8::Unit uu; if (!S.next(i, uu)) break;
              if (F.tid < 256) { const size_t row = (size_t)uu.pm * 256 + F.tid;
                  const f32x4 s0 = *(const f32x4*)(SSQL + row * 8), s1 = *(const f32x4*)(SSQL + row * 8 + 4), t0 = *(const f32x4*)(SSQA + row * 8), t1 = *(const f32x4*)(SSQA + row * 8 + 4);
                  const float ssl = ((s0[0] + s0[1]) + (s0[2] + s0[3])) + ((s1[0] + s1[1]) + (s1[2] + s1[3])), ssa = ((t0[0] + t0[1]) + (t0[2] + t0[3])) + ((t1[0] + t1[1]) + (t1[2] + t1[3]));
                  const float rl = 1.0f / sqrtf(ssl * (1.0f / AW) + EPS), ra = 1.0f / sqrtf(ssa * (1.0f / AW) + EPS);
                  RT[i * 256 + F.tid] = (f32x2){rl / ra, ra}; } }
          __syncthreads(); }
        pg8::EpiOut E{F.x(), H, (float*)(wsp + WS_SSQX), MOD + 2048, RT};
        REP(6) pg8::gemm_phase<pg8::EpiOut, pg8::StaticOrder, true, true, false>(F.lds, g, S, E, F.wave0);
        if (IN(6) && IN(8)) xcd_barrier(bar, F.wave0 * 64 + lane_id());
    }
    TP_B(6);
    TP_A(8);
    if (IN(8)) { unsigned char* wsp = F.ws; asm volatile("" : "+s"(wsp)); { int t_ = F.wave0 * 64 + lane_id(); asm volatile("" : "+v"(t_)); F.tid = t_; F.lane = t_ & 63; F.wave = __builtin_amdgcn_readfirstlane(t_ >> 6); }
        pg8::Gemm g{H, (const u16*)(wsp + WS_WUP4), M_TOK, N_UP, D_MODEL, (size_t)N_UP * D_MODEL * 2}; pg8::StaticOrder S; S.init(M_TOK, N_UP, F.G, (int)blockIdx.x);
        LAS float* R2ALL = (LAS float*)(F.lds + XB_OFF + 8192); LAS float* CT = (LAS float*)(F.lds + XB_OFF + 8192 + 12 * 1024);
        { const float* SSQX = (const float*)(wsp + WS_SSQX);
          for (int i = 0; i < 12; ++i) { pg8::Unit uu; if (!S.next(i, uu)) break;
              if (F.tid < 256) { const size_t row = (size_t)uu.pm * 256 + F.tid;
                  const f32x4 s0 = *(const f32x4*)(SSQX + row * 16), s1 = *(const f32x4*)(SSQX + row * 16 + 4), s2 = *(const f32x4*)(SSQX + row * 16 + 8), s3 = *(const f32x4*)(SSQX + row * 16 + 12);
                  const float ss = (((s0[0] + s0[1]) + (s0[2] + s0[3])) + ((s1[0] + s1[1]) + (s1[2] + s1[3]))) + (((s2[0] + s2[1]) + (s2[2] + s2[3])) + ((s3[0] + s3[1]) + (s3[2] + s3[3])));
                  R2ALL[i * 256 + F.tid] = 1.0f / sqrtf(ss * (1.0f / D_MODEL) + EPS); } }
          __syncthreads(); }
        pg8::EpiFFN E{(u16*)(wsp + WS_ACT), (float*)(wsp + WS_RAW), F.ffn_conv_w(), (const float*)(wsp + WS_CB2), (LAS float*)(F.lds + XB_OFF), (const float*)(wsp + WS_SSQX), (const float*)(wsp + WS_BIAS2), R2ALL, CT};
        REP(8) pg8::gemm_phase<pg8::EpiFFN, pg8::StaticOrder, true, true, false>(F.lds, g, S, E, F.wave0);
        SEAM(8);
    }
    TP_B(8);
    TP_A(9);
    if (IN(9)) { unsigned char* wsp = F.ws; asm volatile("" : "+s"(wsp)); { int t_ = F.wave0 * 64 + lane_id(); asm volatile("" : "+v"(t_)); F.tid = t_; F.lane = t_ & 63; F.wave = __builtin_amdgcn_readfirstlane(t_ >> 6); }
        pg8::Gemm g{(const u16*)(wsp + WS_ACT), (const u16*)(wsp + WS_WDN), M_TOK, D_MODEL, D_FF, 0}; pg8::StaticOrder S; S.init(M_TOK, D_MODEL, F.G, (int)blockIdx.x);
        { pg8::Unit u0, u1; int pm0 = -1; if (S.next(0, u0)) { pm0 = u0.pm; ffn_fixup(F, wsp, pm0); } if (S.next(1, u1) && u1.pm != pm0) ffn_fixup(F, wsp, u1.pm);
          for (int i = 2; ; ++i) { pg8::Unit ux; if (!S.next(i, ux)) break; ffn_fixup(F, wsp, ux.pm); }
          asm volatile("s_waitcnt vmcnt(0)" ::: "memory"); __syncthreads(); }
        pg8::EpiResidB E{H, F.out, MOD + 5120};
        REP(9) pg8::gemm_phase<pg8::EpiResidB, pg8::StaticOrder, true, true, false>(F.lds, g, S, E, F.wave0);
    }
    TP_B(9);
    if (PROBE_PH >= 0 && blockIdx.x == 0) { const unsigned long long t0 = __builtin_amdgcn_s_memrealtime(); const unsigned long long want = 4ull * (tpb - tpa);
        while (__builtin_amdgcn_s_memrealtime() - t0 < want) __builtin_amdgcn_s_sleep(8); }
    if (hi - lo > 1 && hi == N_PHASES) {
        if (xb_ld(ctl + CW_BAR + XB_TMO) != 0u) { asm volatile("s_waitcnt vmcnt(0)" ::: "memory"); __syncthreads();
            for (size_t i = (size_t)blockIdx.x * NT + F.tid; i < (size_t)M_TOK * D_MODEL; i += (size_t)F.G * NT) F.out[i] = __builtin_nanf(""); }
    }
#undef IN
#undef MOD
#undef H
#undef SEAM
}

#ifndef MK_PER_PHASE
#define MK_PER_PHASE 0
#endif
extern "C" void kernel_launch(void* const* d_in, const int* in_sizes, int n_in, void* d_out, int out_size, void* d_ws, size_t ws_size, hipStream_t stream) {
    static int grid = 0;
    if (grid == 0) {
        if (n_in != 23 || in_sizes[0] != M_TOK * D_MODEL || out_size != M_TOK * D_MODEL || ws_size < WS_END) {
            fprintf(stderr, "kernel_launch: unexpected shapes (n_in %d, in0 %d, out %d, ws %zu); nothing launched\n", n_in, n_in > 0 ? in_sizes[0] : -1, out_size, ws_size); grid = -1; return; }
        int dev = 0, cus = 0;
        if (hipGetDevice(&dev) != hipSuccess || hipDeviceGetAttribute(&cus, hipDeviceAttributeMultiprocessorCount, dev) != hipSuccess) { grid = -1; return; }
        if (hipFuncSetAttribute((const void*)hymba_fwd, hipFuncAttributeMaxDynamicSharedMemorySize, LDS_BYTES) != hipSuccess) { fprintf(stderr, "kernel_launch: hipFuncSetAttribute failed\n"); grid = -1; return; }
        grid = cus;
    }
    if (grid < 0) return;
    (void)hipMemsetAsync((char*)d_ws + WS_CTL, 0, CTL_ZERO_BYTES, stream);
    Args a{};
    for (int i = 0; i < 23; ++i) a.in[i] = (const float*)d_in[i];
    a.out = (float*)d_out; a.ws = (unsigned char*)d_ws;
#if MK_PER_PHASE
    for (int p = 0; p < N_PHASES; ++p) { a.ph_lo = p; a.ph_hi = p + 1; hipLaunchKernelGGL(hymba_fwd, dim3(grid), dim3(NT), LDS_BYTES, stream, a); }
#else
    a.ph_lo = 0; a.ph_hi = N_PHASES; hipLaunchKernelGGL(hymba_fwd, dim3(grid), dim3(NT), LDS_BYTES, stream, a);
#endif
}
```

```cpp
#include <hip/hip_runtime.h>
#include <cstdio>
#include <cstdint>

#define GAS __attribute__((address_space(1)))
#define LAS __attribute__((address_space(3)))
typedef unsigned short u16;
typedef short s16x8 __attribute__((ext_vector_type(8)));
typedef _Float16 f16x8 __attribute__((ext_vector_type(8)));
typedef __bf16 bf16x8_t __attribute__((ext_vector_type(8)));
typedef float f32x2 __attribute__((ext_vector_type(2)));
typedef float f32x4 __attribute__((ext_vector_type(4)));
typedef float f32x16 __attribute__((ext_vector_type(16)));
typedef unsigned u32x4 __attribute__((ext_vector_type(4)));
typedef unsigned u32x2 __attribute__((ext_vector_type(2)));
typedef GAS unsigned gu32;
#define RLX_AGENT __ATOMIC_RELAXED, __HIP_MEMORY_SCOPE_AGENT

constexpr int D_MODEL = 1024, BATCH = 4, SEQ = 8192, M_TOK = BATCH * SEQ;
constexpr int N_IN = 2560, D_FF = 2816, N_UP = 2 * D_FF, N_MOD = 6 * D_MODEL;
constexpr int NHEAD = 8, HD = 64, AW = 512, NBLK = 32, BLK = 256;
constexpr float EPS = 1e-6f;
constexpr float LOG2E = 1.4426950408889634f;

__device__ __forceinline__ unsigned cvt_pk_bf16(float lo, float hi) { unsigned r; asm volatile("v_cvt_pk_bf16_f32 %0, %1, %2" : "=v"(r) : "v"(lo), "v"(hi)); return r; }
__device__ __forceinline__ unsigned cvt_pk_f16(float lo, float hi) {
    const _Float16 a = (_Float16)lo, b = (_Float16)hi;
    return (unsigned)__builtin_bit_cast(unsigned short, a) | ((unsigned)__builtin_bit_cast(unsigned short, b) << 16);
}
__device__ __forceinline__ float bf_lo(unsigned w) { return __builtin_bit_cast(float, w << 16); }
__device__ __forceinline__ float bf_hi(unsigned w) { return __builtin_bit_cast(float, w & 0xffff0000u); }
__device__ __forceinline__ float sigmoidf_(float v) { return __builtin_amdgcn_rcpf(1.0f + __builtin_amdgcn_exp2f(-v * LOG2E)); }
__device__ __forceinline__ float gelu_tanh(float v) { const float y = 0.7978845608028654f * (v + 0.044715f * v * v * v); return v * sigmoidf_(2.0f * y); }
__device__ __forceinline__ float wave_sum(float v) {
#pragma unroll
    for (int o = 1; o < 64; o <<= 1) v += __shfl_xor(v, o);
    return v;
}

__device__ __forceinline__ int lane_id() { int l; asm volatile("v_mbcnt_lo_u32_b32 %0, -1, 0\n\tv_mbcnt_hi_u32_b32 %0, -1, %0" : "=v"(l)); return l; }

namespace pg8 {
constexpr int BM = 256, BK = 64, HALF = 128, HTB = HALF * BK * 2, STAGE_BYTES = 8 * HTB, NXCD = 8, WGM = 8;
__host__ __device__ __forceinline__ int lds_byte(int r, int c) { const int st = (r >> 4) * 2 + (c >> 5), rr = r & 15, cc = c & 31, ob = rr * 64 + cc * 2; return st * 1024 + (ob ^ (((ob >> 9) & 1) << 5)); }
__host__ __device__ __forceinline__ void stage_rc(int b, int& R, int& C) { const int st = b / 1024, sb = b % 1024, swz = sb ^ (((sb >> 9) & 1) << 5); R = (st >> 1) * 16 + swz / 64; C = (st & 1) * 32 + (swz % 64) / 2; }
__host__ __device__ __forceinline__ int perm32(int rho) { const int n = rho >> 4, i = rho & 15; return 8 * (i >> 2) + 4 * n + (i & 3); }

struct Unit { int pm, pn, ord; };
struct Gemm { const u16* A; const u16* Bt; int M, N, K; size_t bstride; };

struct StaticOrder {
    int nM, nN, nwg, G, c;
    __host__ __device__ __forceinline__ void init(int M, int N, int G_, int c_) { nM = M / BM; nN = N / BM; nwg = nM * nN; G = G_; c = c_; }
    __host__ __device__ __forceinline__ bool next(int i, Unit& u) const {
        const long L = (long)i * G + c; if (L >= nwg) return false;
        int wgid = (int)L; { const int q = nwg / NXCD, r = nwg % NXCD, xcd = wgid % NXCD, off = wgid / NXCD; wgid = (xcd < r ? xcd * (q + 1) : r * (q + 1) + (xcd - r) * q) + off; }
        const int nig = WGM * nN, gid = wgid / nig, fm = gid * WGM, gsz = (nM - fm) < WGM ? (nM - fm) : WGM;
        u.pm = fm + ((wgid % nig) % gsz); u.pn = (wgid % nig) / gsz; u.ord = i; return true;
    }
    __device__ __forceinline__ void a_ready(const Unit&) const {}
    __device__ __forceinline__ void done(const Unit&) const {}
};

template <bool F16> __device__ __forceinline__ f32x4 mfma16(s16x8 a, s16x8 b, f32x4 c) {
    if constexpr (F16) return __builtin_amdgcn_mfma_f32_16x16x32_f16(__builtin_bit_cast(f16x8, a), __builtin_bit_cast(f16x8, b), c, 0, 0, 0);
    else return __builtin_amdgcn_mfma_f32_16x16x32_bf16(__builtin_bit_cast(bf16x8_t, a), __builtin_bit_cast(bf16x8_t, b), c, 0, 0, 0);
}

template <class Epi, class Sched, bool ALIGN_EPI, bool SP2, bool F16>
__device__ __forceinline__ void gemm_phase(LAS unsigned char* lds, const Gemm g, const Sched& S, const Epi& E, int wave0) {
    int tid_ = wave0 * 64 + lane_id(); asm volatile("" : "+v"(tid_));
    const int tid = tid_, wid = __builtin_amdgcn_readfirstlane(tid >> 6), lane = tid & 63, wr = wid >> 2, wc = wid & 3, fr = lane & 15, fq = lane >> 4;
    const int K = g.K, nt = K / BK;
    unsigned voffA, voffB;
    { int R, C; stage_rc(tid * 16, R, C); const int Rb = Epi::PERM ? ((R & ~31) + perm32(R & 31)) : R;
        const int Ra = Epi::APERM ? ((R & ~63) + 4 * (R & 15) + ((R >> 4) & 3)) : R;
        voffA = (unsigned)(Ra * K + C) * 2u; voffB = (unsigned)(Rb * K + C) * 2u; }
    const unsigned rstep64 = (unsigned)(64 * K * 2);
    const size_t kstep = (size_t)(BK * 2);
    const size_t hstep = (size_t)HALF * K * 2;
    const size_t tstep = 2 * hstep;
    const unsigned ldsw = (unsigned)wid * 1024u;
    const int aoff = lds_byte(wr * 64 + fr, fq * 8), boff = lds_byte(wc * 32 + fr, fq * 8);
#define PG8_SA(b, h) (((b) * 2 + (h)) * HTB)
#define PG8_SB(b, h) ((4 + (b) * 2 + (h)) * HTB)
#define PG8_STAGE(bufoff, gbase, voff) do { _Pragma("unroll") for (int _i = 0; _i < 2; ++_i) \
        __builtin_amdgcn_global_load_lds((const unsigned*)((const char*)(gbase) + _i * rstep64 + (voff)), (LAS unsigned*)(lds + (bufoff) + ldsw + _i * 8192), 16, 0, 0); } while (0)
#define PG8_LDA(dst, b, h) do { _Pragma("unroll") for (int m = 0; m < 4; ++m) _Pragma("unroll") for (int k = 0; k < 2; ++k) dst[m][k] = *(const LAS s16x8*)(lds + PG8_SA(b, h) + aoff + m * 2048 + k * 1024); } while (0)
#define PG8_LDB(dst, b, h) do { _Pragma("unroll") for (int n = 0; n < 2; ++n) _Pragma("unroll") for (int k = 0; k < 2; ++k) dst[n][k] = *(const LAS s16x8*)(lds + PG8_SB(b, h) + boff + n * 2048 + k * 1024); } while (0)
#define PG8_MMA(ai, bj, At, Bt) do { __builtin_amdgcn_s_setprio(1); _Pragma("unroll") for (int m = 0; m < 4; ++m) _Pragma("unroll") for (int n = 0; n < 2; ++n) _Pragma("unroll") for (int k = 0; k < 2; ++k) \
        acc[ai][bj][m][n] = mfma16<F16>(Bt[n][k], At[m][k], acc[ai][bj][m][n]); __builtin_amdgcn_s_setprio(0); } while (0)
#define PG8_WAIT_V(n) asm volatile("s_waitcnt vmcnt(" #n ")" ::: "memory")
#define PG8_WAIT_L(n) asm volatile("s_waitcnt lgkmcnt(" #n ")" ::: "memory")
#define PG8_BAR __builtin_amdgcn_s_barrier()
#define PG8_SCHED __builtin_amdgcn_sched_barrier(0)
    Unit cur, nxt; int ui = 0;
    if (!S.next(0, cur)) return;
    f32x4 acc[2][2][4][2];
#pragma unroll
    for (int a = 0; a < 2; ++a)
#pragma unroll
        for (int b = 0; b < 2; ++b)
#pragma unroll
            for (int m = 0; m < 4; ++m)
#pragma unroll
                for (int n = 0; n < 2; ++n) acc[a][b][m][n] = (f32x4){0.f, 0.f, 0.f, 0.f};
    s16x8 At[4][2], B0[2][2], B1[2][2];
    const char* cA = (const char*)g.A + (size_t)cur.pm * tstep; const char* cB = (const char*)g.Bt + (size_t)cur.pn * tstep + (size_t)(cur.pm >> 5) * g.bstride;
    S.a_ready(cur);
    if constexpr (SP2) {
        PG8_STAGE(PG8_SB(0, 0), cB, voffB); PG8_STAGE(PG8_SB(0, 1), cB + hstep, voffB); PG8_STAGE(PG8_SA(0, 0), cA, voffA); PG8_STAGE(PG8_SA(0, 1), cA + hstep, voffA);
        if (wr == 1) PG8_BAR;
        PG8_WAIT_V(2); PG8_BAR;
        PG8_STAGE(PG8_SB(1, 0), cB + kstep, voffB); PG8_STAGE(PG8_SA(1, 0), cA + kstep, voffA); PG8_STAGE(PG8_SB(1, 1), cB + hstep + kstep, voffB);
        PG8_WAIT_V(6); PG8_BAR;
    } else {
        PG8_STAGE(PG8_SB(0, 0), cB, voffB); PG8_STAGE(PG8_SA(0, 0), cA, voffA); PG8_STAGE(PG8_SB(0, 1), cB + hstep, voffB); PG8_STAGE(PG8_SA(0, 1), cA + hstep, voffA);
        if (wr == 1) PG8_BAR;
        PG8_WAIT_V(4); PG8_BAR;
        PG8_STAGE(PG8_SB(1, 0), cB + kstep, voffB); PG8_STAGE(PG8_SA(1, 0), cA + kstep, voffA); PG8_STAGE(PG8_SB(1, 1), cB + hstep + kstep, voffB);
        PG8_WAIT_V(6); PG8_BAR;
    }
    for (;;) {
        const bool has_next = S.next(ui + 1, nxt);
        const char* nA = has_next ? (const char*)g.A + (size_t)nxt.pm * tstep : cA; const char* nB = has_next ? (const char*)g.Bt + (size_t)nxt.pn * tstep + (size_t)(nxt.pm >> 5) * g.bstride : cB;
        for (int t = 0; t < nt; t += 2) {
            const bool last = (t == nt - 2);
            const char* a1 = cA + (size_t)(t + 1) * kstep;
            const char* a2 = last ? nA : cA + (size_t)(t + 2) * kstep; const char* b2 = last ? nB : cB + (size_t)(t + 2) * kstep;
            const char* a3 = a2 + kstep; const char* b3 = b2 + kstep;
            if (last && has_next) S.a_ready(nxt);
            if constexpr (Epi::MIDK) { if (t == nt / 2) E.midk(acc, cur, wr, fr); }
            if constexpr (SP2) {
            PG8_LDB(B0, 0, 0); PG8_LDB(B1, 0, 1); PG8_SCHED; PG8_LDA(At, 0, 0); PG8_STAGE(PG8_SA(1, 1), a1 + hstep, voffA);
            PG8_WAIT_V(8); PG8_WAIT_L(0); PG8_BAR; PG8_MMA(0, 0, At, B0); PG8_MMA(0, 1, At, B1); PG8_BAR; PG8_SCHED;
            PG8_LDA(At, 0, 1); PG8_STAGE(PG8_SB(0, 0), b2, voffB); PG8_STAGE(PG8_SB(0, 1), b2 + hstep, voffB); PG8_STAGE(PG8_SA(0, 0), a2, voffA);
            PG8_WAIT_V(8); PG8_WAIT_L(0); PG8_BAR; PG8_MMA(1, 0, At, B0); PG8_MMA(1, 1, At, B1); PG8_BAR; PG8_SCHED;
            PG8_LDB(B0, 1, 0); PG8_LDB(B1, 1, 1); PG8_SCHED; PG8_LDA(At, 1, 0); PG8_STAGE(PG8_SA(0, 1), a2 + hstep, voffA);
            PG8_WAIT_V(8); PG8_WAIT_L(0); PG8_BAR; PG8_MMA(0, 0, At, B0); PG8_MMA(0, 1, At, B1); PG8_BAR; PG8_SCHED;
            PG8_LDA(At, 1, 1); PG8_STAGE(PG8_SB(1, 0), b3, voffB); PG8_STAGE(PG8_SB(1, 1), b3 + hstep, voffB); PG8_STAGE(PG8_SA(1, 0), a3, voffA);
            PG8_WAIT_V(8); PG8_WAIT_L(0); PG8_BAR; PG8_MMA(1, 0, At, B0); PG8_MMA(1, 1, At, B1); PG8_BAR; PG8_SCHED;
            } else {
            PG8_LDB(B0, 0, 0); PG8_SCHED; PG8_LDA(At, 0, 0); PG8_STAGE(PG8_SA(1, 1), a1 + hstep, voffA);
            PG8_WAIT_L(8); PG8_BAR; PG8_WAIT_L(0); PG8_MMA(0, 0, At, B0); PG8_BAR; PG8_SCHED;
            PG8_LDB(B1, 0, 1); PG8_STAGE(PG8_SB(0, 0), b2, voffB);
            PG8_BAR; PG8_WAIT_L(0); PG8_MMA(0, 1, At, B1); PG8_BAR;
            PG8_LDA(At, 0, 1); PG8_STAGE(PG8_SA(0, 0), a2, voffA);
            PG8_BAR; PG8_WAIT_L(0); PG8_MMA(1, 0, At, B0); PG8_BAR; PG8_SCHED;
            PG8_STAGE(PG8_SB(0, 1), b2 + hstep, voffB);
            PG8_WAIT_V(6); PG8_BAR; PG8_MMA(1, 1, At, B1); PG8_BAR;
            PG8_LDB(B0, 1, 0); PG8_SCHED; PG8_LDA(At, 1, 0); PG8_STAGE(PG8_SA(0, 1), a2 + hstep, voffA);
            PG8_WAIT_L(8); PG8_BAR; PG8_WAIT_L(0); PG8_MMA(0, 0, At, B0); PG8_BAR; PG8_SCHED;
            PG8_LDB(B1, 1, 1); PG8_STAGE(PG8_SB(1, 0), b3, voffB);
            PG8_BAR; PG8_WAIT_L(0); PG8_MMA(0, 1, At, B1); PG8_BAR;
            PG8_LDA(At, 1, 1); PG8_STAGE(PG8_SA(1, 0), a3, voffA);
            PG8_BAR; PG8_WAIT_L(0); PG8_MMA(1, 0, At, B0); PG8_BAR; PG8_SCHED;
            PG8_STAGE(PG8_SB(1, 1), b3 + hstep, voffB);
            PG8_WAIT_V(6); PG8_BAR; PG8_MMA(1, 1, At, B1); PG8_BAR;
            }
        }
        if constexpr (ALIGN_EPI) { if (wr == 0) PG8_BAR; }
        E(acc, cur, wr, wc, fr, fq); S.done(cur);
        if (!has_next) break;
#pragma unroll
        for (int a = 0; a < 2; ++a)
#pragma unroll
            for (int b = 0; b < 2; ++b)
#pragma unroll
                for (int m = 0; m < 4; ++m)
#pragma unroll
                    for (int n = 0; n < 2; ++n) acc[a][b][m][n] = (f32x4){0.f, 0.f, 0.f, 0.f};
        cur = nxt; cA = nA; cB = nB; ++ui;
        if constexpr (ALIGN_EPI) { if (wr == 1) PG8_BAR; }
    }
    PG8_WAIT_V(0);
    if constexpr (!ALIGN_EPI) { if (wr == 0) PG8_BAR; }
    PG8_BAR;
#undef PG8_SA
#undef PG8_SB
#undef PG8_STAGE
#undef PG8_LDA
#undef PG8_LDB
#undef PG8_MMA
#undef PG8_WAIT_V
#undef PG8_WAIT_L
#undef PG8_BAR
#undef PG8_SCHED
}

struct EpiBf16 {
    static constexpr bool PERM = true, MIDK = false, APERM = false;
    u16* O; int ldc;
    __device__ __forceinline__ void operator()(const f32x4 (&acc)[2][2][4][2], const Unit& u, int wr, int wc, int fr, int fq) const {
        const int row0 = u.pm * BM + wr * 64 + fr; const int col0 = u.pn * BM + wc * 32 + 8 * fq;
#pragma unroll
        for (int ai = 0; ai < 2; ++ai)
#pragma unroll
            for (int m = 0; m < 4; ++m) { u16* rowp = O + (size_t)(row0 + ai * HALF + m * 16) * ldc + col0;
#pragma unroll
                for (int bj = 0; bj < 2; ++bj) { const f32x4 v0 = acc[ai][bj][m][0], v1 = acc[ai][bj][m][1];
                    u32x4 w; w.x = cvt_pk_bf16(v0[0], v0[1]); w.y = cvt_pk_bf16(v0[2], v0[3]); w.z = cvt_pk_bf16(v1[0], v1[1]); w.w = cvt_pk_bf16(v1[2], v1[3]);
                    *(u32x4*)(rowp + bj * HALF) = w; } }
    }
};
struct EpiResid {
    static constexpr bool PERM = false, MIDK = false, APERM = false;
    const float* base; float* out; const float* gate;
    __device__ __forceinline__ void operator()(const f32x4 (&acc)[2][2][4][2], const Unit& u, int wr, int wc, int fr, int fq) const {
        const int row0 = u.pm * BM + wr * 64 + fr, col0 = u.pn * BM + wc * 32 + 4 * fq;
        const int b = (u.pm * BM) / SEQ;
        f32x4 gv[2][2];
#pragma unroll
        for (int bj = 0; bj < 2; ++bj)
#pragma unroll
            for (int n = 0; n < 2; ++n) gv[bj][n] = *(const f32x4*)(gate + (size_t)b * N_MOD + col0 + bj * HALF + n * 16);
#pragma unroll
        for (int ai = 0; ai < 2; ++ai)
#pragma unroll
            for (int m = 0; m < 4; ++m) { const size_t off = (size_t)(row0 + ai * HALF + m * 16) * D_MODEL + col0;
#pragma unroll
                for (int bj = 0; bj < 2; ++bj)
#pragma unroll
                    for (int n = 0; n < 2; ++n) { const f32x4 bs = *(const f32x4*)(base + off + bj * HALF + n * 16);
                        *(f32x4*)(out + off + bj * HALF + n * 16) = bs + gv[bj][n] * acc[ai][bj][m][n]; } }
    }
};
struct EpiInProj {
    static constexpr bool PERM = true, MIDK = false, APERM = false;
    float* QF; u16* KB; u16* VT; u16* XR; u16* GG; float* KM; const float* gq; const float* gk;
    __device__ __forceinline__ void operator()(const f32x4 (&acc)[2][2][4][2], const Unit& u, int wr, int wc, int fr, int fq) const {
        const int type = u.pn >> 1, head = (u.pn & 1) * 4 + wc;
        const int b = (u.pm * BM) / SEQ, blk = u.pm % NBLK;
        const int tok0 = u.pm * BM + wr * 64 + fr;
        const int bh = b * NHEAD + head;
        if (type <= 1) {
            const float* gp = type == 0 ? gq : gk;
            f32x4 gv[2][2];
#pragma unroll
            for (int bj = 0; bj < 2; ++bj)
#pragma unroll
                for (int n = 0; n < 2; ++n) gv[bj][n] = *(const f32x4*)(gp + 32 * bj + 8 * fq + 4 * n);
            f32x4 cs[2][2];
#pragma unroll
            for (int bj = 0; bj < 2; ++bj)
#pragma unroll
                for (int n = 0; n < 2; ++n) cs[bj][n] = (f32x4){0.f, 0.f, 0.f, 0.f};
#pragma unroll
            for (int ai = 0; ai < 2; ++ai)
#pragma unroll
                for (int m = 0; m < 4; ++m) {
                    float ss = 0.f;
#pragma unroll
                    for (int bj = 0; bj < 2; ++bj)
#pragma unroll
                        for (int n = 0; n < 2; ++n) { const f32x4 x = acc[ai][bj][m][n]; ss += (x[0] * x[0] + x[1] * x[1]) + (x[2] * x[2] + x[3] * x[3]); }
                    ss += __shfl_xor(ss, 16); ss += __shfl_xor(ss, 32);
                    const float rstd = 1.0f / sqrtf(ss * (1.0f / 64.0f) + EPS);
                    const int tok = tok0 + ai * HALF + m * 16, s = tok % SEQ;
                    const size_t rowoff = ((size_t)bh * SEQ + s) * HD + 8 * fq;
#pragma unroll
                    for (int bj = 0; bj < 2; ++bj) {
                        const f32x4 v0 = acc[ai][bj][m][0] * rstd * gv[bj][0], v1 = acc[ai][bj][m][1] * rstd * gv[bj][1];
                        if (type == 0) { *(f32x4*)(QF + rowoff + 32 * bj) = v0; *(f32x4*)(QF + rowoff + 32 * bj + 4) = v1; }
                        else { u32x4 w; w.x = cvt_pk_bf16(v0[0], v0[1]); w.y = cvt_pk_bf16(v0[2], v0[3]); w.z = cvt_pk_bf16(v1[0], v1[1]); w.w = cvt_pk_bf16(v1[2], v1[3]);
                            const int kw = s & 255, c8 = 4 * bj + fq;
                            *(u32x4*)(KB + ((size_t)bh * NBLK + blk) * (BLK * HD) + ((((kw >> 5) * 4 + (c8 >> 1)) * 2 + (c8 & 1)) * 32 + (kw & 31)) * 8) = w; cs[bj][0] += v0; cs[bj][1] += v1; }
                    }
                }
            if (type == 1) {
#pragma unroll
                for (int bj = 0; bj < 2; ++bj)
#pragma unroll
                    for (int n = 0; n < 2; ++n)
#pragma unroll
                        for (int i = 0; i < 4; ++i) { float v = cs[bj][n][i]; v += __shfl_xor(v, 1); v += __shfl_xor(v, 2); v += __shfl_xor(v, 4); v += __shfl_xor(v, 8);
                            if (fr == 0) atomicAdd(KM + (((size_t)(b * NBLK + blk) * NHEAD + head) * HD + 32 * bj + 8 * fq + 4 * n + i), v); }
            }
        } else if (type == 2) {
            const int hip = (fr >> 2) & 1, ep = 4 * (fr >> 3) + (fr & 3);
#pragma unroll
            for (int ai = 0; ai < 2; ++ai)
#pragma unroll
                for (int m = 0; m < 4; ++m) { const int kw = ai * HALF + wr * 64 + m * 16 + fr;
#pragma unroll
                    for (int bj = 0; bj < 2; ++bj)
#pragma unroll
                        for (int n = 0; n < 2; ++n) { const f32x4 x = acc[ai][bj][m][n]; const unsigned w0 = cvt_pk_bf16(x[0], x[1]), w1 = cvt_pk_bf16(x[2], x[3]);
                            u16* dst = VT + ((size_t)bh * NBLK + blk) * (BLK * HD) + (((((kw >> 5) * 2 + ((kw >> 4) & 1)) * 2 + bj) * 2 + hip) * 32 + 8 * fq + 4 * n) * 8 + ep;
                            dst[0] = (u16)(w0 & 0xffffu); dst[8] = (u16)(w0 >> 16); dst[16] = (u16)(w1 & 0xffffu); dst[24] = (u16)(w1 >> 16); } }
        } else {
            u16* O = type == 3 ? XR : GG;
#pragma unroll
            for (int ai = 0; ai < 2; ++ai)
#pragma unroll
                for (int m = 0; m < 4; ++m) { const int tok = tok0 + ai * HALF + m * 16, sq = tok % SEQ;
                    u16* tilep = O + ((((size_t)b * (SEQ / 32) + (sq >> 5)) * NHEAD + head) * 2048) + (sq & 31) * 8;
#pragma unroll
                    for (int bj = 0; bj < 2; ++bj) { f32x4 v0 = acc[ai][bj][m][0], v1 = acc[ai][bj][m][1];
                        if (type == 4) {
#pragma unroll
                            for (int i = 0; i < 4; ++i) { v0[i] = gelu_tanh(v0[i]); v1[i] = gelu_tanh(v1[i]); } }
                        u32x4 w; w.x = cvt_pk_bf16(v0[0], v0[1]); w.y = cvt_pk_bf16(v0[2], v0[3]); w.z = cvt_pk_bf16(v1[0], v1[1]); w.w = cvt_pk_bf16(v1[2], v1[3]);
                        *(u32x4*)(tilep + (4 * bj + fq) * 256) = w; } }
        }
    }
};

__device__ __forceinline__ float dpp_f(float old, float x, int ctrl) {
    return 0.f; }
#define DPPF(old, x, ctrl) __builtin_bit_cast(float, __builtin_amdgcn_update_dpp(__builtin_bit_cast(int, (float)(old)), __builtin_bit_cast(int, (float)(x)), (ctrl), 0xf, 0xf, false))
struct EpiFFN {
    static constexpr bool PERM = true, MIDK = false, APERM = true;
    u16* ACT; float* RAW; const float* cw; const float* CB2; LAS float* XB; const float* SSQX; const float* BIAS2; const LAS float* R2ALL; LAS float* CT;
    __device__ __forceinline__ void operator()(const f32x4 (&acc)[2][2][4][2], const Unit& u, int wr, int wc, int fr_, int fq_) const {
        int fr = fr_, fq = fq_; asm volatile("" : "+v"(fr), "+v"(fq));
        const int f0 = u.pn * 128 + wc * 32 + 8 * fq;
        const int b = (u.pm * BM) / SEQ;
        const LAS float* R2S = R2ALL + u.ord * 256;
        { const int t = (wr * 4 + wc) * 64 + fq * 16 + fr;
          if (t < 256) { const int q = t >> 5, c4 = t & 31; const int f = u.pn * 128 + 4 * c4;
              const float* src = ((q & 3) == 3) ? (CB2 + (size_t)b * N_UP + (q >> 2) * D_FF + f) : (cw + (size_t)(q & 3) * N_UP + (q >> 2) * D_FF + f);
              const f32x4 v = *(const f32x4*)src; *(LAS f32x4*)(CT + q * 128 + 4 * c4) = v; } }
#define BBP(kc, bj, n) (*(const f32x4*)(BIAS2 + ((size_t)(kc) * BATCH + b) * N_UP + (bj) * D_FF + f0 + 4 * (n)))
#define BBV(bj, n) ((BBP(0, bj, n) + BBP(1, bj, n)) + (BBP(2, bj, n) + BBP(3, bj, n)))
        const f32x4 r2a = *(const LAS f32x4*)(R2S + wr * 64 + 4 * fr), r2b = *(const LAS f32x4*)(R2S + HALF + wr * 64 + 4 * fr);
        if (fr == 15) {
#pragma unroll
            for (int ai = 0; ai < 2; ++ai)
#pragma unroll
                for (int rr = 0; rr < 2; ++rr)
#pragma unroll
                    for (int bj = 0; bj < 2; ++bj)
#pragma unroll
                        for (int n = 0; n < 2; ++n) *(LAS f32x4*)(XB + (((((ai * 2 + wr) * 4 + wc) * 2 + rr) * 4 + fq) * 16 + (bj * 2 + n) * 4)) = acc[ai][bj][2 + rr][n] * (ai ? r2b[2 + rr] : r2a[2 + rr]);
        }
        if (wr == 1 && fr == 15) {
#pragma unroll
            for (int rr = 0; rr < 2; ++rr)
#pragma unroll
                for (int bj = 0; bj < 2; ++bj)
#pragma unroll
                    for (int n = 0; n < 2; ++n) *(f32x4*)(RAW + ((size_t)u.pm * 4 + 2 + rr) * N_UP + bj * D_FF + f0 + 4 * n) = acc[1][bj][2 + rr][n] * r2b[2 + rr] + BBV(bj, n);
        }
        if (wr == 0 && fr == 0) {
#pragma unroll
            for (int rr = 0; rr < 2; ++rr)
#pragma unroll
                for (int bj = 0; bj < 2; ++bj)
#pragma unroll
                    for (int n = 0; n < 2; ++n) *(f32x4*)(RAW + ((size_t)u.pm * 4 + rr) * N_UP + bj * D_FF + f0 + 4 * n) = acc[0][bj][rr][n] * r2a[rr] + BBV(bj, n);
        }
        asm volatile("s_waitcnt vmcnt(0) lgkmcnt(0)" ::: "memory"); __builtin_amdgcn_s_barrier(); asm volatile("" ::: "memory");
#pragma unroll
        for (int n = 0; n < 2; ++n) {
            const int cl = wc * 32 + 8 * fq + 4 * n;
            const f32x4 wg0 = *(const LAS f32x4*)(CT + 0 * 128 + cl), wg1 = *(const LAS f32x4*)(CT + 1 * 128 + cl), wg2 = *(const LAS f32x4*)(CT + 2 * 128 + cl);
            const f32x4 wv0 = *(const LAS f32x4*)(CT + 4 * 128 + cl), wv1 = *(const LAS f32x4*)(CT + 5 * 128 + cl), wv2 = *(const LAS f32x4*)(CT + 6 * 128 + cl);
            const f32x4 bg = *(const LAS f32x4*)(CT + 3 * 128 + cl), bv = *(const LAS f32x4*)(CT + 7 * 128 + cl);
#pragma unroll
            for (int ai = 0; ai < 2; ++ai) {
                const f32x4 r2v = ai ? r2b : r2a;
                const bool hasprev = (wr == 1) || (ai == 1);
                const int src = (wr == 1) ? (ai * 2 + 0) : ((ai - 1) * 2 + 1);
                f32x4 t1g = (f32x4){0.f, 0.f, 0.f, 0.f}, t2g = t1g, t1v = t1g, t2v = t1g;
                if (hasprev) {
                    const LAS float* xb1 = XB + ((((src * 4 + wc) * 2 + 1) * 4 + fq) * 16), * xb2 = XB + ((((src * 4 + wc) * 2 + 0) * 4 + fq) * 16);
                    t1g = *(const LAS f32x4*)(xb1 + (0 * 2 + n) * 4); t1v = *(const LAS f32x4*)(xb1 + (1 * 2 + n) * 4);
                    t2g = *(const LAS f32x4*)(xb2 + (0 * 2 + n) * 4); t2v = *(const LAS f32x4*)(xb2 + (1 * 2 + n) * 4);
                }
                f32x4 xg[4], xv[4];
#pragma unroll
                for (int m = 0; m < 4; ++m) { xg[m] = acc[ai][0][m][n] * r2v[m]; xv[m] = acc[ai][1][m][n] * r2v[m]; }
                f32x4 pg3, pg2, pv3, pv2;
#pragma unroll
                for (int i = 0; i < 4; ++i) { pg3[i] = DPPF(t1g[i], xg[3][i], 0x111); pg2[i] = DPPF(t2g[i], xg[2][i], 0x111); pv3[i] = DPPF(t1v[i], xv[3][i], 0x111); pv2[i] = DPPF(t2v[i], xv[2][i], 0x111); }
#pragma unroll
                for (int m = 0; m < 4; ++m) {
                    const f32x4 g1 = m == 0 ? pg3 : xg[m > 0 ? m - 1 : 0], g2 = m == 0 ? pg2 : (m == 1 ? pg3 : xg[m > 1 ? m - 2 : 0]);
                    const f32x4 v1 = m == 0 ? pv3 : xv[m > 0 ? m - 1 : 0], v2 = m == 0 ? pv2 : (m == 1 ? pv3 : xv[m > 1 ? m - 2 : 0]);
                    const f32x4 cg = ((wg0 * g2 + wg1 * g1) + wg2 * xg[m]) + bg, cv = ((wv0 * v2 + wv1 * v1) + wv2 * xv[m]) + bv;
                    const f32x4 ex = cg * (-LOG2E);
                    f32x4 sg; sg[0] = __builtin_amdgcn_rcpf(1.0f + __builtin_amdgcn_exp2f(ex[0])); sg[1] = __builtin_amdgcn_rcpf(1.0f + __builtin_amdgcn_exp2f(ex[1]));
                    sg[2] = __builtin_amdgcn_rcpf(1.0f + __builtin_amdgcn_exp2f(ex[2])); sg[3] = __builtin_amdgcn_rcpf(1.0f + __builtin_amdgcn_exp2f(ex[3]));
                    const f32x4 o = (cg * sg) * cv;
                    if (!(ai == 0 && wr == 0 && fr == 0 && m < 2)) { u32x2 w; w.x = cvt_pk_bf16(o[0], o[1]); w.y = cvt_pk_bf16(o[2], o[3]);
                        *(u32x2*)(ACT + (size_t)(u.pm * BM + ai * HALF + wr * 64 + 4 * fr + m) * D_FF + f0 + 4 * n) = w; }
                }
                __builtin_amdgcn_sched_barrier(0);
            }
        }
    }
};

struct EpiOut {
    static constexpr bool PERM = true, MIDK = true, APERM = false;
    const float* base; u16* X1B; float* SSQX; const float* gate; const LAS f32x2* RT;
    __device__ __forceinline__ void rstd(const Unit& u, int rit, float& ratio, float& ra) const { const f32x2 v = RT[u.ord * 256 + rit]; ratio = v.x; ra = v.y; }
    __device__ __forceinline__ void midk(f32x4 (&acc)[2][2][4][2], const Unit& u, int wr, int fr) const {
#pragma unroll
        for (int ai = 0; ai < 2; ++ai)
#pragma unroll
            for (int m = 0; m < 4; ++m) { float ratio, ra; rstd(u, ai * HALF + wr * 64 + m * 16 + fr, ratio, ra);
#pragma unroll
                for (int bj = 0; bj < 2; ++bj)
#pragma unroll
                    for (int n = 0; n < 2; ++n) acc[ai][bj][m][n] *= ratio; }
    }
    __device__ __forceinline__ void operator()(const f32x4 (&acc)[2][2][4][2], const Unit& u, int wr, int wc, int fr, int fq) const {
        const int row0 = u.pm * BM + wr * 64 + fr, col0 = u.pn * BM + wc * 32 + 8 * fq;
        const int b = (u.pm * BM) / SEQ;
        f32x4 gv[2][2];
#pragma unroll
        for (int bj = 0; bj < 2; ++bj)
#pragma unroll
            for (int n = 0; n < 2; ++n) gv[bj][n] = *(const f32x4*)(gate + (size_t)b * N_MOD + col0 + bj * HALF + n * 4);
#pragma unroll
        for (int ai = 0; ai < 2; ++ai)
#pragma unroll
            for (int m = 0; m < 4; ++m) { const int row = row0 + ai * HALF + m * 16; const size_t off = (size_t)row * D_MODEL + col0;
                float rl, ra; rstd(u, wr * 64 + fr + ai * HALF + m * 16, rl, ra);
                float ss = 0.f;
#pragma unroll
                for (int bj = 0; bj < 2; ++bj) {
                    const f32x4 x0 = *(const f32x4*)(base + off + bj * HALF) + gv[bj][0] * (acc[ai][bj][m][0] * ra);
                    const f32x4 x1 = *(const f32x4*)(base + off + bj * HALF + 4) + gv[bj][1] * (acc[ai][bj][m][1] * ra);
                    ss += ((x0[0] * x0[0] + x0[1] * x0[1]) + (x0[2] * x0[2] + x0[3] * x0[3])) + ((x1[0] * x1[0] + x1[1] * x1[1]) + (x1[2] * x1[2] + x1[3] * x1[3]));
                    u32x4 w; w.x = cvt_pk_bf16(x0[0], x0[1]); w.y = cvt_pk_bf16(x0[2], x0[3]); w.z = cvt_pk_bf16(x1[0], x1[1]); w.w = cvt_pk_bf16(x1[2], x1[3]);
                    *(u32x4*)(X1B + off + bj * HALF) = w; }
                ss += __shfl_xor(ss, 16); ss += __shfl_xor(ss, 32);
                if (fq == 0) SSQX[(size_t)row * 16 + u.pn * 4 + wc] = ss; }
    }
};

struct EpiResidB {
    static constexpr bool PERM = false, MIDK = false, APERM = false;
    const u16* base; float* out; const float* gate;
    __device__ __forceinline__ void operator()(const f32x4 (&acc)[2][2][4][2], const Unit& u, int wr, int wc, int fr, int fq) const {
        const int row0 = u.pm * BM + wr * 64 + fr, col0 = u.pn * BM + wc * 32 + 4 * fq;
        const int b = (u.pm * BM) / SEQ;
        f32x4 gv[2][2];
#pragma unroll
        for (int bj = 0; bj < 2; ++bj)
#pragma unroll
            for (int n = 0; n < 2; ++n) gv[bj][n] = *(const f32x4*)(gate + (size_t)b * N_MOD + col0 + bj * HALF + n * 16);
#pragma unroll
        for (int ai = 0; ai < 2; ++ai)
#pragma unroll
            for (int m = 0; m < 4; ++m) { const size_t off = (size_t)(row0 + ai * HALF + m * 16) * D_MODEL + col0;
#pragma unroll
                for (int bj = 0; bj < 2; ++bj)
#pragma unroll
                    for (int n = 0; n < 2; ++n) { const u32x2 xw = *(const u32x2*)(base + off + bj * HALF + n * 16);
                        const f32x4 bs = (f32x4){bf_lo(xw.x), bf_hi(xw.x), bf_lo(xw.y), bf_hi(xw.y)};
                        *(f32x4*)(out + off + bj * HALF + n * 16) = bs + gv[bj][n] * acc[ai][bj][m][n]; } }
    }
};
}
#ifndef ATT_DUP
#define ATT_DUP 0
#endif

constexpr size_t MiB = 1u << 20;
constexpr size_t WS_CTL = 0;
constexpr size_t WS_KM = 1 * MiB;
constexpr size_t CTL_ZERO_BYTES = 2 * MiB;
constexpr size_t WS_MOD = 2 * MiB;
constexpr size_t WS_WIN = 3 * MiB;
constexpr size_t WS_WO = 8 * MiB;
constexpr size_t WS_WUP = 10 * MiB;
constexpr size_t WS_WDN = 21 * MiB;
constexpr size_t WS_WA = 27 * MiB;
constexpr size_t WS_WX = 27 * MiB + 65536;
constexpr size_t WS_AGG = 28 * MiB;
constexpr size_t WS_SSQL = 29 * MiB;
constexpr size_t WS_SSQA = 30 * MiB;
constexpr size_t WS_H = 34 * MiB;
constexpr size_t WS_QF = 98 * MiB;
constexpr size_t WS_KB = 162 * MiB;
constexpr size_t WS_VT = 194 * MiB;
constexpr size_t WS_XR = 226 * MiB;
constexpr size_t WS_GG = 258 * MiB;
constexpr size_t WS_ATT = 288 * MiB;
constexpr size_t WS_LRU = 320 * MiB;
constexpr size_t WS_MIX = 352 * MiB;
constexpr size_t WS_RAW = 98 * MiB;
constexpr size_t WS_ACT = 272 * MiB;
constexpr size_t WS_WUP4 = 448 * MiB;
constexpr size_t WS_BIAS2 = 27 * MiB + 262144;
constexpr size_t WS_CB2 = 27 * MiB + 786432;
constexpr size_t WS_SSQX = 31 * MiB;
constexpr size_t WS_END = 492 * MiB;
constexpr int CW_BAR = 4096, CW_AGGCNT = 1024;

constexpr int RING_BYTES = 131072;
constexpr int MISC_OFF = 160 * 1024 - 256;
constexpr int XB_OFF = RING_BYTES;
constexpr int CLDS_OFF = RING_BYTES + 4096;
constexpr int LDS_BYTES = 160 * 1024;
constexpr int NT = 512, NWAVES = 8;

#define XB_TMO      128
#define XB_XCNT(j)  (256  + 64 * (j))
#define XB_XSUB(j)  (1280 + 64 * (j))
#define XB_XGEN(j)  (2304 + 64 * (j))
#define XB_TOP      3328
#define XB_TOPGEN   3392
#define XCD_BAR_WORDS 3456
#define XB_SPIN_CAP (1u << 18)
__device__ __forceinline__ unsigned xb_ld(unsigned* p)              { return __hip_atomic_load(p, __ATOMIC_RELAXED, __HIP_MEMORY_SCOPE_AGENT); }
__device__ __forceinline__ unsigned xb_add(unsigned* p, unsigned v) { return __hip_atomic_fetch_add(p, v, __ATOMIC_RELAXED, __HIP_MEMORY_SCOPE_AGENT); }
__device__ __forceinline__ unsigned xb_xcc_id() { return (unsigned)__builtin_amdgcn_s_getreg((3 << 11) | 20) & 0xFu; }
#define XB_SPIN(cond, bar) do { unsigned _sp = 0; while (cond) { __builtin_amdgcn_s_sleep(1); \
    if ((++_sp & 255u) == 0u) { if (xb_ld(&(bar)[XB_TMO])) break; if (_sp > XB_SPIN_CAP) { atomicAdd(&(bar)[XB_TMO], 1u); break; } } } } while (0)
struct XcdBarrier { unsigned* bar; unsigned x; volatile LAS unsigned* st; };
__device__ __forceinline__ XcdBarrier xcd_barrier_post(unsigned* bar, volatile LAS unsigned* st) {
    XcdBarrier b; b.bar = bar; b.x = xb_xcc_id(); b.st = st;
    if (threadIdx.x == 0) (void)xb_add(&bar[XB_XCNT(b.x)], 1u);
    return b;
}
__device__ __forceinline__ void xcd_barrier_complete(unsigned* bar, unsigned x, unsigned& nloc, unsigned& nx) {
    const unsigned G = gridDim.x * gridDim.y * gridDim.z;
    unsigned sum, cnt, mine, sp = 0u;
    for (;;) {
        sum = 0u; cnt = 0u; mine = 0u;
#pragma unroll
        for (unsigned j = 0; j < 16; ++j) { const unsigned c = xb_ld(&bar[XB_XCNT(j)]); sum += c; cnt += (c > 0u) ? 1u : 0u; mine = (j == x) ? c : mine; }
        if (sum == G) break;
        __builtin_amdgcn_s_sleep(1);
        if ((++sp & 255u) == 0u) { if (xb_ld(&bar[XB_TMO])) break; if (sp > XB_SPIN_CAP) { atomicAdd(&bar[XB_TMO], 1u); break; } }
    }
    nloc = mine > 0u ? mine : 1u; nx = cnt > 0u ? cnt : 1u;
}
__device__ __forceinline__ void xcd_barrier(const XcdBarrier& b, int tid) {
    asm volatile("s_waitcnt vmcnt(0)" ::: "memory");
    __syncthreads();
    if (tid == 0) {
        unsigned* bar = b.bar;
        __builtin_amdgcn_s_waitcnt(0);
        unsigned nloc = b.st[0], nx = b.st[1];
        if (nloc == 0u) { xcd_barrier_complete(bar, b.x, nloc, nx); b.st[0] = nloc; b.st[1] = nx; }
        const unsigned old = xb_add(&bar[XB_XSUB(b.x)], 1u);
        const unsigned gen = old / nloc;
        if (old + 1u == (gen + 1u) * nloc) {
            __builtin_amdgcn_fence(__ATOMIC_RELEASE, "agent");
            asm volatile("s_waitcnt vmcnt(0)" ::: "memory");
            const unsigned og = xb_add(&bar[XB_TOP], 1u);
            const unsigned tg = og / nx;
            if (og + 1u == (tg + 1u) * nx) xb_add(&bar[XB_TOPGEN], 1u);
            else XB_SPIN(xb_ld(&bar[XB_TOPGEN]) == tg, bar);
            __builtin_amdgcn_fence(__ATOMIC_ACQUIRE, "agent");
            xb_add(&bar[XB_XGEN(b.x)], 1u);
            asm volatile("s_waitcnt vmcnt(0)" ::: "memory");
        } else {
            XB_SPIN(xb_ld(&bar[XB_XGEN(b.x)]) == gen, bar);
            __builtin_amdgcn_fence(__ATOMIC_ACQUIRE, "agent");
            asm volatile("s_waitcnt vmcnt(0)" ::: "memory");
        }
    }
    __syncthreads();
}

struct Args { const float* in[23]; float* out; unsigned char* ws; int ph_lo, ph_hi; };
struct Frame {
    LAS unsigned char* lds;
    int tid, lane, wave, vcu, G, wave0;
    const Args* pa;
    __device__ __forceinline__ const float* x() const { return pa->in[0]; }
    __device__ __forceinline__ const float* c() const { return pa->in[1]; }
    __device__ __forceinline__ const float* w_ada() const { return pa->in[2]; }
    __device__ __forceinline__ const float* b_ada() const { return pa->in[3]; }
    __device__ __forceinline__ const float* norm1_g() const { return pa->in[4]; }
    __device__ __forceinline__ const float* w_in() const { return pa->in[5]; }
    __device__ __forceinline__ const float* q_norm_g() const { return pa->in[6]; }
    __device__ __forceinline__ const float* k_norm_g() const { return pa->in[7]; }
    __device__ __forceinline__ const float* lru_conv_w() const { return pa->in[8]; }
    __device__ __forceinline__ const float* lru_conv_b() const { return pa->in[9]; }
    __device__ __forceinline__ const float* lru_wa() const { return pa->in[10]; }
    __device__ __forceinline__ const float* lru_ba() const { return pa->in[11]; }
    __device__ __forceinline__ const float* lru_wx() const { return pa->in[12]; }
    __device__ __forceinline__ const float* lru_bx() const { return pa->in[13]; }
    __device__ __forceinline__ const float* lru_lambda() const { return pa->in[14]; }
    __device__ __forceinline__ const float* lru_out_g() const { return pa->in[15]; }
    __device__ __forceinline__ const float* attn_out_g() const { return pa->in[16]; }
    __device__ __forceinline__ const float* w_out() const { return pa->in[17]; }
    __device__ __forceinline__ const float* norm2_g() const { return pa->in[18]; }
    __device__ __forceinline__ const float* w_up() const { return pa->in[19]; }
    __device__ __forceinline__ const float* ffn_conv_w() const { return pa->in[20]; }
    __device__ __forceinline__ const float* ffn_conv_b() const { return pa->in[21]; }
    __device__ __forceinline__ const float* w_down() const { return pa->in[22]; }
    float* out; unsigned char* ws;
};
#define LDS_WAIT() asm volatile("s_waitcnt lgkmcnt(0)" ::: "memory")

template <int MODE>
__device__ __forceinline__ void p0_transpose_item(const float* W, int K, int N, u16* WT, LAS float* scr, int item, int lane, const float* kscale = nullptr) {
    const int nblk = N / 32, kb = item / nblk, nb = item % nblk, k0 = 64 * kb, n0 = 32 * nb;
#pragma unroll
    for (int i = 0; i < 8; ++i) { const int f = i * 64 + lane, kk = f >> 3, n4 = f & 7;
        f32x4 w = *(const GAS f32x4*)(W + (size_t)(k0 + kk) * N + n0 + 4 * n4); if (MODE == 3) w *= kscale[k0 + kk];
        LAS float* d = scr + kk * 33 + 4 * n4; d[0] = w.x; d[1] = w.y; d[2] = w.z; d[3] = w.w; }
    LDS_WAIT(); asm volatile("" ::: "memory");
    const int c = lane & 7;
#pragma unroll
    for (int j = 0; j < 4; ++j) { const int n = (lane >> 3) + 8 * j; const LAS float* s = scr + (8 * c) * 33 + n;
        u32x4 o;
        if (MODE == 1) { o.x = cvt_pk_f16(s[0 * 33], s[1 * 33]); o.y = cvt_pk_f16(s[2 * 33], s[3 * 33]); o.z = cvt_pk_f16(s[4 * 33], s[5 * 33]); o.w = cvt_pk_f16(s[6 * 33], s[7 * 33]); }
        else { o.x = cvt_pk_bf16(s[0 * 33], s[1 * 33]); o.y = cvt_pk_bf16(s[2 * 33], s[3 * 33]); o.z = cvt_pk_bf16(s[4 * 33], s[5 * 33]); o.w = cvt_pk_bf16(s[6 * 33], s[7 * 33]); }
        int nn = n0 + n;
        if (MODE == 1) nn = (nn & ~255) + 128 * ((nn >> 5) & 1) + 32 * ((nn >> 6) & 3) + (nn & 31);
        if (MODE == 2) { const int bj = nn >= D_FF ? 1 : 0, f = nn - bj * D_FF; nn = 256 * (f >> 7) + 128 * bj + (f & 127); }
        if (MODE == 4) *(GAS u32x4*)(WT + (((nn >> 5) * 4 + (c >> 1)) * 512 + ((c & 1) * 32 + (nn & 31)) * 8)) = o;
        else *(GAS u32x4*)(WT + (size_t)nn * K + k0 + 8 * c) = o; }
    LDS_WAIT(); asm volatile("" ::: "memory");
}
__device__ __forceinline__ void p0_prologue(Frame& F) {
    unsigned char* wsp = F.ws; asm volatile("" : "+s"(wsp));
    LAS float* cl = (LAS float*)(F.lds + CLDS_OFF);
    for (int i = F.tid; i < BATCH * D_MODEL; i += NT) cl[i] = F.c()[i];
    __syncthreads();
    LAS float* scr = (LAS float*)(F.lds + F.wave * 16384);
    constexpr int I_MOD = N_MOD / 64;
    constexpr int I_IN = (D_MODEL / 64) * (N_IN / 32), I_O = (D_MODEL / 64) * (D_MODEL / 32), I_DN = (D_FF / 64) * (D_MODEL / 32), I_L = 8 * 2;
    constexpr int NITEMS = I_IN + I_O + I_DN + 2 * I_L;
    u16* WinT = (u16*)(wsp + WS_WIN); u16* WoT = (u16*)(wsp + WS_WO); u16* WdT = (u16*)(wsp + WS_WDN);
    u16* WaT = (u16*)(wsp + WS_WA); u16* WxT = (u16*)(wsp + WS_WX);
    float* MOD = (float*)(wsp + WS_MOD);
    if (F.vcu < I_MOD) {
        const int col = F.vcu * 64 + F.lane; float a0 = 0.f, a1 = 0.f, a2 = 0.f, a3 = 0.f;
        const float* wp = F.w_ada() + (size_t)(F.wave * 128) * N_MOD + col; const LAS float* cw = cl + F.wave * 128;
#pragma unroll 64
        for (int k = 0; k < 128; ++k) { const float w = wp[(size_t)k * N_MOD];
            a0 += cw[k] * w; a1 += cw[D_MODEL + k] * w; a2 += cw[2 * D_MODEL + k] * w; a3 += cw[3 * D_MODEL + k] * w; }
        LAS float* part = (LAS float*)(F.lds + CLDS_OFF + 16384);
        part[(F.wave * 4 + 0) * 64 + F.lane] = a0; part[(F.wave * 4 + 1) * 64 + F.lane] = a1; part[(F.wave * 4 + 2) * 64 + F.lane] = a2; part[(F.wave * 4 + 3) * 64 + F.lane] = a3;
        __syncthreads();
        if (F.tid < 256) { const int bb = F.tid >> 6, l = F.tid & 63; float s = F.b_ada()[F.vcu * 64 + l];
#pragma unroll
            for (int w = 0; w < 8; ++w) s += part[(w * 4 + bb) * 64 + l];
            MOD[(size_t)bb * N_MOD + F.vcu * 64 + l] = s; }
    }
    const int gw = F.wave * F.G + ((F.vcu + F.G - I_MOD) % F.G), NGW = F.G * NWAVES;
    for (int it = gw; it < NITEMS; it += NGW) {
        int r = it;
        if (r < I_IN) { p0_transpose_item<1>(F.w_in(), D_MODEL, N_IN, WinT, scr, r, F.lane); continue; } r -= I_IN;
        if (r < I_O) { const int kb = r / (D_MODEL / 32); p0_transpose_item<3>(F.w_out(), D_MODEL, D_MODEL, WoT, scr, r, F.lane, (kb < 8 ? F.lru_out_g() : F.attn_out_g() - AW)); continue; } r -= I_O;

        if (r < I_DN) { p0_transpose_item<0>(F.w_down(), D_FF, D_MODEL, WdT, scr, r, F.lane); continue; } r -= I_DN;
        if (r < I_L) { const int h = r >> 1; p0_transpose_item<4>(F.lru_wa() + h * 4096, 64, 64, WaT + h * 4096, scr, r & 1, F.lane); continue; } r -= I_L;
        { const int h = r >> 1; p0_transpose_item<4>(F.lru_wx() + h * 4096, 64, 64, WxT + h * 4096, scr, r & 1, F.lane); }
    }
}


constexpr int SCL_OFF = RING_BYTES;
__device__ __forceinline__ void p1_upweights(Frame& F, unsigned char* wsp) {
    const float* MODp = (const float*)(wsp + WS_MOD);
    LAS float* SC = (LAS float*)(F.lds + SCL_OFF);
#define SHB(b) ((LAS float*)(F.lds + 16384 * (b) + 8448))
    if (F.tid == 0) *(LAS int*)(F.lds + MISC_OFF - 64) = 0;
    for (int i = F.tid; i < BATCH * D_MODEL; i += NT) { const int b = i >> 10, k = i & 1023; SC[i] = F.norm2_g()[k] * (1.0f + MODp[(size_t)b * N_MOD + 4096 + k]); SHB(b)[k] = MODp[(size_t)b * N_MOD + 3072 + k]; }
    __syncthreads();
    LAS float* scr = (LAS float*)(F.lds + F.wave * 16384);
    u16* W4 = (u16*)(wsp + WS_WUP4); float* BIAS2 = (float*)(wsp + WS_BIAS2);
    const float* W = F.w_up();
    const int gw = F.wave * F.G + F.vcu, NGW = F.G * NWAVES, lane = F.lane;
    for (int it = gw; it < 4 * (N_UP / 32); it += NGW) {
        const int n0 = 32 * (it >> 2), kc = it & 3;
        float bs0 = 0.f, bs1 = 0.f, bs2 = 0.f, bs3 = 0.f;
#pragma unroll 1
        for (int kb = 4 * kc; kb < 4 * kc + 4; ++kb) {
            const int k0 = 64 * kb;
#pragma unroll
            for (int i = 0; i < 8; ++i) { const int f = i * 64 + lane, kk = f >> 3, n4 = f & 7;
                const f32x4 w = *(const GAS f32x4*)(W + (size_t)(k0 + kk) * N_UP + n0 + 4 * n4);
                LAS float* d = scr + kk * 33 + 4 * n4; d[0] = w.x; d[1] = w.y; d[2] = w.z; d[3] = w.w; }
            LDS_WAIT(); asm volatile("" ::: "memory");
            { const int n = lane & 31, kh = lane >> 5;
#pragma unroll 8
              for (int kk = 0; kk < 32; ++kk) { const float w = scr[(32 * kh + kk) * 33 + n]; const int k = k0 + 32 * kh + kk;
                  bs0 += SHB(0)[k] * w; bs1 += SHB(1)[k] * w; bs2 += SHB(2)[k] * w; bs3 += SHB(3)[k] * w; } }
            const int c = lane & 7;
#pragma unroll
            for (int j = 0; j < 4; ++j) { const int n = (lane >> 3) + 8 * j; const LAS float* s = scr + (8 * c) * 33 + n;
                int nn = n0 + n; { const int bj = nn >= D_FF ? 1 : 0, f = nn - bj * D_FF; nn = 256 * (f >> 7) + 128 * bj + (f & 127); }
                float wv[8];
#pragma unroll
                for (int e = 0; e < 8; ++e) wv[e] = s[e * 33];
#pragma unroll
                for (int b = 0; b < BATCH; ++b) { const LAS float* sc = SC + b * 1024 + k0 + 8 * c;
                    u32x4 o; o.x = cvt_pk_bf16(wv[0] * sc[0], wv[1] * sc[1]); o.y = cvt_pk_bf16(wv[2] * sc[2], wv[3] * sc[3]); o.z = cvt_pk_bf16(wv[4] * sc[4], wv[5] * sc[5]); o.w = cvt_pk_bf16(wv[6] * sc[6], wv[7] * sc[7]);
                    *(GAS u32x4*)(W4 + ((size_t)b * N_UP + nn) * D_MODEL + k0 + 8 * c) = o; } }
            LDS_WAIT(); asm volatile("" ::: "memory");
        }
        bs0 += __shfl_xor(bs0, 32); bs1 += __shfl_xor(bs1, 32); bs2 += __shfl_xor(bs2, 32); bs3 += __shfl_xor(bs3, 32);
        if (lane < 32) { float* bp = BIAS2 + (size_t)kc * BATCH * N_UP + n0 + lane; bp[0] = bs0; bp[N_UP] = bs1; bp[2 * N_UP] = bs2; bp[3 * N_UP] = bs3; }
    }
}


__device__ __forceinline__ void cb2_prep(Frame& F, unsigned char* wsp) {
    const float* BIAS2 = (const float*)(wsp + WS_BIAS2); float* CB2 = (float*)(wsp + WS_CB2);
    const float* cw = F.ffn_conv_w(); const float* cb = F.ffn_conv_b();
    for (int i = F.vcu * NT + F.tid; i < BATCH * N_UP; i += F.G * NT) { const int b = i / N_UP, col = i % N_UP;
        const float bias = (BIAS2[(size_t)(0 * BATCH + b) * N_UP + col] + BIAS2[(size_t)(1 * BATCH + b) * N_UP + col]) + (BIAS2[(size_t)(2 * BATCH + b) * N_UP + col] + BIAS2[(size_t)(3 * BATCH + b) * N_UP + col]);
        CB2[i] = cb[col] + ((cw[col] + cw[N_UP + col]) + cw[2 * N_UP + col]) * bias; }
}

template <bool F16>
__device__ __forceinline__ void rownorm_phase(Frame& F, const float* X, const float* g, const float* sh, const float* sc, u16* O) {
    LAS int* ctr = (LAS int*)(F.lds + MISC_OFF - 64);
    for (;;) {
        int k = 0; if (F.lane == 0) k = __hip_atomic_fetch_add(ctr, 1, __ATOMIC_RELAXED, __HIP_MEMORY_SCOPE_WORKGROUP);
        k = __builtin_amdgcn_readfirstlane(k);
        const int m0 = (F.vcu + k * F.G) * 4;
        if (m0 >= M_TOK) break;
        const int b = m0 / SEQ;
        f32x4 v[4][4]; float s[4];
#pragma unroll
        for (int r = 0; r < 4; ++r) { const GAS f32x4* xr = (const GAS f32x4*)(X + (size_t)(m0 + r) * D_MODEL) + F.lane; s[r] = 0.f;
#pragma unroll
            for (int j = 0; j < 4; ++j) v[r][j] = xr[64 * j]; }
#pragma unroll
        for (int r = 0; r < 4; ++r)
#pragma unroll
            for (int j = 0; j < 4; ++j) s[r] += (v[r][j].x * v[r][j].x + v[r][j].y * v[r][j].y) + (v[r][j].z * v[r][j].z + v[r][j].w * v[r][j].w);
#pragma unroll
        for (int o = 1; o < 64; o <<= 1) {
#pragma unroll
            for (int r = 0; r < 4; ++r) s[r] += __shfl_xor(s[r], o); }
        float rstd[4];
#pragma unroll
        for (int r = 0; r < 4; ++r) rstd[r] = 1.0f / sqrtf(s[r] * (1.0f / D_MODEL) + EPS);
#pragma unroll
        for (int j = 0; j < 4; ++j) {
            const int col = 4 * F.lane + 256 * j;
            const f32x4 gv = *(const f32x4*)(g + col), shv = *(const f32x4*)(sh + (size_t)b * N_MOD + col), scv = *(const f32x4*)(sc + (size_t)b * N_MOD + col);
            const f32x4 gs = gv * (scv + 1.0f);
#pragma unroll
            for (int r = 0; r < 4; ++r) {
                const f32x4 y = (v[r][j] * rstd[r]) * gs + shv;
                u32x2 w;
                if (F16) { w.x = cvt_pk_f16(y.x, y.y); w.y = cvt_pk_f16(y.z, y.w); } else { w.x = cvt_pk_bf16(y.x, y.y); w.y = cvt_pk_bf16(y.z, y.w); }
                *((GAS u32x2*)(O + (size_t)(m0 + r) * D_MODEL) + F.lane + 64 * j) = w; }
        }
    }
}

__device__ __forceinline__ int crow(int r, int hi) { return (r & 3) + 8 * (r >> 2) + 4 * hi; }
__device__ __forceinline__ int qs_off(int q, int c) { return q * 64 + ((c ^ ((q >> 1) & 7)) << 3); }
constexpr int AL_QS = 0, AL_SLOT = 32768, AL_LSL = 131072, AL_LIST = 134144, AL_CNT = 150528, AL_MISC = 150656, AL_KMS = 150912;
__device__ __forceinline__ void attn_tile(const u16* Kp, const u16* Vp, const s16x8 (&qf)[4], int nkt, bool own, int tt, int qidx, int hi, float c1, float c2, f32x16& o0, f32x16& o1, float& lsum) {
#pragma unroll
    for (int r = 0; r < 16; ++r) { o0[r] = 0.f; o1[r] = 0.f; }
    lsum = 0.f;
    s16x8 kc[4], kn[4], vc[4];
#pragma unroll
    for (int s = 0; s < 4; ++s) { kc[s] = *(const GAS s16x8*)(Kp + s * 512); kn[s] = kc[s]; }
#pragma unroll 1
    for (int kt = 0; kt < nkt; ++kt) {
#pragma unroll
        for (int s = 0; s < 4; ++s) vc[s] = *(const GAS s16x8*)(Vp + (kt * 4 + s) * 512);
        if (kt + 1 < nkt) {
#pragma unroll
            for (int s = 0; s < 4; ++s) kn[s] = *(const GAS s16x8*)(Kp + ((kt + 1) * 4 + s) * 512);
        }
        f32x16 p;
#pragma unroll
        for (int r = 0; r < 16; ++r) p[r] = 0.f;
#pragma unroll
        for (int s = 0; s < 4; ++s) p = __builtin_amdgcn_mfma_f32_32x32x16_bf16(__builtin_bit_cast(bf16x8_t, kc[s]), __builtin_bit_cast(bf16x8_t, qf[s]), p, 0, 0, 0);
        const bool diag = own && (kt == tt);
#pragma unroll
        for (int r = 0; r < 16; ++r) { float e = __builtin_amdgcn_exp2f(p[r] * c1 - c2);
            if (diag && (32 * kt + crow(r, hi) > qidx)) e = 0.f;
            p[r] = e; lsum += e; }
#pragma unroll
        for (int s2 = 0; s2 < 2; ++s2) {
            u32x4 pw; pw.x = cvt_pk_bf16(p[8 * s2 + 0], p[8 * s2 + 1]); pw.y = cvt_pk_bf16(p[8 * s2 + 2], p[8 * s2 + 3]); pw.z = cvt_pk_bf16(p[8 * s2 + 4], p[8 * s2 + 5]); pw.w = cvt_pk_bf16(p[8 * s2 + 6], p[8 * s2 + 7]);
            const bf16x8_t pa = __builtin_bit_cast(bf16x8_t, pw);
            o0 = __builtin_amdgcn_mfma_f32_32x32x16_bf16(pa, __builtin_bit_cast(bf16x8_t, vc[2 * s2]), o0, 0, 0, 0);
            o1 = __builtin_amdgcn_mfma_f32_32x32x16_bf16(pa, __builtin_bit_cast(bf16x8_t, vc[2 * s2 + 1]), o1, 0, 0, 0);
        }
#pragma unroll
        for (int s = 0; s < 4; ++s) kc[s] = kn[s];
    }
}
__device__ __forceinline__ void attn_tile_full(const u16* Kp, const u16* Vp, const LAS u16* QS, int qidx, int hi, float c1, float c2, f32x16& o0, f32x16& o1, float& lsum) {
#pragma unroll
    for (int r = 0; r < 16; ++r) { o0[r] = 0.f; o1[r] = 0.f; }
    lsum = 0.f;
    s16x8 qf[4];
#pragma unroll
    for (int s = 0; s < 4; ++s) qf[s] = *(const LAS s16x8*)(QS + qs_off(qidx, 2 * s + hi));
    s16x8 kr[3][4], vr[3][4];
    const u16* kp = Kp; const u16* vp = Vp;
#pragma unroll
    for (int d = 0; d < 2; ++d) {
#pragma unroll
        for (int s = 0; s < 4; ++s) { kr[d][s] = *(const GAS s16x8*)(kp + s * 512); vr[d][s] = *(const GAS s16x8*)(vp + s * 512); }
        kp += 2048; vp += 2048; asm volatile("" : "+v"(kp), "+v"(vp));
    }
    f32x16 p, pn;
#pragma unroll
    for (int r = 0; r < 16; ++r) p[r] = 0.f;
#pragma unroll
    for (int s = 0; s < 4; ++s) p = __builtin_amdgcn_mfma_f32_32x32x16_bf16(__builtin_bit_cast(bf16x8_t, kr[0][s]), __builtin_bit_cast(bf16x8_t, qf[s]), p, 0, 0, 0);
#pragma unroll
    for (int kt = 0; kt < 8; ++kt) {
        if (kt + 2 < 8) {
#pragma unroll
            for (int s = 0; s < 4; ++s) { kr[(kt + 2) % 3][s] = *(const GAS s16x8*)(kp + s * 512); vr[(kt + 2) % 3][s] = *(const GAS s16x8*)(vp + s * 512); }
            kp += 2048; vp += 2048; asm volatile("" : "+v"(kp), "+v"(vp));
        }
        __builtin_amdgcn_sched_barrier(0);
        if (kt + 1 < 8) {
#pragma unroll
            for (int r = 0; r < 16; ++r) pn[r] = 0.f;
#pragma unroll
            for (int s = 0; s < 4; ++s) pn = __builtin_amdgcn_mfma_f32_32x32x16_bf16(__builtin_bit_cast(bf16x8_t, kr[(kt + 1) % 3][s]), __builtin_bit_cast(bf16x8_t, qf[s]), pn, 0, 0, 0);
        }
#pragma unroll
        for (int r = 0; r < 16; ++r) { const float e = __builtin_amdgcn_exp2f(p[r] * c1 - c2); p[r] = e; lsum += e; }
#pragma unroll
        for (int s2 = 0; s2 < 2; ++s2) {
            u32x4 pw; pw.x = cvt_pk_bf16(p[8 * s2 + 0], p[8 * s2 + 1]); pw.y = cvt_pk_bf16(p[8 * s2 + 2], p[8 * s2 + 3]); pw.z = cvt_pk_bf16(p[8 * s2 + 4], p[8 * s2 + 5]); pw.w = cvt_pk_bf16(p[8 * s2 + 6], p[8 * s2 + 7]);
            const bf16x8_t pa = __builtin_bit_cast(bf16x8_t, pw);
            o0 = __builtin_amdgcn_mfma_f32_32x32x16_bf16(pa, __builtin_bit_cast(bf16x8_t, vr[kt % 3][2 * s2]), o0, 0, 0, 0);
            o1 = __builtin_amdgcn_mfma_f32_32x32x16_bf16(pa, __builtin_bit_cast(bf16x8_t, vr[kt % 3][2 * s2 + 1]), o1, 0, 0, 0);
        }
        if (kt + 1 < 8) p = pn;
        __builtin_amdgcn_sched_barrier(0);
    }
}
__device__ __forceinline__ void attn_item(Frame& F, int bh, int i, float c1, float c2) {
    unsigned char* wsp = F.ws; asm volatile("" : "+s"(wsp));
    const float* QF = (const float*)(wsp + WS_QF); const u16* KB = (const u16*)(wsp + WS_KB); const u16* VT = (const u16*)(wsp + WS_VT);
    const float* KM = (const float*)(wsp + WS_KM); u16* ATT = (u16*)(wsp + WS_MIX); float* SSQA = (float*)(wsp + WS_SSQA);
    LAS u16* QS = (LAS u16*)(F.lds + AL_QS); LAS u16* SLOT = (LAS u16*)(F.lds + AL_SLOT); LAS float* LSL = (LAS float*)(F.lds + AL_LSL);
    LAS float* KMS = (LAS float*)(F.lds + AL_KMS); LAS u16* LIST = (LAS u16*)(F.lds + AL_LIST); LAS int* CNT = (LAS int*)(F.lds + AL_CNT);
    int tid_ = F.tid; asm volatile("" : "+v"(tid_));
    const int tid = tid_, lane = tid & 63, wave = F.wave, hi = lane >> 5, l31 = lane & 31;
    const int b = bh / NHEAD, h = bh % NHEAD;
    for (int u = tid; u < (3 * 32768 + 3072) / 16; u += NT) *(LAS u32x4*)(F.lds + AL_SLOT + u * 16) = (u32x4){0u, 0u, 0u, 0u};
    if (tid < 32) CNT[tid] = 0;
    for (int u = tid; u < NBLK * HD; u += NT) { const int n = u >> 6, d = u & 63; KMS[u] = KM[(((size_t)(b * NBLK + n)) * NHEAD + h) * HD + d] * (1.0f / 256.0f); }
    __syncthreads();
    {
        const int q = 32 * wave + l31;
        const GAS f32x4* qrow = (const GAS f32x4*)(QF + ((size_t)bh * SEQ + (size_t)i * BLK + q) * HD);
        f32x16 p;
#pragma unroll
        for (int r = 0; r < 16; ++r) p[r] = 0.f;
#pragma unroll
        for (int s = 0; s < 4; ++s) {
            const f32x4 qa = qrow[4 * s + 2 * hi], qc = qrow[4 * s + 2 * hi + 1];
            u32x4 qh; qh.x = cvt_pk_bf16(qa.x, qa.y); qh.y = cvt_pk_bf16(qa.z, qa.w); qh.z = cvt_pk_bf16(qc.x, qc.y); qh.w = cvt_pk_bf16(qc.z, qc.w);
            u32x4 ql; ql.x = cvt_pk_bf16(qa.x - bf_lo(qh.x), qa.y - bf_hi(qh.x)); ql.y = cvt_pk_bf16(qa.z - bf_lo(qh.y), qa.w - bf_hi(qh.y));
            ql.z = cvt_pk_bf16(qc.x - bf_lo(qh.z), qc.y - bf_hi(qh.z)); ql.w = cvt_pk_bf16(qc.z - bf_lo(qh.w), qc.w - bf_hi(qh.w));
            *(LAS u32x4*)(QS + qs_off(q, 2 * s + hi)) = qh;
            const LAS f32x4* kr = (const LAS f32x4*)(KMS + l31 * 64 + 16 * s + 8 * hi);
            const f32x4 ka = kr[0], kc = kr[1];
            u32x4 kh; kh.x = cvt_pk_bf16(ka.x, ka.y); kh.y = cvt_pk_bf16(ka.z, ka.w); kh.z = cvt_pk_bf16(kc.x, kc.y); kh.w = cvt_pk_bf16(kc.z, kc.w);
            u32x4 kl; kl.x = cvt_pk_bf16(ka.x - bf_lo(kh.x), ka.y - bf_hi(kh.x)); kl.y = cvt_pk_bf16(ka.z - bf_lo(kh.y), ka.w - bf_hi(kh.y));
            kl.z = cvt_pk_bf16(kc.x - bf_lo(kh.z), kc.y - bf_hi(kh.z)); kl.w = cvt_pk_bf16(kc.z - bf_lo(kh.w), kc.w - bf_hi(kh.w));
            p = __builtin_amdgcn_mfma_f32_32x32x16_bf16(__builtin_bit_cast(bf16x8_t, kl), __builtin_bit_cast(bf16x8_t, qh), p, 0, 0, 0);
            p = __builtin_amdgcn_mfma_f32_32x32x16_bf16(__builtin_bit_cast(bf16x8_t, kh), __builtin_bit_cast(bf16x8_t, ql), p, 0, 0, 0);
            p = __builtin_amdgcn_mfma_f32_32x32x16_bf16(__builtin_bit_cast(bf16x8_t, kh), __builtin_bit_cast(bf16x8_t, qh), p, 0, 0, 0);
        }
        float v0 = -INFINITY, v1 = -INFINITY, v2 = -INFINITY; int i0 = -1, i1 = -1, i2 = -1;
#pragma unroll
        for (int r = 0; r < 16; ++r) {
            const int n = crow(r, hi); const float g = (n < i) ? p[r] : -INFINITY;
            if (g > v0) { v2 = v1; i2 = i1; v1 = v0; i1 = i0; v0 = g; i0 = n; }
            else if (g > v1) { v2 = v1; i2 = i1; v1 = g; i1 = n; }
            else if (g > v2) { v2 = g; i2 = n; }
        }
        const float pv0 = __shfl_xor(v0, 32), pv1 = __shfl_xor(v1, 32), pv2 = __shfl_xor(v2, 32);
        const int pi0 = __shfl_xor(i0, 32), pi1 = __shfl_xor(i1, 32), pi2 = __shfl_xor(i2, 32);
        if (hi == 0) {
            float av[3] = {v0, v1, v2}, bv[3] = {pv0, pv1, pv2}; int ai[3] = {i0, i1, i2}, bi[3] = {pi0, pi1, pi2};
            int sel[3]; int pa = 0, pb = 0;
#pragma unroll
            for (int k = 0; k < 3; ++k) {
                const float ca = pa == 0 ? av[0] : (pa == 1 ? av[1] : av[2]); const int cai = pa == 0 ? ai[0] : (pa == 1 ? ai[1] : ai[2]);
                const float cb = pb == 0 ? bv[0] : (pb == 1 ? bv[1] : bv[2]); const int cbi = pb == 0 ? bi[0] : (pb == 1 ? bi[1] : bi[2]);
                if (ca > cb || (ca == cb && (cbi < 0 || (cai >= 0 && cai < cbi)))) { sel[k] = cai; ++pa; } else { sel[k] = cbi; ++pb; }
            }
#pragma unroll
            for (int k = 0; k < 3; ++k) if (sel[k] >= 0) { const int pos = __hip_atomic_fetch_add(&CNT[sel[k]], 1, __ATOMIC_RELAXED, __HIP_MEMORY_SCOPE_WORKGROUP); LIST[sel[k] * 256 + pos] = (u16)(q | (k << 8)); }
        }
    }
    __syncthreads();
    {
        int base = 0;
        for (int j = 0; j < i; ++j) {
            const int cntj = __builtin_amdgcn_readfirstlane(CNT[j]);
            const int ntj = (cntj + 31) >> 5;
            for (int t = base + ((wave - base) & 7); t < base + ntj; t += 8) {
                const int tt = t - base;
                const int ridx = 32 * tt + l31; const bool valid = ridx < cntj;
                const int ent = valid ? (int)LIST[j * 256 + ridx] : 0;
                const int qidx = ent & 255;
                s16x8 qf[4];
#pragma unroll
                for (int s = 0; s < 4; ++s) qf[s] = *(const LAS s16x8*)(QS + qs_off(qidx, 2 * s + hi));
                const size_t boff = ((size_t)bh * NBLK + j) * (BLK * HD) + lane * 8;
                f32x16 o0, o1; float lsum;
                attn_tile_full(KB + boff, VT + boff, QS, qidx, hi, c1, c2, o0, o1, lsum);
                const int srow = valid ? ((ent >> 8) * 256 + qidx) : -1;
                lsum += __shfl_xor(lsum, 32);
                if (valid && hi == 0) LSL[srow] = lsum;
#pragma unroll
                for (int r = 0; r < 16; ++r) { const int sr = __shfl(srow, crow(r, hi));
                    if (sr >= 0) { const unsigned w = cvt_pk_bf16(o0[r], o1[r]); SLOT[sr * 64 + l31] = (u16)(w & 0xffffu); SLOT[sr * 64 + 32 + l31] = (u16)(w >> 16); }
                    if ((r & 3) == 3) asm volatile("" ::: "memory"); }
            }
            base += ntj;
        }
    }
    f32x16 oo0, oo1; float lown;
    {
        s16x8 qf[4];
#pragma unroll
        for (int s = 0; s < 4; ++s) qf[s] = *(const LAS s16x8*)(QS + qs_off(32 * wave + l31, 2 * s + hi));
        const size_t boff = ((size_t)bh * NBLK + i) * (BLK * HD) + lane * 8;
        attn_tile(KB + boff, VT + boff, qf, wave + 1, true, wave, 32 * wave + l31, hi, c1, c2, oo0, oo1, lown);
    }
    __syncthreads();
    {
        const int q = 32 * wave + l31;
        float lt = lown + __shfl_xor(lown, 32);
        lt += LSL[q] + LSL[256 + q] + LSL[512 + q];
        const float inv = 1.0f / lt;
#pragma unroll
        for (int r = 0; r < 16; ++r) { const int rl = crow(r, hi), qq = 32 * wave + rl; const float iv = __shfl(inv, rl);
            float a = oo0[r], c = oo1[r];
#pragma unroll
            for (int k = 0; k < 3; ++k) { a += __builtin_bit_cast(float, (unsigned)SLOT[(k * 256 + qq) * 64 + l31] << 16); c += __builtin_bit_cast(float, (unsigned)SLOT[(k * 256 + qq) * 64 + 32 + l31] << 16); }
            const unsigned w = cvt_pk_bf16(a * iv, c * iv);
            QS[qq * 64 + l31] = (u16)(w & 0xffffu); QS[qq * 64 + 32 + l31] = (u16)(w >> 16);
            if ((r & 3) == 3) asm volatile("" ::: "memory"); }
        LDS_WAIT(); asm volatile("" ::: "memory");
#pragma unroll
        for (int it = 0; it < 4; ++it) { const int c = lane + 64 * it, row = c >> 3, ch = c & 7;
            const u32x4 w = *(const LAS u32x4*)(QS + (32 * wave + row) * 64 + 8 * ch);
            const size_t tok = (size_t)b * SEQ + (size_t)i * BLK + 32 * wave + row;
            *(GAS u32x4*)(ATT + tok * D_MODEL + AW + h * HD + 8 * ch) = w;
            float ss = bf_lo(w.x) * bf_lo(w.x) + bf_hi(w.x) * bf_hi(w.x) + bf_lo(w.y) * bf_lo(w.y) + bf_hi(w.y) * bf_hi(w.y) + bf_lo(w.z) * bf_lo(w.z) + bf_hi(w.z) * bf_hi(w.z) + bf_lo(w.w) * bf_lo(w.w) + bf_hi(w.w) * bf_hi(w.w);
            ss += __shfl_xor(ss, 1); ss += __shfl_xor(ss, 2); ss += __shfl_xor(ss, 4);
            if (ch == 0) SSQA[tok * NHEAD + h] = ss; }
    }
    __syncthreads();
}
__device__ __forceinline__ void attn_phase(Frame& F) {
    LAS float* mm = (LAS float*)(F.lds + AL_MISC);
    if (F.tid < 64) { float a = fabsf(F.q_norm_g()[F.tid]), c = fabsf(F.k_norm_g()[F.tid]);
#pragma unroll
        for (int o = 1; o < 64; o <<= 1) { a = fmaxf(a, __shfl_xor(a, o)); c = fmaxf(c, __shfl_xor(c, o)); }
        if (F.tid == 0) { mm[0] = a; mm[1] = c; } }
    __syncthreads();
    const float C = 8.0f * mm[0] * mm[1];
    const float c1 = 0.125f * LOG2E, c2 = C * LOG2E;
    __syncthreads();
    if (F.G == 256) {
        const int xcd = F.vcu >> 5, k = F.vcu & 31;
#pragma unroll 1
        for (int r = 0; r < 4; ++r) attn_item(F, xcd * 4 + r, (r & 1) ? 31 - k : k, c1, c2);
    } else {
        for (int it = F.vcu; it < BATCH * NHEAD * NBLK; it += F.G) attn_item(F, it >> 5, it & 31, c1, c2);
    }
}

constexpr int LL_CW = 0;
template <bool FINAL>
__device__ __forceinline__ void lru_item(Frame& F, int b, int chunk) {
    unsigned char* wsp = F.ws; asm volatile("" : "+s"(wsp));
    const u16* XR = (const u16*)(wsp + WS_XR); const u16* GG = (const u16*)(wsp + WS_GG);
    const u16* WaT = (const u16*)(wsp + WS_WA); const u16* WxT = (const u16*)(wsp + WS_WX);
    float* AGG = (float*)(wsp + WS_AGG); u16* LRU = (u16*)(wsp + WS_MIX); float* SSQL = (float*)(wsp + WS_SSQL);
    const int lane0 = F.lane, hd = F.wave, hi0 = lane0 >> 5, j0 = lane0 & 31;
    LAS float* CW = (LAS float*)(F.lds + LL_CW + hd * 2048);
    LAS u16* OT = (LAS u16*)(F.lds + 16384 + hd * 4096);
    for (int u = lane0; u < 320; u += 64) CW[u] = (u < 256) ? F.lru_conv_w()[(u >> 6) * AW + hd * HD + (u & 63)] : F.lru_conv_b()[hd * HD + (u - 256)];
    CW[320 + lane0] = F.lru_ba()[hd * HD + lane0]; CW[384 + lane0] = F.lru_bx()[hd * HD + lane0]; CW[448 + lane0] = 8.0f * log1pf(expf(-F.lru_lambda()[hd * HD + lane0]));
    LDS_WAIT(); asm volatile("" ::: "memory");
    float carry[2], arun[2];
#pragma unroll
    for (int ct = 0; ct < 2; ++ct) { const int c = hd * HD + 32 * ct + j0; carry[ct] = 0.f; arun[ct] = 1.f;
        if (FINAL) { float hcar = 0.f; for (int cc = 0; cc < chunk; ++cc) { const f32x2 ah = *(const f32x2*)(AGG + (((size_t)(b * 64 + cc)) * AW + c) * 2); hcar = ah.x * hcar + ah.y; } carry[ct] = hcar; } }
    for (int tile = 0; tile < 4; ++tile) {
        const int t0 = chunk * 128 + tile * 32;
        const u16* WaTt = WaT; const u16* WxTt = WxT; int lane = lane0; asm volatile("" : "+s"(WaTt), "+s"(WxTt), "+v"(lane));
        const int hi = lane >> 5, j = lane & 31, jt = j;
        const int pos = t0 + j;
        s16x8 af[4];
#pragma unroll
        for (int s = 0; s < 4; ++s) {
            const int ch0 = 16 * s + 8 * hi;
            float xc[8];
            { const LAS f32x4* bp = (const LAS f32x4*)(CW + 256 + ch0); const f32x4 b0 = bp[0], b1 = bp[1];
              xc[0] = b0.x; xc[1] = b0.y; xc[2] = b0.z; xc[3] = b0.w; xc[4] = b1.x; xc[5] = b1.y; xc[6] = b1.z; xc[7] = b1.w; }
            float accv[8];
#pragma unroll
            for (int e = 0; e < 8; ++e) accv[e] = 0.f;
#pragma unroll
            for (int jj = 0; jj < 4; ++jj) {
                const int p = pos - 3 + jj;
                const int pc = p < 0 ? 0 : p;
                u32x4 xw = *(const GAS u32x4*)(XR + ((((size_t)b * (SEQ / 32) + (pc >> 5)) * NHEAD + hd) * 2048) + ((s * 2 + hi) * 32 + (pc & 31)) * 8);
                if (p < 0) xw = (u32x4){0u, 0u, 0u, 0u};
                const LAS f32x4* wp = (const LAS f32x4*)(CW + jj * 64 + ch0); const f32x4 w0 = wp[0], w1 = wp[1];
                accv[0] += w0.x * bf_lo(xw.x); accv[1] += w0.y * bf_hi(xw.x); accv[2] += w0.z * bf_lo(xw.y); accv[3] += w0.w * bf_hi(xw.y);
                accv[4] += w1.x * bf_lo(xw.z); accv[5] += w1.y * bf_hi(xw.z); accv[6] += w1.z * bf_lo(xw.w); accv[7] += w1.w * bf_hi(xw.w);
            }
#pragma unroll
            for (int e = 0; e < 8; ++e) xc[e] += accv[e];
            u32x4 aw; aw.x = cvt_pk_bf16(xc[0], xc[1]); aw.y = cvt_pk_bf16(xc[2], xc[3]); aw.z = cvt_pk_bf16(xc[4], xc[5]); aw.w = cvt_pk_bf16(xc[6], xc[7]);
            af[s] = __builtin_bit_cast(s16x8, aw);
        }
        float ssacc[16];
#pragma unroll
        for (int r = 0; r < 16; ++r) ssacc[r] = 0.f;
#pragma unroll
        for (int ct = 0; ct < 2; ++ct) {
            float av[16], uv[16];
            {
                f32x16 aA, aX;
#pragma unroll
                for (int r = 0; r < 16; ++r) { aA[r] = 0.f; aX[r] = 0.f; }
#pragma unroll
                for (int s = 0; s < 4; ++s) {
                    const size_t woff = (size_t)hd * 4096 + (ct * 4 + s) * 512 + lane * 8;
                    const s16x8 wa = *(const GAS s16x8*)(WaTt + woff), wx = *(const GAS s16x8*)(WxTt + woff);
                    const bf16x8_t a = __builtin_bit_cast(bf16x8_t, af[s]);
                    aA = __builtin_amdgcn_mfma_f32_32x32x16_bf16(a, __builtin_bit_cast(bf16x8_t, wa), aA, 0, 0, 0);
                    aX = __builtin_amdgcn_mfma_f32_32x32x16_bf16(a, __builtin_bit_cast(bf16x8_t, wx), aX, 0, 0, 0);
                }
                const float bac = CW[320 + 32 * ct + jt], bxc = CW[384 + 32 * ct + jt], sp8c = CW[448 + 32 * ct + jt];
#pragma unroll
                for (int r = 0; r < 16; ++r) {
                    const float rr = sigmoidf_(aA[r] + bac), ii = sigmoidf_(aX[r] + bxc);
                    const float la = -rr * sp8c;
                    const float a = __builtin_amdgcn_exp2f(la * LOG2E);
                    const float om = fmaf(-a, a, 1.0f);
                    av[r] = a; uv[r] = __builtin_amdgcn_sqrtf(om) * ii;
                }
            }
            f32x16 aG;
            {
                f32x16 aI;
#pragma unroll
                for (int r = 0; r < 16; ++r) { aI[r] = 0.f; aG[r] = 0.f; }
#pragma unroll
                for (int s = 0; s < 4; ++s) {
                    s16x8 id;
#pragma unroll
                    for (int e = 0; e < 8; ++e) id[e] = (16 * s + 8 * hi + e == 32 * ct + jt) ? (short)0x3F80 : (short)0;
                    aI = __builtin_amdgcn_mfma_f32_32x32x16_bf16(__builtin_bit_cast(bf16x8_t, af[s]), __builtin_bit_cast(bf16x8_t, id), aI, 0, 0, 0);
                    if (FINAL) { const s16x8 gfr = *(const GAS s16x8*)(GG + ((((size_t)b * (SEQ / 32) + (t0 >> 5)) * NHEAD + hd) * 2048) + s * 512 + lane * 8);
                        aG = __builtin_amdgcn_mfma_f32_32x32x16_bf16(__builtin_bit_cast(bf16x8_t, gfr), __builtin_bit_cast(bf16x8_t, id), aG, 0, 0, 0); }
                }
#pragma unroll
                for (int r = 0; r < 16; ++r) uv[r] *= aI[r];
            }
            float Ag[4], Ug[4];
#pragma unroll
            for (int g = 0; g < 4; ++g) { float A = av[4 * g], U = uv[4 * g];
#pragma unroll
                for (int e = 1; e < 4; ++e) { A *= av[4 * g + e]; U = av[4 * g + e] * U + uv[4 * g + e]; }
                Ag[g] = A; Ug[g] = U; }
            float h = carry[ct], ap = arun[ct];
            float hin[4];
#pragma unroll
            for (int g = 0; g < 4; ++g) {
                const float pA = __shfl_xor(Ag[g], 32), pU = __shfl_xor(Ug[g], 32);
                const float fA = hi ? pA : Ag[g], fU = hi ? pU : Ug[g], sA = hi ? Ag[g] : pA, sU = hi ? Ug[g] : pU;
                const float h1 = fA * h + fU;
                hin[g] = hi ? h1 : h;
                h = sA * h1 + sU; ap *= fA * sA;
            }
            carry[ct] = h; arun[ct] = ap;
            if (FINAL) {
#pragma unroll
                for (int g = 0; g < 4; ++g) { float hh = hin[g];
#pragma unroll
                    for (int e = 0; e < 4; ++e) { const int r = 4 * g + e; hh = av[r] * hh + uv[r]; const float o = hh * aG[r]; ssacc[r] += o * o;
                        OT[crow(r, hi) * 64 + 32 * ct + j] = (u16)(cvt_pk_bf16(o, 0.f) & 0xffffu); } }
            }
        }
        if (FINAL) {
#pragma unroll
            for (int r = 0; r < 16; ++r) {
                const size_t tok = (size_t)b * SEQ + t0 + crow(r, hi);
                float ss = ssacc[r];
                ss += __shfl_xor(ss, 1); ss += __shfl_xor(ss, 2); ss += __shfl_xor(ss, 4); ss += __shfl_xor(ss, 8); ss += __shfl_xor(ss, 16);
                if (j == 0) SSQL[tok * NHEAD + hd] = ss;
            }
            LDS_WAIT(); asm volatile("" ::: "memory");
#pragma unroll
            for (int it = 0; it < 4; ++it) { const int c = lane + 64 * it, row = c >> 3, ch = c & 7;
                const u32x4 w = *(const LAS u32x4*)(OT + row * 64 + 8 * ch);
                *(GAS u32x4*)(LRU + ((size_t)b * SEQ + t0 + row) * D_MODEL + hd * HD + 8 * ch) = w; }
            LDS_WAIT(); asm volatile("" ::: "memory");
        }
    }
    if (!FINAL) { if (hi0 == 0) {
#pragma unroll
        for (int ct = 0; ct < 2; ++ct) { const int c = hd * HD + 32 * ct + j0; *(f32x2*)(AGG + (((size_t)(b * 64 + chunk)) * AW + c) * 2) = (f32x2){arun[ct], carry[ct]}; } } }
}
template <bool FINAL>
__device__ __forceinline__ void lru_phase(Frame& F) {
    for (int it = F.vcu; it < BATCH * 64; it += F.G) { lru_item<FINAL>(F, it >> 6, it & 63); }
}

__device__ __forceinline__ void mix_phase(Frame& F) {
    unsigned char* wsp = F.ws; asm volatile("" : "+s"(wsp));
    const u16* LRU = (const u16*)(wsp + WS_LRU); const u16* ATT = (const u16*)(wsp + WS_ATT);
    const float* SSQL = (const float*)(wsp + WS_SSQL); const float* SSQA = (const float*)(wsp + WS_SSQA); u16* MIX = (u16*)(wsp + WS_MIX);
    const int gw = F.vcu * NWAVES + F.wave, NGW = F.G * NWAVES, lane = F.lane;
    const f32x4 gl0 = *(const f32x4*)(F.lru_out_g() + 8 * lane), gl1 = *(const f32x4*)(F.lru_out_g() + 8 * lane + 4);
    const f32x4 ga0 = *(const f32x4*)(F.attn_out_g() + 8 * lane), ga1 = *(const f32x4*)(F.attn_out_g() + 8 * lane + 4);
    for (int m = gw; m < M_TOK; m += NGW) {
        const f32x4 s0 = *(const GAS f32x4*)(SSQL + (size_t)m * 8), s1 = *(const GAS f32x4*)(SSQL + (size_t)m * 8 + 4);
        const f32x4 t0 = *(const GAS f32x4*)(SSQA + (size_t)m * 8), t1 = *(const GAS f32x4*)(SSQA + (size_t)m * 8 + 4);
        const float ssl = ((s0.x + s0.y) + (s0.z + s0.w)) + ((s1.x + s1.y) + (s1.z + s1.w));
        const float ssa = ((t0.x + t0.y) + (t0.z + t0.w)) + ((t1.x + t1.y) + (t1.z + t1.w));
        const float rl = 1.0f / sqrtf(ssl * (1.0f / AW) + EPS), ra = 1.0f / sqrtf(ssa * (1.0f / AW) + EPS);
        const u32x4 lw = *(const GAS u32x4*)(LRU + (size_t)m * AW + 8 * lane), aw = *(const GAS u32x4*)(ATT + (size_t)m * AW + 8 * lane);
        u32x4 o;
        o.x = cvt_pk_bf16(bf_lo(lw.x) * rl * gl0.x, bf_hi(lw.x) * rl * gl0.y); o.y = cvt_pk_bf16(bf_lo(lw.y) * rl * gl0.z, bf_hi(lw.y) * rl * gl0.w);
        o.z = cvt_pk_bf16(bf_lo(lw.z) * rl * gl1.x, bf_hi(lw.z) * rl * gl1.y); o.w = cvt_pk_bf16(bf_lo(lw.w) * rl * gl1.z, bf_hi(lw.w) * rl * gl1.w);
        *(GAS u32x4*)(MIX + (size_t)m * D_MODEL + 8 * lane) = o;
        o.x = cvt_pk_bf16(bf_lo(aw.x) * ra * ga0.x, bf_hi(aw.x) * ra * ga0.y); o.y = cvt_pk_bf16(bf_lo(aw.y) * ra * ga0.z, bf_hi(aw.y) * ra * ga0.w);
        o.z = cvt_pk_bf16(bf_lo(aw.z) * ra * ga1.x, bf_hi(aw.z) * ra * ga1.y); o.w = cvt_pk_bf16(bf_lo(aw.w) * ra * ga1.z, bf_hi(aw.w) * ra * ga1.w);
        *(GAS u32x4*)(MIX + (size_t)m * D_MODEL + AW + 8 * lane) = o;
    }
}

__device__ __forceinline__ void ffn_fixup(Frame& F, unsigned char* wsp, int pm) {
    const float* RAW = (const float*)(wsp + WS_RAW); u16* ACT = (u16*)(wsp + WS_ACT);
    const float* cw = F.ffn_conv_w(); const float* cb = F.ffn_conv_b();
    const bool first = (pm % NBLK) == 0;
    for (int f = F.tid; f < D_FF; f += NT) {
        float xg[4], xv[4];
        xg[0] = first ? 0.f : RAW[((size_t)(pm - 1) * 4 + 2) * N_UP + f]; xg[1] = first ? 0.f : RAW[((size_t)(pm - 1) * 4 + 3) * N_UP + f];
        xv[0] = first ? 0.f : RAW[((size_t)(pm - 1) * 4 + 2) * N_UP + D_FF + f]; xv[1] = first ? 0.f : RAW[((size_t)(pm - 1) * 4 + 3) * N_UP + D_FF + f];
        xg[2] = RAW[((size_t)pm * 4 + 0) * N_UP + f]; xg[3] = RAW[((size_t)pm * 4 + 1) * N_UP + f];
        xv[2] = RAW[((size_t)pm * 4 + 0) * N_UP + D_FF + f]; xv[3] = RAW[((size_t)pm * 4 + 1) * N_UP + D_FF + f];
        const float wg0 = cw[f], wg1 = cw[N_UP + f], wg2 = cw[2 * N_UP + f], bg = cb[f];
        const float wv0 = cw[D_FF + f], wv1 = cw[N_UP + D_FF + f], wv2 = cw[2 * N_UP + D_FF + f], bv = cb[D_FF + f];
#pragma unroll
        for (int r = 0; r < 2; ++r) {
            const float cg = ((wg0 * xg[r] + wg1 * xg[r + 1]) + wg2 * xg[r + 2]) + bg;
            const float cv = ((wv0 * xv[r] + wv1 * xv[r + 1]) + wv2 * xv[r + 2]) + bv;
            ACT[((size_t)pm * 256 + r) * D_FF + f] = (u16)(cvt_pk_bf16(cg * sigmoidf_(cg) * cv, 0.f) & 0xffffu);
        }
    }
}

constexpr int N_PHASES = 10;
__global__ void __launch_bounds__(NT, 2) hymba_fwd(Args args) {
    extern __shared__ __attribute__((aligned(16))) unsigned char lds_raw[];
    Frame F;
    F.lds = (LAS unsigned char*)lds_raw;
    F.tid = threadIdx.x; F.lane = F.tid & 63; F.wave = __builtin_amdgcn_readfirstlane(F.tid >> 6); F.wave0 = F.wave;
    F.G = gridDim.x; { const int bx = blockIdx.x; F.vcu = (F.G % 8 == 0) ? (bx % 8) * (F.G / 8) + bx / 8 : bx; }
    F.pa = &args;
    F.out = args.out; F.ws = args.ws;
    volatile LAS unsigned* MISC = (volatile LAS unsigned*)(F.lds + MISC_OFF);
    if (F.tid < 32) MISC[F.tid] = 0u;
    __syncthreads();
    const int lo = args.ph_lo, hi = args.ph_hi;
#ifndef PROBE_PH
#define PROBE_PH -1
#endif
    unsigned long long tpa = 0, tpb = 0;
#define TP_A(k) do { if ((k) == PROBE_PH) tpa = __builtin_amdgcn_s_memrealtime(); } while (0)
#define TP_B(k) do { if ((k) == PROBE_PH) tpb = __builtin_amdgcn_s_memrealtime(); } while (0)
    unsigned* ctl = (unsigned*)(F.ws + WS_CTL);
    XcdBarrier bar; bar.bar = ctl + CW_BAR; bar.x = 0; bar.st = nullptr;
    if (hi - lo > 1) bar = xcd_barrier_post(ctl + CW_BAR, MISC + 8);
#ifndef PHASE_MASK
#define PHASE_MASK 0x3FF
#endif
#define IN(k) (((PHASE_MASK >> (k)) & 1) && lo <= (k) && (k) < hi)
#ifndef DUP_MASK
#define DUP_MASK 0
#endif
#define REP(k) _Pragma("unroll 1") for (int rep_ = 0; rep_ < 1 + ((DUP_MASK >> (k)) & 1); ++rep_)
#ifndef XBAR
#define XBAR 0
#endif
#define SEAM(k) do { if (IN(k) && IN((k) + 1)) { xcd_barrier(bar, F.wave0 * 64 + lane_id()); for (int xb_ = 0; xb_ < XBAR; ++xb_) xcd_barrier(bar, F.wave0 * 64 + lane_id()); } } while (0)
#define MOD ((float*)(wsp + WS_MOD))
#define H ((u16*)(wsp + WS_H))

    TP_A(0);
    if (IN(0)) { unsigned char* wsp = F.ws; asm volatile("" : "+s"(wsp)); { int t_ = F.wave0 * 64 + lane_id(); asm volatile("" : "+v"(t_)); F.tid = t_; F.lane = t_ & 63; F.wave = __builtin_amdgcn_readfirstlane(t_ >> 6); } REP(0) p0_prologue(F); SEAM(0); }
    TP_B(0);
    TP_A(1);
    if (IN(1)) { unsigned char* wsp = F.ws; asm volatile("" : "+s"(wsp)); { int t_ = F.wave0 * 64 + lane_id(); asm volatile("" : "+v"(t_)); F.tid = t_; F.lane = t_ & 63; F.wave = __builtin_amdgcn_readfirstlane(t_ >> 6); } REP(1) { p1_upweights(F, wsp); rownorm_phase<true>(F, F.x(), F.norm1_g(), MOD + 0, MOD + 1024, H); } SEAM(1); }
    TP_B(1);
    TP_A(2);
    if (IN(2)) { unsigned char* wsp = F.ws; asm volatile("" : "+s"(wsp)); { int t_ = F.wave0 * 64 + lane_id(); asm volatile("" : "+v"(t_)); F.tid = t_; F.lane = t_ & 63; F.wave = __builtin_amdgcn_readfirstlane(t_ >> 6); }
        pg8::Gemm g{H, (const u16*)(wsp + WS_WIN), M_TOK, N_IN, D_MODEL, 0}; pg8::StaticOrder S; S.init(M_TOK, N_IN, F.G, (int)blockIdx.x);
        pg8::EpiInProj E{(float*)(wsp + WS_QF), (u16*)(wsp + WS_KB), (u16*)(wsp + WS_VT), (u16*)(wsp + WS_XR), (u16*)(wsp + WS_GG), (float*)(wsp + WS_KM), F.q_norm_g(), F.k_norm_g()};
        REP(2) pg8::gemm_phase<pg8::EpiInProj, pg8::StaticOrder, true, true, true>(F.lds, g, S, E, F.wave0);
        SEAM(2);
    }
    TP_B(2);
    TP_A(3);
    if (IN(3)) { unsigned char* wsp = F.ws; asm volatile("" : "+s"(wsp)); { int t_ = F.wave0 * 64 + lane_id(); asm volatile("" : "+v"(t_)); F.tid = t_; F.lane = t_ & 63; F.wave = __builtin_amdgcn_readfirstlane(t_ >> 6); }
        cb2_prep(F, wsp); REP(13) lru_phase<false>(F);
        asm volatile("s_waitcnt vmcnt(0)" ::: "memory"); __syncthreads();
        if (F.tid == 0) { __builtin_amdgcn_fence(__ATOMIC_RELEASE, "agent"); asm volatile("s_waitcnt vmcnt(0)" ::: "memory"); (void)__hip_atomic_fetch_add(ctl + CW_AGGCNT, 1u, __ATOMIC_RELAXED, __HIP_MEMORY_SCOPE_AGENT); }
        { int t_ = F.wave0 * 64 + lane_id(); asm volatile("" : "+v"(t_)); F.tid = t_; F.lane = t_ & 63; F.wave = __builtin_amdgcn_readfirstlane(t_ >> 6); } REP(3) attn_phase(F);
        { int t_ = F.wave0 * 64 + lane_id(); asm volatile("" : "+v"(t_)); F.tid = t_; F.lane = t_ & 63; F.wave = __builtin_amdgcn_readfirstlane(t_ >> 6); }
        if (F.tid < 64) { unsigned sp = 0;
            while ((unsigned)__builtin_amdgcn_readfirstlane(__hip_atomic_load(ctl + CW_AGGCNT, __ATOMIC_RELAXED, __HIP_MEMORY_SCOPE_AGENT)) < (unsigned)F.G) {
                __builtin_amdgcn_s_sleep(2); if (++sp > (1u << 20)) { if (F.tid == 0) atomicAdd(ctl + CW_BAR + XB_TMO, 1u); break; } }
            __builtin_amdgcn_fence(__ATOMIC_ACQUIRE, "agent"); asm volatile("s_waitcnt vmcnt(0)" ::: "memory"); }
        __syncthreads();
        REP(4) lru_phase<true>(F);
        if (IN(3) && IN(6)) xcd_barrier(bar, F.wave0 * 64 + lane_id()); }
    TP_B(3);
    TP_A(4);
    TP_B(4);
    TP_A(6);
    if (IN(6)) { unsigned char* wsp = F.ws; asm volatile("" : "+s"(wsp)); { int t_ = F.wave0 * 64 + lane_id(); asm volatile("" : "+v"(t_)); F.tid = t_; F.lane = t_ & 63; F.wave = __builtin_amdgcn_readfirstlane(t_ >> 6); }
        pg8::Gemm g{(const u16*)(wsp + WS_MIX), (const u16*)(wsp + WS_WO), M_TOK, D_MODEL, D_MODEL, 0}; pg8::StaticOrder S; S.init(M_TOK, D_MODEL, F.G, (int)blockIdx.x);
        LAS f32x2* RT = (LAS f32x2*)(F.lds + XB_OFF);
        { const float* SSQL = (const float*)(wsp + WS_SSQL); const float* SSQA = (const float*)(wsp + WS_SSQA);
          for (int i = 0; i < 8; ++i) { pg8::Unit uu; if (!S.next(i, uu)) break;
              if (F.tid < 256) { const size_t row = (size_t)uu.pm * 256 + F.tid;
                  const f32x4 s0 = *(const f32x4*)(SSQL + row * 8), s1 = *(const f32x4*)(SSQL + row * 8 + 4), t0 = *(const f32x4*)(SSQA + row * 8), t1 = *(const f32x4*)(SSQA + row * 8 + 4);
                  const float ssl = ((s0[0] + s0[1]) + (s0[2] + s0[3])) + ((s1[0] + s1[1]) + (s1[2] + s1[3])), ssa = ((t0[0] + t0[1]) + (t0[2] + t0[3])) + ((t1[0] + t1[1]) + (t1[2] + t1[3]));
                  const float rl = 1.0f / sqrtf(ssl * (1.0f / AW) + EPS), ra = 1.0f / sqrtf(ssa * (1.0f / AW) + EPS);
                  RT[i * 256 + F.tid] = (f32x2){rl / ra, ra}; } }
          __syncthreads(); }
        pg8::EpiOut E{F.x(), H, (float*)(wsp + WS_SSQX), MOD + 2048, RT};
        REP(6) pg8::gemm_phase<pg8::EpiOut, pg8::StaticOrder, true, true, false>(F.lds, g, S, E, F.wave0);
        if (IN(6) && IN(8)) xcd_barrier(bar, F.wave0 * 64 + lane_id());
    }
    TP_B(6);
    TP_A(8);
    if (IN(8)) { unsigned char* wsp = F.ws; asm volatile("" : "+s"(wsp)); { int t_ = F.wave0 * 64 + lane_id(); asm volatile("" : "+v"(t_)); F.tid = t_; F.lane = t_ & 63; F.wave = __builtin_amdgcn_readfirstlane(t_ >> 6); }
        pg8::Gemm g{H, (const u16*)(wsp + WS_WUP4), M_TOK, N_UP, D_MODEL, (size_t)N_UP * D_MODEL * 2}; pg8::StaticOrder S; S.init(M_TOK, N_UP, F.G, (int)blockIdx.x);
        LAS float* R2ALL = (LAS float*)(F.lds + XB_OFF + 8192); LAS float* CT = (LAS float*)(F.lds + XB_OFF + 8192 + 12 * 1024);
        { const float* SSQX = (const float*)(wsp + WS_SSQX);
          for (int i = 0; i < 12; ++i) { pg8::Unit uu; if (!S.next(i, uu)) break;
              if (F.tid < 256) { const size_t row = (size_t)uu.pm * 256 + F.tid;
                  const f32x4 s0 = *(const f32x4*)(SSQX + row * 16), s1 = *(const f32x4*)(SSQX + row * 16 + 4), s2 = *(const f32x4*)(SSQX + row * 16 + 8), s3 = *(const f32x4*)(SSQX + row * 16 + 12);
                  const float ss = (((s0[0] + s0[1]) + (s0[2] + s0[3])) + ((s1[0] + s1[1]) + (s1[2] + s1[3]))) + (((s2[0] + s2[1]) + (s2[2] + s2[3])) + ((s3[0] + s3[1]) + (s3[2] + s3[3])));
                  R2ALL[i * 256 + F.tid] = 1.0f / sqrtf(ss * (1.0f / D_MODEL) + EPS); } }
          __syncthreads(); }
        pg8::EpiFFN E{(u16*)(wsp + WS_ACT), (float*)(wsp + WS_RAW), F.ffn_conv_w(), (const float*)(wsp + WS_CB2), (LAS float*)(F.lds + XB_OFF), (const float*)(wsp + WS_SSQX), (const float*)(wsp + WS_BIAS2), R2ALL, CT};
        REP(8) pg8::gemm_phase<pg8::EpiFFN, pg8::StaticOrder, true, true, false>(F.lds, g, S, E, F.wave0);
        SEAM(8);
    }
    TP_B(8);
    TP_A(9);
    if (IN(9)) { unsigned char* wsp = F.ws; asm volatile("" : "+s"(wsp)); { int t_ = F.wave0 * 64 + lane_id(); asm volatile("" : "+v"(t_)); F.tid = t_; F.lane = t_ & 63; F.wave = __builtin_amdgcn_readfirstlane(t_ >> 6); }
        pg8::Gemm g{(const u16*)(wsp + WS_ACT), (const u16*)(wsp + WS_WDN), M_TOK, D_MODEL, D_FF, 0}; pg8::StaticOrder S; S.init(M_TOK, D_MODEL, F.G, (int)blockIdx.x);
        { pg8::Unit u0, u1; int pm0 = -1; if (S.next(0, u0)) { pm0 = u0.pm; ffn_fixup(F, wsp, pm0); } if (S.next(1, u1) && u1.pm != pm0) ffn_fixup(F, wsp, u1.pm);
          for (int i = 2; ; ++i) { pg8::Unit ux; if (!S.next(i, ux)) break; ffn_fixup(F, wsp, ux.pm); }
          asm volatile("s_waitcnt vmcnt(0)" ::: "memory"); __syncthreads(); }
        pg8::EpiResidB E{H, F.out, MOD + 5120};
        REP(9) pg8::gemm_phase<pg8::EpiResidB, pg8::StaticOrder, true, true, false>(F.lds, g, S, E, F.wave0);
    }
    TP_B(9);
    if (PROBE_PH >= 0 && blockIdx.x == 0) { const unsigned long long t0 = __builtin_amdgcn_s_memrealtime(); const unsigned long long want = 4ull * (tpb - tpa);
        while (__builtin_amdgcn_s_memrealtime() - t0 < want) __builtin_amdgcn_s_sleep(8); }
    if (hi - lo > 1 && hi == N_PHASES) {
        if (xb_ld(ctl + CW_BAR + XB_TMO) != 0u) { asm volatile("s_waitcnt vmcnt(0)" ::: "memory"); __syncthreads();
            for (size_t i = (size_t)blockIdx.x * NT + F.tid; i < (size_t)M_TOK * D_MODEL; i += (size_t)F.G * NT) F.out[i] = __builtin_nanf(""); }
    }
#undef IN
#undef MOD
#undef H
#undef SEAM
}

#ifndef MK_PER_PHASE
#define MK_PER_PHASE 0
#endif
extern "C" void kernel_launch(void* const* d_in, const int* in_sizes, int n_in, void* d_out, int out_size, void* d_ws, size_t ws_size, hipStream_t stream) {
    static int grid = 0;
    if (grid == 0) {
        if (n_in != 23 || in_sizes[0] != M_TOK * D_MODEL || out_size != M_TOK * D_MODEL || ws_size < WS_END) {
            fprintf(stderr, "kernel_launch: unexpected shapes (n_in %d, in0 %d, out %d, ws %zu); nothing launched\n", n_in, n_in > 0 ? in_sizes[0] : -1, out_size, ws_size); grid = -1; return; }
        int dev = 0, cus = 0;
        if (hipGetDevice(&dev) != hipSuccess || hipDeviceGetAttribute(&cus, hipDeviceAttributeMultiprocessorCount, dev) != hipSuccess) { grid = -1; return; }
        if (hipFuncSetAttribute((const void*)hymba_fwd, hipFuncAttributeMaxDynamicSharedMemorySize, LDS_BYTES) != hipSuccess) { fprintf(stderr, "kernel_launch: hipFuncSetAttribute failed\n"); grid = -1; return; }
        grid = cus;
    }
    if (grid < 0) return;
    (void)hipMemsetAsync((char*)d_ws + WS_CTL, 0, CTL_ZERO_BYTES, stream);
    Args a{};
    for (int i = 0; i < 23; ++i) a.in[i] = (const float*)d_in[i];
    a.out = (float*)d_out; a.ws = (unsigned char*)d_ws;
#if MK_PER_PHASE
    for (int p = 0; p < N_PHASES; ++p) { a.ph_lo = p; a.ph_hi = p + 1; hipLaunchKernelGGL(hymba_fwd, dim3(grid), dim3(NT), LDS_BYTES, stream, a); }
#else
    a.ph_lo = 0; a.ph_hi = N_PHASES; hipLaunchKernelGGL(hymba_fwd, dim3(grid), dim3(NT), LDS_BYTES, stream, a);
#endif
}
```

```cpp
#include <hip/hip_runtime.h>
#include <cstdio>
#include <cstdint>

#define GAS __attribute__((address_space(1)))
#define LAS __attribute__((address_space(3)))
typedef unsigned short u16;
typedef short s16x8 __attribute__((ext_vector_type(8)));
typedef _Float16 f16x8 __attribute__((ext_vector_type(8)));
typedef __bf16 bf16x8_t __attribute__((ext_vector_type(8)));
typedef float f32x2 __attribute__((ext_vector_type(2)));
typedef float f32x4 __attribute__((ext_vector_type(4)));
typedef float f32x16 __attribute__((ext_vector_type(16)));
typedef unsigned u32x4 __attribute__((ext_vector_type(4)));
typedef unsigned u32x2 __attribute__((ext_vector_type(2)));
typedef GAS unsigned gu32;
#define RLX_AGENT __ATOMIC_RELAXED, __HIP_MEMORY_SCOPE_AGENT

constexpr int D_MODEL = 1024, BATCH = 4, SEQ = 8192, M_TOK = BATCH * SEQ;
constexpr int N_IN = 2560, D_FF = 2816, N_UP = 2 * D_FF, N_MOD = 6 * D_MODEL;
constexpr int NHEAD = 8, HD = 64, AW = 512, NBLK = 32, BLK = 256;
constexpr float EPS = 1e-6f;
constexpr float LOG2E = 1.4426950408889634f;

__device__ __forceinline__ unsigned cvt_pk_bf16(float lo, float hi) { unsigned r; asm volatile("v_cvt_pk_bf16_f32 %0, %1, %2" : "=v"(r) : "v"(lo), "v"(hi)); return r; }
__device__ __forceinline__ unsigned cvt_pk_f16(float lo, float hi) {
    const _Float16 a = (_Float16)lo, b = (_Float16)hi;
    return (unsigned)__builtin_bit_cast(unsigned short, a) | ((unsigned)__builtin_bit_cast(unsigned short, b) << 16);
}
__device__ __forceinline__ float bf_lo(unsigned w) { return __builtin_bit_cast(float, w << 16); }
__device__ __forceinline__ float bf_hi(unsigned w) { return __builtin_bit_cast(float, w & 0xffff0000u); }
__device__ __forceinline__ float sigmoidf_(float v) { return __builtin_amdgcn_rcpf(1.0f + __builtin_amdgcn_exp2f(-v * LOG2E)); }
__device__ __forceinline__ float gelu_tanh(float v) { const float y = 0.7978845608028654f * (v + 0.044715f * v * v * v); return v * sigmoidf_(2.0f * y); }
__device__ __forceinline__ float wave_sum(float v) {
#pragma unroll
    for (int o = 1; o < 64; o <<= 1) v += __shfl_xor(v, o);
    return v;
}

__device__ __forceinline__ int lane_id() { int l; asm volatile("v_mbcnt_lo_u32_b32 %0, -1, 0\n\tv_mbcnt_hi_u32_b32 %0, -1, %0" : "=v"(l)); return l; }

namespace pg8 {
constexpr int BM = 256, BK = 64, HALF = 128, HTB = HALF * BK * 2, STAGE_BYTES = 8 * HTB, NXCD = 8, WGM = 8;
__host__ __device__ __forceinline__ int lds_byte(int r, int c) { const int st = (r >> 4) * 2 + (c >> 5), rr = r & 15, cc = c & 31, ob = rr * 64 + cc * 2; return st * 1024 + (ob ^ (((ob >> 9) & 1) << 5)); }
__host__ __device__ __forceinline__ void stage_rc(int b, int& R, int& C) { const int st = b / 1024, sb = b % 1024, swz = sb ^ (((sb >> 9) & 1) << 5); R = (st >> 1) * 16 + swz / 64; C = (st & 1) * 32 + (swz % 64) / 2; }
__host__ __device__ __forceinline__ int perm32(int rho) { const int n = rho >> 4, i = rho & 15; return 8 * (i >> 2) + 4 * n + (i & 3); }

struct Unit { int pm, pn, ord; };
struct Gemm { const u16* A; const u16* Bt; int M, N, K; size_t bstride; };

struct StaticOrder {
    int nM, nN, nwg, G, c;
    __host__ __device__ __forceinline__ void init(int M, int N, int G_, int c_) { nM = M / BM; nN = N / BM; nwg = nM * nN; G = G_; c = c_; }
    __host__ __device__ __forceinline__ bool next(int i, Unit& u) const {
        const long L = (long)i * G + c; if (L >= nwg) return false;
        int wgid = (int)L; { const int q = nwg / NXCD, r = nwg % NXCD, xcd = wgid % NXCD, off = wgid / NXCD; wgid = (xcd < r ? xcd * (q + 1) : r * (q + 1) + (xcd - r) * q) + off; }
        const int nig = WGM * nN, gid = wgid / nig, fm = gid * WGM, gsz = (nM - fm) < WGM ? (nM - fm) : WGM;
        u.pm = fm + ((wgid % nig) % gsz); u.pn = (wgid % nig) / gsz; u.ord = i; return true;
    }
    __device__ __forceinline__ void a_ready(const Unit&) const {}
    __device__ __forceinline__ void done(const Unit&) const {}
};

template <bool F16> __device__ __forceinline__ f32x4 mfma16(s16x8 a, s16x8 b, f32x4 c) {
    if constexpr (F16) return __builtin_amdgcn_mfma_f32_16x16x32_f16(__builtin_bit_cast(f16x8, a), __builtin_bit_cast(f16x8, b), c, 0, 0, 0);
    else return __builtin_amdgcn_mfma_f32_16x16x32_bf16(__builtin_bit_cast(bf16x8_t, a), __builtin_bit_cast(bf16x8_t, b), c, 0, 0, 0);
}

template <class Epi, class Sched, bool ALIGN_EPI, bool SP2, bool F16>
__device__ __forceinline__ void gemm_phase(LAS unsigned char* lds, const Gemm g, const Sched& S, const Epi& E, int wave0) {
    int tid_ = wave0 * 64 + lane_id(); asm volatile("" : "+v"(tid_));
    const int tid = tid_, wid = __builtin_amdgcn_readfirstlane(tid >> 6), lane = tid & 63, wr = wid >> 2, wc = wid & 3, fr = lane & 15, fq = lane >> 4;
    const int K = g.K, nt = K / BK;
    unsigned voffA, voffB;
    { int R, C; stage_rc(tid * 16, R, C); const int Rb = Epi::PERM ? ((R & ~31) + perm32(R & 31)) : R;
        const int Ra = Epi::APERM ? ((R & ~63) + 4 * (R & 15) + ((R >> 4) & 3)) : R;
        voffA = (unsigned)(Ra * K + C) * 2u; voffB = (unsigned)(Rb * K + C) * 2u; }
    const unsigned rstep64 = (unsigned)(64 * K * 2);
    const size_t kstep = (size_t)(BK * 2);
    const size_t hstep = (size_t)HALF * K * 2;
    const size_t tstep = 2 * hstep;
    const unsigned ldsw = (unsigned)wid * 1024u;
    const int aoff = lds_byte(wr * 64 + fr, fq * 8), boff = lds_byte(wc * 32 + fr, fq * 8);
#define PG8_SA(b, h) (((b) * 2 + (h)) * HTB)
#define PG8_SB(b, h) ((4 + (b) * 2 + (h)) * HTB)
#define PG8_STAGE(bufoff, gbase, voff) do { _Pragma("unroll") for (int _i = 0; _i < 2; ++_i) \
        __builtin_amdgcn_global_load_lds((const unsigned*)((const char*)(gbase) + _i * rstep64 + (voff)), (LAS unsigned*)(lds + (bufoff) + ldsw + _i * 8192), 16, 0, 0); } while (0)
#define PG8_LDA(dst, b, h) do { _Pragma("unroll") for (int m = 0; m < 4; ++m) _Pragma("unroll") for (int k = 0; k < 2; ++k) dst[m][k] = *(const LAS s16x8*)(lds + PG8_SA(b, h) + aoff + m * 2048 + k * 1024); } while (0)
#define PG8_LDB(dst, b, h) do { _Pragma("unroll") for (int n = 0; n < 2; ++n) _Pragma("unroll") for (int k = 0; k < 2; ++k) dst[n][k] = *(const LAS s16x8*)(lds + PG8_SB(b, h) + boff + n * 2048 + k * 1024); } while (0)
#define PG8_MMA(ai, bj, At, Bt) do { __builtin_amdgcn_s_setprio(1); _Pragma("unroll") for (int m = 0; m < 4; ++m) _Pragma("unroll") for (int n = 0; n < 2; ++n) _Pragma("unroll") for (int k = 0; k < 2; ++k) \
        acc[ai][bj][m][n] = mfma16<F16>(Bt[n][k], At[m][k], acc[ai][bj][m][n]); __builtin_amdgcn_s_setprio(0); } while (0)
#define PG8_WAIT_V(n) asm volatile("s_waitcnt vmcnt(" #n ")" ::: "memory")
#define PG8_WAIT_L(n) asm volatile("s_waitcnt lgkmcnt(" #n ")" ::: "memory")
#define PG8_BAR __builtin_amdgcn_s_barrier()
#define PG8_SCHED __builtin_amdgcn_sched_barrier(0)
    Unit cur, nxt; int ui = 0;
    if (!S.next(0, cur)) return;
    f32x4 acc[2][2][4][2];
#pragma unroll
    for (int a = 0; a < 2; ++a)
#pragma unroll
        for (int b = 0; b < 2; ++b)
#pragma unroll
            for (int m = 0; m < 4; ++m)
#pragma unroll
                for (int n = 0; n < 2; ++n) acc[a][b][m][n] = (f32x4){0.f, 0.f, 0.f, 0.f};
    s16x8 At[4][2], B0[2][2], B1[2][2];
    const char* cA = (const char*)g.A + (size_t)cur.pm * tstep; const char* cB = (const char*)g.Bt + (size_t)cur.pn * tstep + (size_t)(cur.pm >> 5) * g.bstride;
    S.a_ready(cur);
    if constexpr (SP2) {
        PG8_STAGE(PG8_SB(0, 0), cB, voffB); PG8_STAGE(PG8_SB(0, 1), cB + hstep, voffB); PG8_STAGE(PG8_SA(0, 0), cA, voffA); PG8_STAGE(PG8_SA(0, 1), cA + hstep, voffA);
        if (wr == 1) PG8_BAR;
        PG8_WAIT_V(2); PG8_BAR;
        PG8_STAGE(PG8_SB(1, 0), cB + kstep, voffB); PG8_STAGE(PG8_SA(1, 0), cA + kstep, voffA); PG8_STAGE(PG8_SB(1, 1), cB + hstep + kstep, voffB);
        PG8_WAIT_V(6); PG8_BAR;
    } else {
        PG8_STAGE(PG8_SB(0, 0), cB, voffB); PG8_STAGE(PG8_SA(0, 0), cA, voffA); PG8_STAGE(PG8_SB(0, 1), cB + hstep, voffB); PG8_STAGE(PG8_SA(0, 1), cA + hstep, voffA);
        if (wr == 1) PG8_BAR;
        PG8_WAIT_V(4); PG8_BAR;
        PG8_STAGE(PG8_SB(1, 0), cB + kstep, voffB); PG8_STAGE(PG8_SA(1, 0), cA + kstep, voffA); PG8_STAGE(PG8_SB(1, 1), cB + hstep + kstep, voffB);
        PG8_WAIT_V(6); PG8_BAR;
    }
    for (;;) {
        const bool has_next = S.next(ui + 1, nxt);
        const char* nA = has_next ? (const char*)g.A + (size_t)nxt.pm * tstep : cA; const char* nB = has_next ? (const char*)g.Bt + (size_t)nxt.pn * tstep + (size_t)(nxt.pm >> 5) * g.bstride : cB;
        for (int t = 0; t < nt; t += 2) {
            const bool last = (t == nt - 2);
            const char* a1 = cA + (size_t)(t + 1) * kstep;
            const char* a2 = last ? nA : cA + (size_t)(t + 2) * kstep; const char* b2 = last ? nB : cB + (size_t)(t + 2) * kstep;
            const char* a3 = a2 + kstep; const char* b3 = b2 + kstep;
            if (last && has_next) S.a_ready(nxt);
            if constexpr (Epi::MIDK) { if (t == nt / 2) E.midk(acc, cur, wr, fr); }
            if constexpr (SP2) {
            PG8_LDB(B0, 0, 0); PG8_LDB(B1, 0, 1); PG8_SCHED; PG8_LDA(At, 0, 0); PG8_STAGE(PG8_SA(1, 1), a1 + hstep, voffA);
            PG8_WAIT_V(8); PG8_WAIT_L(0); PG8_BAR; PG8_MMA(0, 0, At, B0); PG8_MMA(0, 1, At, B1); PG8_BAR; PG8_SCHED;
            PG8_LDA(At, 0, 1); PG8_STAGE(PG8_SB(0, 0), b2, voffB); PG8_STAGE(PG8_SB(0, 1), b2 + hstep, voffB); PG8_STAGE(PG8_SA(0, 0), a2, voffA);
            PG8_WAIT_V(8); PG8_WAIT_L(0); PG8_BAR; PG8_MMA(1, 0, At, B0); PG8_MMA(1, 1, At, B1); PG8_BAR; PG8_SCHED;
            PG8_LDB(B0, 1, 0); PG8_LDB(B1, 1, 1); PG8_SCHED; PG8_LDA(At, 1, 0); PG8_STAGE(PG8_SA(0, 1), a2 + hstep, voffA);
            PG8_WAIT_V(8); PG8_WAIT_L(0); PG8_BAR; PG8_MMA(0, 0, At, B0); PG8_MMA(0, 1, At, B1); PG8_BAR; PG8_SCHED;
            PG8_LDA(At, 1, 1); PG8_STAGE(PG8_SB(1, 0), b3, voffB); PG8_STAGE(PG8_SB(1, 1), b3 + hstep, voffB); PG8_STAGE(PG8_SA(1, 0), a3, voffA);
            PG8_WAIT_V(8); PG8_WAIT_L(0); PG8_BAR; PG8_MMA(1, 0, At, B0); PG8_MMA(1, 1, At, B1); PG8_BAR; PG8_SCHED;
            } else {
            PG8_LDB(B0, 0, 0); PG8_SCHED; PG8_LDA(At, 0, 0); PG8_STAGE(PG8_SA(1, 1), a1 + hstep, voffA);
            PG8_WAIT_L(8); PG8_BAR; PG8_WAIT_L(0); PG8_MMA(0, 0, At, B0); PG8_BAR; PG8_SCHED;
            PG8_LDB(B1, 0, 1); PG8_STAGE(PG8_SB(0, 0), b2, voffB);
            PG8_BAR; PG8_WAIT_L(0); PG8_MMA(0, 1, At, B1); PG8_BAR;
            PG8_LDA(At, 0, 1); PG8_STAGE(PG8_SA(0, 0), a2, voffA);
            PG8_BAR; PG8_WAIT_L(0); PG8_MMA(1, 0, At, B0); PG8_BAR; PG8_SCHED;
            PG8_STAGE(PG8_SB(0, 1), b2 + hstep, voffB);
            PG8_WAIT_V(6); PG8_BAR; PG8_MMA(1, 1, At, B1); PG8_BAR;
            PG8_LDB(B0, 1, 0); PG8_SCHED; PG8_LDA(At, 1, 0); PG8_STAGE(PG8_SA(0, 1), a2 + hstep, voffA);
            PG8_WAIT_L(8); PG8_BAR; PG8_WAIT_L(0); PG8_MMA(0, 0, At, B0); PG8_BAR; PG8_SCHED;
            PG8_LDB(B1, 1, 1); PG8_STAGE(PG8_SB(1, 0), b3, voffB);
            PG8_BAR; PG8_WAIT_L(0); PG8_MMA(0, 1, At, B1); PG8_BAR;
            PG8_LDA(At, 1, 1); PG8_STAGE(PG8_SA(1, 0), a3, voffA);
            PG8_BAR; PG8_WAIT_L(0); PG8_MMA(1, 0, At, B0); PG8_BAR; PG8_SCHED;
            PG8_STAGE(PG8_SB(1, 1), b3 + hstep, voffB);
            PG8_WAIT_V(6); PG8_BAR; PG8_MMA(1, 1, At, B1); PG8_BAR;
            }
        }
        if constexpr (ALIGN_EPI) { if (wr == 0) PG8_BAR; }
        E(acc, cur, wr, wc, fr, fq); S.done(cur);
        if (!has_next) break;
#pragma unroll
        for (int a = 0; a < 2; ++a)
#pragma unroll
            for (int b = 0; b < 2; ++b)
#pragma unroll
                for (int m = 0; m < 4; ++m)
#pragma unroll
                    for (int n = 0; n < 2; ++n) acc[a][b][m][n] = (f32x4){0.f, 0.f, 0.f, 0.f};
        cur = nxt; cA = nA; cB = nB; ++ui;
        if constexpr (ALIGN_EPI) { if (wr == 1) PG8_BAR; }
    }
    PG8_WAIT_V(0);
    if constexpr (!ALIGN_EPI) { if (wr == 0) PG8_BAR; }
    PG8_BAR;
#undef PG8_SA
#undef PG8_SB
#undef PG8_STAGE
#undef PG8_LDA
#undef PG8_LDB
#undef PG8_MMA
#undef PG8_WAIT_V
#undef PG8_WAIT_L
#undef PG8_BAR
#undef PG8_SCHED
}

struct EpiBf16 {
    static constexpr bool PERM = true, MIDK = false, APERM = false;
    u16* O; int ldc;
    __device__ __forceinline__ void operator()(const f32x4 (&acc)[2][2][4][2], const Unit& u, int wr, int wc, int fr, int fq) const {
        const int row0 = u.pm * BM + wr * 64 + fr; const int col0 = u.pn * BM + wc * 32 + 8 * fq;
#pragma unroll
        for (int ai = 0; ai < 2; ++ai)
#pragma unroll
            for (int m = 0; m < 4; ++m) { u16* rowp = O + (size_t)(row0 + ai * HALF + m * 16) * ldc + col0;
#pragma unroll
                for (int bj = 0; bj < 2; ++bj) { const f32x4 v0 = acc[ai][bj][m][0], v1 = acc[ai][bj][m][1];
                    u32x4 w; w.x = cvt_pk_bf16(v0[0], v0[1]); w.y = cvt_pk_bf16(v0[2], v0[3]); w.z = cvt_pk_bf16(v1[0], v1[1]); w.w = cvt_pk_bf16(v1[2], v1[3]);
                    *(u32x4*)(rowp + bj * HALF) = w; } }
    }
};
struct EpiResid {
    static constexpr bool PERM = false, MIDK = false, APERM = false;
    const float* base; float* out; const float* gate;
    __device__ __forceinline__ void operator()(const f32x4 (&acc)[2][2][4][2], const Unit& u, int wr, int wc, int fr, int fq) const {
        const int row0 = u.pm * BM + wr * 64 + fr, col0 = u.pn * BM + wc * 32 + 4 * fq;
        const int b = (u.pm * BM) / SEQ;
        f32x4 gv[2][2];
#pragma unroll
        for (int bj = 0; bj < 2; ++bj)
#pragma unroll
            for (int n = 0; n < 2; ++n) gv[bj][n] = *(const f32x4*)(gate + (size_t)b * N_MOD + col0 + bj * HALF + n * 16);
#pragma unroll
        for (int ai = 0; ai < 2; ++ai)
#pragma unroll
            for (int m = 0; m < 4; ++m) { const size_t off = (size_t)(row0 + ai * HALF + m * 16) * D_MODEL + col0;
#pragma unroll
                for (int bj = 0; bj < 2; ++bj)
#pragma unroll
                    for (int n = 0; n < 2; ++n) { const f32x4 bs = *(const f32x4*)(base + off + bj * HALF + n * 16);
                        *(f32x4*)(out + off + bj * HALF + n * 16) = bs + gv[bj][n] * acc[ai][bj][m][n]; } }
    }
};
struct EpiInProj {
    static constexpr bool PERM = true, MIDK = false, APERM = false;
    float* QF; u16* KB; u16* VT; u16* XR; u16* GG; float* KM; const float* gq; const float* gk;
    __device__ __forceinline__ void operator()(const f32x4 (&acc)[2][2][4][2], const Unit& u, int wr, int wc, int fr, int fq) const {
        const int type = u.pn >> 1, head = (u.pn & 1) * 4 + wc;
        const int b = (u.pm * BM) / SEQ, blk = u.pm % NBLK;
        const int tok0 = u.pm * BM + wr * 64 + fr;
        const int bh = b * NHEAD + head;
        if (type <= 1) {
            const float* gp = type == 0 ? gq : gk;
            f32x4 gv[2][2];
#pragma unroll
            for (int bj = 0; bj < 2; ++bj)
#pragma unroll
                for (int n = 0; n < 2; ++n) gv[bj][n] = *(const f32x4*)(gp + 32 * bj + 8 * fq + 4 * n);
            f32x4 cs[2][2];
#pragma unroll
            for (int bj = 0; bj < 2; ++bj)
#pragma unroll
                for (int n = 0; n < 2; ++n) cs[bj][n] = (f32x4){0.f, 0.f, 0.f, 0.f};
#pragma unroll
            for (int ai = 0; ai < 2; ++ai)
#pragma unroll
                for (int m = 0; m < 4; ++m) {
                    float ss = 0.f;
#pragma unroll
                    for (int bj = 0; bj < 2; ++bj)
#pragma unroll
                        for (int n = 0; n < 2; ++n) { const f32x4 x = acc[ai][bj][m][n]; ss += (x[0] * x[0] + x[1] * x[1]) + (x[2] * x[2] + x[3] * x[3]); }
                    ss += __shfl_xor(ss, 16); ss += __shfl_xor(ss, 32);
                    const float rstd = 1.0f / sqrtf(ss * (1.0f / 64.0f) + EPS);
                    const int tok = tok0 + ai * HALF + m * 16, s = tok % SEQ;
                    const size_t rowoff = ((size_t)bh * SEQ + s) * HD + 8 * fq;
#pragma unroll
                    for (int bj = 0; bj < 2; ++bj) {
                        const f32x4 v0 = acc[ai][bj][m][0] * rstd * gv[bj][0], v1 = acc[ai][bj][m][1] * rstd * gv[bj][1];
                        if (type == 0) { *(f32x4*)(QF + rowoff + 32 * bj) = v0; *(f32x4*)(QF + rowoff + 32 * bj + 4) = v1; }
                        else { u32x4 w; w.x = cvt_pk_bf16(v0[0], v0[1]); w.y = cvt_pk_bf16(v0[2], v0[3]); w.z = cvt_pk_bf16(v1[0], v1[1]); w.w = cvt_pk_bf16(v1[2], v1[3]);
                            const int kw = s & 255, c8 = 4 * bj + fq;
                            *(u32x4*)(KB + ((size_t)bh * NBLK + blk) * (BLK * HD) + ((((kw >> 5) * 4 + (c8 >> 1)) * 2 + (c8 & 1)) * 32 + (kw & 31)) * 8) = w; cs[bj][0] += v0; cs[bj][1] += v1; }
                    }
                }
            if (type == 1) {
#pragma unroll
                for (int bj = 0; bj < 2; ++bj)
#pragma unroll
                    for (int n = 0; n < 2; ++n)
#pragma unroll
                        for (int i = 0; i < 4; ++i) { float v = cs[bj][n][i]; v += __shfl_xor(v, 1); v += __shfl_xor(v, 2); v += __shfl_xor(v, 4); v += __shfl_xor(v, 8);
                            if (fr == 0) atomicAdd(KM + (((size_t)(b * NBLK + blk) * NHEAD + head) * HD + 32 * bj + 8 * fq + 4 * n + i), v); }
            }
        } else if (type == 2) {
            const int hip = (fr >> 2) & 1, ep = 4 * (fr >> 3) + (fr & 3);
#pragma unroll
            for (int ai = 0; ai < 2; ++ai)
#pragma unroll
                for (int m = 0; m < 4; ++m) { const int kw = ai * HALF + wr * 64 + m * 16 + fr;
#pragma unroll
                    for (int bj = 0; bj < 2; ++bj)
#pragma unroll
                        for (int n = 0; n < 2; ++n) { const f32x4 x = acc[ai][bj][m][n]; const unsigned w0 = cvt_pk_bf16(x[0], x[1]), w1 = cvt_pk_bf16(x[2], x[3]);
                            u16* dst = VT + ((size_t)bh * NBLK + blk) * (BLK * HD) + (((((kw >> 5) * 2 + ((kw >> 4) & 1)) * 2 + bj) * 2 + hip) * 32 + 8 * fq + 4 * n) * 8 + ep;
                            dst[0] = (u16)(w0 & 0xffffu); dst[8] = (u16)(w0 >> 16); dst[16] = (u16)(w1 & 0xffffu); dst[24] = (u16)(w1 >> 16); } }
        } else {
            u16* O = type == 3 ? XR : GG;
#pragma unroll
            for (int ai = 0; ai < 2; ++ai)
#pragma unroll
                for (int m = 0; m < 4; ++m) { const int tok = tok0 + ai * HALF + m * 16, sq = tok % SEQ;
                    u16* tilep = O + ((((size_t)b * (SEQ / 32) + (sq >> 5)) * NHEAD + head) * 2048) + (sq & 31) * 8;
#pragma unroll
                    for (int bj = 0; bj < 2; ++bj) { f32x4 v0 = acc[ai][bj][m][0], v1 = acc[ai][bj][m][1];
                        if (type == 4) {
#pragma unroll
                            for (int i = 0; i < 4; ++i) { v0[i] = gelu_tanh(v0[i]); v1[i] = gelu_tanh(v1[i]); } }
                        u32x4 w; w.x = cvt_pk_bf16(v0[0], v0[1]); w.y = cvt_pk_bf16(v0[2], v0[3]); w.z = cvt_pk_bf16(v1[0], v1[1]); w.w = cvt_pk_bf16(v1[2], v1[3]);
                        *(u32x4*)(tilep + (4 * bj + fq) * 256) = w; } }
        }
    }
};

__device__ __forceinline__ float dpp_f(float old, float x, int ctrl) {
    return 0.f; }
#define DPPF(old, x, ctrl) __builtin_bit_cast(float, __builtin_amdgcn_update_dpp(__builtin_bit_cast(int, (float)(old)), __builtin_bit_cast(int, (float)(x)), (ctrl), 0xf, 0xf, false))
struct EpiFFN {
    static constexpr bool PERM = true, MIDK = false, APERM = true;
    u16* ACT; float* RAW; const float* cw; const float* CB2; LAS float* XB; const float* SSQX; const float* BIAS2; const LAS float* R2ALL; LAS float* CT;
    __device__ __forceinline__ void operator()(const f32x4 (&acc)[2][2][4][2], const Unit& u, int wr, int wc, int fr_, int fq_) const {
        int fr = fr_, fq = fq_; asm volatile("" : "+v"(fr), "+v"(fq));
        const int f0 = u.pn * 128 + wc * 32 + 8 * fq;
        const int b = (u.pm * BM) / SEQ;
        const LAS float* R2S = R2ALL + u.ord * 256;
        { const int t = (wr * 4 + wc) * 64 + fq * 16 + fr;
          if (t < 256) { const int q = t >> 5, c4 = t & 31; const int f = u.pn * 128 + 4 * c4;
              const float* src = ((q & 3) == 3) ? (CB2 + (size_t)b * N_UP + (q >> 2) * D_FF + f) : (cw + (size_t)(q & 3) * N_UP + (q >> 2) * D_FF + f);
              const f32x4 v = *(const f32x4*)src; *(LAS f32x4*)(CT + q * 128 + 4 * c4) = v; } }
#define BBP(kc, bj, n) (*(const f32x4*)(BIAS2 + ((size_t)(kc) * BATCH + b) * N_UP + (bj) * D_FF + f0 + 4 * (n)))
#define BBV(bj, n) ((BBP(0, bj, n) + BBP(1, bj, n)) + (BBP(2, bj, n) + BBP(3, bj, n)))
        const f32x4 r2a = *(const LAS f32x4*)(R2S + wr * 64 + 4 * fr), r2b = *(const LAS f32x4*)(R2S + HALF + wr * 64 + 4 * fr);
        if (fr == 15) {
#pragma unroll
            for (int ai = 0; ai < 2; ++ai)
#pragma unroll
                for (int rr = 0; rr < 2; ++rr)
#pragma unroll
                    for (int bj = 0; bj < 2; ++bj)
#pragma unroll
                        for (int n = 0; n < 2; ++n) *(LAS f32x4*)(XB + (((((ai * 2 + wr) * 4 + wc) * 2 + rr) * 4 + fq) * 16 + (bj * 2 + n) * 4)) = acc[ai][bj][2 + rr][n] * (ai ? r2b[2 + rr] : r2a[2 + rr]);
        }
        if (wr == 1 && fr == 15) {
#pragma unroll
            for (int rr = 0; rr < 2; ++rr)
#pragma unroll
                for (int bj = 0; bj < 2; ++bj)
#pragma unroll
                    for (int n = 0; n < 2; ++n) *(f32x4*)(RAW + ((size_t)u.pm * 4 + 2 + rr) * N_UP + bj * D_FF + f0 + 4 * n) = acc[1][bj][2 + rr][n] * r2b[2 + rr] + BBV(bj, n);
        }
        if (wr == 0 && fr == 0) {
#pragma unroll
            for (int rr = 0; rr < 2; ++rr)
#pragma unroll
                for (int bj = 0; bj < 2; ++bj)
#pragma unroll
                    for (int n = 0; n < 2; ++n) *(f32x4*)(RAW + ((size_t)u.pm * 4 + rr) * N_UP + bj * D_FF + f0 + 4 * n) = acc[0][bj][rr][n] * r2a[rr] + BBV(bj, n);
        }
        asm volatile("s_waitcnt vmcnt(0) lgkmcnt(0)" ::: "memory"); __builtin_amdgcn_s_barrier(); asm volatile("" ::: "memory");
#pragma unroll
        for (int n = 0; n < 2; ++n) {
            const int cl = wc * 32 + 8 * fq + 4 * n;
            const f32x4 wg0 = *(const LAS f32x4*)(CT + 0 * 128 + cl), wg1 = *(const LAS f32x4*)(CT + 1 * 128 + cl), wg2 = *(const LAS f32x4*)(CT + 2 * 128 + cl);
            const f32x4 wv0 = *(const LAS f32x4*)(CT + 4 * 128 + cl), wv1 = *(const LAS f32x4*)(CT + 5 * 128 + cl), wv2 = *(const LAS f32x4*)(CT + 6 * 128 + cl);
            const f32x4 bg = *(const LAS f32x4*)(CT + 3 * 128 + cl), bv = *(const LAS f32x4*)(CT + 7 * 128 + cl);
#pragma unroll
            for (int ai = 0; ai < 2; ++ai) {
                const f32x4 r2v = ai ? r2b : r2a;
                const bool hasprev = (wr == 1) || (ai == 1);
                const int src = (wr == 1) ? (ai * 2 + 0) : ((ai - 1) * 2 + 1);
                f32x4 t1g = (f32x4){0.f, 0.f, 0.f, 0.f}, t2g = t1g, t1v = t1g, t2v = t1g;
                if (hasprev) {
                    const LAS float* xb1 = XB + ((((src * 4 + wc) * 2 + 1) * 4 + fq) * 16), * xb2 = XB + ((((src * 4 + wc) * 2 + 0) * 4 + fq) * 16);
                    t1g = *(const LAS f32x4*)(xb1 + (0 * 2 + n) * 4); t1v = *(const LAS f32x4*)(xb1 + (1 * 2 + n) * 4);
                    t2g = *(const LAS f32x4*)(xb2 + (0 * 2 + n) * 4); t2v = *(const LAS f32x4*)(xb2 + (1 * 2 + n) * 4);
                }
                f32x4 xg[4], xv[4];
#pragma unroll
                for (int m = 0; m < 4; ++m) { xg[m] = acc[ai][0][m][n] * r2v[m]; xv[m] = acc[ai][1][m][n] * r2v[m]; }
                f32x4 pg3, pg2, pv3, pv2;
#pragma unroll
                for (int i = 0; i < 4; ++i) { pg3[i] = DPPF(t1g[i], xg[3][i], 0x111); pg2[i] = DPPF(t2g[i], xg[2][i], 0x111); pv3[i] = DPPF(t1v[i], xv[3][i], 0x111); pv2[i] = DPPF(t2v[i], xv[2][i], 0x111); }
#pragma unroll
                for (int m = 0; m < 4; ++m) {
                    const f32x4 g1 = m == 0 ? pg3 : xg[m > 0 ? m - 1 : 0], g2 = m == 0 ? pg2 : (m == 1 ? pg3 : xg[m > 1 ? m - 2 : 0]);
                    const f32x4 v1 = m == 0 ? pv3 : xv[m > 0 ? m - 1 : 0], v2 = m == 0 ? pv2 : (m == 1 ? pv3 : xv[m > 1 ? m - 2 : 0]);
                    const f32x4 cg = ((wg0 * g2 + wg1 * g1) + wg2 * xg[m]) + bg, cv = ((wv0 * v2 + wv1 * v1) + wv2 * xv[m]) + bv;
                    const f32x4 ex = cg * (-LOG2E);
                    f32x4 sg; sg[0] = __builtin_amdgcn_rcpf(1.0f + __builtin_amdgcn_exp2f(ex[0])); sg[1] = __builtin_amdgcn_rcpf(1.0f + __builtin_amdgcn_exp2f(ex[1]));
                    sg[2] = __builtin_amdgcn_rcpf(1.0f + __builtin_amdgcn_exp2f(ex[2])); sg[3] = __builtin_amdgcn_rcpf(1.0f + __builtin_amdgcn_exp2f(ex[3]));
                    const f32x4 o = (cg * sg) * cv;
                    if (!(ai == 0 && wr == 0 && fr == 0 && m < 2)) { u32x2 w; w.x = cvt_pk_bf16(o[0], o[1]); w.y = cvt_pk_bf16(o[2], o[3]);
                        *(u32x2*)(ACT + (size_t)(u.pm * BM + ai * HALF + wr * 64 + 4 * fr + m) * D_FF + f0 + 4 * n) = w; }
                }
                __builtin_amdgcn_sched_barrier(0);
            }
        }
    }
};

struct EpiOut {
    static constexpr bool PERM = true, MIDK = true, APERM = false;
    const float* base; u16* X1B; float* SSQX; const float* gate; const LAS f32x2* RT;
    __device__ __forceinline__ void rstd(const Unit& u, int rit, float& ratio, float& ra) const { const f32x2 v = RT[u.ord * 256 + rit]; ratio = v.x; ra = v.y; }
    __device__ __forceinline__ void midk(f32x4 (&acc)[2][2][4][2], const Unit& u, int wr, int fr) const {
#pragma unroll
        for (int ai = 0; ai < 2; ++ai)
#pragma unroll
            for (int m = 0; m < 4; ++m) { float ratio, ra; rstd(u, ai * HALF + wr * 64 + m * 16 + fr, ratio, ra);
#pragma unroll
                for (int bj = 0; bj < 2; ++bj)
#pragma unroll
                    for (int n = 0; n < 2; ++n) acc[ai][bj][m][n] *= ratio; }
    }
    __device__ __forceinline__ void operator()(const f32x4 (&acc)[2][2][4][2], const Unit& u, int wr, int wc, int fr, int fq) const {
        const int row0 = u.pm * BM + wr * 64 + fr, col0 = u.pn * BM + wc * 32 + 8 * fq;
        const int b = (u.pm * BM) / SEQ;
        f32x4 gv[2][2];
#pragma unroll
        for (int bj = 0; bj < 2; ++bj)
#pragma unroll
            for (int n = 0; n < 2; ++n) gv[bj][n] = *(const f32x4*)(gate + (size_t)b * N_MOD + col0 + bj * HALF + n * 4);
#pragma unroll
        for (int ai = 0; ai < 2; ++ai)
#pragma unroll
            for (int m = 0; m < 4; ++m) { const int row = row0 + ai * HALF + m * 16; const size_t off = (size_t)row * D_MODEL + col0;
                float rl, ra; rstd(u, wr * 64 + fr + ai * HALF + m * 16, rl, ra);
                float ss = 0.f;
#pragma unroll
                for (int bj = 0; bj < 2; ++bj) {
                    const f32x4 x0 = *(const f32x4*)(base + off + bj * HALF) + gv[bj][0] * (acc[ai][bj][m][0] * ra);
                    const f32x4 x1 = *(const f32x4*)(base + off + bj * HALF + 4) + gv[bj][1] * (acc[ai][bj][m][1] * ra);
                    ss += ((x0[0] * x0[0] + x0[1] * x0[1]) + (x0[2] * x0[2] + x0[3] * x0[3])) + ((x1[0] * x1[0] + x1[1] * x1[1]) + (x1[2] * x1[2] + x1[3] * x1[3]));
                    u32x4 w; w.x = cvt_pk_bf16(x0[0], x0[1]); w.y = cvt_pk_bf16(x0[2], x0[3]); w.z = cvt_pk_bf16(x1[0], x1[1]); w.w = cvt_pk_bf16(x1[2], x1[3]);
                    *(u32x4*)(X1B + off + bj * HALF) = w; }
                ss += __shfl_xor(ss, 16); ss += __shfl_xor(ss, 32);
                if (fq == 0) SSQX[(size_t)row * 16 + u.pn * 4 + wc] = ss; }
    }
};

struct EpiResidB {
    static constexpr bool PERM = false, MIDK = false, APERM = false;
    const u16* base; float* out; const float* gate;
    __device__ __forceinline__ void operator()(const f32x4 (&acc)[2][2][4][2], const Unit& u, int wr, int wc, int fr, int fq) const {
        const int row0 = u.pm * BM + wr * 64 + fr, col0 = u.pn * BM + wc * 32 + 4 * fq;
        const int b = (u.pm * BM) / SEQ;
        f32x4 gv[2][2];
#pragma unroll
        for (int bj = 0; bj < 2; ++bj)
#pragma unroll
            for (int n = 0; n < 2; ++n) gv[bj][n] = *(const f32x4*)(gate + (size_t)b * N_MOD + col0 + bj * HALF + n * 16);
#pragma unroll
        for (int ai = 0; ai < 2; ++ai)
#pragma unroll
            for (int m = 0; m < 4; ++m) { const size_t off = (size_t)(row0 + ai * HALF + m * 16) * D_MODEL + col0;
#pragma unroll
                for (int bj = 0; bj < 2; ++bj)
#pragma unroll
                    for (int n = 0; n < 2; ++n) { const u32x2 xw = *(const u32x2*)(base + off + bj * HALF + n * 16);
                        const f32x4 bs = (f32x4){bf_lo(xw.x), bf_hi(xw.x), bf_lo(xw.y), bf_hi(xw.y)};
                        *(f32x4*)(out + off + bj * HALF + n * 16) = bs + gv[bj][n] * acc[ai][bj][m][n]; } }
    }
};
}
#ifndef ATT_DUP
#define ATT_DUP 0
#endif

constexpr size_t MiB = 1u << 20;
constexpr size_t WS_CTL = 0;
constexpr size_t WS_KM = 1 * MiB;
constexpr size_t CTL_ZERO_BYTES = 2 * MiB;
constexpr size_t WS_MOD = 2 * MiB;
constexpr size_t WS_WIN = 3 * MiB;
constexpr size_t WS_WO = 8 * MiB;
constexpr size_t WS_WUP = 10 * MiB;
constexpr size_t WS_WDN = 21 * MiB;
constexpr size_t WS_WA = 27 * MiB;
constexpr size_t WS_WX = 27 * MiB + 65536;
constexpr size_t WS_AGG = 28 * MiB;
constexpr size_t WS_SSQL = 29 * MiB;
constexpr size_t WS_SSQA = 30 * MiB;
constexpr size_t WS_H = 34 * MiB;
constexpr size_t WS_QF = 98 * MiB;
constexpr size_t WS_KB = 162 * MiB;
constexpr size_t WS_VT = 194 * MiB;
constexpr size_t WS_XR = 226 * MiB;
constexpr size_t WS_GG = 258 * MiB;
constexpr size_t WS_ATT = 288 * MiB;
constexpr size_t WS_LRU = 320 * MiB;
constexpr size_t WS_MIX = 352 * MiB;
constexpr size_t WS_RAW = 98 * MiB;
constexpr size_t WS_ACT = 272 * MiB;
constexpr size_t WS_WUP4 = 448 * MiB;
constexpr size_t WS_BIAS2 = 27 * MiB + 262144;
constexpr size_t WS_CB2 = 27 * MiB + 786432;
constexpr size_t WS_SSQX = 31 * MiB;
constexpr size_t WS_END = 492 * MiB;
constexpr int CW_BAR = 4096, CW_AGGCNT = 1024;

constexpr int RING_BYTES = 131072;
constexpr int MISC_OFF = 160 * 1024 - 256;
constexpr int XB_OFF = RING_BYTES;
constexpr int CLDS_OFF = RING_BYTES + 4096;
constexpr int LDS_BYTES = 160 * 1024;
constexpr int NT = 512, NWAVES = 8;

#define XB_TMO      128
#define XB_XCNT(j)  (256  + 64 * (j))
#define XB_XSUB(j)  (1280 + 64 * (j))
#define XB_XGEN(j)  (2304 + 64 * (j))
#define XB_TOP      3328
#define XB_TOPGEN   3392
#define XCD_BAR_WORDS 3456
#define XB_SPIN_CAP (1u << 18)
__device__ __forceinline__ unsigned xb_ld(unsigned* p)              { return __hip_atomic_load(p, __ATOMIC_RELAXED, __HIP_MEMORY_SCOPE_AGENT); }
__device__ __forceinline__ unsigned xb_add(unsigned* p, unsigned v) { return __hip_atomic_fetch_add(p, v, __ATOMIC_RELAXED, __HIP_MEMORY_SCOPE_AGENT); }
__device__ __forceinline__ unsigned xb_xcc_id() { return (unsigned)__builtin_amdgcn_s_getreg((3 << 11) | 20) & 0xFu; }
#define XB_SPIN(cond, bar) do { unsigned _sp = 0; while (cond) { __builtin_amdgcn_s_sleep(1); \
    if ((++_sp & 255u) == 0u) { if (xb_ld(&(bar)[XB_TMO])) break; if (_sp > XB_SPIN_CAP) { atomicAdd(&(bar)[XB_TMO], 1u); break; } } } } while (0)
struct XcdBarrier { unsigned* bar; unsigned x; volatile LAS unsigned* st; };
__device__ __forceinline__ XcdBarrier xcd_barrier_post(unsigned* bar, volatile LAS unsigned* st) {
    XcdBarrier b; b.bar = bar; b.x = xb_xcc_id(); b.st = st;
    if (threadIdx.x == 0) (void)xb_add(&bar[XB_XCNT(b.x)], 1u);
    return b;
}
__device__ __forceinline__ void xcd_barrier_complete(unsigned* bar, unsigned x, unsigned& nloc, unsigned& nx) {
    const unsigned G = gridDim.x * gridDim.y * gridDim.z;
    unsigned sum, cnt, mine, sp = 0u;
    for (;;) {
        sum = 0u; cnt = 0u; mine = 0u;
#pragma unroll
        for (unsigned j = 0; j < 16; ++j) { const unsigned c = xb_ld(&bar[XB_XCNT(j)]); sum += c; cnt += (c > 0u) ? 1u : 0u; mine = (j == x) ? c : mine; }
        if (sum == G) break;
        __builtin_amdgcn_s_sleep(1);
        if ((++sp & 255u) == 0u) { if (xb_ld(&bar[XB_TMO])) break; if (sp > XB_SPIN_CAP) { atomicAdd(&bar[XB_TMO], 1u); break; } }
    }
    nloc = mine > 0u ? mine : 1u; nx = cnt > 0u ? cnt : 1u;
}
__device__ __forceinline__ void xcd_barrier(const XcdBarrier& b, int tid) {
    asm volatile("s_waitcnt vmcnt(0)" ::: "memory");
    __syncthreads();
    if (tid == 0) {
        unsigned* bar = b.bar;
        __builtin_amdgcn_s_waitcnt(0);
        unsigned nloc = b.st[0], nx = b.st[1];
        if (nloc == 0u) { xcd_barrier_complete(bar, b.x, nloc, nx); b.st[0] = nloc; b.st[1] = nx; }
        const unsigned old = xb_add(&bar[XB_XSUB(b.x)], 1u);
        const unsigned gen = old / nloc;
        if (old + 1u == (gen + 1u) * nloc) {
            __builtin_amdgcn_fence(__ATOMIC_RELEASE, "agent");
            asm volatile("s_waitcnt vmcnt(0)" ::: "memory");
            const unsigned og = xb_add(&bar[XB_TOP], 1u);
            const unsigned tg = og / nx;
            if (og + 1u == (tg + 1u) * nx) xb_add(&bar[XB_TOPGEN], 1u);
            else XB_SPIN(xb_ld(&bar[XB_TOPGEN]) == tg, bar);
            __builtin_amdgcn_fence(__ATOMIC_ACQUIRE, "agent");
            xb_add(&bar[XB_XGEN(b.x)], 1u);
            asm volatile("s_waitcnt vmcnt(0)" ::: "memory");
        } else {
            XB_SPIN(xb_ld(&bar[XB_XGEN(b.x)]) == gen, bar);
            __builtin_amdgcn_fence(__ATOMIC_ACQUIRE, "agent");
            asm volatile("s_waitcnt vmcnt(0)" ::: "memory");
        }
    }
    __syncthreads();
}

struct Args { const float* in[23]; float* out; unsigned char* ws; int ph_lo, ph_hi; };
struct Frame {
    LAS unsigned char* lds;
    int tid, lane, wave, vcu, G, wave0;
    const Args* pa;
    __device__ __forceinline__ const float* x() const { return pa->in[0]; }
    __device__ __forceinline__ const float* c() const { return pa->in[1]; }
    __device__ __forceinline__ const float* w_ada() const { return pa->in[2]; }
    __device__ __forceinline__ const float* b_ada() const { return pa->in[3]; }
    __device__ __forceinline__ const float* norm1_g() const { return pa->in[4]; }
    __device__ __forceinline__ const float* w_in() const { return pa->in[5]; }
    __device__ __forceinline__ const float* q_norm_g() const { return pa->in[6]; }
    __device__ __forceinline__ const float* k_norm_g() const { return pa->in[7]; }
    __device__ __forceinline__ const float* lru_conv_w() const { return pa->in[8]; }
    __device__ __forceinline__ const float* lru_conv_b() const { return pa->in[9]; }
    __device__ __forceinline__ const float* lru_wa() const { return pa->in[10]; }
    __device__ __forceinline__ const float* lru_ba() const { return pa->in[11]; }
    __device__ __forceinline__ const float* lru_wx() const { return pa->in[12]; }
    __device__ __forceinline__ const float* lru_bx() const { return pa->in[13]; }
    __device__ __forceinline__ const float* lru_lambda() const { return pa->in[14]; }
    __device__ __forceinline__ const float* lru_out_g() const { return pa->in[15]; }
    __device__ __forceinline__ const float* attn_out_g() const { return pa->in[16]; }
    __device__ __forceinline__ const float* w_out() const { return pa->in[17]; }
    __device__ __forceinline__ const float* norm2_g() const { return pa->in[18]; }
    __device__ __forceinline__ const float* w_up() const { return pa->in[19]; }
    __device__ __forceinline__ const float* ffn_conv_w() const { return pa->in[20]; }
    __device__ __forceinline__ const float* ffn_conv_b() const { return pa->in[21]; }
    __device__ __forceinline__ const float* w_down() const { return pa->in[22]; }
    float* out; unsigned char* ws;
};
#define LDS_WAIT() asm volatile("s_waitcnt lgkmcnt(0)" ::: "memory")

template <int MODE>
__device__ __forceinline__ void p0_transpose_item(const float* W, int K, int N, u16* WT, LAS float* scr, int item, int lane, const float* kscale = nullptr) {
    const int nblk = N / 32, kb = item / nblk, nb = item % nblk, k0 = 64 * kb, n0 = 32 * nb;
#pragma unroll
    for (int i = 0; i < 8; ++i) { const int f = i * 64 + lane, kk = f >> 3, n4 = f & 7;
        f32x4 w = *(const GAS f32x4*)(W + (size_t)(k0 + kk) * N + n0 + 4 * n4); if (MODE == 3) w *= kscale[k0 + kk];
        LAS float* d = scr + kk * 33 + 4 * n4; d[0] = w.x; d[1] = w.y; d[2] = w.z; d[3] = w.w; }
    LDS_WAIT(); asm volatile("" ::: "memory");
    const int c = lane & 7;
#pragma unroll
    for (int j = 0; j < 4; ++j) { const int n = (lane >> 3) + 8 * j; const LAS float* s = scr + (8 * c) * 33 + n;
        u32x4 o;
        if (MODE == 1) { o.x = cvt_pk_f16(s[0 * 33], s[1 * 33]); o.y = cvt_pk_f16(s[2 * 33], s[3 * 33]); o.z = cvt_pk_f16(s[4 * 33], s[5 * 33]); o.w = cvt_pk_f16(s[6 * 33], s[7 * 33]); }
        else { o.x = cvt_pk_bf16(s[0 * 33], s[1 * 33]); o.y = cvt_pk_bf16(s[2 * 33], s[3 * 33]); o.z = cvt_pk_bf16(s[4 * 33], s[5 * 33]); o.w = cvt_pk_bf16(s[6 * 33], s[7 * 33]); }
        int nn = n0 + n;
        if (MODE == 1) nn = (nn & ~255) + 128 * ((nn >> 5) & 1) + 32 * ((nn >> 6) & 3) + (nn & 31);
        if (MODE == 2) { const int bj = nn >= D_FF ? 1 : 0, f = nn - bj * D_FF; nn = 256 * (f >> 7) + 128 * bj + (f & 127); }
        if (MODE == 4) *(GAS u32x4*)(WT + (((nn >> 5) * 4 + (c >> 1)) * 512 + ((c & 1) * 32 + (nn & 31)) * 8)) = o;
        else *(GAS u32x4*)(WT + (size_t)nn * K + k0 + 8 * c) = o; }
    LDS_WAIT(); asm volatile("" ::: "memory");
}
__device__ __forceinline__ void p0_prologue(Frame& F) {
    unsigned char* wsp = F.ws; asm volatile("" : "+s"(wsp));
    LAS float* cl = (LAS float*)(F.lds + CLDS_OFF);
    for (int i = F.tid; i < BATCH * D_MODEL; i += NT) cl[i] = F.c()[i];
    __syncthreads();
    LAS float* scr = (LAS float*)(F.lds + F.wave * 16384);
    constexpr int I_MOD = N_MOD / 64;
    constexpr int I_IN = (D_MODEL / 64) * (N_IN / 32), I_O = (D_MODEL / 64) * (D_MODEL / 32), I_DN = (D_FF / 64) * (D_MODEL / 32), I_L = 8 * 2;
    constexpr int NITEMS = I_IN + I_O + I_DN + 2 * I_L;
    u16* WinT = (u16*)(wsp + WS_WIN); u16* WoT = (u16*)(wsp + WS_WO); u16* WdT = (u16*)(wsp + WS_WDN);
    u16* WaT = (u16*)(wsp + WS_WA); u16* WxT = (u16*)(wsp + WS_WX);
    float* MOD = (float*)(wsp + WS_MOD);
    if (F.vcu < I_MOD) {
        const int col = F.vcu * 64 + F.lane; float a0 = 0.f, a1 = 0.f, a2 = 0.f, a3 = 0.f;
        const float* wp = F.w_ada() + (size_t)(F.wave * 128) * N_MOD + col; const LAS float* cw = cl + F.wave * 128;
#pragma unroll 64
        for (int k = 0; k < 128; ++k) { const float w = wp[(size_t)k * N_MOD];
            a0 += cw[k] * w; a1 += cw[D_MODEL + k] * w; a2 += cw[2 * D_MODEL + k] * w; a3 += cw[3 * D_MODEL + k] * w; }
        LAS float* part = (LAS float*)(F.lds + CLDS_OFF + 16384);
        part[(F.wave * 4 + 0) * 64 + F.lane] = a0; part[(F.wave * 4 + 1) * 64 + F.lane] = a1; part[(F.wave * 4 + 2) * 64 + F.lane] = a2; part[(F.wave * 4 + 3) * 64 + F.lane] = a3;
        __syncthreads();
        if (F.tid < 256) { const int bb = F.tid >> 6, l = F.tid & 63; float s = F.b_ada()[F.vcu * 64 + l];
#pragma unroll
            for (int w = 0; w < 8; ++w) s += part[(w * 4 + bb) * 64 + l];
            MOD[(size_t)bb * N_MOD + F.vcu * 64 + l] = s; }
    }
    const int gw = F.wave * F.G + ((F.vcu + F.G - I_MOD) % F.G), NGW = F.G * NWAVES;
    for (int it = gw; it < NITEMS; it += NGW) {
        int r = it;
        if (r < I_IN) { p0_transpose_item<1>(F.w_in(), D_MODEL, N_IN, WinT, scr, r, F.lane); continue; } r -= I_IN;
        if (r < I_O) { const int kb = r / (D_MODEL / 32); p0_transpose_item<3>(F.w_out(), D_MODEL, D_MODEL, WoT, scr, r, F.lane, (kb < 8 ? F.lru_out_g() : F.attn_out_g() - AW)); continue; } r -= I_O;

        if (r < I_DN) { p0_transpose_item<0>(F.w_down(), D_FF, D_MODEL, WdT, scr, r, F.lane); continue; } r -= I_DN;
        if (r < I_L) { const int h = r >> 1; p0_transpose_item<4>(F.lru_wa() + h * 4096, 64, 64, WaT + h * 4096, scr, r & 1, F.lane); continue; } r -= I_L;
        { const int h = r >> 1; p0_transpose_item<4>(F.lru_wx() + h * 4096, 64, 64, WxT + h * 4096, scr, r & 1, F.lane); }
    }
}


constexpr int SCL_OFF = RING_BYTES;
__device__ __forceinline__ void p1_upweights(Frame& F, unsigned char* wsp) {
    const float* MODp = (const float*)(wsp + WS_MOD);
    LAS float* SC = (LAS float*)(F.lds + SCL_OFF);
#define SHB(b) ((LAS float*)(F.lds + 16384 * (b) + 8448))
    if (F.tid == 0) *(LAS int*)(F.lds + MISC_OFF - 64) = 0;
    for (int i = F.tid; i < BATCH * D_MODEL; i += NT) { const int b = i >> 10, k = i & 1023; SC[i] = F.norm2_g()[k] * (1.0f + MODp[(size_t)b * N_MOD + 4096 + k]); SHB(b)[k] = MODp[(size_t)b * N_MOD + 3072 + k]; }
    __syncthreads();
    LAS float* scr = (LAS float*)(F.lds + F.wave * 16384);
    u16* W4 = (u16*)(wsp + WS_WUP4); float* BIAS2 = (float*)(wsp + WS_BIAS2);
    const float* W = F.w_up();
    const int gw = F.wave * F.G + F.vcu, NGW = F.G * NWAVES, lane = F.lane;
    for (int it = gw; it < 4 * (N_UP / 32); it += NGW) {
        const int n0 = 32 * (it >> 2), kc = it & 3;
        float bs0 = 0.f, bs1 = 0.f, bs2 = 0.f, bs3 = 0.f;
#pragma unroll 1
        for (int kb = 4 * kc; kb < 4 * kc + 4; ++kb) {
            const int k0 = 64 * kb;
#pragma unroll
            for (int i = 0; i < 8; ++i) { const int f = i * 64 + lane, kk = f >> 3, n4 = f & 7;
                const f32x4 w = *(const GAS f32x4*)(W + (size_t)(k0 + kk) * N_UP + n0 + 4 * n4);
                LAS float* d = scr + kk * 33 + 4 * n4; d[0] = w.x; d[1] = w.y; d[2] = w.z; d[3] = w.w; }
            LDS_WAIT(); asm volatile("" ::: "memory");
            { const int n = lane & 31, kh = lane >> 5;
#pragma unroll 8
              for (int kk = 0; kk < 32; ++kk) { const float w = scr[(32 * kh + kk) * 33 + n]; const int k = k0 + 32 * kh + kk;
                  bs0 += SHB(0)[k] * w; bs1 += SHB(1)[k] * w; bs2 += SHB(2)[k] * w; bs3 += SHB(3)[k] * w; } }
            const int c = lane & 7;
#pragma unroll
            for (int j = 0; j < 4; ++j) { const int n = (lane >> 3) + 8 * j; const LAS float* s = scr + (8 * c) * 33 + n;
                int nn = n0 + n; { const int bj = nn >= D_FF ? 1 : 0, f = nn - bj * D_FF; nn = 256 * (f >> 7) + 128 * bj + (f & 127); }
                float wv[8];
#pragma unroll
                for (int e = 0; e < 8; ++e) wv[e] = s[e * 33];
#pragma unroll
                for (int b = 0; b < BATCH; ++b) { const LAS float* sc = SC + b * 1024 + k0 + 8 * c;
                    u32x4 o; o.x = cvt_pk_bf16(wv[0] * sc[0], wv[1] * sc[1]); o.y = cvt_pk_bf16(wv[2] * sc[2], wv[3] * sc[3]); o.z = cvt_pk_bf16(wv[4] * sc[4], wv[5] * sc[5]); o.w = cvt_pk_bf16(wv[6] * sc[6], wv[7] * sc[7]);
                    *(GAS u32x4*)(W4 + ((size_t)b * N_UP + nn) * D_MODEL + k0 + 8 * c) = o; } }
            LDS_WAIT(); asm volatile("" ::: "memory");
        }
        bs0 += __shfl_xor(bs0, 32); bs1 += __shfl_xor(bs1, 32); bs2 += __shfl_xor(bs2, 32); bs3 += __shfl_xor(bs3, 32);
        if (lane < 32) { float* bp = BIAS2 + (size_t)kc * BATCH * N_UP + n0 + lane; bp[0] = bs0; bp[N_UP] = bs1; bp[2 * N_UP] = bs2; bp[3 * N_UP] = bs3; }
    }
}


__device__ __forceinline__ void cb2_prep(Frame& F, unsigned char* wsp) {
    const float* BIAS2 = (const float*)(wsp + WS_BIAS2); float* CB2 = (float*)(wsp + WS_CB2);
    const float* cw = F.ffn_conv_w(); const float* cb = F.ffn_conv_b();
    for (int i = F.vcu * NT + F.tid; i < BATCH * N_UP; i += F.G * NT) { const int b = i / N_UP, col = i % N_UP;
        const float bias = (BIAS2[(size_t)(0 * BATCH + b) * N_UP + col] + BIAS2[(size_t)(1 * BATCH + b) * N_UP + col]) + (BIAS2[(size_t)(2 * BATCH + b) * N_UP + col] + BIAS2[(size_t)(3 * BATCH + b) * N_UP + col]);
        CB2[i] = cb[col] + ((cw[col] + cw[N_UP + col]) + cw[2 * N_UP + col]) * bias; }
}

template <bool F16>
__device__ __forceinline__ void rownorm_phase(Frame& F, const float* X, const float* g, const float* sh, const float* sc, u16* O) {
    LAS int* ctr = (LAS int*)(F.lds + MISC_OFF - 64);
    for (;;) {
        int k = 0; if (F.lane == 0) k = __hip_atomic_fetch_add(ctr, 1, __ATOMIC_RELAXED, __HIP_MEMORY_SCOPE_WORKGROUP);
        k = __builtin_amdgcn_readfirstlane(k);
        const int m0 = (F.vcu + k * F.G) * 4;
        if (m0 >= M_TOK) break;
        const int b = m0 / SEQ;
        f32x4 v[4][4]; float s[4];
#pragma unroll
        for (int r = 0; r < 4; ++r) { const GAS f32x4* xr = (const GAS f32x4*)(X + (size_t)(m0 + r) * D_MODEL) + F.lane; s[r] = 0.f;
#pragma unroll
            for (int j = 0; j < 4; ++j) v[r][j] = __builtin_nontemporal_load((const f32x4*)(xr + 64 * j)); }
#pragma unroll
        for (int r = 0; r < 4; ++r)
#pragma unroll
            for (int j = 0; j < 4; ++j) s[r] += (v[r][j].x * v[r][j].x + v[r][j].y * v[r][j].y) + (v[r][j].z * v[r][j].z + v[r][j].w * v[r][j].w);
#pragma unroll
        for (int o = 1; o < 64; o <<= 1) {
#pragma unroll
            for (int r = 0; r < 4; ++r) s[r] += __shfl_xor(s[r], o); }
        float rstd[4];
#pragma unroll
        for (int r = 0; r < 4; ++r) rstd[r] = 1.0f / sqrtf(s[r] * (1.0f / D_MODEL) + EPS);
#pragma unroll
        for (int j = 0; j < 4; ++j) {
            const int col = 4 * F.lane + 256 * j;
            const f32x4 gv = *(const f32x4*)(g + col), shv = *(const f32x4*)(sh + (size_t)b * N_MOD + col), scv = *(const f32x4*)(sc + (size_t)b * N_MOD + col);
            const f32x4 gs = gv * (scv + 1.0f);
#pragma unroll
            for (int r = 0; r < 4; ++r) {
                const f32x4 y = (v[r][j] * rstd[r]) * gs + shv;
                u32x2 w;
                if (F16) { w.x = cvt_pk_f16(y.x, y.y); w.y = cvt_pk_f16(y.z, y.w); } else { w.x = cvt_pk_bf16(y.x, y.y); w.y = cvt_pk_bf16(y.z, y.w); }
                *((GAS u32x2*)(O + (size_t)(m0 + r) * D_MODEL) + F.lane + 64 * j) = w; }
        }
    }
}

__device__ __forceinline__ int crow(int r, int hi) { return (r & 3) + 8 * (r >> 2) + 4 * hi; }
__device__ __forceinline__ int qs_off(int q, int c) { return q * 64 + ((c ^ ((q >> 1) & 7)) << 3); }
constexpr int AL_QS = 0, AL_SLOT = 32768, AL_LSL = 131072, AL_LIST = 134144, AL_CNT = 150528, AL_MISC = 150656, AL_KMS = 150912;
__device__ __forceinline__ void attn_tile(const u16* Kp, const u16* Vp, const s16x8 (&qf)[4], int nkt, bool own, int tt, int qidx, int hi, float c1, float c2, f32x16& o0, f32x16& o1, float& lsum) {
#pragma unroll
    for (int r = 0; r < 16; ++r) { o0[r] = 0.f; o1[r] = 0.f; }
    lsum = 0.f;
    s16x8 kc[4], kn[4], vc[4];
#pragma unroll
    for (int s = 0; s < 4; ++s) { kc[s] = *(const GAS s16x8*)(Kp + s * 512); kn[s] = kc[s]; }
#pragma unroll 1
    for (int kt = 0; kt < nkt; ++kt) {
#pragma unroll
        for (int s = 0; s < 4; ++s) vc[s] = *(const GAS s16x8*)(Vp + (kt * 4 + s) * 512);
        if (kt + 1 < nkt) {
#pragma unroll
            for (int s = 0; s < 4; ++s) kn[s] = *(const GAS s16x8*)(Kp + ((kt + 1) * 4 + s) * 512);
        }
        f32x16 p;
#pragma unroll
        for (int r = 0; r < 16; ++r) p[r] = 0.f;
#pragma unroll
        for (int s = 0; s < 4; ++s) p = __builtin_amdgcn_mfma_f32_32x32x16_bf16(__builtin_bit_cast(bf16x8_t, kc[s]), __builtin_bit_cast(bf16x8_t, qf[s]), p, 0, 0, 0);
        const bool diag = own && (kt == tt);
#pragma unroll
        for (int r = 0; r < 16; ++r) { float e = __builtin_amdgcn_exp2f(p[r] * c1 - c2);
            if (diag && (32 * kt + crow(r, hi) > qidx)) e = 0.f;
            p[r] = e; lsum += e; }
#pragma unroll
        for (int s2 = 0; s2 < 2; ++s2) {
            u32x4 pw; pw.x = cvt_pk_bf16(p[8 * s2 + 0], p[8 * s2 + 1]); pw.y = cvt_pk_bf16(p[8 * s2 + 2], p[8 * s2 + 3]); pw.z = cvt_pk_bf16(p[8 * s2 + 4], p[8 * s2 + 5]); pw.w = cvt_pk_bf16(p[8 * s2 + 6], p[8 * s2 + 7]);
            const bf16x8_t pa = __builtin_bit_cast(bf16x8_t, pw);
            o0 = __builtin_amdgcn_mfma_f32_32x32x16_bf16(pa, __builtin_bit_cast(bf16x8_t, vc[2 * s2]), o0, 0, 0, 0);
            o1 = __builtin_amdgcn_mfma_f32_32x32x16_bf16(pa, __builtin_bit_cast(bf16x8_t, vc[2 * s2 + 1]), o1, 0, 0, 0);
        }
#pragma unroll
        for (int s = 0; s < 4; ++s) kc[s] = kn[s];
    }
}
__device__ __forceinline__ void attn_tile_full(const u16* Kp, const u16* Vp, const LAS u16* QS, int qidx, int hi, float c1, float c2, f32x16& o0, f32x16& o1, float& lsum) {
#pragma unroll
    for (int r = 0; r < 16; ++r) { o0[r] = 0.f; o1[r] = 0.f; }
    lsum = 0.f;
    s16x8 qf[4];
#pragma unroll
    for (int s = 0; s < 4; ++s) qf[s] = *(const LAS s16x8*)(QS + qs_off(qidx, 2 * s + hi));
    s16x8 kr[3][4], vr[3][4];
    const u16* kp = Kp; const u16* vp = Vp;
#pragma unroll
    for (int d = 0; d < 2; ++d) {
#pragma unroll
        for (int s = 0; s < 4; ++s) { kr[d][s] = *(const GAS s16x8*)(kp + s * 512); vr[d][s] = *(const GAS s16x8*)(vp + s * 512); }
        kp += 2048; vp += 2048; asm volatile("" : "+v"(kp), "+v"(vp));
    }
    f32x16 p, pn;
#pragma unroll
    for (int r = 0; r < 16; ++r) p[r] = 0.f;
#pragma unroll
    for (int s = 0; s < 4; ++s) p = __builtin_amdgcn_mfma_f32_32x32x16_bf16(__builtin_bit_cast(bf16x8_t, kr[0][s]), __builtin_bit_cast(bf16x8_t, qf[s]), p, 0, 0, 0);
#pragma unroll
    for (int kt = 0; kt < 8; ++kt) {
        if (kt + 2 < 8) {
#pragma unroll
            for (int s = 0; s < 4; ++s) { kr[(kt + 2) % 3][s] = *(const GAS s16x8*)(kp + s * 512); vr[(kt + 2) % 3][s] = *(const GAS s16x8*)(vp + s * 512); }
            kp += 2048; vp += 2048; asm volatile("" : "+v"(kp), "+v"(vp));
        }
        __builtin_amdgcn_sched_barrier(0);
        if (kt + 1 < 8) {
#pragma unroll
            for (int r = 0; r < 16; ++r) pn[r] = 0.f;
#pragma unroll
            for (int s = 0; s < 4; ++s) pn = __builtin_amdgcn_mfma_f32_32x32x16_bf16(__builtin_bit_cast(bf16x8_t, kr[(kt + 1) % 3][s]), __builtin_bit_cast(bf16x8_t, qf[s]), pn, 0, 0, 0);
        }
#pragma unroll
        for (int r = 0; r < 16; ++r) { const float e = __builtin_amdgcn_exp2f(p[r] * c1 - c2); p[r] = e; lsum += e; }
#pragma unroll
        for (int s2 = 0; s2 < 2; ++s2) {
            u32x4 pw; pw.x = cvt_pk_bf16(p[8 * s2 + 0], p[8 * s2 + 1]); pw.y = cvt_pk_bf16(p[8 * s2 + 2], p[8 * s2 + 3]); pw.z = cvt_pk_bf16(p[8 * s2 + 4], p[8 * s2 + 5]); pw.w = cvt_pk_bf16(p[8 * s2 + 6], p[8 * s2 + 7]);
            const bf16x8_t pa = __builtin_bit_cast(bf16x8_t, pw);
            o0 = __builtin_amdgcn_mfma_f32_32x32x16_bf16(pa, __builtin_bit_cast(bf16x8_t, vr[kt % 3][2 * s2]), o0, 0, 0, 0);
            o1 = __builtin_amdgcn_mfma_f32_32x32x16_bf16(pa, __builtin_bit_cast(bf16x8_t, vr[kt % 3][2 * s2 + 1]), o1, 0, 0, 0);
        }
        if (kt + 1 < 8) p = pn;
        __builtin_amdgcn_sched_barrier(0);
    }
}
__device__ __forceinline__ void attn_item(Frame& F, int bh, int i, float c1, float c2) {
    unsigned char* wsp = F.ws; asm volatile("" : "+s"(wsp));
    const float* QF = (const float*)(wsp + WS_QF); const u16* KB = (const u16*)(wsp + WS_KB); const u16* VT = (const u16*)(wsp + WS_VT);
    const float* KM = (const float*)(wsp + WS_KM); u16* ATT = (u16*)(wsp + WS_MIX); float* SSQA = (float*)(wsp + WS_SSQA);
    LAS u16* QS = (LAS u16*)(F.lds + AL_QS); LAS u16* SLOT = (LAS u16*)(F.lds + AL_SLOT); LAS float* LSL = (LAS float*)(F.lds + AL_LSL);
    LAS float* KMS = (LAS float*)(F.lds + AL_KMS); LAS u16* LIST = (LAS u16*)(F.lds + AL_LIST); LAS int* CNT = (LAS int*)(F.lds + AL_CNT);
    int tid_ = F.tid; asm volatile("" : "+v"(tid_));
    const int tid = tid_, lane = tid & 63, wave = F.wave, hi = lane >> 5, l31 = lane & 31;
    const int b = bh / NHEAD, h = bh % NHEAD;
    for (int u = tid; u < (3 * 32768 + 3072) / 16; u += NT) *(LAS u32x4*)(F.lds + AL_SLOT + u * 16) = (u32x4){0u, 0u, 0u, 0u};
    if (tid < 32) CNT[tid] = 0;
    for (int u = tid; u < NBLK * HD; u += NT) { const int n = u >> 6, d = u & 63; KMS[u] = KM[(((size_t)(b * NBLK + n)) * NHEAD + h) * HD + d] * (1.0f / 256.0f); }
    __syncthreads();
    {
        const int q = 32 * wave + l31;
        const GAS f32x4* qrow = (const GAS f32x4*)(QF + ((size_t)bh * SEQ + (size_t)i * BLK + q) * HD);
        f32x16 p;
#pragma unroll
        for (int r = 0; r < 16; ++r) p[r] = 0.f;
#pragma unroll
        for (int s = 0; s < 4; ++s) {
            const f32x4 qa = qrow[4 * s + 2 * hi], qc = qrow[4 * s + 2 * hi + 1];
            u32x4 qh; qh.x = cvt_pk_bf16(qa.x, qa.y); qh.y = cvt_pk_bf16(qa.z, qa.w); qh.z = cvt_pk_bf16(qc.x, qc.y); qh.w = cvt_pk_bf16(qc.z, qc.w);
            u32x4 ql; ql.x = cvt_pk_bf16(qa.x - bf_lo(qh.x), qa.y - bf_hi(qh.x)); ql.y = cvt_pk_bf16(qa.z - bf_lo(qh.y), qa.w - bf_hi(qh.y));
            ql.z = cvt_pk_bf16(qc.x - bf_lo(qh.z), qc.y - bf_hi(qh.z)); ql.w = cvt_pk_bf16(qc.z - bf_lo(qh.w), qc.w - bf_hi(qh.w));
            *(LAS u32x4*)(QS + qs_off(q, 2 * s + hi)) = qh;
            const LAS f32x4* kr = (const LAS f32x4*)(KMS + l31 * 64 + 16 * s + 8 * hi);
            const f32x4 ka = kr[0], kc = kr[1];
            u32x4 kh; kh.x = cvt_pk_bf16(ka.x, ka.y); kh.y = cvt_pk_bf16(ka.z, ka.w); kh.z = cvt_pk_bf16(kc.x, kc.y); kh.w = cvt_pk_bf16(kc.z, kc.w);
            u32x4 kl; kl.x = cvt_pk_bf16(ka.x - bf_lo(kh.x), ka.y - bf_hi(kh.x)); kl.y = cvt_pk_bf16(ka.z - bf_lo(kh.y), ka.w - bf_hi(kh.y));
            kl.z = cvt_pk_bf16(kc.x - bf_lo(kh.z), kc.y - bf_hi(kh.z)); kl.w = cvt_pk_bf16(kc.z - bf_lo(kh.w), kc.w - bf_hi(kh.w));
            p = __builtin_amdgcn_mfma_f32_32x32x16_bf16(__builtin_bit_cast(bf16x8_t, kl), __builtin_bit_cast(bf16x8_t, qh), p, 0, 0, 0);
            p = __builtin_amdgcn_mfma_f32_32x32x16_bf16(__builtin_bit_cast(bf16x8_t, kh), __builtin_bit_cast(bf16x8_t, ql), p, 0, 0, 0);
            p = __builtin_amdgcn_mfma_f32_32x32x16_bf16(__builtin_bit_cast(bf16x8_t, kh), __builtin_bit_cast(bf16x8_t, qh), p, 0, 0, 0);
        }
        float v0 = -INFINITY, v1 = -INFINITY, v2 = -INFINITY; int i0 = -1, i1 = -1, i2 = -1;
#pragma unroll
        for (int r = 0; r < 16; ++r) {
            const int n = crow(r, hi); const float g = (n < i) ? p[r] : -INFINITY;
            if (g > v0) { v2 = v1; i2 = i1; v1 = v0; i1 = i0; v0 = g; i0 = n; }
            else if (g > v1) { v2 = v1; i2 = i1; v1 = g; i1 = n; }
            else if (g > v2) { v2 = g; i2 = n; }
        }
        const float pv0 = __shfl_xor(v0, 32), pv1 = __shfl_xor(v1, 32), pv2 = __shfl_xor(v2, 32);
        const int pi0 = __shfl_xor(i0, 32), pi1 = __shfl_xor(i1, 32), pi2 = __shfl_xor(i2, 32);
        if (hi == 0) {
            float av[3] = {v0, v1, v2}, bv[3] = {pv0, pv1, pv2}; int ai[3] = {i0, i1, i2}, bi[3] = {pi0, pi1, pi2};
            int sel[3]; int pa = 0, pb = 0;
#pragma unroll
            for (int k = 0; k < 3; ++k) {
                const float ca = pa == 0 ? av[0] : (pa == 1 ? av[1] : av[2]); const int cai = pa == 0 ? ai[0] : (pa == 1 ? ai[1] : ai[2]);
                const float cb = pb == 0 ? bv[0] : (pb == 1 ? bv[1] : bv[2]); const int cbi = pb == 0 ? bi[0] : (pb == 1 ? bi[1] : bi[2]);
                if (ca > cb || (ca == cb && (cbi < 0 || (cai >= 0 && cai < cbi)))) { sel[k] = cai; ++pa; } else { sel[k] = cbi; ++pb; }
            }
#pragma unroll
            for (int k = 0; k < 3; ++k) if (sel[k] >= 0) { const int pos = __hip_atomic_fetch_add(&CNT[sel[k]], 1, __ATOMIC_RELAXED, __HIP_MEMORY_SCOPE_WORKGROUP); LIST[sel[k] * 256 + pos] = (u16)(q | (k << 8)); }
        }
    }
    __syncthreads();
    {
        int base = 0;
        for (int j = 0; j < i; ++j) {
            const int cntj = __builtin_amdgcn_readfirstlane(CNT[j]);
            const int ntj = (cntj + 31) >> 5;
            for (int t = base + ((wave - base) & 7); t < base + ntj; t += 8) {
                const int tt = t - base;
                const int ridx = 32 * tt + l31; const bool valid = ridx < cntj;
                const int ent = valid ? (int)LIST[j * 256 + ridx] : 0;
                const int qidx = ent & 255;
                s16x8 qf[4];
#pragma unroll
                for (int s = 0; s < 4; ++s) qf[s] = *(const LAS s16x8*)(QS + qs_off(qidx, 2 * s + hi));
                const size_t boff = ((size_t)bh * NBLK + j) * (BLK * HD) + lane * 8;
                f32x16 o0, o1; float lsum;
                attn_tile_full(KB + boff, VT + boff, QS, qidx, hi, c1, c2, o0, o1, lsum);
                const int srow = valid ? ((ent >> 8) * 256 + qidx) : -1;
                lsum += __shfl_xor(lsum, 32);
                if (valid && hi == 0) LSL[srow] = lsum;
#pragma unroll
                for (int r = 0; r < 16; ++r) { const int sr = __shfl(srow, crow(r, hi));
                    if (sr >= 0) { const unsigned w = cvt_pk_bf16(o0[r], o1[r]); SLOT[sr * 64 + l31] = (u16)(w & 0xffffu); SLOT[sr * 64 + 32 + l31] = (u16)(w >> 16); }
                    if ((r & 3) == 3) asm volatile("" ::: "memory"); }
            }
            base += ntj;
        }
    }
    f32x16 oo0, oo1; float lown;
    {
        s16x8 qf[4];
#pragma unroll
        for (int s = 0; s < 4; ++s) qf[s] = *(const LAS s16x8*)(QS + qs_off(32 * wave + l31, 2 * s + hi));
        const size_t boff = ((size_t)bh * NBLK + i) * (BLK * HD) + lane * 8;
        attn_tile(KB + boff, VT + boff, qf, wave + 1, true, wave, 32 * wave + l31, hi, c1, c2, oo0, oo1, lown);
    }
    __syncthreads();
    {
        const int q = 32 * wave + l31;
        float lt = lown + __shfl_xor(lown, 32);
        lt += LSL[q] + LSL[256 + q] + LSL[512 + q];
        const float inv = 1.0f / lt;
#pragma unroll
        for (int r = 0; r < 16; ++r) { const int rl = crow(r, hi), qq = 32 * wave + rl; const float iv = __shfl(inv, rl);
            float a = oo0[r], c = oo1[r];
#pragma unroll
            for (int k = 0; k < 3; ++k) { a += __builtin_bit_cast(float, (unsigned)SLOT[(k * 256 + qq) * 64 + l31] << 16); c += __builtin_bit_cast(float, (unsigned)SLOT[(k * 256 + qq) * 64 + 32 + l31] << 16); }
            const unsigned w = cvt_pk_bf16(a * iv, c * iv);
            QS[qq * 64 + l31] = (u16)(w & 0xffffu); QS[qq * 64 + 32 + l31] = (u16)(w >> 16);
            if ((r & 3) == 3) asm volatile("" ::: "memory"); }
        LDS_WAIT(); asm volatile("" ::: "memory");
#pragma unroll
        for (int it = 0; it < 4; ++it) { const int c = lane + 64 * it, row = c >> 3, ch = c & 7;
            const u32x4 w = *(const LAS u32x4*)(QS + (32 * wave + row) * 64 + 8 * ch);
            const size_t tok = (size_t)b * SEQ + (size_t)i * BLK + 32 * wave + row;
            *(GAS u32x4*)(ATT + tok * D_MODEL + AW + h * HD + 8 * ch) = w;
            float ss = bf_lo(w.x) * bf_lo(w.x) + bf_hi(w.x) * bf_hi(w.x) + bf_lo(w.y) * bf_lo(w.y) + bf_hi(w.y) * bf_hi(w.y) + bf_lo(w.z) * bf_lo(w.z) + bf_hi(w.z) * bf_hi(w.z) + bf_lo(w.w) * bf_lo(w.w) + bf_hi(w.w) * bf_hi(w.w);
            ss += __shfl_xor(ss, 1); ss += __shfl_xor(ss, 2); ss += __shfl_xor(ss, 4);
            if (ch == 0) SSQA[tok * NHEAD + h] = ss; }
    }
    __syncthreads();
}
__device__ __forceinline__ void attn_phase(Frame& F) {
    LAS float* mm = (LAS float*)(F.lds + AL_MISC);
    if (F.tid < 64) { float a = fabsf(F.q_norm_g()[F.tid]), c = fabsf(F.k_norm_g()[F.tid]);
#pragma unroll
        for (int o = 1; o < 64; o <<= 1) { a = fmaxf(a, __shfl_xor(a, o)); c = fmaxf(c, __shfl_xor(c, o)); }
        if (F.tid == 0) { mm[0] = a; mm[1] = c; } }
    __syncthreads();
    const float C = 8.0f * mm[0] * mm[1];
    const float c1 = 0.125f * LOG2E, c2 = C * LOG2E;
    __syncthreads();
    if (F.G == 256) {
        const int xcd = F.vcu >> 5, k = F.vcu & 31;
#pragma unroll 1
        for (int r = 0; r < 4; ++r) attn_item(F, xcd * 4 + r, (r & 1) ? 31 - k : k, c1, c2);
    } else {
        for (int it = F.vcu; it < BATCH * NHEAD * NBLK; it += F.G) attn_item(F, it >> 5, it & 31, c1, c2);
    }
}

constexpr int LL_CW = 0;
template <bool FINAL>
__device__ __forceinline__ void lru_item(Frame& F, int b, int chunk) {
    unsigned char* wsp = F.ws; asm volatile("" : "+s"(wsp));
    const u16* XR = (const u16*)(wsp + WS_XR); const u16* GG = (const u16*)(wsp + WS_GG);
    const u16* WaT = (const u16*)(wsp + WS_WA); const u16* WxT = (const u16*)(wsp + WS_WX);
    float* AGG = (float*)(wsp + WS_AGG); u16* LRU = (u16*)(wsp + WS_MIX); float* SSQL = (float*)(wsp + WS_SSQL);
    const int lane0 = F.lane, hd = F.wave, hi0 = lane0 >> 5, j0 = lane0 & 31;
    LAS float* CW = (LAS float*)(F.lds + LL_CW + hd * 2048);
    LAS u16* OT = (LAS u16*)(F.lds + 16384 + hd * 4096);
    for (int u = lane0; u < 320; u += 64) CW[u] = (u < 256) ? F.lru_conv_w()[(u >> 6) * AW + hd * HD + (u & 63)] : F.lru_conv_b()[hd * HD + (u - 256)];
    CW[320 + lane0] = F.lru_ba()[hd * HD + lane0]; CW[384 + lane0] = F.lru_bx()[hd * HD + lane0]; CW[448 + lane0] = 8.0f * log1pf(expf(-F.lru_lambda()[hd * HD + lane0]));
    LDS_WAIT(); asm volatile("" ::: "memory");
    float carry[2], arun[2];
#pragma unroll
    for (int ct = 0; ct < 2; ++ct) { const int c = hd * HD + 32 * ct + j0; carry[ct] = 0.f; arun[ct] = 1.f;
        if (FINAL) { float hcar = 0.f; for (int cc = 0; cc < chunk; ++cc) { const f32x2 ah = *(const f32x2*)(AGG + (((size_t)(b * 64 + cc)) * AW + c) * 2); hcar = ah.x * hcar + ah.y; } carry[ct] = hcar; } }
    for (int tile = 0; tile < 4; ++tile) {
        const int t0 = chunk * 128 + tile * 32;
        const u16* WaTt = WaT; const u16* WxTt = WxT; int lane = lane0; asm volatile("" : "+s"(WaTt), "+s"(WxTt), "+v"(lane));
        const int hi = lane >> 5, j = lane & 31, jt = j;
        const int pos = t0 + j;
        s16x8 af[4];
#pragma unroll
        for (int s = 0; s < 4; ++s) {
            const int ch0 = 16 * s + 8 * hi;
            float xc[8];
            { const LAS f32x4* bp = (const LAS f32x4*)(CW + 256 + ch0); const f32x4 b0 = bp[0], b1 = bp[1];
              xc[0] = b0.x; xc[1] = b0.y; xc[2] = b0.z; xc[3] = b0.w; xc[4] = b1.x; xc[5] = b1.y; xc[6] = b1.z; xc[7] = b1.w; }
            float accv[8];
#pragma unroll
            for (int e = 0; e < 8; ++e) accv[e] = 0.f;
#pragma unroll
            for (int jj = 0; jj < 4; ++jj) {
                const int p = pos - 3 + jj;
                const int pc = p < 0 ? 0 : p;
                u32x4 xw = *(const GAS u32x4*)(XR + ((((size_t)b * (SEQ / 32) + (pc >> 5)) * NHEAD + hd) * 2048) + ((s * 2 + hi) * 32 + (pc & 31)) * 8);
                if (p < 0) xw = (u32x4){0u, 0u, 0u, 0u};
                const LAS f32x4* wp = (const LAS f32x4*)(CW + jj * 64 + ch0); const f32x4 w0 = wp[0], w1 = wp[1];
                accv[0] += w0.x * bf_lo(xw.x); accv[1] += w0.y * bf_hi(xw.x); accv[2] += w0.z * bf_lo(xw.y); accv[3] += w0.w * bf_hi(xw.y);
                accv[4] += w1.x * bf_lo(xw.z); accv[5] += w1.y * bf_hi(xw.z); accv[6] += w1.z * bf_lo(xw.w); accv[7] += w1.w * bf_hi(xw.w);
            }
#pragma unroll
            for (int e = 0; e < 8; ++e) xc[e] += accv[e];
            u32x4 aw; aw.x = cvt_pk_bf16(xc[0], xc[1]); aw.y = cvt_pk_bf16(xc[2], xc[3]); aw.z = cvt_pk_bf16(xc[4], xc[5]); aw.w = cvt_pk_bf16(xc[6], xc[7]);
            af[s] = __builtin_bit_cast(s16x8, aw);
        }
        float ssacc[16];
#pragma unroll
        for (int r = 0; r < 16; ++r) ssacc[r] = 0.f;
#pragma unroll
        for (int ct = 0; ct < 2; ++ct) {
            float av[16], uv[16];
            {
                f32x16 aA, aX;
#pragma unroll
                for (int r = 0; r < 16; ++r) { aA[r] = 0.f; aX[r] = 0.f; }
#pragma unroll
                for (int s = 0; s < 4; ++s) {
                    const size_t woff = (size_t)hd * 4096 + (ct * 4 + s) * 512 + lane * 8;
                    const s16x8 wa = *(const GAS s16x8*)(WaTt + woff), wx = *(const GAS s16x8*)(WxTt + woff);
                    const bf16x8_t a = __builtin_bit_cast(bf16x8_t, af[s]);
                    aA = __builtin_amdgcn_mfma_f32_32x32x16_bf16(a, __builtin_bit_cast(bf16x8_t, wa), aA, 0, 0, 0);
                    aX = __builtin_amdgcn_mfma_f32_32x32x16_bf16(a, __builtin_bit_cast(bf16x8_t, wx), aX, 0, 0, 0);
                }
                const float bac = CW[320 + 32 * ct + jt], bxc = CW[384 + 32 * ct + jt], sp8c = CW[448 + 32 * ct + jt];
#pragma unroll
                for (int r = 0; r < 16; ++r) {
                    const float rr = sigmoidf_(aA[r] + bac), ii = sigmoidf_(aX[r] + bxc);
                    const float la = -rr * sp8c;
                    const float a = __builtin_amdgcn_exp2f(la * LOG2E);
                    const float om = fmaf(-a, a, 1.0f);
                    av[r] = a; uv[r] = __builtin_amdgcn_sqrtf(om) * ii;
                }
            }
            f32x16 aG;
            {
                f32x16 aI;
#pragma unroll
                for (int r = 0; r < 16; ++r) { aI[r] = 0.f; aG[r] = 0.f; }
#pragma unroll
                for (int s = 0; s < 4; ++s) {
                    s16x8 id;
#pragma unroll
                    for (int e = 0; e < 8; ++e) id[e] = (16 * s + 8 * hi + e == 32 * ct + jt) ? (short)0x3F80 : (short)0;
                    aI = __builtin_amdgcn_mfma_f32_32x32x16_bf16(__builtin_bit_cast(bf16x8_t, af[s]), __builtin_bit_cast(bf16x8_t, id), aI, 0, 0, 0);
                    if (FINAL) { const s16x8 gfr = *(const GAS s16x8*)(GG + ((((size_t)b * (SEQ / 32) + (t0 >> 5)) * NHEAD + hd) * 2048) + s * 512 + lane * 8);
                        aG = __builtin_amdgcn_mfma_f32_32x32x16_bf16(__builtin_bit_cast(bf16x8_t, gfr), __builtin_bit_cast(bf16x8_t, id), aG, 0, 0, 0); }
                }
#pragma unroll
                for (int r = 0; r < 16; ++r) uv[r] *= aI[r];
            }
            float Ag[4], Ug[4];
#pragma unroll
            for (int g = 0; g < 4; ++g) { float A = av[4 * g], U = uv[4 * g];
#pragma unroll
                for (int e = 1; e < 4; ++e) { A *= av[4 * g + e]; U = av[4 * g + e] * U + uv[4 * g + e]; }
                Ag[g] = A; Ug[g] = U; }
            float h = carry[ct], ap = arun[ct];
            float hin[4];
#pragma unroll
            for (int g = 0; g < 4; ++g) {
                const float pA = __shfl_xor(Ag[g], 32), pU = __shfl_xor(Ug[g], 32);
                const float fA = hi ? pA : Ag[g], fU = hi ? pU : Ug[g], sA = hi ? Ag[g] : pA, sU = hi ? Ug[g] : pU;
                const float h1 = fA * h + fU;
                hin[g] = hi ? h1 : h;
                h = sA * h1 + sU; ap *= fA * sA;
            }
            carry[ct] = h; arun[ct] = ap;
            if (FINAL) {
#pragma unroll
                for (int g = 0; g < 4; ++g) { float hh = hin[g];
#pragma unroll
                    for (int e = 0; e < 4; ++e) { const int r = 4 * g + e; hh = av[r] * hh + uv[r]; const float o = hh * aG[r]; ssacc[r] += o * o;
                        OT[crow(r, hi) * 64 + 32 * ct + j] = (u16)(cvt_pk_bf16(o, 0.f) & 0xffffu); } }
            }
        }
        if (FINAL) {
#pragma unroll
            for (int r = 0; r < 16; ++r) {
                const size_t tok = (size_t)b * SEQ + t0 + crow(r, hi);
                float ss = ssacc[r];
                ss += __shfl_xor(ss, 1); ss += __shfl_xor(ss, 2); ss += __shfl_xor(ss, 4); ss += __shfl_xor(ss, 8); ss += __shfl_xor(ss, 16);
                if (j == 0) SSQL[tok * NHEAD + hd] = ss;
            }
            LDS_WAIT(); asm volatile("" ::: "memory");
#pragma unroll
            for (int it = 0; it < 4; ++it) { const int c = lane + 64 * it, row = c >> 3, ch = c & 7;
                const u32x4 w = *(const LAS u32x4*)(OT + row * 64 + 8 * ch);
                *(GAS u32x4*)(LRU + ((size_t)b * SEQ + t0 + row) * D_MODEL + hd * HD + 8 * ch) = w; }
            LDS_WAIT(); asm volatile("" ::: "memory");
        }
    }
    if (!FINAL) { if (hi0 == 0) {
#pragma unroll
        for (int ct = 0; ct < 2; ++ct) { const int c = hd * HD + 32 * ct + j0; *(f32x2*)(AGG + (((size_t)(b * 64 + chunk)) * AW + c) * 2) = (f32x2){arun[ct], carry[ct]}; } } }
}
template <bool FINAL>
__device__ __forceinline__ void lru_phase(Frame& F) {
    for (int it = F.vcu; it < BATCH * 64; it += F.G) { lru_item<FINAL>(F, it >> 6, it & 63); }
}

__device__ __forceinline__ void mix_phase(Frame& F) {
    unsigned char* wsp = F.ws; asm volatile("" : "+s"(wsp));
    const u16* LRU = (const u16*)(wsp + WS_LRU); const u16* ATT = (const u16*)(wsp + WS_ATT);
    const float* SSQL = (const float*)(wsp + WS_SSQL); const float* SSQA = (const float*)(wsp + WS_SSQA); u16* MIX = (u16*)(wsp + WS_MIX);
    const int gw = F.vcu * NWAVES + F.wave, NGW = F.G * NWAVES, lane = F.lane;
    const f32x4 gl0 = *(const f32x4*)(F.lru_out_g() + 8 * lane), gl1 = *(const f32x4*)(F.lru_out_g() + 8 * lane + 4);
    const f32x4 ga0 = *(const f32x4*)(F.attn_out_g() + 8 * lane), ga1 = *(const f32x4*)(F.attn_out_g() + 8 * lane + 4);
    for (int m = gw; m < M_TOK; m += NGW) {
        const f32x4 s0 = *(const GAS f32x4*)(SSQL + (size_t)m * 8), s1 = *(const GAS f32x4*)(SSQL + (size_t)m * 8 + 4);
        const f32x4 t0 = *(const GAS f32x4*)(SSQA + (size_t)m * 8), t1 = *(const GAS f32x4*)(SSQA + (size_t)m * 8 + 4);
        const float ssl = ((s0.x + s0.y) + (s0.z + s0.w)) + ((s1.x + s1.y) + (s1.z + s1.w));
        const float ssa = ((t0.x + t0.y) + (t0.z + t0.w)) + ((t1.x + t1.y) + (t1.z + t1.w));
        const float rl = 1.0f / sqrtf(ssl * (1.0f / AW) + EPS), ra = 1.0f / sqrtf(ssa * (1.0f / AW) + EPS);
        const u32x4 lw = *(const GAS u32x4*)(LRU + (size_t)m * AW + 8 * lane), aw = *(const GAS u32x4*)(ATT + (size_t)m * AW + 8 * lane);
        u32x4 o;
        o.x = cvt_pk_bf16(bf_lo(lw.x) * rl * gl0.x, bf_hi(lw.x) * rl * gl0.y); o.y = cvt_pk_bf16(bf_lo(lw.y) * rl * gl0.z, bf_hi(lw.y) * rl * gl0.w);
        o.z = cvt_pk_bf16(bf_lo(lw.z) * rl * gl1.x, bf_hi(lw.z) * rl * gl1.y); o.w = cvt_pk_bf16(bf_lo(lw.w) * rl * gl1.z, bf_hi(lw.w) * rl * gl1.w);
        *(GAS u32x4*)(MIX + (size_t)m * D_MODEL + 8 * lane) = o;
        o.x = cvt_pk_bf16(bf_lo(aw.x) * ra * ga0.x, bf_hi(aw.x) * ra * ga0.y); o.y = cvt_pk_bf16(bf_lo(aw.y) * ra * ga0.z, bf_hi(aw.y) * ra * ga0.w);
        o.z = cvt_pk_bf16(bf_lo(aw.z) * ra * ga1.x, bf_hi(aw.z) * ra * ga1.y); o.w = cvt_pk_bf16(bf_lo(aw.w) * ra * ga1.z, bf_hi(aw.w) * ra * ga1.w);
        *(GAS u32x4*)(MIX + (size_t)m * D_MODEL + AW + 8 * lane) = o;
    }
}

__device__ __forceinline__ void ffn_fixup(Frame& F, unsigned char* wsp, int pm) {
    const float* RAW = (const float*)(wsp + WS_RAW); u16* ACT = (u16*)(wsp + WS_ACT);
    const float* cw = F.ffn_conv_w(); const float* cb = F.ffn_conv_b();
    const bool first = (pm % NBLK) == 0;
    for (int f = F.tid; f < D_FF; f += NT) {
        float xg[4], xv[4];
        xg[0] = first ? 0.f : RAW[((size_t)(pm - 1) * 4 + 2) * N_UP + f]; xg[1] = first ? 0.f : RAW[((size_t)(pm - 1) * 4 + 3) * N_UP + f];
        xv[0] = first ? 0.f : RAW[((size_t)(pm - 1) * 4 + 2) * N_UP + D_FF + f]; xv[1] = first ? 0.f : RAW[((size_t)(pm - 1) * 4 + 3) * N_UP + D_FF + f];
        xg[2] = RAW[((size_t)pm * 4 + 0) * N_UP + f]; xg[3] = RAW[((size_t)pm * 4 + 1) * N_UP + f];
        xv[2] = RAW[((size_t)pm * 4 + 0) * N_UP + D_FF + f]; xv[3] = RAW[((size_t)pm * 4 + 1) * N_UP + D_FF + f];
        const float wg0 = cw[f], wg1 = cw[N_UP + f], wg2 = cw[2 * N_UP + f], bg = cb[f];
        const float wv0 = cw[D_FF + f], wv1 = cw[N_UP + D_FF + f], wv2 = cw[2 * N_UP + D_FF + f], bv = cb[D_FF + f];
#pragma unroll
        for (int r = 0; r < 2; ++r) {
            const float cg = ((wg0 * xg[r] + wg1 * xg[r + 1]) + wg2 * xg[r + 2]) + bg;
            const float cv = ((wv0 * xv[r] + wv1 * xv[r + 1]) + wv2 * xv[r + 2]) + bv;
            ACT[((size_t)pm * 256 + r) * D_FF + f] = (u16)(cvt_pk_bf16(cg * sigmoidf_(cg) * cv, 0.f) & 0xffffu);
        }
    }
}

constexpr int N_PHASES = 10;
__global__ void __launch_bounds__(NT, 2) hymba_fwd(Args args) {
    extern __shared__ __attribute__((aligned(16))) unsigned char lds_raw[];
    Frame F;
    F.lds = (LAS unsigned char*)lds_raw;
    F.tid = threadIdx.x; F.lane = F.tid & 63; F.wave = __builtin_amdgcn_readfirstlane(F.tid >> 6); F.wave0 = F.wave;
    F.G = gridDim.x; { const int bx = blockIdx.x; F.vcu = (F.G % 8 == 0) ? (bx % 8) * (F.G / 8) + bx / 8 : bx; }
    F.pa = &args;
    F.out = args.out; F.ws = args.ws;
    volatile LAS unsigned* MISC = (volatile LAS unsigned*)(F.lds + MISC_OFF);
    if (F.tid < 32) MISC[F.tid] = 0u;
    __syncthreads();
    const int lo = args.ph_lo, hi = args.ph_hi;
#ifndef PROBE_PH
#define PROBE_PH -1
#endif
    unsigned long long tpa = 0, tpb = 0;
#define TP_A(k) do { if ((k) == PROBE_PH) tpa = __builtin_amdgcn_s_memrealtime(); } while (0)
#define TP_B(k) do { if ((k) == PROBE_PH) tpb = __builtin_amdgcn_s_memrealtime(); } while (0)
    unsigned* ctl = (unsigned*)(F.ws + WS_CTL);
    XcdBarrier bar; bar.bar = ctl + CW_BAR; bar.x = 0; bar.st = nullptr;
    if (hi - lo > 1) bar = xcd_barrier_post(ctl + CW_BAR, MISC + 8);
#ifndef PHASE_MASK
#define PHASE_MASK 0x3FF
#endif
#define IN(k) (((PHASE_MASK >> (k)) & 1) && lo <= (k) && (k) < hi)
#ifndef DUP_MASK
#define DUP_MASK 0
#endif
#define REP(k) _Pragma("unroll 1") for (int rep_ = 0; rep_ < 1 + ((DUP_MASK >> (k)) & 1); ++rep_)
#ifndef XBAR
#define XBAR 0
#endif
#define SEAM(k) do { if (IN(k) && IN((k) + 1)) { xcd_barrier(bar, F.wave0 * 64 + lane_id()); for (int xb_ = 0; xb_ < XBAR; ++xb_) xcd_barrier(bar, F.wave0 * 64 + lane_id()); } } while (0)
#define MOD ((float*)(wsp + WS_MOD))
#define H ((u16*)(wsp + WS_H))

    TP_A(0);
    if (IN(0)) { unsigned char* wsp = F.ws; asm volatile("" : "+s"(wsp)); { int t_ = F.wave0 * 64 + lane_id(); asm volatile("" : "+v"(t_)); F.tid = t_; F.lane = t_ & 63; F.wave = __builtin_amdgcn_readfirstlane(t_ >> 6); } REP(0) p0_prologue(F); SEAM(0); }
    TP_B(0);
    TP_A(1);
    if (IN(1)) { unsigned char* wsp = F.ws; asm volatile("" : "+s"(wsp)); { int t_ = F.wave0 * 64 + lane_id(); asm volatile("" : "+v"(t_)); F.tid = t_; F.lane = t_ & 63; F.wave = __builtin_amdgcn_readfirstlane(t_ >> 6); } REP(1) { p1_upweights(F, wsp); rownorm_phase<true>(F, F.x(), F.norm1_g(), MOD + 0, MOD + 1024, H); } SEAM(1); }
    TP_B(1);
    TP_A(2);
    if (IN(2)) { unsigned char* wsp = F.ws; asm volatile("" : "+s"(wsp)); { int t_ = F.wave0 * 64 + lane_id(); asm volatile("" : "+v"(t_)); F.tid = t_; F.lane = t_ & 63; F.wave = __builtin_amdgcn_readfirstlane(t_ >> 6); }
        pg8::Gemm g{H, (const u16*)(wsp + WS_WIN), M_TOK, N_IN, D_MODEL, 0}; pg8::StaticOrder S; S.init(M_TOK, N_IN, F.G, (int)blockIdx.x);
        pg8::EpiInProj E{(float*)(wsp + WS_QF), (u16*)(wsp + WS_KB), (u16*)(wsp + WS_VT), (u16*)(wsp + WS_XR), (u16*)(wsp + WS_GG), (float*)(wsp + WS_KM), F.q_norm_g(), F.k_norm_g()};
        REP(2) pg8::gemm_phase<pg8::EpiInProj, pg8::StaticOrder, true, true, true>(F.lds, g, S, E, F.wave0);
        SEAM(2);
    }
    TP_B(2);
    TP_A(3);
    if (IN(3)) { unsigned char* wsp = F.ws; asm volatile("" : "+s"(wsp)); { int t_ = F.wave0 * 64 + lane_id(); asm volatile("" : "+v"(t_)); F.tid = t_; F.lane = t_ & 63; F.wave = __builtin_amdgcn_readfirstlane(t_ >> 6); }
        cb2_prep(F, wsp); REP(13) lru_phase<false>(F);
        asm volatile("s_waitcnt vmcnt(0)" ::: "memory"); __syncthreads();
        if (F.tid == 0) { __builtin_amdgcn_fence(__ATOMIC_RELEASE, "agent"); asm volatile("s_waitcnt vmcnt(0)" ::: "memory"); (void)__hip_atomic_fetch_add(ctl + CW_AGGCNT, 1u, __ATOMIC_RELAXED, __HIP_MEMORY_SCOPE_AGENT); }
        { int t_ = F.wave0 * 64 + lane_id(); asm volatile("" : "+v"(t_)); F.tid = t_; F.lane = t_ & 63; F.wave = __builtin_amdgcn_readfirstlane(t_ >> 6); } REP(3) attn_phase(F);
        { int t_ = F.wave0 * 64 + lane_id(); asm volatile("" : "+v"(t_)); F.tid = t_; F.lane = t_ & 63; F.wave = __builtin_amdgcn_readfirstlane(t_ >> 6); }
        if (F.tid < 64) { unsigned sp = 0;
            while ((unsigned)__builtin_amdgcn_readfirstlane(__hip_atomic_load(ctl + CW_AGGCNT, __ATOMIC_RELAXED, __HIP_MEMORY_SCOPE_AGENT)) < (unsigned)F.G) {
                __builtin_amdgcn_s_sleep(2); if (++sp > (1u << 20)) { if (F.tid == 0) atomicAdd(ctl + CW_BAR + XB_TMO, 1u); break; } }
            __builtin_amdgcn_fence(__ATOMIC_ACQUIRE, "agent"); asm volatile("s_waitcnt vmcnt(0)" ::: "memory"); }
        __syncthreads();
        REP(4) lru_phase<true>(F);
        if (IN(3) && IN(6)) xcd_barrier(bar, F.wave0 * 64 + lane_id()); }
    TP_B(3);
    TP_A(4);
    TP_B(4);
    TP_A(6);
    if (IN(6)) { unsigned char* wsp = F.ws; asm volatile("" : "+s"(wsp)); { int t_ = F.wave0 * 64 + lane_id(); asm volatile("" : "+v"(t_)); F.tid = t_; F.lane = t_ & 63; F.wave = __builtin_amdgcn_readfirstlane(t_ >> 6); }
        pg8::Gemm g{(const u16*)(wsp + WS_MIX), (const u16*)(wsp + WS_WO), M_TOK, D_MODEL, D_MODEL, 0}; pg8::StaticOrder S; S.init(M_TOK, D_MODEL, F.G, (int)blockIdx.x);
        LAS f32x2* RT = (LAS f32x2*)(F.lds + XB_OFF);
        { const float* SSQL = (const float*)(wsp + WS_SSQL); const float* SSQA = (const float*)(wsp + WS_SSQA);
          for (int i = 0; i < 8; ++i) { pg8::Unit uu; if (!S.next(i, uu)) break;
              if (F.tid < 256) { const size_t row = (size_t)uu.pm * 256 + F.tid;
                  const f32x4 s0 = *(const f32x4*)(SSQL + row * 8), s1 = *(const f32x4*)(SSQL + row * 8 + 4), t0 = *(const f32x4*)(SSQA + row * 8), t1 = *(const f32x4*)(SSQA + row * 8 + 4);
                  const float ssl = ((s0[0] + s0[1]) + (s0[2] + s0[3])) + ((s1[0] + s1[1]) + (s1[2] + s1[3])), ssa = ((t0[0] + t0[1]) + (t0[2] + t0[3])) + ((t1[0] + t1[1]) + (t1[2] + t1[3]));
                  const float rl = 1.0f / sqrtf(ssl * (1.0f / AW) + EPS), ra = 1.0f / sqrtf(ssa * (1.0f / AW) + EPS);
                  RT[i * 256 + F.tid] = (f32x2){rl / ra, ra}; } }
          __syncthreads(); }
        pg8::EpiOut E{F.x(), H, (float*)(wsp + WS_SSQX), MOD + 2048, RT};
        REP(6) pg8::gemm_phase<pg8::EpiOut, pg8::StaticOrder, true, true, false>(F.lds, g, S, E, F.wave0);
        if (IN(6) && IN(8)) xcd_barrier(bar, F.wave0 * 64 + lane_id());
    }
    TP_B(6);
    TP_A(8);
    if (IN(8)) { unsigned char* wsp = F.ws; asm volatile("" : "+s"(wsp)); { int t_ = F.wave0 * 64 + lane_id(); asm volatile("" : "+v"(t_)); F.tid = t_; F.lane = t_ & 63; F.wave = __builtin_amdgcn_readfirstlane(t_ >> 6); }
        pg8::Gemm g{H, (const u16*)(wsp + WS_WUP4), M_TOK, N_UP, D_MODEL, (size_t)N_UP * D_MODEL * 2}; pg8::StaticOrder S; S.init(M_TOK, N_UP, F.G, (int)blockIdx.x);
        LAS float* R2ALL = (LAS float*)(F.lds + XB_OFF + 8192); LAS float* CT = (LAS float*)(F.lds + XB_OFF + 8192 + 12 * 1024);
        { const float* SSQX = (const float*)(wsp + WS_SSQX);
          for (int i = 0; i < 12; ++i) { pg8::Unit uu; if (!S.next(i, uu)) break;
              if (F.tid < 256) { const size_t row = (size_t)uu.pm * 256 + F.tid;
                  const f32x4 s0 = *(const f32x4*)(SSQX + row * 16), s1 = *(const f32x4*)(SSQX + row * 16 + 4), s2 = *(const f32x4*)(SSQX + row * 16 + 8), s3 = *(const f32x4*)(SSQX + row * 16 + 12);
                  const float ss = (((s0[0] + s0[1]) + (s0[2] + s0[3])) + ((s1[0] + s1[1]) + (s1[2] + s1[3]))) + (((s2[0] + s2[1]) + (s2[2] + s2[3])) + ((s3[0] + s3[1]) + (s3[2] + s3[3])));
                  R2ALL[i * 256 + F.tid] = 1.0f / sqrtf(ss * (1.0f / D_MODEL) + EPS); } }
          __syncthreads(); }
        pg8::EpiFFN E{(u16*)(wsp + WS_ACT), (float*)(wsp + WS_RAW), F.ffn_conv_w(), (const float*)(wsp + WS_CB2), (LAS float*)(F.lds + XB_OFF), (const float*)(wsp + WS_SSQX), (const float*)(wsp + WS_BIAS2), R2ALL, CT};
        REP(8) pg8::gemm_phase<pg8::EpiFFN, pg8::StaticOrder, true, true, false>(F.lds, g, S, E, F.wave0);
        SEAM(8);
    }
    TP_B(8);
    TP_A(9);
    if (IN(9)) { unsigned char* wsp = F.ws; asm volatile("" : "+s"(wsp)); { int t_ = F.wave0 * 64 + lane_id(); asm volatile("" : "+v"(t_)); F.tid = t_; F.lane = t_ & 63; F.wave = __builtin_amdgcn_readfirstlane(t_ >> 6); }
        pg8::Gemm g{(const u16*)(wsp + WS_ACT), (const u16*)(wsp + WS_WDN), M_TOK, D_MODEL, D_FF, 0}; pg8::StaticOrder S; S.init(M_TOK, D_MODEL, F.G, (int)blockIdx.x);
        { pg8::Unit u0, u1; int pm0 = -1; if (S.next(0, u0)) { pm0 = u0.pm; ffn_fixup(F, wsp, pm0); } if (S.next(1, u1) && u1.pm != pm0) ffn_fixup(F, wsp, u1.pm);
          for (int i = 2; ; ++i) { pg8::Unit ux; if (!S.next(i, ux)) break; ffn_fixup(F, wsp, ux.pm); }
          asm volatile("s_waitcnt vmcnt(0)" ::: "memory"); __syncthreads(); }
        pg8::EpiResidB E{H, F.out, MOD + 5120};
        REP(9) pg8::gemm_phase<pg8::EpiResidB, pg8::StaticOrder, true, true, false>(F.lds, g, S, E, F.wave0);
    }
    TP_B(9);
    if (PROBE_PH >= 0 && blockIdx.x == 0) { const unsigned long long t0 = __builtin_amdgcn_s_memrealtime(); const unsigned long long want = 4ull * (tpb - tpa);
        while (__builtin_amdgcn_s_memrealtime() - t0 < want) __builtin_amdgcn_s_sleep(8); }
    if (hi - lo > 1 && hi == N_PHASES) {
        if (xb_ld(ctl + CW_BAR + XB_TMO) != 0u) { asm volatile("s_waitcnt vmcnt(0)" ::: "memory"); __syncthreads();
            for (size_t i = (size_t)blockIdx.x * NT + F.tid; i < (size_t)M_TOK * D_MODEL; i += (size_t)F.G * NT) F.out[i] = __builtin_nanf(""); }
    }
#undef IN
#undef MOD
#undef H
#undef SEAM
}

#ifndef MK_PER_PHASE
#define MK_PER_PHASE 0
#endif
extern "C" void kernel_launch(void* const* d_in, const int* in_sizes, int n_in, void* d_out, int out_size, void* d_ws, size_t ws_size, hipStream_t stream) {
    static int grid = 0;
    if (grid == 0) {
        if (n_in != 23 || in_sizes[0] != M_TOK * D_MODEL || out_size != M_TOK * D_MODEL || ws_size < WS_END) {
            fprintf(stderr, "kernel_launch: unexpected shapes (n_in %d, in0 %d, out %d, ws %zu); nothing launched\n", n_in, n_in > 0 ? in_sizes[0] : -1, out_size, ws_size); grid = -1; return; }
        int dev = 0, cus = 0;
        if (hipGetDevice(&dev) != hipSuccess || hipDeviceGetAttribute(&cus, hipDeviceAttributeMultiprocessorCount, dev) != hipSuccess) { grid = -1; return; }
        if (hipFuncSetAttribute((const void*)hymba_fwd, hipFuncAttributeMaxDynamicSharedMemorySize, LDS_BYTES) != hipSuccess) { fprintf(stderr, "kernel_launch: hipFuncSetAttribute failed\n"); grid = -1; return; }
        grid = cus;
    }
    if (grid < 0) return;
    (void)hipMemsetAsync((char*)d_ws + WS_CTL, 0, CTL_ZERO_BYTES, stream);
    Args a{};
    for (int i = 0; i < 23; ++i) a.in[i] = (const float*)d_in[i];
    a.out = (float*)d_out; a.ws = (unsigned char*)d_ws;
#if MK_PER_PHASE
    for (int p = 0; p < N_PHASES; ++p) { a.ph_lo = p; a.ph_hi = p + 1; hipLaunchKernelGGL(hymba_fwd, dim3(grid), dim3(NT), LDS_BYTES, stream, a); }
#else
    a.ph_lo = 0; a.ph_hi = N_PHASES; hipLaunchKernelGGL(hymba_fwd, dim3(grid), dim3(NT), LDS_BYTES, stream, a);
#endif
}
```

```cpp
#include <hip/hip_runtime.h>
#include <cstdio>
#include <cstdint>

#define GAS __attribute__((address_space(1)))
#define LAS __attribute__((address_space(3)))
typedef unsigned short u16;
typedef short s16x8 __attribute__((ext_vector_type(8)));
typedef _Float16 f16x8 __attribute__((ext_vector_type(8)));
typedef __bf16 bf16x8_t __attribute__((ext_vector_type(8)));
typedef float f32x2 __attribute__((ext_vector_type(2)));
typedef float f32x4 __attribute__((ext_vector_type(4)));
typedef float f32x16 __attribute__((ext_vector_type(16)));
typedef unsigned u32x4 __attribute__((ext_vector_type(4)));
typedef unsigned u32x2 __attribute__((ext_vector_type(2)));
typedef int i32x4 __attribute__((ext_vector_type(4)));
typedef int i32x8 __attribute__((ext_vector_type(8)));
typedef GAS unsigned gu32;
#define RLX_AGENT __ATOMIC_RELAXED, __HIP_MEMORY_SCOPE_AGENT

constexpr int D_MODEL = 1024, BATCH = 4, SEQ = 8192, M_TOK = BATCH * SEQ;
constexpr int N_IN = 2560, D_FF = 2816, N_UP = 2 * D_FF, N_MOD = 6 * D_MODEL;
constexpr int NHEAD = 8, HD = 64, AW = 512, NBLK = 32, BLK = 256;
constexpr float EPS = 1e-6f;
constexpr float LOG2E = 1.4426950408889634f;
constexpr float ACT_SCALE = 4.0f, WDN_SCALE = 256.0f;

__device__ __forceinline__ unsigned cvt_pk_bf16(float lo, float hi) { unsigned r; asm volatile("v_cvt_pk_bf16_f32 %0, %1, %2" : "=v"(r) : "v"(lo), "v"(hi)); return r; }
__device__ __forceinline__ unsigned cvt_pk_f16(float lo, float hi) {
    const _Float16 a = (_Float16)lo, b = (_Float16)hi;
    return (unsigned)__builtin_bit_cast(unsigned short, a) | ((unsigned)__builtin_bit_cast(unsigned short, b) << 16);
}
__device__ __forceinline__ unsigned cvt_pk_fp8x4(float a, float b, float c, float d) {
    a = __builtin_amdgcn_fmed3f(a, -448.f, 448.f); b = __builtin_amdgcn_fmed3f(b, -448.f, 448.f); c = __builtin_amdgcn_fmed3f(c, -448.f, 448.f); d = __builtin_amdgcn_fmed3f(d, -448.f, 448.f);
    int r = __builtin_amdgcn_cvt_pk_fp8_f32(a, b, 0, false); r = __builtin_amdgcn_cvt_pk_fp8_f32(c, d, r, true); return (unsigned)r; }
__device__ __forceinline__ float bf_lo(unsigned w) { return __builtin_bit_cast(float, w << 16); }
__device__ __forceinline__ float bf_hi(unsigned w) { return __builtin_bit_cast(float, w & 0xffff0000u); }
__device__ __forceinline__ float sigmoidf_(float v) { return __builtin_amdgcn_rcpf(1.0f + __builtin_amdgcn_exp2f(-v * LOG2E)); }
__device__ __forceinline__ float gelu_tanh(float v) { const float y = 0.7978845608028654f * (v + 0.044715f * v * v * v); return v * sigmoidf_(2.0f * y); }
__device__ __forceinline__ float wave_sum(float v) {
#pragma unroll
    for (int o = 1; o < 64; o <<= 1) v += __shfl_xor(v, o);
    return v;
}

__device__ __forceinline__ int lane_id() { int l; asm volatile("v_mbcnt_lo_u32_b32 %0, -1, 0\n\tv_mbcnt_hi_u32_b32 %0, -1, %0" : "=v"(l)); return l; }

namespace pg8 {
constexpr int BM = 256, BK = 64, HALF = 128, HTB = HALF * BK * 2, STAGE_BYTES = 8 * HTB, NXCD = 8, WGM = 8;
__host__ __device__ __forceinline__ int lds_byte(int r, int c) { const int st = (r >> 4) * 2 + (c >> 5), rr = r & 15, cc = c & 31, ob = rr * 64 + cc * 2; return st * 1024 + (ob ^ (((ob >> 9) & 1) << 5)); }
__host__ __device__ __forceinline__ void stage_rc(int b, int& R, int& C) { const int st = b / 1024, sb = b % 1024, swz = sb ^ (((sb >> 9) & 1) << 5); R = (st >> 1) * 16 + swz / 64; C = (st & 1) * 32 + (swz % 64) / 2; }
__host__ __device__ __forceinline__ int perm32(int rho) { const int n = rho >> 4, i = rho & 15; return 8 * (i >> 2) + 4 * n + (i & 3); }

struct Unit { int pm, pn, ord; };
struct Gemm { const u16* A; const u16* Bt; int M, N, K; size_t bstride; };

struct StaticOrder {
    int nM, nN, nwg, G, c;
    __host__ __device__ __forceinline__ void init(int M, int N, int G_, int c_) { nM = M / BM; nN = N / BM; nwg = nM * nN; G = G_; c = c_; }
    __host__ __device__ __forceinline__ bool next(int i, Unit& u) const {
        const long L = (long)i * G + c; if (L >= nwg) return false;
        int wgid = (int)L; { const int q = nwg / NXCD, r = nwg % NXCD, xcd = wgid % NXCD, off = wgid / NXCD; wgid = (xcd < r ? xcd * (q + 1) : r * (q + 1) + (xcd - r) * q) + off; }
        const int nig = WGM * nN, gid = wgid / nig, fm = gid * WGM, gsz = (nM - fm) < WGM ? (nM - fm) : WGM;
        u.pm = fm + ((wgid % nig) % gsz); u.pn = (wgid % nig) / gsz; u.ord = i; return true;
    }
    __device__ __forceinline__ void a_ready(const Unit&) const {}
    __device__ __forceinline__ void done(const Unit&) const {}
};

template <bool F16> __device__ __forceinline__ f32x4 mfma16(s16x8 a, s16x8 b, f32x4 c) {
    if constexpr (F16) return __builtin_amdgcn_mfma_f32_16x16x32_f16(__builtin_bit_cast(f16x8, a), __builtin_bit_cast(f16x8, b), c, 0, 0, 0);
    else return __builtin_amdgcn_mfma_f32_16x16x32_bf16(__builtin_bit_cast(bf16x8_t, a), __builtin_bit_cast(bf16x8_t, b), c, 0, 0, 0);
}

__device__ __forceinline__ f32x4 mfma_f8(const s16x8 (&a)[2], const s16x8 (&b)[2], f32x4 c) {
    const i32x8 av = __builtin_shufflevector(__builtin_bit_cast(i32x4, a[0]), __builtin_bit_cast(i32x4, a[1]), 0, 1, 2, 3, 4, 5, 6, 7);
    const i32x8 bv = __builtin_shufflevector(__builtin_bit_cast(i32x4, b[0]), __builtin_bit_cast(i32x4, b[1]), 0, 1, 2, 3, 4, 5, 6, 7);
    return __builtin_amdgcn_mfma_scale_f32_16x16x128_f8f6f4(av, bv, c, 0, 0, 0, 0, 0, 0);
}
template <class Epi, class Sched, bool ALIGN_EPI, bool SP2, int MT>
__device__ __forceinline__ void gemm_phase(LAS unsigned char* lds, const Gemm g, const Sched& S, const Epi& E, int wave0) {
    int tid_ = wave0 * 64 + lane_id(); asm volatile("" : "+v"(tid_));
    const int tid = tid_, wid = __builtin_amdgcn_readfirstlane(tid >> 6), lane = tid & 63, wr = wid >> 2, wc = wid & 3, fr = lane & 15, fq = lane >> 4;
    const int K = g.K, nt = K / BK;
    unsigned voffA, voffB;
    { int R, C; stage_rc(tid * 16, R, C); const int Rb = Epi::PERM ? ((R & ~31) + perm32(R & 31)) : R;
        const int Ra = Epi::APERM ? ((R & ~63) + 4 * (R & 15) + ((R >> 4) & 3)) : R;
        voffA = (unsigned)(Ra * K + C) * 2u; voffB = (unsigned)(Rb * K + C) * 2u; }
    const unsigned rstep64 = (unsigned)(64 * K * 2);
    const size_t kstep = (size_t)(BK * 2);
    const size_t hstep = (size_t)HALF * K * 2;
    const size_t tstep = 2 * hstep;
    const unsigned ldsw = (unsigned)wid * 1024u;
    const int aoff = lds_byte(wr * 64 + fr, fq * 8), boff = lds_byte(wc * 32 + fr, fq * 8);
#define PG8_SA(b, h) (((b) * 2 + (h)) * HTB)
#define PG8_SB(b, h) ((4 + (b) * 2 + (h)) * HTB)
#define PG8_STAGE(bufoff, gbase, voff) do { _Pragma("unroll") for (int _i = 0; _i < 2; ++_i) \
        __builtin_amdgcn_global_load_lds((const unsigned*)((const char*)(gbase) + _i * rstep64 + (voff)), (LAS unsigned*)(lds + (bufoff) + ldsw + _i * 8192), 16, 0, 0); } while (0)
#define PG8_LDA(dst, b, h) do { _Pragma("unroll") for (int m = 0; m < 4; ++m) _Pragma("unroll") for (int k = 0; k < 2; ++k) dst[m][k] = *(const LAS s16x8*)(lds + PG8_SA(b, h) + aoff + m * 2048 + k * 1024); } while (0)
#define PG8_LDB(dst, b, h) do { _Pragma("unroll") for (int n = 0; n < 2; ++n) _Pragma("unroll") for (int k = 0; k < 2; ++k) dst[n][k] = *(const LAS s16x8*)(lds + PG8_SB(b, h) + boff + n * 2048 + k * 1024); } while (0)
#define PG8_MMA(ai, bj, At, Bt) do { __builtin_amdgcn_s_setprio(1); _Pragma("unroll") for (int m = 0; m < 4; ++m) _Pragma("unroll") for (int n = 0; n < 2; ++n) { \
        if constexpr (MT == 2) acc[ai][bj][m][n] = mfma_f8(Bt[n], At[m], acc[ai][bj][m][n]); \
        else { _Pragma("unroll") for (int k = 0; k < 2; ++k) acc[ai][bj][m][n] = mfma16<MT == 1>(Bt[n][k], At[m][k], acc[ai][bj][m][n]); } } __builtin_amdgcn_s_setprio(0); } while (0)
#define PG8_WAIT_V(n) asm volatile("s_waitcnt vmcnt(" #n ")" ::: "memory")
#define PG8_WAIT_L(n) asm volatile("s_waitcnt lgkmcnt(" #n ")" ::: "memory")
#define PG8_BAR __builtin_amdgcn_s_barrier()
#define PG8_SCHED __builtin_amdgcn_sched_barrier(0)
    Unit cur, nxt; int ui = 0;
    if (!S.next(0, cur)) return;
    f32x4 acc[2][2][4][2];
#pragma unroll
    for (int a = 0; a < 2; ++a)
#pragma unroll
        for (int b = 0; b < 2; ++b)
#pragma unroll
            for (int m = 0; m < 4; ++m)
#pragma unroll
                for (int n = 0; n < 2; ++n) acc[a][b][m][n] = (f32x4){0.f, 0.f, 0.f, 0.f};
    s16x8 At[4][2], B0[2][2], B1[2][2];
    const char* cA = (const char*)g.A + (size_t)cur.pm * tstep; const char* cB = (const char*)g.Bt + (size_t)cur.pn * tstep + (size_t)(cur.pm >> 5) * g.bstride;
    S.a_ready(cur);
    if constexpr (SP2) {
        PG8_STAGE(PG8_SB(0, 0), cB, voffB); PG8_STAGE(PG8_SB(0, 1), cB + hstep, voffB); PG8_STAGE(PG8_SA(0, 0), cA, voffA); PG8_STAGE(PG8_SA(0, 1), cA + hstep, voffA);
        if (wr == 1) PG8_BAR;
        PG8_WAIT_V(2); PG8_BAR;
        PG8_STAGE(PG8_SB(1, 0), cB + kstep, voffB); PG8_STAGE(PG8_SA(1, 0), cA + kstep, voffA); PG8_STAGE(PG8_SB(1, 1), cB + hstep + kstep, voffB);
        PG8_WAIT_V(6); PG8_BAR;
    } else {
        PG8_STAGE(PG8_SB(0, 0), cB, voffB); PG8_STAGE(PG8_SA(0, 0), cA, voffA); PG8_STAGE(PG8_SB(0, 1), cB + hstep, voffB); PG8_STAGE(PG8_SA(0, 1), cA + hstep, voffA);
        if (wr == 1) PG8_BAR;
        PG8_WAIT_V(4); PG8_BAR;
        PG8_STAGE(PG8_SB(1, 0), cB + kstep, voffB); PG8_STAGE(PG8_SA(1, 0), cA + kstep, voffA); PG8_STAGE(PG8_SB(1, 1), cB + hstep + kstep, voffB);
        PG8_WAIT_V(6); PG8_BAR;
    }
    for (;;) {
        const bool has_next = S.next(ui + 1, nxt);
        const char* nA = has_next ? (const char*)g.A + (size_t)nxt.pm * tstep : cA; const char* nB = has_next ? (const char*)g.Bt + (size_t)nxt.pn * tstep + (size_t)(nxt.pm >> 5) * g.bstride : cB;
        for (int t = 0; t < nt; t += 2) {
            const bool last = (t == nt - 2);
            const char* a1 = cA + (size_t)(t + 1) * kstep;
            const char* a2 = last ? nA : cA + (size_t)(t + 2) * kstep; const char* b2 = last ? nB : cB + (size_t)(t + 2) * kstep;
            const char* a3 = a2 + kstep; const char* b3 = b2 + kstep;
            if (last && has_next) S.a_ready(nxt);
            if constexpr (Epi::MIDK) { if (t == nt / 2) E.midk(acc, cur, wr, fr); }
            if constexpr (SP2) {
            PG8_LDB(B0, 0, 0); PG8_LDB(B1, 0, 1); PG8_SCHED; PG8_LDA(At, 0, 0); PG8_STAGE(PG8_SA(1, 1), a1 + hstep, voffA);
            PG8_WAIT_V(8); PG8_WAIT_L(0); PG8_BAR; PG8_MMA(0, 0, At, B0); PG8_MMA(0, 1, At, B1); PG8_BAR; PG8_SCHED;
            PG8_LDA(At, 0, 1); PG8_STAGE(PG8_SB(0, 0), b2, voffB); PG8_STAGE(PG8_SB(0, 1), b2 + hstep, voffB); PG8_STAGE(PG8_SA(0, 0), a2, voffA);
            PG8_WAIT_V(8); PG8_WAIT_L(0); PG8_BAR; PG8_MMA(1, 0, At, B0); PG8_MMA(1, 1, At, B1); PG8_BAR; PG8_SCHED;
            PG8_LDB(B0, 1, 0); PG8_LDB(B1, 1, 1); PG8_SCHED; PG8_LDA(At, 1, 0); PG8_STAGE(PG8_SA(0, 1), a2 + hstep, voffA);
            PG8_WAIT_V(8); PG8_WAIT_L(0); PG8_BAR; PG8_MMA(0, 0, At, B0); PG8_MMA(0, 1, At, B1); PG8_BAR; PG8_SCHED;
            PG8_LDA(At, 1, 1); PG8_STAGE(PG8_SB(1, 0), b3, voffB); PG8_STAGE(PG8_SB(1, 1), b3 + hstep, voffB); PG8_STAGE(PG8_SA(1, 0), a3, voffA);
            PG8_WAIT_V(8); PG8_WAIT_L(0); PG8_BAR; PG8_MMA(1, 0, At, B0); PG8_MMA(1, 1, At, B1); PG8_BAR; PG8_SCHED;
            } else {
            PG8_LDB(B0, 0, 0); PG8_SCHED; PG8_LDA(At, 0, 0); PG8_STAGE(PG8_SA(1, 1), a1 + hstep, voffA);
            PG8_WAIT_L(8); PG8_BAR; PG8_WAIT_L(0); PG8_MMA(0, 0, At, B0); PG8_BAR; PG8_SCHED;
            PG8_LDB(B1, 0, 1); PG8_STAGE(PG8_SB(0, 0), b2, voffB);
            PG8_BAR; PG8_WAIT_L(0); PG8_MMA(0, 1, At, B1); PG8_BAR;
            PG8_LDA(At, 0, 1); PG8_STAGE(PG8_SA(0, 0), a2, voffA);
            PG8_BAR; PG8_WAIT_L(0); PG8_MMA(1, 0, At, B0); PG8_BAR; PG8_SCHED;
            PG8_STAGE(PG8_SB(0, 1), b2 + hstep, voffB);
            PG8_WAIT_V(6); PG8_BAR; PG8_MMA(1, 1, At, B1); PG8_BAR;
            PG8_LDB(B0, 1, 0); PG8_SCHED; PG8_LDA(At, 1, 0); PG8_STAGE(PG8_SA(0, 1), a2 + hstep, voffA);
            PG8_WAIT_L(8); PG8_BAR; PG8_WAIT_L(0); PG8_MMA(0, 0, At, B0); PG8_BAR; PG8_SCHED;
            PG8_LDB(B1, 1, 1); PG8_STAGE(PG8_SB(1, 0), b3, voffB);
            PG8_BAR; PG8_WAIT_L(0); PG8_MMA(0, 1, At, B1); PG8_BAR;
            PG8_LDA(At, 1, 1); PG8_STAGE(PG8_SA(1, 0), a3, voffA);
            PG8_BAR; PG8_WAIT_L(0); PG8_MMA(1, 0, At, B0); PG8_BAR; PG8_SCHED;
            PG8_STAGE(PG8_SB(1, 1), b3 + hstep, voffB);
            PG8_WAIT_V(6); PG8_BAR; PG8_MMA(1, 1, At, B1); PG8_BAR;
            }
        }
        if constexpr (ALIGN_EPI) { if (wr == 0) PG8_BAR; }
        E(acc, cur, wr, wc, fr, fq); S.done(cur);
        if (!has_next) break;
#pragma unroll
        for (int a = 0; a < 2; ++a)
#pragma unroll
            for (int b = 0; b < 2; ++b)
#pragma unroll
                for (int m = 0; m < 4; ++m)
#pragma unroll
                    for (int n = 0; n < 2; ++n) acc[a][b][m][n] = (f32x4){0.f, 0.f, 0.f, 0.f};
        cur = nxt; cA = nA; cB = nB; ++ui;
        if constexpr (ALIGN_EPI) { if (wr == 1) PG8_BAR; }
    }
    PG8_WAIT_V(0);
    if constexpr (!ALIGN_EPI) { if (wr == 0) PG8_BAR; }
    PG8_BAR;
#undef PG8_SA
#undef PG8_SB
#undef PG8_STAGE
#undef PG8_LDA
#undef PG8_LDB
#undef PG8_MMA
#undef PG8_WAIT_V
#undef PG8_WAIT_L
#undef PG8_BAR
#undef PG8_SCHED
}

struct EpiBf16 {
    static constexpr bool PERM = true, MIDK = false, APERM = false;
    u16* O; int ldc;
    __device__ __forceinline__ void operator()(const f32x4 (&acc)[2][2][4][2], const Unit& u, int wr, int wc, int fr, int fq) const {
        const int row0 = u.pm * BM + wr * 64 + fr; const int col0 = u.pn * BM + wc * 32 + 8 * fq;
#pragma unroll
        for (int ai = 0; ai < 2; ++ai)
#pragma unroll
            for (int m = 0; m < 4; ++m) { u16* rowp = O + (size_t)(row0 + ai * HALF + m * 16) * ldc + col0;
#pragma unroll
                for (int bj = 0; bj < 2; ++bj) { const f32x4 v0 = acc[ai][bj][m][0], v1 = acc[ai][bj][m][1];
                    u32x4 w; w.x = cvt_pk_bf16(v0[0], v0[1]); w.y = cvt_pk_bf16(v0[2], v0[3]); w.z = cvt_pk_bf16(v1[0], v1[1]); w.w = cvt_pk_bf16(v1[2], v1[3]);
                    *(u32x4*)(rowp + bj * HALF) = w; } }
    }
};
struct EpiResid {
    static constexpr bool PERM = false, MIDK = false, APERM = false;
    const float* base; float* out; const float* gate;
    __device__ __forceinline__ void operator()(const f32x4 (&acc)[2][2][4][2], const Unit& u, int wr, int wc, int fr, int fq) const {
        const int row0 = u.pm * BM + wr * 64 + fr, col0 = u.pn * BM + wc * 32 + 4 * fq;
        const int b = (u.pm * BM) / SEQ;
        f32x4 gv[2][2];
#pragma unroll
        for (int bj = 0; bj < 2; ++bj)
#pragma unroll
            for (int n = 0; n < 2; ++n) gv[bj][n] = *(const f32x4*)(gate + (size_t)b * N_MOD + col0 + bj * HALF + n * 16);
#pragma unroll
        for (int ai = 0; ai < 2; ++ai)
#pragma unroll
            for (int m = 0; m < 4; ++m) { const size_t off = (size_t)(row0 + ai * HALF + m * 16) * D_MODEL + col0;
#pragma unroll
                for (int bj = 0; bj < 2; ++bj)
#pragma unroll
                    for (int n = 0; n < 2; ++n) { const f32x4 bs = *(const f32x4*)(base + off + bj * HALF + n * 16);
                        *(f32x4*)(out + off + bj * HALF + n * 16) = bs + gv[bj][n] * acc[ai][bj][m][n]; } }
    }
};
struct EpiInProj {
    static constexpr bool PERM = true, MIDK = false, APERM = false;
    float* QF; u16* KB; u16* VT; u16* XR; u16* GG; float* KM; const float* gq; const float* gk;
    __device__ __forceinline__ void operator()(const f32x4 (&acc)[2][2][4][2], const Unit& u, int wr, int wc, int fr, int fq) const {
        const int type = u.pn >> 1, head = (u.pn & 1) * 4 + wc;
        const int b = (u.pm * BM) / SEQ, blk = u.pm % NBLK;
        const int tok0 = u.pm * BM + wr * 64 + fr;
        const int bh = b * NHEAD + head;
        if (type <= 1) {
            const float* gp = type == 0 ? gq : gk;
            f32x4 gv[2][2];
#pragma unroll
            for (int bj = 0; bj < 2; ++bj)
#pragma unroll
                for (int n = 0; n < 2; ++n) gv[bj][n] = *(const f32x4*)(gp + 32 * bj + 8 * fq + 4 * n);
            f32x4 cs[2][2];
#pragma unroll
            for (int bj = 0; bj < 2; ++bj)
#pragma unroll
                for (int n = 0; n < 2; ++n) cs[bj][n] = (f32x4){0.f, 0.f, 0.f, 0.f};
#pragma unroll
            for (int ai = 0; ai < 2; ++ai)
#pragma unroll
                for (int m = 0; m < 4; ++m) {
                    float ss = 0.f;
#pragma unroll
                    for (int bj = 0; bj < 2; ++bj)
#pragma unroll
                        for (int n = 0; n < 2; ++n) { const f32x4 x = acc[ai][bj][m][n]; ss += (x[0] * x[0] + x[1] * x[1]) + (x[2] * x[2] + x[3] * x[3]); }
                    ss += __shfl_xor(ss, 16); ss += __shfl_xor(ss, 32);
                    const float rstd = 1.0f / sqrtf(ss * (1.0f / 64.0f) + EPS);
                    const int tok = tok0 + ai * HALF + m * 16, s = tok % SEQ;
                    const size_t rowoff = ((size_t)bh * SEQ + s) * HD + 8 * fq;
#pragma unroll
                    for (int bj = 0; bj < 2; ++bj) {
                        const f32x4 v0 = acc[ai][bj][m][0] * rstd * gv[bj][0], v1 = acc[ai][bj][m][1] * rstd * gv[bj][1];
                        if (type == 0) { *(f32x4*)(QF + rowoff + 32 * bj) = v0; *(f32x4*)(QF + rowoff + 32 * bj + 4) = v1; }
                        else { u32x4 w; w.x = cvt_pk_bf16(v0[0], v0[1]); w.y = cvt_pk_bf16(v0[2], v0[3]); w.z = cvt_pk_bf16(v1[0], v1[1]); w.w = cvt_pk_bf16(v1[2], v1[3]);
                            const int kw = s & 255, c8 = 4 * bj + fq;
                            *(u32x4*)(KB + ((size_t)bh * NBLK + blk) * (BLK * HD) + ((((kw >> 5) * 4 + (c8 >> 1)) * 2 + (c8 & 1)) * 32 + (kw & 31)) * 8) = w; cs[bj][0] += v0; cs[bj][1] += v1; }
                    }
                }
            if (type == 1) {
#pragma unroll
                for (int bj = 0; bj < 2; ++bj)
#pragma unroll
                    for (int n = 0; n < 2; ++n)
#pragma unroll
                        for (int i = 0; i < 4; ++i) { float v = cs[bj][n][i]; v += __shfl_xor(v, 1); v += __shfl_xor(v, 2); v += __shfl_xor(v, 4); v += __shfl_xor(v, 8);
                            if (fr == 0) atomicAdd(KM + (((size_t)(b * NBLK + blk) * NHEAD + head) * HD + 32 * bj + 8 * fq + 4 * n + i), v); }
            }
        } else if (type == 2) {
            const int hip = (fr >> 2) & 1, ep = 4 * (fr >> 3) + (fr & 3);
#pragma unroll
            for (int ai = 0; ai < 2; ++ai)
#pragma unroll
                for (int m = 0; m < 4; ++m) { const int kw = ai * HALF + wr * 64 + m * 16 + fr;
#pragma unroll
                    for (int bj = 0; bj < 2; ++bj)
#pragma unroll
                        for (int n = 0; n < 2; ++n) { const f32x4 x = acc[ai][bj][m][n]; const unsigned w0 = cvt_pk_bf16(x[0], x[1]), w1 = cvt_pk_bf16(x[2], x[3]);
                            u16* dst = VT + ((size_t)bh * NBLK + blk) * (BLK * HD) + (((((kw >> 5) * 2 + ((kw >> 4) & 1)) * 2 + bj) * 2 + hip) * 32 + 8 * fq + 4 * n) * 8 + ep;
                            dst[0] = (u16)(w0 & 0xffffu); dst[8] = (u16)(w0 >> 16); dst[16] = (u16)(w1 & 0xffffu); dst[24] = (u16)(w1 >> 16); } }
        } else {
            u16* O = type == 3 ? XR : GG;
#pragma unroll
            for (int ai = 0; ai < 2; ++ai)
#pragma unroll
                for (int m = 0; m < 4; ++m) { const int tok = tok0 + ai * HALF + m * 16, sq = tok % SEQ;
                    u16* tilep = O + ((((size_t)b * (SEQ / 32) + (sq >> 5)) * NHEAD + head) * 2048) + (sq & 31) * 8;
#pragma unroll
                    for (int bj = 0; bj < 2; ++bj) { f32x4 v0 = acc[ai][bj][m][0], v1 = acc[ai][bj][m][1];
                        if (type == 4) {
#pragma unroll
                            for (int i = 0; i < 4; ++i) { v0[i] = gelu_tanh(v0[i]); v1[i] = gelu_tanh(v1[i]); } }
                        u32x4 w; w.x = cvt_pk_bf16(v0[0], v0[1]); w.y = cvt_pk_bf16(v0[2], v0[3]); w.z = cvt_pk_bf16(v1[0], v1[1]); w.w = cvt_pk_bf16(v1[2], v1[3]);
                        *(u32x4*)(tilep + (4 * bj + fq) * 256) = w; } }
        }
    }
};

__device__ __forceinline__ float dpp_f(float old, float x, int ctrl) {
    return 0.f; }
#define DPPF(old, x, ctrl) __builtin_bit_cast(float, __builtin_amdgcn_update_dpp(__builtin_bit_cast(int, (float)(old)), __builtin_bit_cast(int, (float)(x)), (ctrl), 0xf, 0xf, false))
struct EpiFFN {
    static constexpr bool PERM = true, MIDK = false, APERM = true;
    unsigned char* ACT; float* RAW; const float* cw; const float* CB2; LAS float* XB; const float* SSQX; const float* BIAS2; const LAS float* R2ALL; LAS float* CT;
    __device__ __forceinline__ void operator()(const f32x4 (&acc)[2][2][4][2], const Unit& u, int wr, int wc, int fr_, int fq_) const {
        int fr = fr_, fq = fq_; asm volatile("" : "+v"(fr), "+v"(fq));
        const int f0 = u.pn * 128 + wc * 32 + 8 * fq;
        const int b = (u.pm * BM) / SEQ;
        const LAS float* R2S = R2ALL + u.ord * 256;
        { const int t = (wr * 4 + wc) * 64 + fq * 16 + fr;
          if (t < 256) { const int q = t >> 5, c4 = t & 31; const int f = u.pn * 128 + 4 * c4;
              const float* src = ((q & 3) == 3) ? (CB2 + (size_t)b * N_UP + (q >> 2) * D_FF + f) : (cw + (size_t)(q & 3) * N_UP + (q >> 2) * D_FF + f);
              const f32x4 v = *(const f32x4*)src; *(LAS f32x4*)(CT + q * 128 + 4 * c4) = v; } }
#define BBP(kc, bj, n) (*(const f32x4*)(BIAS2 + ((size_t)(kc) * BATCH + b) * N_UP + (bj) * D_FF + f0 + 4 * (n)))
#define BBV(bj, n) ((BBP(0, bj, n) + BBP(1, bj, n)) + (BBP(2, bj, n) + BBP(3, bj, n)))
        const f32x4 r2a = *(const LAS f32x4*)(R2S + wr * 64 + 4 * fr), r2b = *(const LAS f32x4*)(R2S + HALF + wr * 64 + 4 * fr);
        if (fr == 15) {
#pragma unroll
            for (int ai = 0; ai < 2; ++ai)
#pragma unroll
                for (int rr = 0; rr < 2; ++rr)
#pragma unroll
                    for (int bj = 0; bj < 2; ++bj)
#pragma unroll
                        for (int n = 0; n < 2; ++n) *(LAS f32x4*)(XB + (((((ai * 2 + wr) * 4 + wc) * 2 + rr) * 4 + fq) * 16 + (bj * 2 + n) * 4)) = acc[ai][bj][2 + rr][n] * (ai ? r2b[2 + rr] : r2a[2 + rr]);
        }
        if (wr == 1 && fr == 15) {
#pragma unroll
            for (int rr = 0; rr < 2; ++rr)
#pragma unroll
                for (int bj = 0; bj < 2; ++bj)
#pragma unroll
                    for (int n = 0; n < 2; ++n) *(f32x4*)(RAW + ((size_t)u.pm * 4 + 2 + rr) * N_UP + bj * D_FF + f0 + 4 * n) = acc[1][bj][2 + rr][n] * r2b[2 + rr] + BBV(bj, n);
        }
        if (wr == 0 && fr == 0) {
#pragma unroll
            for (int rr = 0; rr < 2; ++rr)
#pragma unroll
                for (int bj = 0; bj < 2; ++bj)
#pragma unroll
                    for (int n = 0; n < 2; ++n) *(f32x4*)(RAW + ((size_t)u.pm * 4 + rr) * N_UP + bj * D_FF + f0 + 4 * n) = acc[0][bj][rr][n] * r2a[rr] + BBV(bj, n);
        }
        asm volatile("s_waitcnt vmcnt(0) lgkmcnt(0)" ::: "memory"); __builtin_amdgcn_s_barrier(); asm volatile("" ::: "memory");
#pragma unroll
        for (int n = 0; n < 2; ++n) {
            const int cl = wc * 32 + 8 * fq + 4 * n;
            const f32x4 wg0 = *(const LAS f32x4*)(CT + 0 * 128 + cl), wg1 = *(const LAS f32x4*)(CT + 1 * 128 + cl), wg2 = *(const LAS f32x4*)(CT + 2 * 128 + cl);
            const f32x4 wv0 = *(const LAS f32x4*)(CT + 4 * 128 + cl), wv1 = *(const LAS f32x4*)(CT + 5 * 128 + cl), wv2 = *(const LAS f32x4*)(CT + 6 * 128 + cl);
            const f32x4 bg = *(const LAS f32x4*)(CT + 3 * 128 + cl), bv = *(const LAS f32x4*)(CT + 7 * 128 + cl);
#pragma unroll
            for (int ai = 0; ai < 2; ++ai) {
                const f32x4 r2v = ai ? r2b : r2a;
                const bool hasprev = (wr == 1) || (ai == 1);
                const int src = (wr == 1) ? (ai * 2 + 0) : ((ai - 1) * 2 + 1);
                f32x4 t1g = (f32x4){0.f, 0.f, 0.f, 0.f}, t2g = t1g, t1v = t1g, t2v = t1g;
                if (hasprev) {
                    const LAS float* xb1 = XB + ((((src * 4 + wc) * 2 + 1) * 4 + fq) * 16), * xb2 = XB + ((((src * 4 + wc) * 2 + 0) * 4 + fq) * 16);
                    t1g = *(const LAS f32x4*)(xb1 + (0 * 2 + n) * 4); t1v = *(const LAS f32x4*)(xb1 + (1 * 2 + n) * 4);
                    t2g = *(const LAS f32x4*)(xb2 + (0 * 2 + n) * 4); t2v = *(const LAS f32x4*)(xb2 + (1 * 2 + n) * 4);
                }
                f32x4 xg[4], xv[4];
#pragma unroll
                for (int m = 0; m < 4; ++m) { xg[m] = acc[ai][0][m][n] * r2v[m]; xv[m] = acc[ai][1][m][n] * r2v[m]; }
                f32x4 pg3, pg2, pv3, pv2;
#pragma unroll
                for (int i = 0; i < 4; ++i) { pg3[i] = DPPF(t1g[i], xg[3][i], 0x111); pg2[i] = DPPF(t2g[i], xg[2][i], 0x111); pv3[i] = DPPF(t1v[i], xv[3][i], 0x111); pv2[i] = DPPF(t2v[i], xv[2][i], 0x111); }
#pragma unroll
                for (int m = 0; m < 4; ++m) {
                    const f32x4 g1 = m == 0 ? pg3 : xg[m > 0 ? m - 1 : 0], g2 = m == 0 ? pg2 : (m == 1 ? pg3 : xg[m > 1 ? m - 2 : 0]);
                    const f32x4 v1 = m == 0 ? pv3 : xv[m > 0 ? m - 1 : 0], v2 = m == 0 ? pv2 : (m == 1 ? pv3 : xv[m > 1 ? m - 2 : 0]);
                    const f32x4 cg = ((wg0 * g2 + wg1 * g1) + wg2 * xg[m]) + bg, cv = ((wv0 * v2 + wv1 * v1) + wv2 * xv[m]) + bv;
                    const f32x4 ex = cg * (-LOG2E);
                    f32x4 sg; sg[0] = __builtin_amdgcn_rcpf(1.0f + __builtin_amdgcn_exp2f(ex[0])); sg[1] = __builtin_amdgcn_rcpf(1.0f + __builtin_amdgcn_exp2f(ex[1]));
                    sg[2] = __builtin_amdgcn_rcpf(1.0f + __builtin_amdgcn_exp2f(ex[2])); sg[3] = __builtin_amdgcn_rcpf(1.0f + __builtin_amdgcn_exp2f(ex[3]));
                    const f32x4 o = (cg * sg) * cv;
                    const unsigned pk = cvt_pk_fp8x4(o[0] * ACT_SCALE, o[1] * ACT_SCALE, o[2] * ACT_SCALE, o[3] * ACT_SCALE);
                    if (!(ai == 0 && wr == 0 && fr == 0 && m < 2)) *(unsigned*)(ACT + (size_t)(u.pm * BM + ai * HALF + wr * 64 + 4 * fr + m) * D_FF + f0 + 4 * n) = pk;
                }
                __builtin_amdgcn_sched_barrier(0);
            }
        }
    }
};

struct EpiOut {
    static constexpr bool PERM = true, MIDK = true, APERM = false;
    const float* base; u16* X1B; float* SSQX; const float* gate; const LAS f32x2* RT;
    __device__ __forceinline__ void rstd(const Unit& u, int rit, float& ratio, float& ra) const { const f32x2 v = RT[u.ord * 256 + rit]; ratio = v.x; ra = v.y; }
    __device__ __forceinline__ void midk(f32x4 (&acc)[2][2][4][2], const Unit& u, int wr, int fr) const {
#pragma unroll
        for (int ai = 0; ai < 2; ++ai)
#pragma unroll
            for (int m = 0; m < 4; ++m) { float ratio, ra; rstd(u, ai * HALF + wr * 64 + m * 16 + fr, ratio, ra);
#pragma unroll
                for (int bj = 0; bj < 2; ++bj)
#pragma unroll
                    for (int n = 0; n < 2; ++n) acc[ai][bj][m][n] *= ratio; }
    }
    __device__ __forceinline__ void operator()(const f32x4 (&acc)[2][2][4][2], const Unit& u, int wr, int wc, int fr, int fq) const {
        const int row0 = u.pm * BM + wr * 64 + fr, col0 = u.pn * BM + wc * 32 + 8 * fq;
        const int b = (u.pm * BM) / SEQ;
        f32x4 gv[2][2];
#pragma unroll
        for (int bj = 0; bj < 2; ++bj)
#pragma unroll
            for (int n = 0; n < 2; ++n) gv[bj][n] = *(const f32x4*)(gate + (size_t)b * N_MOD + col0 + bj * HALF + n * 4);
#pragma unroll
        for (int ai = 0; ai < 2; ++ai)
#pragma unroll
            for (int m = 0; m < 4; ++m) { const int row = row0 + ai * HALF + m * 16; const size_t off = (size_t)row * D_MODEL + col0;
                float rl, ra; rstd(u, wr * 64 + fr + ai * HALF + m * 16, rl, ra);
                float ss = 0.f;
#pragma unroll
                for (int bj = 0; bj < 2; ++bj) {
                    const f32x4 x0 = *(const f32x4*)(base + off + bj * HALF) + gv[bj][0] * (acc[ai][bj][m][0] * ra);
                    const f32x4 x1 = *(const f32x4*)(base + off + bj * HALF + 4) + gv[bj][1] * (acc[ai][bj][m][1] * ra);
                    ss += ((x0[0] * x0[0] + x0[1] * x0[1]) + (x0[2] * x0[2] + x0[3] * x0[3])) + ((x1[0] * x1[0] + x1[1] * x1[1]) + (x1[2] * x1[2] + x1[3] * x1[3]));
                    u32x4 w; w.x = cvt_pk_bf16(x0[0], x0[1]); w.y = cvt_pk_bf16(x0[2], x0[3]); w.z = cvt_pk_bf16(x1[0], x1[1]); w.w = cvt_pk_bf16(x1[2], x1[3]);
                    *(u32x4*)(X1B + off + bj * HALF) = w; }
                ss += __shfl_xor(ss, 16); ss += __shfl_xor(ss, 32);
                if (fq == 0) SSQX[(size_t)row * 16 + u.pn * 4 + wc] = ss; }
    }
};

struct EpiResidB {
    static constexpr bool PERM = false, MIDK = false, APERM = false;
    const u16* base; float* out; const float* gate; float dsc;
    __device__ __forceinline__ void operator()(const f32x4 (&acc)[2][2][4][2], const Unit& u, int wr, int wc, int fr_, int fq_) const {
        int fr = fr_, fq = fq_; asm volatile("" : "+v"(fr), "+v"(fq));
        const int row0 = u.pm * BM + wr * 64 + fr, col0 = u.pn * BM + wc * 32 + 4 * fq;
        const int b = (u.pm * BM) / SEQ;
        f32x4 gv[2][2];
#pragma unroll
        for (int bj = 0; bj < 2; ++bj)
#pragma unroll
            for (int n = 0; n < 2; ++n) gv[bj][n] = *(const f32x4*)(gate + (size_t)b * N_MOD + col0 + bj * HALF + n * 16) * dsc;
#pragma unroll
        for (int ai = 0; ai < 2; ++ai)
#pragma unroll
            for (int m = 0; m < 4; ++m) { const size_t off = (size_t)(row0 + ai * HALF + m * 16) * D_MODEL + col0;
#pragma unroll
                for (int bj = 0; bj < 2; ++bj)
#pragma unroll
                    for (int n = 0; n < 2; ++n) { const u32x2 xw = *(const u32x2*)(base + off + bj * HALF + n * 16);
                        const f32x4 bs = (f32x4){bf_lo(xw.x), bf_hi(xw.x), bf_lo(xw.y), bf_hi(xw.y)};
                        *(f32x4*)(out + off + bj * HALF + n * 16) = bs + gv[bj][n] * acc[ai][bj][m][n]; } }
    }
};
}
#ifndef ATT_DUP
#define ATT_DUP 0
#endif

constexpr size_t MiB = 1u << 20;
constexpr size_t WS_CTL = 0;
constexpr size_t WS_KM = 1 * MiB;
constexpr size_t CTL_ZERO_BYTES = 2 * MiB;
constexpr size_t WS_MOD = 2 * MiB;
constexpr size_t WS_WIN = 3 * MiB;
constexpr size_t WS_WO = 8 * MiB;
constexpr size_t WS_WUP = 10 * MiB;
constexpr size_t WS_WDN = 21 * MiB;
constexpr size_t WS_WA = 27 * MiB;
constexpr size_t WS_WX = 27 * MiB + 65536;
constexpr size_t WS_AGG = 28 * MiB;
constexpr size_t WS_SSQL = 29 * MiB;
constexpr size_t WS_SSQA = 30 * MiB;
constexpr size_t WS_H = 34 * MiB;
constexpr size_t WS_QF = 98 * MiB;
constexpr size_t WS_KB = 162 * MiB;
constexpr size_t WS_VT = 194 * MiB;
constexpr size_t WS_XR = 226 * MiB;
constexpr size_t WS_GG = 258 * MiB;
constexpr size_t WS_ATT = 288 * MiB;
constexpr size_t WS_LRU = 320 * MiB;
constexpr size_t WS_MIX = 352 * MiB;
constexpr size_t WS_RAW = 98 * MiB;
constexpr size_t WS_ACT = 272 * MiB;
constexpr size_t WS_WUP4 = 448 * MiB;
constexpr size_t WS_BIAS2 = 27 * MiB + 262144;
constexpr size_t WS_CB2 = 27 * MiB + 786432;
constexpr size_t WS_SSQX = 31 * MiB;
constexpr size_t WS_END = 492 * MiB;
constexpr int CW_BAR = 4096, CW_AGGCNT = 1024;

constexpr int RING_BYTES = 131072;
constexpr int MISC_OFF = 160 * 1024 - 256;
constexpr int XB_OFF = RING_BYTES;
constexpr int CLDS_OFF = RING_BYTES + 4096;
constexpr int LDS_BYTES = 160 * 1024;
constexpr int NT = 512, NWAVES = 8;

#define XB_TMO      128
#define XB_XCNT(j)  (256  + 64 * (j))
#define XB_XSUB(j)  (1280 + 64 * (j))
#define XB_XGEN(j)  (2304 + 64 * (j))
#define XB_TOP      3328
#define XB_TOPGEN   3392
#define XCD_BAR_WORDS 3456
#define XB_SPIN_CAP (1u << 18)
__device__ __forceinline__ unsigned xb_ld(unsigned* p)              { return __hip_atomic_load(p, __ATOMIC_RELAXED, __HIP_MEMORY_SCOPE_AGENT); }
__device__ __forceinline__ unsigned xb_add(unsigned* p, unsigned v) { return __hip_atomic_fetch_add(p, v, __ATOMIC_RELAXED, __HIP_MEMORY_SCOPE_AGENT); }
__device__ __forceinline__ unsigned xb_xcc_id() { return (unsigned)__builtin_amdgcn_s_getreg((3 << 11) | 20) & 0xFu; }
#define XB_SPIN(cond, bar) do { unsigned _sp = 0; while (cond) { __builtin_amdgcn_s_sleep(1); \
    if ((++_sp & 255u) == 0u) { if (xb_ld(&(bar)[XB_TMO])) break; if (_sp > XB_SPIN_CAP) { atomicAdd(&(bar)[XB_TMO], 1u); break; } } } } while (0)
struct XcdBarrier { unsigned* bar; unsigned x; volatile LAS unsigned* st; };
__device__ __forceinline__ XcdBarrier xcd_barrier_post(unsigned* bar, volatile LAS unsigned* st) {
    XcdBarrier b; b.bar = bar; b.x = xb_xcc_id(); b.st = st;
    if (threadIdx.x == 0) (void)xb_add(&bar[XB_XCNT(b.x)], 1u);
    return b;
}
__device__ __forceinline__ void xcd_barrier_complete(unsigned* bar, unsigned x, unsigned& nloc, unsigned& nx) {
    const unsigned G = gridDim.x * gridDim.y * gridDim.z;
    unsigned sum, cnt, mine, sp = 0u;
    for (;;) {
        sum = 0u; cnt = 0u; mine = 0u;
#pragma unroll
        for (unsigned j = 0; j < 16; ++j) { const unsigned c = xb_ld(&bar[XB_XCNT(j)]); sum += c; cnt += (c > 0u) ? 1u : 0u; mine = (j == x) ? c : mine; }
        if (sum == G) break;
        __builtin_amdgcn_s_sleep(1);
        if ((++sp & 255u) == 0u) { if (xb_ld(&bar[XB_TMO])) break; if (sp > XB_SPIN_CAP) { atomicAdd(&bar[XB_TMO], 1u); break; } }
    }
    nloc = mine > 0u ? mine : 1u; nx = cnt > 0u ? cnt : 1u;
}
__device__ __forceinline__ void xcd_barrier(const XcdBarrier& b, int tid) {
    asm volatile("s_waitcnt vmcnt(0)" ::: "memory");
    __syncthreads();
    if (tid == 0) {
        unsigned* bar = b.bar;
        __builtin_amdgcn_s_waitcnt(0);
        unsigned nloc = b.st[0], nx = b.st[1];
        if (nloc == 0u) { xcd_barrier_complete(bar, b.x, nloc, nx); b.st[0] = nloc; b.st[1] = nx; }
        const unsigned old = xb_add(&bar[XB_XSUB(b.x)], 1u);
        const unsigned gen = old / nloc;
        if (old + 1u == (gen + 1u) * nloc) {
            __builtin_amdgcn_fence(__ATOMIC_RELEASE, "agent");
            asm volatile("s_waitcnt vmcnt(0)" ::: "memory");
            const unsigned og = xb_add(&bar[XB_TOP], 1u);
            const unsigned tg = og / nx;
            if (og + 1u == (tg + 1u) * nx) xb_add(&bar[XB_TOPGEN], 1u);
            else XB_SPIN(xb_ld(&bar[XB_TOPGEN]) == tg, bar);
            __builtin_amdgcn_fence(__ATOMIC_ACQUIRE, "agent");
            xb_add(&bar[XB_XGEN(b.x)], 1u);
            asm volatile("s_waitcnt vmcnt(0)" ::: "memory");
        } else {
            XB_SPIN(xb_ld(&bar[XB_XGEN(b.x)]) == gen, bar);
            __builtin_amdgcn_fence(__ATOMIC_ACQUIRE, "agent");
            asm volatile("s_waitcnt vmcnt(0)" ::: "memory");
        }
    }
    __syncthreads();
}

struct Args { const float* in[23]; float* out; unsigned char* ws; int ph_lo, ph_hi; };
struct Frame {
    LAS unsigned char* lds;
    int tid, lane, wave, vcu, G, wave0;
    const Args* pa;
    __device__ __forceinline__ const float* x() const { return pa->in[0]; }
    __device__ __forceinline__ const float* c() const { return pa->in[1]; }
    __device__ __forceinline__ const float* w_ada() const { return pa->in[2]; }
    __device__ __forceinline__ const float* b_ada() const { return pa->in[3]; }
    __device__ __forceinline__ const float* norm1_g() const { return pa->in[4]; }
    __device__ __forceinline__ const float* w_in() const { return pa->in[5]; }
    __device__ __forceinline__ const float* q_norm_g() const { return pa->in[6]; }
    __device__ __forceinline__ const float* k_norm_g() const { return pa->in[7]; }
    __device__ __forceinline__ const float* lru_conv_w() const { return pa->in[8]; }
    __device__ __forceinline__ const float* lru_conv_b() const { return pa->in[9]; }
    __device__ __forceinline__ const float* lru_wa() const { return pa->in[10]; }
    __device__ __forceinline__ const float* lru_ba() const { return pa->in[11]; }
    __device__ __forceinline__ const float* lru_wx() const { return pa->in[12]; }
    __device__ __forceinline__ const float* lru_bx() const { return pa->in[13]; }
    __device__ __forceinline__ const float* lru_lambda() const { return pa->in[14]; }
    __device__ __forceinline__ const float* lru_out_g() const { return pa->in[15]; }
    __device__ __forceinline__ const float* attn_out_g() const { return pa->in[16]; }
    __device__ __forceinline__ const float* w_out() const { return pa->in[17]; }
    __device__ __forceinline__ const float* norm2_g() const { return pa->in[18]; }
    __device__ __forceinline__ const float* w_up() const { return pa->in[19]; }
    __device__ __forceinline__ const float* ffn_conv_w() const { return pa->in[20]; }
    __device__ __forceinline__ const float* ffn_conv_b() const { return pa->in[21]; }
    __device__ __forceinline__ const float* w_down() const { return pa->in[22]; }
    float* out; unsigned char* ws;
};
#define LDS_WAIT() asm volatile("s_waitcnt lgkmcnt(0)" ::: "memory")

template <int MODE>
__device__ __forceinline__ void p0_transpose_item(const float* W, int K, int N, u16* WT, LAS float* scr, int item, int lane, const float* kscale = nullptr) {
    const int nblk = N / 32, kb = item / nblk, nb = item % nblk, k0 = 64 * kb, n0 = 32 * nb;
#pragma unroll
    for (int i = 0; i < 8; ++i) { const int f = i * 64 + lane, kk = f >> 3, n4 = f & 7;
        f32x4 w = *(const GAS f32x4*)(W + (size_t)(k0 + kk) * N + n0 + 4 * n4); if (MODE == 3) w *= kscale[k0 + kk];
        LAS float* d = scr + kk * 33 + 4 * n4; d[0] = w.x; d[1] = w.y; d[2] = w.z; d[3] = w.w; }
    LDS_WAIT(); asm volatile("" ::: "memory");
    const int c = lane & 7;
#pragma unroll
    for (int j = 0; j < 4; ++j) { const int n = (lane >> 3) + 8 * j; const LAS float* s = scr + (8 * c) * 33 + n;
        u32x4 o;
        if (MODE == 1) { o.x = cvt_pk_f16(s[0 * 33], s[1 * 33]); o.y = cvt_pk_f16(s[2 * 33], s[3 * 33]); o.z = cvt_pk_f16(s[4 * 33], s[5 * 33]); o.w = cvt_pk_f16(s[6 * 33], s[7 * 33]); }
        else if (MODE == 5) { o.x = cvt_pk_fp8x4(s[0 * 33] * WDN_SCALE, s[1 * 33] * WDN_SCALE, s[2 * 33] * WDN_SCALE, s[3 * 33] * WDN_SCALE); o.y = cvt_pk_fp8x4(s[4 * 33] * WDN_SCALE, s[5 * 33] * WDN_SCALE, s[6 * 33] * WDN_SCALE, s[7 * 33] * WDN_SCALE); o.z = 0u; o.w = 0u; }
        else { o.x = cvt_pk_bf16(s[0 * 33], s[1 * 33]); o.y = cvt_pk_bf16(s[2 * 33], s[3 * 33]); o.z = cvt_pk_bf16(s[4 * 33], s[5 * 33]); o.w = cvt_pk_bf16(s[6 * 33], s[7 * 33]); }
        int nn = n0 + n;
        if (MODE == 1) nn = (nn & ~255) + 128 * ((nn >> 5) & 1) + 32 * ((nn >> 6) & 3) + (nn & 31);
        if (MODE == 2) { const int bj = nn >= D_FF ? 1 : 0, f = nn - bj * D_FF; nn = 256 * (f >> 7) + 128 * bj + (f & 127); }
        if (MODE == 4) *(GAS u32x4*)(WT + (((nn >> 5) * 4 + (c >> 1)) * 512 + ((c & 1) * 32 + (nn & 31)) * 8)) = o;
        else if (MODE == 5) *(GAS u32x2*)((GAS unsigned char*)WT + (size_t)nn * K + k0 + 8 * c) = (u32x2){o.x, o.y};
        else *(GAS u32x4*)(WT + (size_t)nn * K + k0 + 8 * c) = o; }
    LDS_WAIT(); asm volatile("" ::: "memory");
}
__device__ __forceinline__ void p0_prologue(Frame& F) {
    unsigned char* wsp = F.ws; asm volatile("" : "+s"(wsp));
    LAS float* cl = (LAS float*)(F.lds + CLDS_OFF);
    for (int i = F.tid; i < BATCH * D_MODEL; i += NT) cl[i] = F.c()[i];
    __syncthreads();
    LAS float* scr = (LAS float*)(F.lds + F.wave * 16384);
    constexpr int I_MOD = N_MOD / 64;
    constexpr int I_IN = (D_MODEL / 64) * (N_IN / 32), I_O = (D_MODEL / 64) * (D_MODEL / 32), I_DN = (D_FF / 64) * (D_MODEL / 32), I_L = 8 * 2;
    constexpr int NITEMS = I_IN + I_O + I_DN + 2 * I_L;
    u16* WinT = (u16*)(wsp + WS_WIN); u16* WoT = (u16*)(wsp + WS_WO); u16* WdT = (u16*)(wsp + WS_WDN);
    u16* WaT = (u16*)(wsp + WS_WA); u16* WxT = (u16*)(wsp + WS_WX);
    float* MOD = (float*)(wsp + WS_MOD);
    if (F.vcu < I_MOD) {
        const int col = F.vcu * 64 + F.lane; float a0 = 0.f, a1 = 0.f, a2 = 0.f, a3 = 0.f;
        const float* wp = F.w_ada() + (size_t)(F.wave * 128) * N_MOD + col; const LAS float* cw = cl + F.wave * 128;
#pragma unroll 64
        for (int k = 0; k < 128; ++k) { const float w = wp[(size_t)k * N_MOD];
            a0 += cw[k] * w; a1 += cw[D_MODEL + k] * w; a2 += cw[2 * D_MODEL + k] * w; a3 += cw[3 * D_MODEL + k] * w; }
        LAS float* part = (LAS float*)(F.lds + CLDS_OFF + 16384);
        part[(F.wave * 4 + 0) * 64 + F.lane] = a0; part[(F.wave * 4 + 1) * 64 + F.lane] = a1; part[(F.wave * 4 + 2) * 64 + F.lane] = a2; part[(F.wave * 4 + 3) * 64 + F.lane] = a3;
        __syncthreads();
        if (F.tid < 256) { const int bb = F.tid >> 6, l = F.tid & 63; float s = F.b_ada()[F.vcu * 64 + l];
#pragma unroll
            for (int w = 0; w < 8; ++w) s += part[(w * 4 + bb) * 64 + l];
            MOD[(size_t)bb * N_MOD + F.vcu * 64 + l] = s; }
    }
    const int gw = F.wave * F.G + ((F.vcu + F.G - I_MOD) % F.G), NGW = F.G * NWAVES;
    for (int it = gw; it < NITEMS; it += NGW) {
        int r = it;
        if (r < I_IN) { p0_transpose_item<1>(F.w_in(), D_MODEL, N_IN, WinT, scr, r, F.lane); continue; } r -= I_IN;
        if (r < I_O) { const int kb = r / (D_MODEL / 32); p0_transpose_item<3>(F.w_out(), D_MODEL, D_MODEL, WoT, scr, r, F.lane, (kb < 8 ? F.lru_out_g() : F.attn_out_g() - AW)); continue; } r -= I_O;

        if (r < I_DN) { p0_transpose_item<5>(F.w_down(), D_FF, D_MODEL, WdT, scr, r, F.lane); continue; } r -= I_DN;
        if (r < I_L) { const int h = r >> 1; p0_transpose_item<4>(F.lru_wa() + h * 4096, 64, 64, WaT + h * 4096, scr, r & 1, F.lane); continue; } r -= I_L;
        { const int h = r >> 1; p0_transpose_item<4>(F.lru_wx() + h * 4096, 64, 64, WxT + h * 4096, scr, r & 1, F.lane); }
    }
}


constexpr int SCL_OFF = RING_BYTES;
__device__ __forceinline__ void p1_upweights(Frame& F, unsigned char* wsp) {
    const float* MODp = (const float*)(wsp + WS_MOD);
    LAS float* SC = (LAS float*)(F.lds + SCL_OFF);
#define SHB(b) ((LAS float*)(F.lds + 16384 * (b) + 8448))
    if (F.tid == 0) *(LAS int*)(F.lds + MISC_OFF - 64) = 0;
    for (int i = F.tid; i < BATCH * D_MODEL; i += NT) { const int b = i >> 10, k = i & 1023; SC[i] = F.norm2_g()[k] * (1.0f + MODp[(size_t)b * N_MOD + 4096 + k]); SHB(b)[k] = MODp[(size_t)b * N_MOD + 3072 + k]; }
    __syncthreads();
    LAS float* scr = (LAS float*)(F.lds + F.wave * 16384);
    u16* W4 = (u16*)(wsp + WS_WUP4); float* BIAS2 = (float*)(wsp + WS_BIAS2);
    const float* W = F.w_up();
    const int gw = F.wave * F.G + F.vcu, NGW = F.G * NWAVES, lane = F.lane;
    for (int it = gw; it < 4 * (N_UP / 32); it += NGW) {
        const int n0 = 32 * (it >> 2), kc = it & 3;
        float bs0 = 0.f, bs1 = 0.f, bs2 = 0.f, bs3 = 0.f;
#pragma unroll 1
        for (int kb = 4 * kc; kb < 4 * kc + 4; ++kb) {
            const int k0 = 64 * kb;
#pragma unroll
            for (int i = 0; i < 8; ++i) { const int f = i * 64 + lane, kk = f >> 3, n4 = f & 7;
                const f32x4 w = *(const GAS f32x4*)(W + (size_t)(k0 + kk) * N_UP + n0 + 4 * n4);
                LAS float* d = scr + kk * 33 + 4 * n4; d[0] = w.x; d[1] = w.y; d[2] = w.z; d[3] = w.w; }
            LDS_WAIT(); asm volatile("" ::: "memory");
            { const int n = lane & 31, kh = lane >> 5;
#pragma unroll 8
              for (int kk = 0; kk < 32; ++kk) { const float w = scr[(32 * kh + kk) * 33 + n]; const int k = k0 + 32 * kh + kk;
                  bs0 += SHB(0)[k] * w; bs1 += SHB(1)[k] * w; bs2 += SHB(2)[k] * w; bs3 += SHB(3)[k] * w; } }
            const int c = lane & 7;
#pragma unroll
            for (int j = 0; j < 4; ++j) { const int n = (lane >> 3) + 8 * j; const LAS float* s = scr + (8 * c) * 33 + n;
                int nn = n0 + n; { const int bj = nn >= D_FF ? 1 : 0, f = nn - bj * D_FF; nn = 256 * (f >> 7) + 128 * bj + (f & 127); }
                float wv[8];
#pragma unroll
                for (int e = 0; e < 8; ++e) wv[e] = s[e * 33];
#pragma unroll
                for (int b = 0; b < BATCH; ++b) { const LAS float* sc = SC + b * 1024 + k0 + 8 * c;
                    u32x4 o; o.x = cvt_pk_bf16(wv[0] * sc[0], wv[1] * sc[1]); o.y = cvt_pk_bf16(wv[2] * sc[2], wv[3] * sc[3]); o.z = cvt_pk_bf16(wv[4] * sc[4], wv[5] * sc[5]); o.w = cvt_pk_bf16(wv[6] * sc[6], wv[7] * sc[7]);
                    *(GAS u32x4*)(W4 + ((size_t)b * N_UP + nn) * D_MODEL + k0 + 8 * c) = o; } }
            LDS_WAIT(); asm volatile("" ::: "memory");
        }
        bs0 += __shfl_xor(bs0, 32); bs1 += __shfl_xor(bs1, 32); bs2 += __shfl_xor(bs2, 32); bs3 += __shfl_xor(bs3, 32);
        if (lane < 32) { float* bp = BIAS2 + (size_t)kc * BATCH * N_UP + n0 + lane; bp[0] = bs0; bp[N_UP] = bs1; bp[2 * N_UP] = bs2; bp[3 * N_UP] = bs3; }
    }
}


__device__ __forceinline__ void cb2_prep(Frame& F, unsigned char* wsp) {
    const float* BIAS2 = (const float*)(wsp + WS_BIAS2); float* CB2 = (float*)(wsp + WS_CB2);
    const float* cw = F.ffn_conv_w(); const float* cb = F.ffn_conv_b();
    for (int i = F.vcu * NT + F.tid; i < BATCH * N_UP; i += F.G * NT) { const int b = i / N_UP, col = i % N_UP;
        const float bias = (BIAS2[(size_t)(0 * BATCH + b) * N_UP + col] + BIAS2[(size_t)(1 * BATCH + b) * N_UP + col]) + (BIAS2[(size_t)(2 * BATCH + b) * N_UP + col] + BIAS2[(size_t)(3 * BATCH + b) * N_UP + col]);
        CB2[i] = cb[col] + ((cw[col] + cw[N_UP + col]) + cw[2 * N_UP + col]) * bias; }
}

template <bool F16>
__device__ __forceinline__ void rownorm_phase(Frame& F, const float* X, const float* g, const float* sh, const float* sc, u16* O) {
    LAS int* ctr = (LAS int*)(F.lds + MISC_OFF - 64);
    for (;;) {
        int k = 0; if (F.lane == 0) k = __hip_atomic_fetch_add(ctr, 1, __ATOMIC_RELAXED, __HIP_MEMORY_SCOPE_WORKGROUP);
        k = __builtin_amdgcn_readfirstlane(k);
        const int m0 = (F.vcu + k * F.G) * 4;
        if (m0 >= M_TOK) break;
        const int b = m0 / SEQ;
        f32x4 v[4][4]; float s[4];
#pragma unroll
        for (int r = 0; r < 4; ++r) { const GAS f32x4* xr = (const GAS f32x4*)(X + (size_t)(m0 + r) * D_MODEL) + F.lane; s[r] = 0.f;
#pragma unroll
            for (int j = 0; j < 4; ++j) v[r][j] = __builtin_nontemporal_load((const f32x4*)(xr + 64 * j)); }
#pragma unroll
        for (int r = 0; r < 4; ++r)
#pragma unroll
            for (int j = 0; j < 4; ++j) s[r] += (v[r][j].x * v[r][j].x + v[r][j].y * v[r][j].y) + (v[r][j].z * v[r][j].z + v[r][j].w * v[r][j].w);
#pragma unroll
        for (int o = 1; o < 64; o <<= 1) {
#pragma unroll
            for (int r = 0; r < 4; ++r) s[r] += __shfl_xor(s[r], o); }
        float rstd[4];
#pragma unroll
        for (int r = 0; r < 4; ++r) rstd[r] = 1.0f / sqrtf(s[r] * (1.0f / D_MODEL) + EPS);
#pragma unroll
        for (int j = 0; j < 4; ++j) {
            const int col = 4 * F.lane + 256 * j;
            const f32x4 gv = *(const f32x4*)(g + col), shv = *(const f32x4*)(sh + (size_t)b * N_MOD + col), scv = *(const f32x4*)(sc + (size_t)b * N_MOD + col);
            const f32x4 gs = gv * (scv + 1.0f);
#pragma unroll
            for (int r = 0; r < 4; ++r) {
                const f32x4 y = (v[r][j] * rstd[r]) * gs + shv;
                u32x2 w;
                if (F16) { w.x = cvt_pk_f16(y.x, y.y); w.y = cvt_pk_f16(y.z, y.w); } else { w.x = cvt_pk_bf16(y.x, y.y); w.y = cvt_pk_bf16(y.z, y.w); }
                *((GAS u32x2*)(O + (size_t)(m0 + r) * D_MODEL) + F.lane + 64 * j) = w; }
        }
    }
}

__device__ __forceinline__ int crow(int r, int hi) { return (r & 3) + 8 * (r >> 2) + 4 * hi; }
__device__ __forceinline__ int qs_off(int q, int c) { return q * 64 + ((c ^ ((q >> 1) & 7)) << 3); }
constexpr int AL_QS = 0, AL_SLOT = 32768, AL_LSL = 131072, AL_LIST = 134144, AL_CNT = 150528, AL_MISC = 150656, AL_KMS = 150912;
__device__ __forceinline__ void attn_tile(const u16* Kp, const u16* Vp, const s16x8 (&qf)[4], int nkt, bool own, int tt, int qidx, int hi, float c1, float c2, f32x16& o0, f32x16& o1, float& lsum) {
#pragma unroll
    for (int r = 0; r < 16; ++r) { o0[r] = 0.f; o1[r] = 0.f; }
    lsum = 0.f;
    s16x8 kc[4], kn[4], vc[4];
#pragma unroll
    for (int s = 0; s < 4; ++s) { kc[s] = *(const GAS s16x8*)(Kp + s * 512); kn[s] = kc[s]; }
#pragma unroll 1
    for (int kt = 0; kt < nkt; ++kt) {
#pragma unroll
        for (int s = 0; s < 4; ++s) vc[s] = *(const GAS s16x8*)(Vp + (kt * 4 + s) * 512);
        if (kt + 1 < nkt) {
#pragma unroll
            for (int s = 0; s < 4; ++s) kn[s] = *(const GAS s16x8*)(Kp + ((kt + 1) * 4 + s) * 512);
        }
        f32x16 p;
#pragma unroll
        for (int r = 0; r < 16; ++r) p[r] = 0.f;
#pragma unroll
        for (int s = 0; s < 4; ++s) p = __builtin_amdgcn_mfma_f32_32x32x16_bf16(__builtin_bit_cast(bf16x8_t, kc[s]), __builtin_bit_cast(bf16x8_t, qf[s]), p, 0, 0, 0);
        const bool diag = own && (kt == tt);
#pragma unroll
        for (int r = 0; r < 16; ++r) { float e = __builtin_amdgcn_exp2f(p[r] * c1 - c2);
            if (diag && (32 * kt + crow(r, hi) > qidx)) e = 0.f;
            p[r] = e; lsum += e; }
#pragma unroll
        for (int s2 = 0; s2 < 2; ++s2) {
            u32x4 pw; pw.x = cvt_pk_bf16(p[8 * s2 + 0], p[8 * s2 + 1]); pw.y = cvt_pk_bf16(p[8 * s2 + 2], p[8 * s2 + 3]); pw.z = cvt_pk_bf16(p[8 * s2 + 4], p[8 * s2 + 5]); pw.w = cvt_pk_bf16(p[8 * s2 + 6], p[8 * s2 + 7]);
            const bf16x8_t pa = __builtin_bit_cast(bf16x8_t, pw);
            o0 = __builtin_amdgcn_mfma_f32_32x32x16_bf16(pa, __builtin_bit_cast(bf16x8_t, vc[2 * s2]), o0, 0, 0, 0);
            o1 = __builtin_amdgcn_mfma_f32_32x32x16_bf16(pa, __builtin_bit_cast(bf16x8_t, vc[2 * s2 + 1]), o1, 0, 0, 0);
        }
#pragma unroll
        for (int s = 0; s < 4; ++s) kc[s] = kn[s];
    }
}
__device__ __forceinline__ void attn_tile_full(const u16* Kp, const u16* Vp, const LAS u16* QS, int qidx, int hi, float c1, float c2, f32x16& o0, f32x16& o1, float& lsum) {
#pragma unroll
    for (int r = 0; r < 16; ++r) { o0[r] = 0.f; o1[r] = 0.f; }
    lsum = 0.f;
    s16x8 qf[4];
#pragma unroll
    for (int s = 0; s < 4; ++s) qf[s] = *(const LAS s16x8*)(QS + qs_off(qidx, 2 * s + hi));
    s16x8 kr[3][4], vr[3][4];
    const u16* kp = Kp; const u16* vp = Vp;
#pragma unroll
    for (int d = 0; d < 2; ++d) {
#pragma unroll
        for (int s = 0; s < 4; ++s) { kr[d][s] = *(const GAS s16x8*)(kp + s * 512); vr[d][s] = *(const GAS s16x8*)(vp + s * 512); }
        kp += 2048; vp += 2048; asm volatile("" : "+v"(kp), "+v"(vp));
    }
    f32x16 p, pn;
#pragma unroll
    for (int r = 0; r < 16; ++r) p[r] = 0.f;
#pragma unroll
    for (int s = 0; s < 4; ++s) p = __builtin_amdgcn_mfma_f32_32x32x16_bf16(__builtin_bit_cast(bf16x8_t, kr[0][s]), __builtin_bit_cast(bf16x8_t, qf[s]), p, 0, 0, 0);
#pragma unroll
    for (int kt = 0; kt < 8; ++kt) {
        if (kt + 2 < 8) {
#pragma unroll
            for (int s = 0; s < 4; ++s) { kr[(kt + 2) % 3][s] = *(const GAS s16x8*)(kp + s * 512); vr[(kt + 2) % 3][s] = *(const GAS s16x8*)(vp + s * 512); }
            kp += 2048; vp += 2048; asm volatile("" : "+v"(kp), "+v"(vp));
        }
        __builtin_amdgcn_sched_barrier(0);
        if (kt + 1 < 8) {
#pragma unroll
            for (int r = 0; r < 16; ++r) pn[r] = 0.f;
#pragma unroll
            for (int s = 0; s < 4; ++s) pn = __builtin_amdgcn_mfma_f32_32x32x16_bf16(__builtin_bit_cast(bf16x8_t, kr[(kt + 1) % 3][s]), __builtin_bit_cast(bf16x8_t, qf[s]), pn, 0, 0, 0);
        }
#pragma unroll
        for (int r = 0; r < 16; ++r) { const float e = __builtin_amdgcn_exp2f(p[r] * c1 - c2); p[r] = e; lsum += e; }
#pragma unroll
        for (int s2 = 0; s2 < 2; ++s2) {
            u32x4 pw; pw.x = cvt_pk_bf16(p[8 * s2 + 0], p[8 * s2 + 1]); pw.y = cvt_pk_bf16(p[8 * s2 + 2], p[8 * s2 + 3]); pw.z = cvt_pk_bf16(p[8 * s2 + 4], p[8 * s2 + 5]); pw.w = cvt_pk_bf16(p[8 * s2 + 6], p[8 * s2 + 7]);
            const bf16x8_t pa = __builtin_bit_cast(bf16x8_t, pw);
            o0 = __builtin_amdgcn_mfma_f32_32x32x16_bf16(pa, __builtin_bit_cast(bf16x8_t, vr[kt % 3][2 * s2]), o0, 0, 0, 0);
            o1 = __builtin_amdgcn_mfma_f32_32x32x16_bf16(pa, __builtin_bit_cast(bf16x8_t, vr[kt % 3][2 * s2 + 1]), o1, 0, 0, 0);
        }
        if (kt + 1 < 8) p = pn;
        __builtin_amdgcn_sched_barrier(0);
    }
}
__device__ __forceinline__ void attn_item(Frame& F, int bh, int i, float c1, float c2) {
    unsigned char* wsp = F.ws; asm volatile("" : "+s"(wsp));
    const float* QF = (const float*)(wsp + WS_QF); const u16* KB = (const u16*)(wsp + WS_KB); const u16* VT = (const u16*)(wsp + WS_VT);
    const float* KM = (const float*)(wsp + WS_KM); u16* ATT = (u16*)(wsp + WS_MIX); float* SSQA = (float*)(wsp + WS_SSQA);
    LAS u16* QS = (LAS u16*)(F.lds + AL_QS); LAS u16* SLOT = (LAS u16*)(F.lds + AL_SLOT); LAS float* LSL = (LAS float*)(F.lds + AL_LSL);
    LAS float* KMS = (LAS float*)(F.lds + AL_KMS); LAS u16* LIST = (LAS u16*)(F.lds + AL_LIST); LAS int* CNT = (LAS int*)(F.lds + AL_CNT);
    int tid_ = F.tid; asm volatile("" : "+v"(tid_));
    const int tid = tid_, lane = tid & 63, wave = F.wave, hi = lane >> 5, l31 = lane & 31;
    const int b = bh / NHEAD, h = bh % NHEAD;
    for (int u = tid; u < (3 * 32768 + 3072) / 16; u += NT) *(LAS u32x4*)(F.lds + AL_SLOT + u * 16) = (u32x4){0u, 0u, 0u, 0u};
    if (tid < 32) CNT[tid] = 0;
    for (int u = tid; u < NBLK * HD; u += NT) { const int n = u >> 6, d = u & 63; KMS[u] = KM[(((size_t)(b * NBLK + n)) * NHEAD + h) * HD + d] * (1.0f / 256.0f); }
    __syncthreads();
    {
        const int q = 32 * wave + l31;
        const GAS f32x4* qrow = (const GAS f32x4*)(QF + ((size_t)bh * SEQ + (size_t)i * BLK + q) * HD);
        f32x16 p;
#pragma unroll
        for (int r = 0; r < 16; ++r) p[r] = 0.f;
#pragma unroll
        for (int s = 0; s < 4; ++s) {
            const f32x4 qa = qrow[4 * s + 2 * hi], qc = qrow[4 * s + 2 * hi + 1];
            u32x4 qh; qh.x = cvt_pk_bf16(qa.x, qa.y); qh.y = cvt_pk_bf16(qa.z, qa.w); qh.z = cvt_pk_bf16(qc.x, qc.y); qh.w = cvt_pk_bf16(qc.z, qc.w);
            u32x4 ql; ql.x = cvt_pk_bf16(qa.x - bf_lo(qh.x), qa.y - bf_hi(qh.x)); ql.y = cvt_pk_bf16(qa.z - bf_lo(qh.y), qa.w - bf_hi(qh.y));
            ql.z = cvt_pk_bf16(qc.x - bf_lo(qh.z), qc.y - bf_hi(qh.z)); ql.w = cvt_pk_bf16(qc.z - bf_lo(qh.w), qc.w - bf_hi(qh.w));
            *(LAS u32x4*)(QS + qs_off(q, 2 * s + hi)) = qh;
            const LAS f32x4* kr = (const LAS f32x4*)(KMS + l31 * 64 + 16 * s + 8 * hi);
            const f32x4 ka = kr[0], kc = kr[1];
            u32x4 kh; kh.x = cvt_pk_bf16(ka.x, ka.y); kh.y = cvt_pk_bf16(ka.z, ka.w); kh.z = cvt_pk_bf16(kc.x, kc.y); kh.w = cvt_pk_bf16(kc.z, kc.w);
            u32x4 kl; kl.x = cvt_pk_bf16(ka.x - bf_lo(kh.x), ka.y - bf_hi(kh.x)); kl.y = cvt_pk_bf16(ka.z - bf_lo(kh.y), ka.w - bf_hi(kh.y));
            kl.z = cvt_pk_bf16(kc.x - bf_lo(kh.z), kc.y - bf_hi(kh.z)); kl.w = cvt_pk_bf16(kc.z - bf_lo(kh.w), kc.w - bf_hi(kh.w));
            p = __builtin_amdgcn_mfma_f32_32x32x16_bf16(__builtin_bit_cast(bf16x8_t, kl), __builtin_bit_cast(bf16x8_t, qh), p, 0, 0, 0);
            p = __builtin_amdgcn_mfma_f32_32x32x16_bf16(__builtin_bit_cast(bf16x8_t, kh), __builtin_bit_cast(bf16x8_t, ql), p, 0, 0, 0);
            p = __builtin_amdgcn_mfma_f32_32x32x16_bf16(__builtin_bit_cast(bf16x8_t, kh), __builtin_bit_cast(bf16x8_t, qh), p, 0, 0, 0);
        }
        float v0 = -INFINITY, v1 = -INFINITY, v2 = -INFINITY; int i0 = -1, i1 = -1, i2 = -1;
#pragma unroll
        for (int r = 0; r < 16; ++r) {
            const int n = crow(r, hi); const float g = (n < i) ? p[r] : -INFINITY;
            if (g > v0) { v2 = v1; i2 = i1; v1 = v0; i1 = i0; v0 = g; i0 = n; }
            else if (g > v1) { v2 = v1; i2 = i1; v1 = g; i1 = n; }
            else if (g > v2) { v2 = g; i2 = n; }
        }
        const float pv0 = __shfl_xor(v0, 32), pv1 = __shfl_xor(v1, 32), pv2 = __shfl_xor(v2, 32);
        const int pi0 = __shfl_xor(i0, 32), pi1 = __shfl_xor(i1, 32), pi2 = __shfl_xor(i2, 32);
        if (hi == 0) {
            float av[3] = {v0, v1, v2}, bv[3] = {pv0, pv1, pv2}; int ai[3] = {i0, i1, i2}, bi[3] = {pi0, pi1, pi2};
            int sel[3]; int pa = 0, pb = 0;
#pragma unroll
            for (int k = 0; k < 3; ++k) {
                const float ca = pa == 0 ? av[0] : (pa == 1 ? av[1] : av[2]); const int cai = pa == 0 ? ai[0] : (pa == 1 ? ai[1] : ai[2]);
                const float cb = pb == 0 ? bv[0] : (pb == 1 ? bv[1] : bv[2]); const int cbi = pb == 0 ? bi[0] : (pb == 1 ? bi[1] : bi[2]);
                if (ca > cb || (ca == cb && (cbi < 0 || (cai >= 0 && cai < cbi)))) { sel[k] = cai; ++pa; } else { sel[k] = cbi; ++pb; }
            }
#pragma unroll
            for (int k = 0; k < 3; ++k) if (sel[k] >= 0) { const int pos = __hip_atomic_fetch_add(&CNT[sel[k]], 1, __ATOMIC_RELAXED, __HIP_MEMORY_SCOPE_WORKGROUP); LIST[sel[k] * 256 + pos] = (u16)(q | (k << 8)); }
        }
    }
    __syncthreads();
    {
        int base = 0;
        for (int j = 0; j < i; ++j) {
            const int cntj = __builtin_amdgcn_readfirstlane(CNT[j]);
            const int ntj = (cntj + 31) >> 5;
            for (int t = base + ((wave - base) & 7); t < base + ntj; t += 8) {
                const int tt = t - base;
                const int ridx = 32 * tt + l31; const bool valid = ridx < cntj;
                const int ent = valid ? (int)LIST[j * 256 + ridx] : 0;
                const int qidx = ent & 255;
                s16x8 qf[4];
#pragma unroll
                for (int s = 0; s < 4; ++s) qf[s] = *(const LAS s16x8*)(QS + qs_off(qidx, 2 * s + hi));
                const size_t boff = ((size_t)bh * NBLK + j) * (BLK * HD) + lane * 8;
                f32x16 o0, o1; float lsum;
                attn_tile_full(KB + boff, VT + boff, QS, qidx, hi, c1, c2, o0, o1, lsum);
                const int srow = valid ? ((ent >> 8) * 256 + qidx) : -1;
                lsum += __shfl_xor(lsum, 32);
                if (valid && hi == 0) LSL[srow] = lsum;
#pragma unroll
                for (int r = 0; r < 16; ++r) { const int sr = __shfl(srow, crow(r, hi));
                    if (sr >= 0) { const unsigned w = cvt_pk_bf16(o0[r], o1[r]); SLOT[sr * 64 + l31] = (u16)(w & 0xffffu); SLOT[sr * 64 + 32 + l31] = (u16)(w >> 16); }
                    if ((r & 3) == 3) asm volatile("" ::: "memory"); }
            }
            base += ntj;
        }
    }
    f32x16 oo0, oo1; float lown;
    {
        s16x8 qf[4];
#pragma unroll
        for (int s = 0; s < 4; ++s) qf[s] = *(const LAS s16x8*)(QS + qs_off(32 * wave + l31, 2 * s + hi));
        const size_t boff = ((size_t)bh * NBLK + i) * (BLK * HD) + lane * 8;
        attn_tile(KB + boff, VT + boff, qf, wave + 1, true, wave, 32 * wave + l31, hi, c1, c2, oo0, oo1, lown);
    }
    __syncthreads();
    {
        const int q = 32 * wave + l31;
        float lt = lown + __shfl_xor(lown, 32);
        lt += LSL[q] + LSL[256 + q] + LSL[512 + q];
        const float inv = 1.0f / lt;
#pragma unroll
        for (int r = 0; r < 16; ++r) { const int rl = crow(r, hi), qq = 32 * wave + rl; const float iv = __shfl(inv, rl);
            float a = oo0[r], c = oo1[r];
#pragma unroll
            for (int k = 0; k < 3; ++k) { a += __builtin_bit_cast(float, (unsigned)SLOT[(k * 256 + qq) * 64 + l31] << 16); c += __builtin_bit_cast(float, (unsigned)SLOT[(k * 256 + qq) * 64 + 32 + l31] << 16); }
            const unsigned w = cvt_pk_bf16(a * iv, c * iv);
            QS[qq * 64 + l31] = (u16)(w & 0xffffu); QS[qq * 64 + 32 + l31] = (u16)(w >> 16);
            if ((r & 3) == 3) asm volatile("" ::: "memory"); }
        LDS_WAIT(); asm volatile("" ::: "memory");
#pragma unroll
        for (int it = 0; it < 4; ++it) { const int c = lane + 64 * it, row = c >> 3, ch = c & 7;
            const u32x4 w = *(const LAS u32x4*)(QS + (32 * wave + row) * 64 + 8 * ch);
            const size_t tok = (size_t)b * SEQ + (size_t)i * BLK + 32 * wave + row;
            *(GAS u32x4*)(ATT + tok * D_MODEL + AW + h * HD + 8 * ch) = w;
            float ss = bf_lo(w.x) * bf_lo(w.x) + bf_hi(w.x) * bf_hi(w.x) + bf_lo(w.y) * bf_lo(w.y) + bf_hi(w.y) * bf_hi(w.y) + bf_lo(w.z) * bf_lo(w.z) + bf_hi(w.z) * bf_hi(w.z) + bf_lo(w.w) * bf_lo(w.w) + bf_hi(w.w) * bf_hi(w.w);
            ss += __shfl_xor(ss, 1); ss += __shfl_xor(ss, 2); ss += __shfl_xor(ss, 4);
            if (ch == 0) SSQA[tok * NHEAD + h] = ss; }
    }
    __syncthreads();
}
__device__ __forceinline__ void attn_phase(Frame& F) {
    LAS float* mm = (LAS float*)(F.lds + AL_MISC);
    if (F.tid < 64) { float a = fabsf(F.q_norm_g()[F.tid]), c = fabsf(F.k_norm_g()[F.tid]);
#pragma unroll
        for (int o = 1; o < 64; o <<= 1) { a = fmaxf(a, __shfl_xor(a, o)); c = fmaxf(c, __shfl_xor(c, o)); }
        if (F.tid == 0) { mm[0] = a; mm[1] = c; } }
    __syncthreads();
    const float C = 8.0f * mm[0] * mm[1];
    const float c1 = 0.125f * LOG2E, c2 = C * LOG2E;
    __syncthreads();
    if (F.G == 256) {
        const int xcd = F.vcu >> 5, k = F.vcu & 31;
#pragma unroll 1
        for (int r = 0; r < 4; ++r) attn_item(F, xcd * 4 + r, (r & 1) ? 31 - k : k, c1, c2);
    } else {
        for (int it = F.vcu; it < BATCH * NHEAD * NBLK; it += F.G) attn_item(F, it >> 5, it & 31, c1, c2);
    }
}

constexpr int LL_CW = 0;
template <bool FINAL>
__device__ __forceinline__ void lru_item(Frame& F, int b, int chunk) {
    unsigned char* wsp = F.ws; asm volatile("" : "+s"(wsp));
    const u16* XR = (const u16*)(wsp + WS_XR); const u16* GG = (const u16*)(wsp + WS_GG);
    const u16* WaT = (const u16*)(wsp + WS_WA); const u16* WxT = (const u16*)(wsp + WS_WX);
    float* AGG = (float*)(wsp + WS_AGG); u16* LRU = (u16*)(wsp + WS_MIX); float* SSQL = (float*)(wsp + WS_SSQL);
    const int lane0 = F.lane, hd = F.wave, hi0 = lane0 >> 5, j0 = lane0 & 31;
    LAS float* CW = (LAS float*)(F.lds + LL_CW + hd * 2048);
    LAS u16* OT = (LAS u16*)(F.lds + 16384 + hd * 4096);
    for (int u = lane0; u < 320; u += 64) CW[u] = (u < 256) ? F.lru_conv_w()[(u >> 6) * AW + hd * HD + (u & 63)] : F.lru_conv_b()[hd * HD + (u - 256)];
    CW[320 + lane0] = F.lru_ba()[hd * HD + lane0]; CW[384 + lane0] = F.lru_bx()[hd * HD + lane0]; CW[448 + lane0] = 8.0f * log1pf(expf(-F.lru_lambda()[hd * HD + lane0]));
    LDS_WAIT(); asm volatile("" ::: "memory");
    float carry[2], arun[2];
#pragma unroll
    for (int ct = 0; ct < 2; ++ct) { const int c = hd * HD + 32 * ct + j0; carry[ct] = 0.f; arun[ct] = 1.f;
        if (FINAL) { float hcar = 0.f; for (int cc = 0; cc < chunk; ++cc) { const f32x2 ah = *(const f32x2*)(AGG + (((size_t)(b * 64 + cc)) * AW + c) * 2); hcar = ah.x * hcar + ah.y; } carry[ct] = hcar; } }
    for (int tile = 0; tile < 4; ++tile) {
        const int t0 = chunk * 128 + tile * 32;
        const u16* WaTt = WaT; const u16* WxTt = WxT; int lane = lane0; asm volatile("" : "+s"(WaTt), "+s"(WxTt), "+v"(lane));
        const int hi = lane >> 5, j = lane & 31, jt = j;
        const int pos = t0 + j;
        s16x8 af[4];
#pragma unroll
        for (int s = 0; s < 4; ++s) {
            const int ch0 = 16 * s + 8 * hi;
            float xc[8];
            { const LAS f32x4* bp = (const LAS f32x4*)(CW + 256 + ch0); const f32x4 b0 = bp[0], b1 = bp[1];
              xc[0] = b0.x; xc[1] = b0.y; xc[2] = b0.z; xc[3] = b0.w; xc[4] = b1.x; xc[5] = b1.y; xc[6] = b1.z; xc[7] = b1.w; }
            float accv[8];
#pragma unroll
            for (int e = 0; e < 8; ++e) accv[e] = 0.f;
#pragma unroll
            for (int jj = 0; jj < 4; ++jj) {
                const int p = pos - 3 + jj;
                const int pc = p < 0 ? 0 : p;
                u32x4 xw = *(const GAS u32x4*)(XR + ((((size_t)b * (SEQ / 32) + (pc >> 5)) * NHEAD + hd) * 2048) + ((s * 2 + hi) * 32 + (pc & 31)) * 8);
                if (p < 0) xw = (u32x4){0u, 0u, 0u, 0u};
                const LAS f32x4* wp = (const LAS f32x4*)(CW + jj * 64 + ch0); const f32x4 w0 = wp[0], w1 = wp[1];
                accv[0] += w0.x * bf_lo(xw.x); accv[1] += w0.y * bf_hi(xw.x); accv[2] += w0.z * bf_lo(xw.y); accv[3] += w0.w * bf_hi(xw.y);
                accv[4] += w1.x * bf_lo(xw.z); accv[5] += w1.y * bf_hi(xw.z); accv[6] += w1.z * bf_lo(xw.w); accv[7] += w1.w * bf_hi(xw.w);
            }
#pragma unroll
            for (int e = 0; e < 8; ++e) xc[e] += accv[e];
            u32x4 aw; aw.x = cvt_pk_bf16(xc[0], xc[1]); aw.y = cvt_pk_bf16(xc[2], xc[3]); aw.z = cvt_pk_bf16(xc[4], xc[5]); aw.w = cvt_pk_bf16(xc[6], xc[7]);
            af[s] = __builtin_bit_cast(s16x8, aw);
        }
        float ssacc[16];
#pragma unroll
        for (int r = 0; r < 16; ++r) ssacc[r] = 0.f;
#pragma unroll
        for (int ct = 0; ct < 2; ++ct) {
            float av[16], uv[16];
            {
                f32x16 aA, aX;
#pragma unroll
                for (int r = 0; r < 16; ++r) { aA[r] = 0.f; aX[r] = 0.f; }
#pragma unroll
                for (int s = 0; s < 4; ++s) {
                    const size_t woff = (size_t)hd * 4096 + (ct * 4 + s) * 512 + lane * 8;
                    const s16x8 wa = *(const GAS s16x8*)(WaTt + woff), wx = *(const GAS s16x8*)(WxTt + woff);
                    const bf16x8_t a = __builtin_bit_cast(bf16x8_t, af[s]);
                    aA = __builtin_amdgcn_mfma_f32_32x32x16_bf16(a, __builtin_bit_cast(bf16x8_t, wa), aA, 0, 0, 0);
                    aX = __builtin_amdgcn_mfma_f32_32x32x16_bf16(a, __builtin_bit_cast(bf16x8_t, wx), aX, 0, 0, 0);
                }
                const float bac = CW[320 + 32 * ct + jt], bxc = CW[384 + 32 * ct + jt], sp8c = CW[448 + 32 * ct + jt];
#pragma unroll
                for (int r = 0; r < 16; ++r) {
                    const float rr = sigmoidf_(aA[r] + bac), ii = sigmoidf_(aX[r] + bxc);
                    const float la = -rr * sp8c;
                    const float a = __builtin_amdgcn_exp2f(la * LOG2E);
                    const float om = fmaf(-a, a, 1.0f);
                    av[r] = a; uv[r] = __builtin_amdgcn_sqrtf(om) * ii;
                }
            }
            f32x16 aG;
            {
                f32x16 aI;
#pragma unroll
                for (int r = 0; r < 16; ++r) { aI[r] = 0.f; aG[r] = 0.f; }
#pragma unroll
                for (int s = 0; s < 4; ++s) {
                    s16x8 id;
#pragma unroll
                    for (int e = 0; e < 8; ++e) id[e] = (16 * s + 8 * hi + e == 32 * ct + jt) ? (short)0x3F80 : (short)0;
                    aI = __builtin_amdgcn_mfma_f32_32x32x16_bf16(__builtin_bit_cast(bf16x8_t, af[s]), __builtin_bit_cast(bf16x8_t, id), aI, 0, 0, 0);
                    if (FINAL) { const s16x8 gfr = *(const GAS s16x8*)(GG + ((((size_t)b * (SEQ / 32) + (t0 >> 5)) * NHEAD + hd) * 2048) + s * 512 + lane * 8);
                        aG = __builtin_amdgcn_mfma_f32_32x32x16_bf16(__builtin_bit_cast(bf16x8_t, gfr), __builtin_bit_cast(bf16x8_t, id), aG, 0, 0, 0); }
                }
#pragma unroll
                for (int r = 0; r < 16; ++r) uv[r] *= aI[r];
            }
            float Ag[4], Ug[4];
#pragma unroll
            for (int g = 0; g < 4; ++g) { float A = av[4 * g], U = uv[4 * g];
#pragma unroll
                for (int e = 1; e < 4; ++e) { A *= av[4 * g + e]; U = av[4 * g + e] * U + uv[4 * g + e]; }
                Ag[g] = A; Ug[g] = U; }
            float h = carry[ct], ap = arun[ct];
            float hin[4];
#pragma unroll
            for (int g = 0; g < 4; ++g) {
                const float pA = __shfl_xor(Ag[g], 32), pU = __shfl_xor(Ug[g], 32);
                const float fA = hi ? pA : Ag[g], fU = hi ? pU : Ug[g], sA = hi ? Ag[g] : pA, sU = hi ? Ug[g] : pU;
                const float h1 = fA * h + fU;
                hin[g] = hi ? h1 : h;
                h = sA * h1 + sU; ap *= fA * sA;
            }
            carry[ct] = h; arun[ct] = ap;
            if (FINAL) {
#pragma unroll
                for (int g = 0; g < 4; ++g) { float hh = hin[g];
#pragma unroll
                    for (int e = 0; e < 4; ++e) { const int r = 4 * g + e; hh = av[r] * hh + uv[r]; const float o = hh * aG[r]; ssacc[r] += o * o;
                        OT[crow(r, hi) * 64 + 32 * ct + j] = (u16)(cvt_pk_bf16(o, 0.f) & 0xffffu); } }
            }
        }
        if (FINAL) {
#pragma unroll
            for (int r = 0; r < 16; ++r) {
                const size_t tok = (size_t)b * SEQ + t0 + crow(r, hi);
                float ss = ssacc[r];
                ss += __shfl_xor(ss, 1); ss += __shfl_xor(ss, 2); ss += __shfl_xor(ss, 4); ss += __shfl_xor(ss, 8); ss += __shfl_xor(ss, 16);
                if (j == 0) SSQL[tok * NHEAD + hd] = ss;
            }
            LDS_WAIT(); asm volatile("" ::: "memory");
#pragma unroll
            for (int it = 0; it < 4; ++it) { const int c = lane + 64 * it, row = c >> 3, ch = c & 7;
                const u32x4 w = *(const LAS u32x4*)(OT + row * 64 + 8 * ch);
                *(GAS u32x4*)(LRU + ((size_t)b * SEQ + t0 + row) * D_MODEL + hd * HD + 8 * ch) = w; }
            LDS_WAIT(); asm volatile("" ::: "memory");
        }
    }
    if (!FINAL) { if (hi0 == 0) {
#pragma unroll
        for (int ct = 0; ct < 2; ++ct) { const int c = hd * HD + 32 * ct + j0; *(f32x2*)(AGG + (((size_t)(b * 64 + chunk)) * AW + c) * 2) = (f32x2){arun[ct], carry[ct]}; } } }
}
template <bool FINAL>
__device__ __forceinline__ void lru_phase(Frame& F) {
    for (int it = F.vcu; it < BATCH * 64; it += F.G) { lru_item<FINAL>(F, it >> 6, it & 63); }
}

__device__ __forceinline__ void mix_phase(Frame& F) {
    unsigned char* wsp = F.ws; asm volatile("" : "+s"(wsp));
    const u16* LRU = (const u16*)(wsp + WS_LRU); const u16* ATT = (const u16*)(wsp + WS_ATT);
    const float* SSQL = (const float*)(wsp + WS_SSQL); const float* SSQA = (const float*)(wsp + WS_SSQA); u16* MIX = (u16*)(wsp + WS_MIX);
    const int gw = F.vcu * NWAVES + F.wave, NGW = F.G * NWAVES, lane = F.lane;
    const f32x4 gl0 = *(const f32x4*)(F.lru_out_g() + 8 * lane), gl1 = *(const f32x4*)(F.lru_out_g() + 8 * lane + 4);
    const f32x4 ga0 = *(const f32x4*)(F.attn_out_g() + 8 * lane), ga1 = *(const f32x4*)(F.attn_out_g() + 8 * lane + 4);
    for (int m = gw; m < M_TOK; m += NGW) {
        const f32x4 s0 = *(const GAS f32x4*)(SSQL + (size_t)m * 8), s1 = *(const GAS f32x4*)(SSQL + (size_t)m * 8 + 4);
        const f32x4 t0 = *(const GAS f32x4*)(SSQA + (size_t)m * 8), t1 = *(const GAS f32x4*)(SSQA + (size_t)m * 8 + 4);
        const float ssl = ((s0.x + s0.y) + (s0.z + s0.w)) + ((s1.x + s1.y) + (s1.z + s1.w));
        const float ssa = ((t0.x + t0.y) + (t0.z + t0.w)) + ((t1.x + t1.y) + (t1.z + t1.w));
        const float rl = 1.0f / sqrtf(ssl * (1.0f / AW) + EPS), ra = 1.0f / sqrtf(ssa * (1.0f / AW) + EPS);
        const u32x4 lw = *(const GAS u32x4*)(LRU + (size_t)m * AW + 8 * lane), aw = *(const GAS u32x4*)(ATT + (size_t)m * AW + 8 * lane);
        u32x4 o;
        o.x = cvt_pk_bf16(bf_lo(lw.x) * rl * gl0.x, bf_hi(lw.x) * rl * gl0.y); o.y = cvt_pk_bf16(bf_lo(lw.y) * rl * gl0.z, bf_hi(lw.y) * rl * gl0.w);
        o.z = cvt_pk_bf16(bf_lo(lw.z) * rl * gl1.x, bf_hi(lw.z) * rl * gl1.y); o.w = cvt_pk_bf16(bf_lo(lw.w) * rl * gl1.z, bf_hi(lw.w) * rl * gl1.w);
        *(GAS u32x4*)(MIX + (size_t)m * D_MODEL + 8 * lane) = o;
        o.x = cvt_pk_bf16(bf_lo(aw.x) * ra * ga0.x, bf_hi(aw.x) * ra * ga0.y); o.y = cvt_pk_bf16(bf_lo(aw.y) * ra * ga0.z, bf_hi(aw.y) * ra * ga0.w);
        o.z = cvt_pk_bf16(bf_lo(aw.z) * ra * ga1.x, bf_hi(aw.z) * ra * ga1.y); o.w = cvt_pk_bf16(bf_lo(aw.w) * ra * ga1.z, bf_hi(aw.w) * ra * ga1.w);
        *(GAS u32x4*)(MIX + (size_t)m * D_MODEL + AW + 8 * lane) = o;
    }
}

__device__ __forceinline__ void ffn_fixup(Frame& F, unsigned char* wsp, int pm) {
    const float* RAW = (const float*)(wsp + WS_RAW); unsigned char* ACT = wsp + WS_ACT;
    const float* cw = F.ffn_conv_w(); const float* cb = F.ffn_conv_b();
    const bool first = (pm % NBLK) == 0;
    for (int f = F.tid; f < D_FF; f += NT) {
        float xg[4], xv[4];
        xg[0] = first ? 0.f : RAW[((size_t)(pm - 1) * 4 + 2) * N_UP + f]; xg[1] = first ? 0.f : RAW[((size_t)(pm - 1) * 4 + 3) * N_UP + f];
        xv[0] = first ? 0.f : RAW[((size_t)(pm - 1) * 4 + 2) * N_UP + D_FF + f]; xv[1] = first ? 0.f : RAW[((size_t)(pm - 1) * 4 + 3) * N_UP + D_FF + f];
        xg[2] = RAW[((size_t)pm * 4 + 0) * N_UP + f]; xg[3] = RAW[((size_t)pm * 4 + 1) * N_UP + f];
        xv[2] = RAW[((size_t)pm * 4 + 0) * N_UP + D_FF + f]; xv[3] = RAW[((size_t)pm * 4 + 1) * N_UP + D_FF + f];
        const float wg0 = cw[f], wg1 = cw[N_UP + f], wg2 = cw[2 * N_UP + f], bg = cb[f];
        const float wv0 = cw[D_FF + f], wv1 = cw[N_UP + D_FF + f], wv2 = cw[2 * N_UP + D_FF + f], bv = cb[D_FF + f];
#pragma unroll
        for (int r = 0; r < 2; ++r) {
            const float cg = ((wg0 * xg[r] + wg1 * xg[r + 1]) + wg2 * xg[r + 2]) + bg;
            const float cv = ((wv0 * xv[r] + wv1 * xv[r + 1]) + wv2 * xv[r + 2]) + bv;
            ACT[((size_t)pm * 256 + r) * D_FF + f] = (unsigned char)(cvt_pk_fp8x4(cg * sigmoidf_(cg) * cv * ACT_SCALE, 0.f, 0.f, 0.f) & 0xffu);
        }
    }
}

constexpr int N_PHASES = 10;
__global__ void __launch_bounds__(NT, 2) hymba_fwd(Args args) {
    extern __shared__ __attribute__((aligned(16))) unsigned char lds_raw[];
    Frame F;
    F.lds = (LAS unsigned char*)lds_raw;
    F.tid = threadIdx.x; F.lane = F.tid & 63; F.wave = __builtin_amdgcn_readfirstlane(F.tid >> 6); F.wave0 = F.wave;
    F.G = gridDim.x; { const int bx = blockIdx.x; F.vcu = (F.G % 8 == 0) ? (bx % 8) * (F.G / 8) + bx / 8 : bx; }
    F.pa = &args;
    F.out = args.out; F.ws = args.ws;
    volatile LAS unsigned* MISC = (volatile LAS unsigned*)(F.lds + MISC_OFF);
    if (F.tid < 32) MISC[F.tid] = 0u;
    __syncthreads();
    const int lo = args.ph_lo, hi = args.ph_hi;
#ifndef PROBE_PH
#define PROBE_PH -1
#endif
    unsigned long long tpa = 0, tpb = 0;
#define TP_A(k) do { if ((k) == PROBE_PH) tpa = __builtin_amdgcn_s_memrealtime(); } while (0)
#define TP_B(k) do { if ((k) == PROBE_PH) tpb = __builtin_amdgcn_s_memrealtime(); } while (0)
    unsigned* ctl = (unsigned*)(F.ws + WS_CTL);
    XcdBarrier bar; bar.bar = ctl + CW_BAR; bar.x = 0; bar.st = nullptr;
    if (hi - lo > 1) bar = xcd_barrier_post(ctl + CW_BAR, MISC + 8);
#ifndef PHASE_MASK
#define PHASE_MASK 0x3FF
#endif
#define IN(k) (((PHASE_MASK >> (k)) & 1) && lo <= (k) && (k) < hi)
#ifndef DUP_MASK
#define DUP_MASK 0
#endif
#define REP(k) _Pragma("unroll 1") for (int rep_ = 0; rep_ < 1 + ((DUP_MASK >> (k)) & 1); ++rep_)
#ifndef XBAR
#define XBAR 0
#endif
#define SEAM(k) do { if (IN(k) && IN((k) + 1)) { xcd_barrier(bar, F.wave0 * 64 + lane_id()); for (int xb_ = 0; xb_ < XBAR; ++xb_) xcd_barrier(bar, F.wave0 * 64 + lane_id()); } } while (0)
#define MOD ((float*)(wsp + WS_MOD))
#define H ((u16*)(wsp + WS_H))

    TP_A(0);
    if (IN(0)) { unsigned char* wsp = F.ws; asm volatile("" : "+s"(wsp)); { int t_ = F.wave0 * 64 + lane_id(); asm volatile("" : "+v"(t_)); F.tid = t_; F.lane = t_ & 63; F.wave = __builtin_amdgcn_readfirstlane(t_ >> 6); } REP(0) p0_prologue(F); SEAM(0); }
    TP_B(0);
    TP_A(1);
    if (IN(1)) { unsigned char* wsp = F.ws; asm volatile("" : "+s"(wsp)); { int t_ = F.wave0 * 64 + lane_id(); asm volatile("" : "+v"(t_)); F.tid = t_; F.lane = t_ & 63; F.wave = __builtin_amdgcn_readfirstlane(t_ >> 6); } REP(1) { p1_upweights(F, wsp); rownorm_phase<true>(F, F.x(), F.norm1_g(), MOD + 0, MOD + 1024, H); } SEAM(1); }
    TP_B(1);
    TP_A(2);
    if (IN(2)) { unsigned char* wsp = F.ws; asm volatile("" : "+s"(wsp)); { int t_ = F.wave0 * 64 + lane_id(); asm volatile("" : "+v"(t_)); F.tid = t_; F.lane = t_ & 63; F.wave = __builtin_amdgcn_readfirstlane(t_ >> 6); }
        pg8::Gemm g{H, (const u16*)(wsp + WS_WIN), M_TOK, N_IN, D_MODEL, 0}; pg8::StaticOrder S; S.init(M_TOK, N_IN, F.G, (int)blockIdx.x);
        pg8::EpiInProj E{(float*)(wsp + WS_QF), (u16*)(wsp + WS_KB), (u16*)(wsp + WS_VT), (u16*)(wsp + WS_XR), (u16*)(wsp + WS_GG), (float*)(wsp + WS_KM), F.q_norm_g(), F.k_norm_g()};
        REP(2) pg8::gemm_phase<pg8::EpiInProj, pg8::StaticOrder, true, true, true>(F.lds, g, S, E, F.wave0);
        SEAM(2);
    }
    TP_B(2);
    TP_A(3);
    if (IN(3)) { unsigned char* wsp = F.ws; asm volatile("" : "+s"(wsp)); { int t_ = F.wave0 * 64 + lane_id(); asm volatile("" : "+v"(t_)); F.tid = t_; F.lane = t_ & 63; F.wave = __builtin_amdgcn_readfirstlane(t_ >> 6); }
        cb2_prep(F, wsp); REP(13) lru_phase<false>(F);
        asm volatile("s_waitcnt vmcnt(0)" ::: "memory"); __syncthreads();
        if (F.tid == 0) { __builtin_amdgcn_fence(__ATOMIC_RELEASE, "agent"); asm volatile("s_waitcnt vmcnt(0)" ::: "memory"); (void)__hip_atomic_fetch_add(ctl + CW_AGGCNT, 1u, __ATOMIC_RELAXED, __HIP_MEMORY_SCOPE_AGENT); }
        { int t_ = F.wave0 * 64 + lane_id(); asm volatile("" : "+v"(t_)); F.tid = t_; F.lane = t_ & 63; F.wave = __builtin_amdgcn_readfirstlane(t_ >> 6); } REP(3) attn_phase(F);
        { int t_ = F.wave0 * 64 + lane_id(); asm volatile("" : "+v"(t_)); F.tid = t_; F.lane = t_ & 63; F.wave = __builtin_amdgcn_readfirstlane(t_ >> 6); }
        if (F.tid < 64) { unsigned sp = 0;
            while ((unsigned)__builtin_amdgcn_readfirstlane(__hip_atomic_load(ctl + CW_AGGCNT, __ATOMIC_RELAXED, __HIP_MEMORY_SCOPE_AGENT)) < (unsigned)F.G) {
                __builtin_amdgcn_s_sleep(2); if (++sp > (1u << 20)) { if (F.tid == 0) atomicAdd(ctl + CW_BAR + XB_TMO, 1u); break; } }
            __builtin_amdgcn_fence(__ATOMIC_ACQUIRE, "agent"); asm volatile("s_waitcnt vmcnt(0)" ::: "memory"); }
        __syncthreads();
        REP(4) lru_phase<true>(F);
        if (IN(3) && IN(6)) xcd_barrier(bar, F.wave0 * 64 + lane_id()); }
    TP_B(3);
    TP_A(4);
    TP_B(4);
    TP_A(6);
    if (IN(6)) { unsigned char* wsp = F.ws; asm volatile("" : "+s"(wsp)); { int t_ = F.wave0 * 64 + lane_id(); asm volatile("" : "+v"(t_)); F.tid = t_; F.lane = t_ & 63; F.wave = __builtin_amdgcn_readfirstlane(t_ >> 6); }
        pg8::Gemm g{(const u16*)(wsp + WS_MIX), (const u16*)(wsp + WS_WO), M_TOK, D_MODEL, D_MODEL, 0}; pg8::StaticOrder S; S.init(M_TOK, D_MODEL, F.G, (int)blockIdx.x);
        LAS f32x2* RT = (LAS f32x2*)(F.lds + XB_OFF);
        { const float* SSQL = (const float*)(wsp + WS_SSQL); const float* SSQA = (const float*)(wsp + WS_SSQA);
          for (int i = 0; i < 8; ++i) { pg8::Unit uu; if (!S.next(i, uu)) break;
              if (F.tid < 256) { const size_t row = (size_t)uu.pm * 256 + F.tid;
                  const f32x4 s0 = *(const f32x4*)(SSQL + row * 8), s1 = *(const f32x4*)(SSQL + row * 8 + 4), t0 = *(const f32x4*)(SSQA + row * 8), t1 = *(const f32x4*)(SSQA + row * 8 + 4);
                  const float ssl = ((s0[0] + s0[1]) + (s0[2] + s0[3])) + ((s1[0] + s1[1]) + (s1[2] + s1[3])), ssa = ((t0[0] + t0[1]) + (t0[2] + t0[3])) + ((t1[0] + t1[1]) + (t1[2] + t1[3]));
                  const float rl = 1.0f / sqrtf(ssl * (1.0f / AW) + EPS), ra = 1.0f / sqrtf(ssa * (1.0f / AW) + EPS);
                  RT[i * 256 + F.tid] = (f32x2){rl / ra, ra}; } }
          __syncthreads(); }
        pg8::EpiOut E{F.x(), H, (float*)(wsp + WS_SSQX), MOD + 2048, RT};
        REP(6) pg8::gemm_phase<pg8::EpiOut, pg8::StaticOrder, true, true, false>(F.lds, g, S, E, F.wave0);
        if (IN(6) && IN(8)) xcd_barrier(bar, F.wave0 * 64 + lane_id());
    }
    TP_B(6);
    TP_A(8);
    if (IN(8)) { unsigned char* wsp = F.ws; asm volatile("" : "+s"(wsp)); { int t_ = F.wave0 * 64 + lane_id(); asm volatile("" : "+v"(t_)); F.tid = t_; F.lane = t_ & 63; F.wave = __builtin_amdgcn_readfirstlane(t_ >> 6); }
        pg8::Gemm g{H, (const u16*)(wsp + WS_WUP4), M_TOK, N_UP, D_MODEL, (size_t)N_UP * D_MODEL * 2}; pg8::StaticOrder S; S.init(M_TOK, N_UP, F.G, (int)blockIdx.x);
        LAS float* R2ALL = (LAS float*)(F.lds + XB_OFF + 8192); LAS float* CT = (LAS float*)(F.lds + XB_OFF + 8192 + 12 * 1024);
        { const float* SSQX = (const float*)(wsp + WS_SSQX);
          for (int i = 0; i < 12; ++i) { pg8::Unit uu; if (!S.next(i, uu)) break;
              if (F.tid < 256) { const size_t row = (size_t)uu.pm * 256 + F.tid;
                  const f32x4 s0 = *(const f32x4*)(SSQX + row * 16), s1 = *(const f32x4*)(SSQX + row * 16 + 4), s2 = *(const f32x4*)(SSQX + row * 16 + 8), s3 = *(const f32x4*)(SSQX + row * 16 + 12);
                  const float ss = (((s0[0] + s0[1]) + (s0[2] + s0[3])) + ((s1[0] + s1[1]) + (s1[2] + s1[3]))) + (((s2[0] + s2[1]) + (s2[2] + s2[3])) + ((s3[0] + s3[1]) + (s3[2] + s3[3])));
                  R2ALL[i * 256 + F.tid] = 1.0f / sqrtf(ss * (1.0f / D_MODEL) + EPS); } }
          __syncthreads(); }
        pg8::EpiFFN E{wsp + WS_ACT, (float*)(wsp + WS_RAW), F.ffn_conv_w(), (const float*)(wsp + WS_CB2), (LAS float*)(F.lds + XB_OFF), (const float*)(wsp + WS_SSQX), (const float*)(wsp + WS_BIAS2), R2ALL, CT};
        REP(8) pg8::gemm_phase<pg8::EpiFFN, pg8::StaticOrder, true, true, false>(F.lds, g, S, E, F.wave0);
        SEAM(8);
    }
    TP_B(8);
    TP_A(9);
    if (IN(9)) { unsigned char* wsp = F.ws; asm volatile("" : "+s"(wsp)); { int t_ = F.wave0 * 64 + lane_id(); asm volatile("" : "+v"(t_)); F.tid = t_; F.lane = t_ & 63; F.wave = __builtin_amdgcn_readfirstlane(t_ >> 6); }
        pg8::Gemm g{(const u16*)(wsp + WS_ACT), (const u16*)(wsp + WS_WDN), M_TOK, D_MODEL, D_FF / 2  , 0}; pg8::StaticOrder S; S.init(M_TOK, D_MODEL, F.G, (int)blockIdx.x);
        { pg8::Unit u0, u1; int pm0 = -1; if (S.next(0, u0)) { pm0 = u0.pm; ffn_fixup(F, wsp, pm0); } if (S.next(1, u1) && u1.pm != pm0) ffn_fixup(F, wsp, u1.pm);
          for (int i = 2; ; ++i) { pg8::Unit ux; if (!S.next(i, ux)) break; ffn_fixup(F, wsp, ux.pm); }
          asm volatile("s_waitcnt vmcnt(0)" ::: "memory"); __syncthreads(); }
        pg8::EpiResidB E{H, F.out, MOD + 5120, 1.0f / (ACT_SCALE * WDN_SCALE)};
        REP(9) pg8::gemm_phase<pg8::EpiResidB, pg8::StaticOrder, true, true, 2>(F.lds, g, S, E, F.wave0);
    }
    TP_B(9);
    if (PROBE_PH >= 0 && blockIdx.x == 0) { const unsigned long long t0 = __builtin_amdgcn_s_memrealtime(); const unsigned long long want = 4ull * (tpb - tpa);
        while (__builtin_amdgcn_s_memrealtime() - t0 < want) __builtin_amdgcn_s_sleep(8); }
    if (hi - lo > 1 && hi == N_PHASES) {
        if (xb_ld(ctl + CW_BAR + XB_TMO) != 0u) { asm volatile("s_waitcnt vmcnt(0)" ::: "memory"); __syncthreads();
            const int t9 = F.wave0 * 64 + lane_id();
            for (size_t i = (size_t)blockIdx.x * NT + t9; i < (size_t)M_TOK * D_MODEL; i += (size_t)F.G * NT) F.out[i] = __builtin_nanf(""); }
    }
#undef IN
#undef MOD
#undef H
#undef SEAM
}

#ifndef MK_PER_PHASE
#define MK_PER_PHASE 0
#endif
extern "C" void kernel_launch(void* const* d_in, const int* in_sizes, int n_in, void* d_out, int out_size, void* d_ws, size_t ws_size, hipStream_t stream) {
    static int grid = 0;
    if (grid == 0) {
        if (n_in != 23 || in_sizes[0] != M_TOK * D_MODEL || out_size != M_TOK * D_MODEL || ws_size < WS_END) {
            fprintf(stderr, "kernel_launch: unexpected shapes (n_in %d, in0 %d, out %d, ws %zu); nothing launched\n", n_in, n_in > 0 ? in_sizes[0] : -1, out_size, ws_size); grid = -1; return; }
        int dev = 0, cus = 0;
        if (hipGetDevice(&dev) != hipSuccess || hipDeviceGetAttribute(&cus, hipDeviceAttributeMultiprocessorCount, dev) != hipSuccess) { grid = -1; return; }
        if (hipFuncSetAttribute((const void*)hymba_fwd, hipFuncAttributeMaxDynamicSharedMemorySize, LDS_BYTES) != hipSuccess) { fprintf(stderr, "kernel_launch: hipFuncSetAttribute failed\n"); grid = -1; return; }
        grid = cus;
    }
    if (grid < 0) return;
    (void)hipMemsetAsync((char*)d_ws + WS_CTL, 0, CTL_ZERO_BYTES, stream);
    Args a{};
    for (int i = 0; i < 23; ++i) a.in[i] = (const float*)d_in[i];
    a.out = (float*)d_out; a.ws = (unsigned char*)d_ws;
#if MK_PER_PHASE
    for (int p = 0; p < N_PHASES; ++p) { a.ph_lo = p; a.ph_hi = p + 1; hipLaunchKernelGGL(hymba_fwd, dim3(grid), dim3(NT), LDS_BYTES, stream, a); }
#else
    a.ph_lo = 0; a.ph_hi = N_PHASES; hipLaunchKernelGGL(hymba_fwd, dim3(grid), dim3(NT), LDS_BYTES, stream, a);
#endif
}
```
